# Optimizing an MI355X kernel written in HIP

```python
import jax, jax.numpy as jnp
from jax import lax
import numpy as np

D_MODEL = 1024
BATCH = 16
SEQ = 2048
DEPTH = 2

GRID_W = 64
CTX_LEN = 256
N_HEADS_A = 8
N_KV_A = 2
HEAD_DIM_A = 64
WINDOW = 128
MLA_HEADS = 8
MLA_Q_RANK = 384
MLA_KV_RANK = 256
MLA_NOPE = 64
MLA_ROPE = 32
MLA_V = 64
N_HEADS_C = 8
N_KV_C = 2
HEAD_DIM_C = 128
N_EXPERTS = 32
TOP_K = 4
D_FF = 1024
SWIGLU_ALPHA = 1.702
SWIGLU_LIMIT = 7.0
Q_BLOCK = 128
EXPERT_BLOCK = 128
ROPE_THETA = 10000.0
RMS_EPS = 1e-6
NEG_INF = -1e30
N_EVEN = (DEPTH + 1) // 2
N_ODD = DEPTH // 2
AB_SPLIT_SIZES = [N_HEADS_A * HEAD_DIM_A, N_KV_A * HEAD_DIM_A, N_KV_A * HEAD_DIM_A,
                  MLA_Q_RANK, MLA_KV_RANK, MLA_ROPE]
AB_IN = sum(AB_SPLIT_SIZES)
AB_OUT = N_HEADS_A * HEAD_DIM_A + MLA_HEADS * MLA_V
C_IN = (N_HEADS_C + 2 * N_KV_C) * HEAD_DIM_C
C_OUT = N_HEADS_C * HEAD_DIM_C

kernel_name = "hybrid_swa_mla_gqa2d_moe_dit"


def rms_norm(x, g):
    xf = x.astype(jnp.float32)
    y = xf * lax.rsqrt(jnp.mean(xf * xf, axis=-1, keepdims=True) + RMS_EPS)
    return (y * g.astype(jnp.float32)).astype(x.dtype)


def grid_positions(n_tokens):
    n_rows = n_tokens // GRID_W
    rows = jnp.broadcast_to(jnp.arange(n_rows, dtype=jnp.int32)[:, None], (n_rows, GRID_W)).reshape(-1)
    cols = jnp.broadcast_to(jnp.arange(GRID_W, dtype=jnp.int32)[None, :], (n_rows, GRID_W)).reshape(-1)
    return rows, cols


def axial_rope_table(rows, cols, rot_dim):
    quarter = rot_dim // 4
    inv = ROPE_THETA ** (-jnp.arange(quarter, dtype=jnp.float32) / quarter)
    ang = jnp.concatenate([rows.astype(jnp.float32)[:, None] * inv,
                           cols.astype(jnp.float32)[:, None] * inv], axis=-1)
    return jnp.cos(ang), jnp.sin(ang)


def apply_rope(x, table):
    cos, sin = table
    cos = cos.astype(x.dtype)
    sin = sin.astype(x.dtype)
    x1, x2 = jnp.split(x, 2, axis=-1)
    return jnp.concatenate([x1 * cos - x2 * sin, x2 * cos + x1 * sin], axis=-1)


def heads_to_tokens(o):
    b, hk, g, t, d = o.shape
    return o.transpose(0, 3, 1, 2, 4).reshape(b, t, hk * g * d)


def sdpa(q, k, v, mask=None, sink=None):
    s = jnp.einsum('bhgqd,bhkd->bhgqk', q, k, preferred_element_type=jnp.float32)
    if mask is not None:
        s = jnp.where(mask, s, NEG_INF)
    if sink is None:
        p = jax.nn.softmax(s, axis=-1)
    else:
        sk = sink.astype(jnp.float32)[None, :, :, None, None]
        m = jnp.maximum(jnp.max(s, axis=-1, keepdims=True), sk)
        e = jnp.exp(s - m)
        p = e / (jnp.sum(e, axis=-1, keepdims=True) + jnp.exp(sk - m))
    return jnp.einsum('bhgqk,bhkd->bhgqd', p.astype(v.dtype), v)


def dense_block_attention(q, k, v):
    b, hk, g, t, _ = q.shape
    nb = t // Q_BLOCK

    def one(i):
        qb = lax.dynamic_slice_in_dim(q, i * Q_BLOCK, Q_BLOCK, axis=3)
        return sdpa(qb, k, v)

    out = lax.map(one, jnp.arange(nb))
    return jnp.moveaxis(out, 0, 3).reshape(b, hk, g, t, v.shape[-1])


def window_block_attention(q, k, v, k_ctx, v_ctx, sink):
    b, hk, g, t, _ = q.shape
    nb = t // Q_BLOCK
    pad = ((0, 0), (0, 0), (Q_BLOCK, Q_BLOCK), (0, 0))
    kp = jnp.pad(k, pad)
    vp = jnp.pad(v, pad)
    qi = jnp.arange(Q_BLOCK, dtype=jnp.int32)[:, None]
    kj = jnp.arange(3 * Q_BLOCK, dtype=jnp.int32)[None, :]
    ctx_ok = jnp.ones((Q_BLOCK, k_ctx.shape[2]), dtype=bool)

    def one(i):
        qb = lax.dynamic_slice_in_dim(q, i * Q_BLOCK, Q_BLOCK, axis=3)
        kb = lax.dynamic_slice_in_dim(kp, i * Q_BLOCK, 3 * Q_BLOCK, axis=2)
        vb = lax.dynamic_slice_in_dim(vp, i * Q_BLOCK, 3 * Q_BLOCK, axis=2)
        qpos = i * Q_BLOCK + qi
        kpos = (i - 1) * Q_BLOCK + kj
        ok = (jnp.abs(kpos - qpos) <= WINDOW) & (kpos >= 0) & (kpos < t)
        mask = jnp.concatenate([ok, ctx_ok], axis=-1)
        return sdpa(qb, jnp.concatenate([kb, k_ctx], axis=2), jnp.concatenate([vb, v_ctx], axis=2), mask, sink)

    out = lax.map(one, jnp.arange(nb))
    return jnp.moveaxis(out, 0, 3).reshape(b, hk, g, t, v.shape[-1])


def ab_heads(h, w_in, q_g, wq_b, kv_g, wkv_b, rope_a, rope_b):
    bn, t, _ = h.shape
    splits = np.cumsum(AB_SPLIT_SIZES)[:-1].tolist()
    qa, ka, va, cq, ckv, kr = jnp.split(h @ w_in, splits, axis=-1)
    qa = qa.reshape(bn, t, N_KV_A, N_HEADS_A // N_KV_A, HEAD_DIM_A).transpose(0, 2, 3, 1, 4)
    ka = ka.reshape(bn, t, N_KV_A, HEAD_DIM_A).transpose(0, 2, 1, 3)
    va = va.reshape(bn, t, N_KV_A, HEAD_DIM_A).transpose(0, 2, 1, 3)
    qb = (rms_norm(cq, q_g) @ wq_b).reshape(bn, t, MLA_HEADS, MLA_NOPE + MLA_ROPE).transpose(0, 2, 1, 3)
    kvb = (rms_norm(ckv, kv_g) @ wkv_b).reshape(bn, t, MLA_HEADS, MLA_NOPE + MLA_V).transpose(0, 2, 1, 3)
    q_nope, q_rope = qb[..., :MLA_NOPE], qb[..., MLA_NOPE:]
    k_nope, vb = kvb[..., :MLA_NOPE], kvb[..., MLA_NOPE:]
    kr = kr[:, None]
    if rope_a is not None:
        qa = apply_rope(qa, rope_a)
        ka = apply_rope(ka, rope_a)
        q_rope = apply_rope(q_rope, rope_b)
        kr = apply_rope(kr, rope_b)
    qa = qa * HEAD_DIM_A ** -0.5
    qb = jnp.concatenate([q_nope, q_rope], axis=-1)[:, :, None] * (MLA_NOPE + MLA_ROPE) ** -0.5
    kb = jnp.concatenate([k_nope, jnp.broadcast_to(kr, k_nope.shape[:-1] + (MLA_ROPE,))], axis=-1)
    return qa, ka, va, qb, kb, vb


def mixer_ab(h, hc, w_in, q_g, wq_b, kv_g, wkv_b, sink, w_out, rope_a, rope_b, with_ctx_out):
    qa, ka, va, qb, kb, vb = ab_heads(h, w_in, q_g, wq_b, kv_g, wkv_b, rope_a, rope_b)
    qa_c, ka_c, va_c, qb_c, kb_c, vb_c = ab_heads(hc, w_in, q_g, wq_b, kv_g, wkv_b, None, None)
    sink = sink.reshape(N_KV_A, N_HEADS_A // N_KV_A)
    oa = window_block_attention(qa, ka, va, ka_c, va_c, sink)
    ob = dense_block_attention(qb, jnp.concatenate([kb, kb_c], axis=2), jnp.concatenate([vb, vb_c], axis=2))
    y = jnp.concatenate([heads_to_tokens(oa), heads_to_tokens(ob)], axis=-1) @ w_out
    yc = None
    if with_ctx_out:
        oa_c = sdpa(qa_c, ka_c, va_c, None, sink)
        ob_c = sdpa(qb_c, kb_c, vb_c)
        yc = jnp.concatenate([heads_to_tokens(oa_c), heads_to_tokens(ob_c)], axis=-1) @ w_out
    return y, yc


def c_heads(h, w_in, qn_g, kn_g, rope):
    bn, t, _ = h.shape
    q, k, v = jnp.split(h @ w_in, [N_HEADS_C * HEAD_DIM_C, (N_HEADS_C + N_KV_C) * HEAD_DIM_C], axis=-1)
    q = rms_norm(q.reshape(bn, t, N_KV_C, N_HEADS_C // N_KV_C, HEAD_DIM_C), qn_g).transpose(0, 2, 3, 1, 4)
    k = rms_norm(k.reshape(bn, t, N_KV_C, HEAD_DIM_C), kn_g).transpose(0, 2, 1, 3)
    v = v.reshape(bn, t, N_KV_C, HEAD_DIM_C).transpose(0, 2, 1, 3)
    if rope is not None:
        q = apply_rope(q, rope)
        k = apply_rope(k, rope)
    return q * HEAD_DIM_C ** -0.5, k, v


def mixer_c(h, hc, w_in, qn_g, kn_g, w_out, rope_c, with_ctx_out):
    q, k, v = c_heads(h, w_in, qn_g, kn_g, rope_c)
    q_c, k_c, v_c = c_heads(hc, w_in, qn_g, kn_g, None)
    o = dense_block_attention(q, jnp.concatenate([k, k_c], axis=2), jnp.concatenate([v, v_c], axis=2))
    y = heads_to_tokens(o) @ w_out
    yc = None
    if with_ctx_out:
        yc = heads_to_tokens(sdpa(q_c, k_c, v_c)) @ w_out
    return y, yc


def clamped_swiglu(u):
    glu = jnp.minimum(u[..., ::2], SWIGLU_LIMIT)
    lin = jnp.clip(u[..., 1::2], -SWIGLU_LIMIT, SWIGLU_LIMIT)
    return glu * jax.nn.sigmoid(SWIGLU_ALPHA * glu) * (lin + 1)


def moe(h, router_w, router_b, w_in, b_in, w_out, b_out):
    n_tok, d = h.shape
    logits = (h @ router_w + router_b).astype(jnp.float32)
    top_vals, top_idx = lax.top_k(logits, TOP_K)
    gates = jax.nn.softmax(top_vals, axis=-1)
    n_assign = n_tok * TOP_K
    e_flat = top_idx.reshape(-1).astype(jnp.int32)
    tok_flat = jnp.arange(n_assign, dtype=jnp.int32) // TOP_K
    g_flat = gates.reshape(-1)
    order = jnp.argsort(e_flat)
    e_s, tok_s, g_s = e_flat[order], tok_flat[order], g_flat[order]
    counts = jnp.bincount(e_flat, length=N_EXPERTS).astype(jnp.int32)
    starts = jnp.cumsum(counts) - counts
    padded = (counts + EXPERT_BLOCK - 1) // EXPERT_BLOCK * EXPERT_BLOCK
    pends = jnp.cumsum(padded)
    pstarts = pends - padded
    dest = pstarts[e_s] + (jnp.arange(n_assign, dtype=jnp.int32) - starts[e_s])
    n_blocks = (n_assign + N_EXPERTS * (EXPERT_BLOCK - 1) + EXPERT_BLOCK - 1) // EXPERT_BLOCK
    cap = n_blocks * EXPERT_BLOCK
    tok_buf = jnp.zeros((cap,), jnp.int32).at[dest].set(tok_s)
    g_buf = jnp.zeros((cap,), h.dtype).at[dest].set(g_s.astype(h.dtype))
    blk_start = jnp.arange(n_blocks, dtype=jnp.int32) * EXPERT_BLOCK
    blk_expert = jnp.minimum(jnp.searchsorted(pends, blk_start, side='right'), N_EXPERTS - 1)

    def one(args):
        toks, e = args
        u = h[toks] @ w_in[e] + b_in[e]
        return clamped_swiglu(u) @ w_out[e] + b_out[e]

    y = lax.map(one, (tok_buf.reshape(n_blocks, EXPERT_BLOCK), blk_expert)).reshape(cap, d)
    return jnp.zeros_like(h).at[tok_buf].add(y * g_buf[:, None])


def setup_inputs(seed: int = 0) -> dict:
    key = jax.random.key(seed)
    ks = iter(jax.random.split(key, 32))

    def nrm(shape, scale):
        return jax.random.normal(next(ks), shape, jnp.float32) * scale

    def gain(shape):
        return 1.0 + nrm(shape, 0.05)

    return {
        "x": nrm((BATCH, SEQ, D_MODEL), 1.0),
        "c": nrm((BATCH, D_MODEL), 1.0),
        "ctx": nrm((BATCH, CTX_LEN, D_MODEL), 1.0),
        "c_ctx": nrm((D_MODEL,), 1.0),
        "ada_w": nrm((DEPTH, D_MODEL, 6 * D_MODEL), 0.5 * D_MODEL ** -0.5),
        "ada_b": nrm((DEPTH, 6 * D_MODEL), 0.02),
        "norm_mix_g": gain((DEPTH, D_MODEL)),
        "norm_ffn_g": gain((DEPTH, D_MODEL)),
        "ab_w_in": nrm((N_EVEN, D_MODEL, AB_IN), D_MODEL ** -0.5),
        "mla_q_norm_g": gain((N_EVEN, MLA_Q_RANK)),
        "mla_wq_b": nrm((N_EVEN, MLA_Q_RANK, MLA_HEADS * (MLA_NOPE + MLA_ROPE)), MLA_Q_RANK ** -0.5),
        "mla_kv_norm_g": gain((N_EVEN, MLA_KV_RANK)),
        "mla_wkv_b": nrm((N_EVEN, MLA_KV_RANK, MLA_HEADS * (MLA_NOPE + MLA_V)), MLA_KV_RANK ** -0.5),
        "swa_sink": nrm((N_EVEN, N_HEADS_A), 0.5),
        "ab_w_out": nrm((N_EVEN, AB_OUT, D_MODEL), AB_OUT ** -0.5),
        "c_w_in": nrm((N_ODD, D_MODEL, C_IN), D_MODEL ** -0.5),
        "c_q_norm_g": gain((N_ODD, HEAD_DIM_C)),
        "c_k_norm_g": gain((N_ODD, HEAD_DIM_C)),
        "c_w_out": nrm((N_ODD, C_OUT, D_MODEL), C_OUT ** -0.5),
        "router_w": nrm((DEPTH, D_MODEL, N_EXPERTS), D_MODEL ** -0.5),
        "router_b": nrm((DEPTH, N_EXPERTS), 0.01),
        "moe_w_in": nrm((DEPTH, N_EXPERTS, D_MODEL, 2 * D_FF), D_MODEL ** -0.5),
        "moe_b_in": nrm((DEPTH, N_EXPERTS, 2 * D_FF), 0.02),
        "moe_w_out": nrm((DEPTH, N_EXPERTS, D_FF, D_MODEL), D_FF ** -0.5),
        "moe_b_out": nrm((DEPTH, N_EXPERTS, D_MODEL), 0.02),
        "final_norm_g": gain((D_MODEL,)),
    }


def reference(x, c, ctx, c_ctx, ada_w, ada_b, norm_mix_g, norm_ffn_g, ab_w_in, mla_q_norm_g, mla_wq_b,
              mla_kv_norm_g, mla_wkv_b, swa_sink, ab_w_out, c_w_in, c_q_norm_g, c_k_norm_g, c_w_out,
              router_w, router_b, moe_w_in, moe_b_in, moe_w_out, moe_b_out, final_norm_g):
    bn, s, d = x.shape
    n_ctx = ctx.shape[1]
    rows, cols = grid_positions(s)
    rope_a = axial_rope_table(rows, cols, HEAD_DIM_A)
    rope_b = axial_rope_table(rows, cols, MLA_ROPE)
    rope_c = axial_rope_table(rows, cols, HEAD_DIM_C)
    c_act = jax.nn.silu(c)
    cc_act = jax.nn.silu(c_ctx)
    for i in range(DEPTH):
        with_ctx = i < DEPTH - 1
        j = i // 2
        mod = c_act @ ada_w[i] + ada_b[i]
        mod_c = cc_act @ ada_w[i] + ada_b[i]
        sh1, sc1, g1, sh2, sc2, g2 = [m[:, None] for m in jnp.split(mod, 6, axis=-1)]
        sh1c, sc1c, g1c, sh2c, sc2c, g2c = jnp.split(mod_c, 6, axis=-1)
        h = rms_norm(x, norm_mix_g[i]) * (1 + sc1) + sh1
        hc = rms_norm(ctx, norm_mix_g[i]) * (1 + sc1c) + sh1c
        if i % 2 == 0:
            y, yc = mixer_ab(h, hc, ab_w_in[j], mla_q_norm_g[j], mla_wq_b[j], mla_kv_norm_g[j], mla_wkv_b[j],
                             swa_sink[j], ab_w_out[j], rope_a, rope_b, with_ctx)
        else:
            y, yc = mixer_c(h, hc, c_w_in[j], c_q_norm_g[j], c_k_norm_g[j], c_w_out[j], rope_c, with_ctx)
        x = x + g1 * y
        tokens = (rms_norm(x, norm_ffn_g[i]) * (1 + sc2) + sh2).reshape(bn * s, d)
        if with_ctx:
            ctx = ctx + g1c * yc
            hc2 = rms_norm(ctx, norm_ffn_g[i]) * (1 + sc2c) + sh2c
            tokens = jnp.concatenate([tokens, hc2.reshape(bn * n_ctx, d)], axis=0)
        f = moe(tokens, router_w[i], router_b[i], moe_w_in[i], moe_b_in[i], moe_w_out[i], moe_b_out[i])
        x = x + g2 * f[:bn * s].reshape(bn, s, d)
        if with_ctx:
            ctx = ctx + g2c * f[bn * s:].reshape(bn, n_ctx, d)
    return rms_norm(x, final_norm_g)
```

```cpp
#include <hip/hip_runtime.h>
#include <cstdio>
#include <cstdint>

typedef unsigned short bf16_t;
typedef bf16_t act_t;
#define GAS __attribute__((address_space(1)))
#define LAS __attribute__((address_space(3)))

constexpr int DM = 1024, NB = 16, SEQ = 2048, NCX = 256, GRIDW = 64;
constexpr int NLAT = NB * SEQ, NCTX = NB * NCX, NROW = NLAT + NCTX;
constexpr int AB_IN = 1440, C_IN = 1536, PRJ_LD = 1536;
constexpr int NEXP = 32, DFF = 1024;
constexpr int CAP = 155648;
constexpr float RMS_EPS = 1e-6f;
constexpr int NTHR = 512;

constexpr size_t MiB = 1u << 20;
constexpr size_t ASZ = sizeof(act_t);
constexpr size_t WS_CTL = 0, CTL_BYTES = 1 * MiB;
constexpr size_t WS_MOD = 1 * MiB;
constexpr size_t WS_TOKE = 2 * MiB, WS_TOKP = 3 * MiB, WS_TOKG = 4 * MiB;
constexpr size_t WS_RINV = 5 * MiB;
constexpr size_t WS_TAB = 6 * MiB;
constexpr size_t TAB_A = 0, TAB_B = (size_t)SEQ * 32 * 8, TAB_C = TAB_B + (size_t)SEQ * 16 * 8, TAB_QG = TAB_C + (size_t)SEQ * 64 * 8;
constexpr size_t WS_XR = 16 * MiB;
constexpr size_t WS_H = WS_XR + 144 * MiB;
constexpr size_t WS_BIG = WS_H + (size_t)NROW * 1024 * ASZ;
constexpr size_t OFF_PRJ = 0;
constexpr size_t OFF_QB = OFF_PRJ + (size_t)NROW * 1536 * ASZ;
constexpr size_t OFF_KVB = OFF_QB + (size_t)NROW * 768 * ASZ;
constexpr size_t OFF_O = OFF_KVB + (size_t)NROW * 1024 * ASZ;
constexpr size_t BIG_A = OFF_O + (size_t)NROW * 1024 * ASZ;
constexpr size_t BIG_Y = (size_t)CAP * 1024 * ASZ;
constexpr size_t BIG_BYTES = BIG_A > BIG_Y ? BIG_A : BIG_Y;
constexpr size_t WS_ACT = WS_BIG + BIG_BYTES;
constexpr size_t WS_XS = WS_ACT + (size_t)CAP * 1024 * ASZ;
constexpr size_t WS_W = WS_XS + (size_t)CAP * 1024 * ASZ;
constexpr size_t WO_AB = 0;
constexpr size_t WO_QB = WO_AB + (size_t)1536 * 1024 * 2;
constexpr size_t WO_KVB = WO_QB + (size_t)768 * 384 * 2;
constexpr size_t WO_ABO = WO_KVB + (size_t)1024 * 256 * 2;
constexpr size_t WO_C = WO_ABO + (size_t)1024 * 1024 * 2;
constexpr size_t WO_CO = WO_C + (size_t)1536 * 1024 * 2;
constexpr size_t WO_W1 = WO_CO + (size_t)1024 * 1024 * 2;
constexpr size_t WO_W2 = WO_W1 + (size_t)64 * 2048 * 1024 * 2;
constexpr size_t WS_END = WS_W + WO_W2 + (size_t)64 * 1024 * 1024 * 2;

constexpr int CW_CNT = 64;
constexpr int CW_BAR = 4096;

__device__ __forceinline__ float bf2f(bf16_t v) { return __uint_as_float(((unsigned)v) << 16); }
__device__ __forceinline__ bf16_t f2bf(float f) { unsigned u = __float_as_uint(f); return (bf16_t)((u + 0x7fffu + ((u >> 16) & 1u)) >> 16); }
__device__ __forceinline__ float ldA(const float* p) { return *p; }
__device__ __forceinline__ float ldA(const bf16_t* p) { return bf2f(*p); }
__device__ __forceinline__ void stA(float* p, float v) { *p = v; }
__device__ __forceinline__ void stA(bf16_t* p, float v) { *p = f2bf(v); }
template <int N> __device__ __forceinline__ void load_vec(const float* p, float (&o)[N]) {
#pragma unroll
    for (int i = 0; i < N / 4; ++i) { const float4 t = ((const float4*)p)[i]; o[4 * i] = t.x; o[4 * i + 1] = t.y; o[4 * i + 2] = t.z; o[4 * i + 3] = t.w; }
}
template <int N> __device__ __forceinline__ void load_vec(const bf16_t* p, float (&o)[N]) {
#pragma unroll
    for (int i = 0; i < N / 8; ++i) { const uint4 t = ((const uint4*)p)[i];
        o[8 * i] = __uint_as_float(t.x << 16); o[8 * i + 1] = __uint_as_float(t.x & 0xffff0000u); o[8 * i + 2] = __uint_as_float(t.y << 16); o[8 * i + 3] = __uint_as_float(t.y & 0xffff0000u);
        o[8 * i + 4] = __uint_as_float(t.z << 16); o[8 * i + 5] = __uint_as_float(t.z & 0xffff0000u); o[8 * i + 6] = __uint_as_float(t.w << 16); o[8 * i + 7] = __uint_as_float(t.w & 0xffff0000u); }
}
__device__ __forceinline__ float wave_sum(float v) {
#pragma unroll
    for (int o = 1; o < 64; o <<= 1) v += __shfl_xor(v, o);
    return v;
}

__device__ __forceinline__ void wave_sum2(float& a, float& b) {
#pragma unroll
    for (int o = 1; o < 64; o <<= 1) { const float ta = __shfl_xor(a, o), tb = __shfl_xor(b, o); a += ta; b += tb; }
}
__device__ __forceinline__ void ld16f(const float* p, float (&v)[16]) {
#pragma unroll
    for (int i = 0; i < 4; ++i) { const float4 t = ((const float4*)p)[i]; v[4 * i] = t.x; v[4 * i + 1] = t.y; v[4 * i + 2] = t.z; v[4 * i + 3] = t.w; }
}
__device__ __forceinline__ void st16f(float* p, const float (&v)[16]) {
#pragma unroll
    for (int i = 0; i < 4; ++i) ((float4*)p)[i] = make_float4(v[4 * i], v[4 * i + 1], v[4 * i + 2], v[4 * i + 3]);
}
__device__ __forceinline__ unsigned cvtpk2(float lo, float hi) { unsigned r; asm volatile("v_cvt_pk_bf16_f32 %0, %1, %2" : "=v"(r) : "v"(lo), "v"(hi)); return r; }
__device__ __forceinline__ void st16bf(bf16_t* p, const float (&v)[16]) {
    ((uint4*)p)[0] = make_uint4(cvtpk2(v[0], v[1]), cvtpk2(v[2], v[3]), cvtpk2(v[4], v[5]), cvtpk2(v[6], v[7]));
    ((uint4*)p)[1] = make_uint4(cvtpk2(v[8], v[9]), cvtpk2(v[10], v[11]), cvtpk2(v[12], v[13]), cvtpk2(v[14], v[15]));
}

__device__ __forceinline__ void st16f8(unsigned char* p, const float (&v)[16]) {
    int o[4];
#pragma unroll
    for (int j = 0; j < 4; ++j) { const int t = __builtin_amdgcn_cvt_pk_fp8_f32(v[4 * j], v[4 * j + 1], 0, false); o[j] = __builtin_amdgcn_cvt_pk_fp8_f32(v[4 * j + 2], v[4 * j + 3], t, true); }
    *(int4*)p = make_int4(o[0], o[1], o[2], o[3]);
}
#define XB_TMO      128
#define XB_XCNT(j)  (256  + 64 * (j))
#define XB_XSUB(j)  (1280 + 64 * (j))
#define XB_XGEN(j)  (2304 + 64 * (j))
#define XB_TOP      3328
#define XB_TOPGEN   3392
#define XCD_BAR_WORDS 3456
#define XB_SPIN_CAP (1u << 22)
__device__ __forceinline__ unsigned xb_ld(unsigned* p)              { return __hip_atomic_load(p, __ATOMIC_RELAXED, __HIP_MEMORY_SCOPE_AGENT); }
__device__ __forceinline__ unsigned xb_add(unsigned* p, unsigned v) { return __hip_atomic_fetch_add(p, v, __ATOMIC_RELAXED, __HIP_MEMORY_SCOPE_AGENT); }
__device__ __forceinline__ unsigned xb_xcc_id() { return (unsigned)__builtin_amdgcn_s_getreg((3 << 11) | 20) & 0xFu; }
#define XB_SPIN(cond, bar) do { unsigned _sp = 0; while (cond) { __builtin_amdgcn_s_sleep(1); \
    if ((++_sp & 255u) == 0u) { if (xb_ld(&(bar)[XB_TMO])) break; if (_sp > XB_SPIN_CAP) { atomicAdd(&(bar)[XB_TMO], 1u); break; } } } } while (0)
struct XcdBarrier { unsigned* bar; unsigned x; volatile LAS unsigned* st; };
__device__ __forceinline__ bool xb_is_leader(int wave0) { return wave0 == 0 && __builtin_amdgcn_mbcnt_hi(~0u, __builtin_amdgcn_mbcnt_lo(~0u, 0u)) == 0u; }
__device__ __forceinline__ XcdBarrier xcd_barrier_post(unsigned* bar, volatile LAS unsigned* st, int wave0) {
    XcdBarrier b; b.bar = bar; b.x = xb_xcc_id(); b.st = st;
    if (xb_is_leader(wave0)) (void)xb_add(&bar[XB_XCNT(b.x)], 1u);
    return b;
}
__device__ __forceinline__ void xcd_barrier_complete(unsigned* bar, unsigned x, unsigned& nloc, unsigned& nx) {
    const unsigned G = gridDim.x * gridDim.y * gridDim.z;
    unsigned sum, cnt, mine, sp = 0u;
    for (;;) {
        sum = 0u; cnt = 0u; mine = 0u;
#pragma unroll
        for (unsigned j = 0; j < 16; ++j) { const unsigned c = xb_ld(&bar[XB_XCNT(j)]); sum += c; cnt += (c > 0u) ? 1u : 0u; mine = (j == x) ? c : mine; }
        if (sum == G) break;
        __builtin_amdgcn_s_sleep(1);
        if ((++sp & 255u) == 0u) { if (xb_ld(&bar[XB_TMO])) break; if (sp > XB_SPIN_CAP) { atomicAdd(&bar[XB_TMO], 1u); break; } }
    }
    nloc = mine > 0u ? mine : 1u; nx = cnt > 0u ? cnt : 1u;
}
__device__ __forceinline__ void xcd_barrier(const XcdBarrier& b, int wave0) {
    asm volatile("s_waitcnt vmcnt(0)" ::: "memory");
    __syncthreads();
    if (xb_is_leader(wave0)) {
        unsigned* bar = b.bar;
        __builtin_amdgcn_s_waitcnt(0);
        unsigned nloc = b.st[0], nx = b.st[1];
        if (nloc == 0u) { xcd_barrier_complete(bar, b.x, nloc, nx); b.st[0] = nloc; b.st[1] = nx; }
        const unsigned old = xb_add(&bar[XB_XSUB(b.x)], 1u);
        const unsigned gen = old / nloc;
        if (old + 1u == (gen + 1u) * nloc) {
            __builtin_amdgcn_fence(__ATOMIC_RELEASE, "agent");
            asm volatile("s_waitcnt vmcnt(0)" ::: "memory");
            const unsigned og = xb_add(&bar[XB_TOP], 1u);
            const unsigned tg = og / nx;
            if (og + 1u == (tg + 1u) * nx) xb_add(&bar[XB_TOPGEN], 1u);
            else XB_SPIN(xb_ld(&bar[XB_TOPGEN]) == tg, bar);
            __builtin_amdgcn_fence(__ATOMIC_ACQUIRE, "agent");
            xb_add(&bar[XB_XGEN(b.x)], 1u);
            asm volatile("s_waitcnt vmcnt(0)" ::: "memory");
        } else {
            XB_SPIN(xb_ld(&bar[XB_XGEN(b.x)]) == gen, bar);
            __builtin_amdgcn_fence(__ATOMIC_ACQUIRE, "agent");
            asm volatile("s_waitcnt vmcnt(0)" ::: "memory");
        }
    }
    __syncthreads();
}


#ifndef FAST_GEMM
#define FAST_GEMM 1
#endif
namespace pg8 {
#define PG8_LAS __attribute__((address_space(3)))
typedef short bf16x8 __attribute__((ext_vector_type(8)));
typedef float f32x4 __attribute__((ext_vector_type(4)));
typedef unsigned u32x4 __attribute__((ext_vector_type(4)));
constexpr int BM = 256, BK = 64, HALF = 128, HTB = HALF * BK * 2  , STAGE_BYTES = 8 * HTB, NXCD = 8, WGM = 8;

__host__ __device__ __forceinline__ int lds_byte(int r, int c) { const int st = (r >> 4) * 2 + (c >> 5), rr = r & 15, cc = c & 31, ob = rr * 64 + cc * 2; return st * 1024 + (ob ^ (((ob >> 9) & 1) << 5)); }
__host__ __device__ __forceinline__ void stage_rc(int b, int& R, int& C) { const int st = b / 1024, sb = b % 1024, swz = sb ^ (((sb >> 9) & 1) << 5); R = (st >> 1) * 16 + swz / 64; C = (st & 1) * 32 + (swz % 64) / 2; }
__host__ __device__ __forceinline__ int perm32(int rho) { const int n = rho >> 4, i = rho & 15; return 8 * (i >> 2) + 4 * n + (i & 3); }


struct Unit { const char* a; const char* b; int pm, pn, aux; };
__device__ __forceinline__ unsigned cvt_pk_bf16(float lo, float hi) { unsigned r; asm volatile("v_cvt_pk_bf16_f32 %0, %1, %2" : "=v"(r) : "v"(lo), "v"(hi)); return r; }
typedef int v8i32 __attribute__((ext_vector_type(8)));
__device__ __forceinline__ v8i32 cat16(bf16x8 lo, bf16x8 hi) { typedef int v4i32 __attribute__((ext_vector_type(4))); const v4i32 a = __builtin_bit_cast(v4i32, lo), b = __builtin_bit_cast(v4i32, hi); return __builtin_shufflevector(a, b, 0, 1, 2, 3, 4, 5, 6, 7); }
template <class Epi, class Sched, bool ALIGN_EPI = false, bool SP2 = false, bool F8 = false>
__device__ __forceinline__ void gemm_phase(const int tid, PG8_LAS unsigned char* lds, const int K, const int lda, const Sched& S, const Epi& E) {
    const int wid = __builtin_amdgcn_readfirstlane(tid >> 6), lane = tid & 63, wr = wid >> 2, wc = wid & 3, fr = lane & 15, fq = lane >> 4;
    const int nt = F8 ? K / (2 * BK) : K / BK;
    unsigned voffA[2], voffB[2];
#pragma unroll
    for (int i = 0; i < 2; ++i) { int R, C; stage_rc(tid * 16 + i * 8192, R, C); const int Rb = Epi::PERM ? ((R & ~31) + perm32(R & 31)) : R;
        voffA[i] = F8 ? (unsigned)(R * lda + 2 * C) : (unsigned)(R * lda + C) * 2u; voffB[i] = F8 ? (unsigned)(Rb * K + 2 * C) : (unsigned)(Rb * K + C) * 2u; }
    const size_t kstep = (size_t)(BK * 2);
    const size_t hstepA = (size_t)HALF * lda * (F8 ? 1 : 2);
    const size_t hstep = (size_t)HALF * K * (F8 ? 1 : 2);
    const unsigned ldsbase = (unsigned)__builtin_amdgcn_readfirstlane((int)((unsigned)(uintptr_t)lds + (unsigned)wid * 1024u));
    const unsigned ldsw = (unsigned)wid * 1024u;
    const int aoff = lds_byte(wr * 64 + fr, fq * 8), boff = lds_byte(wc * 32 + fr, fq * 8);
#define PG8_SA(b, h) (((b) * 2 + (h)) * HTB)
#define PG8_SB(b, h) ((4 + (b) * 2 + (h)) * HTB)
#define PG8_STAGE(bufoff, gbase, voff) do { _Pragma("unroll") for (int _i = 0; _i < 2; ++_i) { \
        if constexpr (F8) { unsigned keep_; asm volatile("s_mov_b32 %0, m0\n\ts_mov_b32 m0, %3\n\ts_nop 0\n\tglobal_load_lds_dwordx4 %1, %2\n\ts_mov_b32 m0, %0" : "=&s"(keep_) : "v"((voff)[_i]), "s"((const char*)(gbase)), "s"(ldsbase + (unsigned)((bufoff) + _i * 8192)) : "memory"); } \
        else __builtin_amdgcn_global_load_lds((const unsigned*)((const char*)(gbase) + (voff)[_i]), (PG8_LAS unsigned*)(lds + (bufoff) + ldsw + _i * 8192), 16, 0, 0); } } while (0)
#define PG8_LDA(dst, b, h) do { _Pragma("unroll") for (int m = 0; m < 4; ++m) { _Pragma("unroll") for (int k = 0; k < 2; ++k) dst[m][k] = *(const PG8_LAS bf16x8*)(lds + PG8_SA(b, h) + aoff + m * 2048 + k * 1024); \
        if constexpr (F8) dst##8[m] = cat16(dst[m][0], dst[m][1]); } } while (0)
#define PG8_LDB(dst, b, h) do { _Pragma("unroll") for (int n = 0; n < 2; ++n) { _Pragma("unroll") for (int k = 0; k < 2; ++k) dst[n][k] = *(const PG8_LAS bf16x8*)(lds + PG8_SB(b, h) + boff + n * 2048 + k * 1024); \
        if constexpr (F8) dst##8[n] = cat16(dst[n][0], dst[n][1]); } } while (0)
#define PG8_MMA(ai, bj, At, Bt) do { __builtin_amdgcn_s_setprio(1); _Pragma("unroll") for (int m = 0; m < 4; ++m) _Pragma("unroll") for (int n = 0; n < 2; ++n) { \
        if constexpr (F8) acc[ai][bj][m][n] = __builtin_amdgcn_mfma_scale_f32_16x16x128_f8f6f4(Bt##8[n], At##8[m], acc[ai][bj][m][n], 0, 0, 0, 0x7f7f7f7f, 0, 0x7f7f7f7f); \
        else { _Pragma("unroll") for (int k = 0; k < 2; ++k) acc[ai][bj][m][n] = __builtin_amdgcn_mfma_f32_16x16x32_bf16(Bt[n][k], At[m][k], acc[ai][bj][m][n], 0, 0, 0); } } __builtin_amdgcn_s_setprio(0); } while (0)
#define PG8_WAIT_V(n) asm volatile("s_waitcnt vmcnt(" #n ")" ::: "memory")
#define PG8_WAIT_L(n) asm volatile("s_waitcnt lgkmcnt(" #n ")" ::: "memory")
#define PG8_BAR __builtin_amdgcn_s_barrier()
#define PG8_SCHED __builtin_amdgcn_sched_barrier(0)
    Unit cur, nxt; int ui = 0;
    if (!S.next(0, cur)) return;
    f32x4 acc[2][2][4][2];
#pragma unroll
    for (int a = 0; a < 2; ++a)
#pragma unroll
        for (int b = 0; b < 2; ++b)
#pragma unroll
            for (int m = 0; m < 4; ++m)
#pragma unroll
                for (int n = 0; n < 2; ++n) acc[a][b][m][n] = (f32x4){0.f, 0.f, 0.f, 0.f};
    bf16x8 At[4][2], B0[2][2], B1[2][2]; v8i32 At8[4], B08[2], B18[2]; (void)At8; (void)B08; (void)B18;
    const char* cA = cur.a; const char* cB = cur.b;
    S.a_ready(cur);
    if constexpr (SP2) {
        PG8_STAGE(PG8_SB(0, 0), cB, voffB); PG8_STAGE(PG8_SB(0, 1), cB + hstep, voffB); PG8_STAGE(PG8_SA(0, 0), cA, voffA); PG8_STAGE(PG8_SA(0, 1), cA + hstepA, voffA);
        if (wr == 1) PG8_BAR;
        PG8_WAIT_V(2); PG8_BAR;
        PG8_STAGE(PG8_SB(1, 0), cB + kstep, voffB); PG8_STAGE(PG8_SA(1, 0), cA + kstep, voffA); PG8_STAGE(PG8_SB(1, 1), cB + hstep + kstep, voffB);
        PG8_WAIT_V(6); PG8_BAR;
    } else {
        PG8_STAGE(PG8_SB(0, 0), cB, voffB); PG8_STAGE(PG8_SA(0, 0), cA, voffA); PG8_STAGE(PG8_SB(0, 1), cB + hstep, voffB); PG8_STAGE(PG8_SA(0, 1), cA + hstepA, voffA);
        if (wr == 1) PG8_BAR;
        PG8_WAIT_V(4); PG8_BAR;
        PG8_STAGE(PG8_SB(1, 0), cB + kstep, voffB); PG8_STAGE(PG8_SA(1, 0), cA + kstep, voffA); PG8_STAGE(PG8_SB(1, 1), cB + hstep + kstep, voffB);
        PG8_WAIT_V(6); PG8_BAR;
    }
    for (;;) {
        const bool has_next = S.next(ui + 1, nxt);
        const char* nA = has_next ? nxt.a : cA; const char* nB = has_next ? nxt.b : cB;
#pragma unroll 1
        for (int t = 0; t < nt; t += 2) {
            const bool last = (t == nt - 2);
            const char* a1 = cA + (size_t)(t + 1) * kstep;
            const char* a2 = last ? nA : cA + (size_t)(t + 2) * kstep; const char* b2 = last ? nB : cB + (size_t)(t + 2) * kstep;
            const char* a3 = a2 + kstep; const char* b3 = b2 + kstep;
            if (last && has_next) S.a_ready(nxt);
            if constexpr (SP2) {
            PG8_LDB(B0, 0, 0); PG8_LDB(B1, 0, 1); PG8_SCHED; PG8_LDA(At, 0, 0); PG8_STAGE(PG8_SA(1, 1), a1 + hstepA, voffA);
            PG8_WAIT_V(8); PG8_WAIT_L(0); PG8_BAR; PG8_MMA(0, 0, At, B0); PG8_MMA(0, 1, At, B1); PG8_BAR; PG8_SCHED;
            PG8_LDA(At, 0, 1); PG8_STAGE(PG8_SB(0, 0), b2, voffB); PG8_STAGE(PG8_SB(0, 1), b2 + hstep, voffB); PG8_STAGE(PG8_SA(0, 0), a2, voffA);
            PG8_WAIT_V(8); PG8_WAIT_L(0); PG8_BAR; PG8_MMA(1, 0, At, B0); PG8_MMA(1, 1, At, B1); PG8_BAR; PG8_SCHED;
            PG8_LDB(B0, 1, 0); PG8_LDB(B1, 1, 1); PG8_SCHED; PG8_LDA(At, 1, 0); PG8_STAGE(PG8_SA(0, 1), a2 + hstepA, voffA);
            PG8_WAIT_V(8); PG8_WAIT_L(0); PG8_BAR; PG8_MMA(0, 0, At, B0); PG8_MMA(0, 1, At, B1); PG8_BAR; PG8_SCHED;
            PG8_LDA(At, 1, 1); PG8_STAGE(PG8_SB(1, 0), b3, voffB); PG8_STAGE(PG8_SB(1, 1), b3 + hstep, voffB); PG8_STAGE(PG8_SA(1, 0), a3, voffA);
            PG8_WAIT_V(8); PG8_WAIT_L(0); PG8_BAR; PG8_MMA(1, 0, At, B0); PG8_MMA(1, 1, At, B1); PG8_BAR; PG8_SCHED;
            } else {
            PG8_LDB(B0, 0, 0); PG8_SCHED; PG8_LDA(At, 0, 0); PG8_STAGE(PG8_SA(1, 1), a1 + hstepA, voffA);
            PG8_WAIT_L(8); PG8_BAR; PG8_WAIT_L(0); PG8_MMA(0, 0, At, B0); PG8_BAR; PG8_SCHED;
            PG8_LDB(B1, 0, 1); PG8_STAGE(PG8_SB(0, 0), b2, voffB);
            PG8_BAR; PG8_WAIT_L(0); PG8_MMA(0, 1, At, B1); PG8_BAR;
            PG8_LDA(At, 0, 1); PG8_STAGE(PG8_SA(0, 0), a2, voffA);
            PG8_BAR; PG8_WAIT_L(0); PG8_MMA(1, 0, At, B0); PG8_BAR; PG8_SCHED;
            PG8_STAGE(PG8_SB(0, 1), b2 + hstep, voffB);
            PG8_WAIT_V(6); PG8_BAR; PG8_MMA(1, 1, At, B1); PG8_BAR;
            PG8_LDB(B0, 1, 0); PG8_SCHED; PG8_LDA(At, 1, 0); PG8_STAGE(PG8_SA(0, 1), a2 + hstepA, voffA);
            PG8_WAIT_L(8); PG8_BAR; PG8_WAIT_L(0); PG8_MMA(0, 0, At, B0); PG8_BAR; PG8_SCHED;
            PG8_LDB(B1, 1, 1); PG8_STAGE(PG8_SB(1, 0), b3, voffB);
            PG8_BAR; PG8_WAIT_L(0); PG8_MMA(0, 1, At, B1); PG8_BAR;
            PG8_LDA(At, 1, 1); PG8_STAGE(PG8_SA(1, 0), a3, voffA);
            PG8_BAR; PG8_WAIT_L(0); PG8_MMA(1, 0, At, B0); PG8_BAR; PG8_SCHED;
            PG8_STAGE(PG8_SB(1, 1), b3 + hstep, voffB);
            PG8_WAIT_V(6); PG8_BAR; PG8_MMA(1, 1, At, B1); PG8_BAR;
            }
        }
        if constexpr (ALIGN_EPI) { if (wr == 0) PG8_BAR; }
        if constexpr (!Epi::AFTER_DRAIN) { int tl_ = tid; asm volatile("" : "+v"(tl_)); E(acc, cur, wr, wc, tl_ & 15, (tl_ & 63) >> 4); S.done(cur); }
        if (!has_next) break;
#pragma unroll
        for (int a = 0; a < 2; ++a)
#pragma unroll
            for (int b = 0; b < 2; ++b)
#pragma unroll
                for (int m = 0; m < 4; ++m)
#pragma unroll
                    for (int n = 0; n < 2; ++n) acc[a][b][m][n] = (f32x4){0.f, 0.f, 0.f, 0.f};
        cur = nxt; cA = nA; cB = nB; ++ui;
        if constexpr (ALIGN_EPI) { if (wr == 1) PG8_BAR; }
    }
    PG8_WAIT_V(0);
    if constexpr (!ALIGN_EPI) { if (wr == 0) PG8_BAR; }
    PG8_BAR;
    if constexpr (Epi::AFTER_DRAIN) { E.fused(acc, cur, wr, wc, fr, fq, lds, wid, lane); S.done(cur); }
#undef PG8_SA
#undef PG8_SB
#undef PG8_STAGE
#undef PG8_LDA
#undef PG8_LDB
#undef PG8_MMA
#undef PG8_WAIT_V
#undef PG8_WAIT_L
#undef PG8_BAR
#undef PG8_SCHED
}
}
namespace pg8 {
struct OrderMap {
    __device__ __forceinline__ static bool map(int i, int G, int c, int nM, int nN, int& pm, int& pn) {
        const int nwg = nM * nN; const long L = (long)i * G + c; if (L >= nwg) return false;
        int wgid = (int)L; { const int q = nwg / NXCD, r = nwg % NXCD, xcd = wgid % NXCD, off = wgid / NXCD; wgid = (xcd < r ? xcd * (q + 1) : r * (q + 1) + (xcd - r) * q) + off; }
        const int nig = WGM * nN, gid = wgid / nig, fm = gid * WGM, gsz = (nM - fm) < WGM ? (nM - fm) : WGM;
        pm = fm + ((wgid % nig) % gsz); pn = (wgid % nig) / gsz; return true;
    }
};
struct DenseOrder {
    const char* A; const char* B; int nM, nN, G, c; size_t tstepA, tstepB;
    __device__ __forceinline__ bool next(int i, Unit& u) const { int pm, pn; if (!OrderMap::map(i, G, c, nM, nN, pm, pn)) return false; u.pm = pm; u.pn = pn; u.aux = 0; u.a = A + (size_t)pm * tstepA; u.b = B + (size_t)pn * tstepB; return true; }
    __device__ __forceinline__ void a_ready(const Unit&) const {}
    __device__ __forceinline__ void done(const Unit&) const {}
};
struct MoeOrder {
    const char* A; const char* B; const PG8_LAS int* tile_e; int nM, nN, G, c; size_t tstep, estep;
    __device__ __forceinline__ bool next(int i, Unit& u) const { int pm, pn; if (!OrderMap::map(i, G, c, nM, nN, pm, pn)) return false; const int e = __builtin_amdgcn_readfirstlane(tile_e[pm]); u.pm = pm; u.pn = pn; u.aux = e;
        u.a = A + (size_t)pm * tstep; u.b = B + (size_t)e * estep + (size_t)pn * tstep; return true; }
    __device__ __forceinline__ void a_ready(const Unit&) const {}
    __device__ __forceinline__ void done(const Unit&) const {}
};
struct EpiStoreBf16 { static constexpr bool PERM = true, AFTER_DRAIN = false;
    bf16_t* O; int ldc; float ascale;
    __device__ __forceinline__ void operator()(const f32x4 (&acc)[2][2][4][2], const Unit& u, int wr, int wc, int fr, int fq) const {
        bf16_t* base = O + (size_t)(u.pm * BM + wr * 64 + fr) * ldc + u.pn * BM + wc * 32 + 8 * fq;
        float asc = ascale; asm volatile("" : "+v"(asc));
#pragma unroll
        for (int ai = 0; ai < 2; ++ai)
#pragma unroll
            for (int m = 0; m < 4; ++m) { bf16_t* rowp = base + (size_t)(ai * HALF + m * 16) * ldc;
#pragma unroll
                for (int bj = 0; bj < 2; ++bj) { const f32x4 v0 = acc[ai][bj][m][0] * asc, v1 = acc[ai][bj][m][1] * asc; u32x4 w;
                    w.x = cvt_pk_bf16(v0[0], v0[1]); w.y = cvt_pk_bf16(v0[2], v0[3]); w.z = cvt_pk_bf16(v1[0], v1[1]); w.w = cvt_pk_bf16(v1[2], v1[3]);
                    *(u32x4*)(rowp + bj * HALF) = w; } }
    }
};
struct EpiScaleBf16 { static constexpr bool PERM = true, AFTER_DRAIN = false;
    bf16_t* O; int ldc; const float* rs;
    __device__ __forceinline__ void operator()(const f32x4 (&acc)[2][2][4][2], const Unit& u, int wr, int wc, int fr, int fq) const {
        const int row0 = u.pm * BM + wr * 64 + fr; bf16_t* base = O + (size_t)row0 * ldc + u.pn * BM + wc * 32 + 8 * fq;
#pragma unroll
        for (int ai = 0; ai < 2; ++ai)
#pragma unroll
            for (int m = 0; m < 4; ++m) { bf16_t* rowp = base + (size_t)(ai * HALF + m * 16) * ldc; const float sc = rs[2 * (row0 + ai * HALF + m * 16)];
#pragma unroll
                for (int bj = 0; bj < 2; ++bj) { const f32x4 v0 = acc[ai][bj][m][0] * sc, v1 = acc[ai][bj][m][1] * sc; u32x4 w;
                    w.x = cvt_pk_bf16(v0[0], v0[1]); w.y = cvt_pk_bf16(v0[2], v0[3]); w.z = cvt_pk_bf16(v1[0], v1[1]); w.w = cvt_pk_bf16(v1[2], v1[3]);
                    *(u32x4*)(rowp + bj * HALF) = w; } }
    }
};
struct EpiResid { static constexpr bool PERM = true, AFTER_DRAIN = false;
    const float* src_lat; const float* src_ctx; float* out; const float* mod_g1;
    __device__ __forceinline__ void operator()(const f32x4 (&acc)[2][2][4][2], const Unit& u, int wr, int wc, int fr, int fq) const {
        const int row_t = u.pm * BM; const int mrow = row_t < NLAT ? row_t / SEQ : NB;
        const float* g = mod_g1 + (size_t)mrow * 6144 + u.pn * BM + wc * 32 + 8 * fq;
        const float* sb = (row_t < NLAT ? src_lat + (size_t)row_t * 1024 : src_ctx + (size_t)(row_t - NLAT) * 1024) + u.pn * BM + wc * 32 + 8 * fq;
        float* ob = out + (size_t)row_t * 1024 + u.pn * BM + wc * 32 + 8 * fq;
        f32x4 gv[2][2];
#pragma unroll
        for (int bj = 0; bj < 2; ++bj)
#pragma unroll
            for (int n = 0; n < 2; ++n) gv[bj][n] = *(const f32x4*)(g + bj * HALF + 4 * n);
#pragma unroll
        for (int ai = 0; ai < 2; ++ai)
#pragma unroll
            for (int m = 0; m < 4; ++m) { const size_t off = (size_t)(wr * 64 + fr + ai * HALF + m * 16) * 1024;
#pragma unroll
                for (int bj = 0; bj < 2; ++bj)
#pragma unroll
                    for (int n = 0; n < 2; ++n) { const f32x4 sv = *(const f32x4*)(sb + off + bj * HALF + 4 * n); *(f32x4*)(ob + off + bj * HALF + 4 * n) = sv + gv[bj][n] * acc[ai][bj][m][n]; }
                asm volatile("" ::: "memory"); }
    }
};
__device__ __forceinline__ float swiglu1(float g, float l, float c7, float cn) {
    const float glu = fminf(g, c7), lin = fminf(fmaxf(l, -c7), c7);
    const float sg = __builtin_amdgcn_rcpf(1.0f + __builtin_amdgcn_exp2f(cn * glu));
    return glu * sg * (lin + 1.0f);
}
struct EpiSwiglu { static constexpr bool PERM = true, AFTER_DRAIN = false;
    bf16_t* O; const float* bias; float ascale;
    __device__ __forceinline__ void operator()(const f32x4 (&acc)[2][2][4][2], const Unit& u, int wr, int wc, int fr, int fq) const {
        const int col0 = u.pn * BM + wc * 32 + 8 * fq; const float* b = bias + (size_t)u.aux * 2048 + col0;
        float c7 = 7.0f, cn = -1.702f * 1.4426950408889634f; asm volatile("" : "+v"(c7), "+v"(cn));
        bf16_t* base = O + (size_t)(u.pm * BM + wr * 64 + fr) * 1024 + (col0 >> 1);
        f32x4 bv[2][2];
#pragma unroll
        for (int bj = 0; bj < 2; ++bj)
#pragma unroll
            for (int n = 0; n < 2; ++n) bv[bj][n] = *(const f32x4*)(b + bj * HALF + 4 * n);
#pragma unroll
        for (int ai = 0; ai < 2; ++ai)
#pragma unroll
            for (int m = 0; m < 4; ++m) { bf16_t* rowp = base + (size_t)(ai * HALF + m * 16) * 1024;
#pragma unroll
                for (int bj = 0; bj < 2; ++bj) { const f32x4 v0 = acc[ai][bj][m][0] * ascale + bv[bj][0], v1 = acc[ai][bj][m][1] * ascale + bv[bj][1];
                    uint2 w; w.x = cvt_pk_bf16(swiglu1(v0[0], v0[1], c7, cn), swiglu1(v0[2], v0[3], c7, cn)); w.y = cvt_pk_bf16(swiglu1(v1[0], v1[1], c7, cn), swiglu1(v1[2], v1[3], c7, cn));
                    *(uint2*)(rowp + bj * (HALF / 2)) = w; } }
    }
};
struct EpiSwigluF8 { static constexpr bool PERM = true, AFTER_DRAIN = false;
    unsigned char* O; const float* bias;
    __device__ __forceinline__ void operator()(const f32x4 (&acc)[2][2][4][2], const Unit& u, int wr, int wc, int fr, int fq) const {
        const int col0 = u.pn * BM + wc * 32 + 8 * fq; const float* b = bias + (size_t)u.aux * 2048 + col0;
        float c7 = 7.0f, cn = -1.702f * 1.4426950408889634f, c32 = 0.03125f; asm volatile("" : "+v"(c7), "+v"(cn), "+v"(c32));
        unsigned char* base = O + (size_t)(u.pm * BM + wr * 64 + fr) * 1024 + (col0 >> 1);
        f32x4 bv[2][2];
#pragma unroll
        for (int bj = 0; bj < 2; ++bj)
#pragma unroll
            for (int n = 0; n < 2; ++n) bv[bj][n] = *(const f32x4*)(b + bj * HALF + 4 * n);
#pragma unroll
        for (int ai = 0; ai < 2; ++ai)
#pragma unroll
            for (int m = 0; m < 4; ++m) { unsigned char* rowp = base + (size_t)(ai * HALF + m * 16) * 1024;
#pragma unroll
                for (int bj = 0; bj < 2; ++bj) { const f32x4 v0 = acc[ai][bj][m][0] * c32 + bv[bj][0], v1 = acc[ai][bj][m][1] * c32 + bv[bj][1];
                    int w = __builtin_amdgcn_cvt_pk_fp8_f32(swiglu1(v0[0], v0[1], c7, cn), swiglu1(v0[2], v0[3], c7, cn), 0, false); w = __builtin_amdgcn_cvt_pk_fp8_f32(swiglu1(v1[0], v1[1], c7, cn), swiglu1(v1[2], v1[3], c7, cn), w, true);
                    *(int*)(rowp + bj * (HALF / 2)) = w; } }
    }
};
struct EpiBiasF8 { static constexpr bool PERM = true, AFTER_DRAIN = false;
    unsigned char* O; const float* bias; float ascale;
    __device__ __forceinline__ void operator()(const f32x4 (&acc)[2][2][4][2], const Unit& u, int wr, int wc, int fr, int fq) const {
        const int col0 = u.pn * BM + wc * 32 + 8 * fq; const float* b = bias + (size_t)u.aux * 1024 + col0;
        float asc = ascale; asm volatile("" : "+v"(asc));
        unsigned char* base = O + (size_t)(u.pm * BM + wr * 64 + fr) * 1024 + col0;
        f32x4 bv[2][2];
#pragma unroll
        for (int bj = 0; bj < 2; ++bj)
#pragma unroll
            for (int n = 0; n < 2; ++n) bv[bj][n] = *(const f32x4*)(b + bj * HALF + 4 * n);
#pragma unroll
        for (int ai = 0; ai < 2; ++ai)
#pragma unroll
            for (int m = 0; m < 4; ++m) { unsigned char* rowp = base + (size_t)(ai * HALF + m * 16) * 1024;
#pragma unroll
                for (int bj = 0; bj < 2; ++bj) { const f32x4 v0 = acc[ai][bj][m][0] * asc + bv[bj][0], v1 = acc[ai][bj][m][1] * asc + bv[bj][1];
                    int lo = __builtin_amdgcn_cvt_pk_fp8_f32(v0[0], v0[1], 0, false); lo = __builtin_amdgcn_cvt_pk_fp8_f32(v0[2], v0[3], lo, true);
                    int hi = __builtin_amdgcn_cvt_pk_fp8_f32(v1[0], v1[1], 0, false); hi = __builtin_amdgcn_cvt_pk_fp8_f32(v1[2], v1[3], hi, true);
                    *(int2*)(rowp + bj * HALF) = make_int2(lo, hi); } }
    }
};
struct EpiBiasBf16 { static constexpr bool PERM = true, AFTER_DRAIN = false;
    bf16_t* O; const float* bias; float ascale;
    __device__ __forceinline__ void operator()(const f32x4 (&acc)[2][2][4][2], const Unit& u, int wr, int wc, int fr, int fq) const {
        const int col0 = u.pn * BM + wc * 32 + 8 * fq; const float* b = bias + (size_t)u.aux * 1024 + col0;
        float asc = ascale; asm volatile("" : "+v"(asc));
        bf16_t* base = O + (size_t)(u.pm * BM + wr * 64 + fr) * 1024 + col0;
        f32x4 bv[2][2];
#pragma unroll
        for (int bj = 0; bj < 2; ++bj)
#pragma unroll
            for (int n = 0; n < 2; ++n) bv[bj][n] = *(const f32x4*)(b + bj * HALF + 4 * n);
#pragma unroll
        for (int ai = 0; ai < 2; ++ai)
#pragma unroll
            for (int m = 0; m < 4; ++m) { bf16_t* rowp = base + (size_t)(ai * HALF + m * 16) * 1024;
#pragma unroll
                for (int bj = 0; bj < 2; ++bj) { const f32x4 v0 = acc[ai][bj][m][0] * asc + bv[bj][0], v1 = acc[ai][bj][m][1] * asc + bv[bj][1]; u32x4 w;
                    w.x = cvt_pk_bf16(v0[0], v0[1]); w.y = cvt_pk_bf16(v0[2], v0[3]); w.z = cvt_pk_bf16(v1[0], v1[1]); w.w = cvt_pk_bf16(v1[2], v1[3]);
                    *(u32x4*)(rowp + bj * HALF) = w; } }
    }
};
}
__device__ __forceinline__ unsigned pk2(float lo, float hi) { return (unsigned)f2bf(lo) | ((unsigned)f2bf(hi) << 16); }
__device__ __forceinline__ void transpose_item(const float* __restrict__ W, int K, int N, bf16_t* __restrict__ WT, LAS float* scr, int item, int lane, const float* rowscale = nullptr, float cscale = 1.0f, int cs_ncols = 1 << 30) {
    const int nblk = N / 32, kb = item / nblk, nb = item % nblk, k0 = 64 * kb, n0 = 32 * nb;
    const float cs = n0 < cs_ncols ? cscale : 1.0f;
#pragma unroll 8
    for (int i = 0; i < 32; ++i) { const int kk = 2 * i + (lane >> 5); float w = W[(size_t)(k0 + kk) * N + n0 + (lane & 31)]; if (rowscale) w *= rowscale[k0 + kk]; scr[kk * 33 + (lane & 31)] = w * cs; }
    asm volatile("s_waitcnt lgkmcnt(0)" ::: "memory");
    const int c = lane & 7;
#pragma unroll
    for (int j = 0; j < 4; ++j) { const int n = (lane >> 3) + 8 * j; const LAS float* sp = scr + (8 * c) * 33 + n;
        uint4 o; o.x = pk2(sp[0 * 33], sp[1 * 33]); o.y = pk2(sp[2 * 33], sp[3 * 33]); o.z = pk2(sp[4 * 33], sp[5 * 33]); o.w = pk2(sp[6 * 33], sp[7 * 33]);
        *(uint4*)(WT + (size_t)(n0 + n) * K + k0 + 8 * c) = o; }
    asm volatile("s_waitcnt lgkmcnt(0)" ::: "memory");
}

__device__ __forceinline__ void transpose_item_f8(const float* __restrict__ W, int K, int N, unsigned char* __restrict__ WT, LAS float* scr, int item, int lane, float cscale = 1.0f, int cs_ncols = 1 << 30) {
    const int nblk = N / 32, kb = item / nblk, nb = item % nblk, k0 = 64 * kb, n0 = 32 * nb;
    const float cs = 32.0f * (n0 < cs_ncols ? cscale : 1.0f);
#pragma unroll 8
    for (int i = 0; i < 32; ++i) { const int kk = 2 * i + (lane >> 5); scr[kk * 33 + (lane & 31)] = W[(size_t)(k0 + kk) * N + n0 + (lane & 31)] * cs; }
    asm volatile("s_waitcnt lgkmcnt(0)" ::: "memory");
    const int c = lane & 7;
#pragma unroll
    for (int j = 0; j < 4; ++j) { const int n = (lane >> 3) + 8 * j; const LAS float* sp = scr + (8 * c) * 33 + n;
        int lo = __builtin_amdgcn_cvt_pk_fp8_f32(sp[0 * 33], sp[1 * 33], 0, false); lo = __builtin_amdgcn_cvt_pk_fp8_f32(sp[2 * 33], sp[3 * 33], lo, true);
        int hi = __builtin_amdgcn_cvt_pk_fp8_f32(sp[4 * 33], sp[5 * 33], 0, false); hi = __builtin_amdgcn_cvt_pk_fp8_f32(sp[6 * 33], sp[7 * 33], hi, true);
        *(int2*)(WT + (size_t)(n0 + n) * K + k0 + 8 * c) = make_int2(lo, hi); }
    asm volatile("s_waitcnt lgkmcnt(0)" ::: "memory");
}
template <bool F8OUT>
__device__ __forceinline__ void transpose_item64(const float* __restrict__ W, int K, int N, void* __restrict__ WT, LAS float* scr, int item, int lane, const float* rowscale = nullptr, float cscale = 1.0f) {
    const int nblk = N / 64, kb = item / nblk, nb = item % nblk, k0 = 64 * kb, n0 = 64 * nb;
    const float cs = cscale * (F8OUT ? 32.0f : 1.0f);
    float4 wv[16];
#pragma unroll
    for (int i = 0; i < 16; ++i) wv[i] = *(const float4*)(W + (size_t)(k0 + 4 * i + (lane >> 4)) * N + n0 + 4 * (lane & 15));
#pragma unroll
    for (int i = 0; i < 16; ++i) { const int kk = 4 * i + (lane >> 4); const float4 w = wv[i];
        const float rs = rowscale ? rowscale[k0 + kk] * cs : cs; LAS float* d = scr + kk * 65 + 4 * (lane & 15); d[0] = w.x * rs; d[1] = w.y * rs; d[2] = w.z * rs; d[3] = w.w * rs; }
    asm volatile("s_waitcnt lgkmcnt(0)" ::: "memory");
    const int c = lane & 7;
#pragma unroll
    for (int j = 0; j < 8; ++j) { const int n = (lane >> 3) + 8 * j; const LAS float* sp = scr + (8 * c) * 65 + n;
        if constexpr (F8OUT) { int lo = __builtin_amdgcn_cvt_pk_fp8_f32(sp[0 * 65], sp[1 * 65], 0, false); lo = __builtin_amdgcn_cvt_pk_fp8_f32(sp[2 * 65], sp[3 * 65], lo, true);
            int hi = __builtin_amdgcn_cvt_pk_fp8_f32(sp[4 * 65], sp[5 * 65], 0, false); hi = __builtin_amdgcn_cvt_pk_fp8_f32(sp[6 * 65], sp[7 * 65], hi, true);
            *(int2*)((unsigned char*)WT + (size_t)(n0 + n) * K + k0 + 8 * c) = make_int2(lo, hi); }
        else { uint4 o; o.x = pk2(sp[0 * 65], sp[1 * 65]); o.y = pk2(sp[2 * 65], sp[3 * 65]); o.z = pk2(sp[4 * 65], sp[5 * 65]); o.w = pk2(sp[6 * 65], sp[7 * 65]);
            *(uint4*)((bf16_t*)WT + (size_t)(n0 + n) * K + k0 + 8 * c) = o; } }
    asm volatile("s_waitcnt lgkmcnt(0)" ::: "memory");
}
namespace fa {
using bf16x8 = __attribute__((ext_vector_type(8))) short;
using s16x4  = __attribute__((ext_vector_type(4))) short;
using f32x16 = __attribute__((ext_vector_type(16))) float;
using u32x4  = __attribute__((ext_vector_type(4))) unsigned;
constexpr int QBLK = 32, KVBLK = 64, NW = 8;
constexpr int SHM_V = KVBLK * 128 * 2, SHM_K = KVBLK * 128 * 2, SHM_ATTN = 2 * SHM_V + 2 * SHM_K + NW * 64 * 4;
constexpr float LOG2E = 1.4426950408889634f, THR = 8.0f, NEGS = -1.0e30f;
#define FA_KSWZ(row, colB) ((row) * 256 + ((colB) ^ (((row) & 7) << 4)))
#define FA_SBAR() __builtin_amdgcn_sched_barrier(0)
__device__ __forceinline__ int crow(int r, int hi) { return (r & 3) + 8 * (r >> 2) + 4 * hi; }
__device__ __forceinline__ unsigned cvtpk(float lo, float hi) { unsigned r; asm volatile("v_cvt_pk_bf16_f32 %0, %1, %2" : "=v"(r) : "v"(lo), "v"(hi)); return r; }
__device__ __forceinline__ void partialSM(f32x16& p0, f32x16& p1, float& m_reg, float& mn, float& alpha) {
  float pmax = p0[0];
#pragma unroll
  for (int r = 1; r < 16; ++r) pmax = fmaxf(pmax, p0[r]);
#pragma unroll
  for (int r = 0; r < 16; ++r) pmax = fmaxf(pmax, p1[r]);
  { auto rr = __builtin_amdgcn_permlane32_swap(__float_as_uint(pmax), __float_as_uint(pmax), false, false);
    pmax = fmaxf(__uint_as_float(rr[0]), __uint_as_float(rr[1])); }
  if (__builtin_expect(__all(pmax - m_reg <= THR), 1)) { mn = m_reg; alpha = 1.f; }
  else { mn = fmaxf(m_reg, pmax); alpha = __builtin_amdgcn_exp2f((m_reg - mn) * LOG2E); m_reg = mn; }
  const float mnC = -mn * LOG2E;
#pragma unroll
  for (int r = 0; r < 16; ++r) p0[r] = fmaf(p0[r], LOG2E, mnC);
#pragma unroll
  for (int r = 0; r < 16; ++r) p1[r] = fmaf(p1[r], LOG2E, mnC);
#pragma unroll
  for (int r = 0; r < 16; ++r) p0[r] = __builtin_amdgcn_exp2f(p0[r]);
}
__device__ __forceinline__ void finishSM(f32x16& p0, f32x16& p1, float alpha, float& l_reg, bf16x8& pa0, bf16x8& pa1, bf16x8& pa2, bf16x8& pa3) {
#pragma unroll
  for (int r = 0; r < 16; ++r) p1[r] = __builtin_amdgcn_exp2f(p1[r]);
  float ps = 0;
#pragma unroll
  for (int r = 0; r < 16; ++r) ps += p0[r];
#pragma unroll
  for (int r = 0; r < 16; ++r) ps += p1[r];
  { auto rr = __builtin_amdgcn_permlane32_swap(__float_as_uint(ps), __float_as_uint(ps), false, false);
    ps = __uint_as_float(rr[0]) + __uint_as_float(rr[1]); }
  l_reg = l_reg * alpha + ps;
#define FA_PK4(P, BASE, OUT) do { unsigned a0 = cvtpk(P[BASE + 0], P[BASE + 1]), a1 = cvtpk(P[BASE + 2], P[BASE + 3]);   \
    unsigned b0 = cvtpk(P[BASE + 4], P[BASE + 5]), b1 = cvtpk(P[BASE + 6], P[BASE + 7]);                              \
    auto r0 = __builtin_amdgcn_permlane32_swap(a0, b0, false, false); auto r1 = __builtin_amdgcn_permlane32_swap(a1, b1, false, false); \
    u32x4 w = {r0[0], r1[0], r0[1], r1[1]}; OUT = *reinterpret_cast<bf16x8*>(&w); } while (0)
  FA_PK4(p0, 0, pa0); FA_PK4(p0, 8, pa1); FA_PK4(p1, 0, pa2); FA_PK4(p1, 8, pa3);
#undef FA_PK4
}
template <int NQ> __device__ __forceinline__ void qkt(f32x16& p0, f32x16& p1, const char* Ks, const bf16x8* qr, int r32, int hi) {
  p0 = f32x16{}; p1 = f32x16{};
#pragma unroll
  for (int d0 = 0; d0 < NQ; ++d0) { const int cb = (d0 * 16 + hi * 8) * 2;
    const bf16x8 b0 = *reinterpret_cast<const bf16x8*>(Ks + FA_KSWZ(r32, cb));
    const bf16x8 b1 = *reinterpret_cast<const bf16x8*>(Ks + FA_KSWZ(32 + r32, cb));
    p0 = __builtin_amdgcn_mfma_f32_32x32x16_bf16(b0, qr[d0], p0, 0, 0, 0);
    p1 = __builtin_amdgcn_mfma_f32_32x32x16_bf16(b1, qr[d0], p1, 0, 0, 0); }
}
__device__ __forceinline__ int v_st(int k, int c) { const int kk = (k & ~0xC) | ((k & 4) << 1) | ((k & 8) >> 1); return ((kk >> 3) * 4 + (c >> 5)) * 512 + ((kk & 7) * 32 + (c & 31)) * 2; }
__device__ __forceinline__ int v_rd_base(int lane) { return ((lane & 3) << 3) | (((lane >> 2) & 3) << 6) | (((lane >> 4) & 1) << 5) | (((lane >> 5) & 1) << 8); }
constexpr int v_rd_off(int d0, int ks, int half) { return d0 * 512 + ks * 4096 + half * 2048; }
template <int OFF> __device__ __forceinline__ s16x4 tr_read(int vb) {
  s16x4 r; asm volatile("ds_read_b64_tr_b16 %0, %1 offset:%2" : "=&v"(r) : "v"(vb), "i"(OFF) : "memory"); return r;
}
template <int D0> __device__ __forceinline__ void pv_one(f32x16& od, int vb, bf16x8 pa0, bf16x8 pa1, bf16x8 pa2, bf16x8 pa3) {
  const s16x4 l0 = tr_read<v_rd_off(D0, 0, 0)>(vb), h0 = tr_read<v_rd_off(D0, 0, 1)>(vb), l1 = tr_read<v_rd_off(D0, 1, 0)>(vb), h1 = tr_read<v_rd_off(D0, 1, 1)>(vb);
  const s16x4 l2 = tr_read<v_rd_off(D0, 2, 0)>(vb), h2 = tr_read<v_rd_off(D0, 2, 1)>(vb), l3 = tr_read<v_rd_off(D0, 3, 0)>(vb), h3 = tr_read<v_rd_off(D0, 3, 1)>(vb);
  asm volatile("s_waitcnt lgkmcnt(0)" ::: "memory"); FA_SBAR();
#define FA_PK(L, H) (bf16x8){L[0], L[1], L[2], L[3], H[0], H[1], H[2], H[3]}
  od = __builtin_amdgcn_mfma_f32_32x32x16_bf16(pa0, FA_PK(l0, h0), od, 0, 0, 0);
  od = __builtin_amdgcn_mfma_f32_32x32x16_bf16(pa1, FA_PK(l1, h1), od, 0, 0, 0);
  od = __builtin_amdgcn_mfma_f32_32x32x16_bf16(pa2, FA_PK(l2, h2), od, 0, 0, 0);
  od = __builtin_amdgcn_mfma_f32_32x32x16_bf16(pa3, FA_PK(l3, h3), od, 0, 0, 0);
#undef FA_PK
}
template <int NV> __device__ __forceinline__ void pv_all(f32x16* o, int vb, bf16x8 pa0, bf16x8 pa1, bf16x8 pa2, bf16x8 pa3) {
  pv_one<0>(o[0], vb, pa0, pa1, pa2, pa3); pv_one<1>(o[1], vb, pa0, pa1, pa2, pa3);
  if constexpr (NV == 4) { pv_one<2>(o[2], vb, pa0, pa1, pa2, pa3); pv_one<3>(o[3], vb, pa0, pa1, pa2, pa3); }
}
__device__ __forceinline__ void wmask(f32x16& p0, f32x16& p1, int dq4) {
#pragma unroll
  for (int r = 0; r < 16; ++r) { const int d = dq4 + (r & 3) + 8 * (r >> 2); if ((unsigned)(d + 128) > 256u) p0[r] = NEGS; if ((unsigned)(d + 32 + 128) > 256u) p1[r] = NEGS; }
}

struct Unit {
  const bf16_t* Q; const bf16_t* K; const bf16_t* V; bf16_t* O;
  int rowa, nta, rowb, ntb;
  int window, qpos0, kposb0;
  float sink; int has_sink;
  const bf16_t* K2;
  const float* tab; int pos0;
  const float* qg;
};
template <int DQ, int DV, int LDQ, int LDK, int LDV, int LDO, bool WIN, int RD0, int RH, bool QNORM, bool KSPLIT>
__device__ __forceinline__ void attn_unit(const int tid, const Unit& U, char* lds) {
  constexpr int NQ = DQ / 16, NV = DV / 32;
  const int wid = tid >> 6, lane = tid & 63, r32 = lane & 31, hi = lane >> 5;
  char* V_lds = lds; char* K_lds = lds + 2 * SHM_V;
  float* ws = (float*)(lds + 2 * SHM_V + 2 * SHM_K) + wid * 64; float* li_l = ws; float* al_l = ws + 32;
  float m_reg = -1e30f, l_reg = 0; f32x16 o[NV]; bf16x8 qr[NQ];
#pragma unroll
  for (int d = 0; d < NV; ++d) o[d] = f32x16{};
  const bf16_t* Qw = U.Q + (size_t)(wid * QBLK + r32) * LDQ + hi * 8;
#pragma unroll
  for (int d0 = 0; d0 < NQ; ++d0) qr[d0] = *reinterpret_cast<const bf16x8*>(Qw + d0 * 16);
  if constexpr (QNORM || RH > 0) {
    float qf[NQ][8];
#pragma unroll
    for (int d0 = 0; d0 < NQ; ++d0)
#pragma unroll
      for (int j = 0; j < 8; ++j) qf[d0][j] = __uint_as_float(((unsigned)(unsigned short)qr[d0][j]) << 16);
    if constexpr (QNORM) {
      float ss = 0.f;
#pragma unroll
      for (int d0 = 0; d0 < NQ; ++d0)
#pragma unroll
        for (int j = 0; j < 8; ++j) ss = fmaf(qf[d0][j], qf[d0][j], ss);
      { auto rr = __builtin_amdgcn_permlane32_swap(__float_as_uint(ss), __float_as_uint(ss), false, false); ss = __uint_as_float(rr[0]) + __uint_as_float(rr[1]); }
      const float ri = 1.0f / sqrtf(ss * (1.0f / DQ) + 1e-6f);
#pragma unroll
      for (int d0 = 0; d0 < NQ; ++d0) { const float4 g0 = *(const float4*)(U.qg + 16 * d0 + 8 * hi), g1 = *(const float4*)(U.qg + 16 * d0 + 8 * hi + 4);
        qf[d0][0] *= ri * g0.x; qf[d0][1] *= ri * g0.y; qf[d0][2] *= ri * g0.z; qf[d0][3] *= ri * g0.w; qf[d0][4] *= ri * g1.x; qf[d0][5] *= ri * g1.y; qf[d0][6] *= ri * g1.z; qf[d0][7] *= ri * g1.w; }
    }
    if constexpr (RH > 0) { if (U.tab) {
      const float4* tb = (const float4*)(U.tab + ((size_t)(U.pos0 + wid * QBLK + r32) * (RH * 16) + 8 * hi) * 2);
#pragma unroll
      for (int dd = 0; dd < RH; ++dd) {
#pragma unroll
        for (int j2 = 0; j2 < 4; ++j2) { const float4 t = tb[dd * 8 + j2];
          { const float x1 = qf[RD0 + dd][2 * j2], x2 = qf[RD0 + RH + dd][2 * j2]; qf[RD0 + dd][2 * j2] = x1 * t.x - x2 * t.y; qf[RD0 + RH + dd][2 * j2] = x2 * t.x + x1 * t.y; }
          { const float x1 = qf[RD0 + dd][2 * j2 + 1], x2 = qf[RD0 + RH + dd][2 * j2 + 1]; qf[RD0 + dd][2 * j2 + 1] = x1 * t.z - x2 * t.w; qf[RD0 + RH + dd][2 * j2 + 1] = x2 * t.z + x1 * t.w; } } } } }
#pragma unroll
    for (int d0 = 0; d0 < NQ; ++d0) { u32x4 w = {cvtpk(qf[d0][0], qf[d0][1]), cvtpk(qf[d0][2], qf[d0][3]), cvtpk(qf[d0][4], qf[d0][5]), cvtpk(qf[d0][6], qf[d0][7])}; qr[d0] = *reinterpret_cast<bf16x8*>(&w); }
  }
  const int sr = tid >> 4, sc = (tid & 15) * 8, vst0 = v_st(sr, sc), vst1 = v_st(32 + sr, sc);
  const int sck = sc < DQ - 8 ? sc : DQ - 8, scv = sc < DV - 8 ? sc : DV - 8;
  const int vb0 = (int)(uintptr_t)V_lds + v_rd_base(lane);
  const int nta = U.nta, NT = U.nta + U.ntb;
  const unsigned kof0 = (unsigned)((sr * LDK + sck) * 2), kof1 = kof0 + 32u * LDK * 2u, vof0 = (unsigned)((sr * LDV + scv) * 2), vof1 = vof0 + 32u * LDV * 2u;
  constexpr int LDK2 = 1536;
  const int ci = tid & 15; const bool ksec = KSPLIT && ci >= 8; const int kld = ksec ? LDK2 : LDK;
  const bf16_t* kp0 = ksec ? U.K2 + (size_t)sr * LDK2 + ((ci < 11 ? ci : 11) - 8) * 8 : U.K + (size_t)sr * LDK + ci * 8; const bf16_t* kp1 = kp0 + (size_t)32 * kld;
  (void)kof0; (void)kof1; (void)kp0; (void)kp1; (void)kld;
  struct { bf16x8 vs0, vs1, ks0, ks1; } sr_[2];
#define FA_KROW(j) ((j) < nta ? U.rowa + (j) * KVBLK : U.rowb + ((j) - nta) * KVBLK)
#define FA_SLOAD(i, j) do { const size_t k0_ = (size_t)(FA_KROW(j)); const char* kt_ = (const char*)U.K + k0_ * (LDK * 2); const char* vt_ = (const char*)U.V + k0_ * (LDV * 2); \
    sr_[i].vs0 = *reinterpret_cast<const bf16x8*>(vt_ + vof0); sr_[i].vs1 = *reinterpret_cast<const bf16x8*>(vt_ + vof1); \
    if constexpr (KSPLIT) { sr_[i].ks0 = *reinterpret_cast<const bf16x8*>(kp0 + k0_ * kld); sr_[i].ks1 = *reinterpret_cast<const bf16x8*>(kp1 + k0_ * kld); } \
    else { sr_[i].ks0 = *reinterpret_cast<const bf16x8*>(kt_ + kof0); sr_[i].ks1 = *reinterpret_cast<const bf16x8*>(kt_ + kof1); } } while (0)
#define FA_SWRITE(b, i) do { *(bf16x8*)(V_lds + (b) * SHM_V + vst0) = sr_[i].vs0; *(bf16x8*)(V_lds + (b) * SHM_V + vst1) = sr_[i].vs1; const int kc = sc * 2; \
    *(bf16x8*)(K_lds + (b) * SHM_K + FA_KSWZ(sr, kc)) = sr_[i].ks0; *(bf16x8*)(K_lds + (b) * SHM_K + FA_KSWZ(32 + sr, kc)) = sr_[i].ks1; } while (0)
#define FA_SWAIT() asm volatile("s_waitcnt vmcnt(4)" ::: "memory")
#define FA_RESC(a) do { if (__any((a) < 1.f)) { if (hi == 0) al_l[r32] = (a); asm volatile("s_waitcnt lgkmcnt(0)" ::: "memory"); \
    _Pragma("unroll") for (int d = 0; d < NV; ++d) _Pragma("unroll") for (int r = 0; r < 16; ++r) o[d][r] *= al_l[crow(r, hi)]; } } while (0)
  const int qw0 = U.qpos0 + wid * QBLK;
#define FA_MASK(P0, P1, t) do { if (WIN && U.window && (t) >= nta) { const int kb_ = U.kposb0 + ((t) - nta) * KVBLK; \
    if (kb_ + 63 - qw0 > 128 || qw0 + 31 - kb_ > 128) wmask(P0, P1, kb_ - (qw0 + r32) + 4 * hi); } } while (0)
  f32x16 pA0, pA1, pB0, pB1; float mnA, mnB, alA, alB; bf16x8 pa0, pa1, pa2, pa3;
  constexpr int SE = 0, SO = 1;
  FA_SLOAD(SE, 0); asm volatile("s_waitcnt vmcnt(0)" ::: "memory"); FA_SWRITE(0, SE); __syncthreads();
  qkt<NQ>(pA0, pA1, K_lds, qr, r32, hi); FA_MASK(pA0, pA1, 0); partialSM(pA0, pA1, m_reg, mnA, alA);
  FA_SLOAD(SO, 1); if (2 < NT) FA_SLOAD(SE, 2);
  FA_SWAIT(); FA_SWRITE(1, SO); __syncthreads();
  for (int j = 1; j + 1 < NT; j += 2) {
    FA_SBAR(); qkt<NQ>(pB0, pB1, K_lds + SHM_K, qr, r32, hi);
    finishSM(pA0, pA1, alA, l_reg, pa0, pa1, pa2, pa3); FA_SBAR();
    FA_SLOAD(SO, j + 2); FA_SBAR();
    pv_all<NV>(o, vb0, pa0, pa1, pa2, pa3); FA_MASK(pB0, pB1, j); partialSM(pB0, pB1, m_reg, mnB, alB);
    __syncthreads(); FA_SWAIT(); FA_SWRITE(0, SE);
    FA_RESC(alB); __syncthreads();
    FA_SBAR(); qkt<NQ>(pA0, pA1, K_lds, qr, r32, hi);
    finishSM(pB0, pB1, alB, l_reg, pa0, pa1, pa2, pa3); FA_SBAR();
    if (j + 3 < NT) FA_SLOAD(SE, j + 3); FA_SBAR();
    pv_all<NV>(o, vb0 + SHM_V, pa0, pa1, pa2, pa3); FA_MASK(pA0, pA1, j + 1); partialSM(pA0, pA1, m_reg, mnA, alA);
    __syncthreads(); FA_SWAIT(); FA_SWRITE(1, SO);
    FA_RESC(alA); __syncthreads();
  }
  FA_SBAR(); qkt<NQ>(pB0, pB1, K_lds + SHM_K, qr, r32, hi);
  finishSM(pA0, pA1, alA, l_reg, pa0, pa1, pa2, pa3); FA_SBAR();
  pv_all<NV>(o, vb0, pa0, pa1, pa2, pa3); FA_MASK(pB0, pB1, NT - 1); partialSM(pB0, pB1, m_reg, mnB, alB);
  __syncthreads(); FA_RESC(alB);
  finishSM(pB0, pB1, alB, l_reg, pa0, pa1, pa2, pa3); FA_SBAR();
  pv_all<NV>(o, vb0 + SHM_V, pa0, pa1, pa2, pa3);
  if (U.has_sink) l_reg += __builtin_amdgcn_exp2f((U.sink - m_reg) * LOG2E);
  if (hi == 0) li_l[r32] = l_reg;
  asm volatile("s_waitcnt lgkmcnt(0)" ::: "memory");
  __syncthreads();
  int lane2 = lane; asm volatile("" : "+v"(lane2));
  const int r32e = lane2 & 31, hie = lane2 >> 5;
  bf16_t* stg = (bf16_t*)(lds + wid * 8192);
  bf16_t* stw = stg + hie * 4 * DV + r32e;
#pragma unroll
  for (int r = 0; r < 16; ++r) { const int orow0 = (r & 3) + 8 * (r >> 2); const float rl = __builtin_amdgcn_rcpf(li_l[orow0 + 4 * hie]);
#pragma unroll
    for (int d0 = 0; d0 < NV; ++d0) stw[orow0 * DV + d0 * 32] = f2bf(o[d0][r] * rl); }
  asm volatile("s_waitcnt lgkmcnt(0)" ::: "memory");
  constexpr int CPR = DV / 8, RPI = 64 / CPR;
  const int erow = lane2 / CPR, ech = lane2 % CPR;
  bf16_t* Ow = U.O + (size_t)(wid * QBLK + erow) * LDO + ech * 8; const bf16_t* str = stg + erow * DV + ech * 8;
#pragma unroll
  for (int i = 0; i < 32 / RPI; ++i) { const u32x4 v = *(const u32x4*)(str + i * RPI * DV); *(u32x4*)(Ow + (size_t)(i * RPI) * LDO) = v; }
  __syncthreads();
#undef FA_KROW
#undef FA_SLOAD
#undef FA_SWRITE
#undef FA_SWAIT
#undef FA_RESC
#undef FA_MASK
}
}

__device__ __forceinline__ void route_reduce(const float (&acc)[32], const int lane, const int el, const float rb, float (&tv)[4], int (&ti)[4]) {
    float a16[16], a8[8], a4[4], a2[2];
#pragma unroll
    for (int k = 0; k < 16; ++k) { const bool up = (lane & 32) != 0; const float keep = up ? acc[k + 16] : acc[k], send = up ? acc[k] : acc[k + 16]; a16[k] = keep + __shfl_xor(send, 32); }
#pragma unroll
    for (int k = 0; k < 8; ++k) { const bool up = (lane & 16) != 0; const float keep = up ? a16[k + 8] : a16[k], send = up ? a16[k] : a16[k + 8]; a8[k] = keep + __shfl_xor(send, 16); }
#pragma unroll
    for (int k = 0; k < 4; ++k) { const bool up = (lane & 8) != 0; const float keep = up ? a8[k + 4] : a8[k], send = up ? a8[k] : a8[k + 4]; a4[k] = keep + __shfl_xor(send, 8); }
#pragma unroll
    for (int k = 0; k < 2; ++k) { const bool up = (lane & 4) != 0; const float keep = up ? a4[k + 2] : a4[k], send = up ? a4[k] : a4[k + 2]; a2[k] = keep + __shfl_xor(send, 4); }
    float lg; { const bool up = (lane & 2) != 0; const float keep = up ? a2[1] : a2[0], send = up ? a2[0] : a2[1]; lg = keep + __shfl_xor(send, 2); }
    lg += __shfl_xor(lg, 1); lg += rb;
    unsigned key; { const unsigned u = __float_as_uint(lg); const unsigned ou = (u & 0x80000000u) ? ~u : (u | 0x80000000u); key = (ou & ~31u) | (unsigned)(31 - el); }
#pragma unroll
    for (int k = 0; k < 4; ++k) { unsigned bk = key;
#pragma unroll
        for (int o = 1; o < 64; o <<= 1) { const unsigned ok = (unsigned)__shfl_xor((int)bk, o); bk = ok > bk ? ok : bk; }
        const int bi = 31 - (int)(bk & 31u); const unsigned ou = bk & ~31u; const unsigned ub = (ou & 0x80000000u) ? (ou ^ 0x80000000u) : ~ou;
        tv[k] = __uint_as_float(ub); ti[k] = bi; if (el == bi) key = 0u; }
}

__device__ __forceinline__ void route_reduce32(const float (&acc)[32], const int l5, const float rb, float (&tv)[4], int (&ti)[4]) {
    float a16[16], a8[8], a4[4], a2[2];
#pragma unroll
    for (int k = 0; k < 16; ++k) { const bool up = (l5 & 16) != 0; const float keep = up ? acc[k + 16] : acc[k], send = up ? acc[k] : acc[k + 16]; a16[k] = keep + __shfl_xor(send, 16); }
#pragma unroll
    for (int k = 0; k < 8; ++k) { const bool up = (l5 & 8) != 0; const float keep = up ? a16[k + 8] : a16[k], send = up ? a16[k] : a16[k + 8]; a8[k] = keep + __shfl_xor(send, 8); }
#pragma unroll
    for (int k = 0; k < 4; ++k) { const bool up = (l5 & 4) != 0; const float keep = up ? a8[k + 4] : a8[k], send = up ? a8[k] : a8[k + 4]; a4[k] = keep + __shfl_xor(send, 4); }
#pragma unroll
    for (int k = 0; k < 2; ++k) { const bool up = (l5 & 2) != 0; const float keep = up ? a4[k + 2] : a4[k], send = up ? a4[k] : a4[k + 2]; a2[k] = keep + __shfl_xor(send, 2); }
    float lg; { const bool up = (l5 & 1) != 0; const float keep = up ? a2[1] : a2[0], send = up ? a2[0] : a2[1]; lg = keep + __shfl_xor(send, 1); }
    lg += rb;
    unsigned key; { const unsigned u = __float_as_uint(lg); const unsigned ou = (u & 0x80000000u) ? ~u : (u | 0x80000000u); key = (ou & ~31u) | (unsigned)(31 - l5); }
#pragma unroll
    for (int k = 0; k < 4; ++k) { unsigned bk = key;
#pragma unroll
        for (int o = 1; o < 32; o <<= 1) { const unsigned ok = (unsigned)__shfl_xor((int)bk, o); bk = ok > bk ? ok : bk; }
        const int bi = 31 - (int)(bk & 31u); const unsigned ou = bk & ~31u; const unsigned ub = (ou & 0x80000000u) ? (ou ^ 0x80000000u) : ~ou;
        tv[k] = __uint_as_float(ub); ti[k] = bi; if (l5 == bi) key = 0u; }
}

struct Params {
    const float *x, *c, *ctx, *c_ctx, *ada_w, *ada_b, *norm_mix_g, *norm_ffn_g, *ab_w_in, *mla_q_g, *mla_wq_b, *mla_kv_g, *mla_wkv_b, *swa_sink, *ab_w_out,
        *c_w_in, *c_q_g, *c_k_g, *c_w_out, *router_w, *router_b, *moe_w_in, *moe_b_in, *moe_w_out, *moe_b_out, *final_g;
    float* out; unsigned char* ws; int ph_lo, ph_hi;
};
__device__ __forceinline__ int mod_row_of(int r) { return r < NLAT ? r / SEQ : NB; }
__device__ __forceinline__ float rope_angle(int i, int quarter, int prow, int pcol) {
    const int ii = i < quarter ? i : i - quarter; const float inv = powf(10000.f, -(float)ii / (float)quarter);
    return (float)(i < quarter ? prow : pcol) * inv;
}

#ifndef Y8_L1
#define Y8_L1 1
#endif
#ifndef INPROJ_F8
#define INPROJ_F8 1
#endif
#ifndef MOE_F8_DOWN
#define MOE_F8_DOWN 1
#endif
#ifndef MOE_F8_L0
#define MOE_F8_L0 1
#endif
#ifndef MOE_F8_L1
#define MOE_F8_L1 1
#endif
constexpr int LDS_BYTES = 147456;
constexpr int LDS_MISC = 143360;
constexpr int N_PHASES = 21;

__global__ void __launch_bounds__(NTHR, 2) fwd_kernel(Params p) {
    extern __shared__ __attribute__((aligned(16))) unsigned char lds_raw[];
    float* ldsf = (float*)lds_raw;
    LAS unsigned* misc = (LAS unsigned*)(lds_raw + LDS_MISC + 320);
    const int wave0 = __builtin_amdgcn_readfirstlane((int)(threadIdx.x >> 6));
    const int G = gridDim.x, bid = blockIdx.x;
    const int NGW = G * 8;
    unsigned* ctl0 = (unsigned*)(p.ws + WS_CTL);
#define PHASE_PTRS \
    int tid = wave0 * 64 + (int)__builtin_amdgcn_mbcnt_hi(~0u, __builtin_amdgcn_mbcnt_lo(~0u, 0u)); asm volatile("" : "+v"(tid)); const int lane = tid & 63, wave = tid >> 6, gw = bid * 8 + wave; (void)lane; (void)gw; \
    size_t wsz_ = 0; asm volatile("" : "+s"(wsz_)); unsigned char* ws = p.ws + wsz_; \
    unsigned* ctl = (unsigned*)(ws + WS_CTL); (void)ctl; \
    float* MOD = (float*)(ws + WS_MOD); (void)MOD; \
    int* TOKE = (int*)(ws + WS_TOKE); int* TOKP = (int*)(ws + WS_TOKP); float* TOKG = (float*)(ws + WS_TOKG); (void)TOKE; (void)TOKP; (void)TOKG; \
    float* RINV = (float*)(ws + WS_RINV); (void)RINV; unsigned char* tabs = ws + WS_TAB; (void)tabs; \
    float* XR = (float*)(ws + WS_XR); (void)XR; \
    act_t* H = (act_t*)(ws + WS_H); (void)H; \
    unsigned char* big = ws + WS_BIG; \
    act_t* PRJ = (act_t*)(big + OFF_PRJ); act_t* QB = (act_t*)(big + OFF_QB); act_t* KVB = (act_t*)(big + OFF_KVB); act_t* OB = (act_t*)(big + OFF_O); (void)PRJ; (void)QB; (void)KVB; (void)OB; \
    act_t* Y = (act_t*)big; act_t* ACT = (act_t*)(ws + WS_ACT); act_t* XS = (act_t*)(ws + WS_XS); unsigned char* wts = ws + WS_W; (void)Y; (void)ACT; (void)XS; (void)wts;

    if (threadIdx.x < 32) misc[threadIdx.x] = 0u;
    __syncthreads();
    XcdBarrier bar = xcd_barrier_post(ctl0 + CW_BAR, (volatile LAS unsigned*)(misc + 8), wave0);
    const int lo = p.ph_lo, hi = p.ph_hi;
#ifndef PHASE_MASK
#define PHASE_MASK 0x1FFFFFu
#endif
#define IN(k) ((((PHASE_MASK) >> (k)) & 1u) && lo <= (k) && (k) < hi)
#define SEAM(k) do { if (IN(k) && IN((k) + 1)) xcd_barrier(bar, wave0); } while (0)
#define LDSB ((LAS unsigned char*)lds_raw)

    if (IN(0)) { PHASE_PTRS
        {   LAS float* scr = (LAS float*)(LDSB + wave * 16640);
            constexpr int I_AB = 16 * 45  , I_QB = 6 * 12, I_KVB = 4 * 16, I_ABO = 16 * 16, I_C = 16 * 24, I_CO = 16 * 16, I_W1 = 16 * 32, I_W2 = 16 * 16;
            constexpr int T_W1 = 64 * I_W1, T_W2 = 64 * I_W2, T_ALL = T_W1 + T_W2 + I_AB + I_QB + I_KVB + I_ABO + I_C + I_CO;
            for (int it = gw; it < T_ALL; it += NGW) {
                int r = it;
                if (r < T_W1) { const int mi = r / I_W1; const float* src = p.moe_w_in + (size_t)mi * 1024 * 2048;
                    if ((mi >= 32 && MOE_F8_L1) || (mi < 32 && MOE_F8_L0)) transpose_item64<true>(src, 1024, 2048, (unsigned char*)(wts + WO_W1) + (size_t)(mi >> 5) * 32 * 2048 * 1024 * 2 + (size_t)(mi & 31) * 2048 * 1024, scr, r % I_W1, lane);
                    else transpose_item64<false>(src, 1024, 2048, (bf16_t*)(wts + WO_W1) + (size_t)mi * 2048 * 1024, scr, r % I_W1, lane);
                    continue; } r -= T_W1;
                if (r < T_W2) { const int mi = r / I_W2; const float* src = p.moe_w_out + (size_t)mi * 1024 * 1024;
                    if (MOE_F8_DOWN && ((mi >= 32 && MOE_F8_L1) || (mi < 32 && MOE_F8_L0))) transpose_item64<true>(src, 1024, 1024, (unsigned char*)(wts + WO_W2) + (size_t)(mi >> 5) * 32 * 1024 * 1024 * 2 + (size_t)(mi & 31) * 1024 * 1024, scr, r % I_W2, lane);
                    else transpose_item64<false>(src, 1024, 1024, (bf16_t*)(wts + WO_W2) + (size_t)mi * 1024 * 1024, scr, r % I_W2, lane);
                    continue; } r -= T_W2;
                if (r < I_AB) { if (INPROJ_F8) transpose_item_f8(p.ab_w_in, 1024, AB_IN, (unsigned char*)(wts + WO_AB), scr, r, lane, 0.125f, 512);
                    else transpose_item(p.ab_w_in, 1024, AB_IN, (bf16_t*)(wts + WO_AB), scr, r, lane, nullptr, 0.125f, 512); continue; } r -= I_AB;
                if (r < I_QB) { transpose_item64<false>(p.mla_wq_b, 384, 768, (bf16_t*)(wts + WO_QB), scr, r, lane, p.mla_q_g, 0.10206207261596575f); continue; } r -= I_QB;
                if (r < I_KVB) { transpose_item64<false>(p.mla_wkv_b, 256, 1024, (bf16_t*)(wts + WO_KVB), scr, r, lane, p.mla_kv_g, 1.0f); continue; } r -= I_KVB;
                if (r < I_ABO) { transpose_item64<false>(p.ab_w_out, 1024, 1024, (bf16_t*)(wts + WO_ABO), scr, r, lane); continue; } r -= I_ABO;
                if (r < I_C) { if (INPROJ_F8) transpose_item64<true>(p.c_w_in, 1024, C_IN, (unsigned char*)(wts + WO_C), scr, r, lane); else transpose_item64<false>(p.c_w_in, 1024, C_IN, (bf16_t*)(wts + WO_C), scr, r, lane); continue; } r -= I_C;
                transpose_item64<false>(p.c_w_out, 1024, 1024, (bf16_t*)(wts + WO_CO), scr, r, lane);
            }
            uint4* z = (uint4*)((unsigned char*)(wts + WO_AB) + (size_t)AB_IN * 1024 * (INPROJ_F8 ? 1 : 2));
            for (int i = gw * 64 + lane; i < 96 * 1024 * (INPROJ_F8 ? 1 : 2) / 16; i += NGW * 64) z[i] = make_uint4(0u, 0u, 0u, 0u);
        }
        {
            float2* TA = (float2*)(tabs + TAB_A); float2* TB = (float2*)(tabs + TAB_B); float2* TC = (float2*)(tabs + TAB_C);
            for (int e = bid * NTHR + tid; e < SEQ * 112; e += G * NTHR) { const int s = e / 112, i = e % 112, prow = s / GRIDW, pcol = s % GRIDW;
                int quarter, ii; float2* dst;
                if (i < 32) { quarter = 16; ii = i; dst = TA + s * 32 + ii; } else if (i < 48) { quarter = 8; ii = i - 32; dst = TB + s * 16 + ii; } else { quarter = 32; ii = i - 48; dst = TC + s * 64 + ii; }
                const float ang = rope_angle(ii, quarter, prow, pcol); *dst = make_float2(cosf(ang), sinf(ang)); }
            if (bid == 0 && tid < 128) ((float*)(tabs + TAB_QG))[tid] = p.c_q_g[tid] * 0.08838834764831845f;
        }
        __syncthreads();
        float* ca = ldsf;
        float* red = ldsf + 17 * 1024;
        for (int i = tid; i < 17 * 1024; i += NTHR) { const int b = i >> 10, k = i & 1023; const float v = b < NB ? p.c[b * 1024 + k] : p.c_ctx[k]; ca[i] = v / (1.f + expf(-v)); }
        __syncthreads();
        for (int blk = bid; blk < 2 * 6144 / 64; blk += G) {
            const int l = blk / 96, n = (blk % 96) * 64 + lane, ks = wave;
            float acc[17];
#pragma unroll
            for (int b = 0; b < 17; ++b) acc[b] = 0.f;
            const float* wp = p.ada_w + (size_t)l * 1024 * 6144 + n;
            for (int k = ks * 128; k < ks * 128 + 128; ++k) { const float w = wp[(size_t)k * 6144];
#pragma unroll
                for (int b = 0; b < 17; ++b) acc[b] = fmaf(ca[b * 1024 + k], w, acc[b]); }
#pragma unroll
            for (int b = 0; b < 17; ++b) red[(ks * 17 + b) * 64 + lane] = acc[b];
            __syncthreads();
            for (int i = tid; i < 17 * 64; i += NTHR) { const int b = i >> 6, nl = i & 63; float s = 0.f;
#pragma unroll
                for (int k2 = 0; k2 < 8; ++k2) s += red[(k2 * 17 + b) * 64 + nl];
                const int nn = (blk % 96) * 64 + nl; MOD[((size_t)l * 17 + b) * 6144 + nn] = s + p.ada_b[l * 6144 + nn]; }
            __syncthreads();
        }
    }
    SEAM(0);

#define NORM_MOD16(v, g, mr_) do { float ss_ = 0.f; \
        _Pragma("unroll") for (int j = 0; j < 16; ++j) ss_ = fmaf(v[j], v[j], ss_); \
        ss_ = wave_sum(ss_); const float ri_ = 1.0f / sqrtf(ss_ * (1.0f / 1024.0f) + RMS_EPS); \
        float sh_[16], sc_[16]; ld16f((mr_), sh_); ld16f((mr_) + 1024, sc_); \
        _Pragma("unroll") for (int j = 0; j < 16; ++j) v[j] = (v[j] * ri_ * g[j]) * (1.0f + sc_[j]) + sh_[j]; } while (0)

#define NORM_MOD16x2(v, g, mr0_, mr1_) do { float s0_ = 0.f, s1_ = 0.f; \
        _Pragma("unroll") for (int j = 0; j < 16; ++j) { s0_ = fmaf(v[0][j], v[0][j], s0_); s1_ = fmaf(v[1][j], v[1][j], s1_); } \
        wave_sum2(s0_, s1_); const float ri0_ = 1.0f / sqrtf(s0_ * (1.0f / 1024.0f) + RMS_EPS), ri1_ = 1.0f / sqrtf(s1_ * (1.0f / 1024.0f) + RMS_EPS); \
        float sh_[16], sc_[16]; ld16f((mr0_), sh_); ld16f((mr0_) + 1024, sc_); \
        _Pragma("unroll") for (int j = 0; j < 16; ++j) v[0][j] = (v[0][j] * ri0_ * g[j]) * (1.0f + sc_[j]) + sh_[j]; \
        ld16f((mr1_), sh_); ld16f((mr1_) + 1024, sc_); \
        _Pragma("unroll") for (int j = 0; j < 16; ++j) v[1][j] = (v[1][j] * ri1_ * g[j]) * (1.0f + sc_[j]) + sh_[j]; } while (0)
#define ROWS2(nrows) for (int r0_ = gw; r0_ < (nrows); r0_ += 2 * NGW)
#define ROWS2_IDX(nrows) const bool two_ = (r0_ + NGW) < (nrows); const int rr_[2] = {r0_, two_ ? r0_ + NGW : r0_};

    if (IN(1)) { PHASE_PTRS
        float g[16]; ld16f(p.norm_mix_g + 16 * lane, g);
        ROWS2(NROW) { ROWS2_IDX(NROW)
            float v[2][16]; const float* mr[2];
#pragma unroll
            for (int u = 0; u < 2; ++u) { const int r = rr_[u]; const float* src = r < NLAT ? p.x + (size_t)r * 1024 : p.ctx + (size_t)(r - NLAT) * 1024;
                mr[u] = MOD + (size_t)(0 * 17 + mod_row_of(r)) * 6144 + 16 * lane; ld16f(src + 16 * lane, v[u]); }
            NORM_MOD16x2(v, g, mr[0], mr[1]);
            if (INPROJ_F8) { st16f8((unsigned char*)H + (size_t)rr_[0] * 1024 + 16 * lane, v[0]); if (two_) st16f8((unsigned char*)H + (size_t)rr_[1] * 1024 + 16 * lane, v[1]); }
            else { st16bf(H + (size_t)rr_[0] * 1024 + 16 * lane, v[0]); if (two_) st16bf(H + (size_t)rr_[1] * 1024 + 16 * lane, v[1]); }
        }
    }
    SEAM(1);

    if (IN(2)) { PHASE_PTRS
        constexpr size_t ES_ = INPROJ_F8 ? 1 : 2;
        pg8::DenseOrder S{(const char*)H, (const char*)(wts + WO_AB), NROW / 256, 6, G, bid, (size_t)256 * 1024 * ES_, (size_t)256 * 1024 * ES_};
        pg8::EpiStoreBf16 E{PRJ, PRJ_LD, INPROJ_F8 ? 0.03125f : 1.0f};
        pg8::gemm_phase<pg8::EpiStoreBf16, pg8::DenseOrder, true, true, INPROJ_F8 != 0>(tid, LDSB, 1024, 1024, S, E);
    }
    SEAM(2);

    if (IN(3)) { PHASE_PTRS
        const float2* TA = (const float2*)(tabs + TAB_A); const float2* TB = (const float2*)(tabs + TAB_B);
        for (int r = gw; r < NROW; r += NGW) {
            bf16_t* pr = PRJ + (size_t)r * PRJ_LD;
            if (r < NLAT) { const int s = r % SEQ;
                { bf16_t* kp = pr + 512 + (lane >> 5) * 64 + (lane & 31); const float x1 = bf2f(kp[0]), x2 = bf2f(kp[32]); const float2 t = TA[s * 32 + (lane & 31)];
                  kp[0] = f2bf(x1 * t.x - x2 * t.y); kp[32] = f2bf(x2 * t.x + x1 * t.y); }
                if (lane < 16) { bf16_t* rp = pr + 1408 + lane; const float x1 = bf2f(rp[0]), x2 = bf2f(rp[16]); const float2 t = TB[s * 16 + lane];
                  rp[0] = f2bf(x1 * t.x - x2 * t.y); rp[16] = f2bf(x2 * t.x + x1 * t.y); } }
            float s1 = 0.f, s2 = 0.f;
#pragma unroll
            for (int j = 0; j < 6; ++j) { const float xq = bf2f(pr[768 + lane + 64 * j]); s1 = fmaf(xq, xq, s1); }
#pragma unroll
            for (int j = 0; j < 4; ++j) { const float xk = bf2f(pr[1152 + lane + 64 * j]); s2 = fmaf(xk, xk, s2); }
            s1 = wave_sum(s1); s2 = wave_sum(s2);
            if (lane == 0) { RINV[2 * r] = 1.0f / sqrtf(s1 * (1.0f / 384.0f) + RMS_EPS); RINV[2 * r + 1] = 1.0f / sqrtf(s2 * (1.0f / 256.0f) + RMS_EPS); }
        }
    }
    SEAM(3);

    if (IN(4)) { PHASE_PTRS
        { pg8::DenseOrder S{(const char*)(PRJ + 768), (const char*)(wts + WO_QB), NROW / 256, 3, G, bid, (size_t)256 * PRJ_LD * 2, (size_t)256 * 384 * 2};
          pg8::EpiScaleBf16 E{QB, 768, RINV};
          pg8::gemm_phase<pg8::EpiScaleBf16, pg8::DenseOrder, true, true>(tid, LDSB, 384, PRJ_LD, S, E); }
        __syncthreads();
        { pg8::DenseOrder S{(const char*)(PRJ + 1152), (const char*)(wts + WO_KVB), NROW / 256, 4, G, bid, (size_t)256 * PRJ_LD * 2, (size_t)256 * 256 * 2};
          pg8::EpiScaleBf16 E{KVB, 1024, RINV + 1};
          pg8::gemm_phase<pg8::EpiScaleBf16, pg8::DenseOrder, true, true>(tid, LDSB, 256, PRJ_LD, S, E); }
    }
    SEAM(4);

    if (IN(5)) { PHASE_PTRS
        for (int i = 0;; ++i) { const int u = i * G + bid; if (u >= 1152) break;
            const bool isctx = u >= 1024; int b, h, qb;
            if (!isctx) { const int rest = u >> 3; b = 2 * (u & 7) + (rest >> 6); h = (rest & 63) >> 3; qb = rest & 7; } else { b = (u - 1024) >> 3; h = u & 7; qb = 0; }
            const int qrow0 = isctx ? NLAT + b * NCX : b * SEQ + qb * 256;
            fa::Unit U; U.Q = QB + (size_t)qrow0 * 768 + h * 96; U.K = KVB + h * 128; U.K2 = PRJ + 1408; U.V = KVB + h * 128 + 64;
            U.O = OB + (size_t)qrow0 * 1024 + 512 + h * 64; U.rowa = NLAT + b * NCX; U.nta = 4; U.rowb = b * SEQ; U.ntb = isctx ? 0 : 32;
            U.window = 0; U.qpos0 = 0; U.kposb0 = 0; U.sink = 0.f; U.has_sink = 0; U.tab = isctx ? nullptr : (const float*)(tabs + TAB_B); U.pos0 = qb * 256; U.qg = nullptr;
            fa::attn_unit<96, 64, 768, 1024, 1024, 1024, false, 4, 1, false, true>(tid, U, (char*)lds_raw); }
        for (int i = 0;; ++i) { const int u = i * G + bid; if (u >= 1152) break;
            const bool isctx = u >= 1024; int b, h, qb;
            if (!isctx) { const int rest = u >> 3; b = 2 * (u & 7) + (rest >> 6); h = (rest & 63) >> 3; qb = rest & 7; } else { b = (u - 1024) >> 3; h = u & 7; qb = 0; }
            const int qrow0 = isctx ? NLAT + b * NCX : b * SEQ + qb * 256;
            const int ks = isctx ? 0 : max(0, qb * 256 - 128), ke = isctx ? 0 : min(SEQ, qb * 256 + 384);
            fa::Unit U; U.Q = PRJ + (size_t)qrow0 * PRJ_LD + h * 64; U.K = PRJ + 512 + (h >> 2) * 64; U.K2 = nullptr; U.V = PRJ + 640 + (h >> 2) * 64;
            U.O = OB + (size_t)qrow0 * 1024 + h * 64; U.rowa = NLAT + b * NCX; U.nta = 4; U.rowb = b * SEQ + ks; U.ntb = (ke - ks) / 64;
            U.window = isctx ? 0 : 1; U.qpos0 = qb * 256; U.kposb0 = ks; U.sink = p.swa_sink[h]; U.has_sink = 1; U.tab = isctx ? nullptr : (const float*)(tabs + TAB_A); U.pos0 = qb * 256; U.qg = nullptr;
            fa::attn_unit<64, 64, PRJ_LD, PRJ_LD, PRJ_LD, 1024, true, 0, 2, false, false>(tid, U, (char*)lds_raw); }
    }
    SEAM(5);

    if (IN(6)) { PHASE_PTRS
        pg8::DenseOrder S{(const char*)OB, (const char*)(wts + WO_ABO), NROW / 256, 4, G, bid, (size_t)256 * 1024 * 2, (size_t)256 * 1024 * 2};
        pg8::EpiResid E{p.x, p.ctx, XR, MOD + 2048};
        pg8::gemm_phase<pg8::EpiResid, pg8::DenseOrder, true, true>(tid, LDSB, 1024, 1024, S, E);
    }
    SEAM(6);

#define ROUTER_PHASE(L, nrows) do { \
        { const float4* wsrc_ = (const float4*)(p.router_w + (size_t)(L) * 1024 * 32); float4* wl_ = (float4*)lds_raw; \
          for (int q = tid; q < 8192; q += NTHR) { const int c_ = q >> 3, e4_ = q & 7; wl_[c_ * 8 + (e4_ ^ ((c_ >> 5) & 7))] = wsrc_[q]; } } \
        __syncthreads(); \
        unsigned* cnt_ = ctl + CW_CNT + (L) * 32; \
        LAS unsigned* lcnt_ = (LAS unsigned*)(LDSB + LDS_MISC + 1024); LAS unsigned* lbase_ = lcnt_ + 32;       \
        if (tid < 32) lcnt_[tid] = 0u; \
        __syncthreads(); \
        const int half_ = lane >> 5, l5_ = lane & 31;                        \
        float g_[2][16]; ld16f(p.norm_ffn_g + (L) * 1024 + 32 * l5_, g_[0]); ld16f(p.norm_ffn_g + (L) * 1024 + 32 * l5_ + 16, g_[1]); \
        const float rb_ = p.router_b[(L) * 32 + l5_]; \
        const float4* wl_ = (const float4*)lds_raw + (size_t)(32 * l5_) * 8; const int sw_ = l5_ & 7; \
        for (int rp = gw; rp * 2 < (nrows); rp += NGW) { const int r = rp * 2 + half_; \
            const float* mr = MOD + (size_t)((L) * 17 + mod_row_of(r)) * 6144 + 3072 + 32 * l5_; \
            float v[2][16]; ld16f(XR + (size_t)r * 1024 + 32 * l5_, v[0]); ld16f(XR + (size_t)r * 1024 + 32 * l5_ + 16, v[1]); \
            float ss_ = 0.f; \
            _Pragma("unroll") for (int j = 0; j < 16; ++j) { ss_ = fmaf(v[0][j], v[0][j], ss_); ss_ = fmaf(v[1][j], v[1][j], ss_); } \
            _Pragma("unroll") for (int o_ = 1; o_ < 32; o_ <<= 1) ss_ += __shfl_xor(ss_, o_); \
            const float ri_ = 1.0f / sqrtf(ss_ * (1.0f / 1024.0f) + RMS_EPS); \
            _Pragma("unroll") for (int hh = 0; hh < 2; ++hh) { float sh_[16], sc_[16]; ld16f(mr + 16 * hh, sh_); ld16f(mr + 1024 + 16 * hh, sc_); \
                _Pragma("unroll") for (int j = 0; j < 16; ++j) v[hh][j] = (v[hh][j] * ri_ * g_[hh][j]) * (1.0f + sc_[j]) + sh_[j]; \
                st16f8((unsigned char*)H + (size_t)r * 1024 + 32 * l5_ + 16 * hh, v[hh]); }        \
            float acc[32]; \
            _Pragma("unroll") for (int e = 0; e < 32; ++e) acc[e] = 0.f; \
            _Pragma("unroll") for (int hh = 0; hh < 2; ++hh) _Pragma("unroll") for (int j = 0; j < 16; ++j) { \
                _Pragma("unroll") for (int e4 = 0; e4 < 8; ++e4) { const float4 w = wl_[(16 * hh + j) * 8 + (e4 ^ sw_)]; \
                    acc[4 * e4] = fmaf(v[hh][j], w.x, acc[4 * e4]); acc[4 * e4 + 1] = fmaf(v[hh][j], w.y, acc[4 * e4 + 1]); acc[4 * e4 + 2] = fmaf(v[hh][j], w.z, acc[4 * e4 + 2]); acc[4 * e4 + 3] = fmaf(v[hh][j], w.w, acc[4 * e4 + 3]); } } \
            float tv[4]; int ti[4]; route_reduce32(acc, l5_, rb_, tv, ti); \
            const float e1 = expf(tv[1] - tv[0]), e2 = expf(tv[2] - tv[0]), e3 = expf(tv[3] - tv[0]); const float inv = 1.0f / (1.0f + e1 + e2 + e3); \
            if (l5_ < 4) { const int ek = l5_ == 0 ? ti[0] : l5_ == 1 ? ti[1] : l5_ == 2 ? ti[2] : ti[3]; const float gk = (l5_ == 0 ? 1.0f : l5_ == 1 ? e1 : l5_ == 2 ? e2 : e3) * inv; \
                const unsigned pos = __hip_atomic_fetch_add(lcnt_ + ek, 1u, __ATOMIC_RELAXED, __HIP_MEMORY_SCOPE_WORKGROUP); TOKE[r * 4 + l5_] = ek; TOKP[r * 4 + l5_] = (int)pos; TOKG[r * 4 + l5_] = gk; } \
        } \
        __syncthreads(); \
        if (tid < 32) lbase_[tid] = atomicAdd(cnt_ + tid, lcnt_[tid]); \
        __syncthreads(); \
        for (int rp = gw; rp * 2 < (nrows); rp += NGW) { const int r = rp * 2 + half_; if (l5_ < 4) TOKP[r * 4 + l5_] += (int)lbase_[TOKE[r * 4 + l5_]]; } \
    } while (0)

#define EXCL_SETUP(L) \
        const int c_ = lane < 32 ? (int)ctl[CW_CNT + (L) * 32 + lane] : 0; const int padc_ = (c_ + 255) / 256 * 256; int pre_ = padc_; \
        _Pragma("unroll") for (int o_ = 1; o_ < 32; o_ <<= 1) { const int t_ = __shfl_up(pre_, o_); if ((lane & 31) >= o_) pre_ += t_; } \
        const int excl_ = pre_ - padc_;
#define PERMUTE_PHASE(L, nrows) do { EXCL_SETUP(L) \
        ROWS2(nrows) { ROWS2_IDX(nrows) \
            const int ra_ = rr_[0], rb_ = rr_[1]; \
            const uint4* sa_ = (const uint4*)(H + (size_t)ra_ * 1024) + lane * 2; const uint4* sb_ = (const uint4*)(H + (size_t)rb_ * 1024) + lane * 2; \
            const uint4 a0_ = sa_[0], a1_ = sa_[1], b0_ = sb_[0], b1_ = sb_[1]; \
            const int4 ea_ = *(const int4*)(TOKE + ra_ * 4), pa_ = *(const int4*)(TOKP + ra_ * 4), eb_ = *(const int4*)(TOKE + rb_ * 4), pb_ = *(const int4*)(TOKP + rb_ * 4); \
            const int sa0 = __shfl(excl_, ea_.x) + pa_.x, sa1 = __shfl(excl_, ea_.y) + pa_.y, sa2 = __shfl(excl_, ea_.z) + pa_.z, sa3 = __shfl(excl_, ea_.w) + pa_.w; \
            const int sb0 = __shfl(excl_, eb_.x) + pb_.x, sb1 = __shfl(excl_, eb_.y) + pb_.y, sb2 = __shfl(excl_, eb_.z) + pb_.z, sb3 = __shfl(excl_, eb_.w) + pb_.w; \
            { uint4* d_ = (uint4*)(XS + (size_t)sa0 * 1024) + lane * 2; d_[0] = a0_; d_[1] = a1_; } { uint4* d_ = (uint4*)(XS + (size_t)sa1 * 1024) + lane * 2; d_[0] = a0_; d_[1] = a1_; } \
            { uint4* d_ = (uint4*)(XS + (size_t)sa2 * 1024) + lane * 2; d_[0] = a0_; d_[1] = a1_; } { uint4* d_ = (uint4*)(XS + (size_t)sa3 * 1024) + lane * 2; d_[0] = a0_; d_[1] = a1_; } \
            if (two_) { \
            { uint4* d_ = (uint4*)(XS + (size_t)sb0 * 1024) + lane * 2; d_[0] = b0_; d_[1] = b1_; } { uint4* d_ = (uint4*)(XS + (size_t)sb1 * 1024) + lane * 2; d_[0] = b0_; d_[1] = b1_; } \
            { uint4* d_ = (uint4*)(XS + (size_t)sb2 * 1024) + lane * 2; d_[0] = b0_; d_[1] = b1_; } { uint4* d_ = (uint4*)(XS + (size_t)sb3 * 1024) + lane * 2; d_[0] = b0_; d_[1] = b1_; } } } \
        for (int e = 0; e < 32; ++e) { const int ce = __shfl(c_, e), be = __shfl(excl_, e), pe = __shfl(padc_, e); \
            for (int rr = ce + gw; rr < pe; rr += NGW) { uint4* d_ = (uint4*)(XS + (size_t)(be + rr) * 1024) + lane * 2; d_[0] = make_uint4(0u, 0u, 0u, 0u); d_[1] = make_uint4(0u, 0u, 0u, 0u); } } \
    } while (0)
#define PERMUTE_PHASE_F8(L, nrows) do { EXCL_SETUP(L) \
        unsigned char* XS8 = (unsigned char*)XS; \
        for (int r = gw; r < (nrows); r += NGW) { \
            const int4 ov_ = *((const int4*)((const unsigned char*)H + (size_t)r * 1024) + lane); \
            _Pragma("unroll") for (int k = 0; k < 4; ++k) { const int ek = TOKE[r * 4 + k], pk = TOKP[r * 4 + k]; const int slot = __shfl(excl_, ek) + pk; \
                *((int4*)(XS8 + (size_t)slot * 1024) + lane) = ov_; } } \
        for (int e = 0; e < 32; ++e) { const int ce = __shfl(c_, e), be = __shfl(excl_, e), pe = __shfl(padc_, e); \
            for (int rr = ce + gw; rr < pe; rr += NGW) *((int4*)(XS8 + (size_t)(be + rr) * 1024) + lane) = make_int4(0, 0, 0, 0); } \
    } while (0)
#define MOE_TABLE(L) \
        LAS int* tile_e = (LAS int*)(LDSB + LDS_MISC + 1024); LAS int* nm_p = tile_e + 640; \
        __syncthreads(); \
        if (tid == 0) { int t_ = 0; for (int e = 0; e < 32; ++e) { const int c_ = (int)ctl[CW_CNT + (L) * 32 + e]; const int n_ = (c_ + 255) / 256; for (int j = 0; j < n_; ++j) tile_e[t_ + j] = e; t_ += n_; } *nm_p = t_; } \
        __syncthreads(); \
        const int nM_ = __builtin_amdgcn_readfirstlane(*nm_p);
#define MOE_FAST1(L) do { MOE_TABLE(L) \
        pg8::MoeOrder S{(const char*)XS, (const char*)(wts + WO_W1) + (size_t)(L) * 32 * 2048 * 1024 * 2, tile_e, nM_, 8, G, bid, (size_t)256 * 1024 * 2, (size_t)2048 * 1024 * 2}; \
        pg8::EpiSwiglu E{ACT, p.moe_b_in + (size_t)(L) * 32 * 2048, 1.0f}; \
        pg8::gemm_phase<pg8::EpiSwiglu, pg8::MoeOrder, true, true>(tid, LDSB, 1024, 1024, S, E); } while (0)
#define MOE_FAST2(L) do { MOE_TABLE(L) \
        pg8::MoeOrder S{(const char*)ACT, (const char*)(wts + WO_W2) + (size_t)(L) * 32 * 1024 * 1024 * 2, tile_e, nM_, 4, G, bid, (size_t)256 * 1024 * 2, (size_t)1024 * 1024 * 2}; \
        pg8::EpiBiasBf16 E{Y, p.moe_b_out + (size_t)(L) * 32 * 1024, 1.0f}; \
        pg8::gemm_phase<pg8::EpiBiasBf16, pg8::MoeOrder, true, true>(tid, LDSB, 1024, 1024, S, E); } while (0)
#define MOE_FAST1_F8(L) do { MOE_TABLE(L) \
        pg8::MoeOrder S{(const char*)XS, (const char*)(wts + WO_W1) + (size_t)(L) * 32 * 2048 * 1024 * 2, tile_e, nM_, 8, G, bid, (size_t)256 * 1024, (size_t)2048 * 1024}; \
        if constexpr (MOE_F8_DOWN) { pg8::EpiSwigluF8 E{(unsigned char*)ACT, p.moe_b_in + (size_t)(L) * 32 * 2048}; \
            pg8::gemm_phase<pg8::EpiSwigluF8, pg8::MoeOrder, true, true, true>(tid, LDSB, 1024, 1024, S, E); } \
        else { pg8::EpiSwiglu E{ACT, p.moe_b_in + (size_t)(L) * 32 * 2048, 0.03125f}; \
            pg8::gemm_phase<pg8::EpiSwiglu, pg8::MoeOrder, false, true, true>(tid, LDSB, 1024, 1024, S, E); } } while (0)
#define MOE_FAST2_F8(L) do { MOE_TABLE(L) \
        pg8::MoeOrder S{(const char*)ACT, (const char*)(wts + WO_W2) + (size_t)(L) * 32 * 1024 * 1024 * 2, tile_e, nM_, 4, G, bid, (size_t)256 * 1024, (size_t)1024 * 1024}; \
        if constexpr (Y8_L1 && (L) == 1) { pg8::EpiBiasF8 E{(unsigned char*)Y, p.moe_b_out + (size_t)(L) * 32 * 1024, 0.03125f}; \
            pg8::gemm_phase<pg8::EpiBiasF8, pg8::MoeOrder, true, true, true>(tid, LDSB, 1024, 1024, S, E); } \
        else { pg8::EpiBiasBf16 E{Y, p.moe_b_out + (size_t)(L) * 32 * 1024, 0.03125f}; \
            pg8::gemm_phase<pg8::EpiBiasBf16, pg8::MoeOrder, true, true, true>(tid, LDSB, 1024, 1024, S, E); } } while (0)
#define COMBINE_ROWS2(L, v) do { \
        uint4 ya_[2][4], yb_[2][4]; float gk_[2][4]; float g2v_[2][16]; \
        _Pragma("unroll") for (int u = 0; u < 2; ++u) { const int r = rr_[u]; \
            _Pragma("unroll") for (int k = 0; k < 4; ++k) { const int ek = TOKE[r * 4 + k], pk = TOKP[r * 4 + k]; gk_[u][k] = TOKG[r * 4 + k]; \
                const int slot = __shfl(excl_, ek) + pk; const uint4* yr = (const uint4*)(Y + (size_t)slot * 1024 + 16 * lane); ya_[u][k] = yr[0]; yb_[u][k] = yr[1]; } \
            ld16f(MOD + (size_t)((L) * 17 + mod_row_of(r)) * 6144 + 5120 + 16 * lane, g2v_[u]); ld16f(XR + (size_t)r * 1024 + 16 * lane, v[u]); } \
        _Pragma("unroll") for (int u = 0; u < 2; ++u) { float f_[16]; \
            _Pragma("unroll") for (int j = 0; j < 16; ++j) f_[j] = 0.f; \
            _Pragma("unroll") for (int k = 0; k < 4; ++k) { const unsigned yw[8] = {ya_[u][k].x, ya_[u][k].y, ya_[u][k].z, ya_[u][k].w, yb_[u][k].x, yb_[u][k].y, yb_[u][k].z, yb_[u][k].w}; \
                _Pragma("unroll") for (int j = 0; j < 8; ++j) { f_[2 * j] = fmaf(gk_[u][k], __uint_as_float(yw[j] << 16), f_[2 * j]); f_[2 * j + 1] = fmaf(gk_[u][k], __uint_as_float(yw[j] & 0xffff0000u), f_[2 * j + 1]); } } \
            _Pragma("unroll") for (int j = 0; j < 16; ++j) v[u][j] = fmaf(g2v_[u][j], f_[j], v[u][j]); } } while (0)

#define COMBINE_ROWS2_F8(L, v) do { \
        int4 y8_[2][4]; float gk_[2][4]; float g2v_[2][16]; \
        _Pragma("unroll") for (int u = 0; u < 2; ++u) { const int r = rr_[u]; \
            _Pragma("unroll") for (int k = 0; k < 4; ++k) { const int ek = TOKE[r * 4 + k], pk = TOKP[r * 4 + k]; gk_[u][k] = TOKG[r * 4 + k]; \
                const int slot = __shfl(excl_, ek) + pk; y8_[u][k] = *((const int4*)((const unsigned char*)Y + (size_t)slot * 1024) + lane); } \
            ld16f(MOD + (size_t)((L) * 17 + mod_row_of(r)) * 6144 + 5120 + 16 * lane, g2v_[u]); ld16f(XR + (size_t)r * 1024 + 16 * lane, v[u]); } \
        _Pragma("unroll") for (int u = 0; u < 2; ++u) { float f_[16]; \
            _Pragma("unroll") for (int j = 0; j < 16; ++j) f_[j] = 0.f; \
            _Pragma("unroll") for (int k = 0; k < 4; ++k) { const int yw[4] = {y8_[u][k].x, y8_[u][k].y, y8_[u][k].z, y8_[u][k].w}; \
                _Pragma("unroll") for (int j = 0; j < 4; ++j) { const auto lo_ = __builtin_amdgcn_cvt_pk_f32_fp8(yw[j], false); const auto hi_ = __builtin_amdgcn_cvt_pk_f32_fp8(yw[j], true); \
                    f_[4 * j] = fmaf(gk_[u][k], lo_[0], f_[4 * j]); f_[4 * j + 1] = fmaf(gk_[u][k], lo_[1], f_[4 * j + 1]); f_[4 * j + 2] = fmaf(gk_[u][k], hi_[0], f_[4 * j + 2]); f_[4 * j + 3] = fmaf(gk_[u][k], hi_[1], f_[4 * j + 3]); } } \
            _Pragma("unroll") for (int j = 0; j < 16; ++j) v[u][j] = fmaf(g2v_[u][j], f_[j], v[u][j]); } } while (0)

    if (IN(7)) { PHASE_PTRS ROUTER_PHASE(0, NROW); }
    SEAM(7);
#if MOE_F8_L0
    if (IN(8)) { PHASE_PTRS PERMUTE_PHASE_F8(0, NROW); }
    SEAM(8);
    if (IN(9)) { PHASE_PTRS MOE_FAST1_F8(0); }
    SEAM(9);
#else
    if (IN(8)) { PHASE_PTRS PERMUTE_PHASE(0, NROW); }
    SEAM(8);
    if (IN(9)) { PHASE_PTRS MOE_FAST1(0); }
    SEAM(9);
#endif
    if (IN(10)) { PHASE_PTRS if constexpr (MOE_F8_L0 && MOE_F8_DOWN) { MOE_FAST2_F8(0); } else { MOE_FAST2(0); } }
    SEAM(10);

    if (IN(11)) { PHASE_PTRS EXCL_SETUP(0)
        float g[16]; ld16f(p.norm_mix_g + 1024 + 16 * lane, g);
        ROWS2(NROW) { ROWS2_IDX(NROW)
            float v[2][16]; COMBINE_ROWS2(0, v);
            st16f(XR + (size_t)rr_[0] * 1024 + 16 * lane, v[0]); if (two_) st16f(XR + (size_t)rr_[1] * 1024 + 16 * lane, v[1]);
            const float* mr0 = MOD + (size_t)(1 * 17 + mod_row_of(rr_[0])) * 6144 + 16 * lane; const float* mr1 = MOD + (size_t)(1 * 17 + mod_row_of(rr_[1])) * 6144 + 16 * lane;
            NORM_MOD16x2(v, g, mr0, mr1);
            if (INPROJ_F8) { st16f8((unsigned char*)H + (size_t)rr_[0] * 1024 + 16 * lane, v[0]); if (two_) st16f8((unsigned char*)H + (size_t)rr_[1] * 1024 + 16 * lane, v[1]); }
            else { st16bf(H + (size_t)rr_[0] * 1024 + 16 * lane, v[0]); if (two_) st16bf(H + (size_t)rr_[1] * 1024 + 16 * lane, v[1]); }
        }
    }
    SEAM(11);

    if (IN(12)) { PHASE_PTRS
        constexpr size_t ES_ = INPROJ_F8 ? 1 : 2;
        pg8::DenseOrder S{(const char*)H, (const char*)(wts + WO_C), NROW / 256, 6, G, bid, (size_t)256 * 1024 * ES_, (size_t)256 * 1024 * ES_};
        pg8::EpiStoreBf16 E{PRJ, PRJ_LD, INPROJ_F8 ? 0.03125f : 1.0f};
        pg8::gemm_phase<pg8::EpiStoreBf16, pg8::DenseOrder, true, true, INPROJ_F8 != 0>(tid, LDSB, 1024, 1024, S, E);
    }
    SEAM(12);

    if (IN(13)) { PHASE_PTRS
        const float2* TC = (const float2*)(tabs + TAB_C); const float kg1 = p.c_k_g[lane], kg2 = p.c_k_g[64 + lane];
        for (int r = gw; r < NROW; r += NGW) {
            bf16_t* pr = PRJ + (size_t)r * PRJ_LD + 1024; float2 t = make_float2(1.f, 0.f); if (r < NLAT) t = TC[(r % SEQ) * 64 + lane];
#pragma unroll
            for (int kv = 0; kv < 2; ++kv) { float x1 = bf2f(pr[kv * 128 + lane]), x2 = bf2f(pr[kv * 128 + 64 + lane]);
                const float ss = wave_sum(x1 * x1 + x2 * x2); const float ri = 1.0f / sqrtf(ss * (1.0f / 128.0f) + RMS_EPS);
                x1 = x1 * ri * kg1; x2 = x2 * ri * kg2;
                pr[kv * 128 + lane] = f2bf(x1 * t.x - x2 * t.y); pr[kv * 128 + 64 + lane] = f2bf(x2 * t.x + x1 * t.y); }
        }
    }
    SEAM(13);

    if (IN(14)) { PHASE_PTRS
        for (int i = 0;; ++i) { const int u = i * G + bid; if (u >= 1024) break;
            const int rest = u >> 3; const int b = 2 * (u & 7) + (rest >> 6), h = (rest & 63) >> 3, qb = rest & 7; const int qrow0 = b * SEQ + qb * 256;
            fa::Unit U; U.Q = PRJ + (size_t)qrow0 * PRJ_LD + h * 128; U.K = PRJ + 1024 + (h >> 2) * 128; U.K2 = nullptr; U.V = PRJ + 1280 + (h >> 2) * 128;
            U.O = OB + (size_t)qrow0 * 1024 + h * 128; U.rowa = NLAT + b * NCX; U.nta = 4; U.rowb = b * SEQ; U.ntb = 32;
            U.window = 0; U.qpos0 = 0; U.kposb0 = 0; U.sink = 0.f; U.has_sink = 0; U.tab = (const float*)(tabs + TAB_C); U.pos0 = qb * 256; U.qg = (const float*)(tabs + TAB_QG);
            fa::attn_unit<128, 128, PRJ_LD, PRJ_LD, PRJ_LD, 1024, false, 0, 4, true, false>(tid, U, (char*)lds_raw); }
    }
    SEAM(14);

    if (IN(15)) { PHASE_PTRS
        pg8::DenseOrder S{(const char*)OB, (const char*)(wts + WO_CO), NLAT / 256, 4, G, bid, (size_t)256 * 1024 * 2, (size_t)256 * 1024 * 2};
        pg8::EpiResid E{XR, XR, XR, MOD + 17 * 6144 + 2048};
        pg8::gemm_phase<pg8::EpiResid, pg8::DenseOrder, true, true>(tid, LDSB, 1024, 1024, S, E);
    }
    SEAM(15);

    if (IN(16)) { PHASE_PTRS ROUTER_PHASE(1, NLAT); }
    SEAM(16);
#if MOE_F8_L1
    if (IN(17)) { PHASE_PTRS PERMUTE_PHASE_F8(1, NLAT); }
    SEAM(17);
    if (IN(18)) { PHASE_PTRS MOE_FAST1_F8(1); }
    SEAM(18);
    if (IN(19)) { PHASE_PTRS if constexpr (MOE_F8_DOWN) { MOE_FAST2_F8(1); } else { MOE_FAST2(1); } }
    SEAM(19);
#else
    if (IN(17)) { PHASE_PTRS PERMUTE_PHASE(1, NLAT); }
    SEAM(17);
    if (IN(18)) { PHASE_PTRS MOE_FAST1(1); }
    SEAM(18);
    if (IN(19)) { PHASE_PTRS MOE_FAST2(1); }
    SEAM(19);
#endif

    if (IN(20)) { PHASE_PTRS EXCL_SETUP(1)
        float g[16]; ld16f(p.final_g + 16 * lane, g);
        ROWS2(NLAT) { ROWS2_IDX(NLAT)
            float v[2][16]; if constexpr (Y8_L1 && MOE_F8_L1 && MOE_F8_DOWN) { COMBINE_ROWS2_F8(1, v); } else { COMBINE_ROWS2(1, v); }
            float s0 = 0.f, s1 = 0.f;
#pragma unroll
            for (int j = 0; j < 16; ++j) { s0 = fmaf(v[0][j], v[0][j], s0); s1 = fmaf(v[1][j], v[1][j], s1); }
            wave_sum2(s0, s1); const float ri0 = 1.0f / sqrtf(s0 * (1.0f / 1024.0f) + RMS_EPS), ri1 = 1.0f / sqrtf(s1 * (1.0f / 1024.0f) + RMS_EPS);
#pragma unroll
            for (int j = 0; j < 16; ++j) { v[0][j] = v[0][j] * ri0 * g[j]; v[1][j] = v[1][j] * ri1 * g[j]; }
            st16f(p.out + (size_t)rr_[0] * 1024 + 16 * lane, v[0]); if (two_) st16f(p.out + (size_t)rr_[1] * 1024 + 16 * lane, v[1]);
        }
    }
#undef IN
#undef SEAM
}

#ifndef MK_PER_PHASE
#define MK_PER_PHASE 0
#endif
extern "C" void kernel_launch(void* const* d_in, const int* in_sizes, int n_in, void* d_out, int out_size, void* d_ws, size_t ws_size, hipStream_t stream) {
    static int grid = 0;
    if (grid == 0) {
        if (n_in != 26 || out_size != NLAT * DM || ws_size < WS_END) { fprintf(stderr, "kernel_launch: unexpected shapes (n_in %d out %d ws %zu need %zu)\n", n_in, out_size, ws_size, (size_t)WS_END); grid = -1; return; }
        int dev = 0, cus = 0;
        if (hipGetDevice(&dev) != hipSuccess || hipDeviceGetAttribute(&cus, hipDeviceAttributeMultiprocessorCount, dev) != hipSuccess) { grid = -1; return; }
        if (hipFuncSetAttribute((const void*)fwd_kernel, hipFuncAttributeMaxDynamicSharedMemorySize, LDS_BYTES) != hipSuccess) { fprintf(stderr, "kernel_launch: hipFuncSetAttribute failed\n"); grid = -1; return; }
        int per_cu = 0;
        if (hipOccupancyMaxActiveBlocksPerMultiprocessor(&per_cu, (const void*)fwd_kernel, NTHR, LDS_BYTES) != hipSuccess || per_cu < 1) { fprintf(stderr, "kernel_launch: occupancy query says %d\n", per_cu); }
        (void)hipGetLastError();
        grid = cus;
    }
    if (grid < 0) return;
    (void)hipMemsetAsync((char*)d_ws + WS_CTL, 0, CTL_BYTES, stream);
    Params p{};
    const float** pp = (const float**)&p;
    for (int i = 0; i < 26; ++i) pp[i] = (const float*)d_in[i];
    p.out = (float*)d_out; p.ws = (unsigned char*)d_ws;
#if MK_PER_PHASE
    for (int k = 0; k < N_PHASES; ++k) { p.ph_lo = k; p.ph_hi = k + 1; hipLaunchKernelGGL(fwd_kernel, dim3(grid), dim3(NTHR), LDS_BYTES, stream, p); }
#else
    p.ph_lo = 0; p.ph_hi = N_PHASES;
    hipLaunchKernelGGL(fwd_kernel, dim3(grid), dim3(NTHR), LDS_BYTES, stream, p);
#endif
}
```

```cpp
#include <hip/hip_runtime.h>
#include <cstdio>
#include <cstdint>

typedef unsigned short bf16_t;
typedef bf16_t act_t;
#define GAS __attribute__((address_space(1)))
#define LAS __attribute__((address_space(3)))

constexpr int DM = 1024, NB = 16, SEQ = 2048, NCX = 256, GRIDW = 64;
constexpr int NLAT = NB * SEQ, NCTX = NB * NCX, NROW = NLAT + NCTX;
constexpr int AB_IN = 1440, C_IN = 1536, PRJ_LD = 1536;
constexpr int NEXP = 32, DFF = 1024;
constexpr int CAP = 155648;
constexpr float RMS_EPS = 1e-6f;
constexpr int NTHR = 512;

constexpr size_t MiB = 1u << 20;
constexpr size_t ASZ = sizeof(act_t);
constexpr size_t WS_CTL = 0, CTL_BYTES = 1 * MiB;
constexpr size_t WS_MOD = 1 * MiB;
constexpr size_t WS_TOKE = 2 * MiB, WS_TOKP = 3 * MiB, WS_TOKG = 4 * MiB;
constexpr size_t WS_RINV = 5 * MiB;
constexpr size_t WS_TAB = 6 * MiB;
constexpr size_t TAB_A = 0, TAB_B = (size_t)SEQ * 32 * 8, TAB_C = TAB_B + (size_t)SEQ * 16 * 8, TAB_QG = TAB_C + (size_t)SEQ * 64 * 8;
constexpr size_t WS_XR = 16 * MiB;
constexpr size_t WS_H = WS_XR + 144 * MiB;
constexpr size_t WS_BIG = WS_H + (size_t)NROW * 1024 * ASZ;
constexpr size_t OFF_PRJ = 0;
constexpr size_t OFF_QB = OFF_PRJ + (size_t)NROW * 1536 * ASZ;
constexpr size_t OFF_KVB = OFF_QB + (size_t)NROW * 768 * ASZ;
constexpr size_t OFF_O = OFF_KVB + (size_t)NROW * 1024 * ASZ;
constexpr size_t BIG_A = OFF_O + (size_t)NROW * 1024 * ASZ;
constexpr size_t BIG_Y = (size_t)CAP * 1024 * ASZ;
constexpr size_t BIG_BYTES = BIG_A > BIG_Y ? BIG_A : BIG_Y;
constexpr size_t WS_ACT = WS_BIG + BIG_BYTES;
constexpr size_t WS_XS = WS_ACT + (size_t)CAP * 1024 * ASZ;
constexpr size_t WS_W = WS_XS + (size_t)CAP * 1024 * ASZ;
constexpr size_t WO_AB = 0;
constexpr size_t WO_QB = WO_AB + (size_t)1536 * 1024 * 2;
constexpr size_t WO_KVB = WO_QB + (size_t)768 * 384 * 2;
constexpr size_t WO_ABO = WO_KVB + (size_t)1024 * 256 * 2;
constexpr size_t WO_C = WO_ABO + (size_t)1024 * 1024 * 2;
constexpr size_t WO_CO = WO_C + (size_t)1536 * 1024 * 2;
constexpr size_t WO_W1 = WO_CO + (size_t)1024 * 1024 * 2;
constexpr size_t WO_W2 = WO_W1 + (size_t)64 * 2048 * 1024 * 2;
constexpr size_t WS_END = WS_W + WO_W2 + (size_t)64 * 1024 * 1024 * 2;

constexpr int CW_CNT = 64;
constexpr int CW_BAR = 4096;

__device__ __forceinline__ float bf2f(bf16_t v) { return __uint_as_float(((unsigned)v) << 16); }
__device__ __forceinline__ bf16_t f2bf(float f) { unsigned u = __float_as_uint(f); return (bf16_t)((u + 0x7fffu + ((u >> 16) & 1u)) >> 16); }
__device__ __forceinline__ float ldA(const float* p) { return *p; }
__device__ __forceinline__ float ldA(const bf16_t* p) { return bf2f(*p); }
__device__ __forceinline__ void stA(float* p, float v) { *p = v; }
__device__ __forceinline__ void stA(bf16_t* p, float v) { *p = f2bf(v); }
template <int N> __device__ __forceinline__ void load_vec(const float* p, float (&o)[N]) {
#pragma unroll
    for (int i = 0; i < N / 4; ++i) { const float4 t = ((const float4*)p)[i]; o[4 * i] = t.x; o[4 * i + 1] = t.y; o[4 * i + 2] = t.z; o[4 * i + 3] = t.w; }
}
template <int N> __device__ __forceinline__ void load_vec(const bf16_t* p, float (&o)[N]) {
#pragma unroll
    for (int i = 0; i < N / 8; ++i) { const uint4 t = ((const uint4*)p)[i];
        o[8 * i] = __uint_as_float(t.x << 16); o[8 * i + 1] = __uint_as_float(t.x & 0xffff0000u); o[8 * i + 2] = __uint_as_float(t.y << 16); o[8 * i + 3] = __uint_as_float(t.y & 0xffff0000u);
        o[8 * i + 4] = __uint_as_float(t.z << 16); o[8 * i + 5] = __uint_as_float(t.z & 0xffff0000u); o[8 * i + 6] = __uint_as_float(t.w << 16); o[8 * i + 7] = __uint_as_float(t.w & 0xffff0000u); }
}
__device__ __forceinline__ float wave_sum(float v) {
#pragma unroll
    for (int o = 1; o < 64; o <<= 1) v += __shfl_xor(v, o);
    return v;
}

__device__ __forceinline__ void wave_sum2(float& a, float& b) {
#pragma unroll
    for (int o = 1; o < 64; o <<= 1) { const float ta = __shfl_xor(a, o), tb = __shfl_xor(b, o); a += ta; b += tb; }
}
__device__ __forceinline__ void ld16f(const float* p, float (&v)[16]) {
#pragma unroll
    for (int i = 0; i < 4; ++i) { const float4 t = ((const float4*)p)[i]; v[4 * i] = t.x; v[4 * i + 1] = t.y; v[4 * i + 2] = t.z; v[4 * i + 3] = t.w; }
}
__device__ __forceinline__ void st16f(float* p, const float (&v)[16]) {
#pragma unroll
    for (int i = 0; i < 4; ++i) ((float4*)p)[i] = make_float4(v[4 * i], v[4 * i + 1], v[4 * i + 2], v[4 * i + 3]);
}
__device__ __forceinline__ unsigned cvtpk2(float lo, float hi) { unsigned r; asm volatile("v_cvt_pk_bf16_f32 %0, %1, %2" : "=v"(r) : "v"(lo), "v"(hi)); return r; }
__device__ __forceinline__ void st16bf(bf16_t* p, const float (&v)[16]) {
    ((uint4*)p)[0] = make_uint4(cvtpk2(v[0], v[1]), cvtpk2(v[2], v[3]), cvtpk2(v[4], v[5]), cvtpk2(v[6], v[7]));
    ((uint4*)p)[1] = make_uint4(cvtpk2(v[8], v[9]), cvtpk2(v[10], v[11]), cvtpk2(v[12], v[13]), cvtpk2(v[14], v[15]));
}

__device__ __forceinline__ void st16f8(unsigned char* p, const float (&v)[16]) {
    int o[4];
#pragma unroll
    for (int j = 0; j < 4; ++j) { const int t = __builtin_amdgcn_cvt_pk_fp8_f32(v[4 * j], v[4 * j + 1], 0, false); o[j] = __builtin_amdgcn_cvt_pk_fp8_f32(v[4 * j + 2], v[4 * j + 3], t, true); }
    *(int4*)p = make_int4(o[0], o[1], o[2], o[3]);
}
#define XB_TMO      128
#define XB_XCNT(j)  (256  + 64 * (j))
#define XB_XSUB(j)  (1280 + 64 * (j))
#define XB_XGEN(j)  (2304 + 64 * (j))
#define XB_TOP      3328
#define XB_TOPGEN   3392
#define XCD_BAR_WORDS 3456
#define XB_SPIN_CAP (1u << 22)
__device__ __forceinline__ unsigned xb_ld(unsigned* p)              { return __hip_atomic_load(p, __ATOMIC_RELAXED, __HIP_MEMORY_SCOPE_AGENT); }
__device__ __forceinline__ unsigned xb_add(unsigned* p, unsigned v) { return __hip_atomic_fetch_add(p, v, __ATOMIC_RELAXED, __HIP_MEMORY_SCOPE_AGENT); }
__device__ __forceinline__ unsigned xb_xcc_id() { return (unsigned)__builtin_amdgcn_s_getreg((3 << 11) | 20) & 0xFu; }
#define XB_SPIN(cond, bar) do { unsigned _sp = 0; while (cond) { __builtin_amdgcn_s_sleep(1); \
    if ((++_sp & 255u) == 0u) { if (xb_ld(&(bar)[XB_TMO])) break; if (_sp > XB_SPIN_CAP) { atomicAdd(&(bar)[XB_TMO], 1u); break; } } } } while (0)
struct XcdBarrier { unsigned* bar; unsigned x; volatile LAS unsigned* st; };
__device__ __forceinline__ bool xb_is_leader(int wave0) { return wave0 == 0 && __builtin_amdgcn_mbcnt_hi(~0u, __builtin_amdgcn_mbcnt_lo(~0u, 0u)) == 0u; }
__device__ __forceinline__ XcdBarrier xcd_barrier_post(unsigned* bar, volatile LAS unsigned* st, int wave0) {
    XcdBarrier b; b.bar = bar; b.x = xb_xcc_id(); b.st = st;
    if (xb_is_leader(wave0)) (void)xb_add(&bar[XB_XCNT(b.x)], 1u);
    return b;
}
__device__ __forceinline__ void xcd_barrier_complete(unsigned* bar, unsigned x, unsigned& nloc, unsigned& nx) {
    const unsigned G = gridDim.x * gridDim.y * gridDim.z;
    unsigned sum, cnt, mine, sp = 0u;
    for (;;) {
        sum = 0u; cnt = 0u; mine = 0u;
#pragma unroll
        for (unsigned j = 0; j < 16; ++j) { const unsigned c = xb_ld(&bar[XB_XCNT(j)]); sum += c; cnt += (c > 0u) ? 1u : 0u; mine = (j == x) ? c : mine; }
        if (sum == G) break;
        __builtin_amdgcn_s_sleep(1);
        if ((++sp & 255u) == 0u) { if (xb_ld(&bar[XB_TMO])) break; if (sp > XB_SPIN_CAP) { atomicAdd(&bar[XB_TMO], 1u); break; } }
    }
    nloc = mine > 0u ? mine : 1u; nx = cnt > 0u ? cnt : 1u;
}
__device__ __forceinline__ void xcd_barrier(const XcdBarrier& b, int wave0) {
    asm volatile("s_waitcnt vmcnt(0)" ::: "memory");
    __syncthreads();
    if (xb_is_leader(wave0)) {
        unsigned* bar = b.bar;
        __builtin_amdgcn_s_waitcnt(0);
        unsigned nloc = b.st[0], nx = b.st[1];
        if (nloc == 0u) { xcd_barrier_complete(bar, b.x, nloc, nx); b.st[0] = nloc; b.st[1] = nx; }
        const unsigned old = xb_add(&bar[XB_XSUB(b.x)], 1u);
        const unsigned gen = old / nloc;
        if (old + 1u == (gen + 1u) * nloc) {
            __builtin_amdgcn_fence(__ATOMIC_RELEASE, "agent");
            asm volatile("s_waitcnt vmcnt(0)" ::: "memory");
            const unsigned og = xb_add(&bar[XB_TOP], 1u);
            const unsigned tg = og / nx;
            if (og + 1u == (tg + 1u) * nx) xb_add(&bar[XB_TOPGEN], 1u);
            else XB_SPIN(xb_ld(&bar[XB_TOPGEN]) == tg, bar);
            __builtin_amdgcn_fence(__ATOMIC_ACQUIRE, "agent");
            xb_add(&bar[XB_XGEN(b.x)], 1u);
            asm volatile("s_waitcnt vmcnt(0)" ::: "memory");
        } else {
            XB_SPIN(xb_ld(&bar[XB_XGEN(b.x)]) == gen, bar);
            __builtin_amdgcn_fence(__ATOMIC_ACQUIRE, "agent");
            asm volatile("s_waitcnt vmcnt(0)" ::: "memory");
        }
    }
    __syncthreads();
}


#ifndef FAST_GEMM
#define FAST_GEMM 1
#endif
namespace pg8 {
#define PG8_LAS __attribute__((address_space(3)))
typedef short bf16x8 __attribute__((ext_vector_type(8)));
typedef float f32x4 __attribute__((ext_vector_type(4)));
typedef unsigned u32x4 __attribute__((ext_vector_type(4)));
constexpr int BM = 256, BK = 64, HALF = 128, HTB = HALF * BK * 2  , STAGE_BYTES = 8 * HTB, NXCD = 8, WGM = 8;

__host__ __device__ __forceinline__ int lds_byte(int r, int c) { const int st = (r >> 4) * 2 + (c >> 5), rr = r & 15, cc = c & 31, ob = rr * 64 + cc * 2; return st * 1024 + (ob ^ (((ob >> 9) & 1) << 5)); }
__host__ __device__ __forceinline__ void stage_rc(int b, int& R, int& C) { const int st = b / 1024, sb = b % 1024, swz = sb ^ (((sb >> 9) & 1) << 5); R = (st >> 1) * 16 + swz / 64; C = (st & 1) * 32 + (swz % 64) / 2; }
__host__ __device__ __forceinline__ int perm32(int rho) { const int n = rho >> 4, i = rho & 15; return 8 * (i >> 2) + 4 * n + (i & 3); }


struct Unit { const char* a; const char* b; int pm, pn, aux; };
__device__ __forceinline__ unsigned cvt_pk_bf16(float lo, float hi) { unsigned r; asm volatile("v_cvt_pk_bf16_f32 %0, %1, %2" : "=v"(r) : "v"(lo), "v"(hi)); return r; }
typedef int v8i32 __attribute__((ext_vector_type(8)));
__device__ __forceinline__ v8i32 cat16(bf16x8 lo, bf16x8 hi) { typedef int v4i32 __attribute__((ext_vector_type(4))); const v4i32 a = __builtin_bit_cast(v4i32, lo), b = __builtin_bit_cast(v4i32, hi); return __builtin_shufflevector(a, b, 0, 1, 2, 3, 4, 5, 6, 7); }
template <class Epi, class Sched, bool ALIGN_EPI = false, bool SP2 = false, bool F8 = false>
__device__ __forceinline__ void gemm_phase(const int tid, PG8_LAS unsigned char* lds, const int K, const int lda, const Sched& S, const Epi& E) {
    const int wid = __builtin_amdgcn_readfirstlane(tid >> 6), lane = tid & 63, wr = wid >> 2, wc = wid & 3, fr = lane & 15, fq = lane >> 4;
    const int nt = F8 ? K / (2 * BK) : K / BK;
    unsigned voffA[2], voffB[2];
#pragma unroll
    for (int i = 0; i < 2; ++i) { int R, C; stage_rc(tid * 16 + i * 8192, R, C); const int Rb = Epi::PERM ? ((R & ~31) + perm32(R & 31)) : R;
        voffA[i] = F8 ? (unsigned)(R * lda + 2 * C) : (unsigned)(R * lda + C) * 2u; voffB[i] = F8 ? (unsigned)(Rb * K + 2 * C) : (unsigned)(Rb * K + C) * 2u; }
    const size_t kstep = (size_t)(BK * 2);
    const size_t hstepA = (size_t)HALF * lda * (F8 ? 1 : 2);
    const size_t hstep = (size_t)HALF * K * (F8 ? 1 : 2);
    const unsigned ldsbase = (unsigned)__builtin_amdgcn_readfirstlane((int)((unsigned)(uintptr_t)lds + (unsigned)wid * 1024u));
    const unsigned ldsw = (unsigned)wid * 1024u;
    const int aoff = lds_byte(wr * 64 + fr, fq * 8), boff = lds_byte(wc * 32 + fr, fq * 8);
#define PG8_SA(b, h) (((b) * 2 + (h)) * HTB)
#define PG8_SB(b, h) ((4 + (b) * 2 + (h)) * HTB)
#define PG8_STAGE(bufoff, gbase, voff) do { _Pragma("unroll") for (int _i = 0; _i < 2; ++_i) { \
        if constexpr (F8) { unsigned keep_; asm volatile("s_mov_b32 %0, m0\n\ts_mov_b32 m0, %3\n\ts_nop 0\n\tglobal_load_lds_dwordx4 %1, %2\n\ts_mov_b32 m0, %0" : "=&s"(keep_) : "v"((voff)[_i]), "s"((const char*)(gbase)), "s"(ldsbase + (unsigned)((bufoff) + _i * 8192)) : "memory"); } \
        else __builtin_amdgcn_global_load_lds((const unsigned*)((const char*)(gbase) + (voff)[_i]), (PG8_LAS unsigned*)(lds + (bufoff) + ldsw + _i * 8192), 16, 0, 0); } } while (0)
#define PG8_LDA(dst, b, h) do { _Pragma("unroll") for (int m = 0; m < 4; ++m) { _Pragma("unroll") for (int k = 0; k < 2; ++k) dst[m][k] = *(const PG8_LAS bf16x8*)(lds + PG8_SA(b, h) + aoff + m * 2048 + k * 1024); \
        if constexpr (F8) dst##8[m] = cat16(dst[m][0], dst[m][1]); } } while (0)
#define PG8_LDB(dst, b, h) do { _Pragma("unroll") for (int n = 0; n < 2; ++n) { _Pragma("unroll") for (int k = 0; k < 2; ++k) dst[n][k] = *(const PG8_LAS bf16x8*)(lds + PG8_SB(b, h) + boff + n * 2048 + k * 1024); \
        if constexpr (F8) dst##8[n] = cat16(dst[n][0], dst[n][1]); } } while (0)
#define PG8_MMA(ai, bj, At, Bt) do { __builtin_amdgcn_s_setprio(1); _Pragma("unroll") for (int m = 0; m < 4; ++m) _Pragma("unroll") for (int n = 0; n < 2; ++n) { \
        if constexpr (F8) acc[ai][bj][m][n] = __builtin_amdgcn_mfma_scale_f32_16x16x128_f8f6f4(Bt##8[n], At##8[m], acc[ai][bj][m][n], 0, 0, 0, 0x7f7f7f7f, 0, 0x7f7f7f7f); \
        else { _Pragma("unroll") for (int k = 0; k < 2; ++k) acc[ai][bj][m][n] = __builtin_amdgcn_mfma_f32_16x16x32_bf16(Bt[n][k], At[m][k], acc[ai][bj][m][n], 0, 0, 0); } } __builtin_amdgcn_s_setprio(0); } while (0)
#define PG8_WAIT_V(n) asm volatile("s_waitcnt vmcnt(" #n ")" ::: "memory")
#define PG8_WAIT_L(n) asm volatile("s_waitcnt lgkmcnt(" #n ")" ::: "memory")
#define PG8_BAR __builtin_amdgcn_s_barrier()
#define PG8_SCHED __builtin_amdgcn_sched_barrier(0)
    Unit cur, nxt; int ui = 0;
    if (!S.next(0, cur)) return;
    f32x4 acc[2][2][4][2];
#pragma unroll
    for (int a = 0; a < 2; ++a)
#pragma unroll
        for (int b = 0; b < 2; ++b)
#pragma unroll
            for (int m = 0; m < 4; ++m)
#pragma unroll
                for (int n = 0; n < 2; ++n) acc[a][b][m][n] = (f32x4){0.f, 0.f, 0.f, 0.f};
    bf16x8 At[4][2], B0[2][2], B1[2][2]; v8i32 At8[4], B08[2], B18[2]; (void)At8; (void)B08; (void)B18;
    const char* cA = cur.a; const char* cB = cur.b;
    S.a_ready(cur);
    if constexpr (SP2) {
        PG8_STAGE(PG8_SB(0, 0), cB, voffB); PG8_STAGE(PG8_SB(0, 1), cB + hstep, voffB); PG8_STAGE(PG8_SA(0, 0), cA, voffA); PG8_STAGE(PG8_SA(0, 1), cA + hstepA, voffA);
        if (wr == 1) PG8_BAR;
        PG8_WAIT_V(2); PG8_BAR;
        PG8_STAGE(PG8_SB(1, 0), cB + kstep, voffB); PG8_STAGE(PG8_SA(1, 0), cA + kstep, voffA); PG8_STAGE(PG8_SB(1, 1), cB + hstep + kstep, voffB);
        PG8_WAIT_V(6); PG8_BAR;
    } else {
        PG8_STAGE(PG8_SB(0, 0), cB, voffB); PG8_STAGE(PG8_SA(0, 0), cA, voffA); PG8_STAGE(PG8_SB(0, 1), cB + hstep, voffB); PG8_STAGE(PG8_SA(0, 1), cA + hstepA, voffA);
        if (wr == 1) PG8_BAR;
        PG8_WAIT_V(4); PG8_BAR;
        PG8_STAGE(PG8_SB(1, 0), cB + kstep, voffB); PG8_STAGE(PG8_SA(1, 0), cA + kstep, voffA); PG8_STAGE(PG8_SB(1, 1), cB + hstep + kstep, voffB);
        PG8_WAIT_V(6); PG8_BAR;
    }
    for (;;) {
        const bool has_next = S.next(ui + 1, nxt);
        const char* nA = has_next ? nxt.a : cA; const char* nB = has_next ? nxt.b : cB;
#pragma unroll 1
        for (int t = 0; t < nt; t += 2) {
            const bool last = (t == nt - 2);
            const char* a1 = cA + (size_t)(t + 1) * kstep;
            const char* a2 = last ? nA : cA + (size_t)(t + 2) * kstep; const char* b2 = last ? nB : cB + (size_t)(t + 2) * kstep;
            const char* a3 = a2 + kstep; const char* b3 = b2 + kstep;
            if (last && has_next) S.a_ready(nxt);
            if constexpr (SP2) {
            PG8_LDB(B0, 0, 0); PG8_LDB(B1, 0, 1); PG8_SCHED; PG8_LDA(At, 0, 0); PG8_STAGE(PG8_SA(1, 1), a1 + hstepA, voffA);
            PG8_WAIT_V(8); PG8_WAIT_L(0); PG8_BAR; PG8_MMA(0, 0, At, B0); PG8_MMA(0, 1, At, B1); PG8_BAR; PG8_SCHED;
            PG8_LDA(At, 0, 1); PG8_STAGE(PG8_SB(0, 0), b2, voffB); PG8_STAGE(PG8_SB(0, 1), b2 + hstep, voffB); PG8_STAGE(PG8_SA(0, 0), a2, voffA);
            PG8_WAIT_V(8); PG8_WAIT_L(0); PG8_BAR; PG8_MMA(1, 0, At, B0); PG8_MMA(1, 1, At, B1); PG8_BAR; PG8_SCHED;
            PG8_LDB(B0, 1, 0); PG8_LDB(B1, 1, 1); PG8_SCHED; PG8_LDA(At, 1, 0); PG8_STAGE(PG8_SA(0, 1), a2 + hstepA, voffA);
            PG8_WAIT_V(8); PG8_WAIT_L(0); PG8_BAR; PG8_MMA(0, 0, At, B0); PG8_MMA(0, 1, At, B1); PG8_BAR; PG8_SCHED;
            PG8_LDA(At, 1, 1); PG8_STAGE(PG8_SB(1, 0), b3, voffB); PG8_STAGE(PG8_SB(1, 1), b3 + hstep, voffB); PG8_STAGE(PG8_SA(1, 0), a3, voffA);
            PG8_WAIT_V(8); PG8_WAIT_L(0); PG8_BAR; PG8_MMA(1, 0, At, B0); PG8_MMA(1, 1, At, B1); PG8_BAR; PG8_SCHED;
            } else {
            PG8_LDB(B0, 0, 0); PG8_SCHED; PG8_LDA(At, 0, 0); PG8_STAGE(PG8_SA(1, 1), a1 + hstepA, voffA);
            PG8_WAIT_L(8); PG8_BAR; PG8_WAIT_L(0); PG8_MMA(0, 0, At, B0); PG8_BAR; PG8_SCHED;
            PG8_LDB(B1, 0, 1); PG8_STAGE(PG8_SB(0, 0), b2, voffB);
            PG8_BAR; PG8_WAIT_L(0); PG8_MMA(0, 1, At, B1); PG8_BAR;
            PG8_LDA(At, 0, 1); PG8_STAGE(PG8_SA(0, 0), a2, voffA);
            PG8_BAR; PG8_WAIT_L(0); PG8_MMA(1, 0, At, B0); PG8_BAR; PG8_SCHED;
            PG8_STAGE(PG8_SB(0, 1), b2 + hstep, voffB);
            PG8_WAIT_V(6); PG8_BAR; PG8_MMA(1, 1, At, B1); PG8_BAR;
            PG8_LDB(B0, 1, 0); PG8_SCHED; PG8_LDA(At, 1, 0); PG8_STAGE(PG8_SA(0, 1), a2 + hstepA, voffA);
            PG8_WAIT_L(8); PG8_BAR; PG8_WAIT_L(0); PG8_MMA(0, 0, At, B0); PG8_BAR; PG8_SCHED;
            PG8_LDB(B1, 1, 1); PG8_STAGE(PG8_SB(1, 0), b3, voffB);
            PG8_BAR; PG8_WAIT_L(0); PG8_MMA(0, 1, At, B1); PG8_BAR;
            PG8_LDA(At, 1, 1); PG8_STAGE(PG8_SA(1, 0), a3, voffA);
            PG8_BAR; PG8_WAIT_L(0); PG8_MMA(1, 0, At, B0); PG8_BAR; PG8_SCHED;
            PG8_STAGE(PG8_SB(1, 1), b3 + hstep, voffB);
            PG8_WAIT_V(6); PG8_BAR; PG8_MMA(1, 1, At, B1); PG8_BAR;
            }
        }
        if constexpr (ALIGN_EPI) { if (wr == 0) PG8_BAR; }
        if constexpr (!Epi::AFTER_DRAIN) { int tl_ = tid; asm volatile("" : "+v"(tl_)); E(acc, cur, wr, wc, tl_ & 15, (tl_ & 63) >> 4); S.done(cur); }
        if (!has_next) break;
#pragma unroll
        for (int a = 0; a < 2; ++a)
#pragma unroll
            for (int b = 0; b < 2; ++b)
#pragma unroll
                for (int m = 0; m < 4; ++m)
#pragma unroll
                    for (int n = 0; n < 2; ++n) acc[a][b][m][n] = (f32x4){0.f, 0.f, 0.f, 0.f};
        cur = nxt; cA = nA; cB = nB; ++ui;
        if constexpr (ALIGN_EPI) { if (wr == 1) PG8_BAR; }
    }
    PG8_WAIT_V(0);
    if constexpr (!ALIGN_EPI) { if (wr == 0) PG8_BAR; }
    PG8_BAR;
    if constexpr (Epi::AFTER_DRAIN) { E.fused(acc, cur, wr, wc, fr, fq, lds, wid, lane); S.done(cur); }
#undef PG8_SA
#undef PG8_SB
#undef PG8_STAGE
#undef PG8_LDA
#undef PG8_LDB
#undef PG8_MMA
#undef PG8_WAIT_V
#undef PG8_WAIT_L
#undef PG8_BAR
#undef PG8_SCHED
}
}
namespace pg8 {
struct OrderMap {
    __device__ __forceinline__ static bool map(int i, int G, int c, int nM, int nN, int& pm, int& pn) {
        const int nwg = nM * nN; const long L = (long)i * G + c; if (L >= nwg) return false;
        int wgid = (int)L; { const int q = nwg / NXCD, r = nwg % NXCD, xcd = wgid % NXCD, off = wgid / NXCD; wgid = (xcd < r ? xcd * (q + 1) : r * (q + 1) + (xcd - r) * q) + off; }
        const int nig = WGM * nN, gid = wgid / nig, fm = gid * WGM, gsz = (nM - fm) < WGM ? (nM - fm) : WGM;
        pm = fm + ((wgid % nig) % gsz); pn = (wgid % nig) / gsz; return true;
    }
};
struct DenseOrder {
    const char* A; const char* B; int nM, nN, G, c; size_t tstepA, tstepB;
    __device__ __forceinline__ bool next(int i, Unit& u) const { int pm, pn; if (!OrderMap::map(i, G, c, nM, nN, pm, pn)) return false; u.pm = pm; u.pn = pn; u.aux = 0; u.a = A + (size_t)pm * tstepA; u.b = B + (size_t)pn * tstepB; return true; }
    __device__ __forceinline__ void a_ready(const Unit&) const {}
    __device__ __forceinline__ void done(const Unit&) const {}
};
struct MoeOrder {
    const char* A; const char* B; const PG8_LAS int* tile_e; int nM, nN, G, c; size_t tstep, estep;
    __device__ __forceinline__ bool next(int i, Unit& u) const { int pm, pn; if (!OrderMap::map(i, G, c, nM, nN, pm, pn)) return false; const int e = __builtin_amdgcn_readfirstlane(tile_e[pm]); u.pm = pm; u.pn = pn; u.aux = e;
        u.a = A + (size_t)pm * tstep; u.b = B + (size_t)e * estep + (size_t)pn * tstep; return true; }
    __device__ __forceinline__ void a_ready(const Unit&) const {}
    __device__ __forceinline__ void done(const Unit&) const {}
};
struct EpiStoreBf16 { static constexpr bool PERM = true, AFTER_DRAIN = false;
    bf16_t* O; int ldc; float ascale;
    __device__ __forceinline__ void operator()(const f32x4 (&acc)[2][2][4][2], const Unit& u, int wr, int wc, int fr, int fq) const {
        bf16_t* base = O + (size_t)(u.pm * BM + wr * 64 + fr) * ldc + u.pn * BM + wc * 32 + 8 * fq;
        float asc = ascale; asm volatile("" : "+v"(asc));
#pragma unroll
        for (int ai = 0; ai < 2; ++ai)
#pragma unroll
            for (int m = 0; m < 4; ++m) { bf16_t* rowp = base + (size_t)(ai * HALF + m * 16) * ldc;
#pragma unroll
                for (int bj = 0; bj < 2; ++bj) { const f32x4 v0 = acc[ai][bj][m][0] * asc, v1 = acc[ai][bj][m][1] * asc; u32x4 w;
                    w.x = cvt_pk_bf16(v0[0], v0[1]); w.y = cvt_pk_bf16(v0[2], v0[3]); w.z = cvt_pk_bf16(v1[0], v1[1]); w.w = cvt_pk_bf16(v1[2], v1[3]);
                    *(u32x4*)(rowp + bj * HALF) = w; } }
    }
};
struct EpiScaleBf16 { static constexpr bool PERM = true, AFTER_DRAIN = false;
    bf16_t* O; int ldc; const float* rs;
    __device__ __forceinline__ void operator()(const f32x4 (&acc)[2][2][4][2], const Unit& u, int wr, int wc, int fr, int fq) const {
        const int row0 = u.pm * BM + wr * 64 + fr; bf16_t* base = O + (size_t)row0 * ldc + u.pn * BM + wc * 32 + 8 * fq;
#pragma unroll
        for (int ai = 0; ai < 2; ++ai)
#pragma unroll
            for (int m = 0; m < 4; ++m) { bf16_t* rowp = base + (size_t)(ai * HALF + m * 16) * ldc; const float sc = rs[2 * (row0 + ai * HALF + m * 16)];
#pragma unroll
                for (int bj = 0; bj < 2; ++bj) { const f32x4 v0 = acc[ai][bj][m][0] * sc, v1 = acc[ai][bj][m][1] * sc; u32x4 w;
                    w.x = cvt_pk_bf16(v0[0], v0[1]); w.y = cvt_pk_bf16(v0[2], v0[3]); w.z = cvt_pk_bf16(v1[0], v1[1]); w.w = cvt_pk_bf16(v1[2], v1[3]);
                    *(u32x4*)(rowp + bj * HALF) = w; } }
    }
};
struct EpiResid { static constexpr bool PERM = true, AFTER_DRAIN = false;
    const float* src_lat; const float* src_ctx; float* out; const float* mod_g1; float ascale;
    __device__ __forceinline__ void operator()(const f32x4 (&acc)[2][2][4][2], const Unit& u, int wr, int wc, int fr, int fq) const {
        const int row_t = u.pm * BM; const int mrow = row_t < NLAT ? row_t / SEQ : NB;
        const float* g = mod_g1 + (size_t)mrow * 6144 + u.pn * BM + wc * 32 + 8 * fq;
        const float* sb = (row_t < NLAT ? src_lat + (size_t)row_t * 1024 : src_ctx + (size_t)(row_t - NLAT) * 1024) + u.pn * BM + wc * 32 + 8 * fq;
        float* ob = out + (size_t)row_t * 1024 + u.pn * BM + wc * 32 + 8 * fq;
        f32x4 gv[2][2];
#pragma unroll
        for (int bj = 0; bj < 2; ++bj)
#pragma unroll
            for (int n = 0; n < 2; ++n) gv[bj][n] = *(const f32x4*)(g + bj * HALF + 4 * n) * ascale;
#pragma unroll
        for (int ai = 0; ai < 2; ++ai)
#pragma unroll
            for (int m = 0; m < 4; ++m) { const size_t off = (size_t)(wr * 64 + fr + ai * HALF + m * 16) * 1024;
#pragma unroll
                for (int bj = 0; bj < 2; ++bj)
#pragma unroll
                    for (int n = 0; n < 2; ++n) { const f32x4 sv = *(const f32x4*)(sb + off + bj * HALF + 4 * n); *(f32x4*)(ob + off + bj * HALF + 4 * n) = sv + gv[bj][n] * acc[ai][bj][m][n]; }
                asm volatile("" ::: "memory"); }
    }
};
__device__ __forceinline__ float swiglu1(float g, float l, float c7, float cn) {
    const float glu = fminf(g, c7), lin = fminf(fmaxf(l, -c7), c7);
    const float sg = __builtin_amdgcn_rcpf(1.0f + __builtin_amdgcn_exp2f(cn * glu));
    return glu * sg * (lin + 1.0f);
}
struct EpiSwiglu { static constexpr bool PERM = true, AFTER_DRAIN = false;
    bf16_t* O; const float* bias; float ascale;
    __device__ __forceinline__ void operator()(const f32x4 (&acc)[2][2][4][2], const Unit& u, int wr, int wc, int fr, int fq) const {
        const int col0 = u.pn * BM + wc * 32 + 8 * fq; const float* b = bias + (size_t)u.aux * 2048 + col0;
        float c7 = 7.0f, cn = -1.702f * 1.4426950408889634f; asm volatile("" : "+v"(c7), "+v"(cn));
        bf16_t* base = O + (size_t)(u.pm * BM + wr * 64 + fr) * 1024 + (col0 >> 1);
        f32x4 bv[2][2];
#pragma unroll
        for (int bj = 0; bj < 2; ++bj)
#pragma unroll
            for (int n = 0; n < 2; ++n) bv[bj][n] = *(const f32x4*)(b + bj * HALF + 4 * n);
#pragma unroll
        for (int ai = 0; ai < 2; ++ai)
#pragma unroll
            for (int m = 0; m < 4; ++m) { bf16_t* rowp = base + (size_t)(ai * HALF + m * 16) * 1024;
#pragma unroll
                for (int bj = 0; bj < 2; ++bj) { const f32x4 v0 = acc[ai][bj][m][0] * ascale + bv[bj][0], v1 = acc[ai][bj][m][1] * ascale + bv[bj][1];
                    uint2 w; w.x = cvt_pk_bf16(swiglu1(v0[0], v0[1], c7, cn), swiglu1(v0[2], v0[3], c7, cn)); w.y = cvt_pk_bf16(swiglu1(v1[0], v1[1], c7, cn), swiglu1(v1[2], v1[3], c7, cn));
                    *(uint2*)(rowp + bj * (HALF / 2)) = w; } }
    }
};
struct EpiSwigluF8 { static constexpr bool PERM = true, AFTER_DRAIN = false;
    unsigned char* O; const float* bias;
    __device__ __forceinline__ void operator()(const f32x4 (&acc)[2][2][4][2], const Unit& u, int wr, int wc, int fr, int fq) const {
        const int col0 = u.pn * BM + wc * 32 + 8 * fq; const float* b = bias + (size_t)u.aux * 2048 + col0;
        float c7 = 7.0f, cn = -1.702f * 1.4426950408889634f, c32 = 0.03125f; asm volatile("" : "+v"(c7), "+v"(cn), "+v"(c32));
        unsigned char* base = O + (size_t)(u.pm * BM + wr * 64 + fr) * 1024 + (col0 >> 1);
        f32x4 bv[2][2];
#pragma unroll
        for (int bj = 0; bj < 2; ++bj)
#pragma unroll
            for (int n = 0; n < 2; ++n) bv[bj][n] = *(const f32x4*)(b + bj * HALF + 4 * n);
#pragma unroll
        for (int ai = 0; ai < 2; ++ai)
#pragma unroll
            for (int m = 0; m < 4; ++m) { unsigned char* rowp = base + (size_t)(ai * HALF + m * 16) * 1024;
#pragma unroll
                for (int bj = 0; bj < 2; ++bj) { const f32x4 v0 = acc[ai][bj][m][0] * c32 + bv[bj][0], v1 = acc[ai][bj][m][1] * c32 + bv[bj][1];
                    int w = __builtin_amdgcn_cvt_pk_fp8_f32(swiglu1(v0[0], v0[1], c7, cn), swiglu1(v0[2], v0[3], c7, cn), 0, false); w = __builtin_amdgcn_cvt_pk_fp8_f32(swiglu1(v1[0], v1[1], c7, cn), swiglu1(v1[2], v1[3], c7, cn), w, true);
                    *(int*)(rowp + bj * (HALF / 2)) = w; } }
    }
};
struct EpiBiasF8 { static constexpr bool PERM = true, AFTER_DRAIN = false;
    unsigned char* O; const float* bias; float ascale;
    __device__ __forceinline__ void operator()(const f32x4 (&acc)[2][2][4][2], const Unit& u, int wr, int wc, int fr, int fq) const {
        const int col0 = u.pn * BM + wc * 32 + 8 * fq; const float* b = bias + (size_t)u.aux * 1024 + col0;
        float asc = ascale; asm volatile("" : "+v"(asc));
        unsigned char* base = O + (size_t)(u.pm * BM + wr * 64 + fr) * 1024 + col0;
        f32x4 bv[2][2];
#pragma unroll
        for (int bj = 0; bj < 2; ++bj)
#pragma unroll
            for (int n = 0; n < 2; ++n) bv[bj][n] = *(const f32x4*)(b + bj * HALF + 4 * n);
#pragma unroll
        for (int ai = 0; ai < 2; ++ai)
#pragma unroll
            for (int m = 0; m < 4; ++m) { unsigned char* rowp = base + (size_t)(ai * HALF + m * 16) * 1024;
#pragma unroll
                for (int bj = 0; bj < 2; ++bj) { const f32x4 v0 = acc[ai][bj][m][0] * asc + bv[bj][0], v1 = acc[ai][bj][m][1] * asc + bv[bj][1];
                    int lo = __builtin_amdgcn_cvt_pk_fp8_f32(v0[0], v0[1], 0, false); lo = __builtin_amdgcn_cvt_pk_fp8_f32(v0[2], v0[3], lo, true);
                    int hi = __builtin_amdgcn_cvt_pk_fp8_f32(v1[0], v1[1], 0, false); hi = __builtin_amdgcn_cvt_pk_fp8_f32(v1[2], v1[3], hi, true);
                    *(int2*)(rowp + bj * HALF) = make_int2(lo, hi); } }
    }
};
struct EpiBiasBf16 { static constexpr bool PERM = true, AFTER_DRAIN = false;
    bf16_t* O; const float* bias; float ascale;
    __device__ __forceinline__ void operator()(const f32x4 (&acc)[2][2][4][2], const Unit& u, int wr, int wc, int fr, int fq) const {
        const int col0 = u.pn * BM + wc * 32 + 8 * fq; const float* b = bias + (size_t)u.aux * 1024 + col0;
        float asc = ascale; asm volatile("" : "+v"(asc));
        bf16_t* base = O + (size_t)(u.pm * BM + wr * 64 + fr) * 1024 + col0;
        f32x4 bv[2][2];
#pragma unroll
        for (int bj = 0; bj < 2; ++bj)
#pragma unroll
            for (int n = 0; n < 2; ++n) bv[bj][n] = *(const f32x4*)(b + bj * HALF + 4 * n);
#pragma unroll
        for (int ai = 0; ai < 2; ++ai)
#pragma unroll
            for (int m = 0; m < 4; ++m) { bf16_t* rowp = base + (size_t)(ai * HALF + m * 16) * 1024;
#pragma unroll
                for (int bj = 0; bj < 2; ++bj) { const f32x4 v0 = acc[ai][bj][m][0] * asc + bv[bj][0], v1 = acc[ai][bj][m][1] * asc + bv[bj][1]; u32x4 w;
                    w.x = cvt_pk_bf16(v0[0], v0[1]); w.y = cvt_pk_bf16(v0[2], v0[3]); w.z = cvt_pk_bf16(v1[0], v1[1]); w.w = cvt_pk_bf16(v1[2], v1[3]);
                    *(u32x4*)(rowp + bj * HALF) = w; } }
    }
};
}
__device__ __forceinline__ unsigned pk2(float lo, float hi) { return (unsigned)f2bf(lo) | ((unsigned)f2bf(hi) << 16); }
__device__ __forceinline__ void transpose_item(const float* __restrict__ W, int K, int N, bf16_t* __restrict__ WT, LAS float* scr, int item, int lane, const float* rowscale = nullptr, float cscale = 1.0f, int cs_ncols = 1 << 30) {
    const int nblk = N / 32, kb = item / nblk, nb = item % nblk, k0 = 64 * kb, n0 = 32 * nb;
    const float cs = n0 < cs_ncols ? cscale : 1.0f;
#pragma unroll 8
    for (int i = 0; i < 32; ++i) { const int kk = 2 * i + (lane >> 5); float w = W[(size_t)(k0 + kk) * N + n0 + (lane & 31)]; if (rowscale) w *= rowscale[k0 + kk]; scr[kk * 33 + (lane & 31)] = w * cs; }
    asm volatile("s_waitcnt lgkmcnt(0)" ::: "memory");
    const int c = lane & 7;
#pragma unroll
    for (int j = 0; j < 4; ++j) { const int n = (lane >> 3) + 8 * j; const LAS float* sp = scr + (8 * c) * 33 + n;
        uint4 o; o.x = pk2(sp[0 * 33], sp[1 * 33]); o.y = pk2(sp[2 * 33], sp[3 * 33]); o.z = pk2(sp[4 * 33], sp[5 * 33]); o.w = pk2(sp[6 * 33], sp[7 * 33]);
        *(uint4*)(WT + (size_t)(n0 + n) * K + k0 + 8 * c) = o; }
    asm volatile("s_waitcnt lgkmcnt(0)" ::: "memory");
}

__device__ __forceinline__ void transpose_item_f8(const float* __restrict__ W, int K, int N, unsigned char* __restrict__ WT, LAS float* scr, int item, int lane, float cscale = 1.0f, int cs_ncols = 1 << 30) {
    const int nblk = N / 32, kb = item / nblk, nb = item % nblk, k0 = 64 * kb, n0 = 32 * nb;
    const float cs = 32.0f * (n0 < cs_ncols ? cscale : 1.0f);
#pragma unroll 8
    for (int i = 0; i < 32; ++i) { const int kk = 2 * i + (lane >> 5); scr[kk * 33 + (lane & 31)] = W[(size_t)(k0 + kk) * N + n0 + (lane & 31)] * cs; }
    asm volatile("s_waitcnt lgkmcnt(0)" ::: "memory");
    const int c = lane & 7;
#pragma unroll
    for (int j = 0; j < 4; ++j) { const int n = (lane >> 3) + 8 * j; const LAS float* sp = scr + (8 * c) * 33 + n;
        int lo = __builtin_amdgcn_cvt_pk_fp8_f32(sp[0 * 33], sp[1 * 33], 0, false); lo = __builtin_amdgcn_cvt_pk_fp8_f32(sp[2 * 33], sp[3 * 33], lo, true);
        int hi = __builtin_amdgcn_cvt_pk_fp8_f32(sp[4 * 33], sp[5 * 33], 0, false); hi = __builtin_amdgcn_cvt_pk_fp8_f32(sp[6 * 33], sp[7 * 33], hi, true);
        *(int2*)(WT + (size_t)(n0 + n) * K + k0 + 8 * c) = make_int2(lo, hi); }
    asm volatile("s_waitcnt lgkmcnt(0)" ::: "memory");
}
template <bool F8OUT>
__device__ __forceinline__ void transpose_item64(const float* __restrict__ W, int K, int N, void* __restrict__ WT, LAS float* scr, int item, int lane, const float* rowscale = nullptr, float cscale = 1.0f) {
    const int nblk = N / 64, kb = item / nblk, nb = item % nblk, k0 = 64 * kb, n0 = 64 * nb;
    const float cs = cscale * (F8OUT ? 32.0f : 1.0f);
    float4 wv[16];
#pragma unroll
    for (int i = 0; i < 16; ++i) wv[i] = *(const float4*)(W + (size_t)(k0 + 4 * i + (lane >> 4)) * N + n0 + 4 * (lane & 15));
#pragma unroll
    for (int i = 0; i < 16; ++i) { const int kk = 4 * i + (lane >> 4); const float4 w = wv[i];
        const float rs = rowscale ? rowscale[k0 + kk] * cs : cs; LAS float* d = scr + kk * 65 + 4 * (lane & 15); d[0] = w.x * rs; d[1] = w.y * rs; d[2] = w.z * rs; d[3] = w.w * rs; }
    asm volatile("s_waitcnt lgkmcnt(0)" ::: "memory");
    const int c = lane & 7;
#pragma unroll
    for (int j = 0; j < 8; ++j) { const int n = (lane >> 3) + 8 * j; const LAS float* sp = scr + (8 * c) * 65 + n;
        if constexpr (F8OUT) { int lo = __builtin_amdgcn_cvt_pk_fp8_f32(sp[0 * 65], sp[1 * 65], 0, false); lo = __builtin_amdgcn_cvt_pk_fp8_f32(sp[2 * 65], sp[3 * 65], lo, true);
            int hi = __builtin_amdgcn_cvt_pk_fp8_f32(sp[4 * 65], sp[5 * 65], 0, false); hi = __builtin_amdgcn_cvt_pk_fp8_f32(sp[6 * 65], sp[7 * 65], hi, true);
            *(int2*)((unsigned char*)WT + (size_t)(n0 + n) * K + k0 + 8 * c) = make_int2(lo, hi); }
        else { uint4 o; o.x = pk2(sp[0 * 65], sp[1 * 65]); o.y = pk2(sp[2 * 65], sp[3 * 65]); o.z = pk2(sp[4 * 65], sp[5 * 65]); o.w = pk2(sp[6 * 65], sp[7 * 65]);
            *(uint4*)((bf16_t*)WT + (size_t)(n0 + n) * K + k0 + 8 * c) = o; } }
    asm volatile("s_waitcnt lgkmcnt(0)" ::: "memory");
}
namespace fa {
using bf16x8 = __attribute__((ext_vector_type(8))) short;
using s16x4  = __attribute__((ext_vector_type(4))) short;
using f32x16 = __attribute__((ext_vector_type(16))) float;
using u32x4  = __attribute__((ext_vector_type(4))) unsigned;
constexpr int QBLK = 32, KVBLK = 64, NW = 8;
constexpr int SHM_V = KVBLK * 128 * 2, SHM_K = KVBLK * 128 * 2, SHM_ATTN = 2 * SHM_V + 2 * SHM_K + NW * 64 * 4;
constexpr float LOG2E = 1.4426950408889634f, THR = 8.0f, NEGS = -1.0e30f;
#define FA_KSWZ(row, colB) ((row) * 256 + ((colB) ^ (((row) & 7) << 4)))
#define FA_SBAR() __builtin_amdgcn_sched_barrier(0)
__device__ __forceinline__ int crow(int r, int hi) { return (r & 3) + 8 * (r >> 2) + 4 * hi; }
__device__ __forceinline__ unsigned cvtpk(float lo, float hi) { unsigned r; asm volatile("v_cvt_pk_bf16_f32 %0, %1, %2" : "=v"(r) : "v"(lo), "v"(hi)); return r; }
__device__ __forceinline__ void partialSM(f32x16& p0, f32x16& p1, float& m_reg, float& mn, float& alpha) {
  float pmax = p0[0];
#pragma unroll
  for (int r = 1; r < 16; ++r) pmax = fmaxf(pmax, p0[r]);
#pragma unroll
  for (int r = 0; r < 16; ++r) pmax = fmaxf(pmax, p1[r]);
  { auto rr = __builtin_amdgcn_permlane32_swap(__float_as_uint(pmax), __float_as_uint(pmax), false, false);
    pmax = fmaxf(__uint_as_float(rr[0]), __uint_as_float(rr[1])); }
  if (__builtin_expect(__all(pmax - m_reg <= THR), 1)) { mn = m_reg; alpha = 1.f; }
  else { mn = fmaxf(m_reg, pmax); alpha = __builtin_amdgcn_exp2f((m_reg - mn) * LOG2E); m_reg = mn; }
  const float mnC = -mn * LOG2E;
#pragma unroll
  for (int r = 0; r < 16; ++r) p0[r] = fmaf(p0[r], LOG2E, mnC);
#pragma unroll
  for (int r = 0; r < 16; ++r) p1[r] = fmaf(p1[r], LOG2E, mnC);
#pragma unroll
  for (int r = 0; r < 16; ++r) p0[r] = __builtin_amdgcn_exp2f(p0[r]);
}
__device__ __forceinline__ void finishSM(f32x16& p0, f32x16& p1, float alpha, float& l_reg, bf16x8& pa0, bf16x8& pa1, bf16x8& pa2, bf16x8& pa3) {
#pragma unroll
  for (int r = 0; r < 16; ++r) p1[r] = __builtin_amdgcn_exp2f(p1[r]);
  float ps = 0;
#pragma unroll
  for (int r = 0; r < 16; ++r) ps += p0[r];
#pragma unroll
  for (int r = 0; r < 16; ++r) ps += p1[r];
  { auto rr = __builtin_amdgcn_permlane32_swap(__float_as_uint(ps), __float_as_uint(ps), false, false);
    ps = __uint_as_float(rr[0]) + __uint_as_float(rr[1]); }
  l_reg = l_reg * alpha + ps;
#define FA_PK4(P, BASE, OUT) do { unsigned a0 = cvtpk(P[BASE + 0], P[BASE + 1]), a1 = cvtpk(P[BASE + 2], P[BASE + 3]);   \
    unsigned b0 = cvtpk(P[BASE + 4], P[BASE + 5]), b1 = cvtpk(P[BASE + 6], P[BASE + 7]);                              \
    auto r0 = __builtin_amdgcn_permlane32_swap(a0, b0, false, false); auto r1 = __builtin_amdgcn_permlane32_swap(a1, b1, false, false); \
    u32x4 w = {r0[0], r1[0], r0[1], r1[1]}; OUT = *reinterpret_cast<bf16x8*>(&w); } while (0)
  FA_PK4(p0, 0, pa0); FA_PK4(p0, 8, pa1); FA_PK4(p1, 0, pa2); FA_PK4(p1, 8, pa3);
#undef FA_PK4
}
template <int NQ> __device__ __forceinline__ void qkt(f32x16& p0, f32x16& p1, const char* Ks, const bf16x8* qr, int r32, int hi) {
  p0 = f32x16{}; p1 = f32x16{};
#pragma unroll
  for (int d0 = 0; d0 < NQ; ++d0) { const int cb = (d0 * 16 + hi * 8) * 2;
    const bf16x8 b0 = *reinterpret_cast<const bf16x8*>(Ks + FA_KSWZ(r32, cb));
    const bf16x8 b1 = *reinterpret_cast<const bf16x8*>(Ks + FA_KSWZ(32 + r32, cb));
    p0 = __builtin_amdgcn_mfma_f32_32x32x16_bf16(b0, qr[d0], p0, 0, 0, 0);
    p1 = __builtin_amdgcn_mfma_f32_32x32x16_bf16(b1, qr[d0], p1, 0, 0, 0); }
}
__device__ __forceinline__ int v_st(int k, int c) { const int kk = (k & ~0xC) | ((k & 4) << 1) | ((k & 8) >> 1); return ((kk >> 3) * 4 + (c >> 5)) * 512 + ((kk & 7) * 32 + (c & 31)) * 2; }
__device__ __forceinline__ int v_rd_base(int lane) { return ((lane & 3) << 3) | (((lane >> 2) & 3) << 6) | (((lane >> 4) & 1) << 5) | (((lane >> 5) & 1) << 8); }
constexpr int v_rd_off(int d0, int ks, int half) { return d0 * 512 + ks * 4096 + half * 2048; }
template <int OFF> __device__ __forceinline__ s16x4 tr_read(int vb) {
  s16x4 r; asm volatile("ds_read_b64_tr_b16 %0, %1 offset:%2" : "=&v"(r) : "v"(vb), "i"(OFF) : "memory"); return r;
}
template <int D0> __device__ __forceinline__ void pv_one(f32x16& od, int vb, bf16x8 pa0, bf16x8 pa1, bf16x8 pa2, bf16x8 pa3) {
  const s16x4 l0 = tr_read<v_rd_off(D0, 0, 0)>(vb), h0 = tr_read<v_rd_off(D0, 0, 1)>(vb), l1 = tr_read<v_rd_off(D0, 1, 0)>(vb), h1 = tr_read<v_rd_off(D0, 1, 1)>(vb);
  const s16x4 l2 = tr_read<v_rd_off(D0, 2, 0)>(vb), h2 = tr_read<v_rd_off(D0, 2, 1)>(vb), l3 = tr_read<v_rd_off(D0, 3, 0)>(vb), h3 = tr_read<v_rd_off(D0, 3, 1)>(vb);
  asm volatile("s_waitcnt lgkmcnt(0)" ::: "memory"); FA_SBAR();
#define FA_PK(L, H) (bf16x8){L[0], L[1], L[2], L[3], H[0], H[1], H[2], H[3]}
  od = __builtin_amdgcn_mfma_f32_32x32x16_bf16(pa0, FA_PK(l0, h0), od, 0, 0, 0);
  od = __builtin_amdgcn_mfma_f32_32x32x16_bf16(pa1, FA_PK(l1, h1), od, 0, 0, 0);
  od = __builtin_amdgcn_mfma_f32_32x32x16_bf16(pa2, FA_PK(l2, h2), od, 0, 0, 0);
  od = __builtin_amdgcn_mfma_f32_32x32x16_bf16(pa3, FA_PK(l3, h3), od, 0, 0, 0);
#undef FA_PK
}
template <int NV> __device__ __forceinline__ void pv_all(f32x16* o, int vb, bf16x8 pa0, bf16x8 pa1, bf16x8 pa2, bf16x8 pa3) {
  pv_one<0>(o[0], vb, pa0, pa1, pa2, pa3); pv_one<1>(o[1], vb, pa0, pa1, pa2, pa3);
  if constexpr (NV == 4) { pv_one<2>(o[2], vb, pa0, pa1, pa2, pa3); pv_one<3>(o[3], vb, pa0, pa1, pa2, pa3); }
}
__device__ __forceinline__ void wmask(f32x16& p0, f32x16& p1, int dq4) {
#pragma unroll
  for (int r = 0; r < 16; ++r) { const int d = dq4 + (r & 3) + 8 * (r >> 2); if ((unsigned)(d + 128) > 256u) p0[r] = NEGS; if ((unsigned)(d + 32 + 128) > 256u) p1[r] = NEGS; }
}

struct Unit {
  const bf16_t* Q; const bf16_t* K; const bf16_t* V; bf16_t* O;
  int rowa, nta, rowb, ntb;
  int window, qpos0, kposb0;
  float sink; int has_sink;
  const bf16_t* K2;
  const float* tab; int pos0;
  const float* qg;
};
template <int DQ, int DV, int LDQ, int LDK, int LDV, int LDO, bool WIN, int RD0, int RH, bool QNORM, bool KSPLIT, bool O8>
__device__ __forceinline__ void attn_unit(const int tid, const Unit& U, char* lds) {
  constexpr int NQ = DQ / 16, NV = DV / 32;
  const int wid = tid >> 6, lane = tid & 63, r32 = lane & 31, hi = lane >> 5;
  char* V_lds = lds; char* K_lds = lds + 2 * SHM_V;
  float* ws = (float*)(lds + 2 * SHM_V + 2 * SHM_K) + wid * 64; float* li_l = ws; float* al_l = ws + 32;
  float m_reg = -1e30f, l_reg = 0; f32x16 o[NV]; bf16x8 qr[NQ];
#pragma unroll
  for (int d = 0; d < NV; ++d) o[d] = f32x16{};
  const bf16_t* Qw = U.Q + (size_t)(wid * QBLK + r32) * LDQ + hi * 8;
#pragma unroll
  for (int d0 = 0; d0 < NQ; ++d0) qr[d0] = *reinterpret_cast<const bf16x8*>(Qw + d0 * 16);
  if constexpr (QNORM || RH > 0) {
    float qf[NQ][8];
#pragma unroll
    for (int d0 = 0; d0 < NQ; ++d0)
#pragma unroll
      for (int j = 0; j < 8; ++j) qf[d0][j] = __uint_as_float(((unsigned)(unsigned short)qr[d0][j]) << 16);
    if constexpr (QNORM) {
      float ss = 0.f;
#pragma unroll
      for (int d0 = 0; d0 < NQ; ++d0)
#pragma unroll
        for (int j = 0; j < 8; ++j) ss = fmaf(qf[d0][j], qf[d0][j], ss);
      { auto rr = __builtin_amdgcn_permlane32_swap(__float_as_uint(ss), __float_as_uint(ss), false, false); ss = __uint_as_float(rr[0]) + __uint_as_float(rr[1]); }
      const float ri = 1.0f / sqrtf(ss * (1.0f / DQ) + 1e-6f);
#pragma unroll
      for (int d0 = 0; d0 < NQ; ++d0) { const float4 g0 = *(const float4*)(U.qg + 16 * d0 + 8 * hi), g1 = *(const float4*)(U.qg + 16 * d0 + 8 * hi + 4);
        qf[d0][0] *= ri * g0.x; qf[d0][1] *= ri * g0.y; qf[d0][2] *= ri * g0.z; qf[d0][3] *= ri * g0.w; qf[d0][4] *= ri * g1.x; qf[d0][5] *= ri * g1.y; qf[d0][6] *= ri * g1.z; qf[d0][7] *= ri * g1.w; }
    }
    if constexpr (RH > 0) { if (U.tab) {
      const float4* tb = (const float4*)(U.tab + ((size_t)(U.pos0 + wid * QBLK + r32) * (RH * 16) + 8 * hi) * 2);
#pragma unroll
      for (int dd = 0; dd < RH; ++dd) {
#pragma unroll
        for (int j2 = 0; j2 < 4; ++j2) { const float4 t = tb[dd * 8 + j2];
          { const float x1 = qf[RD0 + dd][2 * j2], x2 = qf[RD0 + RH + dd][2 * j2]; qf[RD0 + dd][2 * j2] = x1 * t.x - x2 * t.y; qf[RD0 + RH + dd][2 * j2] = x2 * t.x + x1 * t.y; }
          { const float x1 = qf[RD0 + dd][2 * j2 + 1], x2 = qf[RD0 + RH + dd][2 * j2 + 1]; qf[RD0 + dd][2 * j2 + 1] = x1 * t.z - x2 * t.w; qf[RD0 + RH + dd][2 * j2 + 1] = x2 * t.z + x1 * t.w; } } } } }
#pragma unroll
    for (int d0 = 0; d0 < NQ; ++d0) { u32x4 w = {cvtpk(qf[d0][0], qf[d0][1]), cvtpk(qf[d0][2], qf[d0][3]), cvtpk(qf[d0][4], qf[d0][5]), cvtpk(qf[d0][6], qf[d0][7])}; qr[d0] = *reinterpret_cast<bf16x8*>(&w); }
  }
  const int sr = tid >> 4, sc = (tid & 15) * 8, vst0 = v_st(sr, sc), vst1 = v_st(32 + sr, sc);
  const int sck = sc < DQ - 8 ? sc : DQ - 8, scv = sc < DV - 8 ? sc : DV - 8;
  const int vb0 = (int)(uintptr_t)V_lds + v_rd_base(lane);
  const int nta = U.nta, NT = U.nta + U.ntb;
  const unsigned kof0 = (unsigned)((sr * LDK + sck) * 2), kof1 = kof0 + 32u * LDK * 2u, vof0 = (unsigned)((sr * LDV + scv) * 2), vof1 = vof0 + 32u * LDV * 2u;
  constexpr int LDK2 = 1536;
  const int ci = tid & 15; const bool ksec = KSPLIT && ci >= 8; const int kld = ksec ? LDK2 : LDK;
  const bf16_t* kp0 = ksec ? U.K2 + (size_t)sr * LDK2 + ((ci < 11 ? ci : 11) - 8) * 8 : U.K + (size_t)sr * LDK + ci * 8; const bf16_t* kp1 = kp0 + (size_t)32 * kld;
  (void)kof0; (void)kof1; (void)kp0; (void)kp1; (void)kld;
  struct { bf16x8 vs0, vs1, ks0, ks1; } sr_[2];
#define FA_KROW(j) ((j) < nta ? U.rowa + (j) * KVBLK : U.rowb + ((j) - nta) * KVBLK)
#define FA_SLOAD(i, j) do { const size_t k0_ = (size_t)(FA_KROW(j)); const char* kt_ = (const char*)U.K + k0_ * (LDK * 2); const char* vt_ = (const char*)U.V + k0_ * (LDV * 2); \
    sr_[i].vs0 = *reinterpret_cast<const bf16x8*>(vt_ + vof0); sr_[i].vs1 = *reinterpret_cast<const bf16x8*>(vt_ + vof1); \
    if constexpr (KSPLIT) { sr_[i].ks0 = *reinterpret_cast<const bf16x8*>(kp0 + k0_ * kld); sr_[i].ks1 = *reinterpret_cast<const bf16x8*>(kp1 + k0_ * kld); } \
    else { sr_[i].ks0 = *reinterpret_cast<const bf16x8*>(kt_ + kof0); sr_[i].ks1 = *reinterpret_cast<const bf16x8*>(kt_ + kof1); } } while (0)
#define FA_SWRITE(b, i) do { *(bf16x8*)(V_lds + (b) * SHM_V + vst0) = sr_[i].vs0; *(bf16x8*)(V_lds + (b) * SHM_V + vst1) = sr_[i].vs1; const int kc = sc * 2; \
    *(bf16x8*)(K_lds + (b) * SHM_K + FA_KSWZ(sr, kc)) = sr_[i].ks0; *(bf16x8*)(K_lds + (b) * SHM_K + FA_KSWZ(32 + sr, kc)) = sr_[i].ks1; } while (0)
#define FA_SWAIT() asm volatile("s_waitcnt vmcnt(4)" ::: "memory")
#define FA_RESC(a) do { if (__any((a) < 1.f)) { if (hi == 0) al_l[r32] = (a); asm volatile("s_waitcnt lgkmcnt(0)" ::: "memory"); \
    _Pragma("unroll") for (int d = 0; d < NV; ++d) _Pragma("unroll") for (int r = 0; r < 16; ++r) o[d][r] *= al_l[crow(r, hi)]; } } while (0)
  const int qw0 = U.qpos0 + wid * QBLK;
#define FA_MASK(P0, P1, t) do { if (WIN && U.window && (t) >= nta) { const int kb_ = U.kposb0 + ((t) - nta) * KVBLK; \
    if (kb_ + 63 - qw0 > 128 || qw0 + 31 - kb_ > 128) wmask(P0, P1, kb_ - (qw0 + r32) + 4 * hi); } } while (0)
  f32x16 pA0, pA1, pB0, pB1; float mnA, mnB, alA, alB; bf16x8 pa0, pa1, pa2, pa3;
  constexpr int SE = 0, SO = 1;
  FA_SLOAD(SE, 0); asm volatile("s_waitcnt vmcnt(0)" ::: "memory"); FA_SWRITE(0, SE); __syncthreads();
  qkt<NQ>(pA0, pA1, K_lds, qr, r32, hi); FA_MASK(pA0, pA1, 0); partialSM(pA0, pA1, m_reg, mnA, alA);
  FA_SLOAD(SO, 1); if (2 < NT) FA_SLOAD(SE, 2);
  FA_SWAIT(); FA_SWRITE(1, SO); __syncthreads();
  for (int j = 1; j + 1 < NT; j += 2) {
    FA_SBAR(); qkt<NQ>(pB0, pB1, K_lds + SHM_K, qr, r32, hi);
    finishSM(pA0, pA1, alA, l_reg, pa0, pa1, pa2, pa3); FA_SBAR();
    FA_SLOAD(SO, j + 2); FA_SBAR();
    pv_all<NV>(o, vb0, pa0, pa1, pa2, pa3); FA_MASK(pB0, pB1, j); partialSM(pB0, pB1, m_reg, mnB, alB);
    __syncthreads(); FA_SWAIT(); FA_SWRITE(0, SE);
    FA_RESC(alB); __syncthreads();
    FA_SBAR(); qkt<NQ>(pA0, pA1, K_lds, qr, r32, hi);
    finishSM(pB0, pB1, alB, l_reg, pa0, pa1, pa2, pa3); FA_SBAR();
    if (j + 3 < NT) FA_SLOAD(SE, j + 3); FA_SBAR();
    pv_all<NV>(o, vb0 + SHM_V, pa0, pa1, pa2, pa3); FA_MASK(pA0, pA1, j + 1); partialSM(pA0, pA1, m_reg, mnA, alA);
    __syncthreads(); FA_SWAIT(); FA_SWRITE(1, SO);
    FA_RESC(alA); __syncthreads();
  }
  FA_SBAR(); qkt<NQ>(pB0, pB1, K_lds + SHM_K, qr, r32, hi);
  finishSM(pA0, pA1, alA, l_reg, pa0, pa1, pa2, pa3); FA_SBAR();
  pv_all<NV>(o, vb0, pa0, pa1, pa2, pa3); FA_MASK(pB0, pB1, NT - 1); partialSM(pB0, pB1, m_reg, mnB, alB);
  __syncthreads(); FA_RESC(alB);
  finishSM(pB0, pB1, alB, l_reg, pa0, pa1, pa2, pa3); FA_SBAR();
  pv_all<NV>(o, vb0 + SHM_V, pa0, pa1, pa2, pa3);
  if (U.has_sink) l_reg += __builtin_amdgcn_exp2f((U.sink - m_reg) * LOG2E);
  if (hi == 0) li_l[r32] = l_reg;
  asm volatile("s_waitcnt lgkmcnt(0)" ::: "memory");
  __syncthreads();
  int lane2 = lane; asm volatile("" : "+v"(lane2));
  const int r32e = lane2 & 31, hie = lane2 >> 5;
  if constexpr (O8) {
    unsigned char* stg = (unsigned char*)(lds + wid * 8192);
    unsigned char* stw = stg + hie * 4 * DV + r32e;
#pragma unroll
    for (int r = 0; r < 16; ++r) { const int orow0 = (r & 3) + 8 * (r >> 2); const float rl = __builtin_amdgcn_rcpf(li_l[orow0 + 4 * hie]);
#pragma unroll
      for (int d0 = 0; d0 < NV; ++d0) stw[orow0 * DV + d0 * 32] = (unsigned char)(__builtin_amdgcn_cvt_pk_fp8_f32(o[d0][r] * rl, 0.f, 0, false) & 0xff); }
    asm volatile("s_waitcnt lgkmcnt(0)" ::: "memory");
    constexpr int CPR = DV / 16, RPI = 64 / CPR;
    const int erow = lane2 / CPR, ech = lane2 % CPR;
    unsigned char* Ow = (unsigned char*)U.O + (size_t)(wid * QBLK + erow) * LDO + ech * 16; const unsigned char* str = stg + erow * DV + ech * 16;
#pragma unroll
    for (int i = 0; i < 32 / RPI; ++i) { const u32x4 v = *(const u32x4*)(str + i * RPI * DV); *(u32x4*)(Ow + (size_t)(i * RPI) * LDO) = v; }
  } else {
  bf16_t* stg = (bf16_t*)(lds + wid * 8192);
  bf16_t* stw = stg + hie * 4 * DV + r32e;
#pragma unroll
  for (int r = 0; r < 16; ++r) { const int orow0 = (r & 3) + 8 * (r >> 2); const float rl = __builtin_amdgcn_rcpf(li_l[orow0 + 4 * hie]);
#pragma unroll
    for (int d0 = 0; d0 < NV; ++d0) stw[orow0 * DV + d0 * 32] = f2bf(o[d0][r] * rl); }
  asm volatile("s_waitcnt lgkmcnt(0)" ::: "memory");
  constexpr int CPR = DV / 8, RPI = 64 / CPR;
  const int erow = lane2 / CPR, ech = lane2 % CPR;
  bf16_t* Ow = U.O + (size_t)(wid * QBLK + erow) * LDO + ech * 8; const bf16_t* str = stg + erow * DV + ech * 8;
#pragma unroll
  for (int i = 0; i < 32 / RPI; ++i) { const u32x4 v = *(const u32x4*)(str + i * RPI * DV); *(u32x4*)(Ow + (size_t)(i * RPI) * LDO) = v; }
  }
  __syncthreads();
#undef FA_KROW
#undef FA_SLOAD
#undef FA_SWRITE
#undef FA_SWAIT
#undef FA_RESC
#undef FA_MASK
}
}

__device__ __forceinline__ void route_reduce(const float (&acc)[32], const int lane, const int el, const float rb, float (&tv)[4], int (&ti)[4]) {
    float a16[16], a8[8], a4[4], a2[2];
#pragma unroll
    for (int k = 0; k < 16; ++k) { const bool up = (lane & 32) != 0; const float keep = up ? acc[k + 16] : acc[k], send = up ? acc[k] : acc[k + 16]; a16[k] = keep + __shfl_xor(send, 32); }
#pragma unroll
    for (int k = 0; k < 8; ++k) { const bool up = (lane & 16) != 0; const float keep = up ? a16[k + 8] : a16[k], send = up ? a16[k] : a16[k + 8]; a8[k] = keep + __shfl_xor(send, 16); }
#pragma unroll
    for (int k = 0; k < 4; ++k) { const bool up = (lane & 8) != 0; const float keep = up ? a8[k + 4] : a8[k], send = up ? a8[k] : a8[k + 4]; a4[k] = keep + __shfl_xor(send, 8); }
#pragma unroll
    for (int k = 0; k < 2; ++k) { const bool up = (lane & 4) != 0; const float keep = up ? a4[k + 2] : a4[k], send = up ? a4[k] : a4[k + 2]; a2[k] = keep + __shfl_xor(send, 4); }
    float lg; { const bool up = (lane & 2) != 0; const float keep = up ? a2[1] : a2[0], send = up ? a2[0] : a2[1]; lg = keep + __shfl_xor(send, 2); }
    lg += __shfl_xor(lg, 1); lg += rb;
    unsigned key; { const unsigned u = __float_as_uint(lg); const unsigned ou = (u & 0x80000000u) ? ~u : (u | 0x80000000u); key = (ou & ~31u) | (unsigned)(31 - el); }
#pragma unroll
    for (int k = 0; k < 4; ++k) { unsigned bk = key;
#pragma unroll
        for (int o = 1; o < 64; o <<= 1) { const unsigned ok = (unsigned)__shfl_xor((int)bk, o); bk = ok > bk ? ok : bk; }
        const int bi = 31 - (int)(bk & 31u); const unsigned ou = bk & ~31u; const unsigned ub = (ou & 0x80000000u) ? (ou ^ 0x80000000u) : ~ou;
        tv[k] = __uint_as_float(ub); ti[k] = bi; if (el == bi) key = 0u; }
}

__device__ __forceinline__ void route_reduce32(const float (&acc)[32], const int l5, const float rb, float (&tv)[4], int (&ti)[4]) {
    float a16[16], a8[8], a4[4], a2[2];
#pragma unroll
    for (int k = 0; k < 16; ++k) { const bool up = (l5 & 16) != 0; const float keep = up ? acc[k + 16] : acc[k], send = up ? acc[k] : acc[k + 16]; a16[k] = keep + __shfl_xor(send, 16); }
#pragma unroll
    for (int k = 0; k < 8; ++k) { const bool up = (l5 & 8) != 0; const float keep = up ? a16[k + 8] : a16[k], send = up ? a16[k] : a16[k + 8]; a8[k] = keep + __shfl_xor(send, 8); }
#pragma unroll
    for (int k = 0; k < 4; ++k) { const bool up = (l5 & 4) != 0; const float keep = up ? a8[k + 4] : a8[k], send = up ? a8[k] : a8[k + 4]; a4[k] = keep + __shfl_xor(send, 4); }
#pragma unroll
    for (int k = 0; k < 2; ++k) { const bool up = (l5 & 2) != 0; const float keep = up ? a4[k + 2] : a4[k], send = up ? a4[k] : a4[k + 2]; a2[k] = keep + __shfl_xor(send, 2); }
    float lg; { const bool up = (l5 & 1) != 0; const float keep = up ? a2[1] : a2[0], send = up ? a2[0] : a2[1]; lg = keep + __shfl_xor(send, 1); }
    lg += rb;
    unsigned key; { const unsigned u = __float_as_uint(lg); const unsigned ou = (u & 0x80000000u) ? ~u : (u | 0x80000000u); key = (ou & ~31u) | (unsigned)(31 - l5); }
#pragma unroll
    for (int k = 0; k < 4; ++k) { unsigned bk = key;
#pragma unroll
        for (int o = 1; o < 32; o <<= 1) { const unsigned ok = (unsigned)__shfl_xor((int)bk, o); bk = ok > bk ? ok : bk; }
        const int bi = 31 - (int)(bk & 31u); const unsigned ou = bk & ~31u; const unsigned ub = (ou & 0x80000000u) ? (ou ^ 0x80000000u) : ~ou;
        tv[k] = __uint_as_float(ub); ti[k] = bi; if (l5 == bi) key = 0u; }
}

struct Params {
    const float *x, *c, *ctx, *c_ctx, *ada_w, *ada_b, *norm_mix_g, *norm_ffn_g, *ab_w_in, *mla_q_g, *mla_wq_b, *mla_kv_g, *mla_wkv_b, *swa_sink, *ab_w_out,
        *c_w_in, *c_q_g, *c_k_g, *c_w_out, *router_w, *router_b, *moe_w_in, *moe_b_in, *moe_w_out, *moe_b_out, *final_g;
    float* out; unsigned char* ws; int ph_lo, ph_hi;
};
__device__ __forceinline__ int mod_row_of(int r) { return r < NLAT ? r / SEQ : NB; }
__device__ __forceinline__ float rope_angle(int i, int quarter, int prow, int pcol) {
    const int ii = i < quarter ? i : i - quarter; const float inv = powf(10000.f, -(float)ii / (float)quarter);
    return (float)(i < quarter ? prow : pcol) * inv;
}

#ifndef OUTPROJ_F8
#define OUTPROJ_F8 1
#endif
#ifndef Y8_L1
#define Y8_L1 1
#endif
#ifndef INPROJ_F8
#define INPROJ_F8 1
#endif
#ifndef MOE_F8_DOWN
#define MOE_F8_DOWN 1
#endif
#ifndef MOE_F8_L0
#define MOE_F8_L0 1
#endif
#ifndef MOE_F8_L1
#define MOE_F8_L1 1
#endif
constexpr int LDS_BYTES = 147456;
constexpr int LDS_MISC = 143360;
constexpr int N_PHASES = 21;

__global__ void __launch_bounds__(NTHR, 2) fwd_kernel(Params p) {
    extern __shared__ __attribute__((aligned(16))) unsigned char lds_raw[];
    float* ldsf = (float*)lds_raw;
    LAS unsigned* misc = (LAS unsigned*)(lds_raw + LDS_MISC + 320);
    const int wave0 = __builtin_amdgcn_readfirstlane((int)(threadIdx.x >> 6));
    const int G = gridDim.x, bid = blockIdx.x;
    const int NGW = G * 8;
    unsigned* ctl0 = (unsigned*)(p.ws + WS_CTL);
#define PHASE_PTRS \
    int tid = wave0 * 64 + (int)__builtin_amdgcn_mbcnt_hi(~0u, __builtin_amdgcn_mbcnt_lo(~0u, 0u)); asm volatile("" : "+v"(tid)); const int lane = tid & 63, wave = tid >> 6, gw = bid * 8 + wave; (void)lane; (void)gw; \
    size_t wsz_ = 0; asm volatile("" : "+s"(wsz_)); unsigned char* ws = p.ws + wsz_; \
    unsigned* ctl = (unsigned*)(ws + WS_CTL); (void)ctl; \
    float* MOD = (float*)(ws + WS_MOD); (void)MOD; \
    int* TOKE = (int*)(ws + WS_TOKE); int* TOKP = (int*)(ws + WS_TOKP); float* TOKG = (float*)(ws + WS_TOKG); (void)TOKE; (void)TOKP; (void)TOKG; \
    float* RINV = (float*)(ws + WS_RINV); (void)RINV; unsigned char* tabs = ws + WS_TAB; (void)tabs; \
    float* XR = (float*)(ws + WS_XR); (void)XR; \
    act_t* H = (act_t*)(ws + WS_H); (void)H; \
    unsigned char* big = ws + WS_BIG; \
    act_t* PRJ = (act_t*)(big + OFF_PRJ); act_t* QB = (act_t*)(big + OFF_QB); act_t* KVB = (act_t*)(big + OFF_KVB); act_t* OB = (act_t*)(big + OFF_O); (void)PRJ; (void)QB; (void)KVB; (void)OB; \
    act_t* Y = (act_t*)big; act_t* ACT = (act_t*)(ws + WS_ACT); act_t* XS = (act_t*)(ws + WS_XS); unsigned char* wts = ws + WS_W; (void)Y; (void)ACT; (void)XS; (void)wts;

    if (threadIdx.x < 32) misc[threadIdx.x] = 0u;
    __syncthreads();
    XcdBarrier bar = xcd_barrier_post(ctl0 + CW_BAR, (volatile LAS unsigned*)(misc + 8), wave0);
    const int lo = p.ph_lo, hi = p.ph_hi;
#ifndef PHASE_MASK
#define PHASE_MASK 0x1FFFFFu
#endif
#define IN(k) ((((PHASE_MASK) >> (k)) & 1u) && lo <= (k) && (k) < hi)
#define SEAM(k) do { if (IN(k) && IN((k) + 1)) xcd_barrier(bar, wave0); } while (0)
#define LDSB ((LAS unsigned char*)lds_raw)

    if (IN(0)) { PHASE_PTRS
        {   LAS float* scr = (LAS float*)(LDSB + wave * 16640);
            constexpr int I_AB = 16 * 45  , I_QB = 6 * 12, I_KVB = 4 * 16, I_ABO = 16 * 16, I_C = 16 * 24, I_CO = 16 * 16, I_W1 = 16 * 32, I_W2 = 16 * 16;
            constexpr int T_W1 = 64 * I_W1, T_W2 = 64 * I_W2, T_ALL = T_W1 + T_W2 + I_AB + I_QB + I_KVB + I_ABO + I_C + I_CO;
            for (int it = gw; it < T_ALL; it += NGW) {
                int r = it;
                if (r < T_W1) { const int mi = r / I_W1; const float* src = p.moe_w_in + (size_t)mi * 1024 * 2048;
                    if ((mi >= 32 && MOE_F8_L1) || (mi < 32 && MOE_F8_L0)) transpose_item64<true>(src, 1024, 2048, (unsigned char*)(wts + WO_W1) + (size_t)(mi >> 5) * 32 * 2048 * 1024 * 2 + (size_t)(mi & 31) * 2048 * 1024, scr, r % I_W1, lane);
                    else transpose_item64<false>(src, 1024, 2048, (bf16_t*)(wts + WO_W1) + (size_t)mi * 2048 * 1024, scr, r % I_W1, lane);
                    continue; } r -= T_W1;
                if (r < T_W2) { const int mi = r / I_W2; const float* src = p.moe_w_out + (size_t)mi * 1024 * 1024;
                    if (MOE_F8_DOWN && ((mi >= 32 && MOE_F8_L1) || (mi < 32 && MOE_F8_L0))) transpose_item64<true>(src, 1024, 1024, (unsigned char*)(wts + WO_W2) + (size_t)(mi >> 5) * 32 * 1024 * 1024 * 2 + (size_t)(mi & 31) * 1024 * 1024, scr, r % I_W2, lane);
                    else transpose_item64<false>(src, 1024, 1024, (bf16_t*)(wts + WO_W2) + (size_t)mi * 1024 * 1024, scr, r % I_W2, lane);
                    continue; } r -= T_W2;
                if (r < I_AB) { if (INPROJ_F8) transpose_item_f8(p.ab_w_in, 1024, AB_IN, (unsigned char*)(wts + WO_AB), scr, r, lane, 0.125f, 512);
                    else transpose_item(p.ab_w_in, 1024, AB_IN, (bf16_t*)(wts + WO_AB), scr, r, lane, nullptr, 0.125f, 512); continue; } r -= I_AB;
                if (r < I_QB) { transpose_item64<false>(p.mla_wq_b, 384, 768, (bf16_t*)(wts + WO_QB), scr, r, lane, p.mla_q_g, 0.10206207261596575f); continue; } r -= I_QB;
                if (r < I_KVB) { transpose_item64<false>(p.mla_wkv_b, 256, 1024, (bf16_t*)(wts + WO_KVB), scr, r, lane, p.mla_kv_g, 1.0f); continue; } r -= I_KVB;
                if (r < I_ABO) { if (OUTPROJ_F8) transpose_item64<true>(p.ab_w_out, 1024, 1024, (unsigned char*)(wts + WO_ABO), scr, r, lane); else transpose_item64<false>(p.ab_w_out, 1024, 1024, (bf16_t*)(wts + WO_ABO), scr, r, lane); continue; } r -= I_ABO;
                if (r < I_C) { if (INPROJ_F8) transpose_item64<true>(p.c_w_in, 1024, C_IN, (unsigned char*)(wts + WO_C), scr, r, lane); else transpose_item64<false>(p.c_w_in, 1024, C_IN, (bf16_t*)(wts + WO_C), scr, r, lane); continue; } r -= I_C;
                if (OUTPROJ_F8) transpose_item64<true>(p.c_w_out, 1024, 1024, (unsigned char*)(wts + WO_CO), scr, r, lane); else transpose_item64<false>(p.c_w_out, 1024, 1024, (bf16_t*)(wts + WO_CO), scr, r, lane);
            }
            uint4* z = (uint4*)((unsigned char*)(wts + WO_AB) + (size_t)AB_IN * 1024 * (INPROJ_F8 ? 1 : 2));
            for (int i = gw * 64 + lane; i < 96 * 1024 * (INPROJ_F8 ? 1 : 2) / 16; i += NGW * 64) z[i] = make_uint4(0u, 0u, 0u, 0u);
        }
        {
            float2* TA = (float2*)(tabs + TAB_A); float2* TB = (float2*)(tabs + TAB_B); float2* TC = (float2*)(tabs + TAB_C);
            for (int e = bid * NTHR + tid; e < SEQ * 112; e += G * NTHR) { const int s = e / 112, i = e % 112, prow = s / GRIDW, pcol = s % GRIDW;
                int quarter, ii; float2* dst;
                if (i < 32) { quarter = 16; ii = i; dst = TA + s * 32 + ii; } else if (i < 48) { quarter = 8; ii = i - 32; dst = TB + s * 16 + ii; } else { quarter = 32; ii = i - 48; dst = TC + s * 64 + ii; }
                const float ang = rope_angle(ii, quarter, prow, pcol); *dst = make_float2(cosf(ang), sinf(ang)); }
            if (bid == 0 && tid < 128) ((float*)(tabs + TAB_QG))[tid] = p.c_q_g[tid] * 0.08838834764831845f;
        }
        __syncthreads();
        float* ca = ldsf;
        float* red = ldsf + 17 * 1024;
        for (int i = tid; i < 17 * 1024; i += NTHR) { const int b = i >> 10, k = i & 1023; const float v = b < NB ? p.c[b * 1024 + k] : p.c_ctx[k]; ca[i] = v / (1.f + expf(-v)); }
        __syncthreads();
        for (int blk = bid; blk < 2 * 6144 / 64; blk += G) {
            const int l = blk / 96, n = (blk % 96) * 64 + lane, ks = wave;
            float acc[17];
#pragma unroll
            for (int b = 0; b < 17; ++b) acc[b] = 0.f;
            const float* wp = p.ada_w + (size_t)l * 1024 * 6144 + n;
            for (int k = ks * 128; k < ks * 128 + 128; ++k) { const float w = wp[(size_t)k * 6144];
#pragma unroll
                for (int b = 0; b < 17; ++b) acc[b] = fmaf(ca[b * 1024 + k], w, acc[b]); }
#pragma unroll
            for (int b = 0; b < 17; ++b) red[(ks * 17 + b) * 64 + lane] = acc[b];
            __syncthreads();
            for (int i = tid; i < 17 * 64; i += NTHR) { const int b = i >> 6, nl = i & 63; float s = 0.f;
#pragma unroll
                for (int k2 = 0; k2 < 8; ++k2) s += red[(k2 * 17 + b) * 64 + nl];
                const int nn = (blk % 96) * 64 + nl; MOD[((size_t)l * 17 + b) * 6144 + nn] = s + p.ada_b[l * 6144 + nn]; }
            __syncthreads();
        }
    }
    SEAM(0);

#define NORM_MOD16(v, g, mr_) do { float ss_ = 0.f; \
        _Pragma("unroll") for (int j = 0; j < 16; ++j) ss_ = fmaf(v[j], v[j], ss_); \
        ss_ = wave_sum(ss_); const float ri_ = 1.0f / sqrtf(ss_ * (1.0f / 1024.0f) + RMS_EPS); \
        float sh_[16], sc_[16]; ld16f((mr_), sh_); ld16f((mr_) + 1024, sc_); \
        _Pragma("unroll") for (int j = 0; j < 16; ++j) v[j] = (v[j] * ri_ * g[j]) * (1.0f + sc_[j]) + sh_[j]; } while (0)

#define NORM_MOD16x2(v, g, mr0_, mr1_) do { float s0_ = 0.f, s1_ = 0.f; \
        _Pragma("unroll") for (int j = 0; j < 16; ++j) { s0_ = fmaf(v[0][j], v[0][j], s0_); s1_ = fmaf(v[1][j], v[1][j], s1_); } \
        wave_sum2(s0_, s1_); const float ri0_ = 1.0f / sqrtf(s0_ * (1.0f / 1024.0f) + RMS_EPS), ri1_ = 1.0f / sqrtf(s1_ * (1.0f / 1024.0f) + RMS_EPS); \
        float sh_[16], sc_[16]; ld16f((mr0_), sh_); ld16f((mr0_) + 1024, sc_); \
        _Pragma("unroll") for (int j = 0; j < 16; ++j) v[0][j] = (v[0][j] * ri0_ * g[j]) * (1.0f + sc_[j]) + sh_[j]; \
        ld16f((mr1_), sh_); ld16f((mr1_) + 1024, sc_); \
        _Pragma("unroll") for (int j = 0; j < 16; ++j) v[1][j] = (v[1][j] * ri1_ * g[j]) * (1.0f + sc_[j]) + sh_[j]; } while (0)
#define ROWS2(nrows) for (int r0_ = gw; r0_ < (nrows); r0_ += 2 * NGW)
#define ROWS2_IDX(nrows) const bool two_ = (r0_ + NGW) < (nrows); const int rr_[2] = {r0_, two_ ? r0_ + NGW : r0_};

    if (IN(1)) { PHASE_PTRS
        float g[16]; ld16f(p.norm_mix_g + 16 * lane, g);
        ROWS2(NROW) { ROWS2_IDX(NROW)
            float v[2][16]; const float* mr[2];
#pragma unroll
            for (int u = 0; u < 2; ++u) { const int r = rr_[u]; const float* src = r < NLAT ? p.x + (size_t)r * 1024 : p.ctx + (size_t)(r - NLAT) * 1024;
                mr[u] = MOD + (size_t)(0 * 17 + mod_row_of(r)) * 6144 + 16 * lane; ld16f(src + 16 * lane, v[u]); }
            NORM_MOD16x2(v, g, mr[0], mr[1]);
            if (INPROJ_F8) { st16f8((unsigned char*)H + (size_t)rr_[0] * 1024 + 16 * lane, v[0]); if (two_) st16f8((unsigned char*)H + (size_t)rr_[1] * 1024 + 16 * lane, v[1]); }
            else { st16bf(H + (size_t)rr_[0] * 1024 + 16 * lane, v[0]); if (two_) st16bf(H + (size_t)rr_[1] * 1024 + 16 * lane, v[1]); }
        }
    }
    SEAM(1);

    if (IN(2)) { PHASE_PTRS
        constexpr size_t ES_ = INPROJ_F8 ? 1 : 2;
        pg8::DenseOrder S{(const char*)H, (const char*)(wts + WO_AB), NROW / 256, 6, G, bid, (size_t)256 * 1024 * ES_, (size_t)256 * 1024 * ES_};
        pg8::EpiStoreBf16 E{PRJ, PRJ_LD, INPROJ_F8 ? 0.03125f : 1.0f};
        pg8::gemm_phase<pg8::EpiStoreBf16, pg8::DenseOrder, true, true, INPROJ_F8 != 0>(tid, LDSB, 1024, 1024, S, E);
    }
    SEAM(2);

    if (IN(3)) { PHASE_PTRS
        const float2* TA = (const float2*)(tabs + TAB_A); const float2* TB = (const float2*)(tabs + TAB_B);
        for (int r = gw; r < NROW; r += NGW) {
            bf16_t* pr = PRJ + (size_t)r * PRJ_LD;
            if (r < NLAT) { const int s = r % SEQ;
                { bf16_t* kp = pr + 512 + (lane >> 5) * 64 + (lane & 31); const float x1 = bf2f(kp[0]), x2 = bf2f(kp[32]); const float2 t = TA[s * 32 + (lane & 31)];
                  kp[0] = f2bf(x1 * t.x - x2 * t.y); kp[32] = f2bf(x2 * t.x + x1 * t.y); }
                if (lane < 16) { bf16_t* rp = pr + 1408 + lane; const float x1 = bf2f(rp[0]), x2 = bf2f(rp[16]); const float2 t = TB[s * 16 + lane];
                  rp[0] = f2bf(x1 * t.x - x2 * t.y); rp[16] = f2bf(x2 * t.x + x1 * t.y); } }
            float s1 = 0.f, s2 = 0.f;
#pragma unroll
            for (int j = 0; j < 6; ++j) { const float xq = bf2f(pr[768 + lane + 64 * j]); s1 = fmaf(xq, xq, s1); }
#pragma unroll
            for (int j = 0; j < 4; ++j) { const float xk = bf2f(pr[1152 + lane + 64 * j]); s2 = fmaf(xk, xk, s2); }
            s1 = wave_sum(s1); s2 = wave_sum(s2);
            if (lane == 0) { RINV[2 * r] = 1.0f / sqrtf(s1 * (1.0f / 384.0f) + RMS_EPS); RINV[2 * r + 1] = 1.0f / sqrtf(s2 * (1.0f / 256.0f) + RMS_EPS); }
        }
    }
    SEAM(3);

    if (IN(4)) { PHASE_PTRS
        { pg8::DenseOrder S{(const char*)(PRJ + 768), (const char*)(wts + WO_QB), NROW / 256, 3, G, bid, (size_t)256 * PRJ_LD * 2, (size_t)256 * 384 * 2};
          pg8::EpiScaleBf16 E{QB, 768, RINV};
          pg8::gemm_phase<pg8::EpiScaleBf16, pg8::DenseOrder, true, true>(tid, LDSB, 384, PRJ_LD, S, E); }
        __syncthreads();
        { pg8::DenseOrder S{(const char*)(PRJ + 1152), (const char*)(wts + WO_KVB), NROW / 256, 4, G, bid, (size_t)256 * PRJ_LD * 2, (size_t)256 * 256 * 2};
          pg8::EpiScaleBf16 E{KVB, 1024, RINV + 1};
          pg8::gemm_phase<pg8::EpiScaleBf16, pg8::DenseOrder, true, true>(tid, LDSB, 256, PRJ_LD, S, E); }
    }
    SEAM(4);

    if (IN(5)) { PHASE_PTRS
        for (int i = 0;; ++i) { const int u = i * G + bid; if (u >= 1152) break;
            const bool isctx = u >= 1024; int b, h, qb;
            if (!isctx) { const int rest = u >> 3; b = 2 * (u & 7) + (rest >> 6); h = (rest & 63) >> 3; qb = rest & 7; } else { b = (u - 1024) >> 3; h = u & 7; qb = 0; }
            const int qrow0 = isctx ? NLAT + b * NCX : b * SEQ + qb * 256;
            fa::Unit U; U.Q = QB + (size_t)qrow0 * 768 + h * 96; U.K = KVB + h * 128; U.K2 = PRJ + 1408; U.V = KVB + h * 128 + 64;
            U.O = OUTPROJ_F8 ? (bf16_t*)((unsigned char*)OB + (size_t)qrow0 * 1024 + 512 + h * 64) : OB + (size_t)qrow0 * 1024 + 512 + h * 64; U.rowa = NLAT + b * NCX; U.nta = 4; U.rowb = b * SEQ; U.ntb = isctx ? 0 : 32;
            U.window = 0; U.qpos0 = 0; U.kposb0 = 0; U.sink = 0.f; U.has_sink = 0; U.tab = isctx ? nullptr : (const float*)(tabs + TAB_B); U.pos0 = qb * 256; U.qg = nullptr;
            fa::attn_unit<96, 64, 768, 1024, 1024, 1024, false, 4, 1, false, true, OUTPROJ_F8 != 0>(tid, U, (char*)lds_raw); }
        for (int i = 0;; ++i) { const int u = i * G + bid; if (u >= 1152) break;
            const bool isctx = u >= 1024; int b, h, qb;
            if (!isctx) { const int rest = u >> 3; b = 2 * (u & 7) + (rest >> 6); h = (rest & 63) >> 3; qb = rest & 7; } else { b = (u - 1024) >> 3; h = u & 7; qb = 0; }
            const int qrow0 = isctx ? NLAT + b * NCX : b * SEQ + qb * 256;
            const int ks = isctx ? 0 : max(0, qb * 256 - 128), ke = isctx ? 0 : min(SEQ, qb * 256 + 384);
            fa::Unit U; U.Q = PRJ + (size_t)qrow0 * PRJ_LD + h * 64; U.K = PRJ + 512 + (h >> 2) * 64; U.K2 = nullptr; U.V = PRJ + 640 + (h >> 2) * 64;
            U.O = OUTPROJ_F8 ? (bf16_t*)((unsigned char*)OB + (size_t)qrow0 * 1024 + h * 64) : OB + (size_t)qrow0 * 1024 + h * 64; U.rowa = NLAT + b * NCX; U.nta = 4; U.rowb = b * SEQ + ks; U.ntb = (ke - ks) / 64;
            U.window = isctx ? 0 : 1; U.qpos0 = qb * 256; U.kposb0 = ks; U.sink = p.swa_sink[h]; U.has_sink = 1; U.tab = isctx ? nullptr : (const float*)(tabs + TAB_A); U.pos0 = qb * 256; U.qg = nullptr;
            fa::attn_unit<64, 64, PRJ_LD, PRJ_LD, PRJ_LD, 1024, true, 0, 2, false, false, OUTPROJ_F8 != 0>(tid, U, (char*)lds_raw); }
    }
    SEAM(5);

    if (IN(6)) { PHASE_PTRS
        constexpr size_t ES_ = OUTPROJ_F8 ? 1 : 2;
        pg8::DenseOrder S{(const char*)OB, (const char*)(wts + WO_ABO), NROW / 256, 4, G, bid, (size_t)256 * 1024 * ES_, (size_t)256 * 1024 * ES_};
        pg8::EpiResid E{p.x, p.ctx, XR, MOD + 2048, OUTPROJ_F8 ? 0.03125f : 1.0f};
        pg8::gemm_phase<pg8::EpiResid, pg8::DenseOrder, true, true, OUTPROJ_F8 != 0>(tid, LDSB, 1024, 1024, S, E);
    }
    SEAM(6);

#define ROUTER_PHASE(L, nrows) do { \
        { const float4* wsrc_ = (const float4*)(p.router_w + (size_t)(L) * 1024 * 32); float4* wl_ = (float4*)lds_raw; \
          for (int q = tid; q < 8192; q += NTHR) { const int c_ = q >> 3, e4_ = q & 7; wl_[c_ * 8 + (e4_ ^ ((c_ >> 5) & 7))] = wsrc_[q]; } } \
        __syncthreads(); \
        unsigned* cnt_ = ctl + CW_CNT + (L) * 32; \
        LAS unsigned* lcnt_ = (LAS unsigned*)(LDSB + LDS_MISC + 1024); LAS unsigned* lbase_ = lcnt_ + 32;       \
        if (tid < 32) lcnt_[tid] = 0u; \
        __syncthreads(); \
        const int half_ = lane >> 5, l5_ = lane & 31;                        \
        float g_[2][16]; ld16f(p.norm_ffn_g + (L) * 1024 + 32 * l5_, g_[0]); ld16f(p.norm_ffn_g + (L) * 1024 + 32 * l5_ + 16, g_[1]); \
        const float rb_ = p.router_b[(L) * 32 + l5_]; \
        const float4* wl_ = (const float4*)lds_raw + (size_t)(32 * l5_) * 8; const int sw_ = l5_ & 7; \
        for (int rp = gw; rp * 2 < (nrows); rp += NGW) { const int r = rp * 2 + half_; \
            const float* mr = MOD + (size_t)((L) * 17 + mod_row_of(r)) * 6144 + 3072 + 32 * l5_; \
            float v[2][16]; ld16f(XR + (size_t)r * 1024 + 32 * l5_, v[0]); ld16f(XR + (size_t)r * 1024 + 32 * l5_ + 16, v[1]); \
            float ss_ = 0.f; \
            _Pragma("unroll") for (int j = 0; j < 16; ++j) { ss_ = fmaf(v[0][j], v[0][j], ss_); ss_ = fmaf(v[1][j], v[1][j], ss_); } \
            _Pragma("unroll") for (int o_ = 1; o_ < 32; o_ <<= 1) ss_ += __shfl_xor(ss_, o_); \
            const float ri_ = 1.0f / sqrtf(ss_ * (1.0f / 1024.0f) + RMS_EPS); \
            _Pragma("unroll") for (int hh = 0; hh < 2; ++hh) { float sh_[16], sc_[16]; ld16f(mr + 16 * hh, sh_); ld16f(mr + 1024 + 16 * hh, sc_); \
                _Pragma("unroll") for (int j = 0; j < 16; ++j) v[hh][j] = (v[hh][j] * ri_ * g_[hh][j]) * (1.0f + sc_[j]) + sh_[j]; \
                st16f8((unsigned char*)H + (size_t)r * 1024 + 32 * l5_ + 16 * hh, v[hh]); }        \
            float acc[32]; \
            _Pragma("unroll") for (int e = 0; e < 32; ++e) acc[e] = 0.f; \
            _Pragma("unroll") for (int hh = 0; hh < 2; ++hh) _Pragma("unroll") for (int j = 0; j < 16; ++j) { \
                _Pragma("unroll") for (int e4 = 0; e4 < 8; ++e4) { const float4 w = wl_[(16 * hh + j) * 8 + (e4 ^ sw_)]; \
                    acc[4 * e4] = fmaf(v[hh][j], w.x, acc[4 * e4]); acc[4 * e4 + 1] = fmaf(v[hh][j], w.y, acc[4 * e4 + 1]); acc[4 * e4 + 2] = fmaf(v[hh][j], w.z, acc[4 * e4 + 2]); acc[4 * e4 + 3] = fmaf(v[hh][j], w.w, acc[4 * e4 + 3]); } } \
            float tv[4]; int ti[4]; route_reduce32(acc, l5_, rb_, tv, ti); \
            const float e1 = expf(tv[1] - tv[0]), e2 = expf(tv[2] - tv[0]), e3 = expf(tv[3] - tv[0]); const float inv = 1.0f / (1.0f + e1 + e2 + e3); \
            if (l5_ < 4) { const int ek = l5_ == 0 ? ti[0] : l5_ == 1 ? ti[1] : l5_ == 2 ? ti[2] : ti[3]; const float gk = (l5_ == 0 ? 1.0f : l5_ == 1 ? e1 : l5_ == 2 ? e2 : e3) * inv; \
                const unsigned pos = __hip_atomic_fetch_add(lcnt_ + ek, 1u, __ATOMIC_RELAXED, __HIP_MEMORY_SCOPE_WORKGROUP); TOKE[r * 4 + l5_] = ek; TOKP[r * 4 + l5_] = (int)pos; TOKG[r * 4 + l5_] = gk; } \
        } \
        __syncthreads(); \
        if (tid < 32) lbase_[tid] = atomicAdd(cnt_ + tid, lcnt_[tid]); \
        __syncthreads(); \
        for (int rp = gw; rp * 2 < (nrows); rp += NGW) { const int r = rp * 2 + half_; if (l5_ < 4) TOKP[r * 4 + l5_] += (int)lbase_[TOKE[r * 4 + l5_]]; } \
    } while (0)

#define EXCL_SETUP(L) \
        const int c_ = lane < 32 ? (int)ctl[CW_CNT + (L) * 32 + lane] : 0; const int padc_ = (c_ + 255) / 256 * 256; int pre_ = padc_; \
        _Pragma("unroll") for (int o_ = 1; o_ < 32; o_ <<= 1) { const int t_ = __shfl_up(pre_, o_); if ((lane & 31) >= o_) pre_ += t_; } \
        const int excl_ = pre_ - padc_;
#define PERMUTE_PHASE(L, nrows) do { EXCL_SETUP(L) \
        ROWS2(nrows) { ROWS2_IDX(nrows) \
            const int ra_ = rr_[0], rb_ = rr_[1]; \
            const uint4* sa_ = (const uint4*)(H + (size_t)ra_ * 1024) + lane * 2; const uint4* sb_ = (const uint4*)(H + (size_t)rb_ * 1024) + lane * 2; \
            const uint4 a0_ = sa_[0], a1_ = sa_[1], b0_ = sb_[0], b1_ = sb_[1]; \
            const int4 ea_ = *(const int4*)(TOKE + ra_ * 4), pa_ = *(const int4*)(TOKP + ra_ * 4), eb_ = *(const int4*)(TOKE + rb_ * 4), pb_ = *(const int4*)(TOKP + rb_ * 4); \
            const int sa0 = __shfl(excl_, ea_.x) + pa_.x, sa1 = __shfl(excl_, ea_.y) + pa_.y, sa2 = __shfl(excl_, ea_.z) + pa_.z, sa3 = __shfl(excl_, ea_.w) + pa_.w; \
            const int sb0 = __shfl(excl_, eb_.x) + pb_.x, sb1 = __shfl(excl_, eb_.y) + pb_.y, sb2 = __shfl(excl_, eb_.z) + pb_.z, sb3 = __shfl(excl_, eb_.w) + pb_.w; \
            { uint4* d_ = (uint4*)(XS + (size_t)sa0 * 1024) + lane * 2; d_[0] = a0_; d_[1] = a1_; } { uint4* d_ = (uint4*)(XS + (size_t)sa1 * 1024) + lane * 2; d_[0] = a0_; d_[1] = a1_; } \
            { uint4* d_ = (uint4*)(XS + (size_t)sa2 * 1024) + lane * 2; d_[0] = a0_; d_[1] = a1_; } { uint4* d_ = (uint4*)(XS + (size_t)sa3 * 1024) + lane * 2; d_[0] = a0_; d_[1] = a1_; } \
            if (two_) { \
            { uint4* d_ = (uint4*)(XS + (size_t)sb0 * 1024) + lane * 2; d_[0] = b0_; d_[1] = b1_; } { uint4* d_ = (uint4*)(XS + (size_t)sb1 * 1024) + lane * 2; d_[0] = b0_; d_[1] = b1_; } \
            { uint4* d_ = (uint4*)(XS + (size_t)sb2 * 1024) + lane * 2; d_[0] = b0_; d_[1] = b1_; } { uint4* d_ = (uint4*)(XS + (size_t)sb3 * 1024) + lane * 2; d_[0] = b0_; d_[1] = b1_; } } } \
        for (int e = 0; e < 32; ++e) { const int ce = __shfl(c_, e), be = __shfl(excl_, e), pe = __shfl(padc_, e); \
            for (int rr = ce + gw; rr < pe; rr += NGW) { uint4* d_ = (uint4*)(XS + (size_t)(be + rr) * 1024) + lane * 2; d_[0] = make_uint4(0u, 0u, 0u, 0u); d_[1] = make_uint4(0u, 0u, 0u, 0u); } } \
    } while (0)
#define PERMUTE_PHASE_F8(L, nrows) do { EXCL_SETUP(L) \
        unsigned char* XS8 = (unsigned char*)XS; \
        for (int r = gw; r < (nrows); r += NGW) { \
            const int4 ov_ = *((const int4*)((const unsigned char*)H + (size_t)r * 1024) + lane); \
            _Pragma("unroll") for (int k = 0; k < 4; ++k) { const int ek = TOKE[r * 4 + k], pk = TOKP[r * 4 + k]; const int slot = __shfl(excl_, ek) + pk; \
                *((int4*)(XS8 + (size_t)slot * 1024) + lane) = ov_; } } \
        for (int e = 0; e < 32; ++e) { const int ce = __shfl(c_, e), be = __shfl(excl_, e), pe = __shfl(padc_, e); \
            for (int rr = ce + gw; rr < pe; rr += NGW) *((int4*)(XS8 + (size_t)(be + rr) * 1024) + lane) = make_int4(0, 0, 0, 0); } \
    } while (0)
#define MOE_TABLE(L) \
        LAS int* tile_e = (LAS int*)(LDSB + LDS_MISC + 1024); LAS int* nm_p = tile_e + 640; \
        __syncthreads(); \
        if (tid == 0) { int t_ = 0; for (int e = 0; e < 32; ++e) { const int c_ = (int)ctl[CW_CNT + (L) * 32 + e]; const int n_ = (c_ + 255) / 256; for (int j = 0; j < n_; ++j) tile_e[t_ + j] = e; t_ += n_; } *nm_p = t_; } \
        __syncthreads(); \
        const int nM_ = __builtin_amdgcn_readfirstlane(*nm_p);
#define MOE_FAST1(L) do { MOE_TABLE(L) \
        pg8::MoeOrder S{(const char*)XS, (const char*)(wts + WO_W1) + (size_t)(L) * 32 * 2048 * 1024 * 2, tile_e, nM_, 8, G, bid, (size_t)256 * 1024 * 2, (size_t)2048 * 1024 * 2}; \
        pg8::EpiSwiglu E{ACT, p.moe_b_in + (size_t)(L) * 32 * 2048, 1.0f}; \
        pg8::gemm_phase<pg8::EpiSwiglu, pg8::MoeOrder, true, true>(tid, LDSB, 1024, 1024, S, E); } while (0)
#define MOE_FAST2(L) do { MOE_TABLE(L) \
        pg8::MoeOrder S{(const char*)ACT, (const char*)(wts + WO_W2) + (size_t)(L) * 32 * 1024 * 1024 * 2, tile_e, nM_, 4, G, bid, (size_t)256 * 1024 * 2, (size_t)1024 * 1024 * 2}; \
        pg8::EpiBiasBf16 E{Y, p.moe_b_out + (size_t)(L) * 32 * 1024, 1.0f}; \
        pg8::gemm_phase<pg8::EpiBiasBf16, pg8::MoeOrder, true, true>(tid, LDSB, 1024, 1024, S, E); } while (0)
#define MOE_FAST1_F8(L) do { MOE_TABLE(L) \
        pg8::MoeOrder S{(const char*)XS, (const char*)(wts + WO_W1) + (size_t)(L) * 32 * 2048 * 1024 * 2, tile_e, nM_, 8, G, bid, (size_t)256 * 1024, (size_t)2048 * 1024}; \
        if constexpr (MOE_F8_DOWN) { pg8::EpiSwigluF8 E{(unsigned char*)ACT, p.moe_b_in + (size_t)(L) * 32 * 2048}; \
            pg8::gemm_phase<pg8::EpiSwigluF8, pg8::MoeOrder, true, true, true>(tid, LDSB, 1024, 1024, S, E); } \
        else { pg8::EpiSwiglu E{ACT, p.moe_b_in + (size_t)(L) * 32 * 2048, 0.03125f}; \
            pg8::gemm_phase<pg8::EpiSwiglu, pg8::MoeOrder, false, true, true>(tid, LDSB, 1024, 1024, S, E); } } while (0)
#define MOE_FAST2_F8(L) do { MOE_TABLE(L) \
        pg8::MoeOrder S{(const char*)ACT, (const char*)(wts + WO_W2) + (size_t)(L) * 32 * 1024 * 1024 * 2, tile_e, nM_, 4, G, bid, (size_t)256 * 1024, (size_t)1024 * 1024}; \
        if constexpr (Y8_L1 && (L) == 1) { pg8::EpiBiasF8 E{(unsigned char*)Y, p.moe_b_out + (size_t)(L) * 32 * 1024, 0.03125f}; \
            pg8::gemm_phase<pg8::EpiBiasF8, pg8::MoeOrder, true, true, true>(tid, LDSB, 1024, 1024, S, E); } \
        else { pg8::EpiBiasBf16 E{Y, p.moe_b_out + (size_t)(L) * 32 * 1024, 0.03125f}; \
            pg8::gemm_phase<pg8::EpiBiasBf16, pg8::MoeOrder, true, true, true>(tid, LDSB, 1024, 1024, S, E); } } while (0)
#define COMBINE_ROWS2(L, v) do { \
        uint4 ya_[2][4], yb_[2][4]; float gk_[2][4]; float g2v_[2][16]; \
        _Pragma("unroll") for (int u = 0; u < 2; ++u) { const int r = rr_[u]; \
            _Pragma("unroll") for (int k = 0; k < 4; ++k) { const int ek = TOKE[r * 4 + k], pk = TOKP[r * 4 + k]; gk_[u][k] = TOKG[r * 4 + k]; \
                const int slot = __shfl(excl_, ek) + pk; const uint4* yr = (const uint4*)(Y + (size_t)slot * 1024 + 16 * lane); ya_[u][k] = yr[0]; yb_[u][k] = yr[1]; } \
            ld16f(MOD + (size_t)((L) * 17 + mod_row_of(r)) * 6144 + 5120 + 16 * lane, g2v_[u]); ld16f(XR + (size_t)r * 1024 + 16 * lane, v[u]); } \
        _Pragma("unroll") for (int u = 0; u < 2; ++u) { float f_[16]; \
            _Pragma("unroll") for (int j = 0; j < 16; ++j) f_[j] = 0.f; \
            _Pragma("unroll") for (int k = 0; k < 4; ++k) { const unsigned yw[8] = {ya_[u][k].x, ya_[u][k].y, ya_[u][k].z, ya_[u][k].w, yb_[u][k].x, yb_[u][k].y, yb_[u][k].z, yb_[u][k].w}; \
                _Pragma("unroll") for (int j = 0; j < 8; ++j) { f_[2 * j] = fmaf(gk_[u][k], __uint_as_float(yw[j] << 16), f_[2 * j]); f_[2 * j + 1] = fmaf(gk_[u][k], __uint_as_float(yw[j] & 0xffff0000u), f_[2 * j + 1]); } } \
            _Pragma("unroll") for (int j = 0; j < 16; ++j) v[u][j] = fmaf(g2v_[u][j], f_[j], v[u][j]); } } while (0)

#define COMBINE_ROWS2_F8(L, v) do { \
        int4 y8_[2][4]; float gk_[2][4]; float g2v_[2][16]; \
        _Pragma("unroll") for (int u = 0; u < 2; ++u) { const int r = rr_[u]; \
            _Pragma("unroll") for (int k = 0; k < 4; ++k) { const int ek = TOKE[r * 4 + k], pk = TOKP[r * 4 + k]; gk_[u][k] = TOKG[r * 4 + k]; \
                const int slot = __shfl(excl_, ek) + pk; y8_[u][k] = *((const int4*)((const unsigned char*)Y + (size_t)slot * 1024) + lane); } \
            ld16f(MOD + (size_t)((L) * 17 + mod_row_of(r)) * 6144 + 5120 + 16 * lane, g2v_[u]); ld16f(XR + (size_t)r * 1024 + 16 * lane, v[u]); } \
        _Pragma("unroll") for (int u = 0; u < 2; ++u) { float f_[16]; \
            _Pragma("unroll") for (int j = 0; j < 16; ++j) f_[j] = 0.f; \
            _Pragma("unroll") for (int k = 0; k < 4; ++k) { const int yw[4] = {y8_[u][k].x, y8_[u][k].y, y8_[u][k].z, y8_[u][k].w}; \
                _Pragma("unroll") for (int j = 0; j < 4; ++j) { const auto lo_ = __builtin_amdgcn_cvt_pk_f32_fp8(yw[j], false); const auto hi_ = __builtin_amdgcn_cvt_pk_f32_fp8(yw[j], true); \
                    f_[4 * j] = fmaf(gk_[u][k], lo_[0], f_[4 * j]); f_[4 * j + 1] = fmaf(gk_[u][k], lo_[1], f_[4 * j + 1]); f_[4 * j + 2] = fmaf(gk_[u][k], hi_[0], f_[4 * j + 2]); f_[4 * j + 3] = fmaf(gk_[u][k], hi_[1], f_[4 * j + 3]); } } \
            _Pragma("unroll") for (int j = 0; j < 16; ++j) v[u][j] = fmaf(g2v_[u][j], f_[j], v[u][j]); } } while (0)

    if (IN(7)) { PHASE_PTRS ROUTER_PHASE(0, NROW); }
    SEAM(7);
#if MOE_F8_L0
    if (IN(8)) { PHASE_PTRS PERMUTE_PHASE_F8(0, NROW); }
    SEAM(8);
    if (IN(9)) { PHASE_PTRS MOE_FAST1_F8(0); }
    SEAM(9);
#else
    if (IN(8)) { PHASE_PTRS PERMUTE_PHASE(0, NROW); }
    SEAM(8);
    if (IN(9)) { PHASE_PTRS MOE_FAST1(0); }
    SEAM(9);
#endif
    if (IN(10)) { PHASE_PTRS if constexpr (MOE_F8_L0 && MOE_F8_DOWN) { MOE_FAST2_F8(0); } else { MOE_FAST2(0); } }
    SEAM(10);

    if (IN(11)) { PHASE_PTRS EXCL_SETUP(0)
        float g[16]; ld16f(p.norm_mix_g + 1024 + 16 * lane, g);
        ROWS2(NROW) { ROWS2_IDX(NROW)
            float v[2][16]; COMBINE_ROWS2(0, v);
            st16f(XR + (size_t)rr_[0] * 1024 + 16 * lane, v[0]); if (two_) st16f(XR + (size_t)rr_[1] * 1024 + 16 * lane, v[1]);
            const float* mr0 = MOD + (size_t)(1 * 17 + mod_row_of(rr_[0])) * 6144 + 16 * lane; const float* mr1 = MOD + (size_t)(1 * 17 + mod_row_of(rr_[1])) * 6144 + 16 * lane;
            NORM_MOD16x2(v, g, mr0, mr1);
            if (INPROJ_F8) { st16f8((unsigned char*)H + (size_t)rr_[0] * 1024 + 16 * lane, v[0]); if (two_) st16f8((unsigned char*)H + (size_t)rr_[1] * 1024 + 16 * lane, v[1]); }
            else { st16bf(H + (size_t)rr_[0] * 1024 + 16 * lane, v[0]); if (two_) st16bf(H + (size_t)rr_[1] * 1024 + 16 * lane, v[1]); }
        }
    }
    SEAM(11);

    if (IN(12)) { PHASE_PTRS
        constexpr size_t ES_ = INPROJ_F8 ? 1 : 2;
        pg8::DenseOrder S{(const char*)H, (const char*)(wts + WO_C), NROW / 256, 6, G, bid, (size_t)256 * 1024 * ES_, (size_t)256 * 1024 * ES_};
        pg8::EpiStoreBf16 E{PRJ, PRJ_LD, INPROJ_F8 ? 0.03125f : 1.0f};
        pg8::gemm_phase<pg8::EpiStoreBf16, pg8::DenseOrder, true, true, INPROJ_F8 != 0>(tid, LDSB, 1024, 1024, S, E);
    }
    SEAM(12);

    if (IN(13)) { PHASE_PTRS
        const float2* TC = (const float2*)(tabs + TAB_C); const float kg1 = p.c_k_g[lane], kg2 = p.c_k_g[64 + lane];
        for (int r = gw; r < NROW; r += NGW) {
            bf16_t* pr = PRJ + (size_t)r * PRJ_LD + 1024; float2 t = make_float2(1.f, 0.f); if (r < NLAT) t = TC[(r % SEQ) * 64 + lane];
#pragma unroll
            for (int kv = 0; kv < 2; ++kv) { float x1 = bf2f(pr[kv * 128 + lane]), x2 = bf2f(pr[kv * 128 + 64 + lane]);
                const float ss = wave_sum(x1 * x1 + x2 * x2); const float ri = 1.0f / sqrtf(ss * (1.0f / 128.0f) + RMS_EPS);
                x1 = x1 * ri * kg1; x2 = x2 * ri * kg2;
                pr[kv * 128 + lane] = f2bf(x1 * t.x - x2 * t.y); pr[kv * 128 + 64 + lane] = f2bf(x2 * t.x + x1 * t.y); }
        }
    }
    SEAM(13);

    if (IN(14)) { PHASE_PTRS
        for (int i = 0;; ++i) { const int u = i * G + bid; if (u >= 1024) break;
            const int rest = u >> 3; const int b = 2 * (u & 7) + (rest >> 6), h = (rest & 63) >> 3, qb = rest & 7; const int qrow0 = b * SEQ + qb * 256;
            fa::Unit U; U.Q = PRJ + (size_t)qrow0 * PRJ_LD + h * 128; U.K = PRJ + 1024 + (h >> 2) * 128; U.K2 = nullptr; U.V = PRJ + 1280 + (h >> 2) * 128;
            U.O = OUTPROJ_F8 ? (bf16_t*)((unsigned char*)OB + (size_t)qrow0 * 1024 + h * 128) : OB + (size_t)qrow0 * 1024 + h * 128; U.rowa = NLAT + b * NCX; U.nta = 4; U.rowb = b * SEQ; U.ntb = 32;
            U.window = 0; U.qpos0 = 0; U.kposb0 = 0; U.sink = 0.f; U.has_sink = 0; U.tab = (const float*)(tabs + TAB_C); U.pos0 = qb * 256; U.qg = (const float*)(tabs + TAB_QG);
            fa::attn_unit<128, 128, PRJ_LD, PRJ_LD, PRJ_LD, 1024, false, 0, 4, true, false, OUTPROJ_F8 != 0>(tid, U, (char*)lds_raw); }
    }
    SEAM(14);

    if (IN(15)) { PHASE_PTRS
        constexpr size_t ES_ = OUTPROJ_F8 ? 1 : 2;
        pg8::DenseOrder S{(const char*)OB, (const char*)(wts + WO_CO), NLAT / 256, 4, G, bid, (size_t)256 * 1024 * ES_, (size_t)256 * 1024 * ES_};
        pg8::EpiResid E{XR, XR, XR, MOD + 17 * 6144 + 2048, OUTPROJ_F8 ? 0.03125f : 1.0f};
        pg8::gemm_phase<pg8::EpiResid, pg8::DenseOrder, true, true, OUTPROJ_F8 != 0>(tid, LDSB, 1024, 1024, S, E);
    }
    SEAM(15);

    if (IN(16)) { PHASE_PTRS ROUTER_PHASE(1, NLAT); }
    SEAM(16);
#if MOE_F8_L1
    if (IN(17)) { PHASE_PTRS PERMUTE_PHASE_F8(1, NLAT); }
    SEAM(17);
    if (IN(18)) { PHASE_PTRS MOE_FAST1_F8(1); }
    SEAM(18);
    if (IN(19)) { PHASE_PTRS if constexpr (MOE_F8_DOWN) { MOE_FAST2_F8(1); } else { MOE_FAST2(1); } }
    SEAM(19);
#else
    if (IN(17)) { PHASE_PTRS PERMUTE_PHASE(1, NLAT); }
    SEAM(17);
    if (IN(18)) { PHASE_PTRS MOE_FAST1(1); }
    SEAM(18);
    if (IN(19)) { PHASE_PTRS MOE_FAST2(1); }
    SEAM(19);
#endif

    if (IN(20)) { PHASE_PTRS EXCL_SETUP(1)
        float g[16]; ld16f(p.final_g + 16 * lane, g);
        ROWS2(NLAT) { ROWS2_IDX(NLAT)
            float v[2][16]; if constexpr (Y8_L1 && MOE_F8_L1 && MOE_F8_DOWN) { COMBINE_ROWS2_F8(1, v); } else { COMBINE_ROWS2(1, v); }
            float s0 = 0.f, s1 = 0.f;
#pragma unroll
            for (int j = 0; j < 16; ++j) { s0 = fmaf(v[0][j], v[0][j], s0); s1 = fmaf(v[1][j], v[1][j], s1); }
            wave_sum2(s0, s1); const float ri0 = 1.0f / sqrtf(s0 * (1.0f / 1024.0f) + RMS_EPS), ri1 = 1.0f / sqrtf(s1 * (1.0f / 1024.0f) + RMS_EPS);
#pragma unroll
            for (int j = 0; j < 16; ++j) { v[0][j] = v[0][j] * ri0 * g[j]; v[1][j] = v[1][j] * ri1 * g[j]; }
            st16f(p.out + (size_t)rr_[0] * 1024 + 16 * lane, v[0]); if (two_) st16f(p.out + (size_t)rr_[1] * 1024 + 16 * lane, v[1]);
        }
    }
#undef IN
#undef SEAM
}

#ifndef MK_PER_PHASE
#define MK_PER_PHASE 0
#endif
extern "C" void kernel_launch(void* const* d_in, const int* in_sizes, int n_in, void* d_out, int out_size, void* d_ws, size_t ws_size, hipStream_t stream) {
    static int grid = 0;
    if (grid == 0) {
        if (n_in != 26 || out_size != NLAT * DM || ws_size < WS_END) { fprintf(stderr, "kernel_launch: unexpected shapes (n_in %d out %d ws %zu need %zu)\n", n_in, out_size, ws_size, (size_t)WS_END); grid = -1; return; }
        int dev = 0, cus = 0;
        if (hipGetDevice(&dev) != hipSuccess || hipDeviceGetAttribute(&cus, hipDeviceAttributeMultiprocessorCount, dev) != hipSuccess) { grid = -1; return; }
        if (hipFuncSetAttribute((const void*)fwd_kernel, hipFuncAttributeMaxDynamicSharedMemorySize, LDS_BYTES) != hipSuccess) { fprintf(stderr, "kernel_launch: hipFuncSetAttribute failed\n"); grid = -1; return; }
        int per_cu = 0;
        if (hipOccupancyMaxActiveBlocksPerMultiprocessor(&per_cu, (const void*)fwd_kernel, NTHR, LDS_BYTES) != hipSuccess || per_cu < 1) { fprintf(stderr, "kernel_launch: occupancy query says %d\n", per_cu); }
        (void)hipGetLastError();
        grid = cus;
    }
    if (grid < 0) return;
    (void)hipMemsetAsync((char*)d_ws + WS_CTL, 0, CTL_BYTES, stream);
    Params p{};
    const float** pp = (const float**)&p;
    for (int i = 0; i < 26; ++i) pp[i] = (const float*)d_in[i];
    p.out = (float*)d_out; p.ws = (unsigned char*)d_ws;
#if MK_PER_PHASE
    for (int k = 0; k < N_PHASES; ++k) { p.ph_lo = k; p.ph_hi = k + 1; hipLaunchKernelGGL(fwd_kernel, dim3(grid), dim3(NTHR), LDS_BYTES, stream, p); }
#else
    p.ph_lo = 0; p.ph_hi = N_PHASES;
    hipLaunchKernelGGL(fwd_kernel, dim3(grid), dim3(NTHR), LDS_BYTES, stream, p);
#endif
}
```

```cpp
#include <hip/hip_runtime.h>
#include <cstdio>
#include <cstdint>

typedef unsigned short bf16_t;
typedef bf16_t act_t;
#define GAS __attribute__((address_space(1)))
#define LAS __attribute__((address_space(3)))

constexpr int DM = 1024, NB = 16, SEQ = 2048, NCX = 256, GRIDW = 64;
constexpr int NLAT = NB * SEQ, NCTX = NB * NCX, NROW = NLAT + NCTX;
constexpr int AB_IN = 1440, C_IN = 1536, PRJ_LD = 1536;
constexpr int NEXP = 32, DFF = 1024;
constexpr int CAP = 155648;
constexpr float RMS_EPS = 1e-6f;
constexpr int NTHR = 512;

constexpr size_t MiB = 1u << 20;
constexpr size_t ASZ = sizeof(act_t);
constexpr size_t WS_CTL = 0, CTL_BYTES = 1 * MiB;
constexpr size_t WS_MOD = 1 * MiB;
constexpr size_t WS_TOKE = 2 * MiB, WS_TOKP = 3 * MiB, WS_TOKG = 4 * MiB;
constexpr size_t WS_RINV = 5 * MiB;
constexpr size_t WS_TAB = 6 * MiB;
constexpr size_t TAB_A = 0, TAB_B = (size_t)SEQ * 32 * 8, TAB_C = TAB_B + (size_t)SEQ * 16 * 8, TAB_QG = TAB_C + (size_t)SEQ * 64 * 8;
constexpr size_t WS_XR = 16 * MiB;
constexpr size_t WS_H = WS_XR + 144 * MiB;
constexpr size_t WS_BIG = WS_H + (size_t)NROW * 1024 * ASZ;
constexpr size_t OFF_PRJ = 0;
constexpr size_t OFF_QB = OFF_PRJ + (size_t)NROW * 1536 * ASZ;
constexpr size_t OFF_KVB = OFF_QB + (size_t)NROW * 768 * ASZ;
constexpr size_t OFF_O = OFF_KVB + (size_t)NROW * 1024 * ASZ;
constexpr size_t BIG_A = OFF_O + (size_t)NROW * 1024 * ASZ;
constexpr size_t BIG_Y = (size_t)CAP * 1024 * ASZ;
constexpr size_t BIG_BYTES = BIG_A > BIG_Y ? BIG_A : BIG_Y;
constexpr size_t WS_ACT = WS_BIG + BIG_BYTES;
constexpr size_t WS_XS = WS_ACT + (size_t)CAP * 1024 * ASZ;
constexpr size_t WS_W = WS_XS + (size_t)CAP * 1024 * ASZ;
constexpr size_t WO_AB = 0;
constexpr size_t WO_QB = WO_AB + (size_t)1536 * 1024 * 2;
constexpr size_t WO_KVB = WO_QB + (size_t)768 * 384 * 2;
constexpr size_t WO_ABO = WO_KVB + (size_t)1024 * 256 * 2;
constexpr size_t WO_C = WO_ABO + (size_t)1024 * 1024 * 2;
constexpr size_t WO_CO = WO_C + (size_t)1536 * 1024 * 2;
constexpr size_t WO_W1 = WO_CO + (size_t)1024 * 1024 * 2;
constexpr size_t WO_W2 = WO_W1 + (size_t)64 * 2048 * 1024 * 2;
constexpr size_t WS_END = WS_W + WO_W2 + (size_t)64 * 1024 * 1024 * 2;

constexpr int CW_CNT = 64;
constexpr int CW_BAR = 4096;

__device__ __forceinline__ float bf2f(bf16_t v) { return __uint_as_float(((unsigned)v) << 16); }
__device__ __forceinline__ bf16_t f2bf(float f) { unsigned u = __float_as_uint(f); return (bf16_t)((u + 0x7fffu + ((u >> 16) & 1u)) >> 16); }
__device__ __forceinline__ float ldA(const float* p) { return *p; }
__device__ __forceinline__ float ldA(const bf16_t* p) { return bf2f(*p); }
__device__ __forceinline__ void stA(float* p, float v) { *p = v; }
__device__ __forceinline__ void stA(bf16_t* p, float v) { *p = f2bf(v); }
template <int N> __device__ __forceinline__ void load_vec(const float* p, float (&o)[N]) {
#pragma unroll
    for (int i = 0; i < N / 4; ++i) { const float4 t = ((const float4*)p)[i]; o[4 * i] = t.x; o[4 * i + 1] = t.y; o[4 * i + 2] = t.z; o[4 * i + 3] = t.w; }
}
template <int N> __device__ __forceinline__ void load_vec(const bf16_t* p, float (&o)[N]) {
#pragma unroll
    for (int i = 0; i < N / 8; ++i) { const uint4 t = ((const uint4*)p)[i];
        o[8 * i] = __uint_as_float(t.x << 16); o[8 * i + 1] = __uint_as_float(t.x & 0xffff0000u); o[8 * i + 2] = __uint_as_float(t.y << 16); o[8 * i + 3] = __uint_as_float(t.y & 0xffff0000u);
        o[8 * i + 4] = __uint_as_float(t.z << 16); o[8 * i + 5] = __uint_as_float(t.z & 0xffff0000u); o[8 * i + 6] = __uint_as_float(t.w << 16); o[8 * i + 7] = __uint_as_float(t.w & 0xffff0000u); }
}
__device__ __forceinline__ float wave_sum(float v) {
#pragma unroll
    for (int o = 1; o < 64; o <<= 1) v += __shfl_xor(v, o);
    return v;
}

__device__ __forceinline__ void wave_sum2(float& a, float& b) {
#pragma unroll
    for (int o = 1; o < 64; o <<= 1) { const float ta = __shfl_xor(a, o), tb = __shfl_xor(b, o); a += ta; b += tb; }
}
__device__ __forceinline__ void ld16f(const float* p, float (&v)[16]) {
#pragma unroll
    for (int i = 0; i < 4; ++i) { const float4 t = ((const float4*)p)[i]; v[4 * i] = t.x; v[4 * i + 1] = t.y; v[4 * i + 2] = t.z; v[4 * i + 3] = t.w; }
}
__device__ __forceinline__ void st16f(float* p, const float (&v)[16]) {
#pragma unroll
    for (int i = 0; i < 4; ++i) ((float4*)p)[i] = make_float4(v[4 * i], v[4 * i + 1], v[4 * i + 2], v[4 * i + 3]);
}
__device__ __forceinline__ unsigned cvtpk2(float lo, float hi) { unsigned r; asm volatile("v_cvt_pk_bf16_f32 %0, %1, %2" : "=v"(r) : "v"(lo), "v"(hi)); return r; }
__device__ __forceinline__ void st16bf(bf16_t* p, const float (&v)[16]) {
    ((uint4*)p)[0] = make_uint4(cvtpk2(v[0], v[1]), cvtpk2(v[2], v[3]), cvtpk2(v[4], v[5]), cvtpk2(v[6], v[7]));
    ((uint4*)p)[1] = make_uint4(cvtpk2(v[8], v[9]), cvtpk2(v[10], v[11]), cvtpk2(v[12], v[13]), cvtpk2(v[14], v[15]));
}

__device__ __forceinline__ void st16f8(unsigned char* p, const float (&v)[16]) {
    int o[4];
#pragma unroll
    for (int j = 0; j < 4; ++j) { const int t = __builtin_amdgcn_cvt_pk_fp8_f32(v[4 * j], v[4 * j + 1], 0, false); o[j] = __builtin_amdgcn_cvt_pk_fp8_f32(v[4 * j + 2], v[4 * j + 3], t, true); }
    *(int4*)p = make_int4(o[0], o[1], o[2], o[3]);
}
#define XB_TMO      128
#define XB_XCNT(j)  (256  + 64 * (j))
#define XB_XSUB(j)  (1280 + 64 * (j))
#define XB_XGEN(j)  (2304 + 64 * (j))
#define XB_TOP      3328
#define XB_TOPGEN   3392
#define XCD_BAR_WORDS 3456
#define XB_SPIN_CAP (1u << 22)
__device__ __forceinline__ unsigned xb_ld(unsigned* p)              { return __hip_atomic_load(p, __ATOMIC_RELAXED, __HIP_MEMORY_SCOPE_AGENT); }
__device__ __forceinline__ unsigned xb_add(unsigned* p, unsigned v) { return __hip_atomic_fetch_add(p, v, __ATOMIC_RELAXED, __HIP_MEMORY_SCOPE_AGENT); }
__device__ __forceinline__ unsigned xb_xcc_id() { return (unsigned)__builtin_amdgcn_s_getreg((3 << 11) | 20) & 0xFu; }
#define XB_SPIN(cond, bar) do { unsigned _sp = 0; while (cond) { __builtin_amdgcn_s_sleep(1); \
    if ((++_sp & 255u) == 0u) { if (xb_ld(&(bar)[XB_TMO])) break; if (_sp > XB_SPIN_CAP) { atomicAdd(&(bar)[XB_TMO], 1u); break; } } } } while (0)
struct XcdBarrier { unsigned* bar; unsigned x; volatile LAS unsigned* st; };
__device__ __forceinline__ bool xb_is_leader(int wave0) { return wave0 == 0 && __builtin_amdgcn_mbcnt_hi(~0u, __builtin_amdgcn_mbcnt_lo(~0u, 0u)) == 0u; }
__device__ __forceinline__ XcdBarrier xcd_barrier_post(unsigned* bar, volatile LAS unsigned* st, int wave0) {
    XcdBarrier b; b.bar = bar; b.x = xb_xcc_id(); b.st = st;
    if (xb_is_leader(wave0)) (void)xb_add(&bar[XB_XCNT(b.x)], 1u);
    return b;
}
__device__ __forceinline__ void xcd_barrier_complete(unsigned* bar, unsigned x, unsigned& nloc, unsigned& nx) {
    const unsigned G = gridDim.x * gridDim.y * gridDim.z;
    unsigned sum, cnt, mine, sp = 0u;
    for (;;) {
        sum = 0u; cnt = 0u; mine = 0u;
#pragma unroll
        for (unsigned j = 0; j < 16; ++j) { const unsigned c = xb_ld(&bar[XB_XCNT(j)]); sum += c; cnt += (c > 0u) ? 1u : 0u; mine = (j == x) ? c : mine; }
        if (sum == G) break;
        __builtin_amdgcn_s_sleep(1);
        if ((++sp & 255u) == 0u) { if (xb_ld(&bar[XB_TMO])) break; if (sp > XB_SPIN_CAP) { atomicAdd(&bar[XB_TMO], 1u); break; } }
    }
    nloc = mine > 0u ? mine : 1u; nx = cnt > 0u ? cnt : 1u;
}
__device__ __forceinline__ void xcd_barrier(const XcdBarrier& b, int wave0) {
    asm volatile("s_waitcnt vmcnt(0)" ::: "memory");
    __syncthreads();
    if (xb_is_leader(wave0)) {
        unsigned* bar = b.bar;
        __builtin_amdgcn_s_waitcnt(0);
        unsigned nloc = b.st[0], nx = b.st[1];
        if (nloc == 0u) { xcd_barrier_complete(bar, b.x, nloc, nx); b.st[0] = nloc; b.st[1] = nx; }
        const unsigned old = xb_add(&bar[XB_XSUB(b.x)], 1u);
        const unsigned gen = old / nloc;
        if (old + 1u == (gen + 1u) * nloc) {
            __builtin_amdgcn_fence(__ATOMIC_RELEASE, "agent");
            asm volatile("s_waitcnt vmcnt(0)" ::: "memory");
            const unsigned og = xb_add(&bar[XB_TOP], 1u);
            const unsigned tg = og / nx;
            if (og + 1u == (tg + 1u) * nx) xb_add(&bar[XB_TOPGEN], 1u);
            else XB_SPIN(xb_ld(&bar[XB_TOPGEN]) == tg, bar);
            __builtin_amdgcn_fence(__ATOMIC_ACQUIRE, "agent");
            xb_add(&bar[XB_XGEN(b.x)], 1u);
            asm volatile("s_waitcnt vmcnt(0)" ::: "memory");
        } else {
            XB_SPIN(xb_ld(&bar[XB_XGEN(b.x)]) == gen, bar);
            __builtin_amdgcn_fence(__ATOMIC_ACQUIRE, "agent");
            asm volatile("s_waitcnt vmcnt(0)" ::: "memory");
        }
    }
    __syncthreads();
}


#ifndef FAST_GEMM
#define FAST_GEMM 1
#endif
namespace pg8 {
#define PG8_LAS __attribute__((address_space(3)))
typedef short bf16x8 __attribute__((ext_vector_type(8)));
typedef float f32x4 __attribute__((ext_vector_type(4)));
typedef unsigned u32x4 __attribute__((ext_vector_type(4)));
constexpr int BM = 256, BK = 64, HALF = 128, HTB = HALF * BK * 2  , STAGE_BYTES = 8 * HTB, NXCD = 8, WGM = 8;

__host__ __device__ __forceinline__ int lds_byte(int r, int c) { const int st = (r >> 4) * 2 + (c >> 5), rr = r & 15, cc = c & 31, ob = rr * 64 + cc * 2; return st * 1024 + (ob ^ (((ob >> 9) & 1) << 5)); }
__host__ __device__ __forceinline__ void stage_rc(int b, int& R, int& C) { const int st = b / 1024, sb = b % 1024, swz = sb ^ (((sb >> 9) & 1) << 5); R = (st >> 1) * 16 + swz / 64; C = (st & 1) * 32 + (swz % 64) / 2; }
__host__ __device__ __forceinline__ int perm32(int rho) { const int n = rho >> 4, i = rho & 15; return 8 * (i >> 2) + 4 * n + (i & 3); }


struct Unit { const char* a; const char* b; int pm, pn, aux; };
__device__ __forceinline__ unsigned cvt_pk_bf16(float lo, float hi) { unsigned r; asm volatile("v_cvt_pk_bf16_f32 %0, %1, %2" : "=v"(r) : "v"(lo), "v"(hi)); return r; }
typedef int v8i32 __attribute__((ext_vector_type(8)));
__device__ __forceinline__ v8i32 cat16(bf16x8 lo, bf16x8 hi) { typedef int v4i32 __attribute__((ext_vector_type(4))); const v4i32 a = __builtin_bit_cast(v4i32, lo), b = __builtin_bit_cast(v4i32, hi); return __builtin_shufflevector(a, b, 0, 1, 2, 3, 4, 5, 6, 7); }
template <class Epi, class Sched, bool ALIGN_EPI = false, bool SP2 = false, bool F8 = false>
__device__ __forceinline__ void gemm_phase(const int tid, PG8_LAS unsigned char* lds, const int K, const int lda, const Sched& S, const Epi& E) {
    const int wid = __builtin_amdgcn_readfirstlane(tid >> 6), lane = tid & 63, wr = wid >> 2, wc = wid & 3, fr = lane & 15, fq = lane >> 4;
    const int nt = F8 ? K / (2 * BK) : K / BK;
    unsigned voffA[2], voffB[2];
#pragma unroll
    for (int i = 0; i < 2; ++i) { int R, C; stage_rc(tid * 16 + i * 8192, R, C); const int Rb = Epi::PERM ? ((R & ~31) + perm32(R & 31)) : R;
        voffA[i] = F8 ? (unsigned)(R * lda + 2 * C) : (unsigned)(R * lda + C) * 2u; voffB[i] = F8 ? (unsigned)(Rb * K + 2 * C) : (unsigned)(Rb * K + C) * 2u; }
    const size_t kstep = (size_t)(BK * 2);
    const size_t hstepA = (size_t)HALF * lda * (F8 ? 1 : 2);
    const size_t hstep = (size_t)HALF * K * (F8 ? 1 : 2);
    const unsigned ldsbase = (unsigned)__builtin_amdgcn_readfirstlane((int)((unsigned)(uintptr_t)lds + (unsigned)wid * 1024u));
    const unsigned ldsw = (unsigned)wid * 1024u;
    const int aoff = lds_byte(wr * 64 + fr, fq * 8), boff = lds_byte(wc * 32 + fr, fq * 8);
#define PG8_SA(b, h) (((b) * 2 + (h)) * HTB)
#define PG8_SB(b, h) ((4 + (b) * 2 + (h)) * HTB)
#define PG8_STAGE(bufoff, gbase, voff) do { _Pragma("unroll") for (int _i = 0; _i < 2; ++_i) { \
        if constexpr (F8) { unsigned keep_; asm volatile("s_mov_b32 %0, m0\n\ts_mov_b32 m0, %3\n\ts_nop 0\n\tglobal_load_lds_dwordx4 %1, %2\n\ts_mov_b32 m0, %0" : "=&s"(keep_) : "v"((voff)[_i]), "s"((const char*)(gbase)), "s"(ldsbase + (unsigned)((bufoff) + _i * 8192)) : "memory"); } \
        else __builtin_amdgcn_global_load_lds((const unsigned*)((const char*)(gbase) + (voff)[_i]), (PG8_LAS unsigned*)(lds + (bufoff) + ldsw + _i * 8192), 16, 0, 0); } } while (0)
#define PG8_LDA(dst, b, h) do { _Pragma("unroll") for (int m = 0; m < 4; ++m) { _Pragma("unroll") for (int k = 0; k < 2; ++k) dst[m][k] = *(const PG8_LAS bf16x8*)(lds + PG8_SA(b, h) + aoff + m * 2048 + k * 1024); \
        if constexpr (F8) dst##8[m] = cat16(dst[m][0], dst[m][1]); } } while (0)
#define PG8_LDB(dst, b, h) do { _Pragma("unroll") for (int n = 0; n < 2; ++n) { _Pragma("unroll") for (int k = 0; k < 2; ++k) dst[n][k] = *(const PG8_LAS bf16x8*)(lds + PG8_SB(b, h) + boff + n * 2048 + k * 1024); \
        if constexpr (F8) dst##8[n] = cat16(dst[n][0], dst[n][1]); } } while (0)
#define PG8_MMA(ai, bj, At, Bt) do { __builtin_amdgcn_s_setprio(1); _Pragma("unroll") for (int m = 0; m < 4; ++m) _Pragma("unroll") for (int n = 0; n < 2; ++n) { \
        if constexpr (F8) acc[ai][bj][m][n] = __builtin_amdgcn_mfma_scale_f32_16x16x128_f8f6f4(Bt##8[n], At##8[m], acc[ai][bj][m][n], 0, 0, 0, 0x7f7f7f7f, 0, 0x7f7f7f7f); \
        else { _Pragma("unroll") for (int k = 0; k < 2; ++k) acc[ai][bj][m][n] = __builtin_amdgcn_mfma_f32_16x16x32_bf16(Bt[n][k], At[m][k], acc[ai][bj][m][n], 0, 0, 0); } } __builtin_amdgcn_s_setprio(0); } while (0)
#define PG8_WAIT_V(n) asm volatile("s_waitcnt vmcnt(" #n ")" ::: "memory")
#define PG8_WAIT_L(n) asm volatile("s_waitcnt lgkmcnt(" #n ")" ::: "memory")
#define PG8_BAR __builtin_amdgcn_s_barrier()
#define PG8_SCHED __builtin_amdgcn_sched_barrier(0)
    Unit cur, nxt; int ui = 0;
    if (!S.next(0, cur)) return;
    f32x4 acc[2][2][4][2];
#pragma unroll
    for (int a = 0; a < 2; ++a)
#pragma unroll
        for (int b = 0; b < 2; ++b)
#pragma unroll
            for (int m = 0; m < 4; ++m)
#pragma unroll
                for (int n = 0; n < 2; ++n) acc[a][b][m][n] = (f32x4){0.f, 0.f, 0.f, 0.f};
    bf16x8 At[4][2], B0[2][2], B1[2][2]; v8i32 At8[4], B08[2], B18[2]; (void)At8; (void)B08; (void)B18;
    const char* cA = cur.a; const char* cB = cur.b;
    S.a_ready(cur);
    if constexpr (SP2) {
        PG8_STAGE(PG8_SB(0, 0), cB, voffB); PG8_STAGE(PG8_SB(0, 1), cB + hstep, voffB); PG8_STAGE(PG8_SA(0, 0), cA, voffA); PG8_STAGE(PG8_SA(0, 1), cA + hstepA, voffA);
        if (wr == 1) PG8_BAR;
        PG8_WAIT_V(2); PG8_BAR;
        PG8_STAGE(PG8_SB(1, 0), cB + kstep, voffB); PG8_STAGE(PG8_SA(1, 0), cA + kstep, voffA); PG8_STAGE(PG8_SB(1, 1), cB + hstep + kstep, voffB);
        PG8_WAIT_V(6); PG8_BAR;
    } else {
        PG8_STAGE(PG8_SB(0, 0), cB, voffB); PG8_STAGE(PG8_SA(0, 0), cA, voffA); PG8_STAGE(PG8_SB(0, 1), cB + hstep, voffB); PG8_STAGE(PG8_SA(0, 1), cA + hstepA, voffA);
        if (wr == 1) PG8_BAR;
        PG8_WAIT_V(4); PG8_BAR;
        PG8_STAGE(PG8_SB(1, 0), cB + kstep, voffB); PG8_STAGE(PG8_SA(1, 0), cA + kstep, voffA); PG8_STAGE(PG8_SB(1, 1), cB + hstep + kstep, voffB);
        PG8_WAIT_V(6); PG8_BAR;
    }
    for (;;) {
        const bool has_next = S.next(ui + 1, nxt);
        const char* nA = has_next ? nxt.a : cA; const char* nB = has_next ? nxt.b : cB;
#pragma unroll 1
        for (int t = 0; t < nt; t += 2) {
            const bool last = (t == nt - 2);
            const char* a1 = cA + (size_t)(t + 1) * kstep;
            const char* a2 = last ? nA : cA + (size_t)(t + 2) * kstep; const char* b2 = last ? nB : cB + (size_t)(t + 2) * kstep;
            const char* a3 = a2 + kstep; const char* b3 = b2 + kstep;
            if (last && has_next) S.a_ready(nxt);
            if constexpr (SP2) {
            PG8_LDB(B0, 0, 0); PG8_LDB(B1, 0, 1); PG8_SCHED; PG8_LDA(At, 0, 0); PG8_STAGE(PG8_SA(1, 1), a1 + hstepA, voffA);
            PG8_WAIT_V(8); PG8_WAIT_L(0); PG8_BAR; PG8_MMA(0, 0, At, B0); PG8_MMA(0, 1, At, B1); PG8_BAR; PG8_SCHED;
            PG8_LDA(At, 0, 1); PG8_STAGE(PG8_SB(0, 0), b2, voffB); PG8_STAGE(PG8_SB(0, 1), b2 + hstep, voffB); PG8_STAGE(PG8_SA(0, 0), a2, voffA);
            PG8_WAIT_V(8); PG8_WAIT_L(0); PG8_BAR; PG8_MMA(1, 0, At, B0); PG8_MMA(1, 1, At, B1); PG8_BAR; PG8_SCHED;
            PG8_LDB(B0, 1, 0); PG8_LDB(B1, 1, 1); PG8_SCHED; PG8_LDA(At, 1, 0); PG8_STAGE(PG8_SA(0, 1), a2 + hstepA, voffA);
            PG8_WAIT_V(8); PG8_WAIT_L(0); PG8_BAR; PG8_MMA(0, 0, At, B0); PG8_MMA(0, 1, At, B1); PG8_BAR; PG8_SCHED;
            PG8_LDA(At, 1, 1); PG8_STAGE(PG8_SB(1, 0), b3, voffB); PG8_STAGE(PG8_SB(1, 1), b3 + hstep, voffB); PG8_STAGE(PG8_SA(1, 0), a3, voffA);
            PG8_WAIT_V(8); PG8_WAIT_L(0); PG8_BAR; PG8_MMA(1, 0, At, B0); PG8_MMA(1, 1, At, B1); PG8_BAR; PG8_SCHED;
            } else {
            PG8_LDB(B0, 0, 0); PG8_SCHED; PG8_LDA(At, 0, 0); PG8_STAGE(PG8_SA(1, 1), a1 + hstepA, voffA);
            PG8_WAIT_L(8); PG8_BAR; PG8_WAIT_L(0); PG8_MMA(0, 0, At, B0); PG8_BAR; PG8_SCHED;
            PG8_LDB(B1, 0, 1); PG8_STAGE(PG8_SB(0, 0), b2, voffB);
            PG8_BAR; PG8_WAIT_L(0); PG8_MMA(0, 1, At, B1); PG8_BAR;
            PG8_LDA(At, 0, 1); PG8_STAGE(PG8_SA(0, 0), a2, voffA);
            PG8_BAR; PG8_WAIT_L(0); PG8_MMA(1, 0, At, B0); PG8_BAR; PG8_SCHED;
            PG8_STAGE(PG8_SB(0, 1), b2 + hstep, voffB);
            PG8_WAIT_V(6); PG8_BAR; PG8_MMA(1, 1, At, B1); PG8_BAR;
            PG8_LDB(B0, 1, 0); PG8_SCHED; PG8_LDA(At, 1, 0); PG8_STAGE(PG8_SA(0, 1), a2 + hstepA, voffA);
            PG8_WAIT_L(8); PG8_BAR; PG8_WAIT_L(0); PG8_MMA(0, 0, At, B0); PG8_BAR; PG8_SCHED;
            PG8_LDB(B1, 1, 1); PG8_STAGE(PG8_SB(1, 0), b3, voffB);
            PG8_BAR; PG8_WAIT_L(0); PG8_MMA(0, 1, At, B1); PG8_BAR;
            PG8_LDA(At, 1, 1); PG8_STAGE(PG8_SA(1, 0), a3, voffA);
            PG8_BAR; PG8_WAIT_L(0); PG8_MMA(1, 0, At, B0); PG8_BAR; PG8_SCHED;
            PG8_STAGE(PG8_SB(1, 1), b3 + hstep, voffB);
            PG8_WAIT_V(6); PG8_BAR; PG8_MMA(1, 1, At, B1); PG8_BAR;
            }
        }
        if constexpr (ALIGN_EPI) { if (wr == 0) PG8_BAR; }
        if constexpr (!Epi::AFTER_DRAIN) { int tl_ = tid; asm volatile("" : "+v"(tl_)); E(acc, cur, wr, wc, tl_ & 15, (tl_ & 63) >> 4); S.done(cur); }
        if (!has_next) break;
#pragma unroll
        for (int a = 0; a < 2; ++a)
#pragma unroll
            for (int b = 0; b < 2; ++b)
#pragma unroll
                for (int m = 0; m < 4; ++m)
#pragma unroll
                    for (int n = 0; n < 2; ++n) acc[a][b][m][n] = (f32x4){0.f, 0.f, 0.f, 0.f};
        cur = nxt; cA = nA; cB = nB; ++ui;
        if constexpr (ALIGN_EPI) { if (wr == 1) PG8_BAR; }
    }
    PG8_WAIT_V(0);
    if constexpr (!ALIGN_EPI) { if (wr == 0) PG8_BAR; }
    PG8_BAR;
    if constexpr (Epi::AFTER_DRAIN) { E.fused(acc, cur, wr, wc, fr, fq, lds, wid, lane); S.done(cur); }
#undef PG8_SA
#undef PG8_SB
#undef PG8_STAGE
#undef PG8_LDA
#undef PG8_LDB
#undef PG8_MMA
#undef PG8_WAIT_V
#undef PG8_WAIT_L
#undef PG8_BAR
#undef PG8_SCHED
}
}
namespace pg8 {
struct OrderMap {
    __device__ __forceinline__ static bool map(int i, int G, int c, int nM, int nN, int& pm, int& pn) {
        const int nwg = nM * nN; const long L = (long)i * G + c; if (L >= nwg) return false;
        int wgid = (int)L; { const int q = nwg / NXCD, r = nwg % NXCD, xcd = wgid % NXCD, off = wgid / NXCD; wgid = (xcd < r ? xcd * (q + 1) : r * (q + 1) + (xcd - r) * q) + off; }
        const int nig = WGM * nN, gid = wgid / nig, fm = gid * WGM, gsz = (nM - fm) < WGM ? (nM - fm) : WGM;
        pm = fm + ((wgid % nig) % gsz); pn = (wgid % nig) / gsz; return true;
    }
};
struct DenseOrder {
    const char* A; const char* B; int nM, nN, G, c; size_t tstepA, tstepB;
    __device__ __forceinline__ bool next(int i, Unit& u) const { int pm, pn; if (!OrderMap::map(i, G, c, nM, nN, pm, pn)) return false; u.pm = pm; u.pn = pn; u.aux = 0; u.a = A + (size_t)pm * tstepA; u.b = B + (size_t)pn * tstepB; return true; }
    __device__ __forceinline__ void a_ready(const Unit&) const {}
    __device__ __forceinline__ void done(const Unit&) const {}
};
struct MoeOrder {
    const char* A; const char* B; const PG8_LAS int* tile_e; int nM, nN, G, c; size_t tstep, estep;
    __device__ __forceinline__ bool next(int i, Unit& u) const { int pm, pn; if (!OrderMap::map(i, G, c, nM, nN, pm, pn)) return false; const int e = __builtin_amdgcn_readfirstlane(tile_e[pm]); u.pm = pm; u.pn = pn; u.aux = e;
        u.a = A + (size_t)pm * tstep; u.b = B + (size_t)e * estep + (size_t)pn * tstep; return true; }
    __device__ __forceinline__ void a_ready(const Unit&) const {}
    __device__ __forceinline__ void done(const Unit&) const {}
};
struct EpiStoreBf16 { static constexpr bool PERM = true, AFTER_DRAIN = false;
    bf16_t* O; int ldc; float ascale;
    __device__ __forceinline__ void operator()(const f32x4 (&acc)[2][2][4][2], const Unit& u, int wr, int wc, int fr, int fq) const {
        bf16_t* base = O + (size_t)(u.pm * BM + wr * 64 + fr) * ldc + u.pn * BM + wc * 32 + 8 * fq;
        float asc = ascale; asm volatile("" : "+v"(asc));
#pragma unroll
        for (int ai = 0; ai < 2; ++ai)
#pragma unroll
            for (int m = 0; m < 4; ++m) { bf16_t* rowp = base + (size_t)(ai * HALF + m * 16) * ldc;
#pragma unroll
                for (int bj = 0; bj < 2; ++bj) { const f32x4 v0 = acc[ai][bj][m][0] * asc, v1 = acc[ai][bj][m][1] * asc; u32x4 w;
                    w.x = cvt_pk_bf16(v0[0], v0[1]); w.y = cvt_pk_bf16(v0[2], v0[3]); w.z = cvt_pk_bf16(v1[0], v1[1]); w.w = cvt_pk_bf16(v1[2], v1[3]);
                    *(u32x4*)(rowp + bj * HALF) = w; } }
    }
};
struct EpiScaleBf16 { static constexpr bool PERM = true, AFTER_DRAIN = false;
    bf16_t* O; int ldc; const float* rs;
    __device__ __forceinline__ void operator()(const f32x4 (&acc)[2][2][4][2], const Unit& u, int wr, int wc, int fr, int fq) const {
        const int row0 = u.pm * BM + wr * 64 + fr; bf16_t* base = O + (size_t)row0 * ldc + u.pn * BM + wc * 32 + 8 * fq;
#pragma unroll
        for (int ai = 0; ai < 2; ++ai)
#pragma unroll
            for (int m = 0; m < 4; ++m) { bf16_t* rowp = base + (size_t)(ai * HALF + m * 16) * ldc; const float sc = rs[2 * (row0 + ai * HALF + m * 16)];
#pragma unroll
                for (int bj = 0; bj < 2; ++bj) { const f32x4 v0 = acc[ai][bj][m][0] * sc, v1 = acc[ai][bj][m][1] * sc; u32x4 w;
                    w.x = cvt_pk_bf16(v0[0], v0[1]); w.y = cvt_pk_bf16(v0[2], v0[3]); w.z = cvt_pk_bf16(v1[0], v1[1]); w.w = cvt_pk_bf16(v1[2], v1[3]);
                    *(u32x4*)(rowp + bj * HALF) = w; } }
    }
};
struct EpiResid { static constexpr bool PERM = true, AFTER_DRAIN = false;
    const float* src_lat; const float* src_ctx; float* out; const float* mod_g1; float ascale;
    __device__ __forceinline__ void operator()(const f32x4 (&acc)[2][2][4][2], const Unit& u, int wr, int wc, int fr, int fq) const {
        const int row_t = u.pm * BM; const int mrow = row_t < NLAT ? row_t / SEQ : NB;
        const float* g = mod_g1 + (size_t)mrow * 6144 + u.pn * BM + wc * 32 + 8 * fq;
        const float* sb = (row_t < NLAT ? src_lat + (size_t)row_t * 1024 : src_ctx + (size_t)(row_t - NLAT) * 1024) + u.pn * BM + wc * 32 + 8 * fq;
        float* ob = out + (size_t)row_t * 1024 + u.pn * BM + wc * 32 + 8 * fq;
        f32x4 gv[2][2];
#pragma unroll
        for (int bj = 0; bj < 2; ++bj)
#pragma unroll
            for (int n = 0; n < 2; ++n) gv[bj][n] = *(const f32x4*)(g + bj * HALF + 4 * n) * ascale;
#pragma unroll
        for (int ai = 0; ai < 2; ++ai)
#pragma unroll
            for (int m = 0; m < 4; ++m) { const size_t off = (size_t)(wr * 64 + fr + ai * HALF + m * 16) * 1024;
#pragma unroll
                for (int bj = 0; bj < 2; ++bj)
#pragma unroll
                    for (int n = 0; n < 2; ++n) { const f32x4 sv = *(const f32x4*)(sb + off + bj * HALF + 4 * n); *(f32x4*)(ob + off + bj * HALF + 4 * n) = sv + gv[bj][n] * acc[ai][bj][m][n]; }
                asm volatile("" ::: "memory"); }
    }
};
__device__ __forceinline__ float swiglu1(float g, float l, float c7, float cn) {
    const float glu = fminf(g, c7), lin = fminf(fmaxf(l, -c7), c7);
    const float sg = __builtin_amdgcn_rcpf(1.0f + __builtin_amdgcn_exp2f(cn * glu));
    return glu * sg * (lin + 1.0f);
}
struct EpiSwiglu { static constexpr bool PERM = true, AFTER_DRAIN = false;
    bf16_t* O; const float* bias; float ascale;
    __device__ __forceinline__ void operator()(const f32x4 (&acc)[2][2][4][2], const Unit& u, int wr, int wc, int fr, int fq) const {
        const int col0 = u.pn * BM + wc * 32 + 8 * fq; const float* b = bias + (size_t)u.aux * 2048 + col0;
        float c7 = 7.0f, cn = -1.702f * 1.4426950408889634f; asm volatile("" : "+v"(c7), "+v"(cn));
        bf16_t* base = O + (size_t)(u.pm * BM + wr * 64 + fr) * 1024 + (col0 >> 1);
        f32x4 bv[2][2];
#pragma unroll
        for (int bj = 0; bj < 2; ++bj)
#pragma unroll
            for (int n = 0; n < 2; ++n) bv[bj][n] = *(const f32x4*)(b + bj * HALF + 4 * n);
#pragma unroll
        for (int ai = 0; ai < 2; ++ai)
#pragma unroll
            for (int m = 0; m < 4; ++m) { bf16_t* rowp = base + (size_t)(ai * HALF + m * 16) * 1024;
#pragma unroll
                for (int bj = 0; bj < 2; ++bj) { const f32x4 v0 = acc[ai][bj][m][0] * ascale + bv[bj][0], v1 = acc[ai][bj][m][1] * ascale + bv[bj][1];
                    uint2 w; w.x = cvt_pk_bf16(swiglu1(v0[0], v0[1], c7, cn), swiglu1(v0[2], v0[3], c7, cn)); w.y = cvt_pk_bf16(swiglu1(v1[0], v1[1], c7, cn), swiglu1(v1[2], v1[3], c7, cn));
                    *(uint2*)(rowp + bj * (HALF / 2)) = w; } }
    }
};
struct EpiSwigluF8 { static constexpr bool PERM = true, AFTER_DRAIN = false;
    unsigned char* O; const float* bias;
    __device__ __forceinline__ void operator()(const f32x4 (&acc)[2][2][4][2], const Unit& u, int wr, int wc, int fr, int fq) const {
        const int col0 = u.pn * BM + wc * 32 + 8 * fq; const float* b = bias + (size_t)u.aux * 2048 + col0;
        float c7 = 7.0f, cn = -1.702f * 1.4426950408889634f, c32 = 0.03125f; asm volatile("" : "+v"(c7), "+v"(cn), "+v"(c32));
        unsigned char* base = O + (size_t)(u.pm * BM + wr * 64 + fr) * 1024 + (col0 >> 1);
        f32x4 bv[2][2];
#pragma unroll
        for (int bj = 0; bj < 2; ++bj)
#pragma unroll
            for (int n = 0; n < 2; ++n) bv[bj][n] = *(const f32x4*)(b + bj * HALF + 4 * n);
#pragma unroll
        for (int ai = 0; ai < 2; ++ai)
#pragma unroll
            for (int m = 0; m < 4; ++m) { unsigned char* rowp = base + (size_t)(ai * HALF + m * 16) * 1024;
#pragma unroll
                for (int bj = 0; bj < 2; ++bj) { const f32x4 v0 = acc[ai][bj][m][0] * c32 + bv[bj][0], v1 = acc[ai][bj][m][1] * c32 + bv[bj][1];
                    int w = __builtin_amdgcn_cvt_pk_fp8_f32(swiglu1(v0[0], v0[1], c7, cn), swiglu1(v0[2], v0[3], c7, cn), 0, false); w = __builtin_amdgcn_cvt_pk_fp8_f32(swiglu1(v1[0], v1[1], c7, cn), swiglu1(v1[2], v1[3], c7, cn), w, true);
                    *(int*)(rowp + bj * (HALF / 2)) = w; } }
    }
};
struct EpiBiasF8 { static constexpr bool PERM = true, AFTER_DRAIN = false;
    unsigned char* O; const float* bias; float ascale;
    __device__ __forceinline__ void operator()(const f32x4 (&acc)[2][2][4][2], const Unit& u, int wr, int wc, int fr, int fq) const {
        const int col0 = u.pn * BM + wc * 32 + 8 * fq; const float* b = bias + (size_t)u.aux * 1024 + col0;
        float asc = ascale; asm volatile("" : "+v"(asc));
        unsigned char* base = O + (size_t)(u.pm * BM + wr * 64 + fr) * 1024 + col0;
        f32x4 bv[2][2];
#pragma unroll
        for (int bj = 0; bj < 2; ++bj)
#pragma unroll
            for (int n = 0; n < 2; ++n) bv[bj][n] = *(const f32x4*)(b + bj * HALF + 4 * n);
#pragma unroll
        for (int ai = 0; ai < 2; ++ai)
#pragma unroll
            for (int m = 0; m < 4; ++m) { unsigned char* rowp = base + (size_t)(ai * HALF + m * 16) * 1024;
#pragma unroll
                for (int bj = 0; bj < 2; ++bj) { const f32x4 v0 = acc[ai][bj][m][0] * asc + bv[bj][0], v1 = acc[ai][bj][m][1] * asc + bv[bj][1];
                    int lo = __builtin_amdgcn_cvt_pk_fp8_f32(v0[0], v0[1], 0, false); lo = __builtin_amdgcn_cvt_pk_fp8_f32(v0[2], v0[3], lo, true);
                    int hi = __builtin_amdgcn_cvt_pk_fp8_f32(v1[0], v1[1], 0, false); hi = __builtin_amdgcn_cvt_pk_fp8_f32(v1[2], v1[3], hi, true);
                    *(int2*)(rowp + bj * HALF) = make_int2(lo, hi); } }
    }
};
struct EpiBiasBf16 { static constexpr bool PERM = true, AFTER_DRAIN = false;
    bf16_t* O; const float* bias; float ascale;
    __device__ __forceinline__ void operator()(const f32x4 (&acc)[2][2][4][2], const Unit& u, int wr, int wc, int fr, int fq) const {
        const int col0 = u.pn * BM + wc * 32 + 8 * fq; const float* b = bias + (size_t)u.aux * 1024 + col0;
        float asc = ascale; asm volatile("" : "+v"(asc));
        bf16_t* base = O + (size_t)(u.pm * BM + wr * 64 + fr) * 1024 + col0;
        f32x4 bv[2][2];
#pragma unroll
        for (int bj = 0; bj < 2; ++bj)
#pragma unroll
            for (int n = 0; n < 2; ++n) bv[bj][n] = *(const f32x4*)(b + bj * HALF + 4 * n);
#pragma unroll
        for (int ai = 0; ai < 2; ++ai)
#pragma unroll
            for (int m = 0; m < 4; ++m) { bf16_t* rowp = base + (size_t)(ai * HALF + m * 16) * 1024;
#pragma unroll
                for (int bj = 0; bj < 2; ++bj) { const f32x4 v0 = acc[ai][bj][m][0] * asc + bv[bj][0], v1 = acc[ai][bj][m][1] * asc + bv[bj][1]; u32x4 w;
                    w.x = cvt_pk_bf16(v0[0], v0[1]); w.y = cvt_pk_bf16(v0[2], v0[3]); w.z = cvt_pk_bf16(v1[0], v1[1]); w.w = cvt_pk_bf16(v1[2], v1[3]);
                    *(u32x4*)(rowp + bj * HALF) = w; } }
    }
};
}
__device__ __forceinline__ unsigned pk2(float lo, float hi) { return (unsigned)f2bf(lo) | ((unsigned)f2bf(hi) << 16); }
__device__ __forceinline__ void transpose_item(const float* __restrict__ W, int K, int N, bf16_t* __restrict__ WT, LAS float* scr, int item, int lane, const float* rowscale = nullptr, float cscale = 1.0f, int cs_ncols = 1 << 30) {
    const int nblk = N / 32, kb = item / nblk, nb = item % nblk, k0 = 64 * kb, n0 = 32 * nb;
    const float cs = n0 < cs_ncols ? cscale : 1.0f;
#pragma unroll 8
    for (int i = 0; i < 32; ++i) { const int kk = 2 * i + (lane >> 5); float w = W[(size_t)(k0 + kk) * N + n0 + (lane & 31)]; if (rowscale) w *= rowscale[k0 + kk]; scr[kk * 33 + (lane & 31)] = w * cs; }
    asm volatile("s_waitcnt lgkmcnt(0)" ::: "memory");
    const int c = lane & 7;
#pragma unroll
    for (int j = 0; j < 4; ++j) { const int n = (lane >> 3) + 8 * j; const LAS float* sp = scr + (8 * c) * 33 + n;
        uint4 o; o.x = pk2(sp[0 * 33], sp[1 * 33]); o.y = pk2(sp[2 * 33], sp[3 * 33]); o.z = pk2(sp[4 * 33], sp[5 * 33]); o.w = pk2(sp[6 * 33], sp[7 * 33]);
        *(uint4*)(WT + (size_t)(n0 + n) * K + k0 + 8 * c) = o; }
    asm volatile("s_waitcnt lgkmcnt(0)" ::: "memory");
}

__device__ __forceinline__ void transpose_item_f8(const float* __restrict__ W, int K, int N, unsigned char* __restrict__ WT, LAS float* scr, int item, int lane, float cscale = 1.0f, int cs_ncols = 1 << 30) {
    const int nblk = N / 32, kb = item / nblk, nb = item % nblk, k0 = 64 * kb, n0 = 32 * nb;
    const float cs = 32.0f * (n0 < cs_ncols ? cscale : 1.0f);
#pragma unroll 8
    for (int i = 0; i < 32; ++i) { const int kk = 2 * i + (lane >> 5); scr[kk * 33 + (lane & 31)] = W[(size_t)(k0 + kk) * N + n0 + (lane & 31)] * cs; }
    asm volatile("s_waitcnt lgkmcnt(0)" ::: "memory");
    const int c = lane & 7;
#pragma unroll
    for (int j = 0; j < 4; ++j) { const int n = (lane >> 3) + 8 * j; const LAS float* sp = scr + (8 * c) * 33 + n;
        int lo = __builtin_amdgcn_cvt_pk_fp8_f32(sp[0 * 33], sp[1 * 33], 0, false); lo = __builtin_amdgcn_cvt_pk_fp8_f32(sp[2 * 33], sp[3 * 33], lo, true);
        int hi = __builtin_amdgcn_cvt_pk_fp8_f32(sp[4 * 33], sp[5 * 33], 0, false); hi = __builtin_amdgcn_cvt_pk_fp8_f32(sp[6 * 33], sp[7 * 33], hi, true);
        *(int2*)(WT + (size_t)(n0 + n) * K + k0 + 8 * c) = make_int2(lo, hi); }
    asm volatile("s_waitcnt lgkmcnt(0)" ::: "memory");
}
template <bool F8OUT>
__device__ __forceinline__ void transpose_item64(const float* __restrict__ W, int K, int N, void* __restrict__ WT, LAS float* scr, int item, int lane, const float* rowscale = nullptr, float cscale = 1.0f) {
    const int nblk = N / 64, kb = item / nblk, nb = item % nblk, k0 = 64 * kb, n0 = 64 * nb;
    const float cs = cscale * (F8OUT ? 32.0f : 1.0f);
    float4 wv[16];
#pragma unroll
    for (int i = 0; i < 16; ++i) wv[i] = *(const float4*)(W + (size_t)(k0 + 4 * i + (lane >> 4)) * N + n0 + 4 * (lane & 15));
#pragma unroll
    for (int i = 0; i < 16; ++i) { const int kk = 4 * i + (lane >> 4); const float4 w = wv[i];
        const float rs = rowscale ? rowscale[k0 + kk] * cs : cs; LAS float* d = scr + kk * 65 + 4 * (lane & 15); d[0] = w.x * rs; d[1] = w.y * rs; d[2] = w.z * rs; d[3] = w.w * rs; }
    asm volatile("s_waitcnt lgkmcnt(0)" ::: "memory");
    const int c = lane & 7;
#pragma unroll
    for (int j = 0; j < 8; ++j) { const int n = (lane >> 3) + 8 * j; const LAS float* sp = scr + (8 * c) * 65 + n;
        if constexpr (F8OUT) { int lo = __builtin_amdgcn_cvt_pk_fp8_f32(sp[0 * 65], sp[1 * 65], 0, false); lo = __builtin_amdgcn_cvt_pk_fp8_f32(sp[2 * 65], sp[3 * 65], lo, true);
            int hi = __builtin_amdgcn_cvt_pk_fp8_f32(sp[4 * 65], sp[5 * 65], 0, false); hi = __builtin_amdgcn_cvt_pk_fp8_f32(sp[6 * 65], sp[7 * 65], hi, true);
            *(int2*)((unsigned char*)WT + (size_t)(n0 + n) * K + k0 + 8 * c) = make_int2(lo, hi); }
        else { uint4 o; o.x = pk2(sp[0 * 65], sp[1 * 65]); o.y = pk2(sp[2 * 65], sp[3 * 65]); o.z = pk2(sp[4 * 65], sp[5 * 65]); o.w = pk2(sp[6 * 65], sp[7 * 65]);
            *(uint4*)((bf16_t*)WT + (size_t)(n0 + n) * K + k0 + 8 * c) = o; } }
    asm volatile("s_waitcnt lgkmcnt(0)" ::: "memory");
}
namespace fa {
using bf16x8 = __attribute__((ext_vector_type(8))) short;
using s16x4  = __attribute__((ext_vector_type(4))) short;
using f32x16 = __attribute__((ext_vector_type(16))) float;
using u32x4  = __attribute__((ext_vector_type(4))) unsigned;
constexpr int QBLK = 32, KVBLK = 64, NW = 8;
constexpr int SHM_V = KVBLK * 128 * 2, SHM_K = KVBLK * 128 * 2, SHM_ATTN = 2 * SHM_V + 2 * SHM_K + NW * 64 * 4;
constexpr float LOG2E = 1.4426950408889634f, THR = 8.0f, NEGS = -1.0e30f;
#define FA_KSWZ(row, colB) ((row) * 256 + ((colB) ^ (((row) & 7) << 4)))
#define FA_SBAR() __builtin_amdgcn_sched_barrier(0)
__device__ __forceinline__ int crow(int r, int hi) { return (r & 3) + 8 * (r >> 2) + 4 * hi; }
__device__ __forceinline__ unsigned cvtpk(float lo, float hi) { unsigned r; asm volatile("v_cvt_pk_bf16_f32 %0, %1, %2" : "=v"(r) : "v"(lo), "v"(hi)); return r; }
__device__ __forceinline__ void partialSM(f32x16& p0, f32x16& p1, float& m_reg, float& mn, float& alpha) {
  float pmax = p0[0];
#pragma unroll
  for (int r = 1; r < 16; ++r) pmax = fmaxf(pmax, p0[r]);
#pragma unroll
  for (int r = 0; r < 16; ++r) pmax = fmaxf(pmax, p1[r]);
  { auto rr = __builtin_amdgcn_permlane32_swap(__float_as_uint(pmax), __float_as_uint(pmax), false, false);
    pmax = fmaxf(__uint_as_float(rr[0]), __uint_as_float(rr[1])); }
  if (__builtin_expect(__all(pmax - m_reg <= THR), 1)) { mn = m_reg; alpha = 1.f; }
  else { mn = fmaxf(m_reg, pmax); alpha = __builtin_amdgcn_exp2f((m_reg - mn) * LOG2E); m_reg = mn; }
  const float mnC = -mn * LOG2E;
#pragma unroll
  for (int r = 0; r < 16; ++r) p0[r] = fmaf(p0[r], LOG2E, mnC);
#pragma unroll
  for (int r = 0; r < 16; ++r) p1[r] = fmaf(p1[r], LOG2E, mnC);
#pragma unroll
  for (int r = 0; r < 16; ++r) p0[r] = __builtin_amdgcn_exp2f(p0[r]);
}
__device__ __forceinline__ void finishSM(f32x16& p0, f32x16& p1, float alpha, float& l_reg, bf16x8& pa0, bf16x8& pa1, bf16x8& pa2, bf16x8& pa3) {
#pragma unroll
  for (int r = 0; r < 16; ++r) p1[r] = __builtin_amdgcn_exp2f(p1[r]);
  float ps = 0;
#pragma unroll
  for (int r = 0; r < 16; ++r) ps += p0[r];
#pragma unroll
  for (int r = 0; r < 16; ++r) ps += p1[r];
  { auto rr = __builtin_amdgcn_permlane32_swap(__float_as_uint(ps), __float_as_uint(ps), false, false);
    ps = __uint_as_float(rr[0]) + __uint_as_float(rr[1]); }
  l_reg = l_reg * alpha + ps;
#define FA_PK4(P, BASE, OUT) do { unsigned a0 = cvtpk(P[BASE + 0], P[BASE + 1]), a1 = cvtpk(P[BASE + 2], P[BASE + 3]);   \
    unsigned b0 = cvtpk(P[BASE + 4], P[BASE + 5]), b1 = cvtpk(P[BASE + 6], P[BASE + 7]);                              \
    auto r0 = __builtin_amdgcn_permlane32_swap(a0, b0, false, false); auto r1 = __builtin_amdgcn_permlane32_swap(a1, b1, false, false); \
    u32x4 w = {r0[0], r1[0], r0[1], r1[1]}; OUT = *reinterpret_cast<bf16x8*>(&w); } while (0)
  FA_PK4(p0, 0, pa0); FA_PK4(p0, 8, pa1); FA_PK4(p1, 0, pa2); FA_PK4(p1, 8, pa3);
#undef FA_PK4
}
template <int NQ> __device__ __forceinline__ void qkt(f32x16& p0, f32x16& p1, const char* Ks, const bf16x8* qr, int r32, int hi) {
  p0 = f32x16{}; p1 = f32x16{};
#pragma unroll
  for (int d0 = 0; d0 < NQ; ++d0) { const int cb = (d0 * 16 + hi * 8) * 2;
    const bf16x8 b0 = *reinterpret_cast<const bf16x8*>(Ks + FA_KSWZ(r32, cb));
    const bf16x8 b1 = *reinterpret_cast<const bf16x8*>(Ks + FA_KSWZ(32 + r32, cb));
    p0 = __builtin_amdgcn_mfma_f32_32x32x16_bf16(b0, qr[d0], p0, 0, 0, 0);
    p1 = __builtin_amdgcn_mfma_f32_32x32x16_bf16(b1, qr[d0], p1, 0, 0, 0); }
}
__device__ __forceinline__ int v_st(int k, int c) { const int kk = (k & ~0xC) | ((k & 4) << 1) | ((k & 8) >> 1); return ((kk >> 3) * 4 + (c >> 5)) * 512 + ((kk & 7) * 32 + (c & 31)) * 2; }
__device__ __forceinline__ int v_rd_base(int lane) { return ((lane & 3) << 3) | (((lane >> 2) & 3) << 6) | (((lane >> 4) & 1) << 5) | (((lane >> 5) & 1) << 8); }
constexpr int v_rd_off(int d0, int ks, int half) { return d0 * 512 + ks * 4096 + half * 2048; }
template <int OFF> __device__ __forceinline__ s16x4 tr_read(int vb) {
  s16x4 r; asm volatile("ds_read_b64_tr_b16 %0, %1 offset:%2" : "=&v"(r) : "v"(vb), "i"(OFF) : "memory"); return r;
}
template <int D0> __device__ __forceinline__ void pv_one(f32x16& od, int vb, bf16x8 pa0, bf16x8 pa1, bf16x8 pa2, bf16x8 pa3) {
  const s16x4 l0 = tr_read<v_rd_off(D0, 0, 0)>(vb), h0 = tr_read<v_rd_off(D0, 0, 1)>(vb), l1 = tr_read<v_rd_off(D0, 1, 0)>(vb), h1 = tr_read<v_rd_off(D0, 1, 1)>(vb);
  const s16x4 l2 = tr_read<v_rd_off(D0, 2, 0)>(vb), h2 = tr_read<v_rd_off(D0, 2, 1)>(vb), l3 = tr_read<v_rd_off(D0, 3, 0)>(vb), h3 = tr_read<v_rd_off(D0, 3, 1)>(vb);
  asm volatile("s_waitcnt lgkmcnt(0)" ::: "memory"); FA_SBAR();
#define FA_PK(L, H) (bf16x8){L[0], L[1], L[2], L[3], H[0], H[1], H[2], H[3]}
  od = __builtin_amdgcn_mfma_f32_32x32x16_bf16(pa0, FA_PK(l0, h0), od, 0, 0, 0);
  od = __builtin_amdgcn_mfma_f32_32x32x16_bf16(pa1, FA_PK(l1, h1), od, 0, 0, 0);
  od = __builtin_amdgcn_mfma_f32_32x32x16_bf16(pa2, FA_PK(l2, h2), od, 0, 0, 0);
  od = __builtin_amdgcn_mfma_f32_32x32x16_bf16(pa3, FA_PK(l3, h3), od, 0, 0, 0);
#undef FA_PK
}
template <int NV> __device__ __forceinline__ void pv_all(f32x16* o, int vb, bf16x8 pa0, bf16x8 pa1, bf16x8 pa2, bf16x8 pa3) {
  pv_one<0>(o[0], vb, pa0, pa1, pa2, pa3); pv_one<1>(o[1], vb, pa0, pa1, pa2, pa3);
  if constexpr (NV == 4) { pv_one<2>(o[2], vb, pa0, pa1, pa2, pa3); pv_one<3>(o[3], vb, pa0, pa1, pa2, pa3); }
}
__device__ __forceinline__ void wmask(f32x16& p0, f32x16& p1, int dq4) {
#pragma unroll
  for (int r = 0; r < 16; ++r) { const int d = dq4 + (r & 3) + 8 * (r >> 2); if ((unsigned)(d + 128) > 256u) p0[r] = NEGS; if ((unsigned)(d + 32 + 128) > 256u) p1[r] = NEGS; }
}

struct Unit {
  const bf16_t* Q; const bf16_t* K; const bf16_t* V; bf16_t* O;
  int rowa, nta, rowb, ntb;
  int window, qpos0, kposb0;
  float sink; int has_sink;
  const bf16_t* K2;
  const float* tab; int pos0;
  const float* qg;
};
template <int DQ, int DV, int LDQ, int LDK, int LDV, int LDO, bool WIN, int RD0, int RH, bool QNORM, bool KSPLIT, bool O8>
__device__ __forceinline__ void attn_unit(const int tid, const Unit& U, char* lds) {
  constexpr int NQ = DQ / 16, NV = DV / 32;
  const int wid = tid >> 6, lane = tid & 63, r32 = lane & 31, hi = lane >> 5;
  char* V_lds = lds; char* K_lds = lds + 2 * SHM_V;
  float* ws = (float*)(lds + 2 * SHM_V + 2 * SHM_K) + wid * 64; float* li_l = ws; float* al_l = ws + 32;
  float m_reg = -1e30f, l_reg = 0; f32x16 o[NV]; bf16x8 qr[NQ];
#pragma unroll
  for (int d = 0; d < NV; ++d) o[d] = f32x16{};
  const bf16_t* Qw = U.Q + (size_t)(wid * QBLK + r32) * LDQ + hi * 8;
#pragma unroll
  for (int d0 = 0; d0 < NQ; ++d0) qr[d0] = *reinterpret_cast<const bf16x8*>(Qw + d0 * 16);
  if constexpr (QNORM || RH > 0) {
    float qf[NQ][8];
#pragma unroll
    for (int d0 = 0; d0 < NQ; ++d0)
#pragma unroll
      for (int j = 0; j < 8; ++j) qf[d0][j] = __uint_as_float(((unsigned)(unsigned short)qr[d0][j]) << 16);
    if constexpr (QNORM) {
      float ss = 0.f;
#pragma unroll
      for (int d0 = 0; d0 < NQ; ++d0)
#pragma unroll
        for (int j = 0; j < 8; ++j) ss = fmaf(qf[d0][j], qf[d0][j], ss);
      { auto rr = __builtin_amdgcn_permlane32_swap(__float_as_uint(ss), __float_as_uint(ss), false, false); ss = __uint_as_float(rr[0]) + __uint_as_float(rr[1]); }
      const float ri = 1.0f / sqrtf(ss * (1.0f / DQ) + 1e-6f);
#pragma unroll
      for (int d0 = 0; d0 < NQ; ++d0) { const float4 g0 = *(const float4*)(U.qg + 16 * d0 + 8 * hi), g1 = *(const float4*)(U.qg + 16 * d0 + 8 * hi + 4);
        qf[d0][0] *= ri * g0.x; qf[d0][1] *= ri * g0.y; qf[d0][2] *= ri * g0.z; qf[d0][3] *= ri * g0.w; qf[d0][4] *= ri * g1.x; qf[d0][5] *= ri * g1.y; qf[d0][6] *= ri * g1.z; qf[d0][7] *= ri * g1.w; }
    }
    if constexpr (RH > 0) { if (U.tab) {
      const float4* tb = (const float4*)(U.tab + ((size_t)(U.pos0 + wid * QBLK + r32) * (RH * 16) + 8 * hi) * 2);
#pragma unroll
      for (int dd = 0; dd < RH; ++dd) {
#pragma unroll
        for (int j2 = 0; j2 < 4; ++j2) { const float4 t = tb[dd * 8 + j2];
          { const float x1 = qf[RD0 + dd][2 * j2], x2 = qf[RD0 + RH + dd][2 * j2]; qf[RD0 + dd][2 * j2] = x1 * t.x - x2 * t.y; qf[RD0 + RH + dd][2 * j2] = x2 * t.x + x1 * t.y; }
          { const float x1 = qf[RD0 + dd][2 * j2 + 1], x2 = qf[RD0 + RH + dd][2 * j2 + 1]; qf[RD0 + dd][2 * j2 + 1] = x1 * t.z - x2 * t.w; qf[RD0 + RH + dd][2 * j2 + 1] = x2 * t.z + x1 * t.w; } } } } }
#pragma unroll
    for (int d0 = 0; d0 < NQ; ++d0) { u32x4 w = {cvtpk(qf[d0][0], qf[d0][1]), cvtpk(qf[d0][2], qf[d0][3]), cvtpk(qf[d0][4], qf[d0][5]), cvtpk(qf[d0][6], qf[d0][7])}; qr[d0] = *reinterpret_cast<bf16x8*>(&w); }
  }
  const int sr = tid >> 4, sc = (tid & 15) * 8, vst0 = v_st(sr, sc), vst1 = v_st(32 + sr, sc);
  const int sck = sc < DQ - 8 ? sc : DQ - 8, scv = sc < DV - 8 ? sc : DV - 8;
  const int vb0 = (int)(uintptr_t)V_lds + v_rd_base(lane);
  const int nta = U.nta, NT = U.nta + U.ntb;
  const unsigned kof0 = (unsigned)((sr * LDK + sck) * 2), kof1 = kof0 + 32u * LDK * 2u, vof0 = (unsigned)((sr * LDV + scv) * 2), vof1 = vof0 + 32u * LDV * 2u;
  constexpr int LDK2 = 1536;
  const int ci = tid & 15; const bool ksec = KSPLIT && ci >= 8; const int kld = ksec ? LDK2 : LDK;
  const bf16_t* kp0 = ksec ? U.K2 + (size_t)sr * LDK2 + ((ci < 11 ? ci : 11) - 8) * 8 : U.K + (size_t)sr * LDK + ci * 8; const bf16_t* kp1 = kp0 + (size_t)32 * kld;
  (void)kof0; (void)kof1; (void)kp0; (void)kp1; (void)kld;
  struct { bf16x8 vs0, vs1, ks0, ks1; } sr_[2];
#define FA_KROW(j) ((j) < nta ? U.rowa + (j) * KVBLK : U.rowb + ((j) - nta) * KVBLK)
#define FA_SLOAD(i, j) do { const size_t k0_ = (size_t)(FA_KROW(j)); const char* kt_ = (const char*)U.K + k0_ * (LDK * 2); const char* vt_ = (const char*)U.V + k0_ * (LDV * 2); \
    sr_[i].vs0 = *reinterpret_cast<const bf16x8*>(vt_ + vof0); sr_[i].vs1 = *reinterpret_cast<const bf16x8*>(vt_ + vof1); \
    if constexpr (KSPLIT) { sr_[i].ks0 = *reinterpret_cast<const bf16x8*>(kp0 + k0_ * kld); sr_[i].ks1 = *reinterpret_cast<const bf16x8*>(kp1 + k0_ * kld); } \
    else { sr_[i].ks0 = *reinterpret_cast<const bf16x8*>(kt_ + kof0); sr_[i].ks1 = *reinterpret_cast<const bf16x8*>(kt_ + kof1); } } while (0)
#define FA_SWRITE(b, i) do { *(bf16x8*)(V_lds + (b) * SHM_V + vst0) = sr_[i].vs0; *(bf16x8*)(V_lds + (b) * SHM_V + vst1) = sr_[i].vs1; const int kc = sc * 2; \
    *(bf16x8*)(K_lds + (b) * SHM_K + FA_KSWZ(sr, kc)) = sr_[i].ks0; *(bf16x8*)(K_lds + (b) * SHM_K + FA_KSWZ(32 + sr, kc)) = sr_[i].ks1; } while (0)
#define FA_SWAIT() asm volatile("s_waitcnt vmcnt(4)" ::: "memory")
#define FA_RESC(a) do { if (__any((a) < 1.f)) { if (hi == 0) al_l[r32] = (a); asm volatile("s_waitcnt lgkmcnt(0)" ::: "memory"); \
    _Pragma("unroll") for (int d = 0; d < NV; ++d) _Pragma("unroll") for (int r = 0; r < 16; ++r) o[d][r] *= al_l[crow(r, hi)]; } } while (0)
  const int qw0 = U.qpos0 + wid * QBLK;
#define FA_MASK(P0, P1, t) do { if (WIN && U.window && (t) >= nta) { const int kb_ = U.kposb0 + ((t) - nta) * KVBLK; \
    if (kb_ + 63 - qw0 > 128 || qw0 + 31 - kb_ > 128) wmask(P0, P1, kb_ - (qw0 + r32) + 4 * hi); } } while (0)
  f32x16 pA0, pA1, pB0, pB1; float mnA, mnB, alA, alB; bf16x8 pa0, pa1, pa2, pa3;
  constexpr int SE = 0, SO = 1;
  FA_SLOAD(SE, 0); asm volatile("s_waitcnt vmcnt(0)" ::: "memory"); FA_SWRITE(0, SE); __syncthreads();
  qkt<NQ>(pA0, pA1, K_lds, qr, r32, hi); FA_MASK(pA0, pA1, 0); partialSM(pA0, pA1, m_reg, mnA, alA);
  FA_SLOAD(SO, 1); if (2 < NT) FA_SLOAD(SE, 2);
  FA_SWAIT(); FA_SWRITE(1, SO); __syncthreads();
  for (int j = 1; j + 1 < NT; j += 2) {
    FA_SBAR(); qkt<NQ>(pB0, pB1, K_lds + SHM_K, qr, r32, hi);
    finishSM(pA0, pA1, alA, l_reg, pa0, pa1, pa2, pa3); FA_SBAR();
    FA_SLOAD(SO, j + 2); FA_SBAR();
    pv_all<NV>(o, vb0, pa0, pa1, pa2, pa3); FA_MASK(pB0, pB1, j); partialSM(pB0, pB1, m_reg, mnB, alB);
    __syncthreads(); FA_SWAIT(); FA_SWRITE(0, SE);
    FA_RESC(alB); __syncthreads();
    FA_SBAR(); qkt<NQ>(pA0, pA1, K_lds, qr, r32, hi);
    finishSM(pB0, pB1, alB, l_reg, pa0, pa1, pa2, pa3); FA_SBAR();
    if (j + 3 < NT) FA_SLOAD(SE, j + 3); FA_SBAR();
    pv_all<NV>(o, vb0 + SHM_V, pa0, pa1, pa2, pa3); FA_MASK(pA0, pA1, j + 1); partialSM(pA0, pA1, m_reg, mnA, alA);
    __syncthreads(); FA_SWAIT(); FA_SWRITE(1, SO);
    FA_RESC(alA); __syncthreads();
  }
  FA_SBAR(); qkt<NQ>(pB0, pB1, K_lds + SHM_K, qr, r32, hi);
  finishSM(pA0, pA1, alA, l_reg, pa0, pa1, pa2, pa3); FA_SBAR();
  pv_all<NV>(o, vb0, pa0, pa1, pa2, pa3); FA_MASK(pB0, pB1, NT - 1); partialSM(pB0, pB1, m_reg, mnB, alB);
  __syncthreads(); FA_RESC(alB);
  finishSM(pB0, pB1, alB, l_reg, pa0, pa1, pa2, pa3); FA_SBAR();
  pv_all<NV>(o, vb0 + SHM_V, pa0, pa1, pa2, pa3);
  if (U.has_sink) l_reg += __builtin_amdgcn_exp2f((U.sink - m_reg) * LOG2E);
  if (hi == 0) li_l[r32] = l_reg;
  asm volatile("s_waitcnt lgkmcnt(0)" ::: "memory");
  __syncthreads();
  int lane2 = lane; asm volatile("" : "+v"(lane2));
  const int r32e = lane2 & 31, hie = lane2 >> 5;
  if constexpr (O8) {
    unsigned char* stg = (unsigned char*)(lds + wid * 8192);
    unsigned char* stw = stg + hie * 4 * DV + r32e;
#pragma unroll
    for (int r = 0; r < 16; ++r) { const int orow0 = (r & 3) + 8 * (r >> 2); const float rl = __builtin_amdgcn_rcpf(li_l[orow0 + 4 * hie]);
#pragma unroll
      for (int d0 = 0; d0 < NV; ++d0) stw[orow0 * DV + d0 * 32] = (unsigned char)(__builtin_amdgcn_cvt_pk_fp8_f32(o[d0][r] * rl, 0.f, 0, false) & 0xff); }
    asm volatile("s_waitcnt lgkmcnt(0)" ::: "memory");
    constexpr int CPR = DV / 16, RPI = 64 / CPR;
    const int erow = lane2 / CPR, ech = lane2 % CPR;
    unsigned char* Ow = (unsigned char*)U.O + (size_t)(wid * QBLK + erow) * LDO + ech * 16; const unsigned char* str = stg + erow * DV + ech * 16;
#pragma unroll
    for (int i = 0; i < 32 / RPI; ++i) { const u32x4 v = *(const u32x4*)(str + i * RPI * DV); *(u32x4*)(Ow + (size_t)(i * RPI) * LDO) = v; }
  } else {
  bf16_t* stg = (bf16_t*)(lds + wid * 8192);
  bf16_t* stw = stg + hie * 4 * DV + r32e;
#pragma unroll
  for (int r = 0; r < 16; ++r) { const int orow0 = (r & 3) + 8 * (r >> 2); const float rl = __builtin_amdgcn_rcpf(li_l[orow0 + 4 * hie]);
#pragma unroll
    for (int d0 = 0; d0 < NV; ++d0) stw[orow0 * DV + d0 * 32] = f2bf(o[d0][r] * rl); }
  asm volatile("s_waitcnt lgkmcnt(0)" ::: "memory");
  constexpr int CPR = DV / 8, RPI = 64 / CPR;
  const int erow = lane2 / CPR, ech = lane2 % CPR;
  bf16_t* Ow = U.O + (size_t)(wid * QBLK + erow) * LDO + ech * 8; const bf16_t* str = stg + erow * DV + ech * 8;
#pragma unroll
  for (int i = 0; i < 32 / RPI; ++i) { const u32x4 v = *(const u32x4*)(str + i * RPI * DV); *(u32x4*)(Ow + (size_t)(i * RPI) * LDO) = v; }
  }
  __syncthreads();
#undef FA_KROW
#undef FA_SLOAD
#undef FA_SWRITE
#undef FA_SWAIT
#undef FA_RESC
#undef FA_MASK
}
}

__device__ __forceinline__ void route_reduce(const float (&acc)[32], const int lane, const int el, const float rb, float (&tv)[4], int (&ti)[4]) {
    float a16[16], a8[8], a4[4], a2[2];
#pragma unroll
    for (int k = 0; k < 16; ++k) { const bool up = (lane & 32) != 0; const float keep = up ? acc[k + 16] : acc[k], send = up ? acc[k] : acc[k + 16]; a16[k] = keep + __shfl_xor(send, 32); }
#pragma unroll
    for (int k = 0; k < 8; ++k) { const bool up = (lane & 16) != 0; const float keep = up ? a16[k + 8] : a16[k], send = up ? a16[k] : a16[k + 8]; a8[k] = keep + __shfl_xor(send, 16); }
#pragma unroll
    for (int k = 0; k < 4; ++k) { const bool up = (lane & 8) != 0; const float keep = up ? a8[k + 4] : a8[k], send = up ? a8[k] : a8[k + 4]; a4[k] = keep + __shfl_xor(send, 8); }
#pragma unroll
    for (int k = 0; k < 2; ++k) { const bool up = (lane & 4) != 0; const float keep = up ? a4[k + 2] : a4[k], send = up ? a4[k] : a4[k + 2]; a2[k] = keep + __shfl_xor(send, 4); }
    float lg; { const bool up = (lane & 2) != 0; const float keep = up ? a2[1] : a2[0], send = up ? a2[0] : a2[1]; lg = keep + __shfl_xor(send, 2); }
    lg += __shfl_xor(lg, 1); lg += rb;
    unsigned key; { const unsigned u = __float_as_uint(lg); const unsigned ou = (u & 0x80000000u) ? ~u : (u | 0x80000000u); key = (ou & ~31u) | (unsigned)(31 - el); }
#pragma unroll
    for (int k = 0; k < 4; ++k) { unsigned bk = key;
#pragma unroll
        for (int o = 1; o < 64; o <<= 1) { const unsigned ok = (unsigned)__shfl_xor((int)bk, o); bk = ok > bk ? ok : bk; }
        const int bi = 31 - (int)(bk & 31u); const unsigned ou = bk & ~31u; const unsigned ub = (ou & 0x80000000u) ? (ou ^ 0x80000000u) : ~ou;
        tv[k] = __uint_as_float(ub); ti[k] = bi; if (el == bi) key = 0u; }
}

__device__ __forceinline__ void route_reduce32(const float (&acc)[32], const int l5, const float rb, float (&tv)[4], int (&ti)[4]) {
    float a16[16], a8[8], a4[4], a2[2];
#pragma unroll
    for (int k = 0; k < 16; ++k) { const bool up = (l5 & 16) != 0; const float keep = up ? acc[k + 16] : acc[k], send = up ? acc[k] : acc[k + 16]; a16[k] = keep + __shfl_xor(send, 16); }
#pragma unroll
    for (int k = 0; k < 8; ++k) { const bool up = (l5 & 8) != 0; const float keep = up ? a16[k + 8] : a16[k], send = up ? a16[k] : a16[k + 8]; a8[k] = keep + __shfl_xor(send, 8); }
#pragma unroll
    for (int k = 0; k < 4; ++k) { const bool up = (l5 & 4) != 0; const float keep = up ? a8[k + 4] : a8[k], send = up ? a8[k] : a8[k + 4]; a4[k] = keep + __shfl_xor(send, 4); }
#pragma unroll
    for (int k = 0; k < 2; ++k) { const bool up = (l5 & 2) != 0; const float keep = up ? a4[k + 2] : a4[k], send = up ? a4[k] : a4[k + 2]; a2[k] = keep + __shfl_xor(send, 2); }
    float lg; { const bool up = (l5 & 1) != 0; const float keep = up ? a2[1] : a2[0], send = up ? a2[0] : a2[1]; lg = keep + __shfl_xor(send, 1); }
    lg += rb;
    unsigned key; { const unsigned u = __float_as_uint(lg); const unsigned ou = (u & 0x80000000u) ? ~u : (u | 0x80000000u); key = (ou & ~31u) | (unsigned)(31 - l5); }
#pragma unroll
    for (int k = 0; k < 4; ++k) { unsigned bk = key;
#pragma unroll
        for (int o = 1; o < 32; o <<= 1) { const unsigned ok = (unsigned)__shfl_xor((int)bk, o); bk = ok > bk ? ok : bk; }
        const int bi = 31 - (int)(bk & 31u); const unsigned ou = bk & ~31u; const unsigned ub = (ou & 0x80000000u) ? (ou ^ 0x80000000u) : ~ou;
        tv[k] = __uint_as_float(ub); ti[k] = bi; if (l5 == bi) key = 0u; }
}

struct Params {
    const float *x, *c, *ctx, *c_ctx, *ada_w, *ada_b, *norm_mix_g, *norm_ffn_g, *ab_w_in, *mla_q_g, *mla_wq_b, *mla_kv_g, *mla_wkv_b, *swa_sink, *ab_w_out,
        *c_w_in, *c_q_g, *c_k_g, *c_w_out, *router_w, *router_b, *moe_w_in, *moe_b_in, *moe_w_out, *moe_b_out, *final_g;
    float* out; unsigned char* ws; int ph_lo, ph_hi;
};
__device__ __forceinline__ int mod_row_of(int r) { return r < NLAT ? r / SEQ : NB; }
__device__ __forceinline__ float rope_angle(int i, int quarter, int prow, int pcol) {
    const int ii = i < quarter ? i : i - quarter; const float inv = powf(10000.f, -(float)ii / (float)quarter);
    return (float)(i < quarter ? prow : pcol) * inv;
}

#ifndef OUTPROJ_F8
#define OUTPROJ_F8 1
#endif
#ifndef Y8_L1
#define Y8_L1 1
#endif
#ifndef INPROJ_F8
#define INPROJ_F8 1
#endif
#ifndef MOE_F8_DOWN
#define MOE_F8_DOWN 1
#endif
#ifndef MOE_F8_L0
#define MOE_F8_L0 1
#endif
#ifndef MOE_F8_L1
#define MOE_F8_L1 1
#endif
constexpr int LDS_BYTES = 147456;
constexpr int LDS_MISC = 143360;
constexpr int N_PHASES = 21;

__global__ void __launch_bounds__(NTHR, 2) fwd_kernel(Params p) {
    extern __shared__ __attribute__((aligned(16))) unsigned char lds_raw[];
    float* ldsf = (float*)lds_raw;
    LAS unsigned* misc = (LAS unsigned*)(lds_raw + LDS_MISC + 320);
    const int wave0 = __builtin_amdgcn_readfirstlane((int)(threadIdx.x >> 6));
    const int G = gridDim.x, bid = blockIdx.x;
    const int NGW = G * 8;
    unsigned* ctl0 = (unsigned*)(p.ws + WS_CTL);
#define PHASE_PTRS \
    int tid = wave0 * 64 + (int)__builtin_amdgcn_mbcnt_hi(~0u, __builtin_amdgcn_mbcnt_lo(~0u, 0u)); asm volatile("" : "+v"(tid)); const int lane = tid & 63, wave = tid >> 6, gw = bid * 8 + wave; (void)lane; (void)gw; \
    size_t wsz_ = 0; asm volatile("" : "+s"(wsz_)); unsigned char* ws = p.ws + wsz_; \
    unsigned* ctl = (unsigned*)(ws + WS_CTL); (void)ctl; \
    float* MOD = (float*)(ws + WS_MOD); (void)MOD; \
    int* TOKE = (int*)(ws + WS_TOKE); int* TOKP = (int*)(ws + WS_TOKP); float* TOKG = (float*)(ws + WS_TOKG); (void)TOKE; (void)TOKP; (void)TOKG; \
    float* RINV = (float*)(ws + WS_RINV); (void)RINV; unsigned char* tabs = ws + WS_TAB; (void)tabs; \
    float* XR = (float*)(ws + WS_XR); (void)XR; \
    act_t* H = (act_t*)(ws + WS_H); (void)H; \
    unsigned char* big = ws + WS_BIG; \
    act_t* PRJ = (act_t*)(big + OFF_PRJ); act_t* QB = (act_t*)(big + OFF_QB); act_t* KVB = (act_t*)(big + OFF_KVB); act_t* OB = (act_t*)(big + OFF_O); (void)PRJ; (void)QB; (void)KVB; (void)OB; \
    act_t* Y = (act_t*)big; act_t* ACT = (act_t*)(ws + WS_ACT); act_t* XS = (act_t*)(ws + WS_XS); unsigned char* wts = ws + WS_W; (void)Y; (void)ACT; (void)XS; (void)wts;

    if (threadIdx.x < 32) misc[threadIdx.x] = 0u;
    __syncthreads();
    XcdBarrier bar = xcd_barrier_post(ctl0 + CW_BAR, (volatile LAS unsigned*)(misc + 8), wave0);
    const int lo = p.ph_lo, hi = p.ph_hi;
#ifndef PHASE_MASK
#define PHASE_MASK 0x1FFFFFu
#endif
#define IN(k) ((((PHASE_MASK) >> (k)) & 1u) && lo <= (k) && (k) < hi)
#define SEAM(k) do { if (IN(k) && IN((k) + 1)) xcd_barrier(bar, wave0); } while (0)
#define LDSB ((LAS unsigned char*)lds_raw)

    if (IN(0)) { PHASE_PTRS
        {   LAS float* scr = (LAS float*)(LDSB + wave * 16640);
            constexpr int I_AB = 16 * 45  , I_QB = 6 * 12, I_KVB = 4 * 16, I_ABO = 16 * 16, I_C = 16 * 24, I_CO = 16 * 16, I_W1 = 16 * 32, I_W2 = 16 * 16;
            constexpr int T_W1 = 64 * I_W1, T_W2 = 64 * I_W2, T_ALL = T_W1 + T_W2 + I_AB + I_QB + I_KVB + I_ABO + I_C + I_CO;
            for (int it = gw; it < T_ALL; it += NGW) {
                int r = it;
                if (r < T_W1) { const int mi = r / I_W1; const float* src = p.moe_w_in + (size_t)mi * 1024 * 2048;
                    if ((mi >= 32 && MOE_F8_L1) || (mi < 32 && MOE_F8_L0)) transpose_item64<true>(src, 1024, 2048, (unsigned char*)(wts + WO_W1) + (size_t)(mi >> 5) * 32 * 2048 * 1024 * 2 + (size_t)(mi & 31) * 2048 * 1024, scr, r % I_W1, lane);
                    else transpose_item64<false>(src, 1024, 2048, (bf16_t*)(wts + WO_W1) + (size_t)mi * 2048 * 1024, scr, r % I_W1, lane);
                    continue; } r -= T_W1;
                if (r < T_W2) { const int mi = r / I_W2; const float* src = p.moe_w_out + (size_t)mi * 1024 * 1024;
                    if (MOE_F8_DOWN && ((mi >= 32 && MOE_F8_L1) || (mi < 32 && MOE_F8_L0))) transpose_item64<true>(src, 1024, 1024, (unsigned char*)(wts + WO_W2) + (size_t)(mi >> 5) * 32 * 1024 * 1024 * 2 + (size_t)(mi & 31) * 1024 * 1024, scr, r % I_W2, lane);
                    else transpose_item64<false>(src, 1024, 1024, (bf16_t*)(wts + WO_W2) + (size_t)mi * 1024 * 1024, scr, r % I_W2, lane);
                    continue; } r -= T_W2;
                if (r < I_AB) { if (INPROJ_F8) transpose_item_f8(p.ab_w_in, 1024, AB_IN, (unsigned char*)(wts + WO_AB), scr, r, lane, 0.125f, 512);
                    else transpose_item(p.ab_w_in, 1024, AB_IN, (bf16_t*)(wts + WO_AB), scr, r, lane, nullptr, 0.125f, 512); continue; } r -= I_AB;
                if (r < I_QB) { transpose_item64<false>(p.mla_wq_b, 384, 768, (bf16_t*)(wts + WO_QB), scr, r, lane, p.mla_q_g, 0.10206207261596575f); continue; } r -= I_QB;
                if (r < I_KVB) { transpose_item64<false>(p.mla_wkv_b, 256, 1024, (bf16_t*)(wts + WO_KVB), scr, r, lane, p.mla_kv_g, 1.0f); continue; } r -= I_KVB;
                if (r < I_ABO) { if (OUTPROJ_F8) transpose_item64<true>(p.ab_w_out, 1024, 1024, (unsigned char*)(wts + WO_ABO), scr, r, lane); else transpose_item64<false>(p.ab_w_out, 1024, 1024, (bf16_t*)(wts + WO_ABO), scr, r, lane); continue; } r -= I_ABO;
                if (r < I_C) { if (INPROJ_F8) transpose_item64<true>(p.c_w_in, 1024, C_IN, (unsigned char*)(wts + WO_C), scr, r, lane); else transpose_item64<false>(p.c_w_in, 1024, C_IN, (bf16_t*)(wts + WO_C), scr, r, lane); continue; } r -= I_C;
                if (OUTPROJ_F8) transpose_item64<true>(p.c_w_out, 1024, 1024, (unsigned char*)(wts + WO_CO), scr, r, lane); else transpose_item64<false>(p.c_w_out, 1024, 1024, (bf16_t*)(wts + WO_CO), scr, r, lane);
            }
            uint4* z = (uint4*)((unsigned char*)(wts + WO_AB) + (size_t)AB_IN * 1024 * (INPROJ_F8 ? 1 : 2));
            for (int i = gw * 64 + lane; i < 96 * 1024 * (INPROJ_F8 ? 1 : 2) / 16; i += NGW * 64) z[i] = make_uint4(0u, 0u, 0u, 0u);
        }
        {
            float2* TA = (float2*)(tabs + TAB_A); float2* TB = (float2*)(tabs + TAB_B); float2* TC = (float2*)(tabs + TAB_C);
            for (int e = bid * NTHR + tid; e < SEQ * 112; e += G * NTHR) { const int s = e / 112, i = e % 112, prow = s / GRIDW, pcol = s % GRIDW;
                int quarter, ii; float2* dst;
                if (i < 32) { quarter = 16; ii = i; dst = TA + s * 32 + ii; } else if (i < 48) { quarter = 8; ii = i - 32; dst = TB + s * 16 + ii; } else { quarter = 32; ii = i - 48; dst = TC + s * 64 + ii; }
                const float ang = rope_angle(ii, quarter, prow, pcol); *dst = make_float2(cosf(ang), sinf(ang)); }
            if (bid == 0 && tid < 128) ((float*)(tabs + TAB_QG))[tid] = p.c_q_g[tid] * 0.08838834764831845f;
        }
        __syncthreads();
        float* ca = ldsf;
        float* red = ldsf + 17 * 1024;
        for (int i = tid; i < 17 * 1024; i += NTHR) { const int b = i >> 10, k = i & 1023; const float v = b < NB ? p.c[b * 1024 + k] : p.c_ctx[k]; ca[i] = v / (1.f + expf(-v)); }
        __syncthreads();
        for (int blk = bid; blk < 2 * 6144 / 64; blk += G) {
            const int l = blk / 96, n = (blk % 96) * 64 + lane, ks = wave;
            float acc[17];
#pragma unroll
            for (int b = 0; b < 17; ++b) acc[b] = 0.f;
            const float* wp = p.ada_w + (size_t)l * 1024 * 6144 + n;
            for (int k = ks * 128; k < ks * 128 + 128; ++k) { const float w = wp[(size_t)k * 6144];
#pragma unroll
                for (int b = 0; b < 17; ++b) acc[b] = fmaf(ca[b * 1024 + k], w, acc[b]); }
#pragma unroll
            for (int b = 0; b < 17; ++b) red[(ks * 17 + b) * 64 + lane] = acc[b];
            __syncthreads();
            for (int i = tid; i < 17 * 64; i += NTHR) { const int b = i >> 6, nl = i & 63; float s = 0.f;
#pragma unroll
                for (int k2 = 0; k2 < 8; ++k2) s += red[(k2 * 17 + b) * 64 + nl];
                const int nn = (blk % 96) * 64 + nl; MOD[((size_t)l * 17 + b) * 6144 + nn] = s + p.ada_b[l * 6144 + nn]; }
            __syncthreads();
        }
    }
    SEAM(0);

#define NORM_MOD16(v, g, mr_) do { float ss_ = 0.f; \
        _Pragma("unroll") for (int j = 0; j < 16; ++j) ss_ = fmaf(v[j], v[j], ss_); \
        ss_ = wave_sum(ss_); const float ri_ = 1.0f / sqrtf(ss_ * (1.0f / 1024.0f) + RMS_EPS); \
        float sh_[16], sc_[16]; ld16f((mr_), sh_); ld16f((mr_) + 1024, sc_); \
        _Pragma("unroll") for (int j = 0; j < 16; ++j) v[j] = (v[j] * ri_ * g[j]) * (1.0f + sc_[j]) + sh_[j]; } while (0)

#define NORM_MOD16x2(v, g, mr0_, mr1_) do { float s0_ = 0.f, s1_ = 0.f; \
        _Pragma("unroll") for (int j = 0; j < 16; ++j) { s0_ = fmaf(v[0][j], v[0][j], s0_); s1_ = fmaf(v[1][j], v[1][j], s1_); } \
        wave_sum2(s0_, s1_); const float ri0_ = 1.0f / sqrtf(s0_ * (1.0f / 1024.0f) + RMS_EPS), ri1_ = 1.0f / sqrtf(s1_ * (1.0f / 1024.0f) + RMS_EPS); \
        float sh_[16], sc_[16]; ld16f((mr0_), sh_); ld16f((mr0_) + 1024, sc_); \
        _Pragma("unroll") for (int j = 0; j < 16; ++j) v[0][j] = (v[0][j] * ri0_ * g[j]) * (1.0f + sc_[j]) + sh_[j]; \
        ld16f((mr1_), sh_); ld16f((mr1_) + 1024, sc_); \
        _Pragma("unroll") for (int j = 0; j < 16; ++j) v[1][j] = (v[1][j] * ri1_ * g[j]) * (1.0f + sc_[j]) + sh_[j]; } while (0)
#define ROWS2(nrows) _Pragma("unroll 1") for (int r0_ = gw; r0_ < (nrows); r0_ += 2 * NGW)
#define ROWS2_IDX(nrows) const bool two_ = (r0_ + NGW) < (nrows); const int rr_[2] = {r0_, two_ ? r0_ + NGW : r0_};

    if (IN(1)) { PHASE_PTRS
        float g[16]; ld16f(p.norm_mix_g + 16 * lane, g);
        ROWS2(NROW) { ROWS2_IDX(NROW)
            float v[2][16]; const float* mr[2];
#pragma unroll
            for (int u = 0; u < 2; ++u) { const int r = rr_[u]; const float* src = r < NLAT ? p.x + (size_t)r * 1024 : p.ctx + (size_t)(r - NLAT) * 1024;
                mr[u] = MOD + (size_t)(0 * 17 + mod_row_of(r)) * 6144 + 16 * lane; ld16f(src + 16 * lane, v[u]); }
            NORM_MOD16x2(v, g, mr[0], mr[1]);
            if (INPROJ_F8) { st16f8((unsigned char*)H + (size_t)rr_[0] * 1024 + 16 * lane, v[0]); if (two_) st16f8((unsigned char*)H + (size_t)rr_[1] * 1024 + 16 * lane, v[1]); }
            else { st16bf(H + (size_t)rr_[0] * 1024 + 16 * lane, v[0]); if (two_) st16bf(H + (size_t)rr_[1] * 1024 + 16 * lane, v[1]); }
        }
    }
    SEAM(1);

    if (IN(2)) { PHASE_PTRS
        constexpr size_t ES_ = INPROJ_F8 ? 1 : 2;
        pg8::DenseOrder S{(const char*)H, (const char*)(wts + WO_AB), NROW / 256, 6, G, bid, (size_t)256 * 1024 * ES_, (size_t)256 * 1024 * ES_};
        pg8::EpiStoreBf16 E{PRJ, PRJ_LD, INPROJ_F8 ? 0.03125f : 1.0f};
        pg8::gemm_phase<pg8::EpiStoreBf16, pg8::DenseOrder, true, true, INPROJ_F8 != 0>(tid, LDSB, 1024, 1024, S, E);
    }
    SEAM(2);

    if (IN(3)) { PHASE_PTRS
        const float2* TA = (const float2*)(tabs + TAB_A); const float2* TB = (const float2*)(tabs + TAB_B);
        for (int r = gw; r < NROW; r += NGW) {
            bf16_t* pr = PRJ + (size_t)r * PRJ_LD;
            if (r < NLAT) { const int s = r % SEQ;
                { bf16_t* kp = pr + 512 + (lane >> 5) * 64 + (lane & 31); const float x1 = bf2f(kp[0]), x2 = bf2f(kp[32]); const float2 t = TA[s * 32 + (lane & 31)];
                  kp[0] = f2bf(x1 * t.x - x2 * t.y); kp[32] = f2bf(x2 * t.x + x1 * t.y); }
                if (lane < 16) { bf16_t* rp = pr + 1408 + lane; const float x1 = bf2f(rp[0]), x2 = bf2f(rp[16]); const float2 t = TB[s * 16 + lane];
                  rp[0] = f2bf(x1 * t.x - x2 * t.y); rp[16] = f2bf(x2 * t.x + x1 * t.y); } }
            float s1 = 0.f, s2 = 0.f;
#pragma unroll
            for (int j = 0; j < 6; ++j) { const float xq = bf2f(pr[768 + lane + 64 * j]); s1 = fmaf(xq, xq, s1); }
#pragma unroll
            for (int j = 0; j < 4; ++j) { const float xk = bf2f(pr[1152 + lane + 64 * j]); s2 = fmaf(xk, xk, s2); }
            s1 = wave_sum(s1); s2 = wave_sum(s2);
            if (lane == 0) { RINV[2 * r] = 1.0f / sqrtf(s1 * (1.0f / 384.0f) + RMS_EPS); RINV[2 * r + 1] = 1.0f / sqrtf(s2 * (1.0f / 256.0f) + RMS_EPS); }
        }
    }
    SEAM(3);

    if (IN(4)) { PHASE_PTRS
        { pg8::DenseOrder S{(const char*)(PRJ + 768), (const char*)(wts + WO_QB), NROW / 256, 3, G, bid, (size_t)256 * PRJ_LD * 2, (size_t)256 * 384 * 2};
          pg8::EpiScaleBf16 E{QB, 768, RINV};
          pg8::gemm_phase<pg8::EpiScaleBf16, pg8::DenseOrder, true, true>(tid, LDSB, 384, PRJ_LD, S, E); }
        __syncthreads();
        { pg8::DenseOrder S{(const char*)(PRJ + 1152), (const char*)(wts + WO_KVB), NROW / 256, 4, G, bid, (size_t)256 * PRJ_LD * 2, (size_t)256 * 256 * 2};
          pg8::EpiScaleBf16 E{KVB, 1024, RINV + 1};
          pg8::gemm_phase<pg8::EpiScaleBf16, pg8::DenseOrder, true, true>(tid, LDSB, 256, PRJ_LD, S, E); }
    }
    SEAM(4);

    if (IN(5)) { PHASE_PTRS
        for (int i = 0;; ++i) { const int u = i * G + bid; if (u >= 1152) break;
            const bool isctx = u >= 1024; int b, h, qb;
            if (!isctx) { const int rest = u >> 3; b = 2 * (u & 7) + (rest >> 6); h = (rest & 63) >> 3; qb = rest & 7; } else { b = (u - 1024) >> 3; h = u & 7; qb = 0; }
            const int qrow0 = isctx ? NLAT + b * NCX : b * SEQ + qb * 256;
            fa::Unit U; U.Q = QB + (size_t)qrow0 * 768 + h * 96; U.K = KVB + h * 128; U.K2 = PRJ + 1408; U.V = KVB + h * 128 + 64;
            U.O = OUTPROJ_F8 ? (bf16_t*)((unsigned char*)OB + (size_t)qrow0 * 1024 + 512 + h * 64) : OB + (size_t)qrow0 * 1024 + 512 + h * 64; U.rowa = NLAT + b * NCX; U.nta = 4; U.rowb = b * SEQ; U.ntb = isctx ? 0 : 32;
            U.window = 0; U.qpos0 = 0; U.kposb0 = 0; U.sink = 0.f; U.has_sink = 0; U.tab = isctx ? nullptr : (const float*)(tabs + TAB_B); U.pos0 = qb * 256; U.qg = nullptr;
            fa::attn_unit<96, 64, 768, 1024, 1024, 1024, false, 4, 1, false, true, OUTPROJ_F8 != 0>(tid, U, (char*)lds_raw); }
        for (int i = 0;; ++i) { const int u = i * G + bid; if (u >= 1152) break;
            const bool isctx = u >= 1024; int b, h, qb;
            if (!isctx) { const int rest = u >> 3; b = 2 * (u & 7) + (rest >> 6); h = (rest & 63) >> 3; qb = rest & 7; } else { b = (u - 1024) >> 3; h = u & 7; qb = 0; }
            const int qrow0 = isctx ? NLAT + b * NCX : b * SEQ + qb * 256;
            const int ks = isctx ? 0 : max(0, qb * 256 - 128), ke = isctx ? 0 : min(SEQ, qb * 256 + 384);
            fa::Unit U; U.Q = PRJ + (size_t)qrow0 * PRJ_LD + h * 64; U.K = PRJ + 512 + (h >> 2) * 64; U.K2 = nullptr; U.V = PRJ + 640 + (h >> 2) * 64;
            U.O = OUTPROJ_F8 ? (bf16_t*)((unsigned char*)OB + (size_t)qrow0 * 1024 + h * 64) : OB + (size_t)qrow0 * 1024 + h * 64; U.rowa = NLAT + b * NCX; U.nta = 4; U.rowb = b * SEQ + ks; U.ntb = (ke - ks) / 64;
            U.window = isctx ? 0 : 1; U.qpos0 = qb * 256; U.kposb0 = ks; U.sink = p.swa_sink[h]; U.has_sink = 1; U.tab = isctx ? nullptr : (const float*)(tabs + TAB_A); U.pos0 = qb * 256; U.qg = nullptr;
            fa::attn_unit<64, 64, PRJ_LD, PRJ_LD, PRJ_LD, 1024, true, 0, 2, false, false, OUTPROJ_F8 != 0>(tid, U, (char*)lds_raw); }
    }
    SEAM(5);

    if (IN(6)) { PHASE_PTRS
        constexpr size_t ES_ = OUTPROJ_F8 ? 1 : 2;
        pg8::DenseOrder S{(const char*)OB, (const char*)(wts + WO_ABO), NROW / 256, 4, G, bid, (size_t)256 * 1024 * ES_, (size_t)256 * 1024 * ES_};
        pg8::EpiResid E{p.x, p.ctx, XR, MOD + 2048, OUTPROJ_F8 ? 0.03125f : 1.0f};
        pg8::gemm_phase<pg8::EpiResid, pg8::DenseOrder, true, true, OUTPROJ_F8 != 0>(tid, LDSB, 1024, 1024, S, E);
    }
    SEAM(6);

#define ROUTER_PHASE(L, nrows) do { \
        { const float4* wsrc_ = (const float4*)(p.router_w + (size_t)(L) * 1024 * 32); float4* wl_ = (float4*)lds_raw; \
          for (int q = tid; q < 8192; q += NTHR) { const int c_ = q >> 3, e4_ = q & 7; wl_[c_ * 8 + (e4_ ^ ((c_ >> 5) & 7))] = wsrc_[q]; } } \
        __syncthreads(); \
        unsigned* cnt_ = ctl + CW_CNT + (L) * 32; \
        LAS unsigned* lcnt_ = (LAS unsigned*)(LDSB + LDS_MISC + 1024); LAS unsigned* lbase_ = lcnt_ + 32;       \
        if (tid < 32) lcnt_[tid] = 0u; \
        __syncthreads(); \
        const int half_ = lane >> 5, l5_ = lane & 31;                        \
        float g_[2][16]; ld16f(p.norm_ffn_g + (L) * 1024 + 32 * l5_, g_[0]); ld16f(p.norm_ffn_g + (L) * 1024 + 32 * l5_ + 16, g_[1]); \
        const float rb_ = p.router_b[(L) * 32 + l5_]; \
        const float4* wl_ = (const float4*)lds_raw + (size_t)(32 * l5_) * 8; const int sw_ = l5_ & 7; \
        for (int rp = gw; rp * 2 < (nrows); rp += NGW) { const int r = rp * 2 + half_; \
            const float* mr = MOD + (size_t)((L) * 17 + mod_row_of(r)) * 6144 + 3072 + 32 * l5_; \
            float v[2][16]; ld16f(XR + (size_t)r * 1024 + 32 * l5_, v[0]); ld16f(XR + (size_t)r * 1024 + 32 * l5_ + 16, v[1]); \
            float ss_ = 0.f; \
            _Pragma("unroll") for (int j = 0; j < 16; ++j) { ss_ = fmaf(v[0][j], v[0][j], ss_); ss_ = fmaf(v[1][j], v[1][j], ss_); } \
            _Pragma("unroll") for (int o_ = 1; o_ < 32; o_ <<= 1) ss_ += __shfl_xor(ss_, o_); \
            const float ri_ = 1.0f / sqrtf(ss_ * (1.0f / 1024.0f) + RMS_EPS); \
            _Pragma("unroll") for (int hh = 0; hh < 2; ++hh) { float sh_[16], sc_[16]; ld16f(mr + 16 * hh, sh_); ld16f(mr + 1024 + 16 * hh, sc_); \
                _Pragma("unroll") for (int j = 0; j < 16; ++j) v[hh][j] = (v[hh][j] * ri_ * g_[hh][j]) * (1.0f + sc_[j]) + sh_[j]; \
                st16f8((unsigned char*)H + (size_t)r * 1024 + 32 * l5_ + 16 * hh, v[hh]); }        \
            float acc[32]; \
            _Pragma("unroll") for (int e = 0; e < 32; ++e) acc[e] = 0.f; \
            _Pragma("unroll") for (int hh = 0; hh < 2; ++hh) _Pragma("unroll") for (int j = 0; j < 16; ++j) { \
                _Pragma("unroll") for (int e4 = 0; e4 < 8; ++e4) { const float4 w = wl_[(16 * hh + j) * 8 + (e4 ^ sw_)]; \
                    acc[4 * e4] = fmaf(v[hh][j], w.x, acc[4 * e4]); acc[4 * e4 + 1] = fmaf(v[hh][j], w.y, acc[4 * e4 + 1]); acc[4 * e4 + 2] = fmaf(v[hh][j], w.z, acc[4 * e4 + 2]); acc[4 * e4 + 3] = fmaf(v[hh][j], w.w, acc[4 * e4 + 3]); } } \
            float tv[4]; int ti[4]; route_reduce32(acc, l5_, rb_, tv, ti); \
            const float e1 = expf(tv[1] - tv[0]), e2 = expf(tv[2] - tv[0]), e3 = expf(tv[3] - tv[0]); const float inv = 1.0f / (1.0f + e1 + e2 + e3); \
            if (l5_ < 4) { const int ek = l5_ == 0 ? ti[0] : l5_ == 1 ? ti[1] : l5_ == 2 ? ti[2] : ti[3]; const float gk = (l5_ == 0 ? 1.0f : l5_ == 1 ? e1 : l5_ == 2 ? e2 : e3) * inv; \
                const unsigned pos = __hip_atomic_fetch_add(lcnt_ + ek, 1u, __ATOMIC_RELAXED, __HIP_MEMORY_SCOPE_WORKGROUP); TOKE[r * 4 + l5_] = ek; TOKP[r * 4 + l5_] = (int)pos; TOKG[r * 4 + l5_] = gk; } \
        } \
        __syncthreads(); \
        if (tid < 32) lbase_[tid] = atomicAdd(cnt_ + tid, lcnt_[tid]); \
        __syncthreads(); \
        for (int rp = gw; rp * 2 < (nrows); rp += NGW) { const int r = rp * 2 + half_; if (l5_ < 4) TOKP[r * 4 + l5_] += (int)lbase_[TOKE[r * 4 + l5_]]; } \
    } while (0)

#define EXCL_SETUP(L) \
        const int c_ = lane < 32 ? (int)ctl[CW_CNT + (L) * 32 + lane] : 0; const int padc_ = (c_ + 255) / 256 * 256; int pre_ = padc_; \
        _Pragma("unroll") for (int o_ = 1; o_ < 32; o_ <<= 1) { const int t_ = __shfl_up(pre_, o_); if ((lane & 31) >= o_) pre_ += t_; } \
        const int excl_ = pre_ - padc_;
#define PERMUTE_PHASE(L, nrows) do { EXCL_SETUP(L) \
        ROWS2(nrows) { ROWS2_IDX(nrows) \
            const int ra_ = rr_[0], rb_ = rr_[1]; \
            const uint4* sa_ = (const uint4*)(H + (size_t)ra_ * 1024) + lane * 2; const uint4* sb_ = (const uint4*)(H + (size_t)rb_ * 1024) + lane * 2; \
            const uint4 a0_ = sa_[0], a1_ = sa_[1], b0_ = sb_[0], b1_ = sb_[1]; \
            const int4 ea_ = *(const int4*)(TOKE + ra_ * 4), pa_ = *(const int4*)(TOKP + ra_ * 4), eb_ = *(const int4*)(TOKE + rb_ * 4), pb_ = *(const int4*)(TOKP + rb_ * 4); \
            const int sa0 = __shfl(excl_, ea_.x) + pa_.x, sa1 = __shfl(excl_, ea_.y) + pa_.y, sa2 = __shfl(excl_, ea_.z) + pa_.z, sa3 = __shfl(excl_, ea_.w) + pa_.w; \
            const int sb0 = __shfl(excl_, eb_.x) + pb_.x, sb1 = __shfl(excl_, eb_.y) + pb_.y, sb2 = __shfl(excl_, eb_.z) + pb_.z, sb3 = __shfl(excl_, eb_.w) + pb_.w; \
            { uint4* d_ = (uint4*)(XS + (size_t)sa0 * 1024) + lane * 2; d_[0] = a0_; d_[1] = a1_; } { uint4* d_ = (uint4*)(XS + (size_t)sa1 * 1024) + lane * 2; d_[0] = a0_; d_[1] = a1_; } \
            { uint4* d_ = (uint4*)(XS + (size_t)sa2 * 1024) + lane * 2; d_[0] = a0_; d_[1] = a1_; } { uint4* d_ = (uint4*)(XS + (size_t)sa3 * 1024) + lane * 2; d_[0] = a0_; d_[1] = a1_; } \
            if (two_) { \
            { uint4* d_ = (uint4*)(XS + (size_t)sb0 * 1024) + lane * 2; d_[0] = b0_; d_[1] = b1_; } { uint4* d_ = (uint4*)(XS + (size_t)sb1 * 1024) + lane * 2; d_[0] = b0_; d_[1] = b1_; } \
            { uint4* d_ = (uint4*)(XS + (size_t)sb2 * 1024) + lane * 2; d_[0] = b0_; d_[1] = b1_; } { uint4* d_ = (uint4*)(XS + (size_t)sb3 * 1024) + lane * 2; d_[0] = b0_; d_[1] = b1_; } } } \
        for (int e = 0; e < 32; ++e) { const int ce = __shfl(c_, e), be = __shfl(excl_, e), pe = __shfl(padc_, e); \
            for (int rr = ce + gw; rr < pe; rr += NGW) { uint4* d_ = (uint4*)(XS + (size_t)(be + rr) * 1024) + lane * 2; d_[0] = make_uint4(0u, 0u, 0u, 0u); d_[1] = make_uint4(0u, 0u, 0u, 0u); } } \
    } while (0)
#define PERMUTE_PHASE_F8(L, nrows) do { EXCL_SETUP(L) \
        unsigned char* XS8 = (unsigned char*)XS; \
        for (int r = gw; r < (nrows); r += NGW) { \
            const int4 ov_ = *((const int4*)((const unsigned char*)H + (size_t)r * 1024) + lane); \
            _Pragma("unroll") for (int k = 0; k < 4; ++k) { const int ek = TOKE[r * 4 + k], pk = TOKP[r * 4 + k]; const int slot = __shfl(excl_, ek) + pk; \
                *((int4*)(XS8 + (size_t)slot * 1024) + lane) = ov_; if (lane == 0) TOKP[r * 4 + k] = slot; } }        \
        for (int e = 0; e < 32; ++e) { const int ce = __shfl(c_, e), be = __shfl(excl_, e), pe = __shfl(padc_, e); \
            for (int rr = ce + gw; rr < pe; rr += NGW) *((int4*)(XS8 + (size_t)(be + rr) * 1024) + lane) = make_int4(0, 0, 0, 0); } \
    } while (0)
#define MOE_TABLE(L) \
        LAS int* tile_e = (LAS int*)(LDSB + LDS_MISC + 1024); LAS int* nm_p = tile_e + 640; \
        LAS int* tpre_ = nm_p + 1;                                       \
        __syncthreads(); \
        if (tid < 64) { const int c_ = lane < 32 ? (int)ctl[CW_CNT + (L) * 32 + lane] : 0; const int n_ = (c_ + 255) / 256; int pre_ = n_; \
            _Pragma("unroll") for (int o_ = 1; o_ < 32; o_ <<= 1) { const int t_ = __shfl_up(pre_, o_); if ((lane & 31) >= o_) pre_ += t_; } \
            if (lane < 32) tpre_[lane] = pre_ - n_; if (lane == 31) { tpre_[32] = pre_; *nm_p = pre_; } } \
        __syncthreads(); \
        const int nM_ = __builtin_amdgcn_readfirstlane(*nm_p); \
        for (int t_ = tid; t_ < nM_; t_ += NTHR) { int e_ = 0; _Pragma("unroll") for (int q_ = 16; q_ >= 1; q_ >>= 1) { if (tpre_[e_ + q_] <= t_) e_ += q_; } tile_e[t_] = e_; }        \
        __syncthreads();
#define MOE_FAST1(L) do { MOE_TABLE(L) \
        pg8::MoeOrder S{(const char*)XS, (const char*)(wts + WO_W1) + (size_t)(L) * 32 * 2048 * 1024 * 2, tile_e, nM_, 8, G, bid, (size_t)256 * 1024 * 2, (size_t)2048 * 1024 * 2}; \
        pg8::EpiSwiglu E{ACT, p.moe_b_in + (size_t)(L) * 32 * 2048, 1.0f}; \
        pg8::gemm_phase<pg8::EpiSwiglu, pg8::MoeOrder, true, true>(tid, LDSB, 1024, 1024, S, E); } while (0)
#define MOE_FAST2(L) do { MOE_TABLE(L) \
        pg8::MoeOrder S{(const char*)ACT, (const char*)(wts + WO_W2) + (size_t)(L) * 32 * 1024 * 1024 * 2, tile_e, nM_, 4, G, bid, (size_t)256 * 1024 * 2, (size_t)1024 * 1024 * 2}; \
        pg8::EpiBiasBf16 E{Y, p.moe_b_out + (size_t)(L) * 32 * 1024, 1.0f}; \
        pg8::gemm_phase<pg8::EpiBiasBf16, pg8::MoeOrder, true, true>(tid, LDSB, 1024, 1024, S, E); } while (0)
#define MOE_FAST1_F8(L) do { MOE_TABLE(L) \
        pg8::MoeOrder S{(const char*)XS, (const char*)(wts + WO_W1) + (size_t)(L) * 32 * 2048 * 1024 * 2, tile_e, nM_, 8, G, bid, (size_t)256 * 1024, (size_t)2048 * 1024}; \
        if constexpr (MOE_F8_DOWN) { pg8::EpiSwigluF8 E{(unsigned char*)ACT, p.moe_b_in + (size_t)(L) * 32 * 2048}; \
            pg8::gemm_phase<pg8::EpiSwigluF8, pg8::MoeOrder, true, true, true>(tid, LDSB, 1024, 1024, S, E); } \
        else { pg8::EpiSwiglu E{ACT, p.moe_b_in + (size_t)(L) * 32 * 2048, 0.03125f}; \
            pg8::gemm_phase<pg8::EpiSwiglu, pg8::MoeOrder, false, true, true>(tid, LDSB, 1024, 1024, S, E); } } while (0)
#define MOE_FAST2_F8(L) do { MOE_TABLE(L) \
        pg8::MoeOrder S{(const char*)ACT, (const char*)(wts + WO_W2) + (size_t)(L) * 32 * 1024 * 1024 * 2, tile_e, nM_, 4, G, bid, (size_t)256 * 1024, (size_t)1024 * 1024}; \
        if constexpr (Y8_L1 && (L) == 1) { pg8::EpiBiasF8 E{(unsigned char*)Y, p.moe_b_out + (size_t)(L) * 32 * 1024, 0.03125f}; \
            pg8::gemm_phase<pg8::EpiBiasF8, pg8::MoeOrder, true, true, true>(tid, LDSB, 1024, 1024, S, E); } \
        else { pg8::EpiBiasBf16 E{Y, p.moe_b_out + (size_t)(L) * 32 * 1024, 0.03125f}; \
            pg8::gemm_phase<pg8::EpiBiasBf16, pg8::MoeOrder, true, true, true>(tid, LDSB, 1024, 1024, S, E); } } while (0)
#define COMBINE_PRE(nrows) typedef int i4n_ __attribute__((ext_vector_type(4))); typedef float f4n_ __attribute__((ext_vector_type(4))); i4n_ sl0_, sl1_; f4n_ gt0_, gt1_; \
        { const int ra_ = gw < (nrows) ? gw : 0, rb_ = gw + NGW < (nrows) ? gw + NGW : ra_; sl0_ = *(const i4n_*)(TOKP + ra_ * 4); gt0_ = *(const f4n_*)(TOKG + ra_ * 4); sl1_ = *(const i4n_*)(TOKP + rb_ * 4); gt1_ = *(const f4n_*)(TOKG + rb_ * 4); }
#define COMBINE_ROWS2(L, v, nrows, F8Y) do { \
        const int slc_[2][4] = {{sl0_[0], sl0_[1], sl0_[2], sl0_[3]}, {sl1_[0], sl1_[1], sl1_[2], sl1_[3]}}; \
        const float gk_[2][4] = {{gt0_[0], gt0_[1], gt0_[2], gt0_[3]}, {gt1_[0], gt1_[1], gt1_[2], gt1_[3]}}; \
        uint4 ya_[2][4], yb_[2][4]; \
        _Pragma("unroll") for (int u = 0; u < 2; ++u) { const int r = rr_[u]; \
            _Pragma("unroll") for (int k = 0; k < 4; ++k) { \
                if constexpr (F8Y) { ya_[u][k] = *((const uint4*)((const unsigned char*)Y + (size_t)slc_[u][k] * 1024) + lane); yb_[u][k] = ya_[u][k]; } \
                else { const uint4* yr = (const uint4*)(Y + (size_t)slc_[u][k] * 1024 + 16 * lane); ya_[u][k] = yr[0]; yb_[u][k] = yr[1]; } } \
            ld16f(XR + (size_t)r * 1024 + 16 * lane, v[u]); } \
        { const int n0_ = r0_ + 2 * NGW; if (n0_ < (nrows)) { const int n1_ = n0_ + NGW < (nrows) ? n0_ + NGW : n0_; \
            sl0_ = *(const i4n_*)(TOKP + n0_ * 4); gt0_ = *(const f4n_*)(TOKG + n0_ * 4); sl1_ = *(const i4n_*)(TOKP + n1_ * 4); gt1_ = *(const f4n_*)(TOKG + n1_ * 4); } } \
        _Pragma("unroll") for (int u = 0; u < 2; ++u) { float f_[16]; \
            _Pragma("unroll") for (int j = 0; j < 16; ++j) f_[j] = 0.f; \
            _Pragma("unroll") for (int k = 0; k < 4; ++k) { \
                if constexpr (F8Y) { const int yw[4] = {(int)ya_[u][k].x, (int)ya_[u][k].y, (int)ya_[u][k].z, (int)ya_[u][k].w}; \
                    _Pragma("unroll") for (int j = 0; j < 4; ++j) { const auto lo_ = __builtin_amdgcn_cvt_pk_f32_fp8(yw[j], false); const auto hi_ = __builtin_amdgcn_cvt_pk_f32_fp8(yw[j], true); \
                        f_[4 * j] = fmaf(gk_[u][k], lo_[0], f_[4 * j]); f_[4 * j + 1] = fmaf(gk_[u][k], lo_[1], f_[4 * j + 1]); f_[4 * j + 2] = fmaf(gk_[u][k], hi_[0], f_[4 * j + 2]); f_[4 * j + 3] = fmaf(gk_[u][k], hi_[1], f_[4 * j + 3]); } } \
                else { const unsigned yw[8] = {ya_[u][k].x, ya_[u][k].y, ya_[u][k].z, ya_[u][k].w, yb_[u][k].x, yb_[u][k].y, yb_[u][k].z, yb_[u][k].w}; \
                    _Pragma("unroll") for (int j = 0; j < 8; ++j) { f_[2 * j] = fmaf(gk_[u][k], __uint_as_float(yw[j] << 16), f_[2 * j]); f_[2 * j + 1] = fmaf(gk_[u][k], __uint_as_float(yw[j] & 0xffff0000u), f_[2 * j + 1]); } } } \
            float g2v_[16]; ld16f(MOD + (size_t)((L) * 17 + mod_row_of(rr_[u])) * 6144 + 5120 + 16 * lane, g2v_);        \
            _Pragma("unroll") for (int j = 0; j < 16; ++j) v[u][j] = fmaf(g2v_[j], f_[j], v[u][j]); } } while (0)

    if (IN(7)) { PHASE_PTRS ROUTER_PHASE(0, NROW); }
    SEAM(7);
#if MOE_F8_L0
    if (IN(8)) { PHASE_PTRS PERMUTE_PHASE_F8(0, NROW); }
    SEAM(8);
    if (IN(9)) { PHASE_PTRS MOE_FAST1_F8(0); }
    SEAM(9);
#else
    if (IN(8)) { PHASE_PTRS PERMUTE_PHASE(0, NROW); }
    SEAM(8);
    if (IN(9)) { PHASE_PTRS MOE_FAST1(0); }
    SEAM(9);
#endif
    if (IN(10)) { PHASE_PTRS if constexpr (MOE_F8_L0 && MOE_F8_DOWN) { MOE_FAST2_F8(0); } else { MOE_FAST2(0); } }
    SEAM(10);

    if (IN(11)) { PHASE_PTRS
        float g[16]; ld16f(p.norm_mix_g + 1024 + 16 * lane, g);
        COMBINE_PRE(NROW)
        ROWS2(NROW) { ROWS2_IDX(NROW)
            float v[2][16]; COMBINE_ROWS2(0, v, NROW, false);
            st16f(XR + (size_t)rr_[0] * 1024 + 16 * lane, v[0]); if (two_) st16f(XR + (size_t)rr_[1] * 1024 + 16 * lane, v[1]);
            const float* mr0 = MOD + (size_t)(1 * 17 + mod_row_of(rr_[0])) * 6144 + 16 * lane; const float* mr1 = MOD + (size_t)(1 * 17 + mod_row_of(rr_[1])) * 6144 + 16 * lane;
            NORM_MOD16x2(v, g, mr0, mr1);
            if (INPROJ_F8) { st16f8((unsigned char*)H + (size_t)rr_[0] * 1024 + 16 * lane, v[0]); if (two_) st16f8((unsigned char*)H + (size_t)rr_[1] * 1024 + 16 * lane, v[1]); }
            else { st16bf(H + (size_t)rr_[0] * 1024 + 16 * lane, v[0]); if (two_) st16bf(H + (size_t)rr_[1] * 1024 + 16 * lane, v[1]); }
        }
    }
    SEAM(11);

    if (IN(12)) { PHASE_PTRS
        constexpr size_t ES_ = INPROJ_F8 ? 1 : 2;
        pg8::DenseOrder S{(const char*)H, (const char*)(wts + WO_C), NROW / 256, 6, G, bid, (size_t)256 * 1024 * ES_, (size_t)256 * 1024 * ES_};
        pg8::EpiStoreBf16 E{PRJ, PRJ_LD, INPROJ_F8 ? 0.03125f : 1.0f};
        pg8::gemm_phase<pg8::EpiStoreBf16, pg8::DenseOrder, true, true, INPROJ_F8 != 0>(tid, LDSB, 1024, 1024, S, E);
    }
    SEAM(12);

    if (IN(13)) { PHASE_PTRS
        const float2* TC = (const float2*)(tabs + TAB_C); const float kg1 = p.c_k_g[lane], kg2 = p.c_k_g[64 + lane];
        for (int r = gw; r < NROW; r += NGW) {
            bf16_t* pr = PRJ + (size_t)r * PRJ_LD + 1024; float2 t = make_float2(1.f, 0.f); if (r < NLAT) t = TC[(r % SEQ) * 64 + lane];
#pragma unroll
            for (int kv = 0; kv < 2; ++kv) { float x1 = bf2f(pr[kv * 128 + lane]), x2 = bf2f(pr[kv * 128 + 64 + lane]);
                const float ss = wave_sum(x1 * x1 + x2 * x2); const float ri = 1.0f / sqrtf(ss * (1.0f / 128.0f) + RMS_EPS);
                x1 = x1 * ri * kg1; x2 = x2 * ri * kg2;
                pr[kv * 128 + lane] = f2bf(x1 * t.x - x2 * t.y); pr[kv * 128 + 64 + lane] = f2bf(x2 * t.x + x1 * t.y); }
        }
    }
    SEAM(13);

    if (IN(14)) { PHASE_PTRS
        for (int i = 0;; ++i) { const int u = i * G + bid; if (u >= 1024) break;
            const int rest = u >> 3; const int b = 2 * (u & 7) + (rest >> 6), h = (rest & 63) >> 3, qb = rest & 7; const int qrow0 = b * SEQ + qb * 256;
            fa::Unit U; U.Q = PRJ + (size_t)qrow0 * PRJ_LD + h * 128; U.K = PRJ + 1024 + (h >> 2) * 128; U.K2 = nullptr; U.V = PRJ + 1280 + (h >> 2) * 128;
            U.O = OUTPROJ_F8 ? (bf16_t*)((unsigned char*)OB + (size_t)qrow0 * 1024 + h * 128) : OB + (size_t)qrow0 * 1024 + h * 128; U.rowa = NLAT + b * NCX; U.nta = 4; U.rowb = b * SEQ; U.ntb = 32;
            U.window = 0; U.qpos0 = 0; U.kposb0 = 0; U.sink = 0.f; U.has_sink = 0; U.tab = (const float*)(tabs + TAB_C); U.pos0 = qb * 256; U.qg = (const float*)(tabs + TAB_QG);
            fa::attn_unit<128, 128, PRJ_LD, PRJ_LD, PRJ_LD, 1024, false, 0, 4, true, false, OUTPROJ_F8 != 0>(tid, U, (char*)lds_raw); }
    }
    SEAM(14);

    if (IN(15)) { PHASE_PTRS
        constexpr size_t ES_ = OUTPROJ_F8 ? 1 : 2;
        pg8::DenseOrder S{(const char*)OB, (const char*)(wts + WO_CO), NLAT / 256, 4, G, bid, (size_t)256 * 1024 * ES_, (size_t)256 * 1024 * ES_};
        pg8::EpiResid E{XR, XR, XR, MOD + 17 * 6144 + 2048, OUTPROJ_F8 ? 0.03125f : 1.0f};
        pg8::gemm_phase<pg8::EpiResid, pg8::DenseOrder, true, true, OUTPROJ_F8 != 0>(tid, LDSB, 1024, 1024, S, E);
    }
    SEAM(15);

    if (IN(16)) { PHASE_PTRS ROUTER_PHASE(1, NLAT); }
    SEAM(16);
#if MOE_F8_L1
    if (IN(17)) { PHASE_PTRS PERMUTE_PHASE_F8(1, NLAT); }
    SEAM(17);
    if (IN(18)) { PHASE_PTRS MOE_FAST1_F8(1); }
    SEAM(18);
    if (IN(19)) { PHASE_PTRS if constexpr (MOE_F8_DOWN) { MOE_FAST2_F8(1); } else { MOE_FAST2(1); } }
    SEAM(19);
#else
    if (IN(17)) { PHASE_PTRS PERMUTE_PHASE(1, NLAT); }
    SEAM(17);
    if (IN(18)) { PHASE_PTRS MOE_FAST1(1); }
    SEAM(18);
    if (IN(19)) { PHASE_PTRS MOE_FAST2(1); }
    SEAM(19);
#endif

    if (IN(20)) { PHASE_PTRS
        float g[16]; ld16f(p.final_g + 16 * lane, g);
        COMBINE_PRE(NLAT)
        ROWS2(NLAT) { ROWS2_IDX(NLAT)
            float v[2][16]; COMBINE_ROWS2(1, v, NLAT, (Y8_L1 && MOE_F8_L1 && MOE_F8_DOWN));
            float s0 = 0.f, s1 = 0.f;
#pragma unroll
            for (int j = 0; j < 16; ++j) { s0 = fmaf(v[0][j], v[0][j], s0); s1 = fmaf(v[1][j], v[1][j], s1); }
            wave_sum2(s0, s1); const float ri0 = 1.0f / sqrtf(s0 * (1.0f / 1024.0f) + RMS_EPS), ri1 = 1.0f / sqrtf(s1 * (1.0f / 1024.0f) + RMS_EPS);
#pragma unroll
            for (int j = 0; j < 16; ++j) { v[0][j] = v[0][j] * ri0 * g[j]; v[1][j] = v[1][j] * ri1 * g[j]; }
            st16f(p.out + (size_t)rr_[0] * 1024 + 16 * lane, v[0]); if (two_) st16f(p.out + (size_t)rr_[1] * 1024 + 16 * lane, v[1]);
        }
    }
#undef IN
#undef SEAM
}

#ifndef MK_PER_PHASE
#define MK_PER_PHASE 0
#endif
extern "C" void kernel_launch(void* const* d_in, const int* in_sizes, int n_in, void* d_out, int out_size, void* d_ws, size_t ws_size, hipStream_t stream) {
    static int grid = 0;
    if (grid == 0) {
        if (n_in != 26 || out_size != NLAT * DM || ws_size < WS_END) { fprintf(stderr, "kernel_launch: unexpected shapes (n_in %d out %d ws %zu need %zu)\n", n_in, out_size, ws_size, (size_t)WS_END); grid = -1; return; }
        int dev = 0, cus = 0;
        if (hipGetDevice(&dev) != hipSuccess || hipDeviceGetAttribute(&cus, hipDeviceAttributeMultiprocessorCount, dev) != hipSuccess) { grid = -1; return; }
        if (hipFuncSetAttribute((const void*)fwd_kernel, hipFuncAttributeMaxDynamicSharedMemorySize, LDS_BYTES) != hipSuccess) { fprintf(stderr, "kernel_launch: hipFuncSetAttribute failed\n"); grid = -1; return; }
        int per_cu = 0;
        if (hipOccupancyMaxActiveBlocksPerMultiprocessor(&per_cu, (const void*)fwd_kernel, NTHR, LDS_BYTES) != hipSuccess || per_cu < 1) { fprintf(stderr, "kernel_launch: occupancy query says %d\n", per_cu); }
        (void)hipGetLastError();
        grid = cus;
    }
    if (grid < 0) return;
    (void)hipMemsetAsync((char*)d_ws + WS_CTL, 0, CTL_BYTES, stream);
    Params p{};
    const float** pp = (const float**)&p;
    for (int i = 0; i < 26; ++i) pp[i] = (const float*)d_in[i];
    p.out = (float*)d_out; p.ws = (unsigned char*)d_ws;
#if MK_PER_PHASE
    for (int k = 0; k < N_PHASES; ++k) { p.ph_lo = k; p.ph_hi = k + 1; hipLaunchKernelGGL(fwd_kernel, dim3(grid), dim3(NTHR), LDS_BYTES, stream, p); }
#else
    p.ph_lo = 0; p.ph_hi = N_PHASES;
    hipLaunchKernelGGL(fwd_kernel, dim3(grid), dim3(NTHR), LDS_BYTES, stream, p);
#endif
}
```

```cpp
#include <hip/hip_runtime.h>
#include <cstdio>
#include <cstdint>

typedef unsigned short bf16_t;
typedef bf16_t act_t;
#define GAS __attribute__((address_space(1)))
#define LAS __attribute__((address_space(3)))

constexpr int DM = 1024, NB = 16, SEQ = 2048, NCX = 256, GRIDW = 64;
constexpr int NLAT = NB * SEQ, NCTX = NB * NCX, NROW = NLAT + NCTX;
constexpr int AB_IN = 1440, C_IN = 1536, PRJ_LD = 1536;
constexpr int NEXP = 32, DFF = 1024;
constexpr int CAP = 155648;
constexpr float RMS_EPS = 1e-6f;
constexpr int NTHR = 512;

constexpr size_t MiB = 1u << 20;
constexpr size_t ASZ = sizeof(act_t);
constexpr size_t WS_CTL = 0, CTL_BYTES = 1 * MiB;
constexpr size_t WS_MOD = 1 * MiB;
constexpr size_t WS_TOKE = 2 * MiB, WS_TOKP = 3 * MiB, WS_TOKG = 4 * MiB;
constexpr size_t WS_RINV = 5 * MiB;
constexpr size_t WS_TAB = 6 * MiB;
constexpr size_t TAB_A = 0, TAB_B = (size_t)SEQ * 32 * 8, TAB_C = TAB_B + (size_t)SEQ * 16 * 8, TAB_QG = TAB_C + (size_t)SEQ * 64 * 8;
constexpr size_t WS_XR = 16 * MiB;
constexpr size_t WS_H = WS_XR + 144 * MiB;
constexpr size_t WS_BIG = WS_H + (size_t)NROW * 1024 * ASZ;
constexpr size_t OFF_PRJ = 0;
constexpr size_t OFF_QB = OFF_PRJ + (size_t)NROW * 1536 * ASZ;
constexpr size_t OFF_KVB = OFF_QB + (size_t)NROW * 768 * ASZ;
constexpr size_t OFF_O = OFF_KVB + (size_t)NROW * 1024 * ASZ;
constexpr size_t BIG_A = OFF_O + (size_t)NROW * 1024 * ASZ;
constexpr size_t BIG_Y = (size_t)CAP * 1024 * ASZ;
constexpr size_t BIG_BYTES = BIG_A > BIG_Y ? BIG_A : BIG_Y;
constexpr size_t WS_ACT = WS_BIG + BIG_BYTES;
constexpr size_t WS_XS = WS_ACT + (size_t)CAP * 1024 * ASZ;
constexpr size_t WS_W = WS_XS + (size_t)CAP * 1024 * ASZ;
constexpr size_t WO_AB = 0;
constexpr size_t WO_QB = WO_AB + (size_t)1536 * 1024 * 2;
constexpr size_t WO_KVB = WO_QB + (size_t)768 * 384 * 2;
constexpr size_t WO_ABO = WO_KVB + (size_t)1024 * 256 * 2;
constexpr size_t WO_C = WO_ABO + (size_t)1024 * 1024 * 2;
constexpr size_t WO_CO = WO_C + (size_t)1536 * 1024 * 2;
constexpr size_t WO_W1 = WO_CO + (size_t)1024 * 1024 * 2;
constexpr size_t WO_W2 = WO_W1 + (size_t)64 * 2048 * 1024 * 2;
constexpr size_t WS_END = WS_W + WO_W2 + (size_t)64 * 1024 * 1024 * 2;

constexpr int CW_CNT = 64;
constexpr int CW_BAR = 4096;

__device__ __forceinline__ float bf2f(bf16_t v) { return __uint_as_float(((unsigned)v) << 16); }
__device__ __forceinline__ bf16_t f2bf(float f) { unsigned u = __float_as_uint(f); return (bf16_t)((u + 0x7fffu + ((u >> 16) & 1u)) >> 16); }
__device__ __forceinline__ float ldA(const float* p) { return *p; }
__device__ __forceinline__ float ldA(const bf16_t* p) { return bf2f(*p); }
__device__ __forceinline__ void stA(float* p, float v) { *p = v; }
__device__ __forceinline__ void stA(bf16_t* p, float v) { *p = f2bf(v); }
template <int N> __device__ __forceinline__ void load_vec(const float* p, float (&o)[N]) {
#pragma unroll
    for (int i = 0; i < N / 4; ++i) { const float4 t = ((const float4*)p)[i]; o[4 * i] = t.x; o[4 * i + 1] = t.y; o[4 * i + 2] = t.z; o[4 * i + 3] = t.w; }
}
template <int N> __device__ __forceinline__ void load_vec(const bf16_t* p, float (&o)[N]) {
#pragma unroll
    for (int i = 0; i < N / 8; ++i) { const uint4 t = ((const uint4*)p)[i];
        o[8 * i] = __uint_as_float(t.x << 16); o[8 * i + 1] = __uint_as_float(t.x & 0xffff0000u); o[8 * i + 2] = __uint_as_float(t.y << 16); o[8 * i + 3] = __uint_as_float(t.y & 0xffff0000u);
        o[8 * i + 4] = __uint_as_float(t.z << 16); o[8 * i + 5] = __uint_as_float(t.z & 0xffff0000u); o[8 * i + 6] = __uint_as_float(t.w << 16); o[8 * i + 7] = __uint_as_float(t.w & 0xffff0000u); }
}
__device__ __forceinline__ float wave_sum(float v) {
#pragma unroll
    for (int o = 1; o < 64; o <<= 1) v += __shfl_xor(v, o);
    return v;
}

__device__ __forceinline__ void wave_sum2(float& a, float& b) {
#pragma unroll
    for (int o = 1; o < 64; o <<= 1) { const float ta = __shfl_xor(a, o), tb = __shfl_xor(b, o); a += ta; b += tb; }
}
__device__ __forceinline__ void ld16f(const float* p, float (&v)[16]) {
#pragma unroll
    for (int i = 0; i < 4; ++i) { const float4 t = ((const float4*)p)[i]; v[4 * i] = t.x; v[4 * i + 1] = t.y; v[4 * i + 2] = t.z; v[4 * i + 3] = t.w; }
}
__device__ __forceinline__ void st16f(float* p, const float (&v)[16]) {
#pragma unroll
    for (int i = 0; i < 4; ++i) ((float4*)p)[i] = make_float4(v[4 * i], v[4 * i + 1], v[4 * i + 2], v[4 * i + 3]);
}
__device__ __forceinline__ unsigned cvtpk2(float lo, float hi) { unsigned r; asm volatile("v_cvt_pk_bf16_f32 %0, %1, %2" : "=v"(r) : "v"(lo), "v"(hi)); return r; }
__device__ __forceinline__ void st16bf(bf16_t* p, const float (&v)[16]) {
    ((uint4*)p)[0] = make_uint4(cvtpk2(v[0], v[1]), cvtpk2(v[2], v[3]), cvtpk2(v[4], v[5]), cvtpk2(v[6], v[7]));
    ((uint4*)p)[1] = make_uint4(cvtpk2(v[8], v[9]), cvtpk2(v[10], v[11]), cvtpk2(v[12], v[13]), cvtpk2(v[14], v[15]));
}

__device__ __forceinline__ void st16f8(unsigned char* p, const float (&v)[16]) {
    int o[4];
#pragma unroll
    for (int j = 0; j < 4; ++j) { const int t = __builtin_amdgcn_cvt_pk_fp8_f32(v[4 * j], v[4 * j + 1], 0, false); o[j] = __builtin_amdgcn_cvt_pk_fp8_f32(v[4 * j + 2], v[4 * j + 3], t, true); }
    *(int4*)p = make_int4(o[0], o[1], o[2], o[3]);
}
#define XB_TMO      128
#define XB_XCNT(j)  (256  + 64 * (j))
#define XB_XSUB(j)  (1280 + 64 * (j))
#define XB_XGEN(j)  (2304 + 64 * (j))
#define XB_TOP      3328
#define XB_TOPGEN   3392
#define XCD_BAR_WORDS 3456
#define XB_SPIN_CAP (1u << 22)
__device__ __forceinline__ unsigned xb_ld(unsigned* p)              { return __hip_atomic_load(p, __ATOMIC_RELAXED, __HIP_MEMORY_SCOPE_AGENT); }
__device__ __forceinline__ unsigned xb_add(unsigned* p, unsigned v) { return __hip_atomic_fetch_add(p, v, __ATOMIC_RELAXED, __HIP_MEMORY_SCOPE_AGENT); }
__device__ __forceinline__ unsigned xb_xcc_id() { return (unsigned)__builtin_amdgcn_s_getreg((3 << 11) | 20) & 0xFu; }
#define XB_SPIN(cond, bar) do { unsigned _sp = 0; while (cond) { __builtin_amdgcn_s_sleep(1); \
    if ((++_sp & 255u) == 0u) { if (xb_ld(&(bar)[XB_TMO])) break; if (_sp > XB_SPIN_CAP) { atomicAdd(&(bar)[XB_TMO], 1u); break; } } } } while (0)
struct XcdBarrier { unsigned* bar; unsigned x; volatile LAS unsigned* st; };
__device__ __forceinline__ bool xb_is_leader(int wave0) { return wave0 == 0 && __builtin_amdgcn_mbcnt_hi(~0u, __builtin_amdgcn_mbcnt_lo(~0u, 0u)) == 0u; }
__device__ __forceinline__ XcdBarrier xcd_barrier_post(unsigned* bar, volatile LAS unsigned* st, int wave0) {
    XcdBarrier b; b.bar = bar; b.x = xb_xcc_id(); b.st = st;
    if (xb_is_leader(wave0)) (void)xb_add(&bar[XB_XCNT(b.x)], 1u);
    return b;
}
__device__ __forceinline__ void xcd_barrier_complete(unsigned* bar, unsigned x, unsigned& nloc, unsigned& nx) {
    const unsigned G = gridDim.x * gridDim.y * gridDim.z;
    unsigned sum, cnt, mine, sp = 0u;
    for (;;) {
        sum = 0u; cnt = 0u; mine = 0u;
#pragma unroll
        for (unsigned j = 0; j < 16; ++j) { const unsigned c = xb_ld(&bar[XB_XCNT(j)]); sum += c; cnt += (c > 0u) ? 1u : 0u; mine = (j == x) ? c : mine; }
        if (sum == G) break;
        __builtin_amdgcn_s_sleep(1);
        if ((++sp & 255u) == 0u) { if (xb_ld(&bar[XB_TMO])) break; if (sp > XB_SPIN_CAP) { atomicAdd(&bar[XB_TMO], 1u); break; } }
    }
    nloc = mine > 0u ? mine : 1u; nx = cnt > 0u ? cnt : 1u;
}
__device__ __forceinline__ void xcd_barrier(const XcdBarrier& b, int wave0) {
    asm volatile("s_waitcnt vmcnt(0)" ::: "memory");
    __syncthreads();
    if (xb_is_leader(wave0)) {
        unsigned* bar = b.bar;
        __builtin_amdgcn_s_waitcnt(0);
        unsigned nloc = b.st[0], nx = b.st[1];
        if (nloc == 0u) { xcd_barrier_complete(bar, b.x, nloc, nx); b.st[0] = nloc; b.st[1] = nx; }
        const unsigned old = xb_add(&bar[XB_XSUB(b.x)], 1u);
        const unsigned gen = old / nloc;
        if (old + 1u == (gen + 1u) * nloc) {
            __builtin_amdgcn_fence(__ATOMIC_RELEASE, "agent");
            asm volatile("s_waitcnt vmcnt(0)" ::: "memory");
            const unsigned og = xb_add(&bar[XB_TOP], 1u);
            const unsigned tg = og / nx;
            if (og + 1u == (tg + 1u) * nx) xb_add(&bar[XB_TOPGEN], 1u);
            else XB_SPIN(xb_ld(&bar[XB_TOPGEN]) == tg, bar);
            __builtin_amdgcn_fence(__ATOMIC_ACQUIRE, "agent");
            xb_add(&bar[XB_XGEN(b.x)], 1u);
            asm volatile("s_waitcnt vmcnt(0)" ::: "memory");
        } else {
            XB_SPIN(xb_ld(&bar[XB_XGEN(b.x)]) == gen, bar);
            __builtin_amdgcn_fence(__ATOMIC_ACQUIRE, "agent");
            asm volatile("s_waitcnt vmcnt(0)" ::: "memory");
        }
    }
    __syncthreads();
}


#ifndef FAST_GEMM
#define FAST_GEMM 1
#endif
namespace pg8 {
#define PG8_LAS __attribute__((address_space(3)))
typedef short bf16x8 __attribute__((ext_vector_type(8)));
typedef float f32x4 __attribute__((ext_vector_type(4)));
typedef unsigned u32x4 __attribute__((ext_vector_type(4)));
constexpr int BM = 256, BK = 64, HALF = 128, HTB = HALF * BK * 2  , STAGE_BYTES = 8 * HTB, NXCD = 8, WGM = 8;

__host__ __device__ __forceinline__ int lds_byte(int r, int c) { const int st = (r >> 4) * 2 + (c >> 5), rr = r & 15, cc = c & 31, ob = rr * 64 + cc * 2; return st * 1024 + (ob ^ (((ob >> 9) & 1) << 5)); }
__host__ __device__ __forceinline__ void stage_rc(int b, int& R, int& C) { const int st = b / 1024, sb = b % 1024, swz = sb ^ (((sb >> 9) & 1) << 5); R = (st >> 1) * 16 + swz / 64; C = (st & 1) * 32 + (swz % 64) / 2; }
__host__ __device__ __forceinline__ int perm32(int rho) { const int n = rho >> 4, i = rho & 15; return 8 * (i >> 2) + 4 * n + (i & 3); }


struct Unit { const char* a; const char* b; int pm, pn, aux; };
__device__ __forceinline__ unsigned cvt_pk_bf16(float lo, float hi) { unsigned r; asm volatile("v_cvt_pk_bf16_f32 %0, %1, %2" : "=v"(r) : "v"(lo), "v"(hi)); return r; }
typedef int v8i32 __attribute__((ext_vector_type(8)));
__device__ __forceinline__ v8i32 cat16(bf16x8 lo, bf16x8 hi) { typedef int v4i32 __attribute__((ext_vector_type(4))); const v4i32 a = __builtin_bit_cast(v4i32, lo), b = __builtin_bit_cast(v4i32, hi); return __builtin_shufflevector(a, b, 0, 1, 2, 3, 4, 5, 6, 7); }
template <class Epi, class Sched, bool ALIGN_EPI = false, bool SP2 = false, bool F8 = false>
__device__ __forceinline__ void gemm_phase(const int tid, PG8_LAS unsigned char* lds, const int K, const int lda, const Sched& S, const Epi& E) {
    const int wid = __builtin_amdgcn_readfirstlane(tid >> 6), lane = tid & 63, wr = wid >> 2, wc = wid & 3, fr = lane & 15, fq = lane >> 4;
    const int nt = F8 ? K / (2 * BK) : K / BK;
    unsigned voffA[2], voffB[2];
#pragma unroll
    for (int i = 0; i < 2; ++i) { int R, C; stage_rc(tid * 16 + i * 8192, R, C); const int Rb = Epi::PERM ? ((R & ~31) + perm32(R & 31)) : R;
        voffA[i] = F8 ? (unsigned)(R * lda + 2 * C) : (unsigned)(R * lda + C) * 2u; voffB[i] = F8 ? (unsigned)(Rb * K + 2 * C) : (unsigned)(Rb * K + C) * 2u; }
    const size_t kstep = (size_t)(BK * 2);
    const size_t hstepA = (size_t)HALF * lda * (F8 ? 1 : 2);
    const size_t hstep = (size_t)HALF * K * (F8 ? 1 : 2);
    const unsigned ldsbase = (unsigned)__builtin_amdgcn_readfirstlane((int)((unsigned)(uintptr_t)lds + (unsigned)wid * 1024u));
    const unsigned ldsw = (unsigned)wid * 1024u;
    const int aoff = lds_byte(wr * 64 + fr, fq * 8), boff = lds_byte(wc * 32 + fr, fq * 8);
#define PG8_SA(b, h) (((b) * 2 + (h)) * HTB)
#define PG8_SB(b, h) ((4 + (b) * 2 + (h)) * HTB)
#define PG8_STAGE(bufoff, gbase, voff) do { _Pragma("unroll") for (int _i = 0; _i < 2; ++_i) { \
        if constexpr (F8) { unsigned keep_; asm volatile("s_mov_b32 %0, m0\n\ts_mov_b32 m0, %3\n\ts_nop 0\n\tglobal_load_lds_dwordx4 %1, %2\n\ts_mov_b32 m0, %0" : "=&s"(keep_) : "v"((voff)[_i]), "s"((const char*)(gbase)), "s"(ldsbase + (unsigned)((bufoff) + _i * 8192)) : "memory"); } \
        else __builtin_amdgcn_global_load_lds((const unsigned*)((const char*)(gbase) + (voff)[_i]), (PG8_LAS unsigned*)(lds + (bufoff) + ldsw + _i * 8192), 16, 0, 0); } } while (0)
#define PG8_LDA(dst, b, h) do { _Pragma("unroll") for (int m = 0; m < 4; ++m) { _Pragma("unroll") for (int k = 0; k < 2; ++k) dst[m][k] = *(const PG8_LAS bf16x8*)(lds + PG8_SA(b, h) + aoff + m * 2048 + k * 1024); \
        if constexpr (F8) dst##8[m] = cat16(dst[m][0], dst[m][1]); } } while (0)
#define PG8_LDB(dst, b, h) do { _Pragma("unroll") for (int n = 0; n < 2; ++n) { _Pragma("unroll") for (int k = 0; k < 2; ++k) dst[n][k] = *(const PG8_LAS bf16x8*)(lds + PG8_SB(b, h) + boff + n * 2048 + k * 1024); \
        if constexpr (F8) dst##8[n] = cat16(dst[n][0], dst[n][1]); } } while (0)
#define PG8_MMA(ai, bj, At, Bt) do { __builtin_amdgcn_s_setprio(1); _Pragma("unroll") for (int m = 0; m < 4; ++m) _Pragma("unroll") for (int n = 0; n < 2; ++n) { \
        if constexpr (F8) acc[ai][bj][m][n] = __builtin_amdgcn_mfma_scale_f32_16x16x128_f8f6f4(Bt##8[n], At##8[m], acc[ai][bj][m][n], 0, 0, 0, 0x7f7f7f7f, 0, 0x7f7f7f7f); \
        else { _Pragma("unroll") for (int k = 0; k < 2; ++k) acc[ai][bj][m][n] = __builtin_amdgcn_mfma_f32_16x16x32_bf16(Bt[n][k], At[m][k], acc[ai][bj][m][n], 0, 0, 0); } } __builtin_amdgcn_s_setprio(0); } while (0)
#define PG8_WAIT_V(n) asm volatile("s_waitcnt vmcnt(" #n ")" ::: "memory")
#define PG8_WAIT_L(n) asm volatile("s_waitcnt lgkmcnt(" #n ")" ::: "memory")
#define PG8_BAR __builtin_amdgcn_s_barrier()
#define PG8_SCHED __builtin_amdgcn_sched_barrier(0)
    Unit cur, nxt; int ui = 0;
    if (!S.next(0, cur)) return;
    f32x4 acc[2][2][4][2];
#pragma unroll
    for (int a = 0; a < 2; ++a)
#pragma unroll
        for (int b = 0; b < 2; ++b)
#pragma unroll
            for (int m = 0; m < 4; ++m)
#pragma unroll
                for (int n = 0; n < 2; ++n) acc[a][b][m][n] = (f32x4){0.f, 0.f, 0.f, 0.f};
    bf16x8 At[4][2], B0[2][2], B1[2][2]; v8i32 At8[4], B08[2], B18[2]; (void)At8; (void)B08; (void)B18;
    const char* cA = cur.a; const char* cB = cur.b;
    S.a_ready(cur);
    if constexpr (SP2) {
        PG8_STAGE(PG8_SB(0, 0), cB, voffB); PG8_STAGE(PG8_SB(0, 1), cB + hstep, voffB); PG8_STAGE(PG8_SA(0, 0), cA, voffA); PG8_STAGE(PG8_SA(0, 1), cA + hstepA, voffA);
        if (wr == 1) PG8_BAR;
        PG8_WAIT_V(2); PG8_BAR;
        PG8_STAGE(PG8_SB(1, 0), cB + kstep, voffB); PG8_STAGE(PG8_SA(1, 0), cA + kstep, voffA); PG8_STAGE(PG8_SB(1, 1), cB + hstep + kstep, voffB);
        PG8_WAIT_V(6); PG8_BAR;
    } else {
        PG8_STAGE(PG8_SB(0, 0), cB, voffB); PG8_STAGE(PG8_SA(0, 0), cA, voffA); PG8_STAGE(PG8_SB(0, 1), cB + hstep, voffB); PG8_STAGE(PG8_SA(0, 1), cA + hstepA, voffA);
        if (wr == 1) PG8_BAR;
        PG8_WAIT_V(4); PG8_BAR;
        PG8_STAGE(PG8_SB(1, 0), cB + kstep, voffB); PG8_STAGE(PG8_SA(1, 0), cA + kstep, voffA); PG8_STAGE(PG8_SB(1, 1), cB + hstep + kstep, voffB);
        PG8_WAIT_V(6); PG8_BAR;
    }
    for (;;) {
        const bool has_next = S.next(ui + 1, nxt);
        const char* nA = has_next ? nxt.a : cA; const char* nB = has_next ? nxt.b : cB;
#pragma unroll 1
        for (int t = 0; t < nt; t += 2) {
            const bool last = (t == nt - 2);
            const char* a1 = cA + (size_t)(t + 1) * kstep;
            const char* a2 = last ? nA : cA + (size_t)(t + 2) * kstep; const char* b2 = last ? nB : cB + (size_t)(t + 2) * kstep;
            const char* a3 = a2 + kstep; const char* b3 = b2 + kstep;
            if (last && has_next) S.a_ready(nxt);
            if constexpr (SP2) {
            PG8_LDB(B0, 0, 0); PG8_LDB(B1, 0, 1); PG8_SCHED; PG8_LDA(At, 0, 0); PG8_STAGE(PG8_SA(1, 1), a1 + hstepA, voffA);
            PG8_WAIT_V(8); PG8_WAIT_L(0); PG8_BAR; PG8_MMA(0, 0, At, B0); PG8_MMA(0, 1, At, B1); PG8_BAR; PG8_SCHED;
            PG8_LDA(At, 0, 1); PG8_STAGE(PG8_SB(0, 0), b2, voffB); PG8_STAGE(PG8_SB(0, 1), b2 + hstep, voffB); PG8_STAGE(PG8_SA(0, 0), a2, voffA);
            PG8_WAIT_V(8); PG8_WAIT_L(0); PG8_BAR; PG8_MMA(1, 0, At, B0); PG8_MMA(1, 1, At, B1); PG8_BAR; PG8_SCHED;
            PG8_LDB(B0, 1, 0); PG8_LDB(B1, 1, 1); PG8_SCHED; PG8_LDA(At, 1, 0); PG8_STAGE(PG8_SA(0, 1), a2 + hstepA, voffA);
            PG8_WAIT_V(8); PG8_WAIT_L(0); PG8_BAR; PG8_MMA(0, 0, At, B0); PG8_MMA(0, 1, At, B1); PG8_BAR; PG8_SCHED;
            PG8_LDA(At, 1, 1); PG8_STAGE(PG8_SB(1, 0), b3, voffB); PG8_STAGE(PG8_SB(1, 1), b3 + hstep, voffB); PG8_STAGE(PG8_SA(1, 0), a3, voffA);
            PG8_WAIT_V(8); PG8_WAIT_L(0); PG8_BAR; PG8_MMA(1, 0, At, B0); PG8_MMA(1, 1, At, B1); PG8_BAR; PG8_SCHED;
            } else {
            PG8_LDB(B0, 0, 0); PG8_SCHED; PG8_LDA(At, 0, 0); PG8_STAGE(PG8_SA(1, 1), a1 + hstepA, voffA);
            PG8_WAIT_L(8); PG8_BAR; PG8_WAIT_L(0); PG8_MMA(0, 0, At, B0); PG8_BAR; PG8_SCHED;
            PG8_LDB(B1, 0, 1); PG8_STAGE(PG8_SB(0, 0), b2, voffB);
            PG8_BAR; PG8_WAIT_L(0); PG8_MMA(0, 1, At, B1); PG8_BAR;
            PG8_LDA(At, 0, 1); PG8_STAGE(PG8_SA(0, 0), a2, voffA);
            PG8_BAR; PG8_WAIT_L(0); PG8_MMA(1, 0, At, B0); PG8_BAR; PG8_SCHED;
            PG8_STAGE(PG8_SB(0, 1), b2 + hstep, voffB);
            PG8_WAIT_V(6); PG8_BAR; PG8_MMA(1, 1, At, B1); PG8_BAR;
            PG8_LDB(B0, 1, 0); PG8_SCHED; PG8_LDA(At, 1, 0); PG8_STAGE(PG8_SA(0, 1), a2 + hstepA, voffA);
            PG8_WAIT_L(8); PG8_BAR; PG8_WAIT_L(0); PG8_MMA(0, 0, At, B0); PG8_BAR; PG8_SCHED;
            PG8_LDB(B1, 1, 1); PG8_STAGE(PG8_SB(1, 0), b3, voffB);
            PG8_BAR; PG8_WAIT_L(0); PG8_MMA(0, 1, At, B1); PG8_BAR;
            PG8_LDA(At, 1, 1); PG8_STAGE(PG8_SA(1, 0), a3, voffA);
            PG8_BAR; PG8_WAIT_L(0); PG8_MMA(1, 0, At, B0); PG8_BAR; PG8_SCHED;
            PG8_STAGE(PG8_SB(1, 1), b3 + hstep, voffB);
            PG8_WAIT_V(6); PG8_BAR; PG8_MMA(1, 1, At, B1); PG8_BAR;
            }
        }
        if constexpr (ALIGN_EPI) { if (wr == 0) PG8_BAR; }
        if constexpr (!Epi::AFTER_DRAIN) { int tl_ = tid; asm volatile("" : "+v"(tl_)); E(acc, cur, wr, wc, tl_ & 15, (tl_ & 63) >> 4); S.done(cur); }
        if (!has_next) break;
#pragma unroll
        for (int a = 0; a < 2; ++a)
#pragma unroll
            for (int b = 0; b < 2; ++b)
#pragma unroll
                for (int m = 0; m < 4; ++m)
#pragma unroll
                    for (int n = 0; n < 2; ++n) acc[a][b][m][n] = (f32x4){0.f, 0.f, 0.f, 0.f};
        cur = nxt; cA = nA; cB = nB; ++ui;
        if constexpr (ALIGN_EPI) { if (wr == 1) PG8_BAR; }
    }
    PG8_WAIT_V(0);
    if constexpr (!ALIGN_EPI) { if (wr == 0) PG8_BAR; }
    PG8_BAR;
    if constexpr (Epi::AFTER_DRAIN) { E.fused(acc, cur, wr, wc, fr, fq, lds, wid, lane); S.done(cur); }
#undef PG8_SA
#undef PG8_SB
#undef PG8_STAGE
#undef PG8_LDA
#undef PG8_LDB
#undef PG8_MMA
#undef PG8_WAIT_V
#undef PG8_WAIT_L
#undef PG8_BAR
#undef PG8_SCHED
}
}
namespace pg8 {
struct OrderMap {
    __device__ __forceinline__ static bool map(int i, int G, int c, int nM, int nN, int& pm, int& pn) {
        const int nwg = nM * nN; const long L = (long)i * G + c; if (L >= nwg) return false;
        int wgid = (int)L; { const int q = nwg / NXCD, r = nwg % NXCD, xcd = wgid % NXCD, off = wgid / NXCD; wgid = (xcd < r ? xcd * (q + 1) : r * (q + 1) + (xcd - r) * q) + off; }
        const int nig = WGM * nN, gid = wgid / nig, fm = gid * WGM, gsz = (nM - fm) < WGM ? (nM - fm) : WGM;
        pm = fm + ((wgid % nig) % gsz); pn = (wgid % nig) / gsz; return true;
    }
};
struct DenseOrder {
    const char* A; const char* B; int nM, nN, G, c; size_t tstepA, tstepB;
    __device__ __forceinline__ bool next(int i, Unit& u) const { int pm, pn; if (!OrderMap::map(i, G, c, nM, nN, pm, pn)) return false; u.pm = pm; u.pn = pn; u.aux = 0; u.a = A + (size_t)pm * tstepA; u.b = B + (size_t)pn * tstepB; return true; }
    __device__ __forceinline__ void a_ready(const Unit&) const {}
    __device__ __forceinline__ void done(const Unit&) const {}
};
struct MoeOrder {
    const char* A; const char* B; const PG8_LAS int* tile_e; int nM, nN, G, c; size_t tstep, estep;
    __device__ __forceinline__ bool next(int i, Unit& u) const { int pm, pn; if (!OrderMap::map(i, G, c, nM, nN, pm, pn)) return false; const int e = __builtin_amdgcn_readfirstlane(tile_e[pm]); u.pm = pm; u.pn = pn; u.aux = e;
        u.a = A + (size_t)pm * tstep; u.b = B + (size_t)e * estep + (size_t)pn * tstep; return true; }
    __device__ __forceinline__ void a_ready(const Unit&) const {}
    __device__ __forceinline__ void done(const Unit&) const {}
};
struct EpiStoreBf16 { static constexpr bool PERM = true, AFTER_DRAIN = false;
    bf16_t* O; int ldc; float ascale;
    __device__ __forceinline__ void operator()(const f32x4 (&acc)[2][2][4][2], const Unit& u, int wr, int wc, int fr, int fq) const {
        bf16_t* base = O + (size_t)(u.pm * BM + wr * 64 + fr) * ldc + u.pn * BM + wc * 32 + 8 * fq;
        float asc = ascale; asm volatile("" : "+v"(asc));
#pragma unroll
        for (int ai = 0; ai < 2; ++ai)
#pragma unroll
            for (int m = 0; m < 4; ++m) { bf16_t* rowp = base + (size_t)(ai * HALF + m * 16) * ldc;
#pragma unroll
                for (int bj = 0; bj < 2; ++bj) { const f32x4 v0 = acc[ai][bj][m][0] * asc, v1 = acc[ai][bj][m][1] * asc; u32x4 w;
                    w.x = cvt_pk_bf16(v0[0], v0[1]); w.y = cvt_pk_bf16(v0[2], v0[3]); w.z = cvt_pk_bf16(v1[0], v1[1]); w.w = cvt_pk_bf16(v1[2], v1[3]);
                    *(u32x4*)(rowp + bj * HALF) = w; } }
    }
};
struct EpiScaleBf16 { static constexpr bool PERM = true, AFTER_DRAIN = false;
    bf16_t* O; int ldc; const float* rs;
    __device__ __forceinline__ void operator()(const f32x4 (&acc)[2][2][4][2], const Unit& u, int wr, int wc, int fr, int fq) const {
        const int row0 = u.pm * BM + wr * 64 + fr; bf16_t* base = O + (size_t)row0 * ldc + u.pn * BM + wc * 32 + 8 * fq;
#pragma unroll
        for (int ai = 0; ai < 2; ++ai)
#pragma unroll
            for (int m = 0; m < 4; ++m) { bf16_t* rowp = base + (size_t)(ai * HALF + m * 16) * ldc; const float sc = rs[2 * (row0 + ai * HALF + m * 16)];
#pragma unroll
                for (int bj = 0; bj < 2; ++bj) { const f32x4 v0 = acc[ai][bj][m][0] * sc, v1 = acc[ai][bj][m][1] * sc; u32x4 w;
                    w.x = cvt_pk_bf16(v0[0], v0[1]); w.y = cvt_pk_bf16(v0[2], v0[3]); w.z = cvt_pk_bf16(v1[0], v1[1]); w.w = cvt_pk_bf16(v1[2], v1[3]);
                    *(u32x4*)(rowp + bj * HALF) = w; } }
    }
};
struct EpiResid { static constexpr bool PERM = true, AFTER_DRAIN = false;
    const float* src_lat; const float* src_ctx; float* out; const float* mod_g1; float ascale;
    __device__ __forceinline__ void operator()(const f32x4 (&acc)[2][2][4][2], const Unit& u, int wr, int wc, int fr, int fq) const {
        const int row_t = u.pm * BM; const int mrow = row_t < NLAT ? row_t / SEQ : NB;
        const float* g = mod_g1 + (size_t)mrow * 6144 + u.pn * BM + wc * 32 + 8 * fq;
        const float* sb = (row_t < NLAT ? src_lat + (size_t)row_t * 1024 : src_ctx + (size_t)(row_t - NLAT) * 1024) + u.pn * BM + wc * 32 + 8 * fq;
        float* ob = out + (size_t)row_t * 1024 + u.pn * BM + wc * 32 + 8 * fq;
        f32x4 gv[2][2];
#pragma unroll
        for (int bj = 0; bj < 2; ++bj)
#pragma unroll
            for (int n = 0; n < 2; ++n) gv[bj][n] = *(const f32x4*)(g + bj * HALF + 4 * n) * ascale;
#pragma unroll
        for (int ai = 0; ai < 2; ++ai)
#pragma unroll
            for (int m = 0; m < 4; ++m) { const size_t off = (size_t)(wr * 64 + fr + ai * HALF + m * 16) * 1024;
#pragma unroll
                for (int bj = 0; bj < 2; ++bj)
#pragma unroll
                    for (int n = 0; n < 2; ++n) { const f32x4 sv = *(const f32x4*)(sb + off + bj * HALF + 4 * n); *(f32x4*)(ob + off + bj * HALF + 4 * n) = sv + gv[bj][n] * acc[ai][bj][m][n]; }
                asm volatile("" ::: "memory"); }
    }
};
__device__ __forceinline__ float swiglu1(float g, float l, float c7, float cn) {
    const float glu = fminf(g, c7), lin = fminf(fmaxf(l, -c7), c7);
    const float sg = __builtin_amdgcn_rcpf(1.0f + __builtin_amdgcn_exp2f(cn * glu));
    return glu * sg * (lin + 1.0f);
}
struct EpiSwiglu { static constexpr bool PERM = true, AFTER_DRAIN = false;
    bf16_t* O; const float* bias; float ascale;
    __device__ __forceinline__ void operator()(const f32x4 (&acc)[2][2][4][2], const Unit& u, int wr, int wc, int fr, int fq) const {
        const int col0 = u.pn * BM + wc * 32 + 8 * fq; const float* b = bias + (size_t)u.aux * 2048 + col0;
        float c7 = 7.0f, cn = -1.702f * 1.4426950408889634f; asm volatile("" : "+v"(c7), "+v"(cn));
        bf16_t* base = O + (size_t)(u.pm * BM + wr * 64 + fr) * 1024 + (col0 >> 1);
        f32x4 bv[2][2];
#pragma unroll
        for (int bj = 0; bj < 2; ++bj)
#pragma unroll
            for (int n = 0; n < 2; ++n) bv[bj][n] = *(const f32x4*)(b + bj * HALF + 4 * n);
#pragma unroll
        for (int ai = 0; ai < 2; ++ai)
#pragma unroll
            for (int m = 0; m < 4; ++m) { bf16_t* rowp = base + (size_t)(ai * HALF + m * 16) * 1024;
#pragma unroll
                for (int bj = 0; bj < 2; ++bj) { const f32x4 v0 = acc[ai][bj][m][0] * ascale + bv[bj][0], v1 = acc[ai][bj][m][1] * ascale + bv[bj][1];
                    uint2 w; w.x = cvt_pk_bf16(swiglu1(v0[0], v0[1], c7, cn), swiglu1(v0[2], v0[3], c7, cn)); w.y = cvt_pk_bf16(swiglu1(v1[0], v1[1], c7, cn), swiglu1(v1[2], v1[3], c7, cn));
                    *(uint2*)(rowp + bj * (HALF / 2)) = w; } }
    }
};
struct EpiSwigluF8 { static constexpr bool PERM = true, AFTER_DRAIN = false;
    unsigned char* O; const float* bias;
    __device__ __forceinline__ void operator()(const f32x4 (&acc)[2][2][4][2], const Unit& u, int wr, int wc, int fr, int fq) const {
        const int col0 = u.pn * BM + wc * 32 + 8 * fq; const float* b = bias + (size_t)u.aux * 2048 + col0;
        float c7 = 7.0f, cn = -1.702f * 1.4426950408889634f, c32 = 0.03125f; asm volatile("" : "+v"(c7), "+v"(cn), "+v"(c32));
        unsigned char* base = O + (size_t)(u.pm * BM + wr * 64 + fr) * 1024 + (col0 >> 1);
        f32x4 bv[2][2];
#pragma unroll
        for (int bj = 0; bj < 2; ++bj)
#pragma unroll
            for (int n = 0; n < 2; ++n) bv[bj][n] = *(const f32x4*)(b + bj * HALF + 4 * n);
#pragma unroll
        for (int ai = 0; ai < 2; ++ai)
#pragma unroll
            for (int m = 0; m < 4; ++m) { unsigned char* rowp = base + (size_t)(ai * HALF + m * 16) * 1024;
#pragma unroll
                for (int bj = 0; bj < 2; ++bj) { const f32x4 v0 = acc[ai][bj][m][0] * c32 + bv[bj][0], v1 = acc[ai][bj][m][1] * c32 + bv[bj][1];
                    int w = __builtin_amdgcn_cvt_pk_fp8_f32(swiglu1(v0[0], v0[1], c7, cn), swiglu1(v0[2], v0[3], c7, cn), 0, false); w = __builtin_amdgcn_cvt_pk_fp8_f32(swiglu1(v1[0], v1[1], c7, cn), swiglu1(v1[2], v1[3], c7, cn), w, true);
                    *(int*)(rowp + bj * (HALF / 2)) = w; } }
    }
};
struct EpiBiasF8 { static constexpr bool PERM = true, AFTER_DRAIN = false;
    unsigned char* O; const float* bias; float ascale;
    __device__ __forceinline__ void operator()(const f32x4 (&acc)[2][2][4][2], const Unit& u, int wr, int wc, int fr, int fq) const {
        const int col0 = u.pn * BM + wc * 32 + 8 * fq; const float* b = bias + (size_t)u.aux * 1024 + col0;
        float asc = ascale; asm volatile("" : "+v"(asc));
        unsigned char* base = O + (size_t)(u.pm * BM + wr * 64 + fr) * 1024 + col0;
        f32x4 bv[2][2];
#pragma unroll
        for (int bj = 0; bj < 2; ++bj)
#pragma unroll
            for (int n = 0; n < 2; ++n) bv[bj][n] = *(const f32x4*)(b + bj * HALF + 4 * n);
#pragma unroll
        for (int ai = 0; ai < 2; ++ai)
#pragma unroll
            for (int m = 0; m < 4; ++m) { unsigned char* rowp = base + (size_t)(ai * HALF + m * 16) * 1024;
#pragma unroll
                for (int bj = 0; bj < 2; ++bj) { const f32x4 v0 = acc[ai][bj][m][0] * asc + bv[bj][0], v1 = acc[ai][bj][m][1] * asc + bv[bj][1];
                    int lo = __builtin_amdgcn_cvt_pk_fp8_f32(v0[0], v0[1], 0, false); lo = __builtin_amdgcn_cvt_pk_fp8_f32(v0[2], v0[3], lo, true);
                    int hi = __builtin_amdgcn_cvt_pk_fp8_f32(v1[0], v1[1], 0, false); hi = __builtin_amdgcn_cvt_pk_fp8_f32(v1[2], v1[3], hi, true);
                    *(int2*)(rowp + bj * HALF) = make_int2(lo, hi); } }
    }
};
struct EpiBiasBf16 { static constexpr bool PERM = true, AFTER_DRAIN = false;
    bf16_t* O; const float* bias; float ascale;
    __device__ __forceinline__ void operator()(const f32x4 (&acc)[2][2][4][2], const Unit& u, int wr, int wc, int fr, int fq) const {
        const int col0 = u.pn * BM + wc * 32 + 8 * fq; const float* b = bias + (size_t)u.aux * 1024 + col0;
        float asc = ascale; asm volatile("" : "+v"(asc));
        bf16_t* base = O + (size_t)(u.pm * BM + wr * 64 + fr) * 1024 + col0;
        f32x4 bv[2][2];
#pragma unroll
        for (int bj = 0; bj < 2; ++bj)
#pragma unroll
            for (int n = 0; n < 2; ++n) bv[bj][n] = *(const f32x4*)(b + bj * HALF + 4 * n);
#pragma unroll
        for (int ai = 0; ai < 2; ++ai)
#pragma unroll
            for (int m = 0; m < 4; ++m) { bf16_t* rowp = base + (size_t)(ai * HALF + m * 16) * 1024;
#pragma unroll
                for (int bj = 0; bj < 2; ++bj) { const f32x4 v0 = acc[ai][bj][m][0] * asc + bv[bj][0], v1 = acc[ai][bj][m][1] * asc + bv[bj][1]; u32x4 w;
                    w.x = cvt_pk_bf16(v0[0], v0[1]); w.y = cvt_pk_bf16(v0[2], v0[3]); w.z = cvt_pk_bf16(v1[0], v1[1]); w.w = cvt_pk_bf16(v1[2], v1[3]);
                    *(u32x4*)(rowp + bj * HALF) = w; } }
    }
};
}
__device__ __forceinline__ unsigned pk2(float lo, float hi) { return (unsigned)f2bf(lo) | ((unsigned)f2bf(hi) << 16); }
__device__ __forceinline__ void transpose_item(const float* __restrict__ W, int K, int N, bf16_t* __restrict__ WT, LAS float* scr, int item, int lane, const float* rowscale = nullptr, float cscale = 1.0f, int cs_ncols = 1 << 30) {
    const int nblk = N / 32, kb = item / nblk, nb = item % nblk, k0 = 64 * kb, n0 = 32 * nb;
    const float cs = n0 < cs_ncols ? cscale : 1.0f;
#pragma unroll 8
    for (int i = 0; i < 32; ++i) { const int kk = 2 * i + (lane >> 5); float w = W[(size_t)(k0 + kk) * N + n0 + (lane & 31)]; if (rowscale) w *= rowscale[k0 + kk]; scr[kk * 33 + (lane & 31)] = w * cs; }
    asm volatile("s_waitcnt lgkmcnt(0)" ::: "memory");
    const int c = lane & 7;
#pragma unroll
    for (int j = 0; j < 4; ++j) { const int n = (lane >> 3) + 8 * j; const LAS float* sp = scr + (8 * c) * 33 + n;
        uint4 o; o.x = pk2(sp[0 * 33], sp[1 * 33]); o.y = pk2(sp[2 * 33], sp[3 * 33]); o.z = pk2(sp[4 * 33], sp[5 * 33]); o.w = pk2(sp[6 * 33], sp[7 * 33]);
        *(uint4*)(WT + (size_t)(n0 + n) * K + k0 + 8 * c) = o; }
    asm volatile("s_waitcnt lgkmcnt(0)" ::: "memory");
}

__device__ __forceinline__ void transpose_item_f8(const float* __restrict__ W, int K, int N, unsigned char* __restrict__ WT, LAS float* scr, int item, int lane, float cscale = 1.0f, int cs_ncols = 1 << 30) {
    const int nblk = N / 32, kb = item / nblk, nb = item % nblk, k0 = 64 * kb, n0 = 32 * nb;
    const float cs = 32.0f * (n0 < cs_ncols ? cscale : 1.0f);
#pragma unroll 8
    for (int i = 0; i < 32; ++i) { const int kk = 2 * i + (lane >> 5); scr[kk * 33 + (lane & 31)] = W[(size_t)(k0 + kk) * N + n0 + (lane & 31)] * cs; }
    asm volatile("s_waitcnt lgkmcnt(0)" ::: "memory");
    const int c = lane & 7;
#pragma unroll
    for (int j = 0; j < 4; ++j) { const int n = (lane >> 3) + 8 * j; const LAS float* sp = scr + (8 * c) * 33 + n;
        int lo = __builtin_amdgcn_cvt_pk_fp8_f32(sp[0 * 33], sp[1 * 33], 0, false); lo = __builtin_amdgcn_cvt_pk_fp8_f32(sp[2 * 33], sp[3 * 33], lo, true);
        int hi = __builtin_amdgcn_cvt_pk_fp8_f32(sp[4 * 33], sp[5 * 33], 0, false); hi = __builtin_amdgcn_cvt_pk_fp8_f32(sp[6 * 33], sp[7 * 33], hi, true);
        *(int2*)(WT + (size_t)(n0 + n) * K + k0 + 8 * c) = make_int2(lo, hi); }
    asm volatile("s_waitcnt lgkmcnt(0)" ::: "memory");
}
template <bool F8OUT>
__device__ __forceinline__ void transpose_item64(const float* __restrict__ W, int K, int N, void* __restrict__ WT, LAS float* scr, int item, int lane, const float* rowscale = nullptr, float cscale = 1.0f) {
    const int nblk = N / 64, kb = item / nblk, nb = item % nblk, k0 = 64 * kb, n0 = 64 * nb;
    const float cs = cscale * (F8OUT ? 32.0f : 1.0f);
    float4 wv[16];
#pragma unroll
    for (int i = 0; i < 16; ++i) wv[i] = *(const float4*)(W + (size_t)(k0 + 4 * i + (lane >> 4)) * N + n0 + 4 * (lane & 15));
#pragma unroll
    for (int i = 0; i < 16; ++i) { const int kk = 4 * i + (lane >> 4); const float4 w = wv[i];
        const float rs = rowscale ? rowscale[k0 + kk] * cs : cs; LAS float* d = scr + kk * 65 + 4 * (lane & 15); d[0] = w.x * rs; d[1] = w.y * rs; d[2] = w.z * rs; d[3] = w.w * rs; }
    asm volatile("s_waitcnt lgkmcnt(0)" ::: "memory");
    const int c = lane & 7;
#pragma unroll
    for (int j = 0; j < 8; ++j) { const int n = (lane >> 3) + 8 * j; const LAS float* sp = scr + (8 * c) * 65 + n;
        if constexpr (F8OUT) { int lo = __builtin_amdgcn_cvt_pk_fp8_f32(sp[0 * 65], sp[1 * 65], 0, false); lo = __builtin_amdgcn_cvt_pk_fp8_f32(sp[2 * 65], sp[3 * 65], lo, true);
            int hi = __builtin_amdgcn_cvt_pk_fp8_f32(sp[4 * 65], sp[5 * 65], 0, false); hi = __builtin_amdgcn_cvt_pk_fp8_f32(sp[6 * 65], sp[7 * 65], hi, true);
            *(int2*)((unsigned char*)WT + (size_t)(n0 + n) * K + k0 + 8 * c) = make_int2(lo, hi); }
        else { uint4 o; o.x = pk2(sp[0 * 65], sp[1 * 65]); o.y = pk2(sp[2 * 65], sp[3 * 65]); o.z = pk2(sp[4 * 65], sp[5 * 65]); o.w = pk2(sp[6 * 65], sp[7 * 65]);
            *(uint4*)((bf16_t*)WT + (size_t)(n0 + n) * K + k0 + 8 * c) = o; } }
    asm volatile("s_waitcnt lgkmcnt(0)" ::: "memory");
}
namespace fa {
using bf16x8 = __attribute__((ext_vector_type(8))) short;
using s16x4  = __attribute__((ext_vector_type(4))) short;
using f32x16 = __attribute__((ext_vector_type(16))) float;
using u32x4  = __attribute__((ext_vector_type(4))) unsigned;
constexpr int QBLK = 32, KVBLK = 64, NW = 8;
constexpr int SHM_V = KVBLK * 128 * 2, SHM_K = KVBLK * 128 * 2, SHM_ATTN = 2 * SHM_V + 2 * SHM_K + NW * 64 * 4;
constexpr float LOG2E = 1.4426950408889634f, THR = 8.0f, NEGS = -1.0e30f;
#define FA_KSWZ(row, colB) ((row) * 256 + ((colB) ^ (((row) & 7) << 4)))
#define FA_SBAR() __builtin_amdgcn_sched_barrier(0)
__device__ __forceinline__ int crow(int r, int hi) { return (r & 3) + 8 * (r >> 2) + 4 * hi; }
__device__ __forceinline__ unsigned cvtpk(float lo, float hi) { unsigned r; asm volatile("v_cvt_pk_bf16_f32 %0, %1, %2" : "=v"(r) : "v"(lo), "v"(hi)); return r; }
__device__ __forceinline__ void partialSM(f32x16& p0, f32x16& p1, float& m_reg, float& mn, float& alpha) {
  float pmax = p0[0];
#pragma unroll
  for (int r = 1; r < 16; ++r) pmax = fmaxf(pmax, p0[r]);
#pragma unroll
  for (int r = 0; r < 16; ++r) pmax = fmaxf(pmax, p1[r]);
  { auto rr = __builtin_amdgcn_permlane32_swap(__float_as_uint(pmax), __float_as_uint(pmax), false, false);
    pmax = fmaxf(__uint_as_float(rr[0]), __uint_as_float(rr[1])); }
  if (__builtin_expect(__all(pmax - m_reg <= THR), 1)) { mn = m_reg; alpha = 1.f; }
  else { mn = fmaxf(m_reg, pmax); alpha = __builtin_amdgcn_exp2f((m_reg - mn) * LOG2E); m_reg = mn; }
  const float mnC = -mn * LOG2E;
#pragma unroll
  for (int r = 0; r < 16; ++r) p0[r] = fmaf(p0[r], LOG2E, mnC);
#pragma unroll
  for (int r = 0; r < 16; ++r) p1[r] = fmaf(p1[r], LOG2E, mnC);
#pragma unroll
  for (int r = 0; r < 16; ++r) p0[r] = __builtin_amdgcn_exp2f(p0[r]);
}
__device__ __forceinline__ void finishSM(f32x16& p0, f32x16& p1, float alpha, float& l_reg, bf16x8& pa0, bf16x8& pa1, bf16x8& pa2, bf16x8& pa3) {
#pragma unroll
  for (int r = 0; r < 16; ++r) p1[r] = __builtin_amdgcn_exp2f(p1[r]);
  float ps = 0;
#pragma unroll
  for (int r = 0; r < 16; ++r) ps += p0[r];
#pragma unroll
  for (int r = 0; r < 16; ++r) ps += p1[r];
  { auto rr = __builtin_amdgcn_permlane32_swap(__float_as_uint(ps), __float_as_uint(ps), false, false);
    ps = __uint_as_float(rr[0]) + __uint_as_float(rr[1]); }
  l_reg = l_reg * alpha + ps;
#define FA_PK4(P, BASE, OUT) do { unsigned a0 = cvtpk(P[BASE + 0], P[BASE + 1]), a1 = cvtpk(P[BASE + 2], P[BASE + 3]);   \
    unsigned b0 = cvtpk(P[BASE + 4], P[BASE + 5]), b1 = cvtpk(P[BASE + 6], P[BASE + 7]);                              \
    auto r0 = __builtin_amdgcn_permlane32_swap(a0, b0, false, false); auto r1 = __builtin_amdgcn_permlane32_swap(a1, b1, false, false); \
    u32x4 w = {r0[0], r1[0], r0[1], r1[1]}; OUT = *reinterpret_cast<bf16x8*>(&w); } while (0)
  FA_PK4(p0, 0, pa0); FA_PK4(p0, 8, pa1); FA_PK4(p1, 0, pa2); FA_PK4(p1, 8, pa3);
#undef FA_PK4
}
template <int NQ> __device__ __forceinline__ void qkt(f32x16& p0, f32x16& p1, const char* Ks, const bf16x8* qr, int r32, int hi) {
  p0 = f32x16{}; p1 = f32x16{};
#pragma unroll
  for (int d0 = 0; d0 < NQ; ++d0) { const int cb = (d0 * 16 + hi * 8) * 2;
    const bf16x8 b0 = *reinterpret_cast<const bf16x8*>(Ks + FA_KSWZ(r32, cb));
    const bf16x8 b1 = *reinterpret_cast<const bf16x8*>(Ks + FA_KSWZ(32 + r32, cb));
    p0 = __builtin_amdgcn_mfma_f32_32x32x16_bf16(b0, qr[d0], p0, 0, 0, 0);
    p1 = __builtin_amdgcn_mfma_f32_32x32x16_bf16(b1, qr[d0], p1, 0, 0, 0); }
}
__device__ __forceinline__ int v_st(int k, int c) { const int kk = (k & ~0xC) | ((k & 4) << 1) | ((k & 8) >> 1); return ((kk >> 3) * 4 + (c >> 5)) * 512 + ((kk & 7) * 32 + (c & 31)) * 2; }
__device__ __forceinline__ int v_rd_base(int lane) { return ((lane & 3) << 3) | (((lane >> 2) & 3) << 6) | (((lane >> 4) & 1) << 5) | (((lane >> 5) & 1) << 8); }
constexpr int v_rd_off(int d0, int ks, int half) { return d0 * 512 + ks * 4096 + half * 2048; }
template <int OFF> __device__ __forceinline__ s16x4 tr_read(int vb) {
  s16x4 r; asm volatile("ds_read_b64_tr_b16 %0, %1 offset:%2" : "=&v"(r) : "v"(vb), "i"(OFF) : "memory"); return r;
}
template <int D0> __device__ __forceinline__ void pv_one(f32x16& od, int vb, bf16x8 pa0, bf16x8 pa1, bf16x8 pa2, bf16x8 pa3) {
  const s16x4 l0 = tr_read<v_rd_off(D0, 0, 0)>(vb), h0 = tr_read<v_rd_off(D0, 0, 1)>(vb), l1 = tr_read<v_rd_off(D0, 1, 0)>(vb), h1 = tr_read<v_rd_off(D0, 1, 1)>(vb);
  const s16x4 l2 = tr_read<v_rd_off(D0, 2, 0)>(vb), h2 = tr_read<v_rd_off(D0, 2, 1)>(vb), l3 = tr_read<v_rd_off(D0, 3, 0)>(vb), h3 = tr_read<v_rd_off(D0, 3, 1)>(vb);
  asm volatile("s_waitcnt lgkmcnt(0)" ::: "memory"); FA_SBAR();
#define FA_PK(L, H) (bf16x8){L[0], L[1], L[2], L[3], H[0], H[1], H[2], H[3]}
  od = __builtin_amdgcn_mfma_f32_32x32x16_bf16(pa0, FA_PK(l0, h0), od, 0, 0, 0);
  od = __builtin_amdgcn_mfma_f32_32x32x16_bf16(pa1, FA_PK(l1, h1), od, 0, 0, 0);
  od = __builtin_amdgcn_mfma_f32_32x32x16_bf16(pa2, FA_PK(l2, h2), od, 0, 0, 0);
  od = __builtin_amdgcn_mfma_f32_32x32x16_bf16(pa3, FA_PK(l3, h3), od, 0, 0, 0);
#undef FA_PK
}
template <int NV> __device__ __forceinline__ void pv_all(f32x16* o, int vb, bf16x8 pa0, bf16x8 pa1, bf16x8 pa2, bf16x8 pa3) {
  pv_one<0>(o[0], vb, pa0, pa1, pa2, pa3); pv_one<1>(o[1], vb, pa0, pa1, pa2, pa3);
  if constexpr (NV == 4) { pv_one<2>(o[2], vb, pa0, pa1, pa2, pa3); pv_one<3>(o[3], vb, pa0, pa1, pa2, pa3); }
}
__device__ __forceinline__ void wmask(f32x16& p0, f32x16& p1, int dq4) {
#pragma unroll
  for (int r = 0; r < 16; ++r) { const int d = dq4 + (r & 3) + 8 * (r >> 2); if ((unsigned)(d + 128) > 256u) p0[r] = NEGS; if ((unsigned)(d + 32 + 128) > 256u) p1[r] = NEGS; }
}

struct Unit {
  const bf16_t* Q; const bf16_t* K; const bf16_t* V; bf16_t* O;
  int rowa, nta, rowb, ntb;
  int window, qpos0, kposb0;
  float sink; int has_sink;
  const bf16_t* K2;
  const float* tab; int pos0;
  const float* qg;
};
template <int DQ, int DV, int LDQ, int LDK, int LDV, int LDO, bool WIN, int RD0, int RH, bool QNORM, bool KSPLIT, bool O8>
__device__ __forceinline__ void attn_unit(const int tid, const Unit& U, char* lds) {
  constexpr int NQ = DQ / 16, NV = DV / 32;
  const int wid = tid >> 6, lane = tid & 63, r32 = lane & 31, hi = lane >> 5;
  char* V_lds = lds; char* K_lds = lds + 2 * SHM_V;
  float* ws = (float*)(lds + 2 * SHM_V + 2 * SHM_K) + wid * 64; float* li_l = ws; float* al_l = ws + 32;
  float m_reg = -1e30f, l_reg = 0; f32x16 o[NV]; bf16x8 qr[NQ];
#pragma unroll
  for (int d = 0; d < NV; ++d) o[d] = f32x16{};
  const bf16_t* Qw = U.Q + (size_t)(wid * QBLK + r32) * LDQ + hi * 8;
#pragma unroll
  for (int d0 = 0; d0 < NQ; ++d0) qr[d0] = *reinterpret_cast<const bf16x8*>(Qw + d0 * 16);
  if constexpr (QNORM || RH > 0) {
    float qf[NQ][8];
#pragma unroll
    for (int d0 = 0; d0 < NQ; ++d0)
#pragma unroll
      for (int j = 0; j < 8; ++j) qf[d0][j] = __uint_as_float(((unsigned)(unsigned short)qr[d0][j]) << 16);
    if constexpr (QNORM) {
      float ss = 0.f;
#pragma unroll
      for (int d0 = 0; d0 < NQ; ++d0)
#pragma unroll
        for (int j = 0; j < 8; ++j) ss = fmaf(qf[d0][j], qf[d0][j], ss);
      { auto rr = __builtin_amdgcn_permlane32_swap(__float_as_uint(ss), __float_as_uint(ss), false, false); ss = __uint_as_float(rr[0]) + __uint_as_float(rr[1]); }
      const float ri = 1.0f / sqrtf(ss * (1.0f / DQ) + 1e-6f);
#pragma unroll
      for (int d0 = 0; d0 < NQ; ++d0) { const float4 g0 = *(const float4*)(U.qg + 16 * d0 + 8 * hi), g1 = *(const float4*)(U.qg + 16 * d0 + 8 * hi + 4);
        qf[d0][0] *= ri * g0.x; qf[d0][1] *= ri * g0.y; qf[d0][2] *= ri * g0.z; qf[d0][3] *= ri * g0.w; qf[d0][4] *= ri * g1.x; qf[d0][5] *= ri * g1.y; qf[d0][6] *= ri * g1.z; qf[d0][7] *= ri * g1.w; }
    }
    if constexpr (RH > 0) { if (U.tab) {
      const float4* tb = (const float4*)(U.tab + ((size_t)(U.pos0 + wid * QBLK + r32) * (RH * 16) + 8 * hi) * 2);
#pragma unroll
      for (int dd = 0; dd < RH; ++dd) {
#pragma unroll
        for (int j2 = 0; j2 < 4; ++j2) { const float4 t = tb[dd * 8 + j2];
          { const float x1 = qf[RD0 + dd][2 * j2], x2 = qf[RD0 + RH + dd][2 * j2]; qf[RD0 + dd][2 * j2] = x1 * t.x - x2 * t.y; qf[RD0 + RH + dd][2 * j2] = x2 * t.x + x1 * t.y; }
          { const float x1 = qf[RD0 + dd][2 * j2 + 1], x2 = qf[RD0 + RH + dd][2 * j2 + 1]; qf[RD0 + dd][2 * j2 + 1] = x1 * t.z - x2 * t.w; qf[RD0 + RH + dd][2 * j2 + 1] = x2 * t.z + x1 * t.w; } } } } }
#pragma unroll
    for (int d0 = 0; d0 < NQ; ++d0) { u32x4 w = {cvtpk(qf[d0][0], qf[d0][1]), cvtpk(qf[d0][2], qf[d0][3]), cvtpk(qf[d0][4], qf[d0][5]), cvtpk(qf[d0][6], qf[d0][7])}; qr[d0] = *reinterpret_cast<bf16x8*>(&w); }
  }
  const int sr = tid >> 4, sc = (tid & 15) * 8, vst0 = v_st(sr, sc), vst1 = v_st(32 + sr, sc);
  const int sck = sc < DQ - 8 ? sc : DQ - 8, scv = sc < DV - 8 ? sc : DV - 8;
  const int vb0 = (int)(uintptr_t)V_lds + v_rd_base(lane);
  const int nta = U.nta, NT = U.nta + U.ntb;
  const unsigned kof0 = (unsigned)((sr * LDK + sck) * 2), kof1 = kof0 + 32u * LDK * 2u, vof0 = (unsigned)((sr * LDV + scv) * 2), vof1 = vof0 + 32u * LDV * 2u;
  constexpr int LDK2 = 1536;
  const int ci = tid & 15; const bool ksec = KSPLIT && ci >= 8; const int kld = ksec ? LDK2 : LDK;
  const bf16_t* kp0 = ksec ? U.K2 + (size_t)sr * LDK2 + ((ci < 11 ? ci : 11) - 8) * 8 : U.K + (size_t)sr * LDK + ci * 8; const bf16_t* kp1 = kp0 + (size_t)32 * kld;
  (void)kof0; (void)kof1; (void)kp0; (void)kp1; (void)kld;
  struct { bf16x8 vs0, vs1, ks0, ks1; } sr_[2];
#define FA_KROW(j) ((j) < nta ? U.rowa + (j) * KVBLK : U.rowb + ((j) - nta) * KVBLK)
#define FA_SLOAD(i, j) do { const size_t k0_ = (size_t)(FA_KROW(j)); const char* kt_ = (const char*)U.K + k0_ * (LDK * 2); const char* vt_ = (const char*)U.V + k0_ * (LDV * 2); \
    sr_[i].vs0 = *reinterpret_cast<const bf16x8*>(vt_ + vof0); sr_[i].vs1 = *reinterpret_cast<const bf16x8*>(vt_ + vof1); \
    if constexpr (KSPLIT) { sr_[i].ks0 = *reinterpret_cast<const bf16x8*>(kp0 + k0_ * kld); sr_[i].ks1 = *reinterpret_cast<const bf16x8*>(kp1 + k0_ * kld); } \
    else { sr_[i].ks0 = *reinterpret_cast<const bf16x8*>(kt_ + kof0); sr_[i].ks1 = *reinterpret_cast<const bf16x8*>(kt_ + kof1); } } while (0)
#define FA_SWRITE(b, i) do { *(bf16x8*)(V_lds + (b) * SHM_V + vst0) = sr_[i].vs0; *(bf16x8*)(V_lds + (b) * SHM_V + vst1) = sr_[i].vs1; const int kc = sc * 2; \
    *(bf16x8*)(K_lds + (b) * SHM_K + FA_KSWZ(sr, kc)) = sr_[i].ks0; *(bf16x8*)(K_lds + (b) * SHM_K + FA_KSWZ(32 + sr, kc)) = sr_[i].ks1; } while (0)
#define FA_SWAIT() asm volatile("s_waitcnt vmcnt(4)" ::: "memory")
#define FA_RESC(a) do { if (__any((a) < 1.f)) { if (hi == 0) al_l[r32] = (a); asm volatile("s_waitcnt lgkmcnt(0)" ::: "memory"); \
    _Pragma("unroll") for (int d = 0; d < NV; ++d) _Pragma("unroll") for (int r = 0; r < 16; ++r) o[d][r] *= al_l[crow(r, hi)]; } } while (0)
  const int qw0 = U.qpos0 + wid * QBLK;
#define FA_MASK(P0, P1, t) do { if (WIN && U.window && (t) >= nta) { const int kb_ = U.kposb0 + ((t) - nta) * KVBLK; \
    if (kb_ + 63 - qw0 > 128 || qw0 + 31 - kb_ > 128) wmask(P0, P1, kb_ - (qw0 + r32) + 4 * hi); } } while (0)
  f32x16 pA0, pA1, pB0, pB1; float mnA, mnB, alA, alB; bf16x8 pa0, pa1, pa2, pa3;
  constexpr int SE = 0, SO = 1;
  FA_SLOAD(SE, 0); asm volatile("s_waitcnt vmcnt(0)" ::: "memory"); FA_SWRITE(0, SE); __syncthreads();
  qkt<NQ>(pA0, pA1, K_lds, qr, r32, hi); FA_MASK(pA0, pA1, 0); partialSM(pA0, pA1, m_reg, mnA, alA);
  FA_SLOAD(SO, 1); if (2 < NT) FA_SLOAD(SE, 2);
  FA_SWAIT(); FA_SWRITE(1, SO); __syncthreads();
  for (int j = 1; j + 1 < NT; j += 2) {
    FA_SBAR(); qkt<NQ>(pB0, pB1, K_lds + SHM_K, qr, r32, hi);
    finishSM(pA0, pA1, alA, l_reg, pa0, pa1, pa2, pa3); FA_SBAR();
    FA_SLOAD(SO, j + 2); FA_SBAR();
    pv_all<NV>(o, vb0, pa0, pa1, pa2, pa3); FA_MASK(pB0, pB1, j); partialSM(pB0, pB1, m_reg, mnB, alB);
    __syncthreads(); FA_SWAIT(); FA_SWRITE(0, SE);
    FA_RESC(alB); __syncthreads();
    FA_SBAR(); qkt<NQ>(pA0, pA1, K_lds, qr, r32, hi);
    finishSM(pB0, pB1, alB, l_reg, pa0, pa1, pa2, pa3); FA_SBAR();
    if (j + 3 < NT) FA_SLOAD(SE, j + 3); FA_SBAR();
    pv_all<NV>(o, vb0 + SHM_V, pa0, pa1, pa2, pa3); FA_MASK(pA0, pA1, j + 1); partialSM(pA0, pA1, m_reg, mnA, alA);
    __syncthreads(); FA_SWAIT(); FA_SWRITE(1, SO);
    FA_RESC(alA); __syncthreads();
  }
  FA_SBAR(); qkt<NQ>(pB0, pB1, K_lds + SHM_K, qr, r32, hi);
  finishSM(pA0, pA1, alA, l_reg, pa0, pa1, pa2, pa3); FA_SBAR();
  pv_all<NV>(o, vb0, pa0, pa1, pa2, pa3); FA_MASK(pB0, pB1, NT - 1); partialSM(pB0, pB1, m_reg, mnB, alB);
  __syncthreads(); FA_RESC(alB);
  finishSM(pB0, pB1, alB, l_reg, pa0, pa1, pa2, pa3); FA_SBAR();
  pv_all<NV>(o, vb0 + SHM_V, pa0, pa1, pa2, pa3);
  if (U.has_sink) l_reg += __builtin_amdgcn_exp2f((U.sink - m_reg) * LOG2E);
  if (hi == 0) li_l[r32] = l_reg;
  asm volatile("s_waitcnt lgkmcnt(0)" ::: "memory");
  __syncthreads();
  int lane2 = lane; asm volatile("" : "+v"(lane2));
  const int r32e = lane2 & 31, hie = lane2 >> 5;
  if constexpr (O8) {
    unsigned char* stg = (unsigned char*)(lds + wid * 8192);
    unsigned char* stw = stg + hie * 4 * DV + r32e;
#pragma unroll
    for (int r = 0; r < 16; ++r) { const int orow0 = (r & 3) + 8 * (r >> 2); const float rl = __builtin_amdgcn_rcpf(li_l[orow0 + 4 * hie]);
#pragma unroll
      for (int d0 = 0; d0 < NV; ++d0) stw[orow0 * DV + d0 * 32] = (unsigned char)(__builtin_amdgcn_cvt_pk_fp8_f32(o[d0][r] * rl, 0.f, 0, false) & 0xff); }
    asm volatile("s_waitcnt lgkmcnt(0)" ::: "memory");
    constexpr int CPR = DV / 16, RPI = 64 / CPR;
    const int erow = lane2 / CPR, ech = lane2 % CPR;
    unsigned char* Ow = (unsigned char*)U.O + (size_t)(wid * QBLK + erow) * LDO + ech * 16; const unsigned char* str = stg + erow * DV + ech * 16;
#pragma unroll
    for (int i = 0; i < 32 / RPI; ++i) { const u32x4 v = *(const u32x4*)(str + i * RPI * DV); *(u32x4*)(Ow + (size_t)(i * RPI) * LDO) = v; }
  } else {
  bf16_t* stg = (bf16_t*)(lds + wid * 8192);
  bf16_t* stw = stg + hie * 4 * DV + r32e;
#pragma unroll
  for (int r = 0; r < 16; ++r) { const int orow0 = (r & 3) + 8 * (r >> 2); const float rl = __builtin_amdgcn_rcpf(li_l[orow0 + 4 * hie]);
#pragma unroll
    for (int d0 = 0; d0 < NV; ++d0) stw[orow0 * DV + d0 * 32] = f2bf(o[d0][r] * rl); }
  asm volatile("s_waitcnt lgkmcnt(0)" ::: "memory");
  constexpr int CPR = DV / 8, RPI = 64 / CPR;
  const int erow = lane2 / CPR, ech = lane2 % CPR;
  bf16_t* Ow = U.O + (size_t)(wid * QBLK + erow) * LDO + ech * 8; const bf16_t* str = stg + erow * DV + ech * 8;
#pragma unroll
  for (int i = 0; i < 32 / RPI; ++i) { const u32x4 v = *(const u32x4*)(str + i * RPI * DV); *(u32x4*)(Ow + (size_t)(i * RPI) * LDO) = v; }
  }
  __syncthreads();
#undef FA_KROW
#undef FA_SLOAD
#undef FA_SWRITE
#undef FA_SWAIT
#undef FA_RESC
#undef FA_MASK
}
}

__device__ __forceinline__ void route_reduce(const float (&acc)[32], const int lane, const int el, const float rb, float (&tv)[4], int (&ti)[4]) {
    float a16[16], a8[8], a4[4], a2[2];
#pragma unroll
    for (int k = 0; k < 16; ++k) { const bool up = (lane & 32) != 0; const float keep = up ? acc[k + 16] : acc[k], send = up ? acc[k] : acc[k + 16]; a16[k] = keep + __shfl_xor(send, 32); }
#pragma unroll
    for (int k = 0; k < 8; ++k) { const bool up = (lane & 16) != 0; const float keep = up ? a16[k + 8] : a16[k], send = up ? a16[k] : a16[k + 8]; a8[k] = keep + __shfl_xor(send, 16); }
#pragma unroll
    for (int k = 0; k < 4; ++k) { const bool up = (lane & 8) != 0; const float keep = up ? a8[k + 4] : a8[k], send = up ? a8[k] : a8[k + 4]; a4[k] = keep + __shfl_xor(send, 8); }
#pragma unroll
    for (int k = 0; k < 2; ++k) { const bool up = (lane & 4) != 0; const float keep = up ? a4[k + 2] : a4[k], send = up ? a4[k] : a4[k + 2]; a2[k] = keep + __shfl_xor(send, 4); }
    float lg; { const bool up = (lane & 2) != 0; const float keep = up ? a2[1] : a2[0], send = up ? a2[0] : a2[1]; lg = keep + __shfl_xor(send, 2); }
    lg += __shfl_xor(lg, 1); lg += rb;
    unsigned key; { const unsigned u = __float_as_uint(lg); const unsigned ou = (u & 0x80000000u) ? ~u : (u | 0x80000000u); key = (ou & ~31u) | (unsigned)(31 - el); }
#pragma unroll
    for (int k = 0; k < 4; ++k) { unsigned bk = key;
#pragma unroll
        for (int o = 1; o < 64; o <<= 1) { const unsigned ok = (unsigned)__shfl_xor((int)bk, o); bk = ok > bk ? ok : bk; }
        const int bi = 31 - (int)(bk & 31u); const unsigned ou = bk & ~31u; const unsigned ub = (ou & 0x80000000u) ? (ou ^ 0x80000000u) : ~ou;
        tv[k] = __uint_as_float(ub); ti[k] = bi; if (el == bi) key = 0u; }
}

__device__ __forceinline__ void route_reduce32(const float (&acc)[32], const int l5, const float rb, float (&tv)[4], int (&ti)[4]) {
    float a16[16], a8[8], a4[4], a2[2];
#pragma unroll
    for (int k = 0; k < 16; ++k) { const bool up = (l5 & 16) != 0; const float keep = up ? acc[k + 16] : acc[k], send = up ? acc[k] : acc[k + 16]; a16[k] = keep + __shfl_xor(send, 16); }
#pragma unroll
    for (int k = 0; k < 8; ++k) { const bool up = (l5 & 8) != 0; const float keep = up ? a16[k + 8] : a16[k], send = up ? a16[k] : a16[k + 8]; a8[k] = keep + __shfl_xor(send, 8); }
#pragma unroll
    for (int k = 0; k < 4; ++k) { const bool up = (l5 & 4) != 0; const float keep = up ? a8[k + 4] : a8[k], send = up ? a8[k] : a8[k + 4]; a4[k] = keep + __shfl_xor(send, 4); }
#pragma unroll
    for (int k = 0; k < 2; ++k) { const bool up = (l5 & 2) != 0; const float keep = up ? a4[k + 2] : a4[k], send = up ? a4[k] : a4[k + 2]; a2[k] = keep + __shfl_xor(send, 2); }
    float lg; { const bool up = (l5 & 1) != 0; const float keep = up ? a2[1] : a2[0], send = up ? a2[0] : a2[1]; lg = keep + __shfl_xor(send, 1); }
    lg += rb;
    unsigned key; { const unsigned u = __float_as_uint(lg); const unsigned ou = (u & 0x80000000u) ? ~u : (u | 0x80000000u); key = (ou & ~31u) | (unsigned)(31 - l5); }
#pragma unroll
    for (int k = 0; k < 4; ++k) { unsigned bk = key;
#pragma unroll
        for (int o = 1; o < 32; o <<= 1) { const unsigned ok = (unsigned)__shfl_xor((int)bk, o); bk = ok > bk ? ok : bk; }
        const int bi = 31 - (int)(bk & 31u); const unsigned ou = bk & ~31u; const unsigned ub = (ou & 0x80000000u) ? (ou ^ 0x80000000u) : ~ou;
        tv[k] = __uint_as_float(ub); ti[k] = bi; if (l5 == bi) key = 0u; }
}

struct Params {
    const float *x, *c, *ctx, *c_ctx, *ada_w, *ada_b, *norm_mix_g, *norm_ffn_g, *ab_w_in, *mla_q_g, *mla_wq_b, *mla_kv_g, *mla_wkv_b, *swa_sink, *ab_w_out,
        *c_w_in, *c_q_g, *c_k_g, *c_w_out, *router_w, *router_b, *moe_w_in, *moe_b_in, *moe_w_out, *moe_b_out, *final_g;
    float* out; unsigned char* ws; int ph_lo, ph_hi;
};
__device__ __forceinline__ int mod_row_of(int r) { return r < NLAT ? r / SEQ : NB; }
__device__ __forceinline__ float rope_angle(int i, int quarter, int prow, int pcol) {
    const int ii = i < quarter ? i : i - quarter; const float inv = powf(10000.f, -(float)ii / (float)quarter);
    return (float)(i < quarter ? prow : pcol) * inv;
}

#ifndef OUTPROJ_F8
#define OUTPROJ_F8 1
#endif
#ifndef Y8_L1
#define Y8_L1 1
#endif
#ifndef INPROJ_F8
#define INPROJ_F8 1
#endif
#ifndef MOE_F8_DOWN
#define MOE_F8_DOWN 1
#endif
#ifndef MOE_F8_L0
#define MOE_F8_L0 1
#endif
#ifndef MOE_F8_L1
#define MOE_F8_L1 1
#endif
constexpr int LDS_BYTES = 147456;
constexpr int LDS_MISC = 143360;
constexpr int N_PHASES = 21;

__global__ void __launch_bounds__(NTHR, 2) fwd_kernel(Params p) {
    extern __shared__ __attribute__((aligned(16))) unsigned char lds_raw[];
    float* ldsf = (float*)lds_raw;
    LAS unsigned* misc = (LAS unsigned*)(lds_raw + LDS_MISC + 320);
    const int wave0 = __builtin_amdgcn_readfirstlane((int)(threadIdx.x >> 6));
    const int G = gridDim.x, bid = blockIdx.x;
    const int NGW = G * 8;
    unsigned* ctl0 = (unsigned*)(p.ws + WS_CTL);
#define PHASE_PTRS \
    int tid = wave0 * 64 + (int)__builtin_amdgcn_mbcnt_hi(~0u, __builtin_amdgcn_mbcnt_lo(~0u, 0u)); asm volatile("" : "+v"(tid)); const int lane = tid & 63, wave = tid >> 6, gw = bid * 8 + wave; (void)lane; (void)gw; \
    size_t wsz_ = 0; asm volatile("" : "+s"(wsz_)); unsigned char* ws = p.ws + wsz_; \
    unsigned* ctl = (unsigned*)(ws + WS_CTL); (void)ctl; \
    float* MOD = (float*)(ws + WS_MOD); (void)MOD; \
    int* TOKE = (int*)(ws + WS_TOKE); int* TOKP = (int*)(ws + WS_TOKP); float* TOKG = (float*)(ws + WS_TOKG); (void)TOKE; (void)TOKP; (void)TOKG; \
    float* RINV = (float*)(ws + WS_RINV); (void)RINV; unsigned char* tabs = ws + WS_TAB; (void)tabs; \
    float* XR = (float*)(ws + WS_XR); (void)XR; \
    act_t* H = (act_t*)(ws + WS_H); (void)H; \
    unsigned char* big = ws + WS_BIG; \
    act_t* PRJ = (act_t*)(big + OFF_PRJ); act_t* QB = (act_t*)(big + OFF_QB); act_t* KVB = (act_t*)(big + OFF_KVB); act_t* OB = (act_t*)(big + OFF_O); (void)PRJ; (void)QB; (void)KVB; (void)OB; \
    act_t* Y = (act_t*)big; act_t* ACT = (act_t*)(ws + WS_ACT); act_t* XS = (act_t*)(ws + WS_XS); unsigned char* wts = ws + WS_W; (void)Y; (void)ACT; (void)XS; (void)wts;

    if (threadIdx.x < 32) misc[threadIdx.x] = 0u;
    __syncthreads();
    XcdBarrier bar = xcd_barrier_post(ctl0 + CW_BAR, (volatile LAS unsigned*)(misc + 8), wave0);
    const int lo = p.ph_lo, hi = p.ph_hi;
#ifndef PHASE_MASK
#define PHASE_MASK 0x1FFFFFu
#endif
#define IN(k) ((((PHASE_MASK) >> (k)) & 1u) && lo <= (k) && (k) < hi)
#define SEAM(k) do { if (IN(k) && IN((k) + 1)) xcd_barrier(bar, wave0); } while (0)
#define LDSB ((LAS unsigned char*)lds_raw)

    if (IN(0)) { PHASE_PTRS
        {   LAS float* scr = (LAS float*)(LDSB + wave * 16640);
            constexpr int I_AB = 16 * 45  , I_QB = 6 * 12, I_KVB = 4 * 16, I_ABO = 16 * 16, I_C = 16 * 24, I_CO = 16 * 16, I_W1 = 16 * 32, I_W2 = 16 * 16;
            constexpr int T_W1 = 64 * I_W1, T_W2 = 64 * I_W2, T_ALL = T_W1 + T_W2 + I_AB + I_QB + I_KVB + I_ABO + I_C + I_CO;
            for (int it = gw; it < T_ALL; it += NGW) {
                int r = it;
                if (r < T_W1) { const int mi = r / I_W1; const float* src = p.moe_w_in + (size_t)mi * 1024 * 2048;
                    if ((mi >= 32 && MOE_F8_L1) || (mi < 32 && MOE_F8_L0)) transpose_item64<true>(src, 1024, 2048, (unsigned char*)(wts + WO_W1) + (size_t)(mi >> 5) * 32 * 2048 * 1024 * 2 + (size_t)(mi & 31) * 2048 * 1024, scr, r % I_W1, lane);
                    else transpose_item64<false>(src, 1024, 2048, (bf16_t*)(wts + WO_W1) + (size_t)mi * 2048 * 1024, scr, r % I_W1, lane);
                    continue; } r -= T_W1;
                if (r < T_W2) { const int mi = r / I_W2; const float* src = p.moe_w_out + (size_t)mi * 1024 * 1024;
                    if (MOE_F8_DOWN && ((mi >= 32 && MOE_F8_L1) || (mi < 32 && MOE_F8_L0))) transpose_item64<true>(src, 1024, 1024, (unsigned char*)(wts + WO_W2) + (size_t)(mi >> 5) * 32 * 1024 * 1024 * 2 + (size_t)(mi & 31) * 1024 * 1024, scr, r % I_W2, lane);
                    else transpose_item64<false>(src, 1024, 1024, (bf16_t*)(wts + WO_W2) + (size_t)mi * 1024 * 1024, scr, r % I_W2, lane);
                    continue; } r -= T_W2;
                if (r < I_AB) { if (INPROJ_F8) transpose_item_f8(p.ab_w_in, 1024, AB_IN, (unsigned char*)(wts + WO_AB), scr, r, lane, 0.125f, 512);
                    else transpose_item(p.ab_w_in, 1024, AB_IN, (bf16_t*)(wts + WO_AB), scr, r, lane, nullptr, 0.125f, 512); continue; } r -= I_AB;
                if (r < I_QB) { transpose_item64<false>(p.mla_wq_b, 384, 768, (bf16_t*)(wts + WO_QB), scr, r, lane, p.mla_q_g, 0.10206207261596575f); continue; } r -= I_QB;
                if (r < I_KVB) { transpose_item64<false>(p.mla_wkv_b, 256, 1024, (bf16_t*)(wts + WO_KVB), scr, r, lane, p.mla_kv_g, 1.0f); continue; } r -= I_KVB;
                if (r < I_ABO) { if (OUTPROJ_F8) transpose_item64<true>(p.ab_w_out, 1024, 1024, (unsigned char*)(wts + WO_ABO), scr, r, lane); else transpose_item64<false>(p.ab_w_out, 1024, 1024, (bf16_t*)(wts + WO_ABO), scr, r, lane); continue; } r -= I_ABO;
                if (r < I_C) { if (INPROJ_F8) transpose_item64<true>(p.c_w_in, 1024, C_IN, (unsigned char*)(wts + WO_C), scr, r, lane); else transpose_item64<false>(p.c_w_in, 1024, C_IN, (bf16_t*)(wts + WO_C), scr, r, lane); continue; } r -= I_C;
                if (OUTPROJ_F8) transpose_item64<true>(p.c_w_out, 1024, 1024, (unsigned char*)(wts + WO_CO), scr, r, lane); else transpose_item64<false>(p.c_w_out, 1024, 1024, (bf16_t*)(wts + WO_CO), scr, r, lane);
            }
            uint4* z = (uint4*)((unsigned char*)(wts + WO_AB) + (size_t)AB_IN * 1024 * (INPROJ_F8 ? 1 : 2));
            for (int i = gw * 64 + lane; i < 96 * 1024 * (INPROJ_F8 ? 1 : 2) / 16; i += NGW * 64) z[i] = make_uint4(0u, 0u, 0u, 0u);
        }
        {
            float2* TA = (float2*)(tabs + TAB_A); float2* TB = (float2*)(tabs + TAB_B); float2* TC = (float2*)(tabs + TAB_C);
            for (int e = bid * NTHR + tid; e < SEQ * 112; e += G * NTHR) { const int s = e / 112, i = e % 112, prow = s / GRIDW, pcol = s % GRIDW;
                int quarter, ii; float2* dst;
                if (i < 32) { quarter = 16; ii = i; dst = TA + s * 32 + ii; } else if (i < 48) { quarter = 8; ii = i - 32; dst = TB + s * 16 + ii; } else { quarter = 32; ii = i - 48; dst = TC + s * 64 + ii; }
                const float ang = rope_angle(ii, quarter, prow, pcol); *dst = make_float2(cosf(ang), sinf(ang)); }
            if (bid == 0 && tid < 128) ((float*)(tabs + TAB_QG))[tid] = p.c_q_g[tid] * 0.08838834764831845f;
        }
        __syncthreads();
        float* ca = ldsf;
        float* red = ldsf + 17 * 1024;
        {   float cv[34];
#pragma unroll
            for (int j = 0; j < 34; ++j) cv[j] = j < 2 * NB ? p.c[j * NTHR + tid] : p.c_ctx[(j - 2 * NB) * NTHR + tid];
#pragma unroll
            for (int j = 0; j < 34; ++j) ca[j * NTHR + tid] = cv[j] / (1.f + expf(-cv[j])); }
        __syncthreads();
        for (int blk = bid; blk < 2 * 6144 / 64; blk += G) {
            typedef float f4m_ __attribute__((ext_vector_type(4)));
            const int l = blk / 96, ks = wave, kr = lane >> 4, c4 = (lane & 15) * 4;
            f4m_ acc[17];
#pragma unroll
            for (int b = 0; b < 17; ++b) acc[b] = (f4m_){0.f, 0.f, 0.f, 0.f};
            const float* wp = p.ada_w + (size_t)l * 1024 * 6144 + (blk % 96) * 64 + c4 + (size_t)(ks * 128 + kr) * 6144;
            const float* cap = ca + ks * 128 + kr;
#pragma unroll 1
            for (int g4 = 0; g4 < 8; ++g4) {
                f4m_ w[4];
#pragma unroll
                for (int j = 0; j < 4; ++j) w[j] = __builtin_nontemporal_load((const f4m_*)(wp + (size_t)((g4 * 4 + j) * 4) * 6144));
#pragma unroll
                for (int j = 0; j < 4; ++j) {
#pragma unroll
                    for (int b = 0; b < 17; ++b) acc[b] += cap[b * 1024 + (g4 * 4 + j) * 4] * w[j]; }
            }
#pragma unroll
            for (int b = 0; b < 17; ++b) {
#pragma unroll
                for (int c = 0; c < 4; ++c) { float v = acc[b][c]; v += __shfl_xor(v, 16); v += __shfl_xor(v, 32); acc[b][c] = v; } }
            if (lane < 16) {
#pragma unroll
                for (int b = 0; b < 17; ++b) *(f4m_*)(red + (ks * 17 + b) * 64 + c4) = acc[b]; }
            __syncthreads();
            for (int i = tid; i < 17 * 64; i += NTHR) { const int b = i >> 6, nl = i & 63; float s = 0.f;
#pragma unroll
                for (int k2 = 0; k2 < 8; ++k2) s += red[(k2 * 17 + b) * 64 + nl];
                const int nn = (blk % 96) * 64 + nl; MOD[((size_t)l * 17 + b) * 6144 + nn] = s + p.ada_b[l * 6144 + nn]; }
            __syncthreads();
        }
    }
    SEAM(0);

#define NORM_MOD16(v, g, mr_) do { float ss_ = 0.f; \
        _Pragma("unroll") for (int j = 0; j < 16; ++j) ss_ = fmaf(v[j], v[j], ss_); \
        ss_ = wave_sum(ss_); const float ri_ = 1.0f / sqrtf(ss_ * (1.0f / 1024.0f) + RMS_EPS); \
        float sh_[16], sc_[16]; ld16f((mr_), sh_); ld16f((mr_) + 1024, sc_); \
        _Pragma("unroll") for (int j = 0; j < 16; ++j) v[j] = (v[j] * ri_ * g[j]) * (1.0f + sc_[j]) + sh_[j]; } while (0)

#define NORM_MOD16x2(v, g, mr0_, mr1_) do { float s0_ = 0.f, s1_ = 0.f; \
        _Pragma("unroll") for (int j = 0; j < 16; ++j) { s0_ = fmaf(v[0][j], v[0][j], s0_); s1_ = fmaf(v[1][j], v[1][j], s1_); } \
        wave_sum2(s0_, s1_); const float ri0_ = 1.0f / sqrtf(s0_ * (1.0f / 1024.0f) + RMS_EPS), ri1_ = 1.0f / sqrtf(s1_ * (1.0f / 1024.0f) + RMS_EPS); \
        float sh_[16], sc_[16]; ld16f((mr0_), sh_); ld16f((mr0_) + 1024, sc_); \
        _Pragma("unroll") for (int j = 0; j < 16; ++j) v[0][j] = (v[0][j] * ri0_ * g[j]) * (1.0f + sc_[j]) + sh_[j]; \
        ld16f((mr1_), sh_); ld16f((mr1_) + 1024, sc_); \
        _Pragma("unroll") for (int j = 0; j < 16; ++j) v[1][j] = (v[1][j] * ri1_ * g[j]) * (1.0f + sc_[j]) + sh_[j]; } while (0)
#define ROWS2(nrows) _Pragma("unroll 1") for (int r0_ = gw; r0_ < (nrows); r0_ += 2 * NGW)
#define ROWS2_IDX(nrows) const bool two_ = (r0_ + NGW) < (nrows); const int rr_[2] = {r0_, two_ ? r0_ + NGW : r0_};

    if (IN(1)) { PHASE_PTRS
        float g[16]; ld16f(p.norm_mix_g + 16 * lane, g);
        ROWS2(NROW) { ROWS2_IDX(NROW)
            float v[2][16]; const float* mr[2];
#pragma unroll
            for (int u = 0; u < 2; ++u) { const int r = rr_[u]; const float* src = r < NLAT ? p.x + (size_t)r * 1024 : p.ctx + (size_t)(r - NLAT) * 1024;
                mr[u] = MOD + (size_t)(0 * 17 + mod_row_of(r)) * 6144 + 16 * lane; ld16f(src + 16 * lane, v[u]); }
            NORM_MOD16x2(v, g, mr[0], mr[1]);
            if (INPROJ_F8) { st16f8((unsigned char*)H + (size_t)rr_[0] * 1024 + 16 * lane, v[0]); if (two_) st16f8((unsigned char*)H + (size_t)rr_[1] * 1024 + 16 * lane, v[1]); }
            else { st16bf(H + (size_t)rr_[0] * 1024 + 16 * lane, v[0]); if (two_) st16bf(H + (size_t)rr_[1] * 1024 + 16 * lane, v[1]); }
        }
    }
    SEAM(1);

    if (IN(2)) { PHASE_PTRS
        constexpr size_t ES_ = INPROJ_F8 ? 1 : 2;
        pg8::DenseOrder S{(const char*)H, (const char*)(wts + WO_AB), NROW / 256, 6, G, bid, (size_t)256 * 1024 * ES_, (size_t)256 * 1024 * ES_};
        pg8::EpiStoreBf16 E{PRJ, PRJ_LD, INPROJ_F8 ? 0.03125f : 1.0f};
        pg8::gemm_phase<pg8::EpiStoreBf16, pg8::DenseOrder, true, true, INPROJ_F8 != 0>(tid, LDSB, 1024, 1024, S, E);
    }
    SEAM(2);

    if (IN(3)) { PHASE_PTRS
        const float2* TA = (const float2*)(tabs + TAB_A); const float2* TB = (const float2*)(tabs + TAB_B);
        for (int r = gw; r < NROW; r += NGW) {
            bf16_t* pr = PRJ + (size_t)r * PRJ_LD;
            if (r < NLAT) { const int s = r % SEQ;
                { bf16_t* kp = pr + 512 + (lane >> 5) * 64 + (lane & 31); const float x1 = bf2f(kp[0]), x2 = bf2f(kp[32]); const float2 t = TA[s * 32 + (lane & 31)];
                  kp[0] = f2bf(x1 * t.x - x2 * t.y); kp[32] = f2bf(x2 * t.x + x1 * t.y); }
                if (lane < 16) { bf16_t* rp = pr + 1408 + lane; const float x1 = bf2f(rp[0]), x2 = bf2f(rp[16]); const float2 t = TB[s * 16 + lane];
                  rp[0] = f2bf(x1 * t.x - x2 * t.y); rp[16] = f2bf(x2 * t.x + x1 * t.y); } }
            float s1 = 0.f, s2 = 0.f;
#pragma unroll
            for (int j = 0; j < 6; ++j) { const float xq = bf2f(pr[768 + lane + 64 * j]); s1 = fmaf(xq, xq, s1); }
#pragma unroll
            for (int j = 0; j < 4; ++j) { const float xk = bf2f(pr[1152 + lane + 64 * j]); s2 = fmaf(xk, xk, s2); }
            s1 = wave_sum(s1); s2 = wave_sum(s2);
            if (lane == 0) { RINV[2 * r] = 1.0f / sqrtf(s1 * (1.0f / 384.0f) + RMS_EPS); RINV[2 * r + 1] = 1.0f / sqrtf(s2 * (1.0f / 256.0f) + RMS_EPS); }
        }
    }
    SEAM(3);

    if (IN(4)) { PHASE_PTRS
        { pg8::DenseOrder S{(const char*)(PRJ + 768), (const char*)(wts + WO_QB), NROW / 256, 3, G, bid, (size_t)256 * PRJ_LD * 2, (size_t)256 * 384 * 2};
          pg8::EpiScaleBf16 E{QB, 768, RINV};
          pg8::gemm_phase<pg8::EpiScaleBf16, pg8::DenseOrder, true, true>(tid, LDSB, 384, PRJ_LD, S, E); }
        __syncthreads();
        { pg8::DenseOrder S{(const char*)(PRJ + 1152), (const char*)(wts + WO_KVB), NROW / 256, 4, G, bid, (size_t)256 * PRJ_LD * 2, (size_t)256 * 256 * 2};
          pg8::EpiScaleBf16 E{KVB, 1024, RINV + 1};
          pg8::gemm_phase<pg8::EpiScaleBf16, pg8::DenseOrder, true, true>(tid, LDSB, 256, PRJ_LD, S, E); }
    }
    SEAM(4);

    if (IN(5)) { PHASE_PTRS
        for (int i = 0;; ++i) { const int u = i * G + bid; if (u >= 1152) break;
            const bool isctx = u >= 1024; int b, h, qb;
            if (!isctx) { const int rest = u >> 3; b = 2 * (u & 7) + (rest >> 6); h = (rest & 63) >> 3; qb = rest & 7; } else { b = (u - 1024) >> 3; h = u & 7; qb = 0; }
            const int qrow0 = isctx ? NLAT + b * NCX : b * SEQ + qb * 256;
            fa::Unit U; U.Q = QB + (size_t)qrow0 * 768 + h * 96; U.K = KVB + h * 128; U.K2 = PRJ + 1408; U.V = KVB + h * 128 + 64;
            U.O = OUTPROJ_F8 ? (bf16_t*)((unsigned char*)OB + (size_t)qrow0 * 1024 + 512 + h * 64) : OB + (size_t)qrow0 * 1024 + 512 + h * 64; U.rowa = NLAT + b * NCX; U.nta = 4; U.rowb = b * SEQ; U.ntb = isctx ? 0 : 32;
            U.window = 0; U.qpos0 = 0; U.kposb0 = 0; U.sink = 0.f; U.has_sink = 0; U.tab = isctx ? nullptr : (const float*)(tabs + TAB_B); U.pos0 = qb * 256; U.qg = nullptr;
            fa::attn_unit<96, 64, 768, 1024, 1024, 1024, false, 4, 1, false, true, OUTPROJ_F8 != 0>(tid, U, (char*)lds_raw); }
        for (int i = 0;; ++i) { const int u = i * G + bid; if (u >= 1152) break;
            const bool isctx = u >= 1024; int b, h, qb;
            if (!isctx) { const int rest = u >> 3; b = 2 * (u & 7) + (rest >> 6); h = (rest & 63) >> 3; qb = rest & 7; } else { b = (u - 1024) >> 3; h = u & 7; qb = 0; }
            const int qrow0 = isctx ? NLAT + b * NCX : b * SEQ + qb * 256;
            const int ks = isctx ? 0 : max(0, qb * 256 - 128), ke = isctx ? 0 : min(SEQ, qb * 256 + 384);
            fa::Unit U; U.Q = PRJ + (size_t)qrow0 * PRJ_LD + h * 64; U.K = PRJ + 512 + (h >> 2) * 64; U.K2 = nullptr; U.V = PRJ + 640 + (h >> 2) * 64;
            U.O = OUTPROJ_F8 ? (bf16_t*)((unsigned char*)OB + (size_t)qrow0 * 1024 + h * 64) : OB + (size_t)qrow0 * 1024 + h * 64; U.rowa = NLAT + b * NCX; U.nta = 4; U.rowb = b * SEQ + ks; U.ntb = (ke - ks) / 64;
            U.window = isctx ? 0 : 1; U.qpos0 = qb * 256; U.kposb0 = ks; U.sink = p.swa_sink[h]; U.has_sink = 1; U.tab = isctx ? nullptr : (const float*)(tabs + TAB_A); U.pos0 = qb * 256; U.qg = nullptr;
            fa::attn_unit<64, 64, PRJ_LD, PRJ_LD, PRJ_LD, 1024, true, 0, 2, false, false, OUTPROJ_F8 != 0>(tid, U, (char*)lds_raw); }
    }
    SEAM(5);

    if (IN(6)) { PHASE_PTRS
        constexpr size_t ES_ = OUTPROJ_F8 ? 1 : 2;
        pg8::DenseOrder S{(const char*)OB, (const char*)(wts + WO_ABO), NROW / 256, 4, G, bid, (size_t)256 * 1024 * ES_, (size_t)256 * 1024 * ES_};
        pg8::EpiResid E{p.x, p.ctx, XR, MOD + 2048, OUTPROJ_F8 ? 0.03125f : 1.0f};
        pg8::gemm_phase<pg8::EpiResid, pg8::DenseOrder, true, true, OUTPROJ_F8 != 0>(tid, LDSB, 1024, 1024, S, E);
    }
    SEAM(6);

#define ROUTER_PHASE(L, nrows) do { \
        { const float4* wsrc_ = (const float4*)(p.router_w + (size_t)(L) * 1024 * 32); float4* wl_ = (float4*)lds_raw; \
          for (int q = tid; q < 8192; q += NTHR) { const int c_ = q >> 3, e4_ = q & 7; wl_[c_ * 8 + (e4_ ^ ((c_ >> 5) & 7))] = wsrc_[q]; } } \
        __syncthreads(); \
        unsigned* cnt_ = ctl + CW_CNT + (L) * 32; \
        LAS unsigned* lcnt_ = (LAS unsigned*)(LDSB + LDS_MISC + 1024); LAS unsigned* lbase_ = lcnt_ + 32;       \
        if (tid < 32) lcnt_[tid] = 0u; \
        __syncthreads(); \
        const int half_ = lane >> 5, l5_ = lane & 31;                        \
        float g_[2][16]; ld16f(p.norm_ffn_g + (L) * 1024 + 32 * l5_, g_[0]); ld16f(p.norm_ffn_g + (L) * 1024 + 32 * l5_ + 16, g_[1]); \
        const float rb_ = p.router_b[(L) * 32 + l5_]; \
        const float4* wl_ = (const float4*)lds_raw + (size_t)(32 * l5_) * 8; const int sw_ = l5_ & 7; \
        LAS unsigned* stash_ = (LAS unsigned*)(LDSB + 131072) + wave * 384;        \
        int it_ = 0; \
        for (int rp = gw; rp * 2 < (nrows); rp += NGW, ++it_) { const int r = rp * 2 + half_; \
            const float* mr = MOD + (size_t)((L) * 17 + mod_row_of(r)) * 6144 + 3072 + 32 * l5_; \
            float v[2][16]; ld16f(XR + (size_t)r * 1024 + 32 * l5_, v[0]); ld16f(XR + (size_t)r * 1024 + 32 * l5_ + 16, v[1]); \
            float ss_ = 0.f; \
            _Pragma("unroll") for (int j = 0; j < 16; ++j) { ss_ = fmaf(v[0][j], v[0][j], ss_); ss_ = fmaf(v[1][j], v[1][j], ss_); } \
            _Pragma("unroll") for (int o_ = 1; o_ < 32; o_ <<= 1) ss_ += __shfl_xor(ss_, o_); \
            const float ri_ = 1.0f / sqrtf(ss_ * (1.0f / 1024.0f) + RMS_EPS); \
            _Pragma("unroll") for (int hh = 0; hh < 2; ++hh) { float sh_[16], sc_[16]; ld16f(mr + 16 * hh, sh_); ld16f(mr + 1024 + 16 * hh, sc_); \
                _Pragma("unroll") for (int j = 0; j < 16; ++j) v[hh][j] = (v[hh][j] * ri_ * g_[hh][j]) * (1.0f + sc_[j]) + sh_[j]; \
                st16f8((unsigned char*)H + (size_t)r * 1024 + 32 * l5_ + 16 * hh, v[hh]); }        \
            float acc[32]; \
            _Pragma("unroll") for (int e = 0; e < 32; ++e) acc[e] = 0.f; \
            _Pragma("unroll") for (int hh = 0; hh < 2; ++hh) _Pragma("unroll") for (int j = 0; j < 16; ++j) { \
                _Pragma("unroll") for (int e4 = 0; e4 < 8; ++e4) { const float4 w = wl_[(16 * hh + j) * 8 + (e4 ^ sw_)]; \
                    acc[4 * e4] = fmaf(v[hh][j], w.x, acc[4 * e4]); acc[4 * e4 + 1] = fmaf(v[hh][j], w.y, acc[4 * e4 + 1]); acc[4 * e4 + 2] = fmaf(v[hh][j], w.z, acc[4 * e4 + 2]); acc[4 * e4 + 3] = fmaf(v[hh][j], w.w, acc[4 * e4 + 3]); } } \
            float tv[4]; int ti[4]; route_reduce32(acc, l5_, rb_, tv, ti); \
            const float e1 = expf(tv[1] - tv[0]), e2 = expf(tv[2] - tv[0]), e3 = expf(tv[3] - tv[0]); const float inv = 1.0f / (1.0f + e1 + e2 + e3); \
            if (l5_ < 4) { const int ek = l5_ == 0 ? ti[0] : l5_ == 1 ? ti[1] : l5_ == 2 ? ti[2] : ti[3]; const float gk = (l5_ == 0 ? 1.0f : l5_ == 1 ? e1 : l5_ == 2 ? e2 : e3) * inv; \
                const unsigned pos = __hip_atomic_fetch_add(lcnt_ + ek, 1u, __ATOMIC_RELAXED, __HIP_MEMORY_SCOPE_WORKGROUP); TOKE[r * 4 + l5_] = ek; TOKG[r * 4 + l5_] = gk; \
                stash_[it_ * 8 + half_ * 4 + l5_] = (unsigned)ek | (pos << 8); } \
        } \
        __syncthreads(); \
        if (tid < 32) lbase_[tid] = atomicAdd(cnt_ + tid, lcnt_[tid]); \
        __syncthreads(); \
        for (int e_ = lane; e_ < it_ * 8; e_ += 64) { const unsigned w_ = stash_[e_]; const int r = (gw + (e_ >> 3) * NGW) * 2 + ((e_ >> 2) & 1); TOKP[r * 4 + (e_ & 3)] = (int)((w_ >> 8) + lbase_[w_ & 255u]); } \
    } while (0)

#define EXCL_SETUP(L) \
        const int c_ = lane < 32 ? (int)ctl[CW_CNT + (L) * 32 + lane] : 0; const int padc_ = (c_ + 255) / 256 * 256; int pre_ = padc_; \
        _Pragma("unroll") for (int o_ = 1; o_ < 32; o_ <<= 1) { const int t_ = __shfl_up(pre_, o_); if ((lane & 31) >= o_) pre_ += t_; } \
        const int excl_ = pre_ - padc_;
#define PERMUTE_PHASE(L, nrows) do { EXCL_SETUP(L) \
        ROWS2(nrows) { ROWS2_IDX(nrows) \
            const int ra_ = rr_[0], rb_ = rr_[1]; \
            const uint4* sa_ = (const uint4*)(H + (size_t)ra_ * 1024) + lane * 2; const uint4* sb_ = (const uint4*)(H + (size_t)rb_ * 1024) + lane * 2; \
            const uint4 a0_ = sa_[0], a1_ = sa_[1], b0_ = sb_[0], b1_ = sb_[1]; \
            const int4 ea_ = *(const int4*)(TOKE + ra_ * 4), pa_ = *(const int4*)(TOKP + ra_ * 4), eb_ = *(const int4*)(TOKE + rb_ * 4), pb_ = *(const int4*)(TOKP + rb_ * 4); \
            const int sa0 = __shfl(excl_, ea_.x) + pa_.x, sa1 = __shfl(excl_, ea_.y) + pa_.y, sa2 = __shfl(excl_, ea_.z) + pa_.z, sa3 = __shfl(excl_, ea_.w) + pa_.w; \
            const int sb0 = __shfl(excl_, eb_.x) + pb_.x, sb1 = __shfl(excl_, eb_.y) + pb_.y, sb2 = __shfl(excl_, eb_.z) + pb_.z, sb3 = __shfl(excl_, eb_.w) + pb_.w; \
            { uint4* d_ = (uint4*)(XS + (size_t)sa0 * 1024) + lane * 2; d_[0] = a0_; d_[1] = a1_; } { uint4* d_ = (uint4*)(XS + (size_t)sa1 * 1024) + lane * 2; d_[0] = a0_; d_[1] = a1_; } \
            { uint4* d_ = (uint4*)(XS + (size_t)sa2 * 1024) + lane * 2; d_[0] = a0_; d_[1] = a1_; } { uint4* d_ = (uint4*)(XS + (size_t)sa3 * 1024) + lane * 2; d_[0] = a0_; d_[1] = a1_; } \
            if (two_) { \
            { uint4* d_ = (uint4*)(XS + (size_t)sb0 * 1024) + lane * 2; d_[0] = b0_; d_[1] = b1_; } { uint4* d_ = (uint4*)(XS + (size_t)sb1 * 1024) + lane * 2; d_[0] = b0_; d_[1] = b1_; } \
            { uint4* d_ = (uint4*)(XS + (size_t)sb2 * 1024) + lane * 2; d_[0] = b0_; d_[1] = b1_; } { uint4* d_ = (uint4*)(XS + (size_t)sb3 * 1024) + lane * 2; d_[0] = b0_; d_[1] = b1_; } } } \
        for (int e = 0; e < 32; ++e) { const int ce = __shfl(c_, e), be = __shfl(excl_, e), pe = __shfl(padc_, e); \
            for (int rr = ce + gw; rr < pe; rr += NGW) { uint4* d_ = (uint4*)(XS + (size_t)(be + rr) * 1024) + lane * 2; d_[0] = make_uint4(0u, 0u, 0u, 0u); d_[1] = make_uint4(0u, 0u, 0u, 0u); } } \
    } while (0)
#define PERMUTE_PHASE_F8(L, nrows) do { EXCL_SETUP(L) \
        unsigned char* XS8 = (unsigned char*)XS; \
        for (int r = gw; r < (nrows); r += NGW) { \
            const int4 ov_ = *((const int4*)((const unsigned char*)H + (size_t)r * 1024) + lane); \
            _Pragma("unroll") for (int k = 0; k < 4; ++k) { const int ek = TOKE[r * 4 + k], pk = TOKP[r * 4 + k]; const int slot = __shfl(excl_, ek) + pk; \
                *((int4*)(XS8 + (size_t)slot * 1024) + lane) = ov_; if (lane == 0) TOKP[r * 4 + k] = slot; } }        \
        for (int e = 0; e < 32; ++e) { const int ce = __shfl(c_, e), be = __shfl(excl_, e), pe = __shfl(padc_, e); \
            for (int rr = ce + gw; rr < pe; rr += NGW) *((int4*)(XS8 + (size_t)(be + rr) * 1024) + lane) = make_int4(0, 0, 0, 0); } \
    } while (0)
#define MOE_TABLE(L) \
        LAS int* tile_e = (LAS int*)(LDSB + LDS_MISC + 1024); LAS int* nm_p = tile_e + 640; \
        LAS int* tpre_ = nm_p + 1;                                       \
        __syncthreads(); \
        if (tid < 64) { const int c_ = lane < 32 ? (int)ctl[CW_CNT + (L) * 32 + lane] : 0; const int n_ = (c_ + 255) / 256; int pre_ = n_; \
            _Pragma("unroll") for (int o_ = 1; o_ < 32; o_ <<= 1) { const int t_ = __shfl_up(pre_, o_); if ((lane & 31) >= o_) pre_ += t_; } \
            if (lane < 32) tpre_[lane] = pre_ - n_; if (lane == 31) { tpre_[32] = pre_; *nm_p = pre_; } } \
        __syncthreads(); \
        const int nM_ = __builtin_amdgcn_readfirstlane(*nm_p); \
        for (int t_ = tid; t_ < nM_; t_ += NTHR) { int e_ = 0; _Pragma("unroll") for (int q_ = 16; q_ >= 1; q_ >>= 1) { if (tpre_[e_ + q_] <= t_) e_ += q_; } tile_e[t_] = e_; }        \
        __syncthreads();
#define MOE_FAST1(L) do { MOE_TABLE(L) \
        pg8::MoeOrder S{(const char*)XS, (const char*)(wts + WO_W1) + (size_t)(L) * 32 * 2048 * 1024 * 2, tile_e, nM_, 8, G, bid, (size_t)256 * 1024 * 2, (size_t)2048 * 1024 * 2}; \
        pg8::EpiSwiglu E{ACT, p.moe_b_in + (size_t)(L) * 32 * 2048, 1.0f}; \
        pg8::gemm_phase<pg8::EpiSwiglu, pg8::MoeOrder, true, true>(tid, LDSB, 1024, 1024, S, E); } while (0)
#define MOE_FAST2(L) do { MOE_TABLE(L) \
        pg8::MoeOrder S{(const char*)ACT, (const char*)(wts + WO_W2) + (size_t)(L) * 32 * 1024 * 1024 * 2, tile_e, nM_, 4, G, bid, (size_t)256 * 1024 * 2, (size_t)1024 * 1024 * 2}; \
        pg8::EpiBiasBf16 E{Y, p.moe_b_out + (size_t)(L) * 32 * 1024, 1.0f}; \
        pg8::gemm_phase<pg8::EpiBiasBf16, pg8::MoeOrder, true, true>(tid, LDSB, 1024, 1024, S, E); } while (0)
#define MOE_FAST1_F8(L) do { MOE_TABLE(L) \
        pg8::MoeOrder S{(const char*)XS, (const char*)(wts + WO_W1) + (size_t)(L) * 32 * 2048 * 1024 * 2, tile_e, nM_, 8, G, bid, (size_t)256 * 1024, (size_t)2048 * 1024}; \
        if constexpr (MOE_F8_DOWN) { pg8::EpiSwigluF8 E{(unsigned char*)ACT, p.moe_b_in + (size_t)(L) * 32 * 2048}; \
            pg8::gemm_phase<pg8::EpiSwigluF8, pg8::MoeOrder, true, true, true>(tid, LDSB, 1024, 1024, S, E); } \
        else { pg8::EpiSwiglu E{ACT, p.moe_b_in + (size_t)(L) * 32 * 2048, 0.03125f}; \
            pg8::gemm_phase<pg8::EpiSwiglu, pg8::MoeOrder, false, true, true>(tid, LDSB, 1024, 1024, S, E); } } while (0)
#define MOE_FAST2_F8(L) do { MOE_TABLE(L) \
        pg8::MoeOrder S{(const char*)ACT, (const char*)(wts + WO_W2) + (size_t)(L) * 32 * 1024 * 1024 * 2, tile_e, nM_, 4, G, bid, (size_t)256 * 1024, (size_t)1024 * 1024}; \
        if constexpr (Y8_L1 && (L) == 1) { pg8::EpiBiasF8 E{(unsigned char*)Y, p.moe_b_out + (size_t)(L) * 32 * 1024, 0.03125f}; \
            pg8::gemm_phase<pg8::EpiBiasF8, pg8::MoeOrder, true, true, true>(tid, LDSB, 1024, 1024, S, E); } \
        else { pg8::EpiBiasBf16 E{Y, p.moe_b_out + (size_t)(L) * 32 * 1024, 0.03125f}; \
            pg8::gemm_phase<pg8::EpiBiasBf16, pg8::MoeOrder, true, true, true>(tid, LDSB, 1024, 1024, S, E); } } while (0)
#define COMBINE_PRE(nrows) typedef int i4n_ __attribute__((ext_vector_type(4))); typedef float f4n_ __attribute__((ext_vector_type(4))); i4n_ sl0_, sl1_; f4n_ gt0_, gt1_; \
        { const int ra_ = gw < (nrows) ? gw : 0, rb_ = gw + NGW < (nrows) ? gw + NGW : ra_; sl0_ = *(const i4n_*)(TOKP + ra_ * 4); gt0_ = *(const f4n_*)(TOKG + ra_ * 4); sl1_ = *(const i4n_*)(TOKP + rb_ * 4); gt1_ = *(const f4n_*)(TOKG + rb_ * 4); }
#define COMBINE_ROWS2(L, v, nrows, F8Y) do { \
        const int slc_[2][4] = {{sl0_[0], sl0_[1], sl0_[2], sl0_[3]}, {sl1_[0], sl1_[1], sl1_[2], sl1_[3]}}; \
        const float gk_[2][4] = {{gt0_[0], gt0_[1], gt0_[2], gt0_[3]}, {gt1_[0], gt1_[1], gt1_[2], gt1_[3]}}; \
        uint4 ya_[2][4], yb_[2][4]; \
        _Pragma("unroll") for (int u = 0; u < 2; ++u) { const int r = rr_[u]; \
            _Pragma("unroll") for (int k = 0; k < 4; ++k) { \
                if constexpr (F8Y) { ya_[u][k] = *((const uint4*)((const unsigned char*)Y + (size_t)slc_[u][k] * 1024) + lane); yb_[u][k] = ya_[u][k]; } \
                else { const uint4* yr = (const uint4*)(Y + (size_t)slc_[u][k] * 1024 + 16 * lane); ya_[u][k] = yr[0]; yb_[u][k] = yr[1]; } } \
            ld16f(XR + (size_t)r * 1024 + 16 * lane, v[u]); } \
        { const int n0_ = r0_ + 2 * NGW; if (n0_ < (nrows)) { const int n1_ = n0_ + NGW < (nrows) ? n0_ + NGW : n0_; \
            sl0_ = *(const i4n_*)(TOKP + n0_ * 4); gt0_ = *(const f4n_*)(TOKG + n0_ * 4); sl1_ = *(const i4n_*)(TOKP + n1_ * 4); gt1_ = *(const f4n_*)(TOKG + n1_ * 4); } } \
        _Pragma("unroll") for (int u = 0; u < 2; ++u) { float f_[16]; \
            _Pragma("unroll") for (int j = 0; j < 16; ++j) f_[j] = 0.f; \
            _Pragma("unroll") for (int k = 0; k < 4; ++k) { \
                if constexpr (F8Y) { const int yw[4] = {(int)ya_[u][k].x, (int)ya_[u][k].y, (int)ya_[u][k].z, (int)ya_[u][k].w}; \
                    _Pragma("unroll") for (int j = 0; j < 4; ++j) { const auto lo_ = __builtin_amdgcn_cvt_pk_f32_fp8(yw[j], false); const auto hi_ = __builtin_amdgcn_cvt_pk_f32_fp8(yw[j], true); \
                        f_[4 * j] = fmaf(gk_[u][k], lo_[0], f_[4 * j]); f_[4 * j + 1] = fmaf(gk_[u][k], lo_[1], f_[4 * j + 1]); f_[4 * j + 2] = fmaf(gk_[u][k], hi_[0], f_[4 * j + 2]); f_[4 * j + 3] = fmaf(gk_[u][k], hi_[1], f_[4 * j + 3]); } } \
                else { const unsigned yw[8] = {ya_[u][k].x, ya_[u][k].y, ya_[u][k].z, ya_[u][k].w, yb_[u][k].x, yb_[u][k].y, yb_[u][k].z, yb_[u][k].w}; \
                    _Pragma("unroll") for (int j = 0; j < 8; ++j) { f_[2 * j] = fmaf(gk_[u][k], __uint_as_float(yw[j] << 16), f_[2 * j]); f_[2 * j + 1] = fmaf(gk_[u][k], __uint_as_float(yw[j] & 0xffff0000u), f_[2 * j + 1]); } } } \
            float g2v_[16]; ld16f(MOD + (size_t)((L) * 17 + mod_row_of(rr_[u])) * 6144 + 5120 + 16 * lane, g2v_);        \
            _Pragma("unroll") for (int j = 0; j < 16; ++j) v[u][j] = fmaf(g2v_[j], f_[j], v[u][j]); } } while (0)

    if (IN(7)) { PHASE_PTRS ROUTER_PHASE(0, NROW); }
    SEAM(7);
#if MOE_F8_L0
    if (IN(8)) { PHASE_PTRS PERMUTE_PHASE_F8(0, NROW); }
    SEAM(8);
    if (IN(9)) { PHASE_PTRS MOE_FAST1_F8(0); }
    SEAM(9);
#else
    if (IN(8)) { PHASE_PTRS PERMUTE_PHASE(0, NROW); }
    SEAM(8);
    if (IN(9)) { PHASE_PTRS MOE_FAST1(0); }
    SEAM(9);
#endif
    if (IN(10)) { PHASE_PTRS if constexpr (MOE_F8_L0 && MOE_F8_DOWN) { MOE_FAST2_F8(0); } else { MOE_FAST2(0); } }
    SEAM(10);

    if (IN(11)) { PHASE_PTRS
        float g[16]; ld16f(p.norm_mix_g + 1024 + 16 * lane, g);
        COMBINE_PRE(NROW)
        ROWS2(NROW) { ROWS2_IDX(NROW)
            float v[2][16]; COMBINE_ROWS2(0, v, NROW, false);
            st16f(XR + (size_t)rr_[0] * 1024 + 16 * lane, v[0]); if (two_) st16f(XR + (size_t)rr_[1] * 1024 + 16 * lane, v[1]);
            const float* mr0 = MOD + (size_t)(1 * 17 + mod_row_of(rr_[0])) * 6144 + 16 * lane; const float* mr1 = MOD + (size_t)(1 * 17 + mod_row_of(rr_[1])) * 6144 + 16 * lane;
            NORM_MOD16x2(v, g, mr0, mr1);
            if (INPROJ_F8) { st16f8((unsigned char*)H + (size_t)rr_[0] * 1024 + 16 * lane, v[0]); if (two_) st16f8((unsigned char*)H + (size_t)rr_[1] * 1024 + 16 * lane, v[1]); }
            else { st16bf(H + (size_t)rr_[0] * 1024 + 16 * lane, v[0]); if (two_) st16bf(H + (size_t)rr_[1] * 1024 + 16 * lane, v[1]); }
        }
    }
    SEAM(11);

    if (IN(12)) { PHASE_PTRS
        constexpr size_t ES_ = INPROJ_F8 ? 1 : 2;
        pg8::DenseOrder S{(const char*)H, (const char*)(wts + WO_C), NROW / 256, 6, G, bid, (size_t)256 * 1024 * ES_, (size_t)256 * 1024 * ES_};
        pg8::EpiStoreBf16 E{PRJ, PRJ_LD, INPROJ_F8 ? 0.03125f : 1.0f};
        pg8::gemm_phase<pg8::EpiStoreBf16, pg8::DenseOrder, true, true, INPROJ_F8 != 0>(tid, LDSB, 1024, 1024, S, E);
    }
    SEAM(12);

    if (IN(13)) { PHASE_PTRS
        const float2* TC = (const float2*)(tabs + TAB_C); const float kg1 = p.c_k_g[lane], kg2 = p.c_k_g[64 + lane];
        for (int r = gw; r < NROW; r += NGW) {
            bf16_t* pr = PRJ + (size_t)r * PRJ_LD + 1024; float2 t = make_float2(1.f, 0.f); if (r < NLAT) t = TC[(r % SEQ) * 64 + lane];
#pragma unroll
            for (int kv = 0; kv < 2; ++kv) { float x1 = bf2f(pr[kv * 128 + lane]), x2 = bf2f(pr[kv * 128 + 64 + lane]);
                const float ss = wave_sum(x1 * x1 + x2 * x2); const float ri = 1.0f / sqrtf(ss * (1.0f / 128.0f) + RMS_EPS);
                x1 = x1 * ri * kg1; x2 = x2 * ri * kg2;
                pr[kv * 128 + lane] = f2bf(x1 * t.x - x2 * t.y); pr[kv * 128 + 64 + lane] = f2bf(x2 * t.x + x1 * t.y); }
        }
    }
    SEAM(13);

    if (IN(14)) { PHASE_PTRS
        for (int i = 0;; ++i) { const int u = i * G + bid; if (u >= 1024) break;
            const int rest = u >> 3; const int b = 2 * (u & 7) + (rest >> 6), h = (rest & 63) >> 3, qb = rest & 7; const int qrow0 = b * SEQ + qb * 256;
            fa::Unit U; U.Q = PRJ + (size_t)qrow0 * PRJ_LD + h * 128; U.K = PRJ + 1024 + (h >> 2) * 128; U.K2 = nullptr; U.V = PRJ + 1280 + (h >> 2) * 128;
            U.O = OUTPROJ_F8 ? (bf16_t*)((unsigned char*)OB + (size_t)qrow0 * 1024 + h * 128) : OB + (size_t)qrow0 * 1024 + h * 128; U.rowa = NLAT + b * NCX; U.nta = 4; U.rowb = b * SEQ; U.ntb = 32;
            U.window = 0; U.qpos0 = 0; U.kposb0 = 0; U.sink = 0.f; U.has_sink = 0; U.tab = (const float*)(tabs + TAB_C); U.pos0 = qb * 256; U.qg = (const float*)(tabs + TAB_QG);
            fa::attn_unit<128, 128, PRJ_LD, PRJ_LD, PRJ_LD, 1024, false, 0, 4, true, false, OUTPROJ_F8 != 0>(tid, U, (char*)lds_raw); }
    }
    SEAM(14);

    if (IN(15)) { PHASE_PTRS
        constexpr size_t ES_ = OUTPROJ_F8 ? 1 : 2;
        pg8::DenseOrder S{(const char*)OB, (const char*)(wts + WO_CO), NLAT / 256, 4, G, bid, (size_t)256 * 1024 * ES_, (size_t)256 * 1024 * ES_};
        pg8::EpiResid E{XR, XR, XR, MOD + 17 * 6144 + 2048, OUTPROJ_F8 ? 0.03125f : 1.0f};
        pg8::gemm_phase<pg8::EpiResid, pg8::DenseOrder, true, true, OUTPROJ_F8 != 0>(tid, LDSB, 1024, 1024, S, E);
    }
    SEAM(15);

    if (IN(16)) { PHASE_PTRS ROUTER_PHASE(1, NLAT); }
    SEAM(16);
#if MOE_F8_L1
    if (IN(17)) { PHASE_PTRS PERMUTE_PHASE_F8(1, NLAT); }
    SEAM(17);
    if (IN(18)) { PHASE_PTRS MOE_FAST1_F8(1); }
    SEAM(18);
    if (IN(19)) { PHASE_PTRS if constexpr (MOE_F8_DOWN) { MOE_FAST2_F8(1); } else { MOE_FAST2(1); } }
    SEAM(19);
#else
    if (IN(17)) { PHASE_PTRS PERMUTE_PHASE(1, NLAT); }
    SEAM(17);
    if (IN(18)) { PHASE_PTRS MOE_FAST1(1); }
    SEAM(18);
    if (IN(19)) { PHASE_PTRS MOE_FAST2(1); }
    SEAM(19);
#endif

    if (IN(20)) { PHASE_PTRS
        float g[16]; ld16f(p.final_g + 16 * lane, g);
        COMBINE_PRE(NLAT)
        ROWS2(NLAT) { ROWS2_IDX(NLAT)
            float v[2][16]; COMBINE_ROWS2(1, v, NLAT, (Y8_L1 && MOE_F8_L1 && MOE_F8_DOWN));
            float s0 = 0.f, s1 = 0.f;
#pragma unroll
            for (int j = 0; j < 16; ++j) { s0 = fmaf(v[0][j], v[0][j], s0); s1 = fmaf(v[1][j], v[1][j], s1); }
            wave_sum2(s0, s1); const float ri0 = 1.0f / sqrtf(s0 * (1.0f / 1024.0f) + RMS_EPS), ri1 = 1.0f / sqrtf(s1 * (1.0f / 1024.0f) + RMS_EPS);
#pragma unroll
            for (int j = 0; j < 16; ++j) { v[0][j] = v[0][j] * ri0 * g[j]; v[1][j] = v[1][j] * ri1 * g[j]; }
            st16f(p.out + (size_t)rr_[0] * 1024 + 16 * lane, v[0]); if (two_) st16f(p.out + (size_t)rr_[1] * 1024 + 16 * lane, v[1]);
        }
    }
#undef IN
#undef SEAM
}

#ifndef MK_PER_PHASE
#define MK_PER_PHASE 0
#endif
extern "C" void kernel_launch(void* const* d_in, const int* in_sizes, int n_in, void* d_out, int out_size, void* d_ws, size_t ws_size, hipStream_t stream) {
    static int grid = 0;
    if (grid == 0) {
        if (n_in != 26 || out_size != NLAT * DM || ws_size < WS_END) { fprintf(stderr, "kernel_launch: unexpected shapes (n_in %d out %d ws %zu need %zu)\n", n_in, out_size, ws_size, (size_t)WS_END); grid = -1; return; }
        int dev = 0, cus = 0;
        if (hipGetDevice(&dev) != hipSuccess || hipDeviceGetAttribute(&cus, hipDeviceAttributeMultiprocessorCount, dev) != hipSuccess) { grid = -1; return; }
        if (hipFuncSetAttribute((const void*)fwd_kernel, hipFuncAttributeMaxDynamicSharedMemorySize, LDS_BYTES) != hipSuccess) { fprintf(stderr, "kernel_launch: hipFuncSetAttribute failed\n"); grid = -1; return; }
        int per_cu = 0;
        if (hipOccupancyMaxActiveBlocksPerMultiprocessor(&per_cu, (const void*)fwd_kernel, NTHR, LDS_BYTES) != hipSuccess || per_cu < 1) { fprintf(stderr, "kernel_launch: occupancy query says %d\n", per_cu); }
        (void)hipGetLastError();
        grid = cus;
    }
    if (grid < 0) return;
    (void)hipMemsetAsync((char*)d_ws + WS_CTL, 0, CTL_BYTES, stream);
    Params p{};
    const float** pp = (const float**)&p;
    for (int i = 0; i < 26; ++i) pp[i] = (const float*)d_in[i];
    p.out = (float*)d_out; p.ws = (unsigned char*)d_ws;
#if MK_PER_PHASE
    for (int k = 0; k < N_PHASES; ++k) { p.ph_lo = k; p.ph_hi = k + 1; hipLaunchKernelGGL(fwd_kernel, dim3(grid), dim3(NTHR), LDS_BYTES, stream, p); }
#else
    p.ph_lo = 0; p.ph_hi = N_PHASES;
    hipLaunchKernelGGL(fwd_kernel, dim3(grid), dim3(NTHR), LDS_BYTES, stream, p);
#endif
}
```

```cpp
#include <hip/hip_runtime.h>
#include <cstdio>
#include <cstdint>

typedef unsigned short bf16_t;
typedef bf16_t act_t;
#define GAS __attribute__((address_space(1)))
#define LAS __attribute__((address_space(3)))

constexpr int DM = 1024, NB = 16, SEQ = 2048, NCX = 256, GRIDW = 64;
constexpr int NLAT = NB * SEQ, NCTX = NB * NCX, NROW = NLAT + NCTX;
constexpr int AB_IN = 1440, C_IN = 1536, PRJ_LD = 1536;
constexpr int NEXP = 32, DFF = 1024;
constexpr int CAP = 155648;
constexpr float RMS_EPS = 1e-6f;
constexpr int NTHR = 512;

constexpr size_t MiB = 1u << 20;
constexpr size_t ASZ = sizeof(act_t);
constexpr size_t WS_CTL = 0, CTL_BYTES = 1 * MiB;
constexpr size_t WS_MOD = 1 * MiB;
constexpr size_t WS_TOKE = 2 * MiB, WS_TOKP = 3 * MiB, WS_TOKG = 4 * MiB;
constexpr size_t WS_RINV = 5 * MiB;
constexpr size_t WS_TAB = 6 * MiB;
constexpr size_t TAB_A = 0, TAB_B = (size_t)SEQ * 32 * 8, TAB_C = TAB_B + (size_t)SEQ * 16 * 8, TAB_QG = TAB_C + (size_t)SEQ * 64 * 8;
constexpr size_t WS_XR = 16 * MiB;
constexpr size_t WS_H = WS_XR + 144 * MiB;
constexpr size_t WS_BIG = WS_H + (size_t)NROW * 1024 * ASZ;
constexpr size_t OFF_PRJ = 0;
constexpr size_t OFF_QB = OFF_PRJ + (size_t)NROW * 1536 * ASZ;
constexpr size_t OFF_KVB = OFF_QB + (size_t)NROW * 768 * ASZ;
constexpr size_t OFF_O = OFF_KVB + (size_t)NROW * 1024 * ASZ;
constexpr size_t BIG_A = OFF_O + (size_t)NROW * 1024 * ASZ;
constexpr size_t BIG_Y = (size_t)CAP * 1024 * ASZ;
constexpr size_t BIG_BYTES = BIG_A > BIG_Y ? BIG_A : BIG_Y;
constexpr size_t WS_ACT = WS_BIG + BIG_BYTES;
constexpr size_t WS_XS = WS_ACT + (size_t)CAP * 1024 * ASZ;
constexpr size_t WS_W = WS_XS + (size_t)CAP * 1024 * ASZ;
constexpr size_t WO_AB = 0;
constexpr size_t WO_QB = WO_AB + (size_t)1536 * 1024 * 2;
constexpr size_t WO_KVB = WO_QB + (size_t)768 * 384 * 2;
constexpr size_t WO_ABO = WO_KVB + (size_t)1024 * 256 * 2;
constexpr size_t WO_C = WO_ABO + (size_t)1024 * 1024 * 2;
constexpr size_t WO_CO = WO_C + (size_t)1536 * 1024 * 2;
constexpr size_t WO_W1 = WO_CO + (size_t)1024 * 1024 * 2;
constexpr size_t WO_W2 = WO_W1 + (size_t)64 * 2048 * 1024 * 2;
constexpr size_t WS_END = WS_W + WO_W2 + (size_t)64 * 1024 * 1024 * 2;

constexpr int CW_CNT = 64;
constexpr int CW_BAR = 4096;

__device__ __forceinline__ float bf2f(bf16_t v) { return __uint_as_float(((unsigned)v) << 16); }
__device__ __forceinline__ bf16_t f2bf(float f) { unsigned u = __float_as_uint(f); return (bf16_t)((u + 0x7fffu + ((u >> 16) & 1u)) >> 16); }
__device__ __forceinline__ float ldA(const float* p) { return *p; }
__device__ __forceinline__ float ldA(const bf16_t* p) { return bf2f(*p); }
__device__ __forceinline__ void stA(float* p, float v) { *p = v; }
__device__ __forceinline__ void stA(bf16_t* p, float v) { *p = f2bf(v); }
template <int N> __device__ __forceinline__ void load_vec(const float* p, float (&o)[N]) {
#pragma unroll
    for (int i = 0; i < N / 4; ++i) { const float4 t = ((const float4*)p)[i]; o[4 * i] = t.x; o[4 * i + 1] = t.y; o[4 * i + 2] = t.z; o[4 * i + 3] = t.w; }
}
template <int N> __device__ __forceinline__ void load_vec(const bf16_t* p, float (&o)[N]) {
#pragma unroll
    for (int i = 0; i < N / 8; ++i) { const uint4 t = ((const uint4*)p)[i];
        o[8 * i] = __uint_as_float(t.x << 16); o[8 * i + 1] = __uint_as_float(t.x & 0xffff0000u); o[8 * i + 2] = __uint_as_float(t.y << 16); o[8 * i + 3] = __uint_as_float(t.y & 0xffff0000u);
        o[8 * i + 4] = __uint_as_float(t.z << 16); o[8 * i + 5] = __uint_as_float(t.z & 0xffff0000u); o[8 * i + 6] = __uint_as_float(t.w << 16); o[8 * i + 7] = __uint_as_float(t.w & 0xffff0000u); }
}
__device__ __forceinline__ float wave_sum(float v) {
#pragma unroll
    for (int o = 1; o < 64; o <<= 1) v += __shfl_xor(v, o);
    return v;
}

__device__ __forceinline__ void wave_sum2(float& a, float& b) {
#pragma unroll
    for (int o = 1; o < 64; o <<= 1) { const float ta = __shfl_xor(a, o), tb = __shfl_xor(b, o); a += ta; b += tb; }
}
__device__ __forceinline__ void ld16f(const float* p, float (&v)[16]) {
#pragma unroll
    for (int i = 0; i < 4; ++i) { const float4 t = ((const float4*)p)[i]; v[4 * i] = t.x; v[4 * i + 1] = t.y; v[4 * i + 2] = t.z; v[4 * i + 3] = t.w; }
}
__device__ __forceinline__ void st16f(float* p, const float (&v)[16]) {
#pragma unroll
    for (int i = 0; i < 4; ++i) ((float4*)p)[i] = make_float4(v[4 * i], v[4 * i + 1], v[4 * i + 2], v[4 * i + 3]);
}
__device__ __forceinline__ unsigned cvtpk2(float lo, float hi) { unsigned r; asm volatile("v_cvt_pk_bf16_f32 %0, %1, %2" : "=v"(r) : "v"(lo), "v"(hi)); return r; }
__device__ __forceinline__ void st16bf(bf16_t* p, const float (&v)[16]) {
    ((uint4*)p)[0] = make_uint4(cvtpk2(v[0], v[1]), cvtpk2(v[2], v[3]), cvtpk2(v[4], v[5]), cvtpk2(v[6], v[7]));
    ((uint4*)p)[1] = make_uint4(cvtpk2(v[8], v[9]), cvtpk2(v[10], v[11]), cvtpk2(v[12], v[13]), cvtpk2(v[14], v[15]));
}

__device__ __forceinline__ void st16f8(unsigned char* p, const float (&v)[16]) {
    int o[4];
#pragma unroll
    for (int j = 0; j < 4; ++j) { const int t = __builtin_amdgcn_cvt_pk_fp8_f32(v[4 * j], v[4 * j + 1], 0, false); o[j] = __builtin_amdgcn_cvt_pk_fp8_f32(v[4 * j + 2], v[4 * j + 3], t, true); }
    *(int4*)p = make_int4(o[0], o[1], o[2], o[3]);
}
#define XB_TMO      128
#define XB_XCNT(j)  (256  + 64 * (j))
#define XB_XSUB(j)  (1280 + 64 * (j))
#define XB_XGEN(j)  (2304 + 64 * (j))
#define XB_TOP      3328
#define XB_TOPGEN   3392
#define XCD_BAR_WORDS 3456
#define XB_SPIN_CAP (1u << 22)
__device__ __forceinline__ unsigned xb_ld(unsigned* p)              { return __hip_atomic_load(p, __ATOMIC_RELAXED, __HIP_MEMORY_SCOPE_AGENT); }
__device__ __forceinline__ unsigned xb_add(unsigned* p, unsigned v) { return __hip_atomic_fetch_add(p, v, __ATOMIC_RELAXED, __HIP_MEMORY_SCOPE_AGENT); }
__device__ __forceinline__ unsigned xb_xcc_id() { return (unsigned)__builtin_amdgcn_s_getreg((3 << 11) | 20) & 0xFu; }
#define XB_SPIN(cond, bar) do { unsigned _sp = 0; while (cond) { __builtin_amdgcn_s_sleep(1); \
    if ((++_sp & 255u) == 0u) { if (xb_ld(&(bar)[XB_TMO])) break; if (_sp > XB_SPIN_CAP) { atomicAdd(&(bar)[XB_TMO], 1u); break; } } } } while (0)
struct XcdBarrier { unsigned* bar; unsigned x; volatile LAS unsigned* st; };
__device__ __forceinline__ bool xb_is_leader(int wave0) { return wave0 == 0 && __builtin_amdgcn_mbcnt_hi(~0u, __builtin_amdgcn_mbcnt_lo(~0u, 0u)) == 0u; }
__device__ __forceinline__ XcdBarrier xcd_barrier_post(unsigned* bar, volatile LAS unsigned* st, int wave0) {
    XcdBarrier b; b.bar = bar; b.x = xb_xcc_id(); b.st = st;
    if (xb_is_leader(wave0)) (void)xb_add(&bar[XB_XCNT(b.x)], 1u);
    return b;
}
__device__ __forceinline__ void xcd_barrier_complete(unsigned* bar, unsigned x, unsigned& nloc, unsigned& nx) {
    const unsigned G = gridDim.x * gridDim.y * gridDim.z;
    unsigned sum, cnt, mine, sp = 0u;
    for (;;) {
        sum = 0u; cnt = 0u; mine = 0u;
#pragma unroll
        for (unsigned j = 0; j < 16; ++j) { const unsigned c = xb_ld(&bar[XB_XCNT(j)]); sum += c; cnt += (c > 0u) ? 1u : 0u; mine = (j == x) ? c : mine; }
        if (sum == G) break;
        __builtin_amdgcn_s_sleep(1);
        if ((++sp & 255u) == 0u) { if (xb_ld(&bar[XB_TMO])) break; if (sp > XB_SPIN_CAP) { atomicAdd(&bar[XB_TMO], 1u); break; } }
    }
    nloc = mine > 0u ? mine : 1u; nx = cnt > 0u ? cnt : 1u;
}
__device__ __forceinline__ void xcd_barrier(const XcdBarrier& b, int wave0) {
    asm volatile("s_waitcnt vmcnt(0)" ::: "memory");
    __syncthreads();
    if (xb_is_leader(wave0)) {
        unsigned* bar = b.bar;
        __builtin_amdgcn_s_waitcnt(0);
        unsigned nloc = b.st[0], nx = b.st[1];
        if (nloc == 0u) { xcd_barrier_complete(bar, b.x, nloc, nx); b.st[0] = nloc; b.st[1] = nx; }
        const unsigned old = xb_add(&bar[XB_XSUB(b.x)], 1u);
        const unsigned gen = old / nloc;
        if (old + 1u == (gen + 1u) * nloc) {
            __builtin_amdgcn_fence(__ATOMIC_RELEASE, "agent");
            asm volatile("s_waitcnt vmcnt(0)" ::: "memory");
            const unsigned og = xb_add(&bar[XB_TOP], 1u);
            const unsigned tg = og / nx;
            if (og + 1u == (tg + 1u) * nx) xb_add(&bar[XB_TOPGEN], 1u);
            else XB_SPIN(xb_ld(&bar[XB_TOPGEN]) == tg, bar);
            __builtin_amdgcn_fence(__ATOMIC_ACQUIRE, "agent");
            xb_add(&bar[XB_XGEN(b.x)], 1u);
            asm volatile("s_waitcnt vmcnt(0)" ::: "memory");
        } else {
            XB_SPIN(xb_ld(&bar[XB_XGEN(b.x)]) == gen, bar);
            __builtin_amdgcn_fence(__ATOMIC_ACQUIRE, "agent");
            asm volatile("s_waitcnt vmcnt(0)" ::: "memory");
        }
    }
    __syncthreads();
}


#ifndef FAST_GEMM
#define FAST_GEMM 1
#endif
namespace pg8 {
#define PG8_LAS __attribute__((address_space(3)))
typedef short bf16x8 __attribute__((ext_vector_type(8)));
typedef float f32x4 __attribute__((ext_vector_type(4)));
typedef unsigned u32x4 __attribute__((ext_vector_type(4)));
constexpr int BM = 256, BK = 64, HALF = 128, HTB = HALF * BK * 2  , STAGE_BYTES = 8 * HTB, NXCD = 8, WGM = 8;

__host__ __device__ __forceinline__ int lds_byte(int r, int c) { const int st = (r >> 4) * 2 + (c >> 5), rr = r & 15, cc = c & 31, ob = rr * 64 + cc * 2; return st * 1024 + (ob ^ (((ob >> 9) & 1) << 5)); }
__host__ __device__ __forceinline__ void stage_rc(int b, int& R, int& C) { const int st = b / 1024, sb = b % 1024, swz = sb ^ (((sb >> 9) & 1) << 5); R = (st >> 1) * 16 + swz / 64; C = (st & 1) * 32 + (swz % 64) / 2; }
__host__ __device__ __forceinline__ int perm32(int rho) { const int n = rho >> 4, i = rho & 15; return 8 * (i >> 2) + 4 * n + (i & 3); }


struct Unit { const char* a; const char* b; int pm, pn, aux; };
__device__ __forceinline__ unsigned cvt_pk_bf16(float lo, float hi) { unsigned r; asm volatile("v_cvt_pk_bf16_f32 %0, %1, %2" : "=v"(r) : "v"(lo), "v"(hi)); return r; }
typedef int v8i32 __attribute__((ext_vector_type(8)));
__device__ __forceinline__ v8i32 cat16(bf16x8 lo, bf16x8 hi) { typedef int v4i32 __attribute__((ext_vector_type(4))); const v4i32 a = __builtin_bit_cast(v4i32, lo), b = __builtin_bit_cast(v4i32, hi); return __builtin_shufflevector(a, b, 0, 1, 2, 3, 4, 5, 6, 7); }
template <class Epi, class Sched, bool ALIGN_EPI = false, bool SP2 = false, bool F8 = false>
__device__ __forceinline__ void gemm_phase(const int tid, PG8_LAS unsigned char* lds, const int K, const int lda, const Sched& S, const Epi& E) {
    const int wid = __builtin_amdgcn_readfirstlane(tid >> 6), lane = tid & 63, wr = wid >> 2, wc = wid & 3, fr = lane & 15, fq = lane >> 4;
    const int nt = F8 ? K / (2 * BK) : K / BK;
    unsigned voffA[2], voffB[2];
#pragma unroll
    for (int i = 0; i < 2; ++i) { int R, C; stage_rc(tid * 16 + i * 8192, R, C); const int Rb = Epi::PERM ? ((R & ~31) + perm32(R & 31)) : R;
        voffA[i] = F8 ? (unsigned)(R * lda + 2 * C) : (unsigned)(R * lda + C) * 2u; voffB[i] = F8 ? (unsigned)(Rb * K + 2 * C) : (unsigned)(Rb * K + C) * 2u; }
    const size_t kstep = (size_t)(BK * 2);
    const size_t hstepA = (size_t)HALF * lda * (F8 ? 1 : 2);
    const size_t hstep = (size_t)HALF * K * (F8 ? 1 : 2);
    const unsigned ldsbase = (unsigned)__builtin_amdgcn_readfirstlane((int)((unsigned)(uintptr_t)lds + (unsigned)wid * 1024u));
    const unsigned ldsw = (unsigned)wid * 1024u;
    const int aoff = lds_byte(wr * 64 + fr, fq * 8), boff = lds_byte(wc * 32 + fr, fq * 8);
#define PG8_SA(b, h) (((b) * 2 + (h)) * HTB)
#define PG8_SB(b, h) ((4 + (b) * 2 + (h)) * HTB)
#define PG8_STAGE(bufoff, gbase, voff) do { _Pragma("unroll") for (int _i = 0; _i < 2; ++_i) { \
        if constexpr (F8) { unsigned keep_; asm volatile("s_mov_b32 %0, m0\n\ts_mov_b32 m0, %3\n\ts_nop 0\n\tglobal_load_lds_dwordx4 %1, %2\n\ts_mov_b32 m0, %0" : "=&s"(keep_) : "v"((voff)[_i]), "s"((const char*)(gbase)), "s"(ldsbase + (unsigned)((bufoff) + _i * 8192)) : "memory"); } \
        else __builtin_amdgcn_global_load_lds((const unsigned*)((const char*)(gbase) + (voff)[_i]), (PG8_LAS unsigned*)(lds + (bufoff) + ldsw + _i * 8192), 16, 0, 0); } } while (0)
#define PG8_LDA(dst, b, h) do { _Pragma("unroll") for (int m = 0; m < 4; ++m) { _Pragma("unroll") for (int k = 0; k < 2; ++k) dst[m][k] = *(const PG8_LAS bf16x8*)(lds + PG8_SA(b, h) + aoff + m * 2048 + k * 1024); \
        if constexpr (F8) dst##8[m] = cat16(dst[m][0], dst[m][1]); } } while (0)
#define PG8_LDB(dst, b, h) do { _Pragma("unroll") for (int n = 0; n < 2; ++n) { _Pragma("unroll") for (int k = 0; k < 2; ++k) dst[n][k] = *(const PG8_LAS bf16x8*)(lds + PG8_SB(b, h) + boff + n * 2048 + k * 1024); \
        if constexpr (F8) dst##8[n] = cat16(dst[n][0], dst[n][1]); } } while (0)
#define PG8_MMA(ai, bj, At, Bt) do { __builtin_amdgcn_s_setprio(1); _Pragma("unroll") for (int m = 0; m < 4; ++m) _Pragma("unroll") for (int n = 0; n < 2; ++n) { \
        if constexpr (F8) acc[ai][bj][m][n] = __builtin_amdgcn_mfma_scale_f32_16x16x128_f8f6f4(Bt##8[n], At##8[m], acc[ai][bj][m][n], 0, 0, 0, 0x7f7f7f7f, 0, 0x7f7f7f7f); \
        else { _Pragma("unroll") for (int k = 0; k < 2; ++k) acc[ai][bj][m][n] = __builtin_amdgcn_mfma_f32_16x16x32_bf16(Bt[n][k], At[m][k], acc[ai][bj][m][n], 0, 0, 0); } } __builtin_amdgcn_s_setprio(0); } while (0)
#define PG8_WAIT_V(n) asm volatile("s_waitcnt vmcnt(" #n ")" ::: "memory")
#define PG8_WAIT_L(n) asm volatile("s_waitcnt lgkmcnt(" #n ")" ::: "memory")
#define PG8_BAR __builtin_amdgcn_s_barrier()
#define PG8_SCHED __builtin_amdgcn_sched_barrier(0)
    Unit cur, nxt; int ui = 0;
    if (!S.next(0, cur)) return;
    f32x4 acc[2][2][4][2];
#pragma unroll
    for (int a = 0; a < 2; ++a)
#pragma unroll
        for (int b = 0; b < 2; ++b)
#pragma unroll
            for (int m = 0; m < 4; ++m)
#pragma unroll
                for (int n = 0; n < 2; ++n) acc[a][b][m][n] = (f32x4){0.f, 0.f, 0.f, 0.f};
    bf16x8 At[4][2], B0[2][2], B1[2][2]; v8i32 At8[4], B08[2], B18[2]; (void)At8; (void)B08; (void)B18;
    const char* cA = cur.a; const char* cB = cur.b;
    S.a_ready(cur);
    if constexpr (SP2) {
        PG8_STAGE(PG8_SB(0, 0), cB, voffB); PG8_STAGE(PG8_SB(0, 1), cB + hstep, voffB); PG8_STAGE(PG8_SA(0, 0), cA, voffA); PG8_STAGE(PG8_SA(0, 1), cA + hstepA, voffA);
        if (wr == 1) PG8_BAR;
        PG8_WAIT_V(2); PG8_BAR;
        PG8_STAGE(PG8_SB(1, 0), cB + kstep, voffB); PG8_STAGE(PG8_SA(1, 0), cA + kstep, voffA); PG8_STAGE(PG8_SB(1, 1), cB + hstep + kstep, voffB);
        PG8_WAIT_V(6); PG8_BAR;
    } else {
        PG8_STAGE(PG8_SB(0, 0), cB, voffB); PG8_STAGE(PG8_SA(0, 0), cA, voffA); PG8_STAGE(PG8_SB(0, 1), cB + hstep, voffB); PG8_STAGE(PG8_SA(0, 1), cA + hstepA, voffA);
        if (wr == 1) PG8_BAR;
        PG8_WAIT_V(4); PG8_BAR;
        PG8_STAGE(PG8_SB(1, 0), cB + kstep, voffB); PG8_STAGE(PG8_SA(1, 0), cA + kstep, voffA); PG8_STAGE(PG8_SB(1, 1), cB + hstep + kstep, voffB);
        PG8_WAIT_V(6); PG8_BAR;
    }
    for (;;) {
        const bool has_next = S.next(ui + 1, nxt);
        const char* nA = has_next ? nxt.a : cA; const char* nB = has_next ? nxt.b : cB;
#pragma unroll 1
        for (int t = 0; t < nt; t += 2) {
            const bool last = (t == nt - 2);
            const char* a1 = cA + (size_t)(t + 1) * kstep;
            const char* a2 = last ? nA : cA + (size_t)(t + 2) * kstep; const char* b2 = last ? nB : cB + (size_t)(t + 2) * kstep;
            const char* a3 = a2 + kstep; const char* b3 = b2 + kstep;
            if (last && has_next) S.a_ready(nxt);
            if constexpr (SP2) {
            PG8_LDB(B0, 0, 0); PG8_LDB(B1, 0, 1); PG8_SCHED; PG8_LDA(At, 0, 0); PG8_STAGE(PG8_SA(1, 1), a1 + hstepA, voffA);
            PG8_WAIT_V(8); PG8_WAIT_L(0); PG8_BAR; PG8_MMA(0, 0, At, B0); PG8_MMA(0, 1, At, B1); PG8_BAR; PG8_SCHED;
            PG8_LDA(At, 0, 1); PG8_STAGE(PG8_SB(0, 0), b2, voffB); PG8_STAGE(PG8_SB(0, 1), b2 + hstep, voffB); PG8_STAGE(PG8_SA(0, 0), a2, voffA);
            PG8_WAIT_V(8); PG8_WAIT_L(0); PG8_BAR; PG8_MMA(1, 0, At, B0); PG8_MMA(1, 1, At, B1); PG8_BAR; PG8_SCHED;
            PG8_LDB(B0, 1, 0); PG8_LDB(B1, 1, 1); PG8_SCHED; PG8_LDA(At, 1, 0); PG8_STAGE(PG8_SA(0, 1), a2 + hstepA, voffA);
            PG8_WAIT_V(8); PG8_WAIT_L(0); PG8_BAR; PG8_MMA(0, 0, At, B0); PG8_MMA(0, 1, At, B1); PG8_BAR; PG8_SCHED;
            PG8_LDA(At, 1, 1); PG8_STAGE(PG8_SB(1, 0), b3, voffB); PG8_STAGE(PG8_SB(1, 1), b3 + hstep, voffB); PG8_STAGE(PG8_SA(1, 0), a3, voffA);
            PG8_WAIT_V(8); PG8_WAIT_L(0); PG8_BAR; PG8_MMA(1, 0, At, B0); PG8_MMA(1, 1, At, B1); PG8_BAR; PG8_SCHED;
            } else {
            PG8_LDB(B0, 0, 0); PG8_SCHED; PG8_LDA(At, 0, 0); PG8_STAGE(PG8_SA(1, 1), a1 + hstepA, voffA);
            PG8_WAIT_L(8); PG8_BAR; PG8_WAIT_L(0); PG8_MMA(0, 0, At, B0); PG8_BAR; PG8_SCHED;
            PG8_LDB(B1, 0, 1); PG8_STAGE(PG8_SB(0, 0), b2, voffB);
            PG8_BAR; PG8_WAIT_L(0); PG8_MMA(0, 1, At, B1); PG8_BAR;
            PG8_LDA(At, 0, 1); PG8_STAGE(PG8_SA(0, 0), a2, voffA);
            PG8_BAR; PG8_WAIT_L(0); PG8_MMA(1, 0, At, B0); PG8_BAR; PG8_SCHED;
            PG8_STAGE(PG8_SB(0, 1), b2 + hstep, voffB);
            PG8_WAIT_V(6); PG8_BAR; PG8_MMA(1, 1, At, B1); PG8_BAR;
            PG8_LDB(B0, 1, 0); PG8_SCHED; PG8_LDA(At, 1, 0); PG8_STAGE(PG8_SA(0, 1), a2 + hstepA, voffA);
            PG8_WAIT_L(8); PG8_BAR; PG8_WAIT_L(0); PG8_MMA(0, 0, At, B0); PG8_BAR; PG8_SCHED;
            PG8_LDB(B1, 1, 1); PG8_STAGE(PG8_SB(1, 0), b3, voffB);
            PG8_BAR; PG8_WAIT_L(0); PG8_MMA(0, 1, At, B1); PG8_BAR;
            PG8_LDA(At, 1, 1); PG8_STAGE(PG8_SA(1, 0), a3, voffA);
            PG8_BAR; PG8_WAIT_L(0); PG8_MMA(1, 0, At, B0); PG8_BAR; PG8_SCHED;
            PG8_STAGE(PG8_SB(1, 1), b3 + hstep, voffB);
            PG8_WAIT_V(6); PG8_BAR; PG8_MMA(1, 1, At, B1); PG8_BAR;
            }
        }
        if constexpr (ALIGN_EPI) { if (wr == 0) PG8_BAR; }
        if constexpr (!Epi::AFTER_DRAIN) { int tl_ = tid; asm volatile("" : "+v"(tl_)); E(acc, cur, wr, wc, tl_ & 15, (tl_ & 63) >> 4); S.done(cur); }
        if (!has_next) break;
#pragma unroll
        for (int a = 0; a < 2; ++a)
#pragma unroll
            for (int b = 0; b < 2; ++b)
#pragma unroll
                for (int m = 0; m < 4; ++m)
#pragma unroll
                    for (int n = 0; n < 2; ++n) acc[a][b][m][n] = (f32x4){0.f, 0.f, 0.f, 0.f};
        cur = nxt; cA = nA; cB = nB; ++ui;
        if constexpr (ALIGN_EPI) { if (wr == 1) PG8_BAR; }
    }
    PG8_WAIT_V(0);
    if constexpr (!ALIGN_EPI) { if (wr == 0) PG8_BAR; }
    PG8_BAR;
    if constexpr (Epi::AFTER_DRAIN) { E.fused(acc, cur, wr, wc, fr, fq, lds, wid, lane); S.done(cur); }
#undef PG8_SA
#undef PG8_SB
#undef PG8_STAGE
#undef PG8_LDA
#undef PG8_LDB
#undef PG8_MMA
#undef PG8_WAIT_V
#undef PG8_WAIT_L
#undef PG8_BAR
#undef PG8_SCHED
}
}
namespace pg8 {
struct OrderMap {
    __device__ __forceinline__ static bool map(int i, int G, int c, int nM, int nN, int& pm, int& pn) {
        const int nwg = nM * nN; const long L = (long)i * G + c; if (L >= nwg) return false;
        int wgid = (int)L; { const int q = nwg / NXCD, r = nwg % NXCD, xcd = wgid % NXCD, off = wgid / NXCD; wgid = (xcd < r ? xcd * (q + 1) : r * (q + 1) + (xcd - r) * q) + off; }
        const int nig = WGM * nN, gid = wgid / nig, fm = gid * WGM, gsz = (nM - fm) < WGM ? (nM - fm) : WGM;
        pm = fm + ((wgid % nig) % gsz); pn = (wgid % nig) / gsz; return true;
    }
};
struct DenseOrder {
    const char* A; const char* B; int nM, nN, G, c; size_t tstepA, tstepB;
    __device__ __forceinline__ bool next(int i, Unit& u) const { int pm, pn; if (!OrderMap::map(i, G, c, nM, nN, pm, pn)) return false; u.pm = pm; u.pn = pn; u.aux = 0; u.a = A + (size_t)pm * tstepA; u.b = B + (size_t)pn * tstepB; return true; }
    __device__ __forceinline__ void a_ready(const Unit&) const {}
    __device__ __forceinline__ void done(const Unit&) const {}
};
struct MoeOrder {
    const char* A; const char* B; const PG8_LAS int* tile_e; int nM, nN, G, c; size_t tstep, estep;
    __device__ __forceinline__ bool next(int i, Unit& u) const { int pm, pn; if (!OrderMap::map(i, G, c, nM, nN, pm, pn)) return false; const int e = __builtin_amdgcn_readfirstlane(tile_e[pm]); u.pm = pm; u.pn = pn; u.aux = e;
        u.a = A + (size_t)pm * tstep; u.b = B + (size_t)e * estep + (size_t)pn * tstep; return true; }
    __device__ __forceinline__ void a_ready(const Unit&) const {}
    __device__ __forceinline__ void done(const Unit&) const {}
};
struct EpiStoreBf16 { static constexpr bool PERM = true, AFTER_DRAIN = false;
    bf16_t* O; int ldc; float ascale;
    __device__ __forceinline__ void operator()(const f32x4 (&acc)[2][2][4][2], const Unit& u, int wr, int wc, int fr, int fq) const {
        bf16_t* base = O + (size_t)(u.pm * BM + wr * 64 + fr) * ldc + u.pn * BM + wc * 32 + 8 * fq;
        float asc = ascale; asm volatile("" : "+v"(asc));
#pragma unroll
        for (int ai = 0; ai < 2; ++ai)
#pragma unroll
            for (int m = 0; m < 4; ++m) { bf16_t* rowp = base + (size_t)(ai * HALF + m * 16) * ldc;
#pragma unroll
                for (int bj = 0; bj < 2; ++bj) { const f32x4 v0 = acc[ai][bj][m][0] * asc, v1 = acc[ai][bj][m][1] * asc; u32x4 w;
                    w.x = cvt_pk_bf16(v0[0], v0[1]); w.y = cvt_pk_bf16(v0[2], v0[3]); w.z = cvt_pk_bf16(v1[0], v1[1]); w.w = cvt_pk_bf16(v1[2], v1[3]);
                    *(u32x4*)(rowp + bj * HALF) = w; } }
    }
};
struct EpiScaleBf16 { static constexpr bool PERM = true, AFTER_DRAIN = false;
    bf16_t* O; int ldc; const float* rs;
    __device__ __forceinline__ void operator()(const f32x4 (&acc)[2][2][4][2], const Unit& u, int wr, int wc, int fr, int fq) const {
        const int row0 = u.pm * BM + wr * 64 + fr; bf16_t* base = O + (size_t)row0 * ldc + u.pn * BM + wc * 32 + 8 * fq;
#pragma unroll
        for (int ai = 0; ai < 2; ++ai)
#pragma unroll
            for (int m = 0; m < 4; ++m) { bf16_t* rowp = base + (size_t)(ai * HALF + m * 16) * ldc; const float sc = rs[2 * (row0 + ai * HALF + m * 16)];
#pragma unroll
                for (int bj = 0; bj < 2; ++bj) { const f32x4 v0 = acc[ai][bj][m][0] * sc, v1 = acc[ai][bj][m][1] * sc; u32x4 w;
                    w.x = cvt_pk_bf16(v0[0], v0[1]); w.y = cvt_pk_bf16(v0[2], v0[3]); w.z = cvt_pk_bf16(v1[0], v1[1]); w.w = cvt_pk_bf16(v1[2], v1[3]);
                    *(u32x4*)(rowp + bj * HALF) = w; } }
    }
};
struct EpiResid { static constexpr bool PERM = true, AFTER_DRAIN = false;
    const float* src_lat; const float* src_ctx; float* out; const float* mod_g1; float ascale;
    __device__ __forceinline__ void operator()(const f32x4 (&acc)[2][2][4][2], const Unit& u, int wr, int wc, int fr, int fq) const {
        const int row_t = u.pm * BM; const int mrow = row_t < NLAT ? row_t / SEQ : NB;
        const float* g = mod_g1 + (size_t)mrow * 6144 + u.pn * BM + wc * 32 + 8 * fq;
        const float* sb = (row_t < NLAT ? src_lat + (size_t)row_t * 1024 : src_ctx + (size_t)(row_t - NLAT) * 1024) + u.pn * BM + wc * 32 + 8 * fq;
        float* ob = out + (size_t)row_t * 1024 + u.pn * BM + wc * 32 + 8 * fq;
        f32x4 gv[2][2];
#pragma unroll
        for (int bj = 0; bj < 2; ++bj)
#pragma unroll
            for (int n = 0; n < 2; ++n) gv[bj][n] = *(const f32x4*)(g + bj * HALF + 4 * n) * ascale;
#pragma unroll
        for (int ai = 0; ai < 2; ++ai)
#pragma unroll
            for (int m = 0; m < 4; ++m) { const size_t off = (size_t)(wr * 64 + fr + ai * HALF + m * 16) * 1024;
#pragma unroll
                for (int bj = 0; bj < 2; ++bj)
#pragma unroll
                    for (int n = 0; n < 2; ++n) { const f32x4 sv = *(const f32x4*)(sb + off + bj * HALF + 4 * n); *(f32x4*)(ob + off + bj * HALF + 4 * n) = sv + gv[bj][n] * acc[ai][bj][m][n]; }
                asm volatile("" ::: "memory"); }
    }
};
__device__ __forceinline__ float swiglu1(float g, float l, float c7, float cn) {
    const float glu = fminf(g, c7), lin = fminf(fmaxf(l, -c7), c7);
    const float sg = __builtin_amdgcn_rcpf(1.0f + __builtin_amdgcn_exp2f(cn * glu));
    return glu * sg * (lin + 1.0f);
}
struct EpiSwiglu { static constexpr bool PERM = true, AFTER_DRAIN = false;
    bf16_t* O; const float* bias; float ascale;
    __device__ __forceinline__ void operator()(const f32x4 (&acc)[2][2][4][2], const Unit& u, int wr, int wc, int fr, int fq) const {
        const int col0 = u.pn * BM + wc * 32 + 8 * fq; const float* b = bias + (size_t)u.aux * 2048 + col0;
        float c7 = 7.0f, cn = -1.702f * 1.4426950408889634f; asm volatile("" : "+v"(c7), "+v"(cn));
        bf16_t* base = O + (size_t)(u.pm * BM + wr * 64 + fr) * 1024 + (col0 >> 1);
        f32x4 bv[2][2];
#pragma unroll
        for (int bj = 0; bj < 2; ++bj)
#pragma unroll
            for (int n = 0; n < 2; ++n) bv[bj][n] = *(const f32x4*)(b + bj * HALF + 4 * n);
#pragma unroll
        for (int ai = 0; ai < 2; ++ai)
#pragma unroll
            for (int m = 0; m < 4; ++m) { bf16_t* rowp = base + (size_t)(ai * HALF + m * 16) * 1024;
#pragma unroll
                for (int bj = 0; bj < 2; ++bj) { const f32x4 v0 = acc[ai][bj][m][0] * ascale + bv[bj][0], v1 = acc[ai][bj][m][1] * ascale + bv[bj][1];
                    uint2 w; w.x = cvt_pk_bf16(swiglu1(v0[0], v0[1], c7, cn), swiglu1(v0[2], v0[3], c7, cn)); w.y = cvt_pk_bf16(swiglu1(v1[0], v1[1], c7, cn), swiglu1(v1[2], v1[3], c7, cn));
                    *(uint2*)(rowp + bj * (HALF / 2)) = w; } }
    }
};
struct EpiSwigluF8 { static constexpr bool PERM = true, AFTER_DRAIN = false;
    unsigned char* O; const float* bias;
    __device__ __forceinline__ void operator()(const f32x4 (&acc)[2][2][4][2], const Unit& u, int wr, int wc, int fr, int fq) const {
        const int col0 = u.pn * BM + wc * 32 + 8 * fq; const float* b = bias + (size_t)u.aux * 2048 + col0;
        float c7 = 7.0f, cn = -1.702f * 1.4426950408889634f, c32 = 0.03125f; asm volatile("" : "+v"(c7), "+v"(cn), "+v"(c32));
        unsigned char* base = O + (size_t)(u.pm * BM + wr * 64 + fr) * 1024 + (col0 >> 1);
        f32x4 bv[2][2];
#pragma unroll
        for (int bj = 0; bj < 2; ++bj)
#pragma unroll
            for (int n = 0; n < 2; ++n) bv[bj][n] = *(const f32x4*)(b + bj * HALF + 4 * n);
#pragma unroll
        for (int ai = 0; ai < 2; ++ai)
#pragma unroll
            for (int m = 0; m < 4; ++m) { unsigned char* rowp = base + (size_t)(ai * HALF + m * 16) * 1024;
#pragma unroll
                for (int bj = 0; bj < 2; ++bj) { const f32x4 v0 = acc[ai][bj][m][0] * c32 + bv[bj][0], v1 = acc[ai][bj][m][1] * c32 + bv[bj][1];
                    int w = __builtin_amdgcn_cvt_pk_fp8_f32(swiglu1(v0[0], v0[1], c7, cn), swiglu1(v0[2], v0[3], c7, cn), 0, false); w = __builtin_amdgcn_cvt_pk_fp8_f32(swiglu1(v1[0], v1[1], c7, cn), swiglu1(v1[2], v1[3], c7, cn), w, true);
                    *(int*)(rowp + bj * (HALF / 2)) = w; } }
    }
};
struct EpiBiasF8 { static constexpr bool PERM = true, AFTER_DRAIN = false;
    unsigned char* O; const float* bias; float ascale;
    __device__ __forceinline__ void operator()(const f32x4 (&acc)[2][2][4][2], const Unit& u, int wr, int wc, int fr, int fq) const {
        const int col0 = u.pn * BM + wc * 32 + 8 * fq; const float* b = bias + (size_t)u.aux * 1024 + col0;
        float asc = ascale; asm volatile("" : "+v"(asc));
        unsigned char* base = O + (size_t)(u.pm * BM + wr * 64 + fr) * 1024 + col0;
        f32x4 bv[2][2];
#pragma unroll
        for (int bj = 0; bj < 2; ++bj)
#pragma unroll
            for (int n = 0; n < 2; ++n) bv[bj][n] = *(const f32x4*)(b + bj * HALF + 4 * n);
#pragma unroll
        for (int ai = 0; ai < 2; ++ai)
#pragma unroll
            for (int m = 0; m < 4; ++m) { unsigned char* rowp = base + (size_t)(ai * HALF + m * 16) * 1024;
#pragma unroll
                for (int bj = 0; bj < 2; ++bj) { const f32x4 v0 = acc[ai][bj][m][0] * asc + bv[bj][0], v1 = acc[ai][bj][m][1] * asc + bv[bj][1];
                    int lo = __builtin_amdgcn_cvt_pk_fp8_f32(v0[0], v0[1], 0, false); lo = __builtin_amdgcn_cvt_pk_fp8_f32(v0[2], v0[3], lo, true);
                    int hi = __builtin_amdgcn_cvt_pk_fp8_f32(v1[0], v1[1], 0, false); hi = __builtin_amdgcn_cvt_pk_fp8_f32(v1[2], v1[3], hi, true);
                    *(int2*)(rowp + bj * HALF) = make_int2(lo, hi); } }
    }
};
struct EpiBiasBf16 { static constexpr bool PERM = true, AFTER_DRAIN = false;
    bf16_t* O; const float* bias; float ascale;
    __device__ __forceinline__ void operator()(const f32x4 (&acc)[2][2][4][2], const Unit& u, int wr, int wc, int fr, int fq) const {
        const int col0 = u.pn * BM + wc * 32 + 8 * fq; const float* b = bias + (size_t)u.aux * 1024 + col0;
        float asc = ascale; asm volatile("" : "+v"(asc));
        bf16_t* base = O + (size_t)(u.pm * BM + wr * 64 + fr) * 1024 + col0;
        f32x4 bv[2][2];
#pragma unroll
        for (int bj = 0; bj < 2; ++bj)
#pragma unroll
            for (int n = 0; n < 2; ++n) bv[bj][n] = *(const f32x4*)(b + bj * HALF + 4 * n);
#pragma unroll
        for (int ai = 0; ai < 2; ++ai)
#pragma unroll
            for (int m = 0; m < 4; ++m) { bf16_t* rowp = base + (size_t)(ai * HALF + m * 16) * 1024;
#pragma unroll
                for (int bj = 0; bj < 2; ++bj) { const f32x4 v0 = acc[ai][bj][m][0] * asc + bv[bj][0], v1 = acc[ai][bj][m][1] * asc + bv[bj][1]; u32x4 w;
                    w.x = cvt_pk_bf16(v0[0], v0[1]); w.y = cvt_pk_bf16(v0[2], v0[3]); w.z = cvt_pk_bf16(v1[0], v1[1]); w.w = cvt_pk_bf16(v1[2], v1[3]);
                    *(u32x4*)(rowp + bj * HALF) = w; } }
    }
};
}
__device__ __forceinline__ unsigned pk2(float lo, float hi) { return (unsigned)f2bf(lo) | ((unsigned)f2bf(hi) << 16); }
__device__ __forceinline__ void transpose_item(const float* __restrict__ W, int K, int N, bf16_t* __restrict__ WT, LAS float* scr, int item, int lane, const float* rowscale = nullptr, float cscale = 1.0f, int cs_ncols = 1 << 30) {
    const int nblk = N / 32, kb = item / nblk, nb = item % nblk, k0 = 64 * kb, n0 = 32 * nb;
    const float cs = n0 < cs_ncols ? cscale : 1.0f;
#pragma unroll 8
    for (int i = 0; i < 32; ++i) { const int kk = 2 * i + (lane >> 5); float w = W[(size_t)(k0 + kk) * N + n0 + (lane & 31)]; if (rowscale) w *= rowscale[k0 + kk]; scr[kk * 33 + (lane & 31)] = w * cs; }
    asm volatile("s_waitcnt lgkmcnt(0)" ::: "memory");
    const int c = lane & 7;
#pragma unroll
    for (int j = 0; j < 4; ++j) { const int n = (lane >> 3) + 8 * j; const LAS float* sp = scr + (8 * c) * 33 + n;
        uint4 o; o.x = pk2(sp[0 * 33], sp[1 * 33]); o.y = pk2(sp[2 * 33], sp[3 * 33]); o.z = pk2(sp[4 * 33], sp[5 * 33]); o.w = pk2(sp[6 * 33], sp[7 * 33]);
        *(uint4*)(WT + (size_t)(n0 + n) * K + k0 + 8 * c) = o; }
    asm volatile("s_waitcnt lgkmcnt(0)" ::: "memory");
}

__device__ __forceinline__ void transpose_item_f8(const float* __restrict__ W, int K, int N, unsigned char* __restrict__ WT, LAS float* scr, int item, int lane, float cscale = 1.0f, int cs_ncols = 1 << 30) {
    const int nblk = N / 32, kb = item / nblk, nb = item % nblk, k0 = 64 * kb, n0 = 32 * nb;
    const float cs = 32.0f * (n0 < cs_ncols ? cscale : 1.0f);
#pragma unroll 8
    for (int i = 0; i < 32; ++i) { const int kk = 2 * i + (lane >> 5); scr[kk * 33 + (lane & 31)] = W[(size_t)(k0 + kk) * N + n0 + (lane & 31)] * cs; }
    asm volatile("s_waitcnt lgkmcnt(0)" ::: "memory");
    const int c = lane & 7;
#pragma unroll
    for (int j = 0; j < 4; ++j) { const int n = (lane >> 3) + 8 * j; const LAS float* sp = scr + (8 * c) * 33 + n;
        int lo = __builtin_amdgcn_cvt_pk_fp8_f32(sp[0 * 33], sp[1 * 33], 0, false); lo = __builtin_amdgcn_cvt_pk_fp8_f32(sp[2 * 33], sp[3 * 33], lo, true);
        int hi = __builtin_amdgcn_cvt_pk_fp8_f32(sp[4 * 33], sp[5 * 33], 0, false); hi = __builtin_amdgcn_cvt_pk_fp8_f32(sp[6 * 33], sp[7 * 33], hi, true);
        *(int2*)(WT + (size_t)(n0 + n) * K + k0 + 8 * c) = make_int2(lo, hi); }
    asm volatile("s_waitcnt lgkmcnt(0)" ::: "memory");
}
template <bool F8OUT>
__device__ __forceinline__ void transpose_item64(const float* __restrict__ W, int K, int N, void* __restrict__ WT, LAS float* scr, int item, int lane, const float* rowscale = nullptr, float cscale = 1.0f) {
    const int nblk = N / 64, kb = item / nblk, nb = item % nblk, k0 = 64 * kb, n0 = 64 * nb;
    const float cs = cscale * (F8OUT ? 32.0f : 1.0f);
    float4 wv[16];
#pragma unroll
    for (int i = 0; i < 16; ++i) wv[i] = *(const float4*)(W + (size_t)(k0 + 4 * i + (lane >> 4)) * N + n0 + 4 * (lane & 15));
#pragma unroll
    for (int i = 0; i < 16; ++i) { const int kk = 4 * i + (lane >> 4); const float4 w = wv[i];
        const float rs = rowscale ? rowscale[k0 + kk] * cs : cs; LAS float* d = scr + kk * 65 + 4 * (lane & 15); d[0] = w.x * rs; d[1] = w.y * rs; d[2] = w.z * rs; d[3] = w.w * rs; }
    asm volatile("s_waitcnt lgkmcnt(0)" ::: "memory");
    const int c = lane & 7;
#pragma unroll
    for (int j = 0; j < 8; ++j) { const int n = (lane >> 3) + 8 * j; const LAS float* sp = scr + (8 * c) * 65 + n;
        if constexpr (F8OUT) { int lo = __builtin_amdgcn_cvt_pk_fp8_f32(sp[0 * 65], sp[1 * 65], 0, false); lo = __builtin_amdgcn_cvt_pk_fp8_f32(sp[2 * 65], sp[3 * 65], lo, true);
            int hi = __builtin_amdgcn_cvt_pk_fp8_f32(sp[4 * 65], sp[5 * 65], 0, false); hi = __builtin_amdgcn_cvt_pk_fp8_f32(sp[6 * 65], sp[7 * 65], hi, true);
            *(int2*)((unsigned char*)WT + (size_t)(n0 + n) * K + k0 + 8 * c) = make_int2(lo, hi); }
        else { uint4 o; o.x = pk2(sp[0 * 65], sp[1 * 65]); o.y = pk2(sp[2 * 65], sp[3 * 65]); o.z = pk2(sp[4 * 65], sp[5 * 65]); o.w = pk2(sp[6 * 65], sp[7 * 65]);
            *(uint4*)((bf16_t*)WT + (size_t)(n0 + n) * K + k0 + 8 * c) = o; } }
    asm volatile("s_waitcnt lgkmcnt(0)" ::: "memory");
}
namespace fa {
using bf16x8 = __attribute__((ext_vector_type(8))) short;
using s16x4  = __attribute__((ext_vector_type(4))) short;
using f32x16 = __attribute__((ext_vector_type(16))) float;
using u32x4  = __attribute__((ext_vector_type(4))) unsigned;
constexpr int QBLK = 32, KVBLK = 64, NW = 8;
constexpr int SHM_V = KVBLK * 128 * 2, SHM_K = KVBLK * 128 * 2, SHM_ATTN = 2 * SHM_V + 2 * SHM_K + NW * 64 * 4;
constexpr float LOG2E = 1.4426950408889634f, THR = 8.0f, NEGS = -1.0e30f;
#define FA_KSWZ(row, colB) ((row) * 256 + ((colB) ^ (((row) & 7) << 4)))
#define FA_SBAR() __builtin_amdgcn_sched_barrier(0)
__device__ __forceinline__ int crow(int r, int hi) { return (r & 3) + 8 * (r >> 2) + 4 * hi; }
__device__ __forceinline__ unsigned cvtpk(float lo, float hi) { unsigned r; asm volatile("v_cvt_pk_bf16_f32 %0, %1, %2" : "=v"(r) : "v"(lo), "v"(hi)); return r; }
__device__ __forceinline__ void partialSM(f32x16& p0, f32x16& p1, float& m_reg, float& mn, float& alpha) {
  float pmax = p0[0];
#pragma unroll
  for (int r = 1; r < 16; ++r) pmax = fmaxf(pmax, p0[r]);
#pragma unroll
  for (int r = 0; r < 16; ++r) pmax = fmaxf(pmax, p1[r]);
  { auto rr = __builtin_amdgcn_permlane32_swap(__float_as_uint(pmax), __float_as_uint(pmax), false, false);
    pmax = fmaxf(__uint_as_float(rr[0]), __uint_as_float(rr[1])); }
  if (__builtin_expect(__all(pmax - m_reg <= THR), 1)) { mn = m_reg; alpha = 1.f; }
  else { mn = fmaxf(m_reg, pmax); alpha = __builtin_amdgcn_exp2f((m_reg - mn) * LOG2E); m_reg = mn; }
  const float mnC = -mn * LOG2E;
#pragma unroll
  for (int r = 0; r < 16; ++r) p0[r] = fmaf(p0[r], LOG2E, mnC);
#pragma unroll
  for (int r = 0; r < 16; ++r) p1[r] = fmaf(p1[r], LOG2E, mnC);
#pragma unroll
  for (int r = 0; r < 16; ++r) p0[r] = __builtin_amdgcn_exp2f(p0[r]);
}
__device__ __forceinline__ void finishSM(f32x16& p0, f32x16& p1, float alpha, float& l_reg, bf16x8& pa0, bf16x8& pa1, bf16x8& pa2, bf16x8& pa3) {
#pragma unroll
  for (int r = 0; r < 16; ++r) p1[r] = __builtin_amdgcn_exp2f(p1[r]);
  float ps = 0;
#pragma unroll
  for (int r = 0; r < 16; ++r) ps += p0[r];
#pragma unroll
  for (int r = 0; r < 16; ++r) ps += p1[r];
  { auto rr = __builtin_amdgcn_permlane32_swap(__float_as_uint(ps), __float_as_uint(ps), false, false);
    ps = __uint_as_float(rr[0]) + __uint_as_float(rr[1]); }
  l_reg = l_reg * alpha + ps;
#define FA_PK4(P, BASE, OUT) do { unsigned a0 = cvtpk(P[BASE + 0], P[BASE + 1]), a1 = cvtpk(P[BASE + 2], P[BASE + 3]);   \
    unsigned b0 = cvtpk(P[BASE + 4], P[BASE + 5]), b1 = cvtpk(P[BASE + 6], P[BASE + 7]);                              \
    auto r0 = __builtin_amdgcn_permlane32_swap(a0, b0, false, false); auto r1 = __builtin_amdgcn_permlane32_swap(a1, b1, false, false); \
    u32x4 w = {r0[0], r1[0], r0[1], r1[1]}; OUT = *reinterpret_cast<bf16x8*>(&w); } while (0)
  FA_PK4(p0, 0, pa0); FA_PK4(p0, 8, pa1); FA_PK4(p1, 0, pa2); FA_PK4(p1, 8, pa3);
#undef FA_PK4
}
template <int NQ> __device__ __forceinline__ void qkt(f32x16& p0, f32x16& p1, const char* Ks, const bf16x8* qr, int r32, int hi) {
  p0 = f32x16{}; p1 = f32x16{};
#pragma unroll
  for (int d0 = 0; d0 < NQ; ++d0) { const int cb = (d0 * 16 + hi * 8) * 2;
    const bf16x8 b0 = *reinterpret_cast<const bf16x8*>(Ks + FA_KSWZ(r32, cb));
    const bf16x8 b1 = *reinterpret_cast<const bf16x8*>(Ks + FA_KSWZ(32 + r32, cb));
    p0 = __builtin_amdgcn_mfma_f32_32x32x16_bf16(b0, qr[d0], p0, 0, 0, 0);
    p1 = __builtin_amdgcn_mfma_f32_32x32x16_bf16(b1, qr[d0], p1, 0, 0, 0); }
}
__device__ __forceinline__ int v_st(int k, int c) { const int kk = (k & ~0xC) | ((k & 4) << 1) | ((k & 8) >> 1); return ((kk >> 3) * 4 + (c >> 5)) * 512 + ((kk & 7) * 32 + (c & 31)) * 2; }
__device__ __forceinline__ int v_rd_base(int lane) { return ((lane & 3) << 3) | (((lane >> 2) & 3) << 6) | (((lane >> 4) & 1) << 5) | (((lane >> 5) & 1) << 8); }
constexpr int v_rd_off(int d0, int ks, int half) { return d0 * 512 + ks * 4096 + half * 2048; }
template <int OFF> __device__ __forceinline__ s16x4 tr_read(int vb) {
  s16x4 r; asm volatile("ds_read_b64_tr_b16 %0, %1 offset:%2" : "=&v"(r) : "v"(vb), "i"(OFF) : "memory"); return r;
}
template <int D0> __device__ __forceinline__ void pv_one(f32x16& od, int vb, bf16x8 pa0, bf16x8 pa1, bf16x8 pa2, bf16x8 pa3) {
  const s16x4 l0 = tr_read<v_rd_off(D0, 0, 0)>(vb), h0 = tr_read<v_rd_off(D0, 0, 1)>(vb), l1 = tr_read<v_rd_off(D0, 1, 0)>(vb), h1 = tr_read<v_rd_off(D0, 1, 1)>(vb);
  const s16x4 l2 = tr_read<v_rd_off(D0, 2, 0)>(vb), h2 = tr_read<v_rd_off(D0, 2, 1)>(vb), l3 = tr_read<v_rd_off(D0, 3, 0)>(vb), h3 = tr_read<v_rd_off(D0, 3, 1)>(vb);
  asm volatile("s_waitcnt lgkmcnt(0)" ::: "memory"); FA_SBAR();
#define FA_PK(L, H) (bf16x8){L[0], L[1], L[2], L[3], H[0], H[1], H[2], H[3]}
  od = __builtin_amdgcn_mfma_f32_32x32x16_bf16(pa0, FA_PK(l0, h0), od, 0, 0, 0);
  od = __builtin_amdgcn_mfma_f32_32x32x16_bf16(pa1, FA_PK(l1, h1), od, 0, 0, 0);
  od = __builtin_amdgcn_mfma_f32_32x32x16_bf16(pa2, FA_PK(l2, h2), od, 0, 0, 0);
  od = __builtin_amdgcn_mfma_f32_32x32x16_bf16(pa3, FA_PK(l3, h3), od, 0, 0, 0);
#undef FA_PK
}
template <int NV> __device__ __forceinline__ void pv_all(f32x16* o, int vb, bf16x8 pa0, bf16x8 pa1, bf16x8 pa2, bf16x8 pa3) {
  pv_one<0>(o[0], vb, pa0, pa1, pa2, pa3); pv_one<1>(o[1], vb, pa0, pa1, pa2, pa3);
  if constexpr (NV == 4) { pv_one<2>(o[2], vb, pa0, pa1, pa2, pa3); pv_one<3>(o[3], vb, pa0, pa1, pa2, pa3); }
}
__device__ __forceinline__ void wmask(f32x16& p0, f32x16& p1, int dq4) {
#pragma unroll
  for (int r = 0; r < 16; ++r) { const int d = dq4 + (r & 3) + 8 * (r >> 2); if ((unsigned)(d + 128) > 256u) p0[r] = NEGS; if ((unsigned)(d + 32 + 128) > 256u) p1[r] = NEGS; }
}

struct Unit {
  const bf16_t* Q; const bf16_t* K; const bf16_t* V; bf16_t* O;
  int rowa, nta, rowb, ntb;
  int window, qpos0, kposb0;
  float sink; int has_sink;
  const bf16_t* K2;
  const float* tab; int pos0;
  const float* qg;
};
template <int DQ, int DV, int LDQ, int LDK, int LDV, int LDO, bool WIN, int RD0, int RH, bool QNORM, bool KSPLIT, bool O8>
__device__ __forceinline__ void attn_unit(const int tid, const Unit& U, char* lds) {
  constexpr int NQ = DQ / 16, NV = DV / 32;
  const int wid = tid >> 6, lane = tid & 63, r32 = lane & 31, hi = lane >> 5;
  char* V_lds = lds; char* K_lds = lds + 2 * SHM_V;
  float* ws = (float*)(lds + 2 * SHM_V + 2 * SHM_K) + wid * 64; float* li_l = ws; float* al_l = ws + 32;
  float m_reg = -1e30f, l_reg = 0; f32x16 o[NV]; bf16x8 qr[NQ];
#pragma unroll
  for (int d = 0; d < NV; ++d) o[d] = f32x16{};
  const bf16_t* Qw = U.Q + (size_t)(wid * QBLK + r32) * LDQ + hi * 8;
#pragma unroll
  for (int d0 = 0; d0 < NQ; ++d0) qr[d0] = *reinterpret_cast<const bf16x8*>(Qw + d0 * 16);
  if constexpr (QNORM || RH > 0) {
    float qf[NQ][8];
#pragma unroll
    for (int d0 = 0; d0 < NQ; ++d0)
#pragma unroll
      for (int j = 0; j < 8; ++j) qf[d0][j] = __uint_as_float(((unsigned)(unsigned short)qr[d0][j]) << 16);
    if constexpr (QNORM) {
      float ss = 0.f;
#pragma unroll
      for (int d0 = 0; d0 < NQ; ++d0)
#pragma unroll
        for (int j = 0; j < 8; ++j) ss = fmaf(qf[d0][j], qf[d0][j], ss);
      { auto rr = __builtin_amdgcn_permlane32_swap(__float_as_uint(ss), __float_as_uint(ss), false, false); ss = __uint_as_float(rr[0]) + __uint_as_float(rr[1]); }
      const float ri = 1.0f / sqrtf(ss * (1.0f / DQ) + 1e-6f);
#pragma unroll
      for (int d0 = 0; d0 < NQ; ++d0) { const float4 g0 = *(const float4*)(U.qg + 16 * d0 + 8 * hi), g1 = *(const float4*)(U.qg + 16 * d0 + 8 * hi + 4);
        qf[d0][0] *= ri * g0.x; qf[d0][1] *= ri * g0.y; qf[d0][2] *= ri * g0.z; qf[d0][3] *= ri * g0.w; qf[d0][4] *= ri * g1.x; qf[d0][5] *= ri * g1.y; qf[d0][6] *= ri * g1.z; qf[d0][7] *= ri * g1.w; }
    }
    if constexpr (RH > 0) { if (U.tab) {
      const float4* tb = (const float4*)(U.tab + ((size_t)(U.pos0 + wid * QBLK + r32) * (RH * 16) + 8 * hi) * 2);
#pragma unroll
      for (int dd = 0; dd < RH; ++dd) {
#pragma unroll
        for (int j2 = 0; j2 < 4; ++j2) { const float4 t = tb[dd * 8 + j2];
          { const float x1 = qf[RD0 + dd][2 * j2], x2 = qf[RD0 + RH + dd][2 * j2]; qf[RD0 + dd][2 * j2] = x1 * t.x - x2 * t.y; qf[RD0 + RH + dd][2 * j2] = x2 * t.x + x1 * t.y; }
          { const float x1 = qf[RD0 + dd][2 * j2 + 1], x2 = qf[RD0 + RH + dd][2 * j2 + 1]; qf[RD0 + dd][2 * j2 + 1] = x1 * t.z - x2 * t.w; qf[RD0 + RH + dd][2 * j2 + 1] = x2 * t.z + x1 * t.w; } } } } }
#pragma unroll
    for (int d0 = 0; d0 < NQ; ++d0) { u32x4 w = {cvtpk(qf[d0][0], qf[d0][1]), cvtpk(qf[d0][2], qf[d0][3]), cvtpk(qf[d0][4], qf[d0][5]), cvtpk(qf[d0][6], qf[d0][7])}; qr[d0] = *reinterpret_cast<bf16x8*>(&w); }
  }
  const int sr = tid >> 4, sc = (tid & 15) * 8, vst0 = v_st(sr, sc), vst1 = v_st(32 + sr, sc);
  const int sck = sc < DQ - 8 ? sc : DQ - 8, scv = sc < DV - 8 ? sc : DV - 8;
  const int vb0 = (int)(uintptr_t)V_lds + v_rd_base(lane);
  const int nta = U.nta, NT = U.nta + U.ntb;
  const unsigned kof0 = (unsigned)((sr * LDK + sck) * 2), kof1 = kof0 + 32u * LDK * 2u, vof0 = (unsigned)((sr * LDV + scv) * 2), vof1 = vof0 + 32u * LDV * 2u;
  constexpr int LDK2 = 1536;
  const int ci = tid & 15; const bool ksec = KSPLIT && ci >= 8; const int kld = ksec ? LDK2 : LDK;
  const bf16_t* kp0 = ksec ? U.K2 + (size_t)sr * LDK2 + ((ci < 11 ? ci : 11) - 8) * 8 : U.K + (size_t)sr * LDK + ci * 8; const bf16_t* kp1 = kp0 + (size_t)32 * kld;
  (void)kof0; (void)kof1; (void)kp0; (void)kp1; (void)kld;
  struct { bf16x8 vs0, vs1, ks0, ks1; } sr_[2];
#define FA_KROW(j) ((j) < nta ? U.rowa + (j) * KVBLK : U.rowb + ((j) - nta) * KVBLK)
#define FA_SLOAD(i, j) do { const size_t k0_ = (size_t)(FA_KROW(j)); const char* kt_ = (const char*)U.K + k0_ * (LDK * 2); const char* vt_ = (const char*)U.V + k0_ * (LDV * 2); \
    sr_[i].vs0 = *reinterpret_cast<const bf16x8*>(vt_ + vof0); sr_[i].vs1 = *reinterpret_cast<const bf16x8*>(vt_ + vof1); \
    if constexpr (KSPLIT) { sr_[i].ks0 = *reinterpret_cast<const bf16x8*>(kp0 + k0_ * kld); sr_[i].ks1 = *reinterpret_cast<const bf16x8*>(kp1 + k0_ * kld); } \
    else { sr_[i].ks0 = *reinterpret_cast<const bf16x8*>(kt_ + kof0); sr_[i].ks1 = *reinterpret_cast<const bf16x8*>(kt_ + kof1); } } while (0)
#define FA_SWRITE(b, i) do { *(bf16x8*)(V_lds + (b) * SHM_V + vst0) = sr_[i].vs0; *(bf16x8*)(V_lds + (b) * SHM_V + vst1) = sr_[i].vs1; const int kc = sc * 2; \
    *(bf16x8*)(K_lds + (b) * SHM_K + FA_KSWZ(sr, kc)) = sr_[i].ks0; *(bf16x8*)(K_lds + (b) * SHM_K + FA_KSWZ(32 + sr, kc)) = sr_[i].ks1; } while (0)
#define FA_SWAIT() asm volatile("s_waitcnt vmcnt(4)" ::: "memory")
#define FA_RESC(a) do { if (__any((a) < 1.f)) { if (hi == 0) al_l[r32] = (a); asm volatile("s_waitcnt lgkmcnt(0)" ::: "memory"); \
    _Pragma("unroll") for (int d = 0; d < NV; ++d) _Pragma("unroll") for (int r = 0; r < 16; ++r) o[d][r] *= al_l[crow(r, hi)]; } } while (0)
  const int qw0 = U.qpos0 + wid * QBLK;
#define FA_MASK(P0, P1, t) do { if (WIN && U.window && (t) >= nta) { const int kb_ = U.kposb0 + ((t) - nta) * KVBLK; \
    if (kb_ + 63 - qw0 > 128 || qw0 + 31 - kb_ > 128) wmask(P0, P1, kb_ - (qw0 + r32) + 4 * hi); } } while (0)
  f32x16 pA0, pA1, pB0, pB1; float mnA, mnB, alA, alB; bf16x8 pa0, pa1, pa2, pa3;
  constexpr int SE = 0, SO = 1;
  FA_SLOAD(SE, 0); asm volatile("s_waitcnt vmcnt(0)" ::: "memory"); FA_SWRITE(0, SE); __syncthreads();
  qkt<NQ>(pA0, pA1, K_lds, qr, r32, hi); FA_MASK(pA0, pA1, 0); partialSM(pA0, pA1, m_reg, mnA, alA);
  FA_SLOAD(SO, 1); if (2 < NT) FA_SLOAD(SE, 2);
  FA_SWAIT(); FA_SWRITE(1, SO); __syncthreads();
  for (int j = 1; j + 1 < NT; j += 2) {
    FA_SBAR(); qkt<NQ>(pB0, pB1, K_lds + SHM_K, qr, r32, hi);
    finishSM(pA0, pA1, alA, l_reg, pa0, pa1, pa2, pa3); FA_SBAR();
    FA_SLOAD(SO, j + 2); FA_SBAR();
    pv_all<NV>(o, vb0, pa0, pa1, pa2, pa3); FA_MASK(pB0, pB1, j); partialSM(pB0, pB1, m_reg, mnB, alB);
    __syncthreads(); FA_SWAIT(); FA_SWRITE(0, SE);
    FA_RESC(alB); __syncthreads();
    FA_SBAR(); qkt<NQ>(pA0, pA1, K_lds, qr, r32, hi);
    finishSM(pB0, pB1, alB, l_reg, pa0, pa1, pa2, pa3); FA_SBAR();
    if (j + 3 < NT) FA_SLOAD(SE, j + 3); FA_SBAR();
    pv_all<NV>(o, vb0 + SHM_V, pa0, pa1, pa2, pa3); FA_MASK(pA0, pA1, j + 1); partialSM(pA0, pA1, m_reg, mnA, alA);
    __syncthreads(); FA_SWAIT(); FA_SWRITE(1, SO);
    FA_RESC(alA); __syncthreads();
  }
  FA_SBAR(); qkt<NQ>(pB0, pB1, K_lds + SHM_K, qr, r32, hi);
  finishSM(pA0, pA1, alA, l_reg, pa0, pa1, pa2, pa3); FA_SBAR();
  pv_all<NV>(o, vb0, pa0, pa1, pa2, pa3); FA_MASK(pB0, pB1, NT - 1); partialSM(pB0, pB1, m_reg, mnB, alB);
  __syncthreads(); FA_RESC(alB);
  finishSM(pB0, pB1, alB, l_reg, pa0, pa1, pa2, pa3); FA_SBAR();
  pv_all<NV>(o, vb0 + SHM_V, pa0, pa1, pa2, pa3);
  if (U.has_sink) l_reg += __builtin_amdgcn_exp2f((U.sink - m_reg) * LOG2E);
  if (hi == 0) li_l[r32] = l_reg;
  asm volatile("s_waitcnt lgkmcnt(0)" ::: "memory");
  __syncthreads();
  int lane2 = lane; asm volatile("" : "+v"(lane2));
  const int r32e = lane2 & 31, hie = lane2 >> 5;
  if constexpr (O8) {
    unsigned char* stg = (unsigned char*)(lds + wid * 8192);
    unsigned char* stw = stg + hie * 4 * DV + r32e;
#pragma unroll
    for (int r = 0; r < 16; ++r) { const int orow0 = (r & 3) + 8 * (r >> 2); const float rl = __builtin_amdgcn_rcpf(li_l[orow0 + 4 * hie]);
#pragma unroll
      for (int d0 = 0; d0 < NV; ++d0) stw[orow0 * DV + d0 * 32] = (unsigned char)(__builtin_amdgcn_cvt_pk_fp8_f32(o[d0][r] * rl, 0.f, 0, false) & 0xff); }
    asm volatile("s_waitcnt lgkmcnt(0)" ::: "memory");
    constexpr int CPR = DV / 16, RPI = 64 / CPR;
    const int erow = lane2 / CPR, ech = lane2 % CPR;
    unsigned char* Ow = (unsigned char*)U.O + (size_t)(wid * QBLK + erow) * LDO + ech * 16; const unsigned char* str = stg + erow * DV + ech * 16;
#pragma unroll
    for (int i = 0; i < 32 / RPI; ++i) { const u32x4 v = *(const u32x4*)(str + i * RPI * DV); *(u32x4*)(Ow + (size_t)(i * RPI) * LDO) = v; }
  } else {
  bf16_t* stg = (bf16_t*)(lds + wid * 8192);
  bf16_t* stw = stg + hie * 4 * DV + r32e;
#pragma unroll
  for (int r = 0; r < 16; ++r) { const int orow0 = (r & 3) + 8 * (r >> 2); const float rl = __builtin_amdgcn_rcpf(li_l[orow0 + 4 * hie]);
#pragma unroll
    for (int d0 = 0; d0 < NV; ++d0) stw[orow0 * DV + d0 * 32] = f2bf(o[d0][r] * rl); }
  asm volatile("s_waitcnt lgkmcnt(0)" ::: "memory");
  constexpr int CPR = DV / 8, RPI = 64 / CPR;
  const int erow = lane2 / CPR, ech = lane2 % CPR;
  bf16_t* Ow = U.O + (size_t)(wid * QBLK + erow) * LDO + ech * 8; const bf16_t* str = stg + erow * DV + ech * 8;
#pragma unroll
  for (int i = 0; i < 32 / RPI; ++i) { const u32x4 v = *(const u32x4*)(str + i * RPI * DV); *(u32x4*)(Ow + (size_t)(i * RPI) * LDO) = v; }
  }
  __syncthreads();
#undef FA_KROW
#undef FA_SLOAD
#undef FA_SWRITE
#undef FA_SWAIT
#undef FA_RESC
#undef FA_MASK
}
}

__device__ __forceinline__ void route_reduce(const float (&acc)[32], const int lane, const int el, const float rb, float (&tv)[4], int (&ti)[4]) {
    float a16[16], a8[8], a4[4], a2[2];
#pragma unroll
    for (int k = 0; k < 16; ++k) { const bool up = (lane & 32) != 0; const float keep = up ? acc[k + 16] : acc[k], send = up ? acc[k] : acc[k + 16]; a16[k] = keep + __shfl_xor(send, 32); }
#pragma unroll
    for (int k = 0; k < 8; ++k) { const bool up = (lane & 16) != 0; const float keep = up ? a16[k + 8] : a16[k], send = up ? a16[k] : a16[k + 8]; a8[k] = keep + __shfl_xor(send, 16); }
#pragma unroll
    for (int k = 0; k < 4; ++k) { const bool up = (lane & 8) != 0; const float keep = up ? a8[k + 4] : a8[k], send = up ? a8[k] : a8[k + 4]; a4[k] = keep + __shfl_xor(send, 8); }
#pragma unroll
    for (int k = 0; k < 2; ++k) { const bool up = (lane & 4) != 0; const float keep = up ? a4[k + 2] : a4[k], send = up ? a4[k] : a4[k + 2]; a2[k] = keep + __shfl_xor(send, 4); }
    float lg; { const bool up = (lane & 2) != 0; const float keep = up ? a2[1] : a2[0], send = up ? a2[0] : a2[1]; lg = keep + __shfl_xor(send, 2); }
    lg += __shfl_xor(lg, 1); lg += rb;
    unsigned key; { const unsigned u = __float_as_uint(lg); const unsigned ou = (u & 0x80000000u) ? ~u : (u | 0x80000000u); key = (ou & ~31u) | (unsigned)(31 - el); }
#pragma unroll
    for (int k = 0; k < 4; ++k) { unsigned bk = key;
#pragma unroll
        for (int o = 1; o < 64; o <<= 1) { const unsigned ok = (unsigned)__shfl_xor((int)bk, o); bk = ok > bk ? ok : bk; }
        const int bi = 31 - (int)(bk & 31u); const unsigned ou = bk & ~31u; const unsigned ub = (ou & 0x80000000u) ? (ou ^ 0x80000000u) : ~ou;
        tv[k] = __uint_as_float(ub); ti[k] = bi; if (el == bi) key = 0u; }
}

template <int CTRL> __device__ __forceinline__ float dpp_f32(const float x) { return __builtin_bit_cast(float, __builtin_amdgcn_update_dpp(0, __builtin_bit_cast(int, x), CTRL, 0xf, 0xf, true)); }
template <int CTRL> __device__ __forceinline__ unsigned dpp_u32(const unsigned x) { return (unsigned)__builtin_amdgcn_update_dpp(0, (int)x, CTRL, 0xf, 0xf, true); }
template <int M> __device__ __forceinline__ float xlane_f32(const float x) {
    if constexpr (M == 1) return dpp_f32<0xB1>(x);
    else if constexpr (M == 2) return dpp_f32<0x4E>(x);
    else if constexpr (M == 4) return dpp_f32<0x1B>(dpp_f32<0x141>(x));
    else return dpp_f32<0x128>(x);
}
template <int M> __device__ __forceinline__ unsigned xlane_u32(const unsigned x) {
    if constexpr (M == 1) return dpp_u32<0xB1>(x);
    else if constexpr (M == 2) return dpp_u32<0x4E>(x);
    else if constexpr (M == 4) return dpp_u32<0x1B>(dpp_u32<0x141>(x));
    else return dpp_u32<0x128>(x);
}
typedef unsigned u32x2_t __attribute__((ext_vector_type(2)));
__device__ __forceinline__ float half_sum32(float v) {
    v += xlane_f32<1>(v); v += xlane_f32<2>(v); v += xlane_f32<4>(v); v += xlane_f32<8>(v);
    const u32x2_t r = __builtin_amdgcn_permlane16_swap(__float_as_uint(v), __float_as_uint(v), false, false);
    return __uint_as_float(r[0]) + __uint_as_float(r[1]);
}
__device__ __forceinline__ void route_reduce32(const float (&acc)[32], const int l5, const float rb, float (&tv)[4], int (&ti)[4]) {
    float a16[16], a8[8], a4[4], a2[2];
#pragma unroll
    for (int k = 0; k < 16; ++k) { const u32x2_t r = __builtin_amdgcn_permlane16_swap(__float_as_uint(acc[k]), __float_as_uint(acc[k + 16]), false, false); a16[k] = __uint_as_float(r[0]) + __uint_as_float(r[1]); }
#pragma unroll
    for (int k = 0; k < 8; ++k) { const bool up = (l5 & 8) != 0; const float keep = up ? a16[k + 8] : a16[k], send = up ? a16[k] : a16[k + 8]; a8[k] = keep + xlane_f32<8>(send); }
#pragma unroll
    for (int k = 0; k < 4; ++k) { const bool up = (l5 & 4) != 0; const float keep = up ? a8[k + 4] : a8[k], send = up ? a8[k] : a8[k + 4]; a4[k] = keep + xlane_f32<4>(send); }
#pragma unroll
    for (int k = 0; k < 2; ++k) { const bool up = (l5 & 2) != 0; const float keep = up ? a4[k + 2] : a4[k], send = up ? a4[k] : a4[k + 2]; a2[k] = keep + xlane_f32<2>(send); }
    float lg; { const bool up = (l5 & 1) != 0; const float keep = up ? a2[1] : a2[0], send = up ? a2[0] : a2[1]; lg = keep + xlane_f32<1>(send); }
    lg += rb;
    unsigned key; { const unsigned u = __float_as_uint(lg); const unsigned ou = (u & 0x80000000u) ? ~u : (u | 0x80000000u); key = (ou & ~31u) | (unsigned)(31 - l5); }
#pragma unroll
    for (int k = 0; k < 4; ++k) { unsigned bk = key;
        { const unsigned ok = xlane_u32<1>(bk); bk = ok > bk ? ok : bk; } { const unsigned ok = xlane_u32<2>(bk); bk = ok > bk ? ok : bk; }
        { const unsigned ok = xlane_u32<4>(bk); bk = ok > bk ? ok : bk; } { const unsigned ok = xlane_u32<8>(bk); bk = ok > bk ? ok : bk; }
        { const u32x2_t r = __builtin_amdgcn_permlane16_swap(bk, bk, false, false); bk = r[0] > r[1] ? r[0] : r[1]; }
        const int bi = 31 - (int)(bk & 31u); const unsigned ou = bk & ~31u; const unsigned ub = (ou & 0x80000000u) ? (ou ^ 0x80000000u) : ~ou;
        tv[k] = __uint_as_float(ub); ti[k] = bi; if (l5 == bi) key = 0u; }
}

struct Params {
    const float *x, *c, *ctx, *c_ctx, *ada_w, *ada_b, *norm_mix_g, *norm_ffn_g, *ab_w_in, *mla_q_g, *mla_wq_b, *mla_kv_g, *mla_wkv_b, *swa_sink, *ab_w_out,
        *c_w_in, *c_q_g, *c_k_g, *c_w_out, *router_w, *router_b, *moe_w_in, *moe_b_in, *moe_w_out, *moe_b_out, *final_g;
    float* out; unsigned char* ws; int ph_lo, ph_hi;
};
__device__ __forceinline__ int mod_row_of(int r) { return r < NLAT ? r / SEQ : NB; }
__device__ __forceinline__ float rope_angle(int i, int quarter, int prow, int pcol) {
    const int ii = i < quarter ? i : i - quarter; const float inv = powf(10000.f, -(float)ii / (float)quarter);
    return (float)(i < quarter ? prow : pcol) * inv;
}

#ifndef OUTPROJ_F8
#define OUTPROJ_F8 1
#endif
#ifndef Y8_L1
#define Y8_L1 1
#endif
#ifndef INPROJ_F8
#define INPROJ_F8 1
#endif
#ifndef MOE_F8_DOWN
#define MOE_F8_DOWN 1
#endif
#ifndef MOE_F8_L0
#define MOE_F8_L0 1
#endif
#ifndef MOE_F8_L1
#define MOE_F8_L1 1
#endif
constexpr int LDS_BYTES = 147456;
constexpr int LDS_MISC = 143360;
constexpr int N_PHASES = 21;

__global__ void __launch_bounds__(NTHR, 2) fwd_kernel(Params p) {
    extern __shared__ __attribute__((aligned(16))) unsigned char lds_raw[];
    float* ldsf = (float*)lds_raw;
    LAS unsigned* misc = (LAS unsigned*)(lds_raw + LDS_MISC + 320);
    const int wave0 = __builtin_amdgcn_readfirstlane((int)(threadIdx.x >> 6));
    const int G = gridDim.x, bid = blockIdx.x;
    const int NGW = G * 8;
    unsigned* ctl0 = (unsigned*)(p.ws + WS_CTL);
#define PHASE_PTRS \
    int tid = wave0 * 64 + (int)__builtin_amdgcn_mbcnt_hi(~0u, __builtin_amdgcn_mbcnt_lo(~0u, 0u)); asm volatile("" : "+v"(tid)); const int lane = tid & 63, wave = tid >> 6, gw = bid * 8 + wave; (void)lane; (void)gw; \
    size_t wsz_ = 0; asm volatile("" : "+s"(wsz_)); unsigned char* ws = p.ws + wsz_; \
    unsigned* ctl = (unsigned*)(ws + WS_CTL); (void)ctl; \
    float* MOD = (float*)(ws + WS_MOD); (void)MOD; \
    int* TOKE = (int*)(ws + WS_TOKE); int* TOKP = (int*)(ws + WS_TOKP); float* TOKG = (float*)(ws + WS_TOKG); (void)TOKE; (void)TOKP; (void)TOKG; \
    float* RINV = (float*)(ws + WS_RINV); (void)RINV; unsigned char* tabs = ws + WS_TAB; (void)tabs; \
    float* XR = (float*)(ws + WS_XR); (void)XR; \
    act_t* H = (act_t*)(ws + WS_H); (void)H; \
    unsigned char* big = ws + WS_BIG; \
    act_t* PRJ = (act_t*)(big + OFF_PRJ); act_t* QB = (act_t*)(big + OFF_QB); act_t* KVB = (act_t*)(big + OFF_KVB); act_t* OB = (act_t*)(big + OFF_O); (void)PRJ; (void)QB; (void)KVB; (void)OB; \
    act_t* Y = (act_t*)big; act_t* ACT = (act_t*)(ws + WS_ACT); act_t* XS = (act_t*)(ws + WS_XS); unsigned char* wts = ws + WS_W; (void)Y; (void)ACT; (void)XS; (void)wts;

    if (threadIdx.x < 32) misc[threadIdx.x] = 0u;
    __syncthreads();
    XcdBarrier bar = xcd_barrier_post(ctl0 + CW_BAR, (volatile LAS unsigned*)(misc + 8), wave0);
    const int lo = p.ph_lo, hi = p.ph_hi;
#ifndef PHASE_MASK
#define PHASE_MASK 0x1FFFFFu
#endif
#define IN(k) ((((PHASE_MASK) >> (k)) & 1u) && lo <= (k) && (k) < hi)
#define SEAM(k) do { if (IN(k) && IN((k) + 1)) xcd_barrier(bar, wave0); } while (0)
#define LDSB ((LAS unsigned char*)lds_raw)

    if (IN(0)) { PHASE_PTRS
        {   LAS float* scr = (LAS float*)(LDSB + wave * 16640);
            constexpr int I_AB = 16 * 45  , I_QB = 6 * 12, I_KVB = 4 * 16, I_ABO = 16 * 16, I_C = 16 * 24, I_CO = 16 * 16, I_W1 = 16 * 32, I_W2 = 16 * 16;
            constexpr int T_W1 = 64 * I_W1, T_W2 = 64 * I_W2, T_ALL = T_W1 + T_W2 + I_AB + I_QB + I_KVB + I_ABO + I_C + I_CO;
            for (int it = gw; it < T_ALL; it += NGW) {
                int r = it;
                if (r < T_W1) { const int mi = r / I_W1; const float* src = p.moe_w_in + (size_t)mi * 1024 * 2048;
                    if ((mi >= 32 && MOE_F8_L1) || (mi < 32 && MOE_F8_L0)) transpose_item64<true>(src, 1024, 2048, (unsigned char*)(wts + WO_W1) + (size_t)(mi >> 5) * 32 * 2048 * 1024 * 2 + (size_t)(mi & 31) * 2048 * 1024, scr, r % I_W1, lane);
                    else transpose_item64<false>(src, 1024, 2048, (bf16_t*)(wts + WO_W1) + (size_t)mi * 2048 * 1024, scr, r % I_W1, lane);
                    continue; } r -= T_W1;
                if (r < T_W2) { const int mi = r / I_W2; const float* src = p.moe_w_out + (size_t)mi * 1024 * 1024;
                    if (MOE_F8_DOWN && ((mi >= 32 && MOE_F8_L1) || (mi < 32 && MOE_F8_L0))) transpose_item64<true>(src, 1024, 1024, (unsigned char*)(wts + WO_W2) + (size_t)(mi >> 5) * 32 * 1024 * 1024 * 2 + (size_t)(mi & 31) * 1024 * 1024, scr, r % I_W2, lane);
                    else transpose_item64<false>(src, 1024, 1024, (bf16_t*)(wts + WO_W2) + (size_t)mi * 1024 * 1024, scr, r % I_W2, lane);
                    continue; } r -= T_W2;
                if (r < I_AB) { if (INPROJ_F8) transpose_item_f8(p.ab_w_in, 1024, AB_IN, (unsigned char*)(wts + WO_AB), scr, r, lane, 0.125f, 512);
                    else transpose_item(p.ab_w_in, 1024, AB_IN, (bf16_t*)(wts + WO_AB), scr, r, lane, nullptr, 0.125f, 512); continue; } r -= I_AB;
                if (r < I_QB) { transpose_item64<false>(p.mla_wq_b, 384, 768, (bf16_t*)(wts + WO_QB), scr, r, lane, p.mla_q_g, 0.10206207261596575f); continue; } r -= I_QB;
                if (r < I_KVB) { transpose_item64<false>(p.mla_wkv_b, 256, 1024, (bf16_t*)(wts + WO_KVB), scr, r, lane, p.mla_kv_g, 1.0f); continue; } r -= I_KVB;
                if (r < I_ABO) { if (OUTPROJ_F8) transpose_item64<true>(p.ab_w_out, 1024, 1024, (unsigned char*)(wts + WO_ABO), scr, r, lane); else transpose_item64<false>(p.ab_w_out, 1024, 1024, (bf16_t*)(wts + WO_ABO), scr, r, lane); continue; } r -= I_ABO;
                if (r < I_C) { if (INPROJ_F8) transpose_item64<true>(p.c_w_in, 1024, C_IN, (unsigned char*)(wts + WO_C), scr, r, lane); else transpose_item64<false>(p.c_w_in, 1024, C_IN, (bf16_t*)(wts + WO_C), scr, r, lane); continue; } r -= I_C;
                if (OUTPROJ_F8) transpose_item64<true>(p.c_w_out, 1024, 1024, (unsigned char*)(wts + WO_CO), scr, r, lane); else transpose_item64<false>(p.c_w_out, 1024, 1024, (bf16_t*)(wts + WO_CO), scr, r, lane);
            }
            uint4* z = (uint4*)((unsigned char*)(wts + WO_AB) + (size_t)AB_IN * 1024 * (INPROJ_F8 ? 1 : 2));
            for (int i = gw * 64 + lane; i < 96 * 1024 * (INPROJ_F8 ? 1 : 2) / 16; i += NGW * 64) z[i] = make_uint4(0u, 0u, 0u, 0u);
        }
        {
            float2* TA = (float2*)(tabs + TAB_A); float2* TB = (float2*)(tabs + TAB_B); float2* TC = (float2*)(tabs + TAB_C);
            for (int e = bid * NTHR + tid; e < SEQ * 112; e += G * NTHR) { const int s = e / 112, i = e % 112, prow = s / GRIDW, pcol = s % GRIDW;
                int quarter, ii; float2* dst;
                if (i < 32) { quarter = 16; ii = i; dst = TA + s * 32 + ii; } else if (i < 48) { quarter = 8; ii = i - 32; dst = TB + s * 16 + ii; } else { quarter = 32; ii = i - 48; dst = TC + s * 64 + ii; }
                const float ang = rope_angle(ii, quarter, prow, pcol); *dst = make_float2(cosf(ang), sinf(ang)); }
            if (bid == 0 && tid < 128) ((float*)(tabs + TAB_QG))[tid] = p.c_q_g[tid] * 0.08838834764831845f;
        }
        __syncthreads();
        float* ca = ldsf;
        float* red = ldsf + 17 * 1024;
        {   float cv[34];
#pragma unroll
            for (int j = 0; j < 34; ++j) cv[j] = j < 2 * NB ? p.c[j * NTHR + tid] : p.c_ctx[(j - 2 * NB) * NTHR + tid];
#pragma unroll
            for (int j = 0; j < 34; ++j) ca[j * NTHR + tid] = cv[j] / (1.f + expf(-cv[j])); }
        __syncthreads();
        for (int blk = bid; blk < 2 * 6144 / 64; blk += G) {
            typedef float f4m_ __attribute__((ext_vector_type(4)));
            const int l = blk / 96, ks = wave, kr = lane >> 4, c4 = (lane & 15) * 4;
            f4m_ acc[17];
#pragma unroll
            for (int b = 0; b < 17; ++b) acc[b] = (f4m_){0.f, 0.f, 0.f, 0.f};
            const float* wp = p.ada_w + (size_t)l * 1024 * 6144 + (blk % 96) * 64 + c4 + (size_t)(ks * 128 + kr) * 6144;
            const float* cap = ca + ks * 128 + kr;
#pragma unroll 1
            for (int g4 = 0; g4 < 8; ++g4) {
                f4m_ w[4];
#pragma unroll
                for (int j = 0; j < 4; ++j) w[j] = __builtin_nontemporal_load((const f4m_*)(wp + (size_t)((g4 * 4 + j) * 4) * 6144));
#pragma unroll
                for (int j = 0; j < 4; ++j) {
#pragma unroll
                    for (int b = 0; b < 17; ++b) acc[b] += cap[b * 1024 + (g4 * 4 + j) * 4] * w[j]; }
            }
#pragma unroll
            for (int b = 0; b < 17; ++b) {
#pragma unroll
                for (int c = 0; c < 4; ++c) { float v = acc[b][c]; v += __shfl_xor(v, 16); v += __shfl_xor(v, 32); acc[b][c] = v; } }
            if (lane < 16) {
#pragma unroll
                for (int b = 0; b < 17; ++b) *(f4m_*)(red + (ks * 17 + b) * 64 + c4) = acc[b]; }
            __syncthreads();
            for (int i = tid; i < 17 * 64; i += NTHR) { const int b = i >> 6, nl = i & 63; float s = 0.f;
#pragma unroll
                for (int k2 = 0; k2 < 8; ++k2) s += red[(k2 * 17 + b) * 64 + nl];
                const int nn = (blk % 96) * 64 + nl; float mv = s + p.ada_b[l * 6144 + nn];
                if (nn >= 4096 && nn < 5120) mv = p.norm_ffn_g[l * 1024 + nn - 4096] * (1.0f + mv);
                MOD[((size_t)l * 17 + b) * 6144 + nn] = mv; }
            __syncthreads();
        }
    }
    SEAM(0);

#define NORM_MOD16(v, g, mr_) do { float ss_ = 0.f; \
        _Pragma("unroll") for (int j = 0; j < 16; ++j) ss_ = fmaf(v[j], v[j], ss_); \
        ss_ = wave_sum(ss_); const float ri_ = 1.0f / sqrtf(ss_ * (1.0f / 1024.0f) + RMS_EPS); \
        float sh_[16], sc_[16]; ld16f((mr_), sh_); ld16f((mr_) + 1024, sc_); \
        _Pragma("unroll") for (int j = 0; j < 16; ++j) v[j] = (v[j] * ri_ * g[j]) * (1.0f + sc_[j]) + sh_[j]; } while (0)

#define NORM_MOD16x2(v, g, mr0_, mr1_) do { float s0_ = 0.f, s1_ = 0.f; \
        _Pragma("unroll") for (int j = 0; j < 16; ++j) { s0_ = fmaf(v[0][j], v[0][j], s0_); s1_ = fmaf(v[1][j], v[1][j], s1_); } \
        wave_sum2(s0_, s1_); const float ri0_ = 1.0f / sqrtf(s0_ * (1.0f / 1024.0f) + RMS_EPS), ri1_ = 1.0f / sqrtf(s1_ * (1.0f / 1024.0f) + RMS_EPS); \
        float sh_[16], sc_[16]; ld16f((mr0_), sh_); ld16f((mr0_) + 1024, sc_); \
        _Pragma("unroll") for (int j = 0; j < 16; ++j) v[0][j] = (v[0][j] * ri0_ * g[j]) * (1.0f + sc_[j]) + sh_[j]; \
        ld16f((mr1_), sh_); ld16f((mr1_) + 1024, sc_); \
        _Pragma("unroll") for (int j = 0; j < 16; ++j) v[1][j] = (v[1][j] * ri1_ * g[j]) * (1.0f + sc_[j]) + sh_[j]; } while (0)
#define ROWS2(nrows) _Pragma("unroll 1") for (int r0_ = gw; r0_ < (nrows); r0_ += 2 * NGW)
#define ROWS2_IDX(nrows) const bool two_ = (r0_ + NGW) < (nrows); const int rr_[2] = {r0_, two_ ? r0_ + NGW : r0_};

    if (IN(1)) { PHASE_PTRS
        float g[16]; ld16f(p.norm_mix_g + 16 * lane, g);
        ROWS2(NROW) { ROWS2_IDX(NROW)
            float v[2][16]; const float* mr[2];
#pragma unroll
            for (int u = 0; u < 2; ++u) { const int r = rr_[u]; const float* src = r < NLAT ? p.x + (size_t)r * 1024 : p.ctx + (size_t)(r - NLAT) * 1024;
                mr[u] = MOD + (size_t)(0 * 17 + mod_row_of(r)) * 6144 + 16 * lane; ld16f(src + 16 * lane, v[u]); }
            NORM_MOD16x2(v, g, mr[0], mr[1]);
            if (INPROJ_F8) { st16f8((unsigned char*)H + (size_t)rr_[0] * 1024 + 16 * lane, v[0]); if (two_) st16f8((unsigned char*)H + (size_t)rr_[1] * 1024 + 16 * lane, v[1]); }
            else { st16bf(H + (size_t)rr_[0] * 1024 + 16 * lane, v[0]); if (two_) st16bf(H + (size_t)rr_[1] * 1024 + 16 * lane, v[1]); }
        }
    }
    SEAM(1);

    if (IN(2)) { PHASE_PTRS
        constexpr size_t ES_ = INPROJ_F8 ? 1 : 2;
        pg8::DenseOrder S{(const char*)H, (const char*)(wts + WO_AB), NROW / 256, 6, G, bid, (size_t)256 * 1024 * ES_, (size_t)256 * 1024 * ES_};
        pg8::EpiStoreBf16 E{PRJ, PRJ_LD, INPROJ_F8 ? 0.03125f : 1.0f};
        pg8::gemm_phase<pg8::EpiStoreBf16, pg8::DenseOrder, true, true, INPROJ_F8 != 0>(tid, LDSB, 1024, 1024, S, E);
    }
    SEAM(2);

    if (IN(3)) { PHASE_PTRS
        const float2* TA = (const float2*)(tabs + TAB_A); const float2* TB = (const float2*)(tabs + TAB_B);
        for (int r = gw; r < NROW; r += NGW) {
            bf16_t* pr = PRJ + (size_t)r * PRJ_LD;
            if (r < NLAT) { const int s = r % SEQ;
                { bf16_t* kp = pr + 512 + (lane >> 5) * 64 + (lane & 31); const float x1 = bf2f(kp[0]), x2 = bf2f(kp[32]); const float2 t = TA[s * 32 + (lane & 31)];
                  kp[0] = f2bf(x1 * t.x - x2 * t.y); kp[32] = f2bf(x2 * t.x + x1 * t.y); }
                if (lane < 16) { bf16_t* rp = pr + 1408 + lane; const float x1 = bf2f(rp[0]), x2 = bf2f(rp[16]); const float2 t = TB[s * 16 + lane];
                  rp[0] = f2bf(x1 * t.x - x2 * t.y); rp[16] = f2bf(x2 * t.x + x1 * t.y); } }
            float s1 = 0.f, s2 = 0.f;
#pragma unroll
            for (int j = 0; j < 6; ++j) { const float xq = bf2f(pr[768 + lane + 64 * j]); s1 = fmaf(xq, xq, s1); }
#pragma unroll
            for (int j = 0; j < 4; ++j) { const float xk = bf2f(pr[1152 + lane + 64 * j]); s2 = fmaf(xk, xk, s2); }
            s1 = wave_sum(s1); s2 = wave_sum(s2);
            if (lane == 0) { RINV[2 * r] = 1.0f / sqrtf(s1 * (1.0f / 384.0f) + RMS_EPS); RINV[2 * r + 1] = 1.0f / sqrtf(s2 * (1.0f / 256.0f) + RMS_EPS); }
        }
    }
    SEAM(3);

    if (IN(4)) { PHASE_PTRS
        { pg8::DenseOrder S{(const char*)(PRJ + 768), (const char*)(wts + WO_QB), NROW / 256, 3, G, bid, (size_t)256 * PRJ_LD * 2, (size_t)256 * 384 * 2};
          pg8::EpiScaleBf16 E{QB, 768, RINV};
          pg8::gemm_phase<pg8::EpiScaleBf16, pg8::DenseOrder, true, true>(tid, LDSB, 384, PRJ_LD, S, E); }
        __syncthreads();
        { pg8::DenseOrder S{(const char*)(PRJ + 1152), (const char*)(wts + WO_KVB), NROW / 256, 4, G, bid, (size_t)256 * PRJ_LD * 2, (size_t)256 * 256 * 2};
          pg8::EpiScaleBf16 E{KVB, 1024, RINV + 1};
          pg8::gemm_phase<pg8::EpiScaleBf16, pg8::DenseOrder, true, true>(tid, LDSB, 256, PRJ_LD, S, E); }
    }
    SEAM(4);

    if (IN(5)) { PHASE_PTRS
        for (int i = 0;; ++i) { const int u = i * G + bid; if (u >= 1152) break;
            const bool isctx = u >= 1024; int b, h, qb;
            if (!isctx) { const int rest = u >> 3; b = 2 * (u & 7) + (rest >> 6); h = (rest & 63) >> 3; qb = rest & 7; } else { b = (u - 1024) >> 3; h = u & 7; qb = 0; }
            const int qrow0 = isctx ? NLAT + b * NCX : b * SEQ + qb * 256;
            fa::Unit U; U.Q = QB + (size_t)qrow0 * 768 + h * 96; U.K = KVB + h * 128; U.K2 = PRJ + 1408; U.V = KVB + h * 128 + 64;
            U.O = OUTPROJ_F8 ? (bf16_t*)((unsigned char*)OB + (size_t)qrow0 * 1024 + 512 + h * 64) : OB + (size_t)qrow0 * 1024 + 512 + h * 64; U.rowa = NLAT + b * NCX; U.nta = 4; U.rowb = b * SEQ; U.ntb = isctx ? 0 : 32;
            U.window = 0; U.qpos0 = 0; U.kposb0 = 0; U.sink = 0.f; U.has_sink = 0; U.tab = isctx ? nullptr : (const float*)(tabs + TAB_B); U.pos0 = qb * 256; U.qg = nullptr;
            fa::attn_unit<96, 64, 768, 1024, 1024, 1024, false, 4, 1, false, true, OUTPROJ_F8 != 0>(tid, U, (char*)lds_raw); }
        for (int i = 0;; ++i) { const int u = i * G + bid; if (u >= 1152) break;
            const bool isctx = u >= 1024; int b, h, qb;
            if (!isctx) { const int rest = u >> 3; b = 2 * (u & 7) + (rest >> 6); h = (rest & 63) >> 3; qb = rest & 7; } else { b = (u - 1024) >> 3; h = u & 7; qb = 0; }
            const int qrow0 = isctx ? NLAT + b * NCX : b * SEQ + qb * 256;
            const int ks = isctx ? 0 : max(0, qb * 256 - 128), ke = isctx ? 0 : min(SEQ, qb * 256 + 384);
            fa::Unit U; U.Q = PRJ + (size_t)qrow0 * PRJ_LD + h * 64; U.K = PRJ + 512 + (h >> 2) * 64; U.K2 = nullptr; U.V = PRJ + 640 + (h >> 2) * 64;
            U.O = OUTPROJ_F8 ? (bf16_t*)((unsigned char*)OB + (size_t)qrow0 * 1024 + h * 64) : OB + (size_t)qrow0 * 1024 + h * 64; U.rowa = NLAT + b * NCX; U.nta = 4; U.rowb = b * SEQ + ks; U.ntb = (ke - ks) / 64;
            U.window = isctx ? 0 : 1; U.qpos0 = qb * 256; U.kposb0 = ks; U.sink = p.swa_sink[h]; U.has_sink = 1; U.tab = isctx ? nullptr : (const float*)(tabs + TAB_A); U.pos0 = qb * 256; U.qg = nullptr;
            fa::attn_unit<64, 64, PRJ_LD, PRJ_LD, PRJ_LD, 1024, true, 0, 2, false, false, OUTPROJ_F8 != 0>(tid, U, (char*)lds_raw); }
    }
    SEAM(5);

    if (IN(6)) { PHASE_PTRS
        constexpr size_t ES_ = OUTPROJ_F8 ? 1 : 2;
        pg8::DenseOrder S{(const char*)OB, (const char*)(wts + WO_ABO), NROW / 256, 4, G, bid, (size_t)256 * 1024 * ES_, (size_t)256 * 1024 * ES_};
        pg8::EpiResid E{p.x, p.ctx, XR, MOD + 2048, OUTPROJ_F8 ? 0.03125f : 1.0f};
        pg8::gemm_phase<pg8::EpiResid, pg8::DenseOrder, true, true, OUTPROJ_F8 != 0>(tid, LDSB, 1024, 1024, S, E);
    }
    SEAM(6);

    typedef float f4a_ __attribute__((ext_vector_type(4)));
#define GLD4(dst, ptr, off) asm volatile("global_load_dwordx4 %0, %1, off offset:" #off : "=v"(dst) : "v"(ptr) : "memory")
#define ROUTER_PHASE(L, nrows) do { \
        { const float4* wsrc_ = (const float4*)(p.router_w + (size_t)(L) * 1024 * 32); float4* wl_ = (float4*)lds_raw; \
          for (int q = tid; q < 8192; q += NTHR) { const int c_ = q >> 3, e4_ = q & 7; wl_[(c_ ^ ((c_ >> 8) & 1)) * 8 + (e4_ ^ ((c_ >> 5) & 7))] = wsrc_[q]; } }        \
        __syncthreads(); \
        unsigned* cnt_ = ctl + CW_CNT + (L) * 32; \
        LAS unsigned* lcnt_ = (LAS unsigned*)(LDSB + LDS_MISC + 1024); LAS unsigned* lbase_ = lcnt_ + 32;       \
        if (tid < 32) lcnt_[tid] = 0u; \
        __syncthreads(); \
        const int half_ = lane >> 5, l5_ = lane & 31;                        \
        const float rb_ = p.router_b[(L) * 32 + l5_]; \
        const float4* wl_ = (const float4*)lds_raw + (size_t)(32 * l5_) * 8; const int sw_ = l5_ & 7; \
        LAS unsigned* stash_ = (LAS unsigned*)(LDSB + 131072) + wave * 384;        \
        int it_ = 0; \
          \
        f4a_ xn0_, xn1_, xn2_, xn3_, xn4_, xn5_, xn6_, xn7_;                 \
        { const int r = (gw * 2 < (nrows) ? gw * 2 : 0) + half_; const float* xp_ = XR + (size_t)r * 1024 + 32 * l5_; \
          GLD4(xn0_, xp_, 0); GLD4(xn1_, xp_, 16); GLD4(xn2_, xp_, 32); GLD4(xn3_, xp_, 48); GLD4(xn4_, xp_, 64); GLD4(xn5_, xp_, 80); GLD4(xn6_, xp_, 96); GLD4(xn7_, xp_, 112); } \
        for (int rp = gw; rp * 2 < (nrows); rp += NGW, ++it_) { const int r = rp * 2 + half_; \
            const float* mr = MOD + (size_t)((L) * 17 + mod_row_of(r)) * 6144 + 3072 + 32 * l5_; const float* mr2 = mr + 1024; \
            asm volatile("s_waitcnt vmcnt(0)" : "+v"(xn0_), "+v"(xn1_), "+v"(xn2_), "+v"(xn3_), "+v"(xn4_), "+v"(xn5_), "+v"(xn6_), "+v"(xn7_) :: "memory"); \
            float v[2][16]; \
            _Pragma("unroll") for (int q = 0; q < 4; ++q) { v[0][q] = xn0_[q]; v[0][4 + q] = xn1_[q]; v[0][8 + q] = xn2_[q]; v[0][12 + q] = xn3_[q]; v[1][q] = xn4_[q]; v[1][4 + q] = xn5_[q]; v[1][8 + q] = xn6_[q]; v[1][12 + q] = xn7_[q]; } \
            f4a_ sh0_, sh1_, sh2_, sh3_, sh4_, sh5_, sh6_, sh7_, sc0_, sc1_, sc2_, sc3_, sc4_, sc5_, sc6_, sc7_; \
            GLD4(sh0_, mr, 0); GLD4(sh1_, mr, 16); GLD4(sh2_, mr, 32); GLD4(sh3_, mr, 48); GLD4(sh4_, mr, 64); GLD4(sh5_, mr, 80); GLD4(sh6_, mr, 96); GLD4(sh7_, mr, 112); \
            GLD4(sc0_, mr2, 0); GLD4(sc1_, mr2, 16); GLD4(sc2_, mr2, 32); GLD4(sc3_, mr2, 48); GLD4(sc4_, mr2, 64); GLD4(sc5_, mr2, 80); GLD4(sc6_, mr2, 96); GLD4(sc7_, mr2, 112); \
            { const int rn_ = ((rp + NGW) * 2 < (nrows) ? (rp + NGW) * 2 : rp * 2) + half_; const float* xp_ = XR + (size_t)rn_ * 1024 + 32 * l5_;        \
              GLD4(xn0_, xp_, 0); GLD4(xn1_, xp_, 16); GLD4(xn2_, xp_, 32); GLD4(xn3_, xp_, 48); GLD4(xn4_, xp_, 64); GLD4(xn5_, xp_, 80); GLD4(xn6_, xp_, 96); GLD4(xn7_, xp_, 112); } \
            asm volatile("s_waitcnt vmcnt(8)" : "+v"(sh0_), "+v"(sh1_), "+v"(sh2_), "+v"(sh3_), "+v"(sh4_), "+v"(sh5_), "+v"(sh6_), "+v"(sh7_), "+v"(sc0_), "+v"(sc1_), "+v"(sc2_), "+v"(sc3_), "+v"(sc4_), "+v"(sc5_), "+v"(sc6_), "+v"(sc7_) :: "memory"); \
            float sh_[2][16], sc_[2][16]; \
            _Pragma("unroll") for (int q = 0; q < 4; ++q) { sh_[0][q] = sh0_[q]; sh_[0][4 + q] = sh1_[q]; sh_[0][8 + q] = sh2_[q]; sh_[0][12 + q] = sh3_[q]; sh_[1][q] = sh4_[q]; sh_[1][4 + q] = sh5_[q]; sh_[1][8 + q] = sh6_[q]; sh_[1][12 + q] = sh7_[q]; \
                sc_[0][q] = sc0_[q]; sc_[0][4 + q] = sc1_[q]; sc_[0][8 + q] = sc2_[q]; sc_[0][12 + q] = sc3_[q]; sc_[1][q] = sc4_[q]; sc_[1][4 + q] = sc5_[q]; sc_[1][8 + q] = sc6_[q]; sc_[1][12 + q] = sc7_[q]; } \
            float ss_ = 0.f; \
            _Pragma("unroll") for (int j = 0; j < 16; ++j) { ss_ = fmaf(v[0][j], v[0][j], ss_); ss_ = fmaf(v[1][j], v[1][j], ss_); } \
            ss_ = half_sum32(ss_); \
            const float ri_ = 1.0f / sqrtf(ss_ * (1.0f / 1024.0f) + RMS_EPS); \
            _Pragma("unroll") for (int hh = 0; hh < 2; ++hh) { \
                _Pragma("unroll") for (int j = 0; j < 16; ++j) v[hh][j] = (v[hh][j] * ri_) * sc_[hh][j] + sh_[hh][j];        \
                st16f8((unsigned char*)H + (size_t)r * 1024 + 32 * l5_ + 16 * hh, v[hh]); }        \
            if (l5_ & 8) { _Pragma("unroll") for (int hh = 0; hh < 2; ++hh) _Pragma("unroll") for (int j = 0; j < 16; j += 2) { const float t_ = v[hh][j]; v[hh][j] = v[hh][j + 1]; v[hh][j + 1] = t_; } }        \
            float acc[32]; \
            _Pragma("unroll") for (int e = 0; e < 32; ++e) acc[e] = 0.f; \
            _Pragma("unroll") for (int hh = 0; hh < 2; ++hh) _Pragma("unroll") for (int j = 0; j < 16; ++j) { \
                _Pragma("unroll") for (int e4 = 0; e4 < 8; ++e4) { const float4 w = wl_[(16 * hh + j) * 8 + (e4 ^ sw_)]; \
                    acc[4 * e4] = fmaf(v[hh][j], w.x, acc[4 * e4]); acc[4 * e4 + 1] = fmaf(v[hh][j], w.y, acc[4 * e4 + 1]); acc[4 * e4 + 2] = fmaf(v[hh][j], w.z, acc[4 * e4 + 2]); acc[4 * e4 + 3] = fmaf(v[hh][j], w.w, acc[4 * e4 + 3]); } } \
            float tv[4]; int ti[4]; route_reduce32(acc, l5_, rb_, tv, ti); \
            const float e1 = expf(tv[1] - tv[0]), e2 = expf(tv[2] - tv[0]), e3 = expf(tv[3] - tv[0]); const float inv = 1.0f / (1.0f + e1 + e2 + e3); \
            if (l5_ < 4) { const int ek = l5_ == 0 ? ti[0] : l5_ == 1 ? ti[1] : l5_ == 2 ? ti[2] : ti[3]; const float gk = (l5_ == 0 ? 1.0f : l5_ == 1 ? e1 : l5_ == 2 ? e2 : e3) * inv; \
                const unsigned pos = __hip_atomic_fetch_add(lcnt_ + ek, 1u, __ATOMIC_RELAXED, __HIP_MEMORY_SCOPE_WORKGROUP); TOKE[r * 4 + l5_] = ek; TOKG[r * 4 + l5_] = gk; \
                stash_[it_ * 8 + half_ * 4 + l5_] = (unsigned)ek | (pos << 8); } \
        } \
        asm volatile("s_waitcnt vmcnt(0)" : "+v"(xn0_), "+v"(xn1_), "+v"(xn2_), "+v"(xn3_), "+v"(xn4_), "+v"(xn5_), "+v"(xn6_), "+v"(xn7_) :: "memory");        \
        __syncthreads(); \
        if (tid < 32) lbase_[tid] = atomicAdd(cnt_ + tid, lcnt_[tid]); \
        __syncthreads(); \
        for (int e_ = lane; e_ < it_ * 8; e_ += 64) { const unsigned w_ = stash_[e_]; const int r = (gw + (e_ >> 3) * NGW) * 2 + ((e_ >> 2) & 1); TOKP[r * 4 + (e_ & 3)] = (int)((w_ >> 8) + lbase_[w_ & 255u]); } \
    } while (0)

#define EXCL_SETUP(L) \
        const int c_ = lane < 32 ? (int)ctl[CW_CNT + (L) * 32 + lane] : 0; const int padc_ = (c_ + 255) / 256 * 256; int pre_ = padc_; \
        _Pragma("unroll") for (int o_ = 1; o_ < 32; o_ <<= 1) { const int t_ = __shfl_up(pre_, o_); if ((lane & 31) >= o_) pre_ += t_; } \
        const int excl_ = pre_ - padc_;
#define PERMUTE_PHASE(L, nrows) do { EXCL_SETUP(L) \
        ROWS2(nrows) { ROWS2_IDX(nrows) \
            const int ra_ = rr_[0], rb_ = rr_[1]; \
            const uint4* sa_ = (const uint4*)(H + (size_t)ra_ * 1024) + lane * 2; const uint4* sb_ = (const uint4*)(H + (size_t)rb_ * 1024) + lane * 2; \
            const uint4 a0_ = sa_[0], a1_ = sa_[1], b0_ = sb_[0], b1_ = sb_[1]; \
            const int4 ea_ = *(const int4*)(TOKE + ra_ * 4), pa_ = *(const int4*)(TOKP + ra_ * 4), eb_ = *(const int4*)(TOKE + rb_ * 4), pb_ = *(const int4*)(TOKP + rb_ * 4); \
            const int sa0 = __shfl(excl_, ea_.x) + pa_.x, sa1 = __shfl(excl_, ea_.y) + pa_.y, sa2 = __shfl(excl_, ea_.z) + pa_.z, sa3 = __shfl(excl_, ea_.w) + pa_.w; \
            const int sb0 = __shfl(excl_, eb_.x) + pb_.x, sb1 = __shfl(excl_, eb_.y) + pb_.y, sb2 = __shfl(excl_, eb_.z) + pb_.z, sb3 = __shfl(excl_, eb_.w) + pb_.w; \
            { uint4* d_ = (uint4*)(XS + (size_t)sa0 * 1024) + lane * 2; d_[0] = a0_; d_[1] = a1_; } { uint4* d_ = (uint4*)(XS + (size_t)sa1 * 1024) + lane * 2; d_[0] = a0_; d_[1] = a1_; } \
            { uint4* d_ = (uint4*)(XS + (size_t)sa2 * 1024) + lane * 2; d_[0] = a0_; d_[1] = a1_; } { uint4* d_ = (uint4*)(XS + (size_t)sa3 * 1024) + lane * 2; d_[0] = a0_; d_[1] = a1_; } \
            if (two_) { \
            { uint4* d_ = (uint4*)(XS + (size_t)sb0 * 1024) + lane * 2; d_[0] = b0_; d_[1] = b1_; } { uint4* d_ = (uint4*)(XS + (size_t)sb1 * 1024) + lane * 2; d_[0] = b0_; d_[1] = b1_; } \
            { uint4* d_ = (uint4*)(XS + (size_t)sb2 * 1024) + lane * 2; d_[0] = b0_; d_[1] = b1_; } { uint4* d_ = (uint4*)(XS + (size_t)sb3 * 1024) + lane * 2; d_[0] = b0_; d_[1] = b1_; } } } \
        for (int e = 0; e < 32; ++e) { const int ce = __shfl(c_, e), be = __shfl(excl_, e), pe = __shfl(padc_, e); \
            for (int rr = ce + gw; rr < pe; rr += NGW) { uint4* d_ = (uint4*)(XS + (size_t)(be + rr) * 1024) + lane * 2; d_[0] = make_uint4(0u, 0u, 0u, 0u); d_[1] = make_uint4(0u, 0u, 0u, 0u); } } \
    } while (0)
#define PERMUTE_PHASE_F8(L, nrows) do { EXCL_SETUP(L) \
        unsigned char* XS8 = (unsigned char*)XS; \
        for (int r = gw; r < (nrows); r += NGW) { \
            const int4 ov_ = *((const int4*)((const unsigned char*)H + (size_t)r * 1024) + lane); \
            _Pragma("unroll") for (int k = 0; k < 4; ++k) { const int ek = TOKE[r * 4 + k], pk = TOKP[r * 4 + k]; const int slot = __shfl(excl_, ek) + pk; \
                *((int4*)(XS8 + (size_t)slot * 1024) + lane) = ov_; if (lane == 0) TOKP[r * 4 + k] = slot; } }        \
        for (int e = 0; e < 32; ++e) { const int ce = __shfl(c_, e), be = __shfl(excl_, e), pe = __shfl(padc_, e); \
            for (int rr = ce + gw; rr < pe; rr += NGW) *((int4*)(XS8 + (size_t)(be + rr) * 1024) + lane) = make_int4(0, 0, 0, 0); } \
    } while (0)
#define MOE_TABLE(L) \
        LAS int* tile_e = (LAS int*)(LDSB + LDS_MISC + 1024); LAS int* nm_p = tile_e + 640; \
        LAS int* tpre_ = nm_p + 1;                                       \
        __syncthreads(); \
        if (tid < 64) { const int c_ = lane < 32 ? (int)ctl[CW_CNT + (L) * 32 + lane] : 0; const int n_ = (c_ + 255) / 256; int pre_ = n_; \
            _Pragma("unroll") for (int o_ = 1; o_ < 32; o_ <<= 1) { const int t_ = __shfl_up(pre_, o_); if ((lane & 31) >= o_) pre_ += t_; } \
            if (lane < 32) tpre_[lane] = pre_ - n_; if (lane == 31) { tpre_[32] = pre_; *nm_p = pre_; } } \
        __syncthreads(); \
        const int nM_ = __builtin_amdgcn_readfirstlane(*nm_p); \
        for (int t_ = tid; t_ < nM_; t_ += NTHR) { int e_ = 0; _Pragma("unroll") for (int q_ = 16; q_ >= 1; q_ >>= 1) { if (tpre_[e_ + q_] <= t_) e_ += q_; } tile_e[t_] = e_; }        \
        __syncthreads();
#define MOE_FAST1(L) do { MOE_TABLE(L) \
        pg8::MoeOrder S{(const char*)XS, (const char*)(wts + WO_W1) + (size_t)(L) * 32 * 2048 * 1024 * 2, tile_e, nM_, 8, G, bid, (size_t)256 * 1024 * 2, (size_t)2048 * 1024 * 2}; \
        pg8::EpiSwiglu E{ACT, p.moe_b_in + (size_t)(L) * 32 * 2048, 1.0f}; \
        pg8::gemm_phase<pg8::EpiSwiglu, pg8::MoeOrder, true, true>(tid, LDSB, 1024, 1024, S, E); } while (0)
#define MOE_FAST2(L) do { MOE_TABLE(L) \
        pg8::MoeOrder S{(const char*)ACT, (const char*)(wts + WO_W2) + (size_t)(L) * 32 * 1024 * 1024 * 2, tile_e, nM_, 4, G, bid, (size_t)256 * 1024 * 2, (size_t)1024 * 1024 * 2}; \
        pg8::EpiBiasBf16 E{Y, p.moe_b_out + (size_t)(L) * 32 * 1024, 1.0f}; \
        pg8::gemm_phase<pg8::EpiBiasBf16, pg8::MoeOrder, true, true>(tid, LDSB, 1024, 1024, S, E); } while (0)
#define MOE_FAST1_F8(L) do { MOE_TABLE(L) \
        pg8::MoeOrder S{(const char*)XS, (const char*)(wts + WO_W1) + (size_t)(L) * 32 * 2048 * 1024 * 2, tile_e, nM_, 8, G, bid, (size_t)256 * 1024, (size_t)2048 * 1024}; \
        if constexpr (MOE_F8_DOWN) { pg8::EpiSwigluF8 E{(unsigned char*)ACT, p.moe_b_in + (size_t)(L) * 32 * 2048}; \
            pg8::gemm_phase<pg8::EpiSwigluF8, pg8::MoeOrder, true, true, true>(tid, LDSB, 1024, 1024, S, E); } \
        else { pg8::EpiSwiglu E{ACT, p.moe_b_in + (size_t)(L) * 32 * 2048, 0.03125f}; \
            pg8::gemm_phase<pg8::EpiSwiglu, pg8::MoeOrder, false, true, true>(tid, LDSB, 1024, 1024, S, E); } } while (0)
#define MOE_FAST2_F8(L) do { MOE_TABLE(L) \
        pg8::MoeOrder S{(const char*)ACT, (const char*)(wts + WO_W2) + (size_t)(L) * 32 * 1024 * 1024 * 2, tile_e, nM_, 4, G, bid, (size_t)256 * 1024, (size_t)1024 * 1024}; \
        if constexpr (Y8_L1 && (L) == 1) { pg8::EpiBiasF8 E{(unsigned char*)Y, p.moe_b_out + (size_t)(L) * 32 * 1024, 0.03125f}; \
            pg8::gemm_phase<pg8::EpiBiasF8, pg8::MoeOrder, true, true, true>(tid, LDSB, 1024, 1024, S, E); } \
        else { pg8::EpiBiasBf16 E{Y, p.moe_b_out + (size_t)(L) * 32 * 1024, 0.03125f}; \
            pg8::gemm_phase<pg8::EpiBiasBf16, pg8::MoeOrder, true, true, true>(tid, LDSB, 1024, 1024, S, E); } } while (0)
#define COMBINE_PRE(nrows) typedef int i4n_ __attribute__((ext_vector_type(4))); typedef float f4n_ __attribute__((ext_vector_type(4))); i4n_ sl0_, sl1_; f4n_ gt0_, gt1_; \
        { const int ra_ = gw < (nrows) ? gw : 0, rb_ = gw + NGW < (nrows) ? gw + NGW : ra_; sl0_ = *(const i4n_*)(TOKP + ra_ * 4); gt0_ = *(const f4n_*)(TOKG + ra_ * 4); sl1_ = *(const i4n_*)(TOKP + rb_ * 4); gt1_ = *(const f4n_*)(TOKG + rb_ * 4); }
#define COMBINE_ROWS2(L, v, nrows, F8Y) do { \
        const int slc_[2][4] = {{sl0_[0], sl0_[1], sl0_[2], sl0_[3]}, {sl1_[0], sl1_[1], sl1_[2], sl1_[3]}}; \
        const float gk_[2][4] = {{gt0_[0], gt0_[1], gt0_[2], gt0_[3]}, {gt1_[0], gt1_[1], gt1_[2], gt1_[3]}}; \
        uint4 ya_[2][4], yb_[2][4]; \
        _Pragma("unroll") for (int u = 0; u < 2; ++u) { const int r = rr_[u]; \
            _Pragma("unroll") for (int k = 0; k < 4; ++k) { \
                if constexpr (F8Y) { ya_[u][k] = *((const uint4*)((const unsigned char*)Y + (size_t)slc_[u][k] * 1024) + lane); yb_[u][k] = ya_[u][k]; } \
                else { const uint4* yr = (const uint4*)(Y + (size_t)slc_[u][k] * 1024 + 16 * lane); ya_[u][k] = yr[0]; yb_[u][k] = yr[1]; } } \
            ld16f(XR + (size_t)r * 1024 + 16 * lane, v[u]); } \
        { const int n0_ = r0_ + 2 * NGW; if (n0_ < (nrows)) { const int n1_ = n0_ + NGW < (nrows) ? n0_ + NGW : n0_; \
            sl0_ = *(const i4n_*)(TOKP + n0_ * 4); gt0_ = *(const f4n_*)(TOKG + n0_ * 4); sl1_ = *(const i4n_*)(TOKP + n1_ * 4); gt1_ = *(const f4n_*)(TOKG + n1_ * 4); } } \
        _Pragma("unroll") for (int u = 0; u < 2; ++u) { float f_[16]; \
            _Pragma("unroll") for (int j = 0; j < 16; ++j) f_[j] = 0.f; \
            _Pragma("unroll") for (int k = 0; k < 4; ++k) { \
                if constexpr (F8Y) { const int yw[4] = {(int)ya_[u][k].x, (int)ya_[u][k].y, (int)ya_[u][k].z, (int)ya_[u][k].w}; \
                    _Pragma("unroll") for (int j = 0; j < 4; ++j) { const auto lo_ = __builtin_amdgcn_cvt_pk_f32_fp8(yw[j], false); const auto hi_ = __builtin_amdgcn_cvt_pk_f32_fp8(yw[j], true); \
                        f_[4 * j] = fmaf(gk_[u][k], lo_[0], f_[4 * j]); f_[4 * j + 1] = fmaf(gk_[u][k], lo_[1], f_[4 * j + 1]); f_[4 * j + 2] = fmaf(gk_[u][k], hi_[0], f_[4 * j + 2]); f_[4 * j + 3] = fmaf(gk_[u][k], hi_[1], f_[4 * j + 3]); } } \
                else { const unsigned yw[8] = {ya_[u][k].x, ya_[u][k].y, ya_[u][k].z, ya_[u][k].w, yb_[u][k].x, yb_[u][k].y, yb_[u][k].z, yb_[u][k].w}; \
                    _Pragma("unroll") for (int j = 0; j < 8; ++j) { f_[2 * j] = fmaf(gk_[u][k], __uint_as_float(yw[j] << 16), f_[2 * j]); f_[2 * j + 1] = fmaf(gk_[u][k], __uint_as_float(yw[j] & 0xffff0000u), f_[2 * j + 1]); } } } \
            float g2v_[16]; ld16f(MOD + (size_t)((L) * 17 + mod_row_of(rr_[u])) * 6144 + 5120 + 16 * lane, g2v_);        \
            _Pragma("unroll") for (int j = 0; j < 16; ++j) v[u][j] = fmaf(g2v_[j], f_[j], v[u][j]); } } while (0)

    if (IN(7)) { PHASE_PTRS ROUTER_PHASE(0, NROW); }
    SEAM(7);
#if MOE_F8_L0
    if (IN(8)) { PHASE_PTRS PERMUTE_PHASE_F8(0, NROW); }
    SEAM(8);
    if (IN(9)) { PHASE_PTRS MOE_FAST1_F8(0); }
    SEAM(9);
#else
    if (IN(8)) { PHASE_PTRS PERMUTE_PHASE(0, NROW); }
    SEAM(8);
    if (IN(9)) { PHASE_PTRS MOE_FAST1(0); }
    SEAM(9);
#endif
    if (IN(10)) { PHASE_PTRS if constexpr (MOE_F8_L0 && MOE_F8_DOWN) { MOE_FAST2_F8(0); } else { MOE_FAST2(0); } }
    SEAM(10);

    if (IN(11)) { PHASE_PTRS
        float g[16]; ld16f(p.norm_mix_g + 1024 + 16 * lane, g);
        COMBINE_PRE(NROW)
        ROWS2(NROW) { ROWS2_IDX(NROW)
            float v[2][16]; COMBINE_ROWS2(0, v, NROW, false);
            st16f(XR + (size_t)rr_[0] * 1024 + 16 * lane, v[0]); if (two_) st16f(XR + (size_t)rr_[1] * 1024 + 16 * lane, v[1]);
            const float* mr0 = MOD + (size_t)(1 * 17 + mod_row_of(rr_[0])) * 6144 + 16 * lane; const float* mr1 = MOD + (size_t)(1 * 17 + mod_row_of(rr_[1])) * 6144 + 16 * lane;
            NORM_MOD16x2(v, g, mr0, mr1);
            if (INPROJ_F8) { st16f8((unsigned char*)H + (size_t)rr_[0] * 1024 + 16 * lane, v[0]); if (two_) st16f8((unsigned char*)H + (size_t)rr_[1] * 1024 + 16 * lane, v[1]); }
            else { st16bf(H + (size_t)rr_[0] * 1024 + 16 * lane, v[0]); if (two_) st16bf(H + (size_t)rr_[1] * 1024 + 16 * lane, v[1]); }
        }
    }
    SEAM(11);

    if (IN(12)) { PHASE_PTRS
        constexpr size_t ES_ = INPROJ_F8 ? 1 : 2;
        pg8::DenseOrder S{(const char*)H, (const char*)(wts + WO_C), NROW / 256, 6, G, bid, (size_t)256 * 1024 * ES_, (size_t)256 * 1024 * ES_};
        pg8::EpiStoreBf16 E{PRJ, PRJ_LD, INPROJ_F8 ? 0.03125f : 1.0f};
        pg8::gemm_phase<pg8::EpiStoreBf16, pg8::DenseOrder, true, true, INPROJ_F8 != 0>(tid, LDSB, 1024, 1024, S, E);
    }
    SEAM(12);

    if (IN(13)) { PHASE_PTRS
        const float2* TC = (const float2*)(tabs + TAB_C); const float kg1 = p.c_k_g[lane], kg2 = p.c_k_g[64 + lane];
        for (int r = gw; r < NROW; r += NGW) {
            bf16_t* pr = PRJ + (size_t)r * PRJ_LD + 1024; float2 t = make_float2(1.f, 0.f); if (r < NLAT) t = TC[(r % SEQ) * 64 + lane];
#pragma unroll
            for (int kv = 0; kv < 2; ++kv) { float x1 = bf2f(pr[kv * 128 + lane]), x2 = bf2f(pr[kv * 128 + 64 + lane]);
                const float ss = wave_sum(x1 * x1 + x2 * x2); const float ri = 1.0f / sqrtf(ss * (1.0f / 128.0f) + RMS_EPS);
                x1 = x1 * ri * kg1; x2 = x2 * ri * kg2;
                pr[kv * 128 + lane] = f2bf(x1 * t.x - x2 * t.y); pr[kv * 128 + 64 + lane] = f2bf(x2 * t.x + x1 * t.y); }
        }
    }
    SEAM(13);

    if (IN(14)) { PHASE_PTRS
        for (int i = 0;; ++i) { const int u = i * G + bid; if (u >= 1024) break;
            const int rest = u >> 3; const int b = 2 * (u & 7) + (rest >> 6), h = (rest & 63) >> 3, qb = rest & 7; const int qrow0 = b * SEQ + qb * 256;
            fa::Unit U; U.Q = PRJ + (size_t)qrow0 * PRJ_LD + h * 128; U.K = PRJ + 1024 + (h >> 2) * 128; U.K2 = nullptr; U.V = PRJ + 1280 + (h >> 2) * 128;
            U.O = OUTPROJ_F8 ? (bf16_t*)((unsigned char*)OB + (size_t)qrow0 * 1024 + h * 128) : OB + (size_t)qrow0 * 1024 + h * 128; U.rowa = NLAT + b * NCX; U.nta = 4; U.rowb = b * SEQ; U.ntb = 32;
            U.window = 0; U.qpos0 = 0; U.kposb0 = 0; U.sink = 0.f; U.has_sink = 0; U.tab = (const float*)(tabs + TAB_C); U.pos0 = qb * 256; U.qg = (const float*)(tabs + TAB_QG);
            fa::attn_unit<128, 128, PRJ_LD, PRJ_LD, PRJ_LD, 1024, false, 0, 4, true, false, OUTPROJ_F8 != 0>(tid, U, (char*)lds_raw); }
    }
    SEAM(14);

    if (IN(15)) { PHASE_PTRS
        constexpr size_t ES_ = OUTPROJ_F8 ? 1 : 2;
        pg8::DenseOrder S{(const char*)OB, (const char*)(wts + WO_CO), NLAT / 256, 4, G, bid, (size_t)256 * 1024 * ES_, (size_t)256 * 1024 * ES_};
        pg8::EpiResid E{XR, XR, XR, MOD + 17 * 6144 + 2048, OUTPROJ_F8 ? 0.03125f : 1.0f};
        pg8::gemm_phase<pg8::EpiResid, pg8::DenseOrder, true, true, OUTPROJ_F8 != 0>(tid, LDSB, 1024, 1024, S, E);
    }
    SEAM(15);

    if (IN(16)) { PHASE_PTRS ROUTER_PHASE(1, NLAT); }
    SEAM(16);
#if MOE_F8_L1
    if (IN(17)) { PHASE_PTRS PERMUTE_PHASE_F8(1, NLAT); }
    SEAM(17);
    if (IN(18)) { PHASE_PTRS MOE_FAST1_F8(1); }
    SEAM(18);
    if (IN(19)) { PHASE_PTRS if constexpr (MOE_F8_DOWN) { MOE_FAST2_F8(1); } else { MOE_FAST2(1); } }
    SEAM(19);
#else
    if (IN(17)) { PHASE_PTRS PERMUTE_PHASE(1, NLAT); }
    SEAM(17);
    if (IN(18)) { PHASE_PTRS MOE_FAST1(1); }
    SEAM(18);
    if (IN(19)) { PHASE_PTRS MOE_FAST2(1); }
    SEAM(19);
#endif

    if (IN(20)) { PHASE_PTRS
        float g[16]; ld16f(p.final_g + 16 * lane, g);
        COMBINE_PRE(NLAT)
        ROWS2(NLAT) { ROWS2_IDX(NLAT)
            float v[2][16]; COMBINE_ROWS2(1, v, NLAT, (Y8_L1 && MOE_F8_L1 && MOE_F8_DOWN));
            float s0 = 0.f, s1 = 0.f;
#pragma unroll
            for (int j = 0; j < 16; ++j) { s0 = fmaf(v[0][j], v[0][j], s0); s1 = fmaf(v[1][j], v[1][j], s1); }
            wave_sum2(s0, s1); const float ri0 = 1.0f / sqrtf(s0 * (1.0f / 1024.0f) + RMS_EPS), ri1 = 1.0f / sqrtf(s1 * (1.0f / 1024.0f) + RMS_EPS);
#pragma unroll
            for (int j = 0; j < 16; ++j) { v[0][j] = v[0][j] * ri0 * g[j]; v[1][j] = v[1][j] * ri1 * g[j]; }
            st16f(p.out + (size_t)rr_[0] * 1024 + 16 * lane, v[0]); if (two_) st16f(p.out + (size_t)rr_[1] * 1024 + 16 * lane, v[1]);
        }
    }
#undef IN
#undef SEAM
}

#ifndef MK_PER_PHASE
#define MK_PER_PHASE 0
#endif
extern "C" void kernel_launch(void* const* d_in, const int* in_sizes, int n_in, void* d_out, int out_size, void* d_ws, size_t ws_size, hipStream_t stream) {
    static int grid = 0;
    if (grid == 0) {
        if (n_in != 26 || out_size != NLAT * DM || ws_size < WS_END) { fprintf(stderr, "kernel_launch: unexpected shapes (n_in %d out %d ws %zu need %zu)\n", n_in, out_size, ws_size, (size_t)WS_END); grid = -1; return; }
        int dev = 0, cus = 0;
        if (hipGetDevice(&dev) != hipSuccess || hipDeviceGetAttribute(&cus, hipDeviceAttributeMultiprocessorCount, dev) != hipSuccess) { grid = -1; return; }
        if (hipFuncSetAttribute((const void*)fwd_kernel, hipFuncAttributeMaxDynamicSharedMemorySize, LDS_BYTES) != hipSuccess) { fprintf(stderr, "kernel_launch: hipFuncSetAttribute failed\n"); grid = -1; return; }
        int per_cu = 0;
        if (hipOccupancyMaxActiveBlocksPerMultiprocessor(&per_cu, (const void*)fwd_kernel, NTHR, LDS_BYTES) != hipSuccess || per_cu < 1) { fprintf(stderr, "kernel_launch: occupancy query says %d\n", per_cu); }
        (void)hipGetLastError();
        grid = cus;
    }
    if (grid < 0) return;
    (void)hipMemsetAsync((char*)d_ws + WS_CTL, 0, CTL_BYTES, stream);
    Params p{};
    const float** pp = (const float**)&p;
    for (int i = 0; i < 26; ++i) pp[i] = (const float*)d_in[i];
    p.out = (float*)d_out; p.ws = (unsigned char*)d_ws;
#if MK_PER_PHASE
    for (int k = 0; k < N_PHASES; ++k) { p.ph_lo = k; p.ph_hi = k + 1; hipLaunchKernelGGL(fwd_kernel, dim3(grid), dim3(NTHR), LDS_BYTES, stream, p); }
#else
    p.ph_lo = 0; p.ph_hi = N_PHASES;
    hipLaunchKernelGGL(fwd_kernel, dim3(grid), dim3(NTHR), LDS_BYTES, stream, p);
#endif
}
```

```cpp
#include <hip/hip_runtime.h>
#include <cstdio>
#include <cstdint>

typedef unsigned short bf16_t;
typedef bf16_t act_t;
#define GAS __attribute__((address_space(1)))
#define LAS __attribute__((address_space(3)))

constexpr int DM = 1024, NB = 16, SEQ = 2048, NCX = 256, GRIDW = 64;
constexpr int NLAT = NB * SEQ, NCTX = NB * NCX, NROW = NLAT + NCTX;
constexpr int AB_IN = 1440, C_IN = 1536, PRJ_LD = 1536;
constexpr int NEXP = 32, DFF = 1024;
constexpr int CAP = 155648;
constexpr float RMS_EPS = 1e-6f;
constexpr int NTHR = 512;

constexpr size_t MiB = 1u << 20;
constexpr size_t ASZ = sizeof(act_t);
constexpr size_t WS_CTL = 0, CTL_BYTES = 1 * MiB;
constexpr size_t WS_MOD = 1 * MiB;
constexpr size_t WS_TOKE = 2 * MiB, WS_TOKP = 3 * MiB, WS_TOKG = 4 * MiB;
constexpr size_t WS_RINV = 5 * MiB;
constexpr size_t WS_TAB = 6 * MiB;
constexpr size_t TAB_A = 0, TAB_B = (size_t)SEQ * 32 * 8, TAB_C = TAB_B + (size_t)SEQ * 16 * 8, TAB_QG = TAB_C + (size_t)SEQ * 64 * 8;
constexpr size_t WS_XR = 16 * MiB;
constexpr size_t WS_H = WS_XR + 144 * MiB;
constexpr size_t WS_BIG = WS_H + (size_t)NROW * 1024 * ASZ;
constexpr size_t OFF_PRJ = 0;
constexpr size_t OFF_QB = OFF_PRJ + (size_t)NROW * 1536 * ASZ;
constexpr size_t OFF_KVB = OFF_QB + (size_t)NROW * 768 * ASZ;
constexpr size_t OFF_O = OFF_KVB + (size_t)NROW * 1024 * ASZ;
constexpr size_t BIG_A = OFF_O + (size_t)NROW * 1024 * ASZ;
constexpr size_t BIG_Y = (size_t)CAP * 1024 * ASZ;
constexpr size_t BIG_BYTES = BIG_A > BIG_Y ? BIG_A : BIG_Y;
constexpr size_t WS_ACT = WS_BIG + BIG_BYTES;
constexpr size_t WS_XS = WS_ACT + (size_t)CAP * 1024 * ASZ;
constexpr size_t WS_W = WS_XS + (size_t)CAP * 1024 * ASZ;
constexpr size_t WO_AB = 0;
constexpr size_t WO_QB = WO_AB + (size_t)1536 * 1024 * 2;
constexpr size_t WO_KVB = WO_QB + (size_t)768 * 384 * 2;
constexpr size_t WO_ABO = WO_KVB + (size_t)1024 * 256 * 2;
constexpr size_t WO_C = WO_ABO + (size_t)1024 * 1024 * 2;
constexpr size_t WO_CO = WO_C + (size_t)1536 * 1024 * 2;
constexpr size_t WO_W1 = WO_CO + (size_t)1024 * 1024 * 2;
constexpr size_t WO_W2 = WO_W1 + (size_t)64 * 2048 * 1024 * 2;
constexpr size_t WS_END = WS_W + WO_W2 + (size_t)64 * 1024 * 1024 * 2;

constexpr int CW_CNT = 64;
constexpr int CW_BAR = 4096;

__device__ __forceinline__ float bf2f(bf16_t v) { return __uint_as_float(((unsigned)v) << 16); }
__device__ __forceinline__ bf16_t f2bf(float f) { unsigned u = __float_as_uint(f); return (bf16_t)((u + 0x7fffu + ((u >> 16) & 1u)) >> 16); }
__device__ __forceinline__ float ldA(const float* p) { return *p; }
__device__ __forceinline__ float ldA(const bf16_t* p) { return bf2f(*p); }
__device__ __forceinline__ void stA(float* p, float v) { *p = v; }
__device__ __forceinline__ void stA(bf16_t* p, float v) { *p = f2bf(v); }
template <int N> __device__ __forceinline__ void load_vec(const float* p, float (&o)[N]) {
#pragma unroll
    for (int i = 0; i < N / 4; ++i) { const float4 t = ((const float4*)p)[i]; o[4 * i] = t.x; o[4 * i + 1] = t.y; o[4 * i + 2] = t.z; o[4 * i + 3] = t.w; }
}
template <int N> __device__ __forceinline__ void load_vec(const bf16_t* p, float (&o)[N]) {
#pragma unroll
    for (int i = 0; i < N / 8; ++i) { const uint4 t = ((const uint4*)p)[i];
        o[8 * i] = __uint_as_float(t.x << 16); o[8 * i + 1] = __uint_as_float(t.x & 0xffff0000u); o[8 * i + 2] = __uint_as_float(t.y << 16); o[8 * i + 3] = __uint_as_float(t.y & 0xffff0000u);
        o[8 * i + 4] = __uint_as_float(t.z << 16); o[8 * i + 5] = __uint_as_float(t.z & 0xffff0000u); o[8 * i + 6] = __uint_as_float(t.w << 16); o[8 * i + 7] = __uint_as_float(t.w & 0xffff0000u); }
}
__device__ __forceinline__ float wave_sum(float v) {
#pragma unroll
    for (int o = 1; o < 64; o <<= 1) v += __shfl_xor(v, o);
    return v;
}

__device__ __forceinline__ void wave_sum2(float& a, float& b) {
#pragma unroll
    for (int o = 1; o < 64; o <<= 1) { const float ta = __shfl_xor(a, o), tb = __shfl_xor(b, o); a += ta; b += tb; }
}
__device__ __forceinline__ void ld16f(const float* p, float (&v)[16]) {
#pragma unroll
    for (int i = 0; i < 4; ++i) { const float4 t = ((const float4*)p)[i]; v[4 * i] = t.x; v[4 * i + 1] = t.y; v[4 * i + 2] = t.z; v[4 * i + 3] = t.w; }
}
__device__ __forceinline__ void st16f(float* p, const float (&v)[16]) {
#pragma unroll
    for (int i = 0; i < 4; ++i) ((float4*)p)[i] = make_float4(v[4 * i], v[4 * i + 1], v[4 * i + 2], v[4 * i + 3]);
}
__device__ __forceinline__ unsigned cvtpk2(float lo, float hi) { unsigned r; asm volatile("v_cvt_pk_bf16_f32 %0, %1, %2" : "=v"(r) : "v"(lo), "v"(hi)); return r; }
__device__ __forceinline__ void st16bf(bf16_t* p, const float (&v)[16]) {
    ((uint4*)p)[0] = make_uint4(cvtpk2(v[0], v[1]), cvtpk2(v[2], v[3]), cvtpk2(v[4], v[5]), cvtpk2(v[6], v[7]));
    ((uint4*)p)[1] = make_uint4(cvtpk2(v[8], v[9]), cvtpk2(v[10], v[11]), cvtpk2(v[12], v[13]), cvtpk2(v[14], v[15]));
}

__device__ __forceinline__ void st16f8(unsigned char* p, const float (&v)[16]) {
    int o[4];
#pragma unroll
    for (int j = 0; j < 4; ++j) { const int t = __builtin_amdgcn_cvt_pk_fp8_f32(v[4 * j], v[4 * j + 1], 0, false); o[j] = __builtin_amdgcn_cvt_pk_fp8_f32(v[4 * j + 2], v[4 * j + 3], t, true); }
    *(int4*)p = make_int4(o[0], o[1], o[2], o[3]);
}
#define XB_TMO      128
#define XB_XCNT(j)  (256  + 64 * (j))
#define XB_XSUB(j)  (1280 + 64 * (j))
#define XB_XGEN(j)  (2304 + 64 * (j))
#define XB_TOP      3328
#define XB_TOPGEN   3392
#define XCD_BAR_WORDS 3456
#define XB_SPIN_CAP (1u << 22)
__device__ __forceinline__ unsigned xb_ld(unsigned* p)              { return __hip_atomic_load(p, __ATOMIC_RELAXED, __HIP_MEMORY_SCOPE_AGENT); }
__device__ __forceinline__ unsigned xb_add(unsigned* p, unsigned v) { return __hip_atomic_fetch_add(p, v, __ATOMIC_RELAXED, __HIP_MEMORY_SCOPE_AGENT); }
__device__ __forceinline__ unsigned xb_xcc_id() { return (unsigned)__builtin_amdgcn_s_getreg((3 << 11) | 20) & 0xFu; }
#define XB_SPIN(cond, bar) do { unsigned _sp = 0; while (cond) { __builtin_amdgcn_s_sleep(1); \
    if ((++_sp & 255u) == 0u) { if (xb_ld(&(bar)[XB_TMO])) break; if (_sp > XB_SPIN_CAP) { atomicAdd(&(bar)[XB_TMO], 1u); break; } } } } while (0)
struct XcdBarrier { unsigned* bar; unsigned x; volatile LAS unsigned* st; };
__device__ __forceinline__ bool xb_is_leader(int wave0) { return wave0 == 0 && __builtin_amdgcn_mbcnt_hi(~0u, __builtin_amdgcn_mbcnt_lo(~0u, 0u)) == 0u; }
__device__ __forceinline__ XcdBarrier xcd_barrier_post(unsigned* bar, volatile LAS unsigned* st, int wave0) {
    XcdBarrier b; b.bar = bar; b.x = xb_xcc_id(); b.st = st;
    if (xb_is_leader(wave0)) (void)xb_add(&bar[XB_XCNT(b.x)], 1u);
    return b;
}
__device__ __forceinline__ void xcd_barrier_complete(unsigned* bar, unsigned x, unsigned& nloc, unsigned& nx) {
    const unsigned G = gridDim.x * gridDim.y * gridDim.z;
    unsigned sum, cnt, mine, sp = 0u;
    for (;;) {
        sum = 0u; cnt = 0u; mine = 0u;
#pragma unroll
        for (unsigned j = 0; j < 16; ++j) { const unsigned c = xb_ld(&bar[XB_XCNT(j)]); sum += c; cnt += (c > 0u) ? 1u : 0u; mine = (j == x) ? c : mine; }
        if (sum == G) break;
        __builtin_amdgcn_s_sleep(1);
        if ((++sp & 255u) == 0u) { if (xb_ld(&bar[XB_TMO])) break; if (sp > XB_SPIN_CAP) { atomicAdd(&bar[XB_TMO], 1u); break; } }
    }
    nloc = mine > 0u ? mine : 1u; nx = cnt > 0u ? cnt : 1u;
}
__device__ __forceinline__ void xcd_barrier(const XcdBarrier& b, int wave0) {
    asm volatile("s_waitcnt vmcnt(0)" ::: "memory");
    __syncthreads();
    if (xb_is_leader(wave0)) {
        unsigned* bar = b.bar;
        __builtin_amdgcn_s_waitcnt(0);
        unsigned nloc = b.st[0], nx = b.st[1];
        if (nloc == 0u) { xcd_barrier_complete(bar, b.x, nloc, nx); b.st[0] = nloc; b.st[1] = nx; }
        const unsigned old = xb_add(&bar[XB_XSUB(b.x)], 1u);
        const unsigned gen = old / nloc;
        if (old + 1u == (gen + 1u) * nloc) {
            __builtin_amdgcn_fence(__ATOMIC_RELEASE, "agent");
            asm volatile("s_waitcnt vmcnt(0)" ::: "memory");
            const unsigned og = xb_add(&bar[XB_TOP], 1u);
            const unsigned tg = og / nx;
            if (og + 1u == (tg + 1u) * nx) xb_add(&bar[XB_TOPGEN], 1u);
            else XB_SPIN(xb_ld(&bar[XB_TOPGEN]) == tg, bar);
            __builtin_amdgcn_fence(__ATOMIC_ACQUIRE, "agent");
            xb_add(&bar[XB_XGEN(b.x)], 1u);
            asm volatile("s_waitcnt vmcnt(0)" ::: "memory");
        } else {
            XB_SPIN(xb_ld(&bar[XB_XGEN(b.x)]) == gen, bar);
            __builtin_amdgcn_fence(__ATOMIC_ACQUIRE, "agent");
            asm volatile("s_waitcnt vmcnt(0)" ::: "memory");
        }
    }
    __syncthreads();
}


#ifndef FAST_GEMM
#define FAST_GEMM 1
#endif
namespace pg8 {
#define PG8_LAS __attribute__((address_space(3)))
typedef short bf16x8 __attribute__((ext_vector_type(8)));
typedef float f32x4 __attribute__((ext_vector_type(4)));
typedef unsigned u32x4 __attribute__((ext_vector_type(4)));
constexpr int BM = 256, BK = 64, HALF = 128, HTB = HALF * BK * 2  , STAGE_BYTES = 8 * HTB, NXCD = 8, WGM = 8;

__host__ __device__ __forceinline__ int lds_byte(int r, int c) { const int st = (r >> 4) * 2 + (c >> 5), rr = r & 15, cc = c & 31, ob = rr * 64 + cc * 2; return st * 1024 + (ob ^ (((ob >> 9) & 1) << 5)); }
__host__ __device__ __forceinline__ void stage_rc(int b, int& R, int& C) { const int st = b / 1024, sb = b % 1024, swz = sb ^ (((sb >> 9) & 1) << 5); R = (st >> 1) * 16 + swz / 64; C = (st & 1) * 32 + (swz % 64) / 2; }
__host__ __device__ __forceinline__ int perm32(int rho) { const int n = rho >> 4, i = rho & 15; return 8 * (i >> 2) + 4 * n + (i & 3); }


struct Unit { const char* a; const char* b; int pm, pn, aux; };
__device__ __forceinline__ unsigned cvt_pk_bf16(float lo, float hi) { unsigned r; asm volatile("v_cvt_pk_bf16_f32 %0, %1, %2" : "=v"(r) : "v"(lo), "v"(hi)); return r; }
typedef int v8i32 __attribute__((ext_vector_type(8)));
__device__ __forceinline__ v8i32 cat16(bf16x8 lo, bf16x8 hi) { typedef int v4i32 __attribute__((ext_vector_type(4))); const v4i32 a = __builtin_bit_cast(v4i32, lo), b = __builtin_bit_cast(v4i32, hi); return __builtin_shufflevector(a, b, 0, 1, 2, 3, 4, 5, 6, 7); }
template <class Epi, class Sched, bool ALIGN_EPI = false, bool SP2 = false, bool F8 = false>
__device__ __forceinline__ void gemm_phase(const int tid, PG8_LAS unsigned char* lds, const int K, const int lda, const Sched& S, const Epi& E) {
    const int wid = __builtin_amdgcn_readfirstlane(tid >> 6), lane = tid & 63, wr = wid >> 2, wc = wid & 3, fr = lane & 15, fq = lane >> 4;
    const int nt = F8 ? K / (2 * BK) : K / BK;
    unsigned voffA[2], voffB[2];
#pragma unroll
    for (int i = 0; i < 2; ++i) { int R, C; stage_rc(tid * 16 + i * 8192, R, C); const int Rb = Epi::PERM ? ((R & ~31) + perm32(R & 31)) : R;
        voffA[i] = F8 ? (unsigned)(R * lda + 2 * C) : (unsigned)(R * lda + C) * 2u; voffB[i] = F8 ? (unsigned)(Rb * K + 2 * C) : (unsigned)(Rb * K + C) * 2u; }
    const size_t kstep = (size_t)(BK * 2);
    const size_t hstepA = (size_t)HALF * lda * (F8 ? 1 : 2);
    const size_t hstep = (size_t)HALF * K * (F8 ? 1 : 2);
    const unsigned ldsbase = (unsigned)__builtin_amdgcn_readfirstlane((int)((unsigned)(uintptr_t)lds + (unsigned)wid * 1024u));
    const unsigned ldsw = (unsigned)wid * 1024u;
    const int aoff = lds_byte(wr * 64 + fr, fq * 8), boff = lds_byte(wc * 32 + fr, fq * 8);
#define PG8_SA(b, h) (((b) * 2 + (h)) * HTB)
#define PG8_SB(b, h) ((4 + (b) * 2 + (h)) * HTB)
#define PG8_STAGE(bufoff, gbase, voff) do { _Pragma("unroll") for (int _i = 0; _i < 2; ++_i) { \
        if constexpr (F8) { unsigned keep_; asm volatile("s_mov_b32 %0, m0\n\ts_mov_b32 m0, %3\n\ts_nop 0\n\tglobal_load_lds_dwordx4 %1, %2\n\ts_mov_b32 m0, %0" : "=&s"(keep_) : "v"((voff)[_i]), "s"((const char*)(gbase)), "s"(ldsbase + (unsigned)((bufoff) + _i * 8192)) : "memory"); } \
        else __builtin_amdgcn_global_load_lds((const unsigned*)((const char*)(gbase) + (voff)[_i]), (PG8_LAS unsigned*)(lds + (bufoff) + ldsw + _i * 8192), 16, 0, 0); } } while (0)
#define PG8_LDA(dst, b, h) do { _Pragma("unroll") for (int m = 0; m < 4; ++m) { _Pragma("unroll") for (int k = 0; k < 2; ++k) dst[m][k] = *(const PG8_LAS bf16x8*)(lds + PG8_SA(b, h) + aoff + m * 2048 + k * 1024); \
        if constexpr (F8) dst##8[m] = cat16(dst[m][0], dst[m][1]); } } while (0)
#define PG8_LDB(dst, b, h) do { _Pragma("unroll") for (int n = 0; n < 2; ++n) { _Pragma("unroll") for (int k = 0; k < 2; ++k) dst[n][k] = *(const PG8_LAS bf16x8*)(lds + PG8_SB(b, h) + boff + n * 2048 + k * 1024); \
        if constexpr (F8) dst##8[n] = cat16(dst[n][0], dst[n][1]); } } while (0)
#define PG8_MMA(ai, bj, At, Bt) do { __builtin_amdgcn_s_setprio(1); _Pragma("unroll") for (int m = 0; m < 4; ++m) _Pragma("unroll") for (int n = 0; n < 2; ++n) { \
        if constexpr (F8) acc[ai][bj][m][n] = __builtin_amdgcn_mfma_scale_f32_16x16x128_f8f6f4(Bt##8[n], At##8[m], acc[ai][bj][m][n], 0, 0, 0, 0x7f7f7f7f, 0, 0x7f7f7f7f); \
        else { _Pragma("unroll") for (int k = 0; k < 2; ++k) acc[ai][bj][m][n] = __builtin_amdgcn_mfma_f32_16x16x32_bf16(Bt[n][k], At[m][k], acc[ai][bj][m][n], 0, 0, 0); } } __builtin_amdgcn_s_setprio(0); } while (0)
#define PG8_WAIT_V(n) asm volatile("s_waitcnt vmcnt(" #n ")" ::: "memory")
#define PG8_WAIT_L(n) asm volatile("s_waitcnt lgkmcnt(" #n ")" ::: "memory")
#define PG8_BAR __builtin_amdgcn_s_barrier()
#define PG8_SCHED __builtin_amdgcn_sched_barrier(0)
    Unit cur, nxt; int ui = 0;
    if (!S.next(0, cur)) return;
    f32x4 acc[2][2][4][2];
#pragma unroll
    for (int a = 0; a < 2; ++a)
#pragma unroll
        for (int b = 0; b < 2; ++b)
#pragma unroll
            for (int m = 0; m < 4; ++m)
#pragma unroll
                for (int n = 0; n < 2; ++n) acc[a][b][m][n] = (f32x4){0.f, 0.f, 0.f, 0.f};
    bf16x8 At[4][2], B0[2][2], B1[2][2]; v8i32 At8[4], B08[2], B18[2]; (void)At8; (void)B08; (void)B18;
    const char* cA = cur.a; const char* cB = cur.b;
    S.a_ready(cur);
    if constexpr (SP2) {
        PG8_STAGE(PG8_SB(0, 0), cB, voffB); PG8_STAGE(PG8_SB(0, 1), cB + hstep, voffB); PG8_STAGE(PG8_SA(0, 0), cA, voffA); PG8_STAGE(PG8_SA(0, 1), cA + hstepA, voffA);
        if (wr == 1) PG8_BAR;
        PG8_WAIT_V(2); PG8_BAR;
        PG8_STAGE(PG8_SB(1, 0), cB + kstep, voffB); PG8_STAGE(PG8_SA(1, 0), cA + kstep, voffA); PG8_STAGE(PG8_SB(1, 1), cB + hstep + kstep, voffB);
        PG8_WAIT_V(6); PG8_BAR;
    } else {
        PG8_STAGE(PG8_SB(0, 0), cB, voffB); PG8_STAGE(PG8_SA(0, 0), cA, voffA); PG8_STAGE(PG8_SB(0, 1), cB + hstep, voffB); PG8_STAGE(PG8_SA(0, 1), cA + hstepA, voffA);
        if (wr == 1) PG8_BAR;
        PG8_WAIT_V(4); PG8_BAR;
        PG8_STAGE(PG8_SB(1, 0), cB + kstep, voffB); PG8_STAGE(PG8_SA(1, 0), cA + kstep, voffA); PG8_STAGE(PG8_SB(1, 1), cB + hstep + kstep, voffB);
        PG8_WAIT_V(6); PG8_BAR;
    }
    for (;;) {
        const bool has_next = S.next(ui + 1, nxt);
        const char* nA = has_next ? nxt.a : cA; const char* nB = has_next ? nxt.b : cB;
#pragma unroll 1
        for (int t = 0; t < nt; t += 2) {
            const bool last = (t == nt - 2);
            const char* a1 = cA + (size_t)(t + 1) * kstep;
            const char* a2 = last ? nA : cA + (size_t)(t + 2) * kstep; const char* b2 = last ? nB : cB + (size_t)(t + 2) * kstep;
            const char* a3 = a2 + kstep; const char* b3 = b2 + kstep;
            if (last && has_next) S.a_ready(nxt);
            if constexpr (SP2) {
            PG8_LDB(B0, 0, 0); PG8_LDB(B1, 0, 1); PG8_SCHED; PG8_LDA(At, 0, 0); PG8_STAGE(PG8_SA(1, 1), a1 + hstepA, voffA);
            PG8_WAIT_V(8); PG8_WAIT_L(0); PG8_BAR; PG8_MMA(0, 0, At, B0); PG8_MMA(0, 1, At, B1); PG8_BAR; PG8_SCHED;
            PG8_LDA(At, 0, 1); PG8_STAGE(PG8_SB(0, 0), b2, voffB); PG8_STAGE(PG8_SB(0, 1), b2 + hstep, voffB); PG8_STAGE(PG8_SA(0, 0), a2, voffA);
            PG8_WAIT_V(8); PG8_WAIT_L(0); PG8_BAR; PG8_MMA(1, 0, At, B0); PG8_MMA(1, 1, At, B1); PG8_BAR; PG8_SCHED;
            PG8_LDB(B0, 1, 0); PG8_LDB(B1, 1, 1); PG8_SCHED; PG8_LDA(At, 1, 0); PG8_STAGE(PG8_SA(0, 1), a2 + hstepA, voffA);
            PG8_WAIT_V(8); PG8_WAIT_L(0); PG8_BAR; PG8_MMA(0, 0, At, B0); PG8_MMA(0, 1, At, B1); PG8_BAR; PG8_SCHED;
            PG8_LDA(At, 1, 1); PG8_STAGE(PG8_SB(1, 0), b3, voffB); PG8_STAGE(PG8_SB(1, 1), b3 + hstep, voffB); PG8_STAGE(PG8_SA(1, 0), a3, voffA);
            PG8_WAIT_V(8); PG8_WAIT_L(0); PG8_BAR; PG8_MMA(1, 0, At, B0); PG8_MMA(1, 1, At, B1); PG8_BAR; PG8_SCHED;
            } else {
            PG8_LDB(B0, 0, 0); PG8_SCHED; PG8_LDA(At, 0, 0); PG8_STAGE(PG8_SA(1, 1), a1 + hstepA, voffA);
            PG8_WAIT_L(8); PG8_BAR; PG8_WAIT_L(0); PG8_MMA(0, 0, At, B0); PG8_BAR; PG8_SCHED;
            PG8_LDB(B1, 0, 1); PG8_STAGE(PG8_SB(0, 0), b2, voffB);
            PG8_BAR; PG8_WAIT_L(0); PG8_MMA(0, 1, At, B1); PG8_BAR;
            PG8_LDA(At, 0, 1); PG8_STAGE(PG8_SA(0, 0), a2, voffA);
            PG8_BAR; PG8_WAIT_L(0); PG8_MMA(1, 0, At, B0); PG8_BAR; PG8_SCHED;
            PG8_STAGE(PG8_SB(0, 1), b2 + hstep, voffB);
            PG8_WAIT_V(6); PG8_BAR; PG8_MMA(1, 1, At, B1); PG8_BAR;
            PG8_LDB(B0, 1, 0); PG8_SCHED; PG8_LDA(At, 1, 0); PG8_STAGE(PG8_SA(0, 1), a2 + hstepA, voffA);
            PG8_WAIT_L(8); PG8_BAR; PG8_WAIT_L(0); PG8_MMA(0, 0, At, B0); PG8_BAR; PG8_SCHED;
            PG8_LDB(B1, 1, 1); PG8_STAGE(PG8_SB(1, 0), b3, voffB);
            PG8_BAR; PG8_WAIT_L(0); PG8_MMA(0, 1, At, B1); PG8_BAR;
            PG8_LDA(At, 1, 1); PG8_STAGE(PG8_SA(1, 0), a3, voffA);
            PG8_BAR; PG8_WAIT_L(0); PG8_MMA(1, 0, At, B0); PG8_BAR; PG8_SCHED;
            PG8_STAGE(PG8_SB(1, 1), b3 + hstep, voffB);
            PG8_WAIT_V(6); PG8_BAR; PG8_MMA(1, 1, At, B1); PG8_BAR;
            }
        }
        if constexpr (ALIGN_EPI) { if (wr == 0) PG8_BAR; }
        if constexpr (!Epi::AFTER_DRAIN) { int tl_ = tid; asm volatile("" : "+v"(tl_)); E(acc, cur, wr, wc, tl_ & 15, (tl_ & 63) >> 4); S.done(cur); }
        if (!has_next) break;
#pragma unroll
        for (int a = 0; a < 2; ++a)
#pragma unroll
            for (int b = 0; b < 2; ++b)
#pragma unroll
                for (int m = 0; m < 4; ++m)
#pragma unroll
                    for (int n = 0; n < 2; ++n) acc[a][b][m][n] = (f32x4){0.f, 0.f, 0.f, 0.f};
        cur = nxt; cA = nA; cB = nB; ++ui;
        if constexpr (ALIGN_EPI) { if (wr == 1) PG8_BAR; }
    }
    PG8_WAIT_V(0);
    if constexpr (!ALIGN_EPI) { if (wr == 0) PG8_BAR; }
    PG8_BAR;
    if constexpr (Epi::AFTER_DRAIN) { E.fused(acc, cur, wr, wc, fr, fq, lds, wid, lane); S.done(cur); }
#undef PG8_SA
#undef PG8_SB
#undef PG8_STAGE
#undef PG8_LDA
#undef PG8_LDB
#undef PG8_MMA
#undef PG8_WAIT_V
#undef PG8_WAIT_L
#undef PG8_BAR
#undef PG8_SCHED
}
}
namespace pg8 {
struct OrderMap {
    __device__ __forceinline__ static bool map(int i, int G, int c, int nM, int nN, int& pm, int& pn) {
        const int nwg = nM * nN; const long L = (long)i * G + c; if (L >= nwg) return false;
        int wgid = (int)L; { const int q = nwg / NXCD, r = nwg % NXCD, xcd = wgid % NXCD, off = wgid / NXCD; wgid = (xcd < r ? xcd * (q + 1) : r * (q + 1) + (xcd - r) * q) + off; }
        const int nig = WGM * nN, gid = wgid / nig, fm = gid * WGM, gsz = (nM - fm) < WGM ? (nM - fm) : WGM;
        pm = fm + ((wgid % nig) % gsz); pn = (wgid % nig) / gsz; return true;
    }
};
struct DenseOrder {
    const char* A; const char* B; int nM, nN, G, c; size_t tstepA, tstepB;
    __device__ __forceinline__ bool next(int i, Unit& u) const { int pm, pn; if (!OrderMap::map(i, G, c, nM, nN, pm, pn)) return false; u.pm = pm; u.pn = pn; u.aux = 0; u.a = A + (size_t)pm * tstepA; u.b = B + (size_t)pn * tstepB; return true; }
    __device__ __forceinline__ void a_ready(const Unit&) const {}
    __device__ __forceinline__ void done(const Unit&) const {}
};
struct MoeOrder {
    const char* A; const char* B; const PG8_LAS int* tile_e; int nM, nN, G, c; size_t tstep, estep;
    __device__ __forceinline__ bool next(int i, Unit& u) const { int pm, pn; if (!OrderMap::map(i, G, c, nM, nN, pm, pn)) return false; const int e = __builtin_amdgcn_readfirstlane(tile_e[pm]); u.pm = pm; u.pn = pn; u.aux = e;
        u.a = A + (size_t)pm * tstep; u.b = B + (size_t)e * estep + (size_t)pn * tstep; return true; }
    __device__ __forceinline__ void a_ready(const Unit&) const {}
    __device__ __forceinline__ void done(const Unit&) const {}
};
struct EpiStoreBf16 { static constexpr bool PERM = true, AFTER_DRAIN = false;
    bf16_t* O; int ldc; float ascale;
    __device__ __forceinline__ void operator()(const f32x4 (&acc)[2][2][4][2], const Unit& u, int wr, int wc, int fr, int fq) const {
        bf16_t* base = O + (size_t)(u.pm * BM + wr * 64 + fr) * ldc + u.pn * BM + wc * 32 + 8 * fq;
        float asc = ascale; asm volatile("" : "+v"(asc));
#pragma unroll
        for (int ai = 0; ai < 2; ++ai)
#pragma unroll
            for (int m = 0; m < 4; ++m) { bf16_t* rowp = base + (size_t)(ai * HALF + m * 16) * ldc;
#pragma unroll
                for (int bj = 0; bj < 2; ++bj) { const f32x4 v0 = acc[ai][bj][m][0] * asc, v1 = acc[ai][bj][m][1] * asc; u32x4 w;
                    w.x = cvt_pk_bf16(v0[0], v0[1]); w.y = cvt_pk_bf16(v0[2], v0[3]); w.z = cvt_pk_bf16(v1[0], v1[1]); w.w = cvt_pk_bf16(v1[2], v1[3]);
                    *(u32x4*)(rowp + bj * HALF) = w; } }
    }
};
struct EpiScaleBf16 { static constexpr bool PERM = true, AFTER_DRAIN = false;
    bf16_t* O; int ldc; const float* rs;
    __device__ __forceinline__ void operator()(const f32x4 (&acc)[2][2][4][2], const Unit& u, int wr, int wc, int fr, int fq) const {
        const int row0 = u.pm * BM + wr * 64 + fr; bf16_t* base = O + (size_t)row0 * ldc + u.pn * BM + wc * 32 + 8 * fq;
#pragma unroll
        for (int ai = 0; ai < 2; ++ai)
#pragma unroll
            for (int m = 0; m < 4; ++m) { bf16_t* rowp = base + (size_t)(ai * HALF + m * 16) * ldc; const float sc = rs[2 * (row0 + ai * HALF + m * 16)];
#pragma unroll
                for (int bj = 0; bj < 2; ++bj) { const f32x4 v0 = acc[ai][bj][m][0] * sc, v1 = acc[ai][bj][m][1] * sc; u32x4 w;
                    w.x = cvt_pk_bf16(v0[0], v0[1]); w.y = cvt_pk_bf16(v0[2], v0[3]); w.z = cvt_pk_bf16(v1[0], v1[1]); w.w = cvt_pk_bf16(v1[2], v1[3]);
                    *(u32x4*)(rowp + bj * HALF) = w; } }
    }
};
struct EpiResid { static constexpr bool PERM = true, AFTER_DRAIN = false;
    const float* src_lat; const float* src_ctx; float* out; const float* mod_g1; float ascale;
    __device__ __forceinline__ void operator()(const f32x4 (&acc)[2][2][4][2], const Unit& u, int wr, int wc, int fr, int fq) const {
        const int row_t = u.pm * BM; const int mrow = row_t < NLAT ? row_t / SEQ : NB;
        const float* g = mod_g1 + (size_t)mrow * 6144 + u.pn * BM + wc * 32 + 8 * fq;
        const float* sb = (row_t < NLAT ? src_lat + (size_t)row_t * 1024 : src_ctx + (size_t)(row_t - NLAT) * 1024) + u.pn * BM + wc * 32 + 8 * fq;
        float* ob = out + (size_t)row_t * 1024 + u.pn * BM + wc * 32 + 8 * fq;
        f32x4 gv[2][2];
#pragma unroll
        for (int bj = 0; bj < 2; ++bj)
#pragma unroll
            for (int n = 0; n < 2; ++n) gv[bj][n] = *(const f32x4*)(g + bj * HALF + 4 * n) * ascale;
#pragma unroll
        for (int ai = 0; ai < 2; ++ai)
#pragma unroll
            for (int m = 0; m < 4; ++m) { const size_t off = (size_t)(wr * 64 + fr + ai * HALF + m * 16) * 1024;
#pragma unroll
                for (int bj = 0; bj < 2; ++bj)
#pragma unroll
                    for (int n = 0; n < 2; ++n) { const f32x4 sv = *(const f32x4*)(sb + off + bj * HALF + 4 * n); *(f32x4*)(ob + off + bj * HALF + 4 * n) = sv + gv[bj][n] * acc[ai][bj][m][n]; }
                asm volatile("" ::: "memory"); }
    }
};
__device__ __forceinline__ float swiglu1(float g, float l, float c7, float cn) {
    const float glu = fminf(g, c7), lin = fminf(fmaxf(l, -c7), c7);
    const float sg = __builtin_amdgcn_rcpf(1.0f + __builtin_amdgcn_exp2f(cn * glu));
    return glu * sg * (lin + 1.0f);
}
struct EpiSwiglu { static constexpr bool PERM = true, AFTER_DRAIN = false;
    bf16_t* O; const float* bias; float ascale;
    __device__ __forceinline__ void operator()(const f32x4 (&acc)[2][2][4][2], const Unit& u, int wr, int wc, int fr, int fq) const {
        const int col0 = u.pn * BM + wc * 32 + 8 * fq; const float* b = bias + (size_t)u.aux * 2048 + col0;
        float c7 = 7.0f, cn = -1.702f * 1.4426950408889634f; asm volatile("" : "+v"(c7), "+v"(cn));
        bf16_t* base = O + (size_t)(u.pm * BM + wr * 64 + fr) * 1024 + (col0 >> 1);
        f32x4 bv[2][2];
#pragma unroll
        for (int bj = 0; bj < 2; ++bj)
#pragma unroll
            for (int n = 0; n < 2; ++n) bv[bj][n] = *(const f32x4*)(b + bj * HALF + 4 * n);
#pragma unroll
        for (int ai = 0; ai < 2; ++ai)
#pragma unroll
            for (int m = 0; m < 4; ++m) { bf16_t* rowp = base + (size_t)(ai * HALF + m * 16) * 1024;
#pragma unroll
                for (int bj = 0; bj < 2; ++bj) { const f32x4 v0 = acc[ai][bj][m][0] * ascale + bv[bj][0], v1 = acc[ai][bj][m][1] * ascale + bv[bj][1];
                    uint2 w; w.x = cvt_pk_bf16(swiglu1(v0[0], v0[1], c7, cn), swiglu1(v0[2], v0[3], c7, cn)); w.y = cvt_pk_bf16(swiglu1(v1[0], v1[1], c7, cn), swiglu1(v1[2], v1[3], c7, cn));
                    *(uint2*)(rowp + bj * (HALF / 2)) = w; } }
    }
};
struct EpiSwigluF8 { static constexpr bool PERM = true, AFTER_DRAIN = false;
    unsigned char* O; const float* bias;
    __device__ __forceinline__ void operator()(const f32x4 (&acc)[2][2][4][2], const Unit& u, int wr, int wc, int fr, int fq) const {
        const int col0 = u.pn * BM + wc * 32 + 8 * fq; const float* b = bias + (size_t)u.aux * 2048 + col0;
        float c7 = 7.0f, cn = -1.702f * 1.4426950408889634f, c32 = 0.03125f; asm volatile("" : "+v"(c7), "+v"(cn), "+v"(c32));
        unsigned char* base = O + (size_t)(u.pm * BM + wr * 64 + fr) * 1024 + (col0 >> 1);
        f32x4 bv[2][2];
#pragma unroll
        for (int bj = 0; bj < 2; ++bj)
#pragma unroll
            for (int n = 0; n < 2; ++n) bv[bj][n] = *(const f32x4*)(b + bj * HALF + 4 * n);
#pragma unroll
        for (int ai = 0; ai < 2; ++ai)
#pragma unroll
            for (int m = 0; m < 4; ++m) { unsigned char* rowp = base + (size_t)(ai * HALF + m * 16) * 1024;
#pragma unroll
                for (int bj = 0; bj < 2; ++bj) { const f32x4 v0 = acc[ai][bj][m][0] * c32 + bv[bj][0], v1 = acc[ai][bj][m][1] * c32 + bv[bj][1];
                    int w = __builtin_amdgcn_cvt_pk_fp8_f32(swiglu1(v0[0], v0[1], c7, cn), swiglu1(v0[2], v0[3], c7, cn), 0, false); w = __builtin_amdgcn_cvt_pk_fp8_f32(swiglu1(v1[0], v1[1], c7, cn), swiglu1(v1[2], v1[3], c7, cn), w, true);
                    *(int*)(rowp + bj * (HALF / 2)) = w; } }
    }
};
struct EpiBiasF8 { static constexpr bool PERM = true, AFTER_DRAIN = false;
    unsigned char* O; const float* bias; float ascale;
    __device__ __forceinline__ void operator()(const f32x4 (&acc)[2][2][4][2], const Unit& u, int wr, int wc, int fr, int fq) const {
        const int col0 = u.pn * BM + wc * 32 + 8 * fq; const float* b = bias + (size_t)u.aux * 1024 + col0;
        float asc = ascale; asm volatile("" : "+v"(asc));
        unsigned char* base = O + (size_t)(u.pm * BM + wr * 64 + fr) * 1024 + col0;
        f32x4 bv[2][2];
#pragma unroll
        for (int bj = 0; bj < 2; ++bj)
#pragma unroll
            for (int n = 0; n < 2; ++n) bv[bj][n] = *(const f32x4*)(b + bj * HALF + 4 * n);
#pragma unroll
        for (int ai = 0; ai < 2; ++ai)
#pragma unroll
            for (int m = 0; m < 4; ++m) { unsigned char* rowp = base + (size_t)(ai * HALF + m * 16) * 1024;
#pragma unroll
                for (int bj = 0; bj < 2; ++bj) { const f32x4 v0 = acc[ai][bj][m][0] * asc + bv[bj][0], v1 = acc[ai][bj][m][1] * asc + bv[bj][1];
                    int lo = __builtin_amdgcn_cvt_pk_fp8_f32(v0[0], v0[1], 0, false); lo = __builtin_amdgcn_cvt_pk_fp8_f32(v0[2], v0[3], lo, true);
                    int hi = __builtin_amdgcn_cvt_pk_fp8_f32(v1[0], v1[1], 0, false); hi = __builtin_amdgcn_cvt_pk_fp8_f32(v1[2], v1[3], hi, true);
                    *(int2*)(rowp + bj * HALF) = make_int2(lo, hi); } }
    }
};
struct EpiBiasBf16 { static constexpr bool PERM = true, AFTER_DRAIN = false;
    bf16_t* O; const float* bias; float ascale;
    __device__ __forceinline__ void operator()(const f32x4 (&acc)[2][2][4][2], const Unit& u, int wr, int wc, int fr, int fq) const {
        const int col0 = u.pn * BM + wc * 32 + 8 * fq; const float* b = bias + (size_t)u.aux * 1024 + col0;
        float asc = ascale; asm volatile("" : "+v"(asc));
        bf16_t* base = O + (size_t)(u.pm * BM + wr * 64 + fr) * 1024 + col0;
        f32x4 bv[2][2];
#pragma unroll
        for (int bj = 0; bj < 2; ++bj)
#pragma unroll
            for (int n = 0; n < 2; ++n) bv[bj][n] = *(const f32x4*)(b + bj * HALF + 4 * n);
#pragma unroll
        for (int ai = 0; ai < 2; ++ai)
#pragma unroll
            for (int m = 0; m < 4; ++m) { bf16_t* rowp = base + (size_t)(ai * HALF + m * 16) * 1024;
#pragma unroll
                for (int bj = 0; bj < 2; ++bj) { const f32x4 v0 = acc[ai][bj][m][0] * asc + bv[bj][0], v1 = acc[ai][bj][m][1] * asc + bv[bj][1]; u32x4 w;
                    w.x = cvt_pk_bf16(v0[0], v0[1]); w.y = cvt_pk_bf16(v0[2], v0[3]); w.z = cvt_pk_bf16(v1[0], v1[1]); w.w = cvt_pk_bf16(v1[2], v1[3]);
                    *(u32x4*)(rowp + bj * HALF) = w; } }
    }
};
}
__device__ __forceinline__ unsigned pk2(float lo, float hi) { return (unsigned)f2bf(lo) | ((unsigned)f2bf(hi) << 16); }
__device__ __forceinline__ void transpose_item(const float* __restrict__ W, int K, int N, bf16_t* __restrict__ WT, LAS float* scr, int item, int lane, const float* rowscale = nullptr, float cscale = 1.0f, int cs_ncols = 1 << 30) {
    const int nblk = N / 32, kb = item / nblk, nb = item % nblk, k0 = 64 * kb, n0 = 32 * nb;
    const float cs = n0 < cs_ncols ? cscale : 1.0f;
#pragma unroll 8
    for (int i = 0; i < 32; ++i) { const int kk = 2 * i + (lane >> 5); float w = W[(size_t)(k0 + kk) * N + n0 + (lane & 31)]; if (rowscale) w *= rowscale[k0 + kk]; scr[kk * 33 + (lane & 31)] = w * cs; }
    asm volatile("s_waitcnt lgkmcnt(0)" ::: "memory");
    const int c = lane & 7;
#pragma unroll
    for (int j = 0; j < 4; ++j) { const int n = (lane >> 3) + 8 * j; const LAS float* sp = scr + (8 * c) * 33 + n;
        uint4 o; o.x = pk2(sp[0 * 33], sp[1 * 33]); o.y = pk2(sp[2 * 33], sp[3 * 33]); o.z = pk2(sp[4 * 33], sp[5 * 33]); o.w = pk2(sp[6 * 33], sp[7 * 33]);
        *(uint4*)(WT + (size_t)(n0 + n) * K + k0 + 8 * c) = o; }
    asm volatile("s_waitcnt lgkmcnt(0)" ::: "memory");
}

__device__ __forceinline__ void transpose_item_f8(const float* __restrict__ W, int K, int N, unsigned char* __restrict__ WT, LAS float* scr, int item, int lane, float cscale = 1.0f, int cs_ncols = 1 << 30) {
    const int nblk = N / 32, kb = item / nblk, nb = item % nblk, k0 = 64 * kb, n0 = 32 * nb;
    const float cs = 32.0f * (n0 < cs_ncols ? cscale : 1.0f);
#pragma unroll 8
    for (int i = 0; i < 32; ++i) { const int kk = 2 * i + (lane >> 5); scr[kk * 33 + (lane & 31)] = W[(size_t)(k0 + kk) * N + n0 + (lane & 31)] * cs; }
    asm volatile("s_waitcnt lgkmcnt(0)" ::: "memory");
    const int c = lane & 7;
#pragma unroll
    for (int j = 0; j < 4; ++j) { const int n = (lane >> 3) + 8 * j; const LAS float* sp = scr + (8 * c) * 33 + n;
        int lo = __builtin_amdgcn_cvt_pk_fp8_f32(sp[0 * 33], sp[1 * 33], 0, false); lo = __builtin_amdgcn_cvt_pk_fp8_f32(sp[2 * 33], sp[3 * 33], lo, true);
        int hi = __builtin_amdgcn_cvt_pk_fp8_f32(sp[4 * 33], sp[5 * 33], 0, false); hi = __builtin_amdgcn_cvt_pk_fp8_f32(sp[6 * 33], sp[7 * 33], hi, true);
        *(int2*)(WT + (size_t)(n0 + n) * K + k0 + 8 * c) = make_int2(lo, hi); }
    asm volatile("s_waitcnt lgkmcnt(0)" ::: "memory");
}
template <bool F8OUT>
__device__ __forceinline__ void transpose_item64(const float* __restrict__ W, int K, int N, void* __restrict__ WT, LAS float* scr, int item, int lane, const float* rowscale = nullptr, float cscale = 1.0f) {
    const int nblk = N / 64, kb = item / nblk, nb = item % nblk, k0 = 64 * kb, n0 = 64 * nb;
    const float cs = cscale * (F8OUT ? 32.0f : 1.0f);
    float4 wv[16];
#pragma unroll
    for (int i = 0; i < 16; ++i) wv[i] = *(const float4*)(W + (size_t)(k0 + 4 * i + (lane >> 4)) * N + n0 + 4 * (lane & 15));
#pragma unroll
    for (int i = 0; i < 16; ++i) { const int kk = 4 * i + (lane >> 4); const float4 w = wv[i];
        const float rs = rowscale ? rowscale[k0 + kk] * cs : cs; LAS float* d = scr + kk * 65 + 4 * (lane & 15); d[0] = w.x * rs; d[1] = w.y * rs; d[2] = w.z * rs; d[3] = w.w * rs; }
    asm volatile("s_waitcnt lgkmcnt(0)" ::: "memory");
    const int c = lane & 7;
#pragma unroll
    for (int j = 0; j < 8; ++j) { const int n = (lane >> 3) + 8 * j; const LAS float* sp = scr + (8 * c) * 65 + n;
        if constexpr (F8OUT) { int lo = __builtin_amdgcn_cvt_pk_fp8_f32(sp[0 * 65], sp[1 * 65], 0, false); lo = __builtin_amdgcn_cvt_pk_fp8_f32(sp[2 * 65], sp[3 * 65], lo, true);
            int hi = __builtin_amdgcn_cvt_pk_fp8_f32(sp[4 * 65], sp[5 * 65], 0, false); hi = __builtin_amdgcn_cvt_pk_fp8_f32(sp[6 * 65], sp[7 * 65], hi, true);
            *(int2*)((unsigned char*)WT + (size_t)(n0 + n) * K + k0 + 8 * c) = make_int2(lo, hi); }
        else { uint4 o; o.x = pk2(sp[0 * 65], sp[1 * 65]); o.y = pk2(sp[2 * 65], sp[3 * 65]); o.z = pk2(sp[4 * 65], sp[5 * 65]); o.w = pk2(sp[6 * 65], sp[7 * 65]);
            *(uint4*)((bf16_t*)WT + (size_t)(n0 + n) * K + k0 + 8 * c) = o; } }
    asm volatile("s_waitcnt lgkmcnt(0)" ::: "memory");
}
namespace fa {
using bf16x8 = __attribute__((ext_vector_type(8))) short;
using s16x4  = __attribute__((ext_vector_type(4))) short;
using f32x16 = __attribute__((ext_vector_type(16))) float;
using u32x4  = __attribute__((ext_vector_type(4))) unsigned;
constexpr int QBLK = 32, KVBLK = 64, NW = 8;
constexpr int SHM_V = KVBLK * 128 * 2, SHM_K = KVBLK * 128 * 2, SHM_ATTN = 2 * SHM_V + 2 * SHM_K + NW * 64 * 4;
constexpr float LOG2E = 1.4426950408889634f, THR = 8.0f, NEGS = -1.0e30f;
#define FA_KSWZ(row, colB) ((row) * 256 + ((colB) ^ (((row) & 7) << 4)))
#define FA_SBAR() __builtin_amdgcn_sched_barrier(0)
__device__ __forceinline__ int crow(int r, int hi) { return (r & 3) + 8 * (r >> 2) + 4 * hi; }
__device__ __forceinline__ unsigned cvtpk(float lo, float hi) { unsigned r; asm volatile("v_cvt_pk_bf16_f32 %0, %1, %2" : "=v"(r) : "v"(lo), "v"(hi)); return r; }
__device__ __forceinline__ void partialSM(f32x16& p0, f32x16& p1, float& m_reg, float& mn, float& alpha) {
  float pmax = p0[0];
#pragma unroll
  for (int r = 1; r < 16; ++r) pmax = fmaxf(pmax, p0[r]);
#pragma unroll
  for (int r = 0; r < 16; ++r) pmax = fmaxf(pmax, p1[r]);
  { auto rr = __builtin_amdgcn_permlane32_swap(__float_as_uint(pmax), __float_as_uint(pmax), false, false);
    pmax = fmaxf(__uint_as_float(rr[0]), __uint_as_float(rr[1])); }
  if (__builtin_expect(__all(pmax - m_reg <= THR), 1)) { mn = m_reg; alpha = 1.f; }
  else { mn = fmaxf(m_reg, pmax); alpha = __builtin_amdgcn_exp2f((m_reg - mn) * LOG2E); m_reg = mn; }
  const float mnC = -mn * LOG2E;
#pragma unroll
  for (int r = 0; r < 16; ++r) p0[r] = fmaf(p0[r], LOG2E, mnC);
#pragma unroll
  for (int r = 0; r < 16; ++r) p1[r] = fmaf(p1[r], LOG2E, mnC);
#pragma unroll
  for (int r = 0; r < 16; ++r) p0[r] = __builtin_amdgcn_exp2f(p0[r]);
}
__device__ __forceinline__ void finishSM(f32x16& p0, f32x16& p1, float alpha, float& l_reg, bf16x8& pa0, bf16x8& pa1, bf16x8& pa2, bf16x8& pa3) {
#pragma unroll
  for (int r = 0; r < 16; ++r) p1[r] = __builtin_amdgcn_exp2f(p1[r]);
  float ps = 0;
#pragma unroll
  for (int r = 0; r < 16; ++r) ps += p0[r];
#pragma unroll
  for (int r = 0; r < 16; ++r) ps += p1[r];
  { auto rr = __builtin_amdgcn_permlane32_swap(__float_as_uint(ps), __float_as_uint(ps), false, false);
    ps = __uint_as_float(rr[0]) + __uint_as_float(rr[1]); }
  l_reg = l_reg * alpha + ps;
#define FA_PK4(P, BASE, OUT) do { unsigned a0 = cvtpk(P[BASE + 0], P[BASE + 1]), a1 = cvtpk(P[BASE + 2], P[BASE + 3]);   \
    unsigned b0 = cvtpk(P[BASE + 4], P[BASE + 5]), b1 = cvtpk(P[BASE + 6], P[BASE + 7]);                              \
    auto r0 = __builtin_amdgcn_permlane32_swap(a0, b0, false, false); auto r1 = __builtin_amdgcn_permlane32_swap(a1, b1, false, false); \
    u32x4 w = {r0[0], r1[0], r0[1], r1[1]}; OUT = *reinterpret_cast<bf16x8*>(&w); } while (0)
  FA_PK4(p0, 0, pa0); FA_PK4(p0, 8, pa1); FA_PK4(p1, 0, pa2); FA_PK4(p1, 8, pa3);
#undef FA_PK4
}
template <int NQ> __device__ __forceinline__ void qkt(f32x16& p0, f32x16& p1, const char* Ks, const bf16x8* qr, int r32, int hi) {
  p0 = f32x16{}; p1 = f32x16{};
#pragma unroll
  for (int d0 = 0; d0 < NQ; ++d0) { const int cb = (d0 * 16 + hi * 8) * 2;
    const bf16x8 b0 = *reinterpret_cast<const bf16x8*>(Ks + FA_KSWZ(r32, cb));
    const bf16x8 b1 = *reinterpret_cast<const bf16x8*>(Ks + FA_KSWZ(32 + r32, cb));
    p0 = __builtin_amdgcn_mfma_f32_32x32x16_bf16(b0, qr[d0], p0, 0, 0, 0);
    p1 = __builtin_amdgcn_mfma_f32_32x32x16_bf16(b1, qr[d0], p1, 0, 0, 0); }
}
__device__ __forceinline__ int v_st(int k, int c) { const int kk = (k & ~0xC) | ((k & 4) << 1) | ((k & 8) >> 1); return ((kk >> 3) * 4 + (c >> 5)) * 512 + ((kk & 7) * 32 + (c & 31)) * 2; }
__device__ __forceinline__ int v_rd_base(int lane) { return ((lane & 3) << 3) | (((lane >> 2) & 3) << 6) | (((lane >> 4) & 1) << 5) | (((lane >> 5) & 1) << 8); }
constexpr int v_rd_off(int d0, int ks, int half) { return d0 * 512 + ks * 4096 + half * 2048; }
template <int OFF> __device__ __forceinline__ s16x4 tr_read(int vb) {
  s16x4 r; asm volatile("ds_read_b64_tr_b16 %0, %1 offset:%2" : "=&v"(r) : "v"(vb), "i"(OFF) : "memory"); return r;
}
template <int D0> __device__ __forceinline__ void pv_one(f32x16& od, int vb, bf16x8 pa0, bf16x8 pa1, bf16x8 pa2, bf16x8 pa3) {
  const s16x4 l0 = tr_read<v_rd_off(D0, 0, 0)>(vb), h0 = tr_read<v_rd_off(D0, 0, 1)>(vb), l1 = tr_read<v_rd_off(D0, 1, 0)>(vb), h1 = tr_read<v_rd_off(D0, 1, 1)>(vb);
  const s16x4 l2 = tr_read<v_rd_off(D0, 2, 0)>(vb), h2 = tr_read<v_rd_off(D0, 2, 1)>(vb), l3 = tr_read<v_rd_off(D0, 3, 0)>(vb), h3 = tr_read<v_rd_off(D0, 3, 1)>(vb);
  asm volatile("s_waitcnt lgkmcnt(0)" ::: "memory"); FA_SBAR();
#define FA_PK(L, H) (bf16x8){L[0], L[1], L[2], L[3], H[0], H[1], H[2], H[3]}
  od = __builtin_amdgcn_mfma_f32_32x32x16_bf16(pa0, FA_PK(l0, h0), od, 0, 0, 0);
  od = __builtin_amdgcn_mfma_f32_32x32x16_bf16(pa1, FA_PK(l1, h1), od, 0, 0, 0);
  od = __builtin_amdgcn_mfma_f32_32x32x16_bf16(pa2, FA_PK(l2, h2), od, 0, 0, 0);
  od = __builtin_amdgcn_mfma_f32_32x32x16_bf16(pa3, FA_PK(l3, h3), od, 0, 0, 0);
#undef FA_PK
}
template <int NV> __device__ __forceinline__ void pv_all(f32x16* o, int vb, bf16x8 pa0, bf16x8 pa1, bf16x8 pa2, bf16x8 pa3) {
  pv_one<0>(o[0], vb, pa0, pa1, pa2, pa3); pv_one<1>(o[1], vb, pa0, pa1, pa2, pa3);
  if constexpr (NV == 4) { pv_one<2>(o[2], vb, pa0, pa1, pa2, pa3); pv_one<3>(o[3], vb, pa0, pa1, pa2, pa3); }
}
__device__ __forceinline__ void wmask(f32x16& p0, f32x16& p1, int dq4) {
#pragma unroll
  for (int r = 0; r < 16; ++r) { const int d = dq4 + (r & 3) + 8 * (r >> 2); if ((unsigned)(d + 128) > 256u) p0[r] = NEGS; if ((unsigned)(d + 32 + 128) > 256u) p1[r] = NEGS; }
}

struct Unit {
  const bf16_t* Q; const bf16_t* K; const bf16_t* V; bf16_t* O;
  int rowa, nta, rowb, ntb;
  int window, qpos0, kposb0;
  float sink; int has_sink;
  const bf16_t* K2;
  const float* tab; int pos0;
  const float* qg;
};
template <int DQ, int DV, int LDQ, int LDK, int LDV, int LDO, bool WIN, int RD0, int RH, bool QNORM, bool KSPLIT, bool O8>
__device__ __forceinline__ void attn_unit(const int tid, const Unit& U, char* lds) {
  constexpr int NQ = DQ / 16, NV = DV / 32;
  const int wid = tid >> 6, lane = tid & 63, r32 = lane & 31, hi = lane >> 5;
  char* V_lds = lds; char* K_lds = lds + 2 * SHM_V;
  float* ws = (float*)(lds + 2 * SHM_V + 2 * SHM_K) + wid * 64; float* li_l = ws; float* al_l = ws + 32;
  float m_reg = -1e30f, l_reg = 0; f32x16 o[NV]; bf16x8 qr[NQ];
#pragma unroll
  for (int d = 0; d < NV; ++d) o[d] = f32x16{};
  const bf16_t* Qw = U.Q + (size_t)(wid * QBLK + r32) * LDQ + hi * 8;
#pragma unroll
  for (int d0 = 0; d0 < NQ; ++d0) qr[d0] = *reinterpret_cast<const bf16x8*>(Qw + d0 * 16);
  if constexpr (QNORM || RH > 0) {
    float qf[NQ][8];
#pragma unroll
    for (int d0 = 0; d0 < NQ; ++d0)
#pragma unroll
      for (int j = 0; j < 8; ++j) qf[d0][j] = __uint_as_float(((unsigned)(unsigned short)qr[d0][j]) << 16);
    if constexpr (QNORM) {
      float ss = 0.f;
#pragma unroll
      for (int d0 = 0; d0 < NQ; ++d0)
#pragma unroll
        for (int j = 0; j < 8; ++j) ss = fmaf(qf[d0][j], qf[d0][j], ss);
      { auto rr = __builtin_amdgcn_permlane32_swap(__float_as_uint(ss), __float_as_uint(ss), false, false); ss = __uint_as_float(rr[0]) + __uint_as_float(rr[1]); }
      const float ri = 1.0f / sqrtf(ss * (1.0f / DQ) + 1e-6f);
#pragma unroll
      for (int d0 = 0; d0 < NQ; ++d0) { const float4 g0 = *(const float4*)(U.qg + 16 * d0 + 8 * hi), g1 = *(const float4*)(U.qg + 16 * d0 + 8 * hi + 4);
        qf[d0][0] *= ri * g0.x; qf[d0][1] *= ri * g0.y; qf[d0][2] *= ri * g0.z; qf[d0][3] *= ri * g0.w; qf[d0][4] *= ri * g1.x; qf[d0][5] *= ri * g1.y; qf[d0][6] *= ri * g1.z; qf[d0][7] *= ri * g1.w; }
    }
    if constexpr (RH > 0) { if (U.tab) {
      const float4* tb = (const float4*)(U.tab + ((size_t)(U.pos0 + wid * QBLK + r32) * (RH * 16) + 8 * hi) * 2);
#pragma unroll
      for (int dd = 0; dd < RH; ++dd) {
#pragma unroll
        for (int j2 = 0; j2 < 4; ++j2) { const float4 t = tb[dd * 8 + j2];
          { const float x1 = qf[RD0 + dd][2 * j2], x2 = qf[RD0 + RH + dd][2 * j2]; qf[RD0 + dd][2 * j2] = x1 * t.x - x2 * t.y; qf[RD0 + RH + dd][2 * j2] = x2 * t.x + x1 * t.y; }
          { const float x1 = qf[RD0 + dd][2 * j2 + 1], x2 = qf[RD0 + RH + dd][2 * j2 + 1]; qf[RD0 + dd][2 * j2 + 1] = x1 * t.z - x2 * t.w; qf[RD0 + RH + dd][2 * j2 + 1] = x2 * t.z + x1 * t.w; } } } } }
#pragma unroll
    for (int d0 = 0; d0 < NQ; ++d0) { u32x4 w = {cvtpk(qf[d0][0], qf[d0][1]), cvtpk(qf[d0][2], qf[d0][3]), cvtpk(qf[d0][4], qf[d0][5]), cvtpk(qf[d0][6], qf[d0][7])}; qr[d0] = *reinterpret_cast<bf16x8*>(&w); }
  }
  const int sr = tid >> 4, sc = (tid & 15) * 8, vst0 = v_st(sr, sc), vst1 = v_st(32 + sr, sc);
  const int sck = sc < DQ - 8 ? sc : DQ - 8, scv = sc < DV - 8 ? sc : DV - 8;
  const int vb0 = (int)(uintptr_t)V_lds + v_rd_base(lane);
  const int nta = U.nta, NT = U.nta + U.ntb;
  const unsigned kof0 = (unsigned)((sr * LDK + sck) * 2), kof1 = kof0 + 32u * LDK * 2u, vof0 = (unsigned)((sr * LDV + scv) * 2), vof1 = vof0 + 32u * LDV * 2u;
  constexpr int LDK2 = 1536;
  const int ci = tid & 15; const bool ksec = KSPLIT && ci >= 8; const int kld = ksec ? LDK2 : LDK;
  const bf16_t* kp0 = ksec ? U.K2 + (size_t)sr * LDK2 + ((ci < 11 ? ci : 11) - 8) * 8 : U.K + (size_t)sr * LDK + ci * 8; const bf16_t* kp1 = kp0 + (size_t)32 * kld;
  (void)kof0; (void)kof1; (void)kp0; (void)kp1; (void)kld;
  struct { bf16x8 vs0, vs1, ks0, ks1; } sr_[2];
#define FA_KROW(j) ((j) < nta ? U.rowa + (j) * KVBLK : U.rowb + ((j) - nta) * KVBLK)
#define FA_SLOAD(i, j) do { const size_t k0_ = (size_t)(FA_KROW(j)); const char* kt_ = (const char*)U.K + k0_ * (LDK * 2); const char* vt_ = (const char*)U.V + k0_ * (LDV * 2); \
    sr_[i].vs0 = *reinterpret_cast<const bf16x8*>(vt_ + vof0); sr_[i].vs1 = *reinterpret_cast<const bf16x8*>(vt_ + vof1); \
    if constexpr (KSPLIT) { sr_[i].ks0 = *reinterpret_cast<const bf16x8*>(kp0 + k0_ * kld); sr_[i].ks1 = *reinterpret_cast<const bf16x8*>(kp1 + k0_ * kld); } \
    else { sr_[i].ks0 = *reinterpret_cast<const bf16x8*>(kt_ + kof0); sr_[i].ks1 = *reinterpret_cast<const bf16x8*>(kt_ + kof1); } } while (0)
#define FA_SWRITE(b, i) do { *(bf16x8*)(V_lds + (b) * SHM_V + vst0) = sr_[i].vs0; *(bf16x8*)(V_lds + (b) * SHM_V + vst1) = sr_[i].vs1; const int kc = sc * 2; \
    *(bf16x8*)(K_lds + (b) * SHM_K + FA_KSWZ(sr, kc)) = sr_[i].ks0; *(bf16x8*)(K_lds + (b) * SHM_K + FA_KSWZ(32 + sr, kc)) = sr_[i].ks1; } while (0)
#define FA_SWAIT() asm volatile("s_waitcnt vmcnt(4)" ::: "memory")
#define FA_RESC(a) do { if (__any((a) < 1.f)) { if (hi == 0) al_l[r32] = (a); asm volatile("s_waitcnt lgkmcnt(0)" ::: "memory"); \
    _Pragma("unroll") for (int d = 0; d < NV; ++d) _Pragma("unroll") for (int r = 0; r < 16; ++r) o[d][r] *= al_l[crow(r, hi)]; } } while (0)
  const int qw0 = U.qpos0 + wid * QBLK;
#define FA_MASK(P0, P1, t) do { if (WIN && U.window && (t) >= nta) { const int kb_ = U.kposb0 + ((t) - nta) * KVBLK; \
    if (kb_ + 63 - qw0 > 128 || qw0 + 31 - kb_ > 128) wmask(P0, P1, kb_ - (qw0 + r32) + 4 * hi); } } while (0)
  f32x16 pA0, pA1, pB0, pB1; float mnA, mnB, alA, alB; bf16x8 pa0, pa1, pa2, pa3;
  constexpr int SE = 0, SO = 1;
  FA_SLOAD(SE, 0); asm volatile("s_waitcnt vmcnt(0)" ::: "memory"); FA_SWRITE(0, SE); __syncthreads();
  qkt<NQ>(pA0, pA1, K_lds, qr, r32, hi); FA_MASK(pA0, pA1, 0); partialSM(pA0, pA1, m_reg, mnA, alA);
  FA_SLOAD(SO, 1); if (2 < NT) FA_SLOAD(SE, 2);
  FA_SWAIT(); FA_SWRITE(1, SO); __syncthreads();
  for (int j = 1; j + 1 < NT; j += 2) {
    FA_SBAR(); qkt<NQ>(pB0, pB1, K_lds + SHM_K, qr, r32, hi);
    finishSM(pA0, pA1, alA, l_reg, pa0, pa1, pa2, pa3); FA_SBAR();
    FA_SLOAD(SO, j + 2); FA_SBAR();
    pv_all<NV>(o, vb0, pa0, pa1, pa2, pa3); FA_MASK(pB0, pB1, j); partialSM(pB0, pB1, m_reg, mnB, alB);
    __syncthreads(); FA_SWAIT(); FA_SWRITE(0, SE);
    FA_RESC(alB); __syncthreads();
    FA_SBAR(); qkt<NQ>(pA0, pA1, K_lds, qr, r32, hi);
    finishSM(pB0, pB1, alB, l_reg, pa0, pa1, pa2, pa3); FA_SBAR();
    if (j + 3 < NT) FA_SLOAD(SE, j + 3); FA_SBAR();
    pv_all<NV>(o, vb0 + SHM_V, pa0, pa1, pa2, pa3); FA_MASK(pA0, pA1, j + 1); partialSM(pA0, pA1, m_reg, mnA, alA);
    __syncthreads(); FA_SWAIT(); FA_SWRITE(1, SO);
    FA_RESC(alA); __syncthreads();
  }
  FA_SBAR(); qkt<NQ>(pB0, pB1, K_lds + SHM_K, qr, r32, hi);
  finishSM(pA0, pA1, alA, l_reg, pa0, pa1, pa2, pa3); FA_SBAR();
  pv_all<NV>(o, vb0, pa0, pa1, pa2, pa3); FA_MASK(pB0, pB1, NT - 1); partialSM(pB0, pB1, m_reg, mnB, alB);
  __syncthreads(); FA_RESC(alB);
  finishSM(pB0, pB1, alB, l_reg, pa0, pa1, pa2, pa3); FA_SBAR();
  pv_all<NV>(o, vb0 + SHM_V, pa0, pa1, pa2, pa3);
  if (U.has_sink) l_reg += __builtin_amdgcn_exp2f((U.sink - m_reg) * LOG2E);
  if (hi == 0) li_l[r32] = l_reg;
  asm volatile("s_waitcnt lgkmcnt(0)" ::: "memory");
  __syncthreads();
  int lane2 = lane; asm volatile("" : "+v"(lane2));
  const int r32e = lane2 & 31, hie = lane2 >> 5;
  if constexpr (O8) {
    unsigned char* stg = (unsigned char*)(lds + wid * 8192);
    unsigned char* stw = stg + hie * 4 * DV + r32e;
#pragma unroll
    for (int r = 0; r < 16; ++r) { const int orow0 = (r & 3) + 8 * (r >> 2); const float rl = __builtin_amdgcn_rcpf(li_l[orow0 + 4 * hie]);
#pragma unroll
      for (int d0 = 0; d0 < NV; ++d0) stw[orow0 * DV + d0 * 32] = (unsigned char)(__builtin_amdgcn_cvt_pk_fp8_f32(o[d0][r] * rl, 0.f, 0, false) & 0xff); }
    asm volatile("s_waitcnt lgkmcnt(0)" ::: "memory");
    constexpr int CPR = DV / 16, RPI = 64 / CPR;
    const int erow = lane2 / CPR, ech = lane2 % CPR;
    unsigned char* Ow = (unsigned char*)U.O + (size_t)(wid * QBLK + erow) * LDO + ech * 16; const unsigned char* str = stg + erow * DV + ech * 16;
#pragma unroll
    for (int i = 0; i < 32 / RPI; ++i) { const u32x4 v = *(const u32x4*)(str + i * RPI * DV); *(u32x4*)(Ow + (size_t)(i * RPI) * LDO) = v; }
  } else {
  bf16_t* stg = (bf16_t*)(lds + wid * 8192);
  bf16_t* stw = stg + hie * 4 * DV + r32e;
#pragma unroll
  for (int r = 0; r < 16; ++r) { const int orow0 = (r & 3) + 8 * (r >> 2); const float rl = __builtin_amdgcn_rcpf(li_l[orow0 + 4 * hie]);
#pragma unroll
    for (int d0 = 0; d0 < NV; ++d0) stw[orow0 * DV + d0 * 32] = f2bf(o[d0][r] * rl); }
  asm volatile("s_waitcnt lgkmcnt(0)" ::: "memory");
  constexpr int CPR = DV / 8, RPI = 64 / CPR;
  const int erow = lane2 / CPR, ech = lane2 % CPR;
  bf16_t* Ow = U.O + (size_t)(wid * QBLK + erow) * LDO + ech * 8; const bf16_t* str = stg + erow * DV + ech * 8;
#pragma unroll
  for (int i = 0; i < 32 / RPI; ++i) { const u32x4 v = *(const u32x4*)(str + i * RPI * DV); *(u32x4*)(Ow + (size_t)(i * RPI) * LDO) = v; }
  }
  __syncthreads();
#undef FA_KROW
#undef FA_SLOAD
#undef FA_SWRITE
#undef FA_SWAIT
#undef FA_RESC
#undef FA_MASK
}
}

__device__ __forceinline__ void route_reduce(const float (&acc)[32], const int lane, const int el, const float rb, float (&tv)[4], int (&ti)[4]) {
    float a16[16], a8[8], a4[4], a2[2];
#pragma unroll
    for (int k = 0; k < 16; ++k) { const bool up = (lane & 32) != 0; const float keep = up ? acc[k + 16] : acc[k], send = up ? acc[k] : acc[k + 16]; a16[k] = keep + __shfl_xor(send, 32); }
#pragma unroll
    for (int k = 0; k < 8; ++k) { const bool up = (lane & 16) != 0; const float keep = up ? a16[k + 8] : a16[k], send = up ? a16[k] : a16[k + 8]; a8[k] = keep + __shfl_xor(send, 16); }
#pragma unroll
    for (int k = 0; k < 4; ++k) { const bool up = (lane & 8) != 0; const float keep = up ? a8[k + 4] : a8[k], send = up ? a8[k] : a8[k + 4]; a4[k] = keep + __shfl_xor(send, 8); }
#pragma unroll
    for (int k = 0; k < 2; ++k) { const bool up = (lane & 4) != 0; const float keep = up ? a4[k + 2] : a4[k], send = up ? a4[k] : a4[k + 2]; a2[k] = keep + __shfl_xor(send, 4); }
    float lg; { const bool up = (lane & 2) != 0; const float keep = up ? a2[1] : a2[0], send = up ? a2[0] : a2[1]; lg = keep + __shfl_xor(send, 2); }
    lg += __shfl_xor(lg, 1); lg += rb;
    unsigned key; { const unsigned u = __float_as_uint(lg); const unsigned ou = (u & 0x80000000u) ? ~u : (u | 0x80000000u); key = (ou & ~31u) | (unsigned)(31 - el); }
#pragma unroll
    for (int k = 0; k < 4; ++k) { unsigned bk = key;
#pragma unroll
        for (int o = 1; o < 64; o <<= 1) { const unsigned ok = (unsigned)__shfl_xor((int)bk, o); bk = ok > bk ? ok : bk; }
        const int bi = 31 - (int)(bk & 31u); const unsigned ou = bk & ~31u; const unsigned ub = (ou & 0x80000000u) ? (ou ^ 0x80000000u) : ~ou;
        tv[k] = __uint_as_float(ub); ti[k] = bi; if (el == bi) key = 0u; }
}

template <int CTRL> __device__ __forceinline__ float dpp_f32(const float x) { return __builtin_bit_cast(float, __builtin_amdgcn_update_dpp(0, __builtin_bit_cast(int, x), CTRL, 0xf, 0xf, true)); }
template <int CTRL> __device__ __forceinline__ unsigned dpp_u32(const unsigned x) { return (unsigned)__builtin_amdgcn_update_dpp(0, (int)x, CTRL, 0xf, 0xf, true); }
template <int M> __device__ __forceinline__ float xlane_f32(const float x) {
    if constexpr (M == 1) return dpp_f32<0xB1>(x);
    else if constexpr (M == 2) return dpp_f32<0x4E>(x);
    else if constexpr (M == 4) return dpp_f32<0x1B>(dpp_f32<0x141>(x));
    else return dpp_f32<0x128>(x);
}
template <int M> __device__ __forceinline__ unsigned xlane_u32(const unsigned x) {
    if constexpr (M == 1) return dpp_u32<0xB1>(x);
    else if constexpr (M == 2) return dpp_u32<0x4E>(x);
    else if constexpr (M == 4) return dpp_u32<0x1B>(dpp_u32<0x141>(x));
    else return dpp_u32<0x128>(x);
}
typedef unsigned u32x2_t __attribute__((ext_vector_type(2)));
__device__ __forceinline__ float half_sum32(float v) {
    v += xlane_f32<1>(v); v += xlane_f32<2>(v); v += xlane_f32<4>(v); v += xlane_f32<8>(v);
    const u32x2_t r = __builtin_amdgcn_permlane16_swap(__float_as_uint(v), __float_as_uint(v), false, false);
    return __uint_as_float(r[0]) + __uint_as_float(r[1]);
}
__device__ __forceinline__ void route_reduce32(const float (&acc)[32], const int l5, const float rb, float (&tv)[4], int (&ti)[4]) {
    float a16[16], a8[8], a4[4], a2[2];
#pragma unroll
    for (int k = 0; k < 16; ++k) { const u32x2_t r = __builtin_amdgcn_permlane16_swap(__float_as_uint(acc[k]), __float_as_uint(acc[k + 16]), false, false); a16[k] = __uint_as_float(r[0]) + __uint_as_float(r[1]); }
#pragma unroll
    for (int k = 0; k < 8; ++k) { const bool up = (l5 & 8) != 0; const float keep = up ? a16[k + 8] : a16[k], send = up ? a16[k] : a16[k + 8]; a8[k] = keep + xlane_f32<8>(send); }
#pragma unroll
    for (int k = 0; k < 4; ++k) { const bool up = (l5 & 4) != 0; const float keep = up ? a8[k + 4] : a8[k], send = up ? a8[k] : a8[k + 4]; a4[k] = keep + xlane_f32<4>(send); }
#pragma unroll
    for (int k = 0; k < 2; ++k) { const bool up = (l5 & 2) != 0; const float keep = up ? a4[k + 2] : a4[k], send = up ? a4[k] : a4[k + 2]; a2[k] = keep + xlane_f32<2>(send); }
    float lg; { const bool up = (l5 & 1) != 0; const float keep = up ? a2[1] : a2[0], send = up ? a2[0] : a2[1]; lg = keep + xlane_f32<1>(send); }
    lg += rb;
    unsigned key; { const unsigned u = __float_as_uint(lg); const unsigned ou = (u & 0x80000000u) ? ~u : (u | 0x80000000u); key = (ou & ~31u) | (unsigned)(31 - l5); }
#pragma unroll
    for (int k = 0; k < 4; ++k) { unsigned bk = key;
        { const unsigned ok = xlane_u32<1>(bk); bk = ok > bk ? ok : bk; } { const unsigned ok = xlane_u32<2>(bk); bk = ok > bk ? ok : bk; }
        { const unsigned ok = xlane_u32<4>(bk); bk = ok > bk ? ok : bk; } { const unsigned ok = xlane_u32<8>(bk); bk = ok > bk ? ok : bk; }
        { const u32x2_t r = __builtin_amdgcn_permlane16_swap(bk, bk, false, false); bk = r[0] > r[1] ? r[0] : r[1]; }
        const int bi = 31 - (int)(bk & 31u); const unsigned ou = bk & ~31u; const unsigned ub = (ou & 0x80000000u) ? (ou ^ 0x80000000u) : ~ou;
        tv[k] = __uint_as_float(ub); ti[k] = bi; if (l5 == bi) key = 0u; }
}

struct Params {
    const float *x, *c, *ctx, *c_ctx, *ada_w, *ada_b, *norm_mix_g, *norm_ffn_g, *ab_w_in, *mla_q_g, *mla_wq_b, *mla_kv_g, *mla_wkv_b, *swa_sink, *ab_w_out,
        *c_w_in, *c_q_g, *c_k_g, *c_w_out, *router_w, *router_b, *moe_w_in, *moe_b_in, *moe_w_out, *moe_b_out, *final_g;
    float* out; unsigned char* ws; int ph_lo, ph_hi;
};
__device__ __forceinline__ int mod_row_of(int r) { return r < NLAT ? r / SEQ : NB; }
__device__ __forceinline__ float rope_angle(int i, int quarter, int prow, int pcol) {
    const int ii = i < quarter ? i : i - quarter; const float inv = powf(10000.f, -(float)ii / (float)quarter);
    return (float)(i < quarter ? prow : pcol) * inv;
}

#ifndef OUTPROJ_F8
#define OUTPROJ_F8 1
#endif
#ifndef Y8_L1
#define Y8_L1 1
#endif
#ifndef Y8_L0
#define Y8_L0 1
#endif
#ifndef INPROJ_F8
#define INPROJ_F8 1
#endif
#ifndef MOE_F8_DOWN
#define MOE_F8_DOWN 1
#endif
#ifndef MOE_F8_L0
#define MOE_F8_L0 1
#endif
#ifndef MOE_F8_L1
#define MOE_F8_L1 1
#endif
constexpr int LDS_BYTES = 147456;
constexpr int LDS_MISC = 143360;
constexpr int N_PHASES = 21;

__global__ void __launch_bounds__(NTHR, 2) fwd_kernel(Params p) {
    extern __shared__ __attribute__((aligned(16))) unsigned char lds_raw[];
    float* ldsf = (float*)lds_raw;
    LAS unsigned* misc = (LAS unsigned*)(lds_raw + LDS_MISC + 320);
    const int wave0 = __builtin_amdgcn_readfirstlane((int)(threadIdx.x >> 6));
    const int G = gridDim.x, bid = blockIdx.x;
    const int NGW = G * 8;
    unsigned* ctl0 = (unsigned*)(p.ws + WS_CTL);
#define PHASE_PTRS \
    int tid = wave0 * 64 + (int)__builtin_amdgcn_mbcnt_hi(~0u, __builtin_amdgcn_mbcnt_lo(~0u, 0u)); asm volatile("" : "+v"(tid)); const int lane = tid & 63, wave = tid >> 6, gw = bid * 8 + wave; (void)lane; (void)gw; \
    size_t wsz_ = 0; asm volatile("" : "+s"(wsz_)); unsigned char* ws = p.ws + wsz_; \
    unsigned* ctl = (unsigned*)(ws + WS_CTL); (void)ctl; \
    float* MOD = (float*)(ws + WS_MOD); (void)MOD; \
    int* TOKE = (int*)(ws + WS_TOKE); int* TOKP = (int*)(ws + WS_TOKP); float* TOKG = (float*)(ws + WS_TOKG); (void)TOKE; (void)TOKP; (void)TOKG; \
    float* RINV = (float*)(ws + WS_RINV); (void)RINV; unsigned char* tabs = ws + WS_TAB; (void)tabs; \
    float* XR = (float*)(ws + WS_XR); (void)XR; \
    act_t* H = (act_t*)(ws + WS_H); (void)H; \
    unsigned char* big = ws + WS_BIG; \
    act_t* PRJ = (act_t*)(big + OFF_PRJ); act_t* QB = (act_t*)(big + OFF_QB); act_t* KVB = (act_t*)(big + OFF_KVB); act_t* OB = (act_t*)(big + OFF_O); (void)PRJ; (void)QB; (void)KVB; (void)OB; \
    act_t* Y = (act_t*)big; act_t* ACT = (act_t*)(ws + WS_ACT); act_t* XS = (act_t*)(ws + WS_XS); unsigned char* wts = ws + WS_W; (void)Y; (void)ACT; (void)XS; (void)wts;

    if (threadIdx.x < 32) misc[threadIdx.x] = 0u;
    __syncthreads();
    XcdBarrier bar = xcd_barrier_post(ctl0 + CW_BAR, (volatile LAS unsigned*)(misc + 8), wave0);
    const int lo = p.ph_lo, hi = p.ph_hi;
#ifndef PHASE_MASK
#define PHASE_MASK 0x1FFFFFu
#endif
#define IN(k) ((((PHASE_MASK) >> (k)) & 1u) && lo <= (k) && (k) < hi)
#define SEAM(k) do { if (IN(k) && IN((k) + 1)) xcd_barrier(bar, wave0); } while (0)
#define LDSB ((LAS unsigned char*)lds_raw)

    if (IN(0)) { PHASE_PTRS
        {   LAS float* scr = (LAS float*)(LDSB + wave * 16640);
            constexpr int I_AB = 16 * 45  , I_QB = 6 * 12, I_KVB = 4 * 16, I_ABO = 16 * 16, I_C = 16 * 24, I_CO = 16 * 16, I_W1 = 16 * 32, I_W2 = 16 * 16;
            constexpr int T_W1 = 64 * I_W1, T_W2 = 64 * I_W2, T_ALL = T_W1 + T_W2 + I_AB + I_QB + I_KVB + I_ABO + I_C + I_CO;
            for (int it = gw; it < T_ALL; it += NGW) {
                int r = it;
                if (r < T_W1) { const int mi = r / I_W1; const float* src = p.moe_w_in + (size_t)mi * 1024 * 2048;
                    if ((mi >= 32 && MOE_F8_L1) || (mi < 32 && MOE_F8_L0)) transpose_item64<true>(src, 1024, 2048, (unsigned char*)(wts + WO_W1) + (size_t)(mi >> 5) * 32 * 2048 * 1024 * 2 + (size_t)(mi & 31) * 2048 * 1024, scr, r % I_W1, lane);
                    else transpose_item64<false>(src, 1024, 2048, (bf16_t*)(wts + WO_W1) + (size_t)mi * 2048 * 1024, scr, r % I_W1, lane);
                    continue; } r -= T_W1;
                if (r < T_W2) { const int mi = r / I_W2; const float* src = p.moe_w_out + (size_t)mi * 1024 * 1024;
                    if (MOE_F8_DOWN && ((mi >= 32 && MOE_F8_L1) || (mi < 32 && MOE_F8_L0))) transpose_item64<true>(src, 1024, 1024, (unsigned char*)(wts + WO_W2) + (size_t)(mi >> 5) * 32 * 1024 * 1024 * 2 + (size_t)(mi & 31) * 1024 * 1024, scr, r % I_W2, lane);
                    else transpose_item64<false>(src, 1024, 1024, (bf16_t*)(wts + WO_W2) + (size_t)mi * 1024 * 1024, scr, r % I_W2, lane);
                    continue; } r -= T_W2;
                if (r < I_AB) { if (INPROJ_F8) transpose_item_f8(p.ab_w_in, 1024, AB_IN, (unsigned char*)(wts + WO_AB), scr, r, lane, 0.125f, 512);
                    else transpose_item(p.ab_w_in, 1024, AB_IN, (bf16_t*)(wts + WO_AB), scr, r, lane, nullptr, 0.125f, 512); continue; } r -= I_AB;
                if (r < I_QB) { transpose_item64<false>(p.mla_wq_b, 384, 768, (bf16_t*)(wts + WO_QB), scr, r, lane, p.mla_q_g, 0.10206207261596575f); continue; } r -= I_QB;
                if (r < I_KVB) { transpose_item64<false>(p.mla_wkv_b, 256, 1024, (bf16_t*)(wts + WO_KVB), scr, r, lane, p.mla_kv_g, 1.0f); continue; } r -= I_KVB;
                if (r < I_ABO) { if (OUTPROJ_F8) transpose_item64<true>(p.ab_w_out, 1024, 1024, (unsigned char*)(wts + WO_ABO), scr, r, lane); else transpose_item64<false>(p.ab_w_out, 1024, 1024, (bf16_t*)(wts + WO_ABO), scr, r, lane); continue; } r -= I_ABO;
                if (r < I_C) { if (INPROJ_F8) transpose_item64<true>(p.c_w_in, 1024, C_IN, (unsigned char*)(wts + WO_C), scr, r, lane); else transpose_item64<false>(p.c_w_in, 1024, C_IN, (bf16_t*)(wts + WO_C), scr, r, lane); continue; } r -= I_C;
                if (OUTPROJ_F8) transpose_item64<true>(p.c_w_out, 1024, 1024, (unsigned char*)(wts + WO_CO), scr, r, lane); else transpose_item64<false>(p.c_w_out, 1024, 1024, (bf16_t*)(wts + WO_CO), scr, r, lane);
            }
            uint4* z = (uint4*)((unsigned char*)(wts + WO_AB) + (size_t)AB_IN * 1024 * (INPROJ_F8 ? 1 : 2));
            for (int i = gw * 64 + lane; i < 96 * 1024 * (INPROJ_F8 ? 1 : 2) / 16; i += NGW * 64) z[i] = make_uint4(0u, 0u, 0u, 0u);
        }
        {
            float2* TA = (float2*)(tabs + TAB_A); float2* TB = (float2*)(tabs + TAB_B); float2* TC = (float2*)(tabs + TAB_C);
            for (int e = bid * NTHR + tid; e < SEQ * 112; e += G * NTHR) { const int s = e / 112, i = e % 112, prow = s / GRIDW, pcol = s % GRIDW;
                int quarter, ii; float2* dst;
                if (i < 32) { quarter = 16; ii = i; dst = TA + s * 32 + ii; } else if (i < 48) { quarter = 8; ii = i - 32; dst = TB + s * 16 + ii; } else { quarter = 32; ii = i - 48; dst = TC + s * 64 + ii; }
                const float ang = rope_angle(ii, quarter, prow, pcol); *dst = make_float2(cosf(ang), sinf(ang)); }
            if (bid == 0 && tid < 128) ((float*)(tabs + TAB_QG))[tid] = p.c_q_g[tid] * 0.08838834764831845f;
        }
        __syncthreads();
        float* ca = ldsf;
        float* red = ldsf + 17 * 1024;
        {   float cv[34];
#pragma unroll
            for (int j = 0; j < 34; ++j) cv[j] = j < 2 * NB ? p.c[j * NTHR + tid] : p.c_ctx[(j - 2 * NB) * NTHR + tid];
#pragma unroll
            for (int j = 0; j < 34; ++j) ca[j * NTHR + tid] = cv[j] / (1.f + expf(-cv[j])); }
        __syncthreads();
        for (int blk = bid; blk < 2 * 6144 / 64; blk += G) {
            typedef float f4m_ __attribute__((ext_vector_type(4)));
            const int l = blk / 96, ks = wave, kr = lane >> 4, c4 = (lane & 15) * 4;
            f4m_ acc[17];
#pragma unroll
            for (int b = 0; b < 17; ++b) acc[b] = (f4m_){0.f, 0.f, 0.f, 0.f};
            const float* wp = p.ada_w + (size_t)l * 1024 * 6144 + (blk % 96) * 64 + c4 + (size_t)(ks * 128 + kr) * 6144;
            const float* cap = ca + ks * 128 + kr;
#pragma unroll 1
            for (int g4 = 0; g4 < 8; ++g4) {
                f4m_ w[4];
#pragma unroll
                for (int j = 0; j < 4; ++j) w[j] = __builtin_nontemporal_load((const f4m_*)(wp + (size_t)((g4 * 4 + j) * 4) * 6144));
#pragma unroll
                for (int j = 0; j < 4; ++j) {
#pragma unroll
                    for (int b = 0; b < 17; ++b) acc[b] += cap[b * 1024 + (g4 * 4 + j) * 4] * w[j]; }
            }
#pragma unroll
            for (int b = 0; b < 17; ++b) {
#pragma unroll
                for (int c = 0; c < 4; ++c) { float v = acc[b][c]; v += __shfl_xor(v, 16); v += __shfl_xor(v, 32); acc[b][c] = v; } }
            if (lane < 16) {
#pragma unroll
                for (int b = 0; b < 17; ++b) *(f4m_*)(red + (ks * 17 + b) * 64 + c4) = acc[b]; }
            __syncthreads();
            for (int i = tid; i < 17 * 64; i += NTHR) { const int b = i >> 6, nl = i & 63; float s = 0.f;
#pragma unroll
                for (int k2 = 0; k2 < 8; ++k2) s += red[(k2 * 17 + b) * 64 + nl];
                const int nn = (blk % 96) * 64 + nl; float mv = s + p.ada_b[l * 6144 + nn];
                if (nn >= 4096 && nn < 5120) mv = p.norm_ffn_g[l * 1024 + nn - 4096] * (1.0f + mv);
                MOD[((size_t)l * 17 + b) * 6144 + nn] = mv; }
            __syncthreads();
        }
    }
    SEAM(0);

#define NORM_MOD16(v, g, mr_) do { float ss_ = 0.f; \
        _Pragma("unroll") for (int j = 0; j < 16; ++j) ss_ = fmaf(v[j], v[j], ss_); \
        ss_ = wave_sum(ss_); const float ri_ = 1.0f / sqrtf(ss_ * (1.0f / 1024.0f) + RMS_EPS); \
        float sh_[16], sc_[16]; ld16f((mr_), sh_); ld16f((mr_) + 1024, sc_); \
        _Pragma("unroll") for (int j = 0; j < 16; ++j) v[j] = (v[j] * ri_ * g[j]) * (1.0f + sc_[j]) + sh_[j]; } while (0)

#define NORM_MOD16x2(v, g, mr0_, mr1_) do { float s0_ = 0.f, s1_ = 0.f; \
        _Pragma("unroll") for (int j = 0; j < 16; ++j) { s0_ = fmaf(v[0][j], v[0][j], s0_); s1_ = fmaf(v[1][j], v[1][j], s1_); } \
        wave_sum2(s0_, s1_); const float ri0_ = 1.0f / sqrtf(s0_ * (1.0f / 1024.0f) + RMS_EPS), ri1_ = 1.0f / sqrtf(s1_ * (1.0f / 1024.0f) + RMS_EPS); \
        float sh_[16], sc_[16]; ld16f((mr0_), sh_); ld16f((mr0_) + 1024, sc_); \
        _Pragma("unroll") for (int j = 0; j < 16; ++j) v[0][j] = (v[0][j] * ri0_ * g[j]) * (1.0f + sc_[j]) + sh_[j]; \
        ld16f((mr1_), sh_); ld16f((mr1_) + 1024, sc_); \
        _Pragma("unroll") for (int j = 0; j < 16; ++j) v[1][j] = (v[1][j] * ri1_ * g[j]) * (1.0f + sc_[j]) + sh_[j]; } while (0)
#define ROWS2(nrows) _Pragma("unroll 1") for (int r0_ = gw; r0_ < (nrows); r0_ += 2 * NGW)
#define ROWS2_IDX(nrows) const bool two_ = (r0_ + NGW) < (nrows); const int rr_[2] = {r0_, two_ ? r0_ + NGW : r0_};

    if (IN(1)) { PHASE_PTRS
        float g[16]; ld16f(p.norm_mix_g + 16 * lane, g);
        ROWS2(NROW) { ROWS2_IDX(NROW)
            float v[2][16]; const float* mr[2];
#pragma unroll
            for (int u = 0; u < 2; ++u) { const int r = rr_[u]; const float* src = r < NLAT ? p.x + (size_t)r * 1024 : p.ctx + (size_t)(r - NLAT) * 1024;
                mr[u] = MOD + (size_t)(0 * 17 + mod_row_of(r)) * 6144 + 16 * lane; ld16f(src + 16 * lane, v[u]); }
            NORM_MOD16x2(v, g, mr[0], mr[1]);
            if (INPROJ_F8) { st16f8((unsigned char*)H + (size_t)rr_[0] * 1024 + 16 * lane, v[0]); if (two_) st16f8((unsigned char*)H + (size_t)rr_[1] * 1024 + 16 * lane, v[1]); }
            else { st16bf(H + (size_t)rr_[0] * 1024 + 16 * lane, v[0]); if (two_) st16bf(H + (size_t)rr_[1] * 1024 + 16 * lane, v[1]); }
        }
    }
    SEAM(1);

    if (IN(2)) { PHASE_PTRS
        constexpr size_t ES_ = INPROJ_F8 ? 1 : 2;
        pg8::DenseOrder S{(const char*)H, (const char*)(wts + WO_AB), NROW / 256, 6, G, bid, (size_t)256 * 1024 * ES_, (size_t)256 * 1024 * ES_};
        pg8::EpiStoreBf16 E{PRJ, PRJ_LD, INPROJ_F8 ? 0.03125f : 1.0f};
        pg8::gemm_phase<pg8::EpiStoreBf16, pg8::DenseOrder, true, true, INPROJ_F8 != 0>(tid, LDSB, 1024, 1024, S, E);
    }
    SEAM(2);

    if (IN(3)) { PHASE_PTRS
        const float2* TA = (const float2*)(tabs + TAB_A); const float2* TB = (const float2*)(tabs + TAB_B);
        for (int r = gw; r < NROW; r += NGW) {
            bf16_t* pr = PRJ + (size_t)r * PRJ_LD;
            if (r < NLAT) { const int s = r % SEQ;
                { bf16_t* kp = pr + 512 + (lane >> 5) * 64 + (lane & 31); const float x1 = bf2f(kp[0]), x2 = bf2f(kp[32]); const float2 t = TA[s * 32 + (lane & 31)];
                  kp[0] = f2bf(x1 * t.x - x2 * t.y); kp[32] = f2bf(x2 * t.x + x1 * t.y); }
                if (lane < 16) { bf16_t* rp = pr + 1408 + lane; const float x1 = bf2f(rp[0]), x2 = bf2f(rp[16]); const float2 t = TB[s * 16 + lane];
                  rp[0] = f2bf(x1 * t.x - x2 * t.y); rp[16] = f2bf(x2 * t.x + x1 * t.y); } }
            float s1 = 0.f, s2 = 0.f;
#pragma unroll
            for (int j = 0; j < 6; ++j) { const float xq = bf2f(pr[768 + lane + 64 * j]); s1 = fmaf(xq, xq, s1); }
#pragma unroll
            for (int j = 0; j < 4; ++j) { const float xk = bf2f(pr[1152 + lane + 64 * j]); s2 = fmaf(xk, xk, s2); }
            s1 = wave_sum(s1); s2 = wave_sum(s2);
            if (lane == 0) { RINV[2 * r] = 1.0f / sqrtf(s1 * (1.0f / 384.0f) + RMS_EPS); RINV[2 * r + 1] = 1.0f / sqrtf(s2 * (1.0f / 256.0f) + RMS_EPS); }
        }
    }
    SEAM(3);

    if (IN(4)) { PHASE_PTRS
        { pg8::DenseOrder S{(const char*)(PRJ + 768), (const char*)(wts + WO_QB), NROW / 256, 3, G, bid, (size_t)256 * PRJ_LD * 2, (size_t)256 * 384 * 2};
          pg8::EpiScaleBf16 E{QB, 768, RINV};
          pg8::gemm_phase<pg8::EpiScaleBf16, pg8::DenseOrder, true, true>(tid, LDSB, 384, PRJ_LD, S, E); }
        __syncthreads();
        { pg8::DenseOrder S{(const char*)(PRJ + 1152), (const char*)(wts + WO_KVB), NROW / 256, 4, G, bid, (size_t)256 * PRJ_LD * 2, (size_t)256 * 256 * 2};
          pg8::EpiScaleBf16 E{KVB, 1024, RINV + 1};
          pg8::gemm_phase<pg8::EpiScaleBf16, pg8::DenseOrder, true, true>(tid, LDSB, 256, PRJ_LD, S, E); }
    }
    SEAM(4);

    if (IN(5)) { PHASE_PTRS
        for (int i = 0;; ++i) { const int u = i * G + bid; if (u >= 1152) break;
            const bool isctx = u >= 1024; int b, h, qb;
            if (!isctx) { const int rest = u >> 3; b = 2 * (u & 7) + (rest >> 6); h = (rest & 63) >> 3; qb = rest & 7; } else { b = (u - 1024) >> 3; h = u & 7; qb = 0; }
            const int qrow0 = isctx ? NLAT + b * NCX : b * SEQ + qb * 256;
            fa::Unit U; U.Q = QB + (size_t)qrow0 * 768 + h * 96; U.K = KVB + h * 128; U.K2 = PRJ + 1408; U.V = KVB + h * 128 + 64;
            U.O = OUTPROJ_F8 ? (bf16_t*)((unsigned char*)OB + (size_t)qrow0 * 1024 + 512 + h * 64) : OB + (size_t)qrow0 * 1024 + 512 + h * 64; U.rowa = NLAT + b * NCX; U.nta = 4; U.rowb = b * SEQ; U.ntb = isctx ? 0 : 32;
            U.window = 0; U.qpos0 = 0; U.kposb0 = 0; U.sink = 0.f; U.has_sink = 0; U.tab = isctx ? nullptr : (const float*)(tabs + TAB_B); U.pos0 = qb * 256; U.qg = nullptr;
            fa::attn_unit<96, 64, 768, 1024, 1024, 1024, false, 4, 1, false, true, OUTPROJ_F8 != 0>(tid, U, (char*)lds_raw); }
        for (int i = 0;; ++i) { const int u = i * G + bid; if (u >= 1152) break;
            const bool isctx = u >= 1024; int b, h, qb;
            if (!isctx) { const int rest = u >> 3; b = 2 * (u & 7) + (rest >> 6); h = (rest & 63) >> 3; qb = rest & 7; } else { b = (u - 1024) >> 3; h = u & 7; qb = 0; }
            const int qrow0 = isctx ? NLAT + b * NCX : b * SEQ + qb * 256;
            const int ks = isctx ? 0 : max(0, qb * 256 - 128), ke = isctx ? 0 : min(SEQ, qb * 256 + 384);
            fa::Unit U; U.Q = PRJ + (size_t)qrow0 * PRJ_LD + h * 64; U.K = PRJ + 512 + (h >> 2) * 64; U.K2 = nullptr; U.V = PRJ + 640 + (h >> 2) * 64;
            U.O = OUTPROJ_F8 ? (bf16_t*)((unsigned char*)OB + (size_t)qrow0 * 1024 + h * 64) : OB + (size_t)qrow0 * 1024 + h * 64; U.rowa = NLAT + b * NCX; U.nta = 4; U.rowb = b * SEQ + ks; U.ntb = (ke - ks) / 64;
            U.window = isctx ? 0 : 1; U.qpos0 = qb * 256; U.kposb0 = ks; U.sink = p.swa_sink[h]; U.has_sink = 1; U.tab = isctx ? nullptr : (const float*)(tabs + TAB_A); U.pos0 = qb * 256; U.qg = nullptr;
            fa::attn_unit<64, 64, PRJ_LD, PRJ_LD, PRJ_LD, 1024, true, 0, 2, false, false, OUTPROJ_F8 != 0>(tid, U, (char*)lds_raw); }
    }
    SEAM(5);

    if (IN(6)) { PHASE_PTRS
        constexpr size_t ES_ = OUTPROJ_F8 ? 1 : 2;
        pg8::DenseOrder S{(const char*)OB, (const char*)(wts + WO_ABO), NROW / 256, 4, G, bid, (size_t)256 * 1024 * ES_, (size_t)256 * 1024 * ES_};
        pg8::EpiResid E{p.x, p.ctx, XR, MOD + 2048, OUTPROJ_F8 ? 0.03125f : 1.0f};
        pg8::gemm_phase<pg8::EpiResid, pg8::DenseOrder, true, true, OUTPROJ_F8 != 0>(tid, LDSB, 1024, 1024, S, E);
    }
    SEAM(6);

    typedef float f4a_ __attribute__((ext_vector_type(4)));
#define GLD4(dst, ptr, off) asm volatile("global_load_dwordx4 %0, %1, off offset:" #off : "=v"(dst) : "v"(ptr) : "memory")
#define ROUTER_PHASE(L, nrows) do { \
        { const float4* wsrc_ = (const float4*)(p.router_w + (size_t)(L) * 1024 * 32); float4* wl_ = (float4*)lds_raw; \
          for (int q = tid; q < 8192; q += NTHR) { const int c_ = q >> 3, e4_ = q & 7; wl_[(c_ ^ ((c_ >> 8) & 1)) * 8 + (e4_ ^ ((c_ >> 5) & 7))] = wsrc_[q]; } }        \
        __syncthreads(); \
        unsigned* cnt_ = ctl + CW_CNT + (L) * 32; \
        LAS unsigned* lcnt_ = (LAS unsigned*)(LDSB + LDS_MISC + 1024); LAS unsigned* lbase_ = lcnt_ + 32;       \
        if (tid < 32) lcnt_[tid] = 0u; \
        __syncthreads(); \
        const int half_ = lane >> 5, l5_ = lane & 31;                        \
        const float rb_ = p.router_b[(L) * 32 + l5_]; \
        const float4* wl_ = (const float4*)lds_raw + (size_t)(32 * l5_) * 8; const int sw_ = l5_ & 7; \
        LAS unsigned* stash_ = (LAS unsigned*)(LDSB + 131072) + wave * 384;        \
        int it_ = 0; \
          \
        f4a_ xn0_, xn1_, xn2_, xn3_, xn4_, xn5_, xn6_, xn7_;                 \
        { const int r = (gw * 2 < (nrows) ? gw * 2 : 0) + half_; const float* xp_ = XR + (size_t)r * 1024 + 32 * l5_; \
          GLD4(xn0_, xp_, 0); GLD4(xn1_, xp_, 16); GLD4(xn2_, xp_, 32); GLD4(xn3_, xp_, 48); GLD4(xn4_, xp_, 64); GLD4(xn5_, xp_, 80); GLD4(xn6_, xp_, 96); GLD4(xn7_, xp_, 112); } \
        for (int rp = gw; rp * 2 < (nrows); rp += NGW, ++it_) { const int r = rp * 2 + half_; \
            const float* mr = MOD + (size_t)((L) * 17 + mod_row_of(r)) * 6144 + 3072 + 32 * l5_; const float* mr2 = mr + 1024; \
            asm volatile("s_waitcnt vmcnt(0)" : "+v"(xn0_), "+v"(xn1_), "+v"(xn2_), "+v"(xn3_), "+v"(xn4_), "+v"(xn5_), "+v"(xn6_), "+v"(xn7_) :: "memory"); \
            float v[2][16]; \
            _Pragma("unroll") for (int q = 0; q < 4; ++q) { v[0][q] = xn0_[q]; v[0][4 + q] = xn1_[q]; v[0][8 + q] = xn2_[q]; v[0][12 + q] = xn3_[q]; v[1][q] = xn4_[q]; v[1][4 + q] = xn5_[q]; v[1][8 + q] = xn6_[q]; v[1][12 + q] = xn7_[q]; } \
            f4a_ sh0_, sh1_, sh2_, sh3_, sh4_, sh5_, sh6_, sh7_, sc0_, sc1_, sc2_, sc3_, sc4_, sc5_, sc6_, sc7_; \
            GLD4(sh0_, mr, 0); GLD4(sh1_, mr, 16); GLD4(sh2_, mr, 32); GLD4(sh3_, mr, 48); GLD4(sh4_, mr, 64); GLD4(sh5_, mr, 80); GLD4(sh6_, mr, 96); GLD4(sh7_, mr, 112); \
            GLD4(sc0_, mr2, 0); GLD4(sc1_, mr2, 16); GLD4(sc2_, mr2, 32); GLD4(sc3_, mr2, 48); GLD4(sc4_, mr2, 64); GLD4(sc5_, mr2, 80); GLD4(sc6_, mr2, 96); GLD4(sc7_, mr2, 112); \
            { const int rn_ = ((rp + NGW) * 2 < (nrows) ? (rp + NGW) * 2 : rp * 2) + half_; const float* xp_ = XR + (size_t)rn_ * 1024 + 32 * l5_;        \
              GLD4(xn0_, xp_, 0); GLD4(xn1_, xp_, 16); GLD4(xn2_, xp_, 32); GLD4(xn3_, xp_, 48); GLD4(xn4_, xp_, 64); GLD4(xn5_, xp_, 80); GLD4(xn6_, xp_, 96); GLD4(xn7_, xp_, 112); } \
            asm volatile("s_waitcnt vmcnt(8)" : "+v"(sh0_), "+v"(sh1_), "+v"(sh2_), "+v"(sh3_), "+v"(sh4_), "+v"(sh5_), "+v"(sh6_), "+v"(sh7_), "+v"(sc0_), "+v"(sc1_), "+v"(sc2_), "+v"(sc3_), "+v"(sc4_), "+v"(sc5_), "+v"(sc6_), "+v"(sc7_) :: "memory"); \
            float sh_[2][16], sc_[2][16]; \
            _Pragma("unroll") for (int q = 0; q < 4; ++q) { sh_[0][q] = sh0_[q]; sh_[0][4 + q] = sh1_[q]; sh_[0][8 + q] = sh2_[q]; sh_[0][12 + q] = sh3_[q]; sh_[1][q] = sh4_[q]; sh_[1][4 + q] = sh5_[q]; sh_[1][8 + q] = sh6_[q]; sh_[1][12 + q] = sh7_[q]; \
                sc_[0][q] = sc0_[q]; sc_[0][4 + q] = sc1_[q]; sc_[0][8 + q] = sc2_[q]; sc_[0][12 + q] = sc3_[q]; sc_[1][q] = sc4_[q]; sc_[1][4 + q] = sc5_[q]; sc_[1][8 + q] = sc6_[q]; sc_[1][12 + q] = sc7_[q]; } \
            float ss_ = 0.f; \
            _Pragma("unroll") for (int j = 0; j < 16; ++j) { ss_ = fmaf(v[0][j], v[0][j], ss_); ss_ = fmaf(v[1][j], v[1][j], ss_); } \
            ss_ = half_sum32(ss_); \
            const float ri_ = 1.0f / sqrtf(ss_ * (1.0f / 1024.0f) + RMS_EPS); \
            _Pragma("unroll") for (int hh = 0; hh < 2; ++hh) { \
                _Pragma("unroll") for (int j = 0; j < 16; ++j) v[hh][j] = (v[hh][j] * ri_) * sc_[hh][j] + sh_[hh][j];        \
                st16f8((unsigned char*)H + (size_t)r * 1024 + 32 * l5_ + 16 * hh, v[hh]); }        \
            if (l5_ & 8) { _Pragma("unroll") for (int hh = 0; hh < 2; ++hh) _Pragma("unroll") for (int j = 0; j < 16; j += 2) { const float t_ = v[hh][j]; v[hh][j] = v[hh][j + 1]; v[hh][j + 1] = t_; } }        \
            float acc[32]; \
            _Pragma("unroll") for (int e = 0; e < 32; ++e) acc[e] = 0.f; \
            _Pragma("unroll") for (int hh = 0; hh < 2; ++hh) _Pragma("unroll") for (int j = 0; j < 16; ++j) { \
                _Pragma("unroll") for (int e4 = 0; e4 < 8; ++e4) { const float4 w = wl_[(16 * hh + j) * 8 + (e4 ^ sw_)]; \
                    acc[4 * e4] = fmaf(v[hh][j], w.x, acc[4 * e4]); acc[4 * e4 + 1] = fmaf(v[hh][j], w.y, acc[4 * e4 + 1]); acc[4 * e4 + 2] = fmaf(v[hh][j], w.z, acc[4 * e4 + 2]); acc[4 * e4 + 3] = fmaf(v[hh][j], w.w, acc[4 * e4 + 3]); } } \
            float tv[4]; int ti[4]; route_reduce32(acc, l5_, rb_, tv, ti); \
            const float e1 = expf(tv[1] - tv[0]), e2 = expf(tv[2] - tv[0]), e3 = expf(tv[3] - tv[0]); const float inv = 1.0f / (1.0f + e1 + e2 + e3); \
            if (l5_ < 4) { const int ek = l5_ == 0 ? ti[0] : l5_ == 1 ? ti[1] : l5_ == 2 ? ti[2] : ti[3]; const float gk = (l5_ == 0 ? 1.0f : l5_ == 1 ? e1 : l5_ == 2 ? e2 : e3) * inv; \
                const unsigned pos = __hip_atomic_fetch_add(lcnt_ + ek, 1u, __ATOMIC_RELAXED, __HIP_MEMORY_SCOPE_WORKGROUP); TOKE[r * 4 + l5_] = ek; TOKG[r * 4 + l5_] = gk; \
                stash_[it_ * 8 + half_ * 4 + l5_] = (unsigned)ek | (pos << 8); } \
        } \
        asm volatile("s_waitcnt vmcnt(0)" : "+v"(xn0_), "+v"(xn1_), "+v"(xn2_), "+v"(xn3_), "+v"(xn4_), "+v"(xn5_), "+v"(xn6_), "+v"(xn7_) :: "memory");        \
        __syncthreads(); \
        if (tid < 32) lbase_[tid] = atomicAdd(cnt_ + tid, lcnt_[tid]); \
        __syncthreads(); \
        for (int e_ = lane; e_ < it_ * 8; e_ += 64) { const unsigned w_ = stash_[e_]; const int r = (gw + (e_ >> 3) * NGW) * 2 + ((e_ >> 2) & 1); TOKP[r * 4 + (e_ & 3)] = (int)((w_ >> 8) + lbase_[w_ & 255u]); } \
    } while (0)

#define EXCL_SETUP(L) \
        const int c_ = lane < 32 ? (int)ctl[CW_CNT + (L) * 32 + lane] : 0; const int padc_ = (c_ + 255) / 256 * 256; int pre_ = padc_; \
        _Pragma("unroll") for (int o_ = 1; o_ < 32; o_ <<= 1) { const int t_ = __shfl_up(pre_, o_); if ((lane & 31) >= o_) pre_ += t_; } \
        const int excl_ = pre_ - padc_;
#define PERMUTE_PHASE(L, nrows) do { EXCL_SETUP(L) \
        ROWS2(nrows) { ROWS2_IDX(nrows) \
            const int ra_ = rr_[0], rb_ = rr_[1]; \
            const uint4* sa_ = (const uint4*)(H + (size_t)ra_ * 1024) + lane * 2; const uint4* sb_ = (const uint4*)(H + (size_t)rb_ * 1024) + lane * 2; \
            const uint4 a0_ = sa_[0], a1_ = sa_[1], b0_ = sb_[0], b1_ = sb_[1]; \
            const int4 ea_ = *(const int4*)(TOKE + ra_ * 4), pa_ = *(const int4*)(TOKP + ra_ * 4), eb_ = *(const int4*)(TOKE + rb_ * 4), pb_ = *(const int4*)(TOKP + rb_ * 4); \
            const int sa0 = __shfl(excl_, ea_.x) + pa_.x, sa1 = __shfl(excl_, ea_.y) + pa_.y, sa2 = __shfl(excl_, ea_.z) + pa_.z, sa3 = __shfl(excl_, ea_.w) + pa_.w; \
            const int sb0 = __shfl(excl_, eb_.x) + pb_.x, sb1 = __shfl(excl_, eb_.y) + pb_.y, sb2 = __shfl(excl_, eb_.z) + pb_.z, sb3 = __shfl(excl_, eb_.w) + pb_.w; \
            { uint4* d_ = (uint4*)(XS + (size_t)sa0 * 1024) + lane * 2; d_[0] = a0_; d_[1] = a1_; } { uint4* d_ = (uint4*)(XS + (size_t)sa1 * 1024) + lane * 2; d_[0] = a0_; d_[1] = a1_; } \
            { uint4* d_ = (uint4*)(XS + (size_t)sa2 * 1024) + lane * 2; d_[0] = a0_; d_[1] = a1_; } { uint4* d_ = (uint4*)(XS + (size_t)sa3 * 1024) + lane * 2; d_[0] = a0_; d_[1] = a1_; } \
            if (two_) { \
            { uint4* d_ = (uint4*)(XS + (size_t)sb0 * 1024) + lane * 2; d_[0] = b0_; d_[1] = b1_; } { uint4* d_ = (uint4*)(XS + (size_t)sb1 * 1024) + lane * 2; d_[0] = b0_; d_[1] = b1_; } \
            { uint4* d_ = (uint4*)(XS + (size_t)sb2 * 1024) + lane * 2; d_[0] = b0_; d_[1] = b1_; } { uint4* d_ = (uint4*)(XS + (size_t)sb3 * 1024) + lane * 2; d_[0] = b0_; d_[1] = b1_; } } } \
        for (int e = 0; e < 32; ++e) { const int ce = __shfl(c_, e), be = __shfl(excl_, e), pe = __shfl(padc_, e); \
            for (int rr = ce + gw; rr < pe; rr += NGW) { uint4* d_ = (uint4*)(XS + (size_t)(be + rr) * 1024) + lane * 2; d_[0] = make_uint4(0u, 0u, 0u, 0u); d_[1] = make_uint4(0u, 0u, 0u, 0u); } } \
    } while (0)
#define PERMUTE_PHASE_F8(L, nrows) do { EXCL_SETUP(L) \
        unsigned char* XS8 = (unsigned char*)XS; \
        for (int r = gw; r < (nrows); r += NGW) { \
            const int4 ov_ = *((const int4*)((const unsigned char*)H + (size_t)r * 1024) + lane); \
            _Pragma("unroll") for (int k = 0; k < 4; ++k) { const int ek = TOKE[r * 4 + k], pk = TOKP[r * 4 + k]; const int slot = __shfl(excl_, ek) + pk; \
                *((int4*)(XS8 + (size_t)slot * 1024) + lane) = ov_; if (lane == 0) TOKP[r * 4 + k] = slot; } }        \
        for (int e = 0; e < 32; ++e) { const int ce = __shfl(c_, e), be = __shfl(excl_, e), pe = __shfl(padc_, e); \
            for (int rr = ce + gw; rr < pe; rr += NGW) *((int4*)(XS8 + (size_t)(be + rr) * 1024) + lane) = make_int4(0, 0, 0, 0); } \
    } while (0)
#define MOE_TABLE(L) \
        LAS int* tile_e = (LAS int*)(LDSB + LDS_MISC + 1024); LAS int* nm_p = tile_e + 640; \
        LAS int* tpre_ = nm_p + 1;                                       \
        __syncthreads(); \
        if (tid < 64) { const int c_ = lane < 32 ? (int)ctl[CW_CNT + (L) * 32 + lane] : 0; const int n_ = (c_ + 255) / 256; int pre_ = n_; \
            _Pragma("unroll") for (int o_ = 1; o_ < 32; o_ <<= 1) { const int t_ = __shfl_up(pre_, o_); if ((lane & 31) >= o_) pre_ += t_; } \
            if (lane < 32) tpre_[lane] = pre_ - n_; if (lane == 31) { tpre_[32] = pre_; *nm_p = pre_; } } \
        __syncthreads(); \
        const int nM_ = __builtin_amdgcn_readfirstlane(*nm_p); \
        for (int t_ = tid; t_ < nM_; t_ += NTHR) { int e_ = 0; _Pragma("unroll") for (int q_ = 16; q_ >= 1; q_ >>= 1) { if (tpre_[e_ + q_] <= t_) e_ += q_; } tile_e[t_] = e_; }        \
        __syncthreads();
#define MOE_FAST1(L) do { MOE_TABLE(L) \
        pg8::MoeOrder S{(const char*)XS, (const char*)(wts + WO_W1) + (size_t)(L) * 32 * 2048 * 1024 * 2, tile_e, nM_, 8, G, bid, (size_t)256 * 1024 * 2, (size_t)2048 * 1024 * 2}; \
        pg8::EpiSwiglu E{ACT, p.moe_b_in + (size_t)(L) * 32 * 2048, 1.0f}; \
        pg8::gemm_phase<pg8::EpiSwiglu, pg8::MoeOrder, true, true>(tid, LDSB, 1024, 1024, S, E); } while (0)
#define MOE_FAST2(L) do { MOE_TABLE(L) \
        pg8::MoeOrder S{(const char*)ACT, (const char*)(wts + WO_W2) + (size_t)(L) * 32 * 1024 * 1024 * 2, tile_e, nM_, 4, G, bid, (size_t)256 * 1024 * 2, (size_t)1024 * 1024 * 2}; \
        pg8::EpiBiasBf16 E{Y, p.moe_b_out + (size_t)(L) * 32 * 1024, 1.0f}; \
        pg8::gemm_phase<pg8::EpiBiasBf16, pg8::MoeOrder, true, true>(tid, LDSB, 1024, 1024, S, E); } while (0)
#define MOE_FAST1_F8(L) do { MOE_TABLE(L) \
        pg8::MoeOrder S{(const char*)XS, (const char*)(wts + WO_W1) + (size_t)(L) * 32 * 2048 * 1024 * 2, tile_e, nM_, 8, G, bid, (size_t)256 * 1024, (size_t)2048 * 1024}; \
        if constexpr (MOE_F8_DOWN) { pg8::EpiSwigluF8 E{(unsigned char*)ACT, p.moe_b_in + (size_t)(L) * 32 * 2048}; \
            pg8::gemm_phase<pg8::EpiSwigluF8, pg8::MoeOrder, true, true, true>(tid, LDSB, 1024, 1024, S, E); } \
        else { pg8::EpiSwiglu E{ACT, p.moe_b_in + (size_t)(L) * 32 * 2048, 0.03125f}; \
            pg8::gemm_phase<pg8::EpiSwiglu, pg8::MoeOrder, false, true, true>(tid, LDSB, 1024, 1024, S, E); } } while (0)
#define MOE_FAST2_F8(L) do { MOE_TABLE(L) \
        pg8::MoeOrder S{(const char*)ACT, (const char*)(wts + WO_W2) + (size_t)(L) * 32 * 1024 * 1024 * 2, tile_e, nM_, 4, G, bid, (size_t)256 * 1024, (size_t)1024 * 1024}; \
        if constexpr ((Y8_L1 && (L) == 1) || (Y8_L0 && (L) == 0)) { pg8::EpiBiasF8 E{(unsigned char*)Y, p.moe_b_out + (size_t)(L) * 32 * 1024, 0.03125f}; \
            pg8::gemm_phase<pg8::EpiBiasF8, pg8::MoeOrder, true, true, true>(tid, LDSB, 1024, 1024, S, E); } \
        else { pg8::EpiBiasBf16 E{Y, p.moe_b_out + (size_t)(L) * 32 * 1024, 0.03125f}; \
            pg8::gemm_phase<pg8::EpiBiasBf16, pg8::MoeOrder, true, true, true>(tid, LDSB, 1024, 1024, S, E); } } while (0)
#define COMBINE_PRE(nrows) typedef int i4n_ __attribute__((ext_vector_type(4))); typedef float f4n_ __attribute__((ext_vector_type(4))); i4n_ sl0_, sl1_; f4n_ gt0_, gt1_; \
        { const int ra_ = gw < (nrows) ? gw : 0, rb_ = gw + NGW < (nrows) ? gw + NGW : ra_; sl0_ = *(const i4n_*)(TOKP + ra_ * 4); gt0_ = *(const f4n_*)(TOKG + ra_ * 4); sl1_ = *(const i4n_*)(TOKP + rb_ * 4); gt1_ = *(const f4n_*)(TOKG + rb_ * 4); }
#define COMBINE_ROWS2(L, v, nrows, F8Y) do { \
        const int slc_[2][4] = {{sl0_[0], sl0_[1], sl0_[2], sl0_[3]}, {sl1_[0], sl1_[1], sl1_[2], sl1_[3]}}; \
        const float gk_[2][4] = {{gt0_[0], gt0_[1], gt0_[2], gt0_[3]}, {gt1_[0], gt1_[1], gt1_[2], gt1_[3]}}; \
        uint4 ya_[2][4], yb_[2][4]; \
        _Pragma("unroll") for (int u = 0; u < 2; ++u) { const int r = rr_[u]; \
            _Pragma("unroll") for (int k = 0; k < 4; ++k) { \
                if constexpr (F8Y) { ya_[u][k] = *((const uint4*)((const unsigned char*)Y + (size_t)slc_[u][k] * 1024) + lane); yb_[u][k] = ya_[u][k]; } \
                else { const uint4* yr = (const uint4*)(Y + (size_t)slc_[u][k] * 1024 + 16 * lane); ya_[u][k] = yr[0]; yb_[u][k] = yr[1]; } } \
            ld16f(XR + (size_t)r * 1024 + 16 * lane, v[u]); } \
        { const int n0_ = r0_ + 2 * NGW; if (n0_ < (nrows)) { const int n1_ = n0_ + NGW < (nrows) ? n0_ + NGW : n0_; \
            sl0_ = *(const i4n_*)(TOKP + n0_ * 4); gt0_ = *(const f4n_*)(TOKG + n0_ * 4); sl1_ = *(const i4n_*)(TOKP + n1_ * 4); gt1_ = *(const f4n_*)(TOKG + n1_ * 4); } } \
        _Pragma("unroll") for (int u = 0; u < 2; ++u) { float f_[16]; \
            _Pragma("unroll") for (int j = 0; j < 16; ++j) f_[j] = 0.f; \
            _Pragma("unroll") for (int k = 0; k < 4; ++k) { \
                if constexpr (F8Y) { const int yw[4] = {(int)ya_[u][k].x, (int)ya_[u][k].y, (int)ya_[u][k].z, (int)ya_[u][k].w}; \
                    _Pragma("unroll") for (int j = 0; j < 4; ++j) { const auto lo_ = __builtin_amdgcn_cvt_pk_f32_fp8(yw[j], false); const auto hi_ = __builtin_amdgcn_cvt_pk_f32_fp8(yw[j], true); \
                        f_[4 * j] = fmaf(gk_[u][k], lo_[0], f_[4 * j]); f_[4 * j + 1] = fmaf(gk_[u][k], lo_[1], f_[4 * j + 1]); f_[4 * j + 2] = fmaf(gk_[u][k], hi_[0], f_[4 * j + 2]); f_[4 * j + 3] = fmaf(gk_[u][k], hi_[1], f_[4 * j + 3]); } } \
                else { const unsigned yw[8] = {ya_[u][k].x, ya_[u][k].y, ya_[u][k].z, ya_[u][k].w, yb_[u][k].x, yb_[u][k].y, yb_[u][k].z, yb_[u][k].w}; \
                    _Pragma("unroll") for (int j = 0; j < 8; ++j) { f_[2 * j] = fmaf(gk_[u][k], __uint_as_float(yw[j] << 16), f_[2 * j]); f_[2 * j + 1] = fmaf(gk_[u][k], __uint_as_float(yw[j] & 0xffff0000u), f_[2 * j + 1]); } } } \
            float g2v_[16]; ld16f(MOD + (size_t)((L) * 17 + mod_row_of(rr_[u])) * 6144 + 5120 + 16 * lane, g2v_);        \
            _Pragma("unroll") for (int j = 0; j < 16; ++j) v[u][j] = fmaf(g2v_[j], f_[j], v[u][j]); } } while (0)

    if (IN(7)) { PHASE_PTRS ROUTER_PHASE(0, NROW); }
    SEAM(7);
#if MOE_F8_L0
    if (IN(8)) { PHASE_PTRS PERMUTE_PHASE_F8(0, NROW); }
    SEAM(8);
    if (IN(9)) { PHASE_PTRS MOE_FAST1_F8(0); }
    SEAM(9);
#else
    if (IN(8)) { PHASE_PTRS PERMUTE_PHASE(0, NROW); }
    SEAM(8);
    if (IN(9)) { PHASE_PTRS MOE_FAST1(0); }
    SEAM(9);
#endif
    if (IN(10)) { PHASE_PTRS if constexpr (MOE_F8_L0 && MOE_F8_DOWN) { MOE_FAST2_F8(0); } else { MOE_FAST2(0); } }
    SEAM(10);

    if (IN(11)) { PHASE_PTRS
        float g[16]; ld16f(p.norm_mix_g + 1024 + 16 * lane, g);
        COMBINE_PRE(NROW)
        ROWS2(NROW) { ROWS2_IDX(NROW)
            float v[2][16]; COMBINE_ROWS2(0, v, NROW, (Y8_L0 && MOE_F8_L0 && MOE_F8_DOWN));
            st16f(XR + (size_t)rr_[0] * 1024 + 16 * lane, v[0]); if (two_) st16f(XR + (size_t)rr_[1] * 1024 + 16 * lane, v[1]);
            const float* mr0 = MOD + (size_t)(1 * 17 + mod_row_of(rr_[0])) * 6144 + 16 * lane; const float* mr1 = MOD + (size_t)(1 * 17 + mod_row_of(rr_[1])) * 6144 + 16 * lane;
            NORM_MOD16x2(v, g, mr0, mr1);
            if (INPROJ_F8) { st16f8((unsigned char*)H + (size_t)rr_[0] * 1024 + 16 * lane, v[0]); if (two_) st16f8((unsigned char*)H + (size_t)rr_[1] * 1024 + 16 * lane, v[1]); }
            else { st16bf(H + (size_t)rr_[0] * 1024 + 16 * lane, v[0]); if (two_) st16bf(H + (size_t)rr_[1] * 1024 + 16 * lane, v[1]); }
        }
    }
    SEAM(11);

    if (IN(12)) { PHASE_PTRS
        constexpr size_t ES_ = INPROJ_F8 ? 1 : 2;
        pg8::DenseOrder S{(const char*)H, (const char*)(wts + WO_C), NROW / 256, 6, G, bid, (size_t)256 * 1024 * ES_, (size_t)256 * 1024 * ES_};
        pg8::EpiStoreBf16 E{PRJ, PRJ_LD, INPROJ_F8 ? 0.03125f : 1.0f};
        pg8::gemm_phase<pg8::EpiStoreBf16, pg8::DenseOrder, true, true, INPROJ_F8 != 0>(tid, LDSB, 1024, 1024, S, E);
    }
    SEAM(12);

    if (IN(13)) { PHASE_PTRS
        const float2* TC = (const float2*)(tabs + TAB_C); const float kg1 = p.c_k_g[lane], kg2 = p.c_k_g[64 + lane];
        for (int r = gw; r < NROW; r += NGW) {
            bf16_t* pr = PRJ + (size_t)r * PRJ_LD + 1024; float2 t = make_float2(1.f, 0.f); if (r < NLAT) t = TC[(r % SEQ) * 64 + lane];
#pragma unroll
            for (int kv = 0; kv < 2; ++kv) { float x1 = bf2f(pr[kv * 128 + lane]), x2 = bf2f(pr[kv * 128 + 64 + lane]);
                const float ss = wave_sum(x1 * x1 + x2 * x2); const float ri = 1.0f / sqrtf(ss * (1.0f / 128.0f) + RMS_EPS);
                x1 = x1 * ri * kg1; x2 = x2 * ri * kg2;
                pr[kv * 128 + lane] = f2bf(x1 * t.x - x2 * t.y); pr[kv * 128 + 64 + lane] = f2bf(x2 * t.x + x1 * t.y); }
        }
    }
    SEAM(13);

    if (IN(14)) { PHASE_PTRS
        for (int i = 0;; ++i) { const int u = i * G + bid; if (u >= 1024) break;
            const int rest = u >> 3; const int b = 2 * (u & 7) + (rest >> 6), h = (rest & 63) >> 3, qb = rest & 7; const int qrow0 = b * SEQ + qb * 256;
            fa::Unit U; U.Q = PRJ + (size_t)qrow0 * PRJ_LD + h * 128; U.K = PRJ + 1024 + (h >> 2) * 128; U.K2 = nullptr; U.V = PRJ + 1280 + (h >> 2) * 128;
            U.O = OUTPROJ_F8 ? (bf16_t*)((unsigned char*)OB + (size_t)qrow0 * 1024 + h * 128) : OB + (size_t)qrow0 * 1024 + h * 128; U.rowa = NLAT + b * NCX; U.nta = 4; U.rowb = b * SEQ; U.ntb = 32;
            U.window = 0; U.qpos0 = 0; U.kposb0 = 0; U.sink = 0.f; U.has_sink = 0; U.tab = (const float*)(tabs + TAB_C); U.pos0 = qb * 256; U.qg = (const float*)(tabs + TAB_QG);
            fa::attn_unit<128, 128, PRJ_LD, PRJ_LD, PRJ_LD, 1024, false, 0, 4, true, false, OUTPROJ_F8 != 0>(tid, U, (char*)lds_raw); }
    }
    SEAM(14);

    if (IN(15)) { PHASE_PTRS
        constexpr size_t ES_ = OUTPROJ_F8 ? 1 : 2;
        pg8::DenseOrder S{(const char*)OB, (const char*)(wts + WO_CO), NLAT / 256, 4, G, bid, (size_t)256 * 1024 * ES_, (size_t)256 * 1024 * ES_};
        pg8::EpiResid E{XR, XR, XR, MOD + 17 * 6144 + 2048, OUTPROJ_F8 ? 0.03125f : 1.0f};
        pg8::gemm_phase<pg8::EpiResid, pg8::DenseOrder, true, true, OUTPROJ_F8 != 0>(tid, LDSB, 1024, 1024, S, E);
    }
    SEAM(15);

    if (IN(16)) { PHASE_PTRS ROUTER_PHASE(1, NLAT); }
    SEAM(16);
#if MOE_F8_L1
    if (IN(17)) { PHASE_PTRS PERMUTE_PHASE_F8(1, NLAT); }
    SEAM(17);
    if (IN(18)) { PHASE_PTRS MOE_FAST1_F8(1); }
    SEAM(18);
    if (IN(19)) { PHASE_PTRS if constexpr (MOE_F8_DOWN) { MOE_FAST2_F8(1); } else { MOE_FAST2(1); } }
    SEAM(19);
#else
    if (IN(17)) { PHASE_PTRS PERMUTE_PHASE(1, NLAT); }
    SEAM(17);
    if (IN(18)) { PHASE_PTRS MOE_FAST1(1); }
    SEAM(18);
    if (IN(19)) { PHASE_PTRS MOE_FAST2(1); }
    SEAM(19);
#endif

    if (IN(20)) { PHASE_PTRS
        float g[16]; ld16f(p.final_g + 16 * lane, g);
        COMBINE_PRE(NLAT)
        ROWS2(NLAT) { ROWS2_IDX(NLAT)
            float v[2][16]; COMBINE_ROWS2(1, v, NLAT, (Y8_L1 && MOE_F8_L1 && MOE_F8_DOWN));
            float s0 = 0.f, s1 = 0.f;
#pragma unroll
            for (int j = 0; j < 16; ++j) { s0 = fmaf(v[0][j], v[0][j], s0); s1 = fmaf(v[1][j], v[1][j], s1); }
            wave_sum2(s0, s1); const float ri0 = 1.0f / sqrtf(s0 * (1.0f / 1024.0f) + RMS_EPS), ri1 = 1.0f / sqrtf(s1 * (1.0f / 1024.0f) + RMS_EPS);
#pragma unroll
            for (int j = 0; j < 16; ++j) { v[0][j] = v[0][j] * ri0 * g[j]; v[1][j] = v[1][j] * ri1 * g[j]; }
            st16f(p.out + (size_t)rr_[0] * 1024 + 16 * lane, v[0]); if (two_) st16f(p.out + (size_t)rr_[1] * 1024 + 16 * lane, v[1]);
        }
    }
#undef IN
#undef SEAM
}

#ifndef MK_PER_PHASE
#define MK_PER_PHASE 0
#endif
extern "C" void kernel_launch(void* const* d_in, const int* in_sizes, int n_in, void* d_out, int out_size, void* d_ws, size_t ws_size, hipStream_t stream) {
    static int grid = 0;
    if (grid == 0) {
        if (n_in != 26 || out_size != NLAT * DM || ws_size < WS_END) { fprintf(stderr, "kernel_launch: unexpected shapes (n_in %d out %d ws %zu need %zu)\n", n_in, out_size, ws_size, (size_t)WS_END); grid = -1; return; }
        int dev = 0, cus = 0;
        if (hipGetDevice(&dev) != hipSuccess || hipDeviceGetAttribute(&cus, hipDeviceAttributeMultiprocessorCount, dev) != hipSuccess) { grid = -1; return; }
        if (hipFuncSetAttribute((const void*)fwd_kernel, hipFuncAttributeMaxDynamicSharedMemorySize, LDS_BYTES) != hipSuccess) { fprintf(stderr, "kernel_launch: hipFuncSetAttribute failed\n"); grid = -1; return; }
        int per_cu = 0;
        if (hipOccupancyMaxActiveBlocksPerMultiprocessor(&per_cu, (const void*)fwd_kernel, NTHR, LDS_BYTES) != hipSuccess || per_cu < 1) { fprintf(stderr, "kernel_launch: occupancy query says %d\n", per_cu); }
        (void)hipGetLastError();
        grid = cus;
    }
    if (grid < 0) return;
    (void)hipMemsetAsync((char*)d_ws + WS_CTL, 0, CTL_BYTES, stream);
    Params p{};
    const float** pp = (const float**)&p;
    for (int i = 0; i < 26; ++i) pp[i] = (const float*)d_in[i];
    p.out = (float*)d_out; p.ws = (unsigned char*)d_ws;
#if MK_PER_PHASE
    for (int k = 0; k < N_PHASES; ++k) { p.ph_lo = k; p.ph_hi = k + 1; hipLaunchKernelGGL(fwd_kernel, dim3(grid), dim3(NTHR), LDS_BYTES, stream, p); }
#else
    p.ph_lo = 0; p.ph_hi = N_PHASES;
    hipLaunchKernelGGL(fwd_kernel, dim3(grid), dim3(NTHR), LDS_BYTES, stream, p);
#endif
}
```

```cpp
#include <hip/hip_runtime.h>
#include <cstdio>
#include <cstdint>

typedef unsigned short bf16_t;
typedef bf16_t act_t;
#define GAS __attribute__((address_space(1)))
#define LAS __attribute__((address_space(3)))

constexpr int DM = 1024, NB = 16, SEQ = 2048, NCX = 256, GRIDW = 64;
constexpr int NLAT = NB * SEQ, NCTX = NB * NCX, NROW = NLAT + NCTX;
constexpr int AB_IN = 1440, C_IN = 1536, PRJ_LD = 1536;
constexpr int NEXP = 32, DFF = 1024;
constexpr int CAP = 155648;
constexpr float RMS_EPS = 1e-6f;
constexpr int NTHR = 512;

constexpr size_t MiB = 1u << 20;
constexpr size_t ASZ = sizeof(act_t);
constexpr size_t WS_CTL = 0, CTL_BYTES = 1 * MiB;
constexpr size_t WS_MOD = 1 * MiB;
constexpr size_t WS_TOKE = 2 * MiB, WS_TOKP = 3 * MiB, WS_TOKG = 4 * MiB;
constexpr size_t WS_RINV = 5 * MiB;
constexpr size_t WS_TAB = 6 * MiB;
constexpr size_t TAB_A = 0, TAB_B = (size_t)SEQ * 32 * 8, TAB_C = TAB_B + (size_t)SEQ * 16 * 8, TAB_QG = TAB_C + (size_t)SEQ * 64 * 8;
constexpr size_t WS_XR = 16 * MiB;
constexpr size_t WS_H = WS_XR + 144 * MiB;
constexpr size_t WS_BIG = WS_H + (size_t)NROW * 1024 * ASZ;
constexpr size_t OFF_PRJ = 0;
constexpr size_t OFF_QB = OFF_PRJ + (size_t)NROW * 1536 * ASZ;
constexpr size_t OFF_KVB = OFF_QB + (size_t)NROW * 768 * ASZ;
constexpr size_t OFF_O = OFF_KVB + (size_t)NROW * 1024 * ASZ;
constexpr size_t BIG_A = OFF_O + (size_t)NROW * 1024 * ASZ;
constexpr size_t BIG_Y = (size_t)CAP * 1024 * ASZ;
constexpr size_t BIG_BYTES = BIG_A > BIG_Y ? BIG_A : BIG_Y;
constexpr size_t WS_ACT = WS_BIG + BIG_BYTES;
constexpr size_t WS_XS = WS_ACT + (size_t)CAP * 1024 * ASZ;
constexpr size_t WS_W = WS_XS + (size_t)CAP * 1024 * ASZ;
constexpr size_t WO_AB = 0;
constexpr size_t WO_QB = WO_AB + (size_t)1536 * 1024 * 2;
constexpr size_t WO_KVB = WO_QB + (size_t)768 * 384 * 2;
constexpr size_t WO_ABO = WO_KVB + (size_t)1024 * 256 * 2;
constexpr size_t WO_C = WO_ABO + (size_t)1024 * 1024 * 2;
constexpr size_t WO_CO = WO_C + (size_t)1536 * 1024 * 2;
constexpr size_t WO_W1 = WO_CO + (size_t)1024 * 1024 * 2;
constexpr size_t WO_W2 = WO_W1 + (size_t)64 * 2048 * 1024 * 2;
constexpr size_t WS_END = WS_W + WO_W2 + (size_t)64 * 1024 * 1024 * 2;

constexpr int CW_CNT = 64;
constexpr int CW_BAR = 4096;

__device__ __forceinline__ float bf2f(bf16_t v) { return __uint_as_float(((unsigned)v) << 16); }
__device__ __forceinline__ bf16_t f2bf(float f) { unsigned u = __float_as_uint(f); return (bf16_t)((u + 0x7fffu + ((u >> 16) & 1u)) >> 16); }
__device__ __forceinline__ float ldA(const float* p) { return *p; }
__device__ __forceinline__ float ldA(const bf16_t* p) { return bf2f(*p); }
__device__ __forceinline__ void stA(float* p, float v) { *p = v; }
__device__ __forceinline__ void stA(bf16_t* p, float v) { *p = f2bf(v); }
template <int N> __device__ __forceinline__ void load_vec(const float* p, float (&o)[N]) {
#pragma unroll
    for (int i = 0; i < N / 4; ++i) { const float4 t = ((const float4*)p)[i]; o[4 * i] = t.x; o[4 * i + 1] = t.y; o[4 * i + 2] = t.z; o[4 * i + 3] = t.w; }
}
template <int N> __device__ __forceinline__ void load_vec(const bf16_t* p, float (&o)[N]) {
#pragma unroll
    for (int i = 0; i < N / 8; ++i) { const uint4 t = ((const uint4*)p)[i];
        o[8 * i] = __uint_as_float(t.x << 16); o[8 * i + 1] = __uint_as_float(t.x & 0xffff0000u); o[8 * i + 2] = __uint_as_float(t.y << 16); o[8 * i + 3] = __uint_as_float(t.y & 0xffff0000u);
        o[8 * i + 4] = __uint_as_float(t.z << 16); o[8 * i + 5] = __uint_as_float(t.z & 0xffff0000u); o[8 * i + 6] = __uint_as_float(t.w << 16); o[8 * i + 7] = __uint_as_float(t.w & 0xffff0000u); }
}
__device__ __forceinline__ float wave_sum(float v) {
#pragma unroll
    for (int o = 1; o < 64; o <<= 1) v += __shfl_xor(v, o);
    return v;
}

__device__ __forceinline__ void wave_sum2(float& a, float& b) {
#pragma unroll
    for (int o = 1; o < 64; o <<= 1) { const float ta = __shfl_xor(a, o), tb = __shfl_xor(b, o); a += ta; b += tb; }
}
__device__ __forceinline__ void ld16f(const float* p, float (&v)[16]) {
#pragma unroll
    for (int i = 0; i < 4; ++i) { const float4 t = ((const float4*)p)[i]; v[4 * i] = t.x; v[4 * i + 1] = t.y; v[4 * i + 2] = t.z; v[4 * i + 3] = t.w; }
}
__device__ __forceinline__ void st16f(float* p, const float (&v)[16]) {
#pragma unroll
    for (int i = 0; i < 4; ++i) ((float4*)p)[i] = make_float4(v[4 * i], v[4 * i + 1], v[4 * i + 2], v[4 * i + 3]);
}
__device__ __forceinline__ unsigned cvtpk2(float lo, float hi) { unsigned r; asm volatile("v_cvt_pk_bf16_f32 %0, %1, %2" : "=v"(r) : "v"(lo), "v"(hi)); return r; }
__device__ __forceinline__ void st16bf(bf16_t* p, const float (&v)[16]) {
    ((uint4*)p)[0] = make_uint4(cvtpk2(v[0], v[1]), cvtpk2(v[2], v[3]), cvtpk2(v[4], v[5]), cvtpk2(v[6], v[7]));
    ((uint4*)p)[1] = make_uint4(cvtpk2(v[8], v[9]), cvtpk2(v[10], v[11]), cvtpk2(v[12], v[13]), cvtpk2(v[14], v[15]));
}

#ifndef XR16
#define XR16 1
#endif
#if XR16
typedef bf16_t xr_t;
#else
typedef float xr_t;
#endif
__device__ __forceinline__ void ld16x(const float* p, float (&v)[16]) { ld16f(p, v); }
__device__ __forceinline__ void st16x(float* p, const float (&v)[16]) { st16f(p, v); }
__device__ __forceinline__ void ld16x(const bf16_t* p, float (&v)[16]) {
#pragma unroll
    for (int i = 0; i < 2; ++i) { const uint4 t = ((const uint4*)p)[i]; const unsigned w[4] = {t.x, t.y, t.z, t.w};
#pragma unroll
        for (int j = 0; j < 4; ++j) { v[8 * i + 2 * j] = __uint_as_float(w[j] << 16); v[8 * i + 2 * j + 1] = __uint_as_float(w[j] & 0xffff0000u); } }
}
__device__ __forceinline__ void st16x(bf16_t* p, const float (&v)[16]) { st16bf(p, v); }
__device__ __forceinline__ void st16f8(unsigned char* p, const float (&v)[16]) {
    int o[4];
#pragma unroll
    for (int j = 0; j < 4; ++j) { const int t = __builtin_amdgcn_cvt_pk_fp8_f32(v[4 * j], v[4 * j + 1], 0, false); o[j] = __builtin_amdgcn_cvt_pk_fp8_f32(v[4 * j + 2], v[4 * j + 3], t, true); }
    *(int4*)p = make_int4(o[0], o[1], o[2], o[3]);
}
#define XB_TMO      128
#define XB_XCNT(j)  (256  + 64 * (j))
#define XB_XSUB(j)  (1280 + 64 * (j))
#define XB_XGEN(j)  (2304 + 64 * (j))
#define XB_TOP      3328
#define XB_TOPGEN   3392
#define XCD_BAR_WORDS 3456
#define XB_SPIN_CAP (1u << 22)
__device__ __forceinline__ unsigned xb_ld(unsigned* p)              { return __hip_atomic_load(p, __ATOMIC_RELAXED, __HIP_MEMORY_SCOPE_AGENT); }
__device__ __forceinline__ unsigned xb_add(unsigned* p, unsigned v) { return __hip_atomic_fetch_add(p, v, __ATOMIC_RELAXED, __HIP_MEMORY_SCOPE_AGENT); }
__device__ __forceinline__ unsigned xb_xcc_id() { return (unsigned)__builtin_amdgcn_s_getreg((3 << 11) | 20) & 0xFu; }
#define XB_SPIN(cond, bar) do { unsigned _sp = 0; while (cond) { __builtin_amdgcn_s_sleep(1); \
    if ((++_sp & 255u) == 0u) { if (xb_ld(&(bar)[XB_TMO])) break; if (_sp > XB_SPIN_CAP) { atomicAdd(&(bar)[XB_TMO], 1u); break; } } } } while (0)
struct XcdBarrier { unsigned* bar; unsigned x; volatile LAS unsigned* st; };
__device__ __forceinline__ bool xb_is_leader(int wave0) { return wave0 == 0 && __builtin_amdgcn_mbcnt_hi(~0u, __builtin_amdgcn_mbcnt_lo(~0u, 0u)) == 0u; }
__device__ __forceinline__ XcdBarrier xcd_barrier_post(unsigned* bar, volatile LAS unsigned* st, int wave0) {
    XcdBarrier b; b.bar = bar; b.x = xb_xcc_id(); b.st = st;
    if (xb_is_leader(wave0)) (void)xb_add(&bar[XB_XCNT(b.x)], 1u);
    return b;
}
__device__ __forceinline__ void xcd_barrier_complete(unsigned* bar, unsigned x, unsigned& nloc, unsigned& nx) {
    const unsigned G = gridDim.x * gridDim.y * gridDim.z;
    unsigned sum, cnt, mine, sp = 0u;
    for (;;) {
        sum = 0u; cnt = 0u; mine = 0u;
#pragma unroll
        for (unsigned j = 0; j < 16; ++j) { const unsigned c = xb_ld(&bar[XB_XCNT(j)]); sum += c; cnt += (c > 0u) ? 1u : 0u; mine = (j == x) ? c : mine; }
        if (sum == G) break;
        __builtin_amdgcn_s_sleep(1);
        if ((++sp & 255u) == 0u) { if (xb_ld(&bar[XB_TMO])) break; if (sp > XB_SPIN_CAP) { atomicAdd(&bar[XB_TMO], 1u); break; } }
    }
    nloc = mine > 0u ? mine : 1u; nx = cnt > 0u ? cnt : 1u;
}
__device__ __forceinline__ void xcd_barrier(const XcdBarrier& b, int wave0) {
    asm volatile("s_waitcnt vmcnt(0)" ::: "memory");
    __syncthreads();
    if (xb_is_leader(wave0)) {
        unsigned* bar = b.bar;
        __builtin_amdgcn_s_waitcnt(0);
        unsigned nloc = b.st[0], nx = b.st[1];
        if (nloc == 0u) { xcd_barrier_complete(bar, b.x, nloc, nx); b.st[0] = nloc; b.st[1] = nx; }
        const unsigned old = xb_add(&bar[XB_XSUB(b.x)], 1u);
        const unsigned gen = old / nloc;
        if (old + 1u == (gen + 1u) * nloc) {
            __builtin_amdgcn_fence(__ATOMIC_RELEASE, "agent");
            asm volatile("s_waitcnt vmcnt(0)" ::: "memory");
            const unsigned og = xb_add(&bar[XB_TOP], 1u);
            const unsigned tg = og / nx;
            if (og + 1u == (tg + 1u) * nx) xb_add(&bar[XB_TOPGEN], 1u);
            else XB_SPIN(xb_ld(&bar[XB_TOPGEN]) == tg, bar);
            __builtin_amdgcn_fence(__ATOMIC_ACQUIRE, "agent");
            xb_add(&bar[XB_XGEN(b.x)], 1u);
            asm volatile("s_waitcnt vmcnt(0)" ::: "memory");
        } else {
            XB_SPIN(xb_ld(&bar[XB_XGEN(b.x)]) == gen, bar);
            __builtin_amdgcn_fence(__ATOMIC_ACQUIRE, "agent");
            asm volatile("s_waitcnt vmcnt(0)" ::: "memory");
        }
    }
    __syncthreads();
}


#ifndef FAST_GEMM
#define FAST_GEMM 1
#endif
namespace pg8 {
#define PG8_LAS __attribute__((address_space(3)))
typedef short bf16x8 __attribute__((ext_vector_type(8)));
typedef float f32x4 __attribute__((ext_vector_type(4)));
typedef unsigned u32x4 __attribute__((ext_vector_type(4)));
constexpr int BM = 256, BK = 64, HALF = 128, HTB = HALF * BK * 2  , STAGE_BYTES = 8 * HTB, NXCD = 8, WGM = 8;

__host__ __device__ __forceinline__ int lds_byte(int r, int c) { const int st = (r >> 4) * 2 + (c >> 5), rr = r & 15, cc = c & 31, ob = rr * 64 + cc * 2; return st * 1024 + (ob ^ (((ob >> 9) & 1) << 5)); }
__host__ __device__ __forceinline__ void stage_rc(int b, int& R, int& C) { const int st = b / 1024, sb = b % 1024, swz = sb ^ (((sb >> 9) & 1) << 5); R = (st >> 1) * 16 + swz / 64; C = (st & 1) * 32 + (swz % 64) / 2; }
__host__ __device__ __forceinline__ int perm32(int rho) { const int n = rho >> 4, i = rho & 15; return 8 * (i >> 2) + 4 * n + (i & 3); }


struct Unit { const char* a; const char* b; int pm, pn, aux; };
__device__ __forceinline__ unsigned cvt_pk_bf16(float lo, float hi) { unsigned r; asm volatile("v_cvt_pk_bf16_f32 %0, %1, %2" : "=v"(r) : "v"(lo), "v"(hi)); return r; }
typedef int v8i32 __attribute__((ext_vector_type(8)));
__device__ __forceinline__ v8i32 cat16(bf16x8 lo, bf16x8 hi) { typedef int v4i32 __attribute__((ext_vector_type(4))); const v4i32 a = __builtin_bit_cast(v4i32, lo), b = __builtin_bit_cast(v4i32, hi); return __builtin_shufflevector(a, b, 0, 1, 2, 3, 4, 5, 6, 7); }
template <class Epi, class Sched, bool ALIGN_EPI = false, bool SP2 = false, bool F8 = false>
__device__ __forceinline__ void gemm_phase(const int tid, PG8_LAS unsigned char* lds, const int K, const int lda, const Sched& S, const Epi& E) {
    const int wid = __builtin_amdgcn_readfirstlane(tid >> 6), lane = tid & 63, wr = wid >> 2, wc = wid & 3, fr = lane & 15, fq = lane >> 4;
    const int nt = F8 ? K / (2 * BK) : K / BK;
    unsigned voffA[2], voffB[2];
#pragma unroll
    for (int i = 0; i < 2; ++i) { int R, C; stage_rc(tid * 16 + i * 8192, R, C); const int Rb = Epi::PERM ? ((R & ~31) + perm32(R & 31)) : R;
        voffA[i] = F8 ? (unsigned)(R * lda + 2 * C) : (unsigned)(R * lda + C) * 2u; voffB[i] = F8 ? (unsigned)(Rb * K + 2 * C) : (unsigned)(Rb * K + C) * 2u; }
    const size_t kstep = (size_t)(BK * 2);
    const size_t hstepA = (size_t)HALF * lda * (F8 ? 1 : 2);
    const size_t hstep = (size_t)HALF * K * (F8 ? 1 : 2);
    const unsigned ldsbase = (unsigned)__builtin_amdgcn_readfirstlane((int)((unsigned)(uintptr_t)lds + (unsigned)wid * 1024u));
    const unsigned ldsw = (unsigned)wid * 1024u;
    const int aoff = lds_byte(wr * 64 + fr, fq * 8), boff = lds_byte(wc * 32 + fr, fq * 8);
#define PG8_SA(b, h) (((b) * 2 + (h)) * HTB)
#define PG8_SB(b, h) ((4 + (b) * 2 + (h)) * HTB)
#define PG8_STAGE(bufoff, gbase, voff) do { _Pragma("unroll") for (int _i = 0; _i < 2; ++_i) { \
        if constexpr (F8) { unsigned keep_; asm volatile("s_mov_b32 %0, m0\n\ts_mov_b32 m0, %3\n\ts_nop 0\n\tglobal_load_lds_dwordx4 %1, %2\n\ts_mov_b32 m0, %0" : "=&s"(keep_) : "v"((voff)[_i]), "s"((const char*)(gbase)), "s"(ldsbase + (unsigned)((bufoff) + _i * 8192)) : "memory"); } \
        else __builtin_amdgcn_global_load_lds((const unsigned*)((const char*)(gbase) + (voff)[_i]), (PG8_LAS unsigned*)(lds + (bufoff) + ldsw + _i * 8192), 16, 0, 0); } } while (0)
#define PG8_LDA(dst, b, h) do { _Pragma("unroll") for (int m = 0; m < 4; ++m) { _Pragma("unroll") for (int k = 0; k < 2; ++k) dst[m][k] = *(const PG8_LAS bf16x8*)(lds + PG8_SA(b, h) + aoff + m * 2048 + k * 1024); \
        if constexpr (F8) dst##8[m] = cat16(dst[m][0], dst[m][1]); } } while (0)
#define PG8_LDB(dst, b, h) do { _Pragma("unroll") for (int n = 0; n < 2; ++n) { _Pragma("unroll") for (int k = 0; k < 2; ++k) dst[n][k] = *(const PG8_LAS bf16x8*)(lds + PG8_SB(b, h) + boff + n * 2048 + k * 1024); \
        if constexpr (F8) dst##8[n] = cat16(dst[n][0], dst[n][1]); } } while (0)
#define PG8_MMA(ai, bj, At, Bt) do { __builtin_amdgcn_s_setprio(1); _Pragma("unroll") for (int m = 0; m < 4; ++m) _Pragma("unroll") for (int n = 0; n < 2; ++n) { \
        if constexpr (F8) acc[ai][bj][m][n] = __builtin_amdgcn_mfma_scale_f32_16x16x128_f8f6f4(Bt##8[n], At##8[m], acc[ai][bj][m][n], 0, 0, 0, 0x7f7f7f7f, 0, 0x7f7f7f7f); \
        else { _Pragma("unroll") for (int k = 0; k < 2; ++k) acc[ai][bj][m][n] = __builtin_amdgcn_mfma_f32_16x16x32_bf16(Bt[n][k], At[m][k], acc[ai][bj][m][n], 0, 0, 0); } } __builtin_amdgcn_s_setprio(0); } while (0)
#define PG8_WAIT_V(n) asm volatile("s_waitcnt vmcnt(" #n ")" ::: "memory")
#define PG8_WAIT_L(n) asm volatile("s_waitcnt lgkmcnt(" #n ")" ::: "memory")
#define PG8_BAR __builtin_amdgcn_s_barrier()
#define PG8_SCHED __builtin_amdgcn_sched_barrier(0)
    Unit cur, nxt; int ui = 0;
    if (!S.next(0, cur)) return;
    f32x4 acc[2][2][4][2];
#pragma unroll
    for (int a = 0; a < 2; ++a)
#pragma unroll
        for (int b = 0; b < 2; ++b)
#pragma unroll
            for (int m = 0; m < 4; ++m)
#pragma unroll
                for (int n = 0; n < 2; ++n) acc[a][b][m][n] = (f32x4){0.f, 0.f, 0.f, 0.f};
    bf16x8 At[4][2], B0[2][2], B1[2][2]; v8i32 At8[4], B08[2], B18[2]; (void)At8; (void)B08; (void)B18;
    const char* cA = cur.a; const char* cB = cur.b;
    S.a_ready(cur);
    if constexpr (SP2) {
        PG8_STAGE(PG8_SB(0, 0), cB, voffB); PG8_STAGE(PG8_SB(0, 1), cB + hstep, voffB); PG8_STAGE(PG8_SA(0, 0), cA, voffA); PG8_STAGE(PG8_SA(0, 1), cA + hstepA, voffA);
        if (wr == 1) PG8_BAR;
        PG8_WAIT_V(2); PG8_BAR;
        PG8_STAGE(PG8_SB(1, 0), cB + kstep, voffB); PG8_STAGE(PG8_SA(1, 0), cA + kstep, voffA); PG8_STAGE(PG8_SB(1, 1), cB + hstep + kstep, voffB);
        PG8_WAIT_V(6); PG8_BAR;
    } else {
        PG8_STAGE(PG8_SB(0, 0), cB, voffB); PG8_STAGE(PG8_SA(0, 0), cA, voffA); PG8_STAGE(PG8_SB(0, 1), cB + hstep, voffB); PG8_STAGE(PG8_SA(0, 1), cA + hstepA, voffA);
        if (wr == 1) PG8_BAR;
        PG8_WAIT_V(4); PG8_BAR;
        PG8_STAGE(PG8_SB(1, 0), cB + kstep, voffB); PG8_STAGE(PG8_SA(1, 0), cA + kstep, voffA); PG8_STAGE(PG8_SB(1, 1), cB + hstep + kstep, voffB);
        PG8_WAIT_V(6); PG8_BAR;
    }
    for (;;) {
        const bool has_next = S.next(ui + 1, nxt);
        const char* nA = has_next ? nxt.a : cA; const char* nB = has_next ? nxt.b : cB;
#pragma unroll 1
        for (int t = 0; t < nt; t += 2) {
            const bool last = (t == nt - 2);
            const char* a1 = cA + (size_t)(t + 1) * kstep;
            const char* a2 = last ? nA : cA + (size_t)(t + 2) * kstep; const char* b2 = last ? nB : cB + (size_t)(t + 2) * kstep;
            const char* a3 = a2 + kstep; const char* b3 = b2 + kstep;
            if (last && has_next) S.a_ready(nxt);
            if constexpr (SP2) {
            PG8_LDB(B0, 0, 0); PG8_LDB(B1, 0, 1); PG8_SCHED; PG8_LDA(At, 0, 0); PG8_STAGE(PG8_SA(1, 1), a1 + hstepA, voffA);
            PG8_WAIT_V(8); PG8_WAIT_L(0); PG8_BAR; PG8_MMA(0, 0, At, B0); PG8_MMA(0, 1, At, B1); PG8_BAR; PG8_SCHED;
            PG8_LDA(At, 0, 1); PG8_STAGE(PG8_SB(0, 0), b2, voffB); PG8_STAGE(PG8_SB(0, 1), b2 + hstep, voffB); PG8_STAGE(PG8_SA(0, 0), a2, voffA);
            PG8_WAIT_V(8); PG8_WAIT_L(0); PG8_BAR; PG8_MMA(1, 0, At, B0); PG8_MMA(1, 1, At, B1); PG8_BAR; PG8_SCHED;
            PG8_LDB(B0, 1, 0); PG8_LDB(B1, 1, 1); PG8_SCHED; PG8_LDA(At, 1, 0); PG8_STAGE(PG8_SA(0, 1), a2 + hstepA, voffA);
            PG8_WAIT_V(8); PG8_WAIT_L(0); PG8_BAR; PG8_MMA(0, 0, At, B0); PG8_MMA(0, 1, At, B1); PG8_BAR; PG8_SCHED;
            PG8_LDA(At, 1, 1); PG8_STAGE(PG8_SB(1, 0), b3, voffB); PG8_STAGE(PG8_SB(1, 1), b3 + hstep, voffB); PG8_STAGE(PG8_SA(1, 0), a3, voffA);
            PG8_WAIT_V(8); PG8_WAIT_L(0); PG8_BAR; PG8_MMA(1, 0, At, B0); PG8_MMA(1, 1, At, B1); PG8_BAR; PG8_SCHED;
            } else {
            PG8_LDB(B0, 0, 0); PG8_SCHED; PG8_LDA(At, 0, 0); PG8_STAGE(PG8_SA(1, 1), a1 + hstepA, voffA);
            PG8_WAIT_L(8); PG8_BAR; PG8_WAIT_L(0); PG8_MMA(0, 0, At, B0); PG8_BAR; PG8_SCHED;
            PG8_LDB(B1, 0, 1); PG8_STAGE(PG8_SB(0, 0), b2, voffB);
            PG8_BAR; PG8_WAIT_L(0); PG8_MMA(0, 1, At, B1); PG8_BAR;
            PG8_LDA(At, 0, 1); PG8_STAGE(PG8_SA(0, 0), a2, voffA);
            PG8_BAR; PG8_WAIT_L(0); PG8_MMA(1, 0, At, B0); PG8_BAR; PG8_SCHED;
            PG8_STAGE(PG8_SB(0, 1), b2 + hstep, voffB);
            PG8_WAIT_V(6); PG8_BAR; PG8_MMA(1, 1, At, B1); PG8_BAR;
            PG8_LDB(B0, 1, 0); PG8_SCHED; PG8_LDA(At, 1, 0); PG8_STAGE(PG8_SA(0, 1), a2 + hstepA, voffA);
            PG8_WAIT_L(8); PG8_BAR; PG8_WAIT_L(0); PG8_MMA(0, 0, At, B0); PG8_BAR; PG8_SCHED;
            PG8_LDB(B1, 1, 1); PG8_STAGE(PG8_SB(1, 0), b3, voffB);
            PG8_BAR; PG8_WAIT_L(0); PG8_MMA(0, 1, At, B1); PG8_BAR;
            PG8_LDA(At, 1, 1); PG8_STAGE(PG8_SA(1, 0), a3, voffA);
            PG8_BAR; PG8_WAIT_L(0); PG8_MMA(1, 0, At, B0); PG8_BAR; PG8_SCHED;
            PG8_STAGE(PG8_SB(1, 1), b3 + hstep, voffB);
            PG8_WAIT_V(6); PG8_BAR; PG8_MMA(1, 1, At, B1); PG8_BAR;
            }
        }
        if constexpr (ALIGN_EPI) { if (wr == 0) PG8_BAR; }
        if constexpr (!Epi::AFTER_DRAIN) { int tl_ = tid; asm volatile("" : "+v"(tl_)); E(acc, cur, wr, wc, tl_ & 15, (tl_ & 63) >> 4); S.done(cur); }
        if (!has_next) break;
#pragma unroll
        for (int a = 0; a < 2; ++a)
#pragma unroll
            for (int b = 0; b < 2; ++b)
#pragma unroll
                for (int m = 0; m < 4; ++m)
#pragma unroll
                    for (int n = 0; n < 2; ++n) acc[a][b][m][n] = (f32x4){0.f, 0.f, 0.f, 0.f};
        cur = nxt; cA = nA; cB = nB; ++ui;
        if constexpr (ALIGN_EPI) { if (wr == 1) PG8_BAR; }
    }
    PG8_WAIT_V(0);
    if constexpr (!ALIGN_EPI) { if (wr == 0) PG8_BAR; }
    PG8_BAR;
    if constexpr (Epi::AFTER_DRAIN) { E.fused(acc, cur, wr, wc, fr, fq, lds, wid, lane); S.done(cur); }
#undef PG8_SA
#undef PG8_SB
#undef PG8_STAGE
#undef PG8_LDA
#undef PG8_LDB
#undef PG8_MMA
#undef PG8_WAIT_V
#undef PG8_WAIT_L
#undef PG8_BAR
#undef PG8_SCHED
}
}
namespace pg8 {
struct OrderMap {
    __device__ __forceinline__ static bool map(int i, int G, int c, int nM, int nN, int& pm, int& pn) {
        const int nwg = nM * nN; const long L = (long)i * G + c; if (L >= nwg) return false;
        int wgid = (int)L; { const int q = nwg / NXCD, r = nwg % NXCD, xcd = wgid % NXCD, off = wgid / NXCD; wgid = (xcd < r ? xcd * (q + 1) : r * (q + 1) + (xcd - r) * q) + off; }
        const int nig = WGM * nN, gid = wgid / nig, fm = gid * WGM, gsz = (nM - fm) < WGM ? (nM - fm) : WGM;
        pm = fm + ((wgid % nig) % gsz); pn = (wgid % nig) / gsz; return true;
    }
};
struct DenseOrder {
    const char* A; const char* B; int nM, nN, G, c; size_t tstepA, tstepB;
    __device__ __forceinline__ bool next(int i, Unit& u) const { int pm, pn; if (!OrderMap::map(i, G, c, nM, nN, pm, pn)) return false; u.pm = pm; u.pn = pn; u.aux = 0; u.a = A + (size_t)pm * tstepA; u.b = B + (size_t)pn * tstepB; return true; }
    __device__ __forceinline__ void a_ready(const Unit&) const {}
    __device__ __forceinline__ void done(const Unit&) const {}
};
struct MoeOrder {
    const char* A; const char* B; const PG8_LAS int* tile_e; int nM, nN, G, c; size_t tstep, estep;
    __device__ __forceinline__ bool next(int i, Unit& u) const { int pm, pn; if (!OrderMap::map(i, G, c, nM, nN, pm, pn)) return false; const int e = __builtin_amdgcn_readfirstlane(tile_e[pm]); u.pm = pm; u.pn = pn; u.aux = e;
        u.a = A + (size_t)pm * tstep; u.b = B + (size_t)e * estep + (size_t)pn * tstep; return true; }
    __device__ __forceinline__ void a_ready(const Unit&) const {}
    __device__ __forceinline__ void done(const Unit&) const {}
};
struct EpiStoreBf16 { static constexpr bool PERM = true, AFTER_DRAIN = false;
    bf16_t* O; int ldc; float ascale;
    __device__ __forceinline__ void operator()(const f32x4 (&acc)[2][2][4][2], const Unit& u, int wr, int wc, int fr, int fq) const {
        bf16_t* base = O + (size_t)(u.pm * BM + wr * 64 + fr) * ldc + u.pn * BM + wc * 32 + 8 * fq;
        float asc = ascale; asm volatile("" : "+v"(asc));
#pragma unroll
        for (int ai = 0; ai < 2; ++ai)
#pragma unroll
            for (int m = 0; m < 4; ++m) { bf16_t* rowp = base + (size_t)(ai * HALF + m * 16) * ldc;
#pragma unroll
                for (int bj = 0; bj < 2; ++bj) { const f32x4 v0 = acc[ai][bj][m][0] * asc, v1 = acc[ai][bj][m][1] * asc; u32x4 w;
                    w.x = cvt_pk_bf16(v0[0], v0[1]); w.y = cvt_pk_bf16(v0[2], v0[3]); w.z = cvt_pk_bf16(v1[0], v1[1]); w.w = cvt_pk_bf16(v1[2], v1[3]);
                    *(u32x4*)(rowp + bj * HALF) = w; } }
    }
};
struct EpiScaleBf16 { static constexpr bool PERM = true, AFTER_DRAIN = false;
    bf16_t* O; int ldc; const float* rs;
    __device__ __forceinline__ void operator()(const f32x4 (&acc)[2][2][4][2], const Unit& u, int wr, int wc, int fr, int fq) const {
        const int row0 = u.pm * BM + wr * 64 + fr; bf16_t* base = O + (size_t)row0 * ldc + u.pn * BM + wc * 32 + 8 * fq;
#pragma unroll
        for (int ai = 0; ai < 2; ++ai)
#pragma unroll
            for (int m = 0; m < 4; ++m) { bf16_t* rowp = base + (size_t)(ai * HALF + m * 16) * ldc; const float sc = rs[2 * (row0 + ai * HALF + m * 16)];
#pragma unroll
                for (int bj = 0; bj < 2; ++bj) { const f32x4 v0 = acc[ai][bj][m][0] * sc, v1 = acc[ai][bj][m][1] * sc; u32x4 w;
                    w.x = cvt_pk_bf16(v0[0], v0[1]); w.y = cvt_pk_bf16(v0[2], v0[3]); w.z = cvt_pk_bf16(v1[0], v1[1]); w.w = cvt_pk_bf16(v1[2], v1[3]);
                    *(u32x4*)(rowp + bj * HALF) = w; } }
    }
};
template <typename ST, typename OT>
struct EpiResidT { static constexpr bool PERM = true, AFTER_DRAIN = false;
    const ST* src_lat; const ST* src_ctx; OT* out; const float* mod_g1; float ascale;
    __device__ __forceinline__ void operator()(const f32x4 (&acc)[2][2][4][2], const Unit& u, int wr, int wc, int fr, int fq) const {
        const int row_t = u.pm * BM; const int mrow = row_t < NLAT ? row_t / SEQ : NB;
        const float* g = mod_g1 + (size_t)mrow * 6144 + u.pn * BM + wc * 32 + 8 * fq;
        const ST* sb = (row_t < NLAT ? src_lat + (size_t)row_t * 1024 : src_ctx + (size_t)(row_t - NLAT) * 1024) + u.pn * BM + wc * 32 + 8 * fq;
        OT* ob = out + (size_t)row_t * 1024 + u.pn * BM + wc * 32 + 8 * fq;
        f32x4 gv[2][2];
#pragma unroll
        for (int bj = 0; bj < 2; ++bj)
#pragma unroll
            for (int n = 0; n < 2; ++n) gv[bj][n] = *(const f32x4*)(g + bj * HALF + 4 * n) * ascale;
#pragma unroll
        for (int ai = 0; ai < 2; ++ai)
#pragma unroll
            for (int m = 0; m < 4; ++m) { const size_t off = (size_t)(wr * 64 + fr + ai * HALF + m * 16) * 1024;
#pragma unroll
                for (int bj = 0; bj < 2; ++bj) { f32x4 sv[2];
                    if constexpr (sizeof(ST) == 2) { const u32x4 t = *(const u32x4*)(sb + off + bj * HALF);
                        sv[0] = (f32x4){__uint_as_float(t[0] << 16), __uint_as_float(t[0] & 0xffff0000u), __uint_as_float(t[1] << 16), __uint_as_float(t[1] & 0xffff0000u)};
                        sv[1] = (f32x4){__uint_as_float(t[2] << 16), __uint_as_float(t[2] & 0xffff0000u), __uint_as_float(t[3] << 16), __uint_as_float(t[3] & 0xffff0000u)}; }
                    else { sv[0] = *(const f32x4*)(sb + off + bj * HALF); sv[1] = *(const f32x4*)(sb + off + bj * HALF + 4); }
                    const f32x4 o0 = sv[0] + gv[bj][0] * acc[ai][bj][m][0], o1 = sv[1] + gv[bj][1] * acc[ai][bj][m][1];
                    if constexpr (sizeof(OT) == 2) { u32x4 t; t[0] = cvt_pk_bf16(o0[0], o0[1]); t[1] = cvt_pk_bf16(o0[2], o0[3]); t[2] = cvt_pk_bf16(o1[0], o1[1]); t[3] = cvt_pk_bf16(o1[2], o1[3]); *(u32x4*)(ob + off + bj * HALF) = t; }
                    else { *(f32x4*)(ob + off + bj * HALF) = o0; *(f32x4*)(ob + off + bj * HALF + 4) = o1; } }
                asm volatile("" ::: "memory"); }
    }
};
__device__ __forceinline__ float swiglu1(float g, float l, float c7, float cn) {
    const float glu = fminf(g, c7), lin = fminf(fmaxf(l, -c7), c7);
    const float sg = __builtin_amdgcn_rcpf(1.0f + __builtin_amdgcn_exp2f(cn * glu));
    return glu * sg * (lin + 1.0f);
}
struct EpiSwiglu { static constexpr bool PERM = true, AFTER_DRAIN = false;
    bf16_t* O; const float* bias; float ascale;
    __device__ __forceinline__ void operator()(const f32x4 (&acc)[2][2][4][2], const Unit& u, int wr, int wc, int fr, int fq) const {
        const int col0 = u.pn * BM + wc * 32 + 8 * fq; const float* b = bias + (size_t)u.aux * 2048 + col0;
        float c7 = 7.0f, cn = -1.702f * 1.4426950408889634f; asm volatile("" : "+v"(c7), "+v"(cn));
        bf16_t* base = O + (size_t)(u.pm * BM + wr * 64 + fr) * 1024 + (col0 >> 1);
        f32x4 bv[2][2];
#pragma unroll
        for (int bj = 0; bj < 2; ++bj)
#pragma unroll
            for (int n = 0; n < 2; ++n) bv[bj][n] = *(const f32x4*)(b + bj * HALF + 4 * n);
#pragma unroll
        for (int ai = 0; ai < 2; ++ai)
#pragma unroll
            for (int m = 0; m < 4; ++m) { bf16_t* rowp = base + (size_t)(ai * HALF + m * 16) * 1024;
#pragma unroll
                for (int bj = 0; bj < 2; ++bj) { const f32x4 v0 = acc[ai][bj][m][0] * ascale + bv[bj][0], v1 = acc[ai][bj][m][1] * ascale + bv[bj][1];
                    uint2 w; w.x = cvt_pk_bf16(swiglu1(v0[0], v0[1], c7, cn), swiglu1(v0[2], v0[3], c7, cn)); w.y = cvt_pk_bf16(swiglu1(v1[0], v1[1], c7, cn), swiglu1(v1[2], v1[3], c7, cn));
                    *(uint2*)(rowp + bj * (HALF / 2)) = w; } }
    }
};
struct EpiSwigluF8 { static constexpr bool PERM = true, AFTER_DRAIN = false;
    unsigned char* O; const float* bias;
    __device__ __forceinline__ void operator()(const f32x4 (&acc)[2][2][4][2], const Unit& u, int wr, int wc, int fr, int fq) const {
        const int col0 = u.pn * BM + wc * 32 + 8 * fq; const float* b = bias + (size_t)u.aux * 2048 + col0;
        float c7 = 7.0f, cn = -1.702f * 1.4426950408889634f, c32 = 0.03125f; asm volatile("" : "+v"(c7), "+v"(cn), "+v"(c32));
        unsigned char* base = O + (size_t)(u.pm * BM + wr * 64 + fr) * 1024 + (col0 >> 1);
        f32x4 bv[2][2];
#pragma unroll
        for (int bj = 0; bj < 2; ++bj)
#pragma unroll
            for (int n = 0; n < 2; ++n) bv[bj][n] = *(const f32x4*)(b + bj * HALF + 4 * n);
#pragma unroll
        for (int ai = 0; ai < 2; ++ai)
#pragma unroll
            for (int m = 0; m < 4; ++m) { unsigned char* rowp = base + (size_t)(ai * HALF + m * 16) * 1024;
#pragma unroll
                for (int bj = 0; bj < 2; ++bj) { const f32x4 v0 = acc[ai][bj][m][0] * c32 + bv[bj][0], v1 = acc[ai][bj][m][1] * c32 + bv[bj][1];
                    int w = __builtin_amdgcn_cvt_pk_fp8_f32(swiglu1(v0[0], v0[1], c7, cn), swiglu1(v0[2], v0[3], c7, cn), 0, false); w = __builtin_amdgcn_cvt_pk_fp8_f32(swiglu1(v1[0], v1[1], c7, cn), swiglu1(v1[2], v1[3], c7, cn), w, true);
                    *(int*)(rowp + bj * (HALF / 2)) = w; } }
    }
};
struct EpiBiasF8 { static constexpr bool PERM = true, AFTER_DRAIN = false;
    unsigned char* O; const float* bias; float ascale;
    __device__ __forceinline__ void operator()(const f32x4 (&acc)[2][2][4][2], const Unit& u, int wr, int wc, int fr, int fq) const {
        const int col0 = u.pn * BM + wc * 32 + 8 * fq; const float* b = bias + (size_t)u.aux * 1024 + col0;
        float asc = ascale; asm volatile("" : "+v"(asc));
        unsigned char* base = O + (size_t)(u.pm * BM + wr * 64 + fr) * 1024 + col0;
        f32x4 bv[2][2];
#pragma unroll
        for (int bj = 0; bj < 2; ++bj)
#pragma unroll
            for (int n = 0; n < 2; ++n) bv[bj][n] = *(const f32x4*)(b + bj * HALF + 4 * n);
#pragma unroll
        for (int ai = 0; ai < 2; ++ai)
#pragma unroll
            for (int m = 0; m < 4; ++m) { unsigned char* rowp = base + (size_t)(ai * HALF + m * 16) * 1024;
#pragma unroll
                for (int bj = 0; bj < 2; ++bj) { const f32x4 v0 = acc[ai][bj][m][0] * asc + bv[bj][0], v1 = acc[ai][bj][m][1] * asc + bv[bj][1];
                    int lo = __builtin_amdgcn_cvt_pk_fp8_f32(v0[0], v0[1], 0, false); lo = __builtin_amdgcn_cvt_pk_fp8_f32(v0[2], v0[3], lo, true);
                    int hi = __builtin_amdgcn_cvt_pk_fp8_f32(v1[0], v1[1], 0, false); hi = __builtin_amdgcn_cvt_pk_fp8_f32(v1[2], v1[3], hi, true);
                    *(int2*)(rowp + bj * HALF) = make_int2(lo, hi); } }
    }
};
struct EpiBiasBf16 { static constexpr bool PERM = true, AFTER_DRAIN = false;
    bf16_t* O; const float* bias; float ascale;
    __device__ __forceinline__ void operator()(const f32x4 (&acc)[2][2][4][2], const Unit& u, int wr, int wc, int fr, int fq) const {
        const int col0 = u.pn * BM + wc * 32 + 8 * fq; const float* b = bias + (size_t)u.aux * 1024 + col0;
        float asc = ascale; asm volatile("" : "+v"(asc));
        bf16_t* base = O + (size_t)(u.pm * BM + wr * 64 + fr) * 1024 + col0;
        f32x4 bv[2][2];
#pragma unroll
        for (int bj = 0; bj < 2; ++bj)
#pragma unroll
            for (int n = 0; n < 2; ++n) bv[bj][n] = *(const f32x4*)(b + bj * HALF + 4 * n);
#pragma unroll
        for (int ai = 0; ai < 2; ++ai)
#pragma unroll
            for (int m = 0; m < 4; ++m) { bf16_t* rowp = base + (size_t)(ai * HALF + m * 16) * 1024;
#pragma unroll
                for (int bj = 0; bj < 2; ++bj) { const f32x4 v0 = acc[ai][bj][m][0] * asc + bv[bj][0], v1 = acc[ai][bj][m][1] * asc + bv[bj][1]; u32x4 w;
                    w.x = cvt_pk_bf16(v0[0], v0[1]); w.y = cvt_pk_bf16(v0[2], v0[3]); w.z = cvt_pk_bf16(v1[0], v1[1]); w.w = cvt_pk_bf16(v1[2], v1[3]);
                    *(u32x4*)(rowp + bj * HALF) = w; } }
    }
};
}
__device__ __forceinline__ unsigned pk2(float lo, float hi) { return (unsigned)f2bf(lo) | ((unsigned)f2bf(hi) << 16); }
__device__ __forceinline__ void transpose_item(const float* __restrict__ W, int K, int N, bf16_t* __restrict__ WT, LAS float* scr, int item, int lane, const float* rowscale = nullptr, float cscale = 1.0f, int cs_ncols = 1 << 30) {
    const int nblk = N / 32, kb = item / nblk, nb = item % nblk, k0 = 64 * kb, n0 = 32 * nb;
    const float cs = n0 < cs_ncols ? cscale : 1.0f;
#pragma unroll 8
    for (int i = 0; i < 32; ++i) { const int kk = 2 * i + (lane >> 5); float w = W[(size_t)(k0 + kk) * N + n0 + (lane & 31)]; if (rowscale) w *= rowscale[k0 + kk]; scr[kk * 33 + (lane & 31)] = w * cs; }
    asm volatile("s_waitcnt lgkmcnt(0)" ::: "memory");
    const int c = lane & 7;
#pragma unroll
    for (int j = 0; j < 4; ++j) { const int n = (lane >> 3) + 8 * j; const LAS float* sp = scr + (8 * c) * 33 + n;
        uint4 o; o.x = pk2(sp[0 * 33], sp[1 * 33]); o.y = pk2(sp[2 * 33], sp[3 * 33]); o.z = pk2(sp[4 * 33], sp[5 * 33]); o.w = pk2(sp[6 * 33], sp[7 * 33]);
        *(uint4*)(WT + (size_t)(n0 + n) * K + k0 + 8 * c) = o; }
    asm volatile("s_waitcnt lgkmcnt(0)" ::: "memory");
}

__device__ __forceinline__ void transpose_item_f8(const float* __restrict__ W, int K, int N, unsigned char* __restrict__ WT, LAS float* scr, int item, int lane, float cscale = 1.0f, int cs_ncols = 1 << 30) {
    const int nblk = N / 32, kb = item / nblk, nb = item % nblk, k0 = 64 * kb, n0 = 32 * nb;
    const float cs = 32.0f * (n0 < cs_ncols ? cscale : 1.0f);
#pragma unroll 8
    for (int i = 0; i < 32; ++i) { const int kk = 2 * i + (lane >> 5); scr[kk * 33 + (lane & 31)] = W[(size_t)(k0 + kk) * N + n0 + (lane & 31)] * cs; }
    asm volatile("s_waitcnt lgkmcnt(0)" ::: "memory");
    const int c = lane & 7;
#pragma unroll
    for (int j = 0; j < 4; ++j) { const int n = (lane >> 3) + 8 * j; const LAS float* sp = scr + (8 * c) * 33 + n;
        int lo = __builtin_amdgcn_cvt_pk_fp8_f32(sp[0 * 33], sp[1 * 33], 0, false); lo = __builtin_amdgcn_cvt_pk_fp8_f32(sp[2 * 33], sp[3 * 33], lo, true);
        int hi = __builtin_amdgcn_cvt_pk_fp8_f32(sp[4 * 33], sp[5 * 33], 0, false); hi = __builtin_amdgcn_cvt_pk_fp8_f32(sp[6 * 33], sp[7 * 33], hi, true);
        *(int2*)(WT + (size_t)(n0 + n) * K + k0 + 8 * c) = make_int2(lo, hi); }
    asm volatile("s_waitcnt lgkmcnt(0)" ::: "memory");
}
template <bool F8OUT>
__device__ __forceinline__ void transpose_item64(const float* __restrict__ W, int K, int N, void* __restrict__ WT, LAS float* scr, int item, int lane, const float* rowscale = nullptr, float cscale = 1.0f) {
    const int nblk = N / 64, kb = item / nblk, nb = item % nblk, k0 = 64 * kb, n0 = 64 * nb;
    const float cs = cscale * (F8OUT ? 32.0f : 1.0f);
    float4 wv[16];
#pragma unroll
    for (int i = 0; i < 16; ++i) wv[i] = *(const float4*)(W + (size_t)(k0 + 4 * i + (lane >> 4)) * N + n0 + 4 * (lane & 15));
#pragma unroll
    for (int i = 0; i < 16; ++i) { const int kk = 4 * i + (lane >> 4); const float4 w = wv[i];
        const float rs = rowscale ? rowscale[k0 + kk] * cs : cs; LAS float* d = scr + kk * 65 + 4 * (lane & 15); d[0] = w.x * rs; d[1] = w.y * rs; d[2] = w.z * rs; d[3] = w.w * rs; }
    asm volatile("s_waitcnt lgkmcnt(0)" ::: "memory");
    const int c = lane & 7;
#pragma unroll
    for (int j = 0; j < 8; ++j) { const int n = (lane >> 3) + 8 * j; const LAS float* sp = scr + (8 * c) * 65 + n;
        if constexpr (F8OUT) { int lo = __builtin_amdgcn_cvt_pk_fp8_f32(sp[0 * 65], sp[1 * 65], 0, false); lo = __builtin_amdgcn_cvt_pk_fp8_f32(sp[2 * 65], sp[3 * 65], lo, true);
            int hi = __builtin_amdgcn_cvt_pk_fp8_f32(sp[4 * 65], sp[5 * 65], 0, false); hi = __builtin_amdgcn_cvt_pk_fp8_f32(sp[6 * 65], sp[7 * 65], hi, true);
            *(int2*)((unsigned char*)WT + (size_t)(n0 + n) * K + k0 + 8 * c) = make_int2(lo, hi); }
        else { uint4 o; o.x = pk2(sp[0 * 65], sp[1 * 65]); o.y = pk2(sp[2 * 65], sp[3 * 65]); o.z = pk2(sp[4 * 65], sp[5 * 65]); o.w = pk2(sp[6 * 65], sp[7 * 65]);
            *(uint4*)((bf16_t*)WT + (size_t)(n0 + n) * K + k0 + 8 * c) = o; } }
    asm volatile("s_waitcnt lgkmcnt(0)" ::: "memory");
}
namespace fa {
using bf16x8 = __attribute__((ext_vector_type(8))) short;
using s16x4  = __attribute__((ext_vector_type(4))) short;
using f32x16 = __attribute__((ext_vector_type(16))) float;
using u32x4  = __attribute__((ext_vector_type(4))) unsigned;
constexpr int QBLK = 32, KVBLK = 64, NW = 8;
constexpr int SHM_V = KVBLK * 128 * 2, SHM_K = KVBLK * 128 * 2, SHM_ATTN = 2 * SHM_V + 2 * SHM_K + NW * 64 * 4;
constexpr float LOG2E = 1.4426950408889634f, THR = 8.0f, NEGS = -1.0e30f;
#define FA_KSWZ(row, colB) ((row) * 256 + ((colB) ^ (((row) & 7) << 4)))
#define FA_SBAR() __builtin_amdgcn_sched_barrier(0)
__device__ __forceinline__ int crow(int r, int hi) { return (r & 3) + 8 * (r >> 2) + 4 * hi; }
__device__ __forceinline__ unsigned cvtpk(float lo, float hi) { unsigned r; asm volatile("v_cvt_pk_bf16_f32 %0, %1, %2" : "=v"(r) : "v"(lo), "v"(hi)); return r; }
__device__ __forceinline__ void partialSM(f32x16& p0, f32x16& p1, float& m_reg, float& mn, float& alpha) {
  float pmax = p0[0];
#pragma unroll
  for (int r = 1; r < 16; ++r) pmax = fmaxf(pmax, p0[r]);
#pragma unroll
  for (int r = 0; r < 16; ++r) pmax = fmaxf(pmax, p1[r]);
  { auto rr = __builtin_amdgcn_permlane32_swap(__float_as_uint(pmax), __float_as_uint(pmax), false, false);
    pmax = fmaxf(__uint_as_float(rr[0]), __uint_as_float(rr[1])); }
  if (__builtin_expect(__all(pmax - m_reg <= THR), 1)) { mn = m_reg; alpha = 1.f; }
  else { mn = fmaxf(m_reg, pmax); alpha = __builtin_amdgcn_exp2f((m_reg - mn) * LOG2E); m_reg = mn; }
  const float mnC = -mn * LOG2E;
#pragma unroll
  for (int r = 0; r < 16; ++r) p0[r] = fmaf(p0[r], LOG2E, mnC);
#pragma unroll
  for (int r = 0; r < 16; ++r) p1[r] = fmaf(p1[r], LOG2E, mnC);
#pragma unroll
  for (int r = 0; r < 16; ++r) p0[r] = __builtin_amdgcn_exp2f(p0[r]);
}
__device__ __forceinline__ void finishSM(f32x16& p0, f32x16& p1, float alpha, float& l_reg, bf16x8& pa0, bf16x8& pa1, bf16x8& pa2, bf16x8& pa3) {
#pragma unroll
  for (int r = 0; r < 16; ++r) p1[r] = __builtin_amdgcn_exp2f(p1[r]);
  float ps = 0;
#pragma unroll
  for (int r = 0; r < 16; ++r) ps += p0[r];
#pragma unroll
  for (int r = 0; r < 16; ++r) ps += p1[r];
  { auto rr = __builtin_amdgcn_permlane32_swap(__float_as_uint(ps), __float_as_uint(ps), false, false);
    ps = __uint_as_float(rr[0]) + __uint_as_float(rr[1]); }
  l_reg = l_reg * alpha + ps;
#define FA_PK4(P, BASE, OUT) do { unsigned a0 = cvtpk(P[BASE + 0], P[BASE + 1]), a1 = cvtpk(P[BASE + 2], P[BASE + 3]);   \
    unsigned b0 = cvtpk(P[BASE + 4], P[BASE + 5]), b1 = cvtpk(P[BASE + 6], P[BASE + 7]);                              \
    auto r0 = __builtin_amdgcn_permlane32_swap(a0, b0, false, false); auto r1 = __builtin_amdgcn_permlane32_swap(a1, b1, false, false); \
    u32x4 w = {r0[0], r1[0], r0[1], r1[1]}; OUT = *reinterpret_cast<bf16x8*>(&w); } while (0)
  FA_PK4(p0, 0, pa0); FA_PK4(p0, 8, pa1); FA_PK4(p1, 0, pa2); FA_PK4(p1, 8, pa3);
#undef FA_PK4
}
template <int NQ> __device__ __forceinline__ void qkt(f32x16& p0, f32x16& p1, const char* Ks, const bf16x8* qr, int r32, int hi) {
  p0 = f32x16{}; p1 = f32x16{};
#pragma unroll
  for (int d0 = 0; d0 < NQ; ++d0) { const int cb = (d0 * 16 + hi * 8) * 2;
    const bf16x8 b0 = *reinterpret_cast<const bf16x8*>(Ks + FA_KSWZ(r32, cb));
    const bf16x8 b1 = *reinterpret_cast<const bf16x8*>(Ks + FA_KSWZ(32 + r32, cb));
    p0 = __builtin_amdgcn_mfma_f32_32x32x16_bf16(b0, qr[d0], p0, 0, 0, 0);
    p1 = __builtin_amdgcn_mfma_f32_32x32x16_bf16(b1, qr[d0], p1, 0, 0, 0); }
}
__device__ __forceinline__ int v_st(int k, int c) { const int kk = (k & ~0xC) | ((k & 4) << 1) | ((k & 8) >> 1); return ((kk >> 3) * 4 + (c >> 5)) * 512 + ((kk & 7) * 32 + (c & 31)) * 2; }
__device__ __forceinline__ int v_rd_base(int lane) { return ((lane & 3) << 3) | (((lane >> 2) & 3) << 6) | (((lane >> 4) & 1) << 5) | (((lane >> 5) & 1) << 8); }
constexpr int v_rd_off(int d0, int ks, int half) { return d0 * 512 + ks * 4096 + half * 2048; }
template <int OFF> __device__ __forceinline__ s16x4 tr_read(int vb) {
  s16x4 r; asm volatile("ds_read_b64_tr_b16 %0, %1 offset:%2" : "=&v"(r) : "v"(vb), "i"(OFF) : "memory"); return r;
}
template <int D0> __device__ __forceinline__ void pv_one(f32x16& od, int vb, bf16x8 pa0, bf16x8 pa1, bf16x8 pa2, bf16x8 pa3) {
  const s16x4 l0 = tr_read<v_rd_off(D0, 0, 0)>(vb), h0 = tr_read<v_rd_off(D0, 0, 1)>(vb), l1 = tr_read<v_rd_off(D0, 1, 0)>(vb), h1 = tr_read<v_rd_off(D0, 1, 1)>(vb);
  const s16x4 l2 = tr_read<v_rd_off(D0, 2, 0)>(vb), h2 = tr_read<v_rd_off(D0, 2, 1)>(vb), l3 = tr_read<v_rd_off(D0, 3, 0)>(vb), h3 = tr_read<v_rd_off(D0, 3, 1)>(vb);
  asm volatile("s_waitcnt lgkmcnt(0)" ::: "memory"); FA_SBAR();
#define FA_PK(L, H) (bf16x8){L[0], L[1], L[2], L[3], H[0], H[1], H[2], H[3]}
  od = __builtin_amdgcn_mfma_f32_32x32x16_bf16(pa0, FA_PK(l0, h0), od, 0, 0, 0);
  od = __builtin_amdgcn_mfma_f32_32x32x16_bf16(pa1, FA_PK(l1, h1), od, 0, 0, 0);
  od = __builtin_amdgcn_mfma_f32_32x32x16_bf16(pa2, FA_PK(l2, h2), od, 0, 0, 0);
  od = __builtin_amdgcn_mfma_f32_32x32x16_bf16(pa3, FA_PK(l3, h3), od, 0, 0, 0);
#undef FA_PK
}
template <int NV> __device__ __forceinline__ void pv_all(f32x16* o, int vb, bf16x8 pa0, bf16x8 pa1, bf16x8 pa2, bf16x8 pa3) {
  pv_one<0>(o[0], vb, pa0, pa1, pa2, pa3); pv_one<1>(o[1], vb, pa0, pa1, pa2, pa3);
  if constexpr (NV == 4) { pv_one<2>(o[2], vb, pa0, pa1, pa2, pa3); pv_one<3>(o[3], vb, pa0, pa1, pa2, pa3); }
}
__device__ __forceinline__ void wmask(f32x16& p0, f32x16& p1, int dq4) {
#pragma unroll
  for (int r = 0; r < 16; ++r) { const int d = dq4 + (r & 3) + 8 * (r >> 2); if ((unsigned)(d + 128) > 256u) p0[r] = NEGS; if ((unsigned)(d + 32 + 128) > 256u) p1[r] = NEGS; }
}

struct Unit {
  const bf16_t* Q; const bf16_t* K; const bf16_t* V; bf16_t* O;
  int rowa, nta, rowb, ntb;
  int window, qpos0, kposb0;
  float sink; int has_sink;
  const bf16_t* K2;
  const float* tab; int pos0;
  const float* qg;
};
template <int DQ, int DV, int LDQ, int LDK, int LDV, int LDO, bool WIN, int RD0, int RH, bool QNORM, bool KSPLIT, bool O8>
__device__ __forceinline__ void attn_unit(const int tid, const Unit& U, char* lds) {
  constexpr int NQ = DQ / 16, NV = DV / 32;
  const int wid = tid >> 6, lane = tid & 63, r32 = lane & 31, hi = lane >> 5;
  char* V_lds = lds; char* K_lds = lds + 2 * SHM_V;
  float* ws = (float*)(lds + 2 * SHM_V + 2 * SHM_K) + wid * 64; float* li_l = ws; float* al_l = ws + 32;
  float m_reg = -1e30f, l_reg = 0; f32x16 o[NV]; bf16x8 qr[NQ];
#pragma unroll
  for (int d = 0; d < NV; ++d) o[d] = f32x16{};
  const bf16_t* Qw = U.Q + (size_t)(wid * QBLK + r32) * LDQ + hi * 8;
#pragma unroll
  for (int d0 = 0; d0 < NQ; ++d0) qr[d0] = *reinterpret_cast<const bf16x8*>(Qw + d0 * 16);
  if constexpr (QNORM || RH > 0) {
    float qf[NQ][8];
#pragma unroll
    for (int d0 = 0; d0 < NQ; ++d0)
#pragma unroll
      for (int j = 0; j < 8; ++j) qf[d0][j] = __uint_as_float(((unsigned)(unsigned short)qr[d0][j]) << 16);
    if constexpr (QNORM) {
      float ss = 0.f;
#pragma unroll
      for (int d0 = 0; d0 < NQ; ++d0)
#pragma unroll
        for (int j = 0; j < 8; ++j) ss = fmaf(qf[d0][j], qf[d0][j], ss);
      { auto rr = __builtin_amdgcn_permlane32_swap(__float_as_uint(ss), __float_as_uint(ss), false, false); ss = __uint_as_float(rr[0]) + __uint_as_float(rr[1]); }
      const float ri = 1.0f / sqrtf(ss * (1.0f / DQ) + 1e-6f);
#pragma unroll
      for (int d0 = 0; d0 < NQ; ++d0) { const float4 g0 = *(const float4*)(U.qg + 16 * d0 + 8 * hi), g1 = *(const float4*)(U.qg + 16 * d0 + 8 * hi + 4);
        qf[d0][0] *= ri * g0.x; qf[d0][1] *= ri * g0.y; qf[d0][2] *= ri * g0.z; qf[d0][3] *= ri * g0.w; qf[d0][4] *= ri * g1.x; qf[d0][5] *= ri * g1.y; qf[d0][6] *= ri * g1.z; qf[d0][7] *= ri * g1.w; }
    }
    if constexpr (RH > 0) { if (U.tab) {
      const float4* tb = (const float4*)(U.tab + ((size_t)(U.pos0 + wid * QBLK + r32) * (RH * 16) + 8 * hi) * 2);
#pragma unroll
      for (int dd = 0; dd < RH; ++dd) {
#pragma unroll
        for (int j2 = 0; j2 < 4; ++j2) { const float4 t = tb[dd * 8 + j2];
          { const float x1 = qf[RD0 + dd][2 * j2], x2 = qf[RD0 + RH + dd][2 * j2]; qf[RD0 + dd][2 * j2] = x1 * t.x - x2 * t.y; qf[RD0 + RH + dd][2 * j2] = x2 * t.x + x1 * t.y; }
          { const float x1 = qf[RD0 + dd][2 * j2 + 1], x2 = qf[RD0 + RH + dd][2 * j2 + 1]; qf[RD0 + dd][2 * j2 + 1] = x1 * t.z - x2 * t.w; qf[RD0 + RH + dd][2 * j2 + 1] = x2 * t.z + x1 * t.w; } } } } }
#pragma unroll
    for (int d0 = 0; d0 < NQ; ++d0) { u32x4 w = {cvtpk(qf[d0][0], qf[d0][1]), cvtpk(qf[d0][2], qf[d0][3]), cvtpk(qf[d0][4], qf[d0][5]), cvtpk(qf[d0][6], qf[d0][7])}; qr[d0] = *reinterpret_cast<bf16x8*>(&w); }
  }
  const int sr = tid >> 4, sc = (tid & 15) * 8, vst0 = v_st(sr, sc), vst1 = v_st(32 + sr, sc);
  const int sck = sc < DQ - 8 ? sc : DQ - 8, scv = sc < DV - 8 ? sc : DV - 8;
  const int vb0 = (int)(uintptr_t)V_lds + v_rd_base(lane);
  const int nta = U.nta, NT = U.nta + U.ntb;
  const unsigned kof0 = (unsigned)((sr * LDK + sck) * 2), kof1 = kof0 + 32u * LDK * 2u, vof0 = (unsigned)((sr * LDV + scv) * 2), vof1 = vof0 + 32u * LDV * 2u;
  constexpr int LDK2 = 1536;
  const int ci = tid & 15; const bool ksec = KSPLIT && ci >= 8; const int kld = ksec ? LDK2 : LDK;
  const bf16_t* kp0 = ksec ? U.K2 + (size_t)sr * LDK2 + ((ci < 11 ? ci : 11) - 8) * 8 : U.K + (size_t)sr * LDK + ci * 8; const bf16_t* kp1 = kp0 + (size_t)32 * kld;
  (void)kof0; (void)kof1; (void)kp0; (void)kp1; (void)kld;
  struct { bf16x8 vs0, vs1, ks0, ks1; } sr_[2];
#define FA_KROW(j) ((j) < nta ? U.rowa + (j) * KVBLK : U.rowb + ((j) - nta) * KVBLK)
#define FA_SLOAD(i, j) do { const size_t k0_ = (size_t)(FA_KROW(j)); const char* kt_ = (const char*)U.K + k0_ * (LDK * 2); const char* vt_ = (const char*)U.V + k0_ * (LDV * 2); \
    sr_[i].vs0 = *reinterpret_cast<const bf16x8*>(vt_ + vof0); sr_[i].vs1 = *reinterpret_cast<const bf16x8*>(vt_ + vof1); \
    if constexpr (KSPLIT) { sr_[i].ks0 = *reinterpret_cast<const bf16x8*>(kp0 + k0_ * kld); sr_[i].ks1 = *reinterpret_cast<const bf16x8*>(kp1 + k0_ * kld); } \
    else { sr_[i].ks0 = *reinterpret_cast<const bf16x8*>(kt_ + kof0); sr_[i].ks1 = *reinterpret_cast<const bf16x8*>(kt_ + kof1); } } while (0)
#define FA_SWRITE(b, i) do { *(bf16x8*)(V_lds + (b) * SHM_V + vst0) = sr_[i].vs0; *(bf16x8*)(V_lds + (b) * SHM_V + vst1) = sr_[i].vs1; const int kc = sc * 2; \
    *(bf16x8*)(K_lds + (b) * SHM_K + FA_KSWZ(sr, kc)) = sr_[i].ks0; *(bf16x8*)(K_lds + (b) * SHM_K + FA_KSWZ(32 + sr, kc)) = sr_[i].ks1; } while (0)
#define FA_SWAIT() asm volatile("s_waitcnt vmcnt(4)" ::: "memory")
#define FA_RESC(a) do { if (__any((a) < 1.f)) { if (hi == 0) al_l[r32] = (a); asm volatile("s_waitcnt lgkmcnt(0)" ::: "memory"); \
    _Pragma("unroll") for (int d = 0; d < NV; ++d) _Pragma("unroll") for (int r = 0; r < 16; ++r) o[d][r] *= al_l[crow(r, hi)]; } } while (0)
  const int qw0 = U.qpos0 + wid * QBLK;
#define FA_MASK(P0, P1, t) do { if (WIN && U.window && (t) >= nta) { const int kb_ = U.kposb0 + ((t) - nta) * KVBLK; \
    if (kb_ + 63 - qw0 > 128 || qw0 + 31 - kb_ > 128) wmask(P0, P1, kb_ - (qw0 + r32) + 4 * hi); } } while (0)
  f32x16 pA0, pA1, pB0, pB1; float mnA, mnB, alA, alB; bf16x8 pa0, pa1, pa2, pa3;
  constexpr int SE = 0, SO = 1;
  FA_SLOAD(SE, 0); asm volatile("s_waitcnt vmcnt(0)" ::: "memory"); FA_SWRITE(0, SE); __syncthreads();
  qkt<NQ>(pA0, pA1, K_lds, qr, r32, hi); FA_MASK(pA0, pA1, 0); partialSM(pA0, pA1, m_reg, mnA, alA);
  FA_SLOAD(SO, 1); if (2 < NT) FA_SLOAD(SE, 2);
  FA_SWAIT(); FA_SWRITE(1, SO); __syncthreads();
  for (int j = 1; j + 1 < NT; j += 2) {
    FA_SBAR(); qkt<NQ>(pB0, pB1, K_lds + SHM_K, qr, r32, hi);
    finishSM(pA0, pA1, alA, l_reg, pa0, pa1, pa2, pa3); FA_SBAR();
    FA_SLOAD(SO, j + 2); FA_SBAR();
    pv_all<NV>(o, vb0, pa0, pa1, pa2, pa3); FA_MASK(pB0, pB1, j); partialSM(pB0, pB1, m_reg, mnB, alB);
    __syncthreads(); FA_SWAIT(); FA_SWRITE(0, SE);
    FA_RESC(alB); __syncthreads();
    FA_SBAR(); qkt<NQ>(pA0, pA1, K_lds, qr, r32, hi);
    finishSM(pB0, pB1, alB, l_reg, pa0, pa1, pa2, pa3); FA_SBAR();
    if (j + 3 < NT) FA_SLOAD(SE, j + 3); FA_SBAR();
    pv_all<NV>(o, vb0 + SHM_V, pa0, pa1, pa2, pa3); FA_MASK(pA0, pA1, j + 1); partialSM(pA0, pA1, m_reg, mnA, alA);
    __syncthreads(); FA_SWAIT(); FA_SWRITE(1, SO);
    FA_RESC(alA); __syncthreads();
  }
  FA_SBAR(); qkt<NQ>(pB0, pB1, K_lds + SHM_K, qr, r32, hi);
  finishSM(pA0, pA1, alA, l_reg, pa0, pa1, pa2, pa3); FA_SBAR();
  pv_all<NV>(o, vb0, pa0, pa1, pa2, pa3); FA_MASK(pB0, pB1, NT - 1); partialSM(pB0, pB1, m_reg, mnB, alB);
  __syncthreads(); FA_RESC(alB);
  finishSM(pB0, pB1, alB, l_reg, pa0, pa1, pa2, pa3); FA_SBAR();
  pv_all<NV>(o, vb0 + SHM_V, pa0, pa1, pa2, pa3);
  if (U.has_sink) l_reg += __builtin_amdgcn_exp2f((U.sink - m_reg) * LOG2E);
  if (hi == 0) li_l[r32] = l_reg;
  asm volatile("s_waitcnt lgkmcnt(0)" ::: "memory");
  __syncthreads();
  int lane2 = lane; asm volatile("" : "+v"(lane2));
  const int r32e = lane2 & 31, hie = lane2 >> 5;
  if constexpr (O8) {
    unsigned char* stg = (unsigned char*)(lds + wid * 8192);
    unsigned char* stw = stg + hie * 4 * DV + r32e;
#pragma unroll
    for (int r = 0; r < 16; ++r) { const int orow0 = (r & 3) + 8 * (r >> 2); const float rl = __builtin_amdgcn_rcpf(li_l[orow0 + 4 * hie]);
#pragma unroll
      for (int d0 = 0; d0 < NV; ++d0) stw[orow0 * DV + d0 * 32] = (unsigned char)(__builtin_amdgcn_cvt_pk_fp8_f32(o[d0][r] * rl, 0.f, 0, false) & 0xff); }
    asm volatile("s_waitcnt lgkmcnt(0)" ::: "memory");
    constexpr int CPR = DV / 16, RPI = 64 / CPR;
    const int erow = lane2 / CPR, ech = lane2 % CPR;
    unsigned char* Ow = (unsigned char*)U.O + (size_t)(wid * QBLK + erow) * LDO + ech * 16; const unsigned char* str = stg + erow * DV + ech * 16;
#pragma unroll
    for (int i = 0; i < 32 / RPI; ++i) { const u32x4 v = *(const u32x4*)(str + i * RPI * DV); *(u32x4*)(Ow + (size_t)(i * RPI) * LDO) = v; }
  } else {
  bf16_t* stg = (bf16_t*)(lds + wid * 8192);
  bf16_t* stw = stg + hie * 4 * DV + r32e;
#pragma unroll
  for (int r = 0; r < 16; ++r) { const int orow0 = (r & 3) + 8 * (r >> 2); const float rl = __builtin_amdgcn_rcpf(li_l[orow0 + 4 * hie]);
#pragma unroll
    for (int d0 = 0; d0 < NV; ++d0) stw[orow0 * DV + d0 * 32] = f2bf(o[d0][r] * rl); }
  asm volatile("s_waitcnt lgkmcnt(0)" ::: "memory");
  constexpr int CPR = DV / 8, RPI = 64 / CPR;
  const int erow = lane2 / CPR, ech = lane2 % CPR;
  bf16_t* Ow = U.O + (size_t)(wid * QBLK + erow) * LDO + ech * 8; const bf16_t* str = stg + erow * DV + ech * 8;
#pragma unroll
  for (int i = 0; i < 32 / RPI; ++i) { const u32x4 v = *(const u32x4*)(str + i * RPI * DV); *(u32x4*)(Ow + (size_t)(i * RPI) * LDO) = v; }
  }
  __syncthreads();
#undef FA_KROW
#undef FA_SLOAD
#undef FA_SWRITE
#undef FA_SWAIT
#undef FA_RESC
#undef FA_MASK
}
}

__device__ __forceinline__ void route_reduce(const float (&acc)[32], const int lane, const int el, const float rb, float (&tv)[4], int (&ti)[4]) {
    float a16[16], a8[8], a4[4], a2[2];
#pragma unroll
    for (int k = 0; k < 16; ++k) { const bool up = (lane & 32) != 0; const float keep = up ? acc[k + 16] : acc[k], send = up ? acc[k] : acc[k + 16]; a16[k] = keep + __shfl_xor(send, 32); }
#pragma unroll
    for (int k = 0; k < 8; ++k) { const bool up = (lane & 16) != 0; const float keep = up ? a16[k + 8] : a16[k], send = up ? a16[k] : a16[k + 8]; a8[k] = keep + __shfl_xor(send, 16); }
#pragma unroll
    for (int k = 0; k < 4; ++k) { const bool up = (lane & 8) != 0; const float keep = up ? a8[k + 4] : a8[k], send = up ? a8[k] : a8[k + 4]; a4[k] = keep + __shfl_xor(send, 8); }
#pragma unroll
    for (int k = 0; k < 2; ++k) { const bool up = (lane & 4) != 0; const float keep = up ? a4[k + 2] : a4[k], send = up ? a4[k] : a4[k + 2]; a2[k] = keep + __shfl_xor(send, 4); }
    float lg; { const bool up = (lane & 2) != 0; const float keep = up ? a2[1] : a2[0], send = up ? a2[0] : a2[1]; lg = keep + __shfl_xor(send, 2); }
    lg += __shfl_xor(lg, 1); lg += rb;
    unsigned key; { const unsigned u = __float_as_uint(lg); const unsigned ou = (u & 0x80000000u) ? ~u : (u | 0x80000000u); key = (ou & ~31u) | (unsigned)(31 - el); }
#pragma unroll
    for (int k = 0; k < 4; ++k) { unsigned bk = key;
#pragma unroll
        for (int o = 1; o < 64; o <<= 1) { const unsigned ok = (unsigned)__shfl_xor((int)bk, o); bk = ok > bk ? ok : bk; }
        const int bi = 31 - (int)(bk & 31u); const unsigned ou = bk & ~31u; const unsigned ub = (ou & 0x80000000u) ? (ou ^ 0x80000000u) : ~ou;
        tv[k] = __uint_as_float(ub); ti[k] = bi; if (el == bi) key = 0u; }
}

template <int CTRL> __device__ __forceinline__ float dpp_f32(const float x) { return __builtin_bit_cast(float, __builtin_amdgcn_update_dpp(0, __builtin_bit_cast(int, x), CTRL, 0xf, 0xf, true)); }
template <int CTRL> __device__ __forceinline__ unsigned dpp_u32(const unsigned x) { return (unsigned)__builtin_amdgcn_update_dpp(0, (int)x, CTRL, 0xf, 0xf, true); }
template <int M> __device__ __forceinline__ float xlane_f32(const float x) {
    if constexpr (M == 1) return dpp_f32<0xB1>(x);
    else if constexpr (M == 2) return dpp_f32<0x4E>(x);
    else if constexpr (M == 4) return dpp_f32<0x1B>(dpp_f32<0x141>(x));
    else return dpp_f32<0x128>(x);
}
template <int M> __device__ __forceinline__ unsigned xlane_u32(const unsigned x) {
    if constexpr (M == 1) return dpp_u32<0xB1>(x);
    else if constexpr (M == 2) return dpp_u32<0x4E>(x);
    else if constexpr (M == 4) return dpp_u32<0x1B>(dpp_u32<0x141>(x));
    else return dpp_u32<0x128>(x);
}
typedef unsigned u32x2_t __attribute__((ext_vector_type(2)));
__device__ __forceinline__ float half_sum32(float v) {
    v += xlane_f32<1>(v); v += xlane_f32<2>(v); v += xlane_f32<4>(v); v += xlane_f32<8>(v);
    const u32x2_t r = __builtin_amdgcn_permlane16_swap(__float_as_uint(v), __float_as_uint(v), false, false);
    return __uint_as_float(r[0]) + __uint_as_float(r[1]);
}
__device__ __forceinline__ void route_reduce32(const float (&acc)[32], const int l5, const float rb, float (&tv)[4], int (&ti)[4]) {
    float a16[16], a8[8], a4[4], a2[2];
#pragma unroll
    for (int k = 0; k < 16; ++k) { const u32x2_t r = __builtin_amdgcn_permlane16_swap(__float_as_uint(acc[k]), __float_as_uint(acc[k + 16]), false, false); a16[k] = __uint_as_float(r[0]) + __uint_as_float(r[1]); }
#pragma unroll
    for (int k = 0; k < 8; ++k) { const bool up = (l5 & 8) != 0; const float keep = up ? a16[k + 8] : a16[k], send = up ? a16[k] : a16[k + 8]; a8[k] = keep + xlane_f32<8>(send); }
#pragma unroll
    for (int k = 0; k < 4; ++k) { const bool up = (l5 & 4) != 0; const float keep = up ? a8[k + 4] : a8[k], send = up ? a8[k] : a8[k + 4]; a4[k] = keep + xlane_f32<4>(send); }
#pragma unroll
    for (int k = 0; k < 2; ++k) { const bool up = (l5 & 2) != 0; const float keep = up ? a4[k + 2] : a4[k], send = up ? a4[k] : a4[k + 2]; a2[k] = keep + xlane_f32<2>(send); }
    float lg; { const bool up = (l5 & 1) != 0; const float keep = up ? a2[1] : a2[0], send = up ? a2[0] : a2[1]; lg = keep + xlane_f32<1>(send); }
    lg += rb;
    unsigned key; { const unsigned u = __float_as_uint(lg); const unsigned ou = (u & 0x80000000u) ? ~u : (u | 0x80000000u); key = (ou & ~31u) | (unsigned)(31 - l5); }
#pragma unroll
    for (int k = 0; k < 4; ++k) { unsigned bk = key;
        { const unsigned ok = xlane_u32<1>(bk); bk = ok > bk ? ok : bk; } { const unsigned ok = xlane_u32<2>(bk); bk = ok > bk ? ok : bk; }
        { const unsigned ok = xlane_u32<4>(bk); bk = ok > bk ? ok : bk; } { const unsigned ok = xlane_u32<8>(bk); bk = ok > bk ? ok : bk; }
        { const u32x2_t r = __builtin_amdgcn_permlane16_swap(bk, bk, false, false); bk = r[0] > r[1] ? r[0] : r[1]; }
        const int bi = 31 - (int)(bk & 31u); const unsigned ou = bk & ~31u; const unsigned ub = (ou & 0x80000000u) ? (ou ^ 0x80000000u) : ~ou;
        tv[k] = __uint_as_float(ub); ti[k] = bi; if (l5 == bi) key = 0u; }
}

struct Params {
    const float *x, *c, *ctx, *c_ctx, *ada_w, *ada_b, *norm_mix_g, *norm_ffn_g, *ab_w_in, *mla_q_g, *mla_wq_b, *mla_kv_g, *mla_wkv_b, *swa_sink, *ab_w_out,
        *c_w_in, *c_q_g, *c_k_g, *c_w_out, *router_w, *router_b, *moe_w_in, *moe_b_in, *moe_w_out, *moe_b_out, *final_g;
    float* out; unsigned char* ws; int ph_lo, ph_hi;
};
__device__ __forceinline__ int mod_row_of(int r) { return r < NLAT ? r / SEQ : NB; }
__device__ __forceinline__ float rope_angle(int i, int quarter, int prow, int pcol) {
    const int ii = i < quarter ? i : i - quarter; const float inv = powf(10000.f, -(float)ii / (float)quarter);
    return (float)(i < quarter ? prow : pcol) * inv;
}

#ifndef OUTPROJ_F8
#define OUTPROJ_F8 1
#endif
#ifndef Y8_L1
#define Y8_L1 1
#endif
#ifndef Y8_L0
#define Y8_L0 1
#endif
#ifndef INPROJ_F8
#define INPROJ_F8 1
#endif
#ifndef MOE_F8_DOWN
#define MOE_F8_DOWN 1
#endif
#ifndef MOE_F8_L0
#define MOE_F8_L0 1
#endif
#ifndef MOE_F8_L1
#define MOE_F8_L1 1
#endif
constexpr int LDS_BYTES = 147456;
constexpr int LDS_MISC = 143360;
constexpr int N_PHASES = 21;

__global__ void __launch_bounds__(NTHR, 2) fwd_kernel(Params p) {
    extern __shared__ __attribute__((aligned(16))) unsigned char lds_raw[];
    float* ldsf = (float*)lds_raw;
    LAS unsigned* misc = (LAS unsigned*)(lds_raw + LDS_MISC + 320);
    const int wave0 = __builtin_amdgcn_readfirstlane((int)(threadIdx.x >> 6));
    const int G = gridDim.x, bid = blockIdx.x;
    const int NGW = G * 8;
    unsigned* ctl0 = (unsigned*)(p.ws + WS_CTL);
#define PHASE_PTRS \
    int tid = wave0 * 64 + (int)__builtin_amdgcn_mbcnt_hi(~0u, __builtin_amdgcn_mbcnt_lo(~0u, 0u)); asm volatile("" : "+v"(tid)); const int lane = tid & 63, wave = tid >> 6, gw = bid * 8 + wave; (void)lane; (void)gw; \
    size_t wsz_ = 0; asm volatile("" : "+s"(wsz_)); unsigned char* ws = p.ws + wsz_; \
    unsigned* ctl = (unsigned*)(ws + WS_CTL); (void)ctl; \
    float* MOD = (float*)(ws + WS_MOD); (void)MOD; \
    int* TOKE = (int*)(ws + WS_TOKE); int* TOKP = (int*)(ws + WS_TOKP); float* TOKG = (float*)(ws + WS_TOKG); (void)TOKE; (void)TOKP; (void)TOKG; \
    float* RINV = (float*)(ws + WS_RINV); (void)RINV; unsigned char* tabs = ws + WS_TAB; (void)tabs; \
    xr_t* XR = (xr_t*)(ws + WS_XR); (void)XR; \
    act_t* H = (act_t*)(ws + WS_H); (void)H; \
    unsigned char* big = ws + WS_BIG; \
    act_t* PRJ = (act_t*)(big + OFF_PRJ); act_t* QB = (act_t*)(big + OFF_QB); act_t* KVB = (act_t*)(big + OFF_KVB); act_t* OB = (act_t*)(big + OFF_O); (void)PRJ; (void)QB; (void)KVB; (void)OB; \
    act_t* Y = (act_t*)big; act_t* ACT = (act_t*)(ws + WS_ACT); act_t* XS = (act_t*)(ws + WS_XS); unsigned char* wts = ws + WS_W; (void)Y; (void)ACT; (void)XS; (void)wts;

    if (threadIdx.x < 32) misc[threadIdx.x] = 0u;
    __syncthreads();
    XcdBarrier bar = xcd_barrier_post(ctl0 + CW_BAR, (volatile LAS unsigned*)(misc + 8), wave0);
    const int lo = p.ph_lo, hi = p.ph_hi;
#ifndef PHASE_MASK
#define PHASE_MASK 0x1FFFFFu
#endif
#define IN(k) ((((PHASE_MASK) >> (k)) & 1u) && lo <= (k) && (k) < hi)
#define SEAM(k) do { if (IN(k) && IN((k) + 1)) xcd_barrier(bar, wave0); } while (0)
#define LDSB ((LAS unsigned char*)lds_raw)

    if (IN(0)) { PHASE_PTRS
        {   LAS float* scr = (LAS float*)(LDSB + wave * 16640);
            constexpr int I_AB = 16 * 45  , I_QB = 6 * 12, I_KVB = 4 * 16, I_ABO = 16 * 16, I_C = 16 * 24, I_CO = 16 * 16, I_W1 = 16 * 32, I_W2 = 16 * 16;
            constexpr int T_W1 = 64 * I_W1, T_W2 = 64 * I_W2, T_ALL = T_W1 + T_W2 + I_AB + I_QB + I_KVB + I_ABO + I_C + I_CO;
            for (int it = gw; it < T_ALL; it += NGW) {
                int r = it;
                if (r < T_W1) { const int mi = r / I_W1; const float* src = p.moe_w_in + (size_t)mi * 1024 * 2048;
                    if ((mi >= 32 && MOE_F8_L1) || (mi < 32 && MOE_F8_L0)) transpose_item64<true>(src, 1024, 2048, (unsigned char*)(wts + WO_W1) + (size_t)(mi >> 5) * 32 * 2048 * 1024 * 2 + (size_t)(mi & 31) * 2048 * 1024, scr, r % I_W1, lane);
                    else transpose_item64<false>(src, 1024, 2048, (bf16_t*)(wts + WO_W1) + (size_t)mi * 2048 * 1024, scr, r % I_W1, lane);
                    continue; } r -= T_W1;
                if (r < T_W2) { const int mi = r / I_W2; const float* src = p.moe_w_out + (size_t)mi * 1024 * 1024;
                    if (MOE_F8_DOWN && ((mi >= 32 && MOE_F8_L1) || (mi < 32 && MOE_F8_L0))) transpose_item64<true>(src, 1024, 1024, (unsigned char*)(wts + WO_W2) + (size_t)(mi >> 5) * 32 * 1024 * 1024 * 2 + (size_t)(mi & 31) * 1024 * 1024, scr, r % I_W2, lane);
                    else transpose_item64<false>(src, 1024, 1024, (bf16_t*)(wts + WO_W2) + (size_t)mi * 1024 * 1024, scr, r % I_W2, lane);
                    continue; } r -= T_W2;
                if (r < I_AB) { if (INPROJ_F8) transpose_item_f8(p.ab_w_in, 1024, AB_IN, (unsigned char*)(wts + WO_AB), scr, r, lane, 0.125f, 512);
                    else transpose_item(p.ab_w_in, 1024, AB_IN, (bf16_t*)(wts + WO_AB), scr, r, lane, nullptr, 0.125f, 512); continue; } r -= I_AB;
                if (r < I_QB) { transpose_item64<false>(p.mla_wq_b, 384, 768, (bf16_t*)(wts + WO_QB), scr, r, lane, p.mla_q_g, 0.10206207261596575f); continue; } r -= I_QB;
                if (r < I_KVB) { transpose_item64<false>(p.mla_wkv_b, 256, 1024, (bf16_t*)(wts + WO_KVB), scr, r, lane, p.mla_kv_g, 1.0f); continue; } r -= I_KVB;
                if (r < I_ABO) { if (OUTPROJ_F8) transpose_item64<true>(p.ab_w_out, 1024, 1024, (unsigned char*)(wts + WO_ABO), scr, r, lane); else transpose_item64<false>(p.ab_w_out, 1024, 1024, (bf16_t*)(wts + WO_ABO), scr, r, lane); continue; } r -= I_ABO;
                if (r < I_C) { if (INPROJ_F8) transpose_item64<true>(p.c_w_in, 1024, C_IN, (unsigned char*)(wts + WO_C), scr, r, lane); else transpose_item64<false>(p.c_w_in, 1024, C_IN, (bf16_t*)(wts + WO_C), scr, r, lane); continue; } r -= I_C;
                if (OUTPROJ_F8) transpose_item64<true>(p.c_w_out, 1024, 1024, (unsigned char*)(wts + WO_CO), scr, r, lane); else transpose_item64<false>(p.c_w_out, 1024, 1024, (bf16_t*)(wts + WO_CO), scr, r, lane);
            }
            uint4* z = (uint4*)((unsigned char*)(wts + WO_AB) + (size_t)AB_IN * 1024 * (INPROJ_F8 ? 1 : 2));
            for (int i = gw * 64 + lane; i < 96 * 1024 * (INPROJ_F8 ? 1 : 2) / 16; i += NGW * 64) z[i] = make_uint4(0u, 0u, 0u, 0u);
        }
        {
            float2* TA = (float2*)(tabs + TAB_A); float2* TB = (float2*)(tabs + TAB_B); float2* TC = (float2*)(tabs + TAB_C);
            for (int e = bid * NTHR + tid; e < SEQ * 112; e += G * NTHR) { const int s = e / 112, i = e % 112, prow = s / GRIDW, pcol = s % GRIDW;
                int quarter, ii; float2* dst;
                if (i < 32) { quarter = 16; ii = i; dst = TA + s * 32 + ii; } else if (i < 48) { quarter = 8; ii = i - 32; dst = TB + s * 16 + ii; } else { quarter = 32; ii = i - 48; dst = TC + s * 64 + ii; }
                const float ang = rope_angle(ii, quarter, prow, pcol); *dst = make_float2(cosf(ang), sinf(ang)); }
            if (bid == 0 && tid < 128) ((float*)(tabs + TAB_QG))[tid] = p.c_q_g[tid] * 0.08838834764831845f;
        }
        __syncthreads();
        float* ca = ldsf;
        float* red = ldsf + 17 * 1024;
        {   float cv[34];
#pragma unroll
            for (int j = 0; j < 34; ++j) cv[j] = j < 2 * NB ? p.c[j * NTHR + tid] : p.c_ctx[(j - 2 * NB) * NTHR + tid];
#pragma unroll
            for (int j = 0; j < 34; ++j) ca[j * NTHR + tid] = cv[j] / (1.f + expf(-cv[j])); }
        __syncthreads();
        for (int blk = bid; blk < 2 * 6144 / 64; blk += G) {
            typedef float f4m_ __attribute__((ext_vector_type(4)));
            const int l = blk / 96, ks = wave, kr = lane >> 4, c4 = (lane & 15) * 4;
            f4m_ acc[17];
#pragma unroll
            for (int b = 0; b < 17; ++b) acc[b] = (f4m_){0.f, 0.f, 0.f, 0.f};
            const float* wp = p.ada_w + (size_t)l * 1024 * 6144 + (blk % 96) * 64 + c4 + (size_t)(ks * 128 + kr) * 6144;
            const float* cap = ca + ks * 128 + kr;
#pragma unroll 1
            for (int g4 = 0; g4 < 8; ++g4) {
                f4m_ w[4];
#pragma unroll
                for (int j = 0; j < 4; ++j) w[j] = __builtin_nontemporal_load((const f4m_*)(wp + (size_t)((g4 * 4 + j) * 4) * 6144));
#pragma unroll
                for (int j = 0; j < 4; ++j) {
#pragma unroll
                    for (int b = 0; b < 17; ++b) acc[b] += cap[b * 1024 + (g4 * 4 + j) * 4] * w[j]; }
            }
#pragma unroll
            for (int b = 0; b < 17; ++b) {
#pragma unroll
                for (int c = 0; c < 4; ++c) { float v = acc[b][c]; v += __shfl_xor(v, 16); v += __shfl_xor(v, 32); acc[b][c] = v; } }
            if (lane < 16) {
#pragma unroll
                for (int b = 0; b < 17; ++b) *(f4m_*)(red + (ks * 17 + b) * 64 + c4) = acc[b]; }
            __syncthreads();
            for (int i = tid; i < 17 * 64; i += NTHR) { const int b = i >> 6, nl = i & 63; float s = 0.f;
#pragma unroll
                for (int k2 = 0; k2 < 8; ++k2) s += red[(k2 * 17 + b) * 64 + nl];
                const int nn = (blk % 96) * 64 + nl; float mv = s + p.ada_b[l * 6144 + nn];
                if (nn >= 4096 && nn < 5120) mv = p.norm_ffn_g[l * 1024 + nn - 4096] * (1.0f + mv);
                MOD[((size_t)l * 17 + b) * 6144 + nn] = mv; }
            __syncthreads();
        }
    }
    SEAM(0);

#define NORM_MOD16(v, g, mr_) do { float ss_ = 0.f; \
        _Pragma("unroll") for (int j = 0; j < 16; ++j) ss_ = fmaf(v[j], v[j], ss_); \
        ss_ = wave_sum(ss_); const float ri_ = 1.0f / sqrtf(ss_ * (1.0f / 1024.0f) + RMS_EPS); \
        float sh_[16], sc_[16]; ld16f((mr_), sh_); ld16f((mr_) + 1024, sc_); \
        _Pragma("unroll") for (int j = 0; j < 16; ++j) v[j] = (v[j] * ri_ * g[j]) * (1.0f + sc_[j]) + sh_[j]; } while (0)

#define NORM_MOD16x2(v, g, mr0_, mr1_) do { float s0_ = 0.f, s1_ = 0.f; \
        _Pragma("unroll") for (int j = 0; j < 16; ++j) { s0_ = fmaf(v[0][j], v[0][j], s0_); s1_ = fmaf(v[1][j], v[1][j], s1_); } \
        wave_sum2(s0_, s1_); const float ri0_ = 1.0f / sqrtf(s0_ * (1.0f / 1024.0f) + RMS_EPS), ri1_ = 1.0f / sqrtf(s1_ * (1.0f / 1024.0f) + RMS_EPS); \
        float sh_[16], sc_[16]; ld16f((mr0_), sh_); ld16f((mr0_) + 1024, sc_); \
        _Pragma("unroll") for (int j = 0; j < 16; ++j) v[0][j] = (v[0][j] * ri0_ * g[j]) * (1.0f + sc_[j]) + sh_[j]; \
        ld16f((mr1_), sh_); ld16f((mr1_) + 1024, sc_); \
        _Pragma("unroll") for (int j = 0; j < 16; ++j) v[1][j] = (v[1][j] * ri1_ * g[j]) * (1.0f + sc_[j]) + sh_[j]; } while (0)
#define ROWS2(nrows) _Pragma("unroll 1") for (int r0_ = gw; r0_ < (nrows); r0_ += 2 * NGW)
#define ROWS2_IDX(nrows) const bool two_ = (r0_ + NGW) < (nrows); const int rr_[2] = {r0_, two_ ? r0_ + NGW : r0_};

    if (IN(1)) { PHASE_PTRS
        float g[16]; ld16f(p.norm_mix_g + 16 * lane, g);
        ROWS2(NROW) { ROWS2_IDX(NROW)
            float v[2][16]; const float* mr[2];
#pragma unroll
            for (int u = 0; u < 2; ++u) { const int r = rr_[u]; const float* src = r < NLAT ? p.x + (size_t)r * 1024 : p.ctx + (size_t)(r - NLAT) * 1024;
                mr[u] = MOD + (size_t)(0 * 17 + mod_row_of(r)) * 6144 + 16 * lane; ld16f(src + 16 * lane, v[u]); }
            NORM_MOD16x2(v, g, mr[0], mr[1]);
            if (INPROJ_F8) { st16f8((unsigned char*)H + (size_t)rr_[0] * 1024 + 16 * lane, v[0]); if (two_) st16f8((unsigned char*)H + (size_t)rr_[1] * 1024 + 16 * lane, v[1]); }
            else { st16bf(H + (size_t)rr_[0] * 1024 + 16 * lane, v[0]); if (two_) st16bf(H + (size_t)rr_[1] * 1024 + 16 * lane, v[1]); }
        }
    }
    SEAM(1);

    if (IN(2)) { PHASE_PTRS
        constexpr size_t ES_ = INPROJ_F8 ? 1 : 2;
        pg8::DenseOrder S{(const char*)H, (const char*)(wts + WO_AB), NROW / 256, 6, G, bid, (size_t)256 * 1024 * ES_, (size_t)256 * 1024 * ES_};
        pg8::EpiStoreBf16 E{PRJ, PRJ_LD, INPROJ_F8 ? 0.03125f : 1.0f};
        pg8::gemm_phase<pg8::EpiStoreBf16, pg8::DenseOrder, true, true, INPROJ_F8 != 0>(tid, LDSB, 1024, 1024, S, E);
    }
    SEAM(2);

    if (IN(3)) { PHASE_PTRS
        const float2* TA = (const float2*)(tabs + TAB_A); const float2* TB = (const float2*)(tabs + TAB_B);
        for (int r = gw; r < NROW; r += NGW) {
            bf16_t* pr = PRJ + (size_t)r * PRJ_LD;
            if (r < NLAT) { const int s = r % SEQ;
                { bf16_t* kp = pr + 512 + (lane >> 5) * 64 + (lane & 31); const float x1 = bf2f(kp[0]), x2 = bf2f(kp[32]); const float2 t = TA[s * 32 + (lane & 31)];
                  kp[0] = f2bf(x1 * t.x - x2 * t.y); kp[32] = f2bf(x2 * t.x + x1 * t.y); }
                if (lane < 16) { bf16_t* rp = pr + 1408 + lane; const float x1 = bf2f(rp[0]), x2 = bf2f(rp[16]); const float2 t = TB[s * 16 + lane];
                  rp[0] = f2bf(x1 * t.x - x2 * t.y); rp[16] = f2bf(x2 * t.x + x1 * t.y); } }
            float s1 = 0.f, s2 = 0.f;
#pragma unroll
            for (int j = 0; j < 6; ++j) { const float xq = bf2f(pr[768 + lane + 64 * j]); s1 = fmaf(xq, xq, s1); }
#pragma unroll
            for (int j = 0; j < 4; ++j) { const float xk = bf2f(pr[1152 + lane + 64 * j]); s2 = fmaf(xk, xk, s2); }
            s1 = wave_sum(s1); s2 = wave_sum(s2);
            if (lane == 0) { RINV[2 * r] = 1.0f / sqrtf(s1 * (1.0f / 384.0f) + RMS_EPS); RINV[2 * r + 1] = 1.0f / sqrtf(s2 * (1.0f / 256.0f) + RMS_EPS); }
        }
    }
    SEAM(3);

    if (IN(4)) { PHASE_PTRS
        { pg8::DenseOrder S{(const char*)(PRJ + 768), (const char*)(wts + WO_QB), NROW / 256, 3, G, bid, (size_t)256 * PRJ_LD * 2, (size_t)256 * 384 * 2};
          pg8::EpiScaleBf16 E{QB, 768, RINV};
          pg8::gemm_phase<pg8::EpiScaleBf16, pg8::DenseOrder, true, true>(tid, LDSB, 384, PRJ_LD, S, E); }
        __syncthreads();
        { pg8::DenseOrder S{(const char*)(PRJ + 1152), (const char*)(wts + WO_KVB), NROW / 256, 4, G, bid, (size_t)256 * PRJ_LD * 2, (size_t)256 * 256 * 2};
          pg8::EpiScaleBf16 E{KVB, 1024, RINV + 1};
          pg8::gemm_phase<pg8::EpiScaleBf16, pg8::DenseOrder, true, true>(tid, LDSB, 256, PRJ_LD, S, E); }
    }
    SEAM(4);

    if (IN(5)) { PHASE_PTRS
        for (int i = 0;; ++i) { const int u = i * G + bid; if (u >= 1152) break;
            const bool isctx = u >= 1024; int b, h, qb;
            if (!isctx) { const int rest = u >> 3; b = 2 * (u & 7) + (rest >> 6); h = (rest & 63) >> 3; qb = rest & 7; } else { b = (u - 1024) >> 3; h = u & 7; qb = 0; }
            const int qrow0 = isctx ? NLAT + b * NCX : b * SEQ + qb * 256;
            fa::Unit U; U.Q = QB + (size_t)qrow0 * 768 + h * 96; U.K = KVB + h * 128; U.K2 = PRJ + 1408; U.V = KVB + h * 128 + 64;
            U.O = OUTPROJ_F8 ? (bf16_t*)((unsigned char*)OB + (size_t)qrow0 * 1024 + 512 + h * 64) : OB + (size_t)qrow0 * 1024 + 512 + h * 64; U.rowa = NLAT + b * NCX; U.nta = 4; U.rowb = b * SEQ; U.ntb = isctx ? 0 : 32;
            U.window = 0; U.qpos0 = 0; U.kposb0 = 0; U.sink = 0.f; U.has_sink = 0; U.tab = isctx ? nullptr : (const float*)(tabs + TAB_B); U.pos0 = qb * 256; U.qg = nullptr;
            fa::attn_unit<96, 64, 768, 1024, 1024, 1024, false, 4, 1, false, true, OUTPROJ_F8 != 0>(tid, U, (char*)lds_raw); }
        for (int i = 0;; ++i) { const int u = i * G + bid; if (u >= 1152) break;
            const bool isctx = u >= 1024; int b, h, qb;
            if (!isctx) { const int rest = u >> 3; b = 2 * (u & 7) + (rest >> 6); h = (rest & 63) >> 3; qb = rest & 7; } else { b = (u - 1024) >> 3; h = u & 7; qb = 0; }
            const int qrow0 = isctx ? NLAT + b * NCX : b * SEQ + qb * 256;
            const int ks = isctx ? 0 : max(0, qb * 256 - 128), ke = isctx ? 0 : min(SEQ, qb * 256 + 384);
            fa::Unit U; U.Q = PRJ + (size_t)qrow0 * PRJ_LD + h * 64; U.K = PRJ + 512 + (h >> 2) * 64; U.K2 = nullptr; U.V = PRJ + 640 + (h >> 2) * 64;
            U.O = OUTPROJ_F8 ? (bf16_t*)((unsigned char*)OB + (size_t)qrow0 * 1024 + h * 64) : OB + (size_t)qrow0 * 1024 + h * 64; U.rowa = NLAT + b * NCX; U.nta = 4; U.rowb = b * SEQ + ks; U.ntb = (ke - ks) / 64;
            U.window = isctx ? 0 : 1; U.qpos0 = qb * 256; U.kposb0 = ks; U.sink = p.swa_sink[h]; U.has_sink = 1; U.tab = isctx ? nullptr : (const float*)(tabs + TAB_A); U.pos0 = qb * 256; U.qg = nullptr;
            fa::attn_unit<64, 64, PRJ_LD, PRJ_LD, PRJ_LD, 1024, true, 0, 2, false, false, OUTPROJ_F8 != 0>(tid, U, (char*)lds_raw); }
    }
    SEAM(5);

    if (IN(6)) { PHASE_PTRS
        constexpr size_t ES_ = OUTPROJ_F8 ? 1 : 2;
        pg8::DenseOrder S{(const char*)OB, (const char*)(wts + WO_ABO), NROW / 256, 4, G, bid, (size_t)256 * 1024 * ES_, (size_t)256 * 1024 * ES_};
        pg8::EpiResidT<float, xr_t> E{p.x, p.ctx, XR, MOD + 2048, OUTPROJ_F8 ? 0.03125f : 1.0f};
        pg8::gemm_phase<pg8::EpiResidT<float, xr_t>, pg8::DenseOrder, true, true, OUTPROJ_F8 != 0>(tid, LDSB, 1024, 1024, S, E);
    }
    SEAM(6);

    typedef float f4a_ __attribute__((ext_vector_type(4)));
#define GLD4(dst, ptr, off) asm volatile("global_load_dwordx4 %0, %1, off offset:" #off : "=v"(dst) : "v"(ptr) : "memory")
#if XR16
#define XR_LOADS(xp_) GLD4(xn0_, xp_, 0); GLD4(xn1_, xp_, 16); GLD4(xn2_, xp_, 32); GLD4(xn3_, xp_, 48); xn4_ = xn0_; xn5_ = xn0_; xn6_ = xn0_; xn7_ = xn0_
#define XR_WAIT_MOD "s_waitcnt vmcnt(4)"
#define XR_UNPACK(v) _Pragma("unroll") for (int q = 0; q < 4; ++q) { const unsigned w0_ = __float_as_uint(xn0_[q]), w1_ = __float_as_uint(xn1_[q]), w2_ = __float_as_uint(xn2_[q]), w3_ = __float_as_uint(xn3_[q]); \
        v[0][2 * q] = __uint_as_float(w0_ << 16); v[0][2 * q + 1] = __uint_as_float(w0_ & 0xffff0000u); v[0][8 + 2 * q] = __uint_as_float(w1_ << 16); v[0][9 + 2 * q] = __uint_as_float(w1_ & 0xffff0000u); \
        v[1][2 * q] = __uint_as_float(w2_ << 16); v[1][2 * q + 1] = __uint_as_float(w2_ & 0xffff0000u); v[1][8 + 2 * q] = __uint_as_float(w3_ << 16); v[1][9 + 2 * q] = __uint_as_float(w3_ & 0xffff0000u); }
#else
#define XR_LOADS(xp_) GLD4(xn0_, xp_, 0); GLD4(xn1_, xp_, 16); GLD4(xn2_, xp_, 32); GLD4(xn3_, xp_, 48); GLD4(xn4_, xp_, 64); GLD4(xn5_, xp_, 80); GLD4(xn6_, xp_, 96); GLD4(xn7_, xp_, 112)
#define XR_WAIT_MOD "s_waitcnt vmcnt(8)"
#define XR_UNPACK(v) _Pragma("unroll") for (int q = 0; q < 4; ++q) { v[0][q] = xn0_[q]; v[0][4 + q] = xn1_[q]; v[0][8 + q] = xn2_[q]; v[0][12 + q] = xn3_[q]; v[1][q] = xn4_[q]; v[1][4 + q] = xn5_[q]; v[1][8 + q] = xn6_[q]; v[1][12 + q] = xn7_[q]; }
#endif
#define ROUTER_PHASE(L, nrows) do { \
        { const float4* wsrc_ = (const float4*)(p.router_w + (size_t)(L) * 1024 * 32); float4* wl_ = (float4*)lds_raw; \
          for (int q = tid; q < 8192; q += NTHR) { const int c_ = q >> 3, e4_ = q & 7; wl_[(c_ ^ ((c_ >> 8) & 1)) * 8 + (e4_ ^ ((c_ >> 5) & 7))] = wsrc_[q]; } }        \
        __syncthreads(); \
        unsigned* cnt_ = ctl + CW_CNT + (L) * 32; \
        LAS unsigned* lcnt_ = (LAS unsigned*)(LDSB + LDS_MISC + 1024); LAS unsigned* lbase_ = lcnt_ + 32;       \
        if (tid < 32) lcnt_[tid] = 0u; \
        __syncthreads(); \
        const int half_ = lane >> 5, l5_ = lane & 31;                        \
        const float rb_ = p.router_b[(L) * 32 + l5_]; \
        const float4* wl_ = (const float4*)lds_raw + (size_t)(32 * l5_) * 8; const int sw_ = l5_ & 7; \
        LAS unsigned* stash_ = (LAS unsigned*)(LDSB + 131072) + wave * 384;        \
        int it_ = 0; \
          \
        f4a_ xn0_, xn1_, xn2_, xn3_, xn4_, xn5_, xn6_, xn7_;                 \
        { const int r = (gw * 2 < (nrows) ? gw * 2 : 0) + half_; const xr_t* xp_ = XR + (size_t)r * 1024 + 32 * l5_; XR_LOADS(xp_); } \
        for (int rp = gw; rp * 2 < (nrows); rp += NGW, ++it_) { const int r = rp * 2 + half_; \
            const float* mr = MOD + (size_t)((L) * 17 + mod_row_of(r)) * 6144 + 3072 + 32 * l5_; const float* mr2 = mr + 1024; \
            asm volatile("s_waitcnt vmcnt(0)" : "+v"(xn0_), "+v"(xn1_), "+v"(xn2_), "+v"(xn3_), "+v"(xn4_), "+v"(xn5_), "+v"(xn6_), "+v"(xn7_) :: "memory"); \
            float v[2][16]; XR_UNPACK(v); \
            f4a_ sh0_, sh1_, sh2_, sh3_, sh4_, sh5_, sh6_, sh7_, sc0_, sc1_, sc2_, sc3_, sc4_, sc5_, sc6_, sc7_; \
            GLD4(sh0_, mr, 0); GLD4(sh1_, mr, 16); GLD4(sh2_, mr, 32); GLD4(sh3_, mr, 48); GLD4(sh4_, mr, 64); GLD4(sh5_, mr, 80); GLD4(sh6_, mr, 96); GLD4(sh7_, mr, 112); \
            GLD4(sc0_, mr2, 0); GLD4(sc1_, mr2, 16); GLD4(sc2_, mr2, 32); GLD4(sc3_, mr2, 48); GLD4(sc4_, mr2, 64); GLD4(sc5_, mr2, 80); GLD4(sc6_, mr2, 96); GLD4(sc7_, mr2, 112); \
            { const int rn_ = ((rp + NGW) * 2 < (nrows) ? (rp + NGW) * 2 : rp * 2) + half_; const xr_t* xp_ = XR + (size_t)rn_ * 1024 + 32 * l5_; XR_LOADS(xp_); }        \
            asm volatile(XR_WAIT_MOD : "+v"(sh0_), "+v"(sh1_), "+v"(sh2_), "+v"(sh3_), "+v"(sh4_), "+v"(sh5_), "+v"(sh6_), "+v"(sh7_), "+v"(sc0_), "+v"(sc1_), "+v"(sc2_), "+v"(sc3_), "+v"(sc4_), "+v"(sc5_), "+v"(sc6_), "+v"(sc7_) :: "memory"); \
            float sh_[2][16], sc_[2][16]; \
            _Pragma("unroll") for (int q = 0; q < 4; ++q) { sh_[0][q] = sh0_[q]; sh_[0][4 + q] = sh1_[q]; sh_[0][8 + q] = sh2_[q]; sh_[0][12 + q] = sh3_[q]; sh_[1][q] = sh4_[q]; sh_[1][4 + q] = sh5_[q]; sh_[1][8 + q] = sh6_[q]; sh_[1][12 + q] = sh7_[q]; \
                sc_[0][q] = sc0_[q]; sc_[0][4 + q] = sc1_[q]; sc_[0][8 + q] = sc2_[q]; sc_[0][12 + q] = sc3_[q]; sc_[1][q] = sc4_[q]; sc_[1][4 + q] = sc5_[q]; sc_[1][8 + q] = sc6_[q]; sc_[1][12 + q] = sc7_[q]; } \
            float ss_ = 0.f; \
            _Pragma("unroll") for (int j = 0; j < 16; ++j) { ss_ = fmaf(v[0][j], v[0][j], ss_); ss_ = fmaf(v[1][j], v[1][j], ss_); } \
            ss_ = half_sum32(ss_); \
            const float ri_ = 1.0f / sqrtf(ss_ * (1.0f / 1024.0f) + RMS_EPS); \
            _Pragma("unroll") for (int hh = 0; hh < 2; ++hh) { \
                _Pragma("unroll") for (int j = 0; j < 16; ++j) v[hh][j] = (v[hh][j] * ri_) * sc_[hh][j] + sh_[hh][j];        \
                st16f8((unsigned char*)H + (size_t)r * 1024 + 32 * l5_ + 16 * hh, v[hh]); }        \
            if (l5_ & 8) { _Pragma("unroll") for (int hh = 0; hh < 2; ++hh) _Pragma("unroll") for (int j = 0; j < 16; j += 2) { const float t_ = v[hh][j]; v[hh][j] = v[hh][j + 1]; v[hh][j + 1] = t_; } }        \
            float acc[32]; \
            _Pragma("unroll") for (int e = 0; e < 32; ++e) acc[e] = 0.f; \
            _Pragma("unroll") for (int hh = 0; hh < 2; ++hh) _Pragma("unroll") for (int j = 0; j < 16; ++j) { \
                _Pragma("unroll") for (int e4 = 0; e4 < 8; ++e4) { const float4 w = wl_[(16 * hh + j) * 8 + (e4 ^ sw_)]; \
                    acc[4 * e4] = fmaf(v[hh][j], w.x, acc[4 * e4]); acc[4 * e4 + 1] = fmaf(v[hh][j], w.y, acc[4 * e4 + 1]); acc[4 * e4 + 2] = fmaf(v[hh][j], w.z, acc[4 * e4 + 2]); acc[4 * e4 + 3] = fmaf(v[hh][j], w.w, acc[4 * e4 + 3]); } } \
            float tv[4]; int ti[4]; route_reduce32(acc, l5_, rb_, tv, ti); \
            const float e1 = expf(tv[1] - tv[0]), e2 = expf(tv[2] - tv[0]), e3 = expf(tv[3] - tv[0]); const float inv = 1.0f / (1.0f + e1 + e2 + e3); \
            if (l5_ < 4) { const int ek = l5_ == 0 ? ti[0] : l5_ == 1 ? ti[1] : l5_ == 2 ? ti[2] : ti[3]; const float gk = (l5_ == 0 ? 1.0f : l5_ == 1 ? e1 : l5_ == 2 ? e2 : e3) * inv; \
                const unsigned pos = __hip_atomic_fetch_add(lcnt_ + ek, 1u, __ATOMIC_RELAXED, __HIP_MEMORY_SCOPE_WORKGROUP); TOKE[r * 4 + l5_] = ek; TOKG[r * 4 + l5_] = gk; \
                stash_[it_ * 8 + half_ * 4 + l5_] = (unsigned)ek | (pos << 8); } \
        } \
        asm volatile("s_waitcnt vmcnt(0)" : "+v"(xn0_), "+v"(xn1_), "+v"(xn2_), "+v"(xn3_), "+v"(xn4_), "+v"(xn5_), "+v"(xn6_), "+v"(xn7_) :: "memory");        \
        __syncthreads(); \
        if (tid < 32) lbase_[tid] = atomicAdd(cnt_ + tid, lcnt_[tid]); \
        __syncthreads(); \
        for (int e_ = lane; e_ < it_ * 8; e_ += 64) { const unsigned w_ = stash_[e_]; const int r = (gw + (e_ >> 3) * NGW) * 2 + ((e_ >> 2) & 1); TOKP[r * 4 + (e_ & 3)] = (int)((w_ >> 8) + lbase_[w_ & 255u]); } \
    } while (0)

#define EXCL_SETUP(L) \
        const int c_ = lane < 32 ? (int)ctl[CW_CNT + (L) * 32 + lane] : 0; const int padc_ = (c_ + 255) / 256 * 256; int pre_ = padc_; \
        _Pragma("unroll") for (int o_ = 1; o_ < 32; o_ <<= 1) { const int t_ = __shfl_up(pre_, o_); if ((lane & 31) >= o_) pre_ += t_; } \
        const int excl_ = pre_ - padc_;
#define PERMUTE_PHASE(L, nrows) do { EXCL_SETUP(L) \
        ROWS2(nrows) { ROWS2_IDX(nrows) \
            const int ra_ = rr_[0], rb_ = rr_[1]; \
            const uint4* sa_ = (const uint4*)(H + (size_t)ra_ * 1024) + lane * 2; const uint4* sb_ = (const uint4*)(H + (size_t)rb_ * 1024) + lane * 2; \
            const uint4 a0_ = sa_[0], a1_ = sa_[1], b0_ = sb_[0], b1_ = sb_[1]; \
            const int4 ea_ = *(const int4*)(TOKE + ra_ * 4), pa_ = *(const int4*)(TOKP + ra_ * 4), eb_ = *(const int4*)(TOKE + rb_ * 4), pb_ = *(const int4*)(TOKP + rb_ * 4); \
            const int sa0 = __shfl(excl_, ea_.x) + pa_.x, sa1 = __shfl(excl_, ea_.y) + pa_.y, sa2 = __shfl(excl_, ea_.z) + pa_.z, sa3 = __shfl(excl_, ea_.w) + pa_.w; \
            const int sb0 = __shfl(excl_, eb_.x) + pb_.x, sb1 = __shfl(excl_, eb_.y) + pb_.y, sb2 = __shfl(excl_, eb_.z) + pb_.z, sb3 = __shfl(excl_, eb_.w) + pb_.w; \
            { uint4* d_ = (uint4*)(XS + (size_t)sa0 * 1024) + lane * 2; d_[0] = a0_; d_[1] = a1_; } { uint4* d_ = (uint4*)(XS + (size_t)sa1 * 1024) + lane * 2; d_[0] = a0_; d_[1] = a1_; } \
            { uint4* d_ = (uint4*)(XS + (size_t)sa2 * 1024) + lane * 2; d_[0] = a0_; d_[1] = a1_; } { uint4* d_ = (uint4*)(XS + (size_t)sa3 * 1024) + lane * 2; d_[0] = a0_; d_[1] = a1_; } \
            if (two_) { \
            { uint4* d_ = (uint4*)(XS + (size_t)sb0 * 1024) + lane * 2; d_[0] = b0_; d_[1] = b1_; } { uint4* d_ = (uint4*)(XS + (size_t)sb1 * 1024) + lane * 2; d_[0] = b0_; d_[1] = b1_; } \
            { uint4* d_ = (uint4*)(XS + (size_t)sb2 * 1024) + lane * 2; d_[0] = b0_; d_[1] = b1_; } { uint4* d_ = (uint4*)(XS + (size_t)sb3 * 1024) + lane * 2; d_[0] = b0_; d_[1] = b1_; } } } \
        for (int e = 0; e < 32; ++e) { const int ce = __shfl(c_, e), be = __shfl(excl_, e), pe = __shfl(padc_, e); \
            for (int rr = ce + gw; rr < pe; rr += NGW) { uint4* d_ = (uint4*)(XS + (size_t)(be + rr) * 1024) + lane * 2; d_[0] = make_uint4(0u, 0u, 0u, 0u); d_[1] = make_uint4(0u, 0u, 0u, 0u); } } \
    } while (0)
#define PERMUTE_PHASE_F8(L, nrows) do { EXCL_SETUP(L) \
        unsigned char* XS8 = (unsigned char*)XS; \
        for (int r = gw; r < (nrows); r += NGW) { \
            const int4 ov_ = *((const int4*)((const unsigned char*)H + (size_t)r * 1024) + lane); \
            _Pragma("unroll") for (int k = 0; k < 4; ++k) { const int ek = TOKE[r * 4 + k], pk = TOKP[r * 4 + k]; const int slot = __shfl(excl_, ek) + pk; \
                *((int4*)(XS8 + (size_t)slot * 1024) + lane) = ov_; if (lane == 0) TOKP[r * 4 + k] = slot; } }        \
        for (int e = 0; e < 32; ++e) { const int ce = __shfl(c_, e), be = __shfl(excl_, e), pe = __shfl(padc_, e); \
            for (int rr = ce + gw; rr < pe; rr += NGW) *((int4*)(XS8 + (size_t)(be + rr) * 1024) + lane) = make_int4(0, 0, 0, 0); } \
    } while (0)
#define MOE_TABLE(L) \
        LAS int* tile_e = (LAS int*)(LDSB + LDS_MISC + 1024); LAS int* nm_p = tile_e + 640; \
        LAS int* tpre_ = nm_p + 1;                                       \
        __syncthreads(); \
        if (tid < 64) { const int c_ = lane < 32 ? (int)ctl[CW_CNT + (L) * 32 + lane] : 0; const int n_ = (c_ + 255) / 256; int pre_ = n_; \
            _Pragma("unroll") for (int o_ = 1; o_ < 32; o_ <<= 1) { const int t_ = __shfl_up(pre_, o_); if ((lane & 31) >= o_) pre_ += t_; } \
            if (lane < 32) tpre_[lane] = pre_ - n_; if (lane == 31) { tpre_[32] = pre_; *nm_p = pre_; } } \
        __syncthreads(); \
        const int nM_ = __builtin_amdgcn_readfirstlane(*nm_p); \
        for (int t_ = tid; t_ < nM_; t_ += NTHR) { int e_ = 0; _Pragma("unroll") for (int q_ = 16; q_ >= 1; q_ >>= 1) { if (tpre_[e_ + q_] <= t_) e_ += q_; } tile_e[t_] = e_; }        \
        __syncthreads();
#define MOE_FAST1(L) do { MOE_TABLE(L) \
        pg8::MoeOrder S{(const char*)XS, (const char*)(wts + WO_W1) + (size_t)(L) * 32 * 2048 * 1024 * 2, tile_e, nM_, 8, G, bid, (size_t)256 * 1024 * 2, (size_t)2048 * 1024 * 2}; \
        pg8::EpiSwiglu E{ACT, p.moe_b_in + (size_t)(L) * 32 * 2048, 1.0f}; \
        pg8::gemm_phase<pg8::EpiSwiglu, pg8::MoeOrder, true, true>(tid, LDSB, 1024, 1024, S, E); } while (0)
#define MOE_FAST2(L) do { MOE_TABLE(L) \
        pg8::MoeOrder S{(const char*)ACT, (const char*)(wts + WO_W2) + (size_t)(L) * 32 * 1024 * 1024 * 2, tile_e, nM_, 4, G, bid, (size_t)256 * 1024 * 2, (size_t)1024 * 1024 * 2}; \
        pg8::EpiBiasBf16 E{Y, p.moe_b_out + (size_t)(L) * 32 * 1024, 1.0f}; \
        pg8::gemm_phase<pg8::EpiBiasBf16, pg8::MoeOrder, true, true>(tid, LDSB, 1024, 1024, S, E); } while (0)
#define MOE_FAST1_F8(L) do { MOE_TABLE(L) \
        pg8::MoeOrder S{(const char*)XS, (const char*)(wts + WO_W1) + (size_t)(L) * 32 * 2048 * 1024 * 2, tile_e, nM_, 8, G, bid, (size_t)256 * 1024, (size_t)2048 * 1024}; \
        if constexpr (MOE_F8_DOWN) { pg8::EpiSwigluF8 E{(unsigned char*)ACT, p.moe_b_in + (size_t)(L) * 32 * 2048}; \
            pg8::gemm_phase<pg8::EpiSwigluF8, pg8::MoeOrder, true, true, true>(tid, LDSB, 1024, 1024, S, E); } \
        else { pg8::EpiSwiglu E{ACT, p.moe_b_in + (size_t)(L) * 32 * 2048, 0.03125f}; \
            pg8::gemm_phase<pg8::EpiSwiglu, pg8::MoeOrder, false, true, true>(tid, LDSB, 1024, 1024, S, E); } } while (0)
#define MOE_FAST2_F8(L) do { MOE_TABLE(L) \
        pg8::MoeOrder S{(const char*)ACT, (const char*)(wts + WO_W2) + (size_t)(L) * 32 * 1024 * 1024 * 2, tile_e, nM_, 4, G, bid, (size_t)256 * 1024, (size_t)1024 * 1024}; \
        if constexpr ((Y8_L1 && (L) == 1) || (Y8_L0 && (L) == 0)) { pg8::EpiBiasF8 E{(unsigned char*)Y, p.moe_b_out + (size_t)(L) * 32 * 1024, 0.03125f}; \
            pg8::gemm_phase<pg8::EpiBiasF8, pg8::MoeOrder, true, true, true>(tid, LDSB, 1024, 1024, S, E); } \
        else { pg8::EpiBiasBf16 E{Y, p.moe_b_out + (size_t)(L) * 32 * 1024, 0.03125f}; \
            pg8::gemm_phase<pg8::EpiBiasBf16, pg8::MoeOrder, true, true, true>(tid, LDSB, 1024, 1024, S, E); } } while (0)
#define COMBINE_PRE(nrows) typedef int i4n_ __attribute__((ext_vector_type(4))); typedef float f4n_ __attribute__((ext_vector_type(4))); i4n_ sl0_, sl1_; f4n_ gt0_, gt1_; \
        { const int ra_ = gw < (nrows) ? gw : 0, rb_ = gw + NGW < (nrows) ? gw + NGW : ra_; sl0_ = *(const i4n_*)(TOKP + ra_ * 4); gt0_ = *(const f4n_*)(TOKG + ra_ * 4); sl1_ = *(const i4n_*)(TOKP + rb_ * 4); gt1_ = *(const f4n_*)(TOKG + rb_ * 4); }
#define COMBINE_ROWS2(L, v, nrows, F8Y) do { \
        const int slc_[2][4] = {{sl0_[0], sl0_[1], sl0_[2], sl0_[3]}, {sl1_[0], sl1_[1], sl1_[2], sl1_[3]}}; \
        const float gk_[2][4] = {{gt0_[0], gt0_[1], gt0_[2], gt0_[3]}, {gt1_[0], gt1_[1], gt1_[2], gt1_[3]}}; \
        uint4 ya_[2][4], yb_[2][4]; \
        _Pragma("unroll") for (int u = 0; u < 2; ++u) { const int r = rr_[u]; \
            _Pragma("unroll") for (int k = 0; k < 4; ++k) { \
                if constexpr (F8Y) { ya_[u][k] = *((const uint4*)((const unsigned char*)Y + (size_t)slc_[u][k] * 1024) + lane); yb_[u][k] = ya_[u][k]; } \
                else { const uint4* yr = (const uint4*)(Y + (size_t)slc_[u][k] * 1024 + 16 * lane); ya_[u][k] = yr[0]; yb_[u][k] = yr[1]; } } \
            ld16x(XR + (size_t)r * 1024 + 16 * lane, v[u]); } \
        { const int n0_ = r0_ + 2 * NGW; if (n0_ < (nrows)) { const int n1_ = n0_ + NGW < (nrows) ? n0_ + NGW : n0_; \
            sl0_ = *(const i4n_*)(TOKP + n0_ * 4); gt0_ = *(const f4n_*)(TOKG + n0_ * 4); sl1_ = *(const i4n_*)(TOKP + n1_ * 4); gt1_ = *(const f4n_*)(TOKG + n1_ * 4); } } \
        _Pragma("unroll") for (int u = 0; u < 2; ++u) { float f_[16]; \
            _Pragma("unroll") for (int j = 0; j < 16; ++j) f_[j] = 0.f; \
            _Pragma("unroll") for (int k = 0; k < 4; ++k) { \
                if constexpr (F8Y) { const int yw[4] = {(int)ya_[u][k].x, (int)ya_[u][k].y, (int)ya_[u][k].z, (int)ya_[u][k].w}; \
                    _Pragma("unroll") for (int j = 0; j < 4; ++j) { const auto lo_ = __builtin_amdgcn_cvt_pk_f32_fp8(yw[j], false); const auto hi_ = __builtin_amdgcn_cvt_pk_f32_fp8(yw[j], true); \
                        f_[4 * j] = fmaf(gk_[u][k], lo_[0], f_[4 * j]); f_[4 * j + 1] = fmaf(gk_[u][k], lo_[1], f_[4 * j + 1]); f_[4 * j + 2] = fmaf(gk_[u][k], hi_[0], f_[4 * j + 2]); f_[4 * j + 3] = fmaf(gk_[u][k], hi_[1], f_[4 * j + 3]); } } \
                else { const unsigned yw[8] = {ya_[u][k].x, ya_[u][k].y, ya_[u][k].z, ya_[u][k].w, yb_[u][k].x, yb_[u][k].y, yb_[u][k].z, yb_[u][k].w}; \
                    _Pragma("unroll") for (int j = 0; j < 8; ++j) { f_[2 * j] = fmaf(gk_[u][k], __uint_as_float(yw[j] << 16), f_[2 * j]); f_[2 * j + 1] = fmaf(gk_[u][k], __uint_as_float(yw[j] & 0xffff0000u), f_[2 * j + 1]); } } } \
            float g2v_[16]; ld16f(MOD + (size_t)((L) * 17 + mod_row_of(rr_[u])) * 6144 + 5120 + 16 * lane, g2v_);        \
            _Pragma("unroll") for (int j = 0; j < 16; ++j) v[u][j] = fmaf(g2v_[j], f_[j], v[u][j]); } } while (0)

    if (IN(7)) { PHASE_PTRS ROUTER_PHASE(0, NROW); }
    SEAM(7);
#if MOE_F8_L0
    if (IN(8)) { PHASE_PTRS PERMUTE_PHASE_F8(0, NROW); }
    SEAM(8);
    if (IN(9)) { PHASE_PTRS MOE_FAST1_F8(0); }
    SEAM(9);
#else
    if (IN(8)) { PHASE_PTRS PERMUTE_PHASE(0, NROW); }
    SEAM(8);
    if (IN(9)) { PHASE_PTRS MOE_FAST1(0); }
    SEAM(9);
#endif
    if (IN(10)) { PHASE_PTRS if constexpr (MOE_F8_L0 && MOE_F8_DOWN) { MOE_FAST2_F8(0); } else { MOE_FAST2(0); } }
    SEAM(10);

    if (IN(11)) { PHASE_PTRS
        float g[16]; ld16f(p.norm_mix_g + 1024 + 16 * lane, g);
        COMBINE_PRE(NROW)
        ROWS2(NROW) { ROWS2_IDX(NROW)
            float v[2][16]; COMBINE_ROWS2(0, v, NROW, (Y8_L0 && MOE_F8_L0 && MOE_F8_DOWN));
            st16x(XR + (size_t)rr_[0] * 1024 + 16 * lane, v[0]); if (two_) st16x(XR + (size_t)rr_[1] * 1024 + 16 * lane, v[1]);
            const float* mr0 = MOD + (size_t)(1 * 17 + mod_row_of(rr_[0])) * 6144 + 16 * lane; const float* mr1 = MOD + (size_t)(1 * 17 + mod_row_of(rr_[1])) * 6144 + 16 * lane;
            NORM_MOD16x2(v, g, mr0, mr1);
            if (INPROJ_F8) { st16f8((unsigned char*)H + (size_t)rr_[0] * 1024 + 16 * lane, v[0]); if (two_) st16f8((unsigned char*)H + (size_t)rr_[1] * 1024 + 16 * lane, v[1]); }
            else { st16bf(H + (size_t)rr_[0] * 1024 + 16 * lane, v[0]); if (two_) st16bf(H + (size_t)rr_[1] * 1024 + 16 * lane, v[1]); }
        }
    }
    SEAM(11);

    if (IN(12)) { PHASE_PTRS
        constexpr size_t ES_ = INPROJ_F8 ? 1 : 2;
        pg8::DenseOrder S{(const char*)H, (const char*)(wts + WO_C), NROW / 256, 6, G, bid, (size_t)256 * 1024 * ES_, (size_t)256 * 1024 * ES_};
        pg8::EpiStoreBf16 E{PRJ, PRJ_LD, INPROJ_F8 ? 0.03125f : 1.0f};
        pg8::gemm_phase<pg8::EpiStoreBf16, pg8::DenseOrder, true, true, INPROJ_F8 != 0>(tid, LDSB, 1024, 1024, S, E);
    }
    SEAM(12);

    if (IN(13)) { PHASE_PTRS
        const float2* TC = (const float2*)(tabs + TAB_C); const float kg1 = p.c_k_g[lane], kg2 = p.c_k_g[64 + lane];
        for (int r = gw; r < NROW; r += NGW) {
            bf16_t* pr = PRJ + (size_t)r * PRJ_LD + 1024; float2 t = make_float2(1.f, 0.f); if (r < NLAT) t = TC[(r % SEQ) * 64 + lane];
#pragma unroll
            for (int kv = 0; kv < 2; ++kv) { float x1 = bf2f(pr[kv * 128 + lane]), x2 = bf2f(pr[kv * 128 + 64 + lane]);
                const float ss = wave_sum(x1 * x1 + x2 * x2); const float ri = 1.0f / sqrtf(ss * (1.0f / 128.0f) + RMS_EPS);
                x1 = x1 * ri * kg1; x2 = x2 * ri * kg2;
                pr[kv * 128 + lane] = f2bf(x1 * t.x - x2 * t.y); pr[kv * 128 + 64 + lane] = f2bf(x2 * t.x + x1 * t.y); }
        }
    }
    SEAM(13);

    if (IN(14)) { PHASE_PTRS
        for (int i = 0;; ++i) { const int u = i * G + bid; if (u >= 1024) break;
            const int rest = u >> 3; const int b = 2 * (u & 7) + (rest >> 6), h = (rest & 63) >> 3, qb = rest & 7; const int qrow0 = b * SEQ + qb * 256;
            fa::Unit U; U.Q = PRJ + (size_t)qrow0 * PRJ_LD + h * 128; U.K = PRJ + 1024 + (h >> 2) * 128; U.K2 = nullptr; U.V = PRJ + 1280 + (h >> 2) * 128;
            U.O = OUTPROJ_F8 ? (bf16_t*)((unsigned char*)OB + (size_t)qrow0 * 1024 + h * 128) : OB + (size_t)qrow0 * 1024 + h * 128; U.rowa = NLAT + b * NCX; U.nta = 4; U.rowb = b * SEQ; U.ntb = 32;
            U.window = 0; U.qpos0 = 0; U.kposb0 = 0; U.sink = 0.f; U.has_sink = 0; U.tab = (const float*)(tabs + TAB_C); U.pos0 = qb * 256; U.qg = (const float*)(tabs + TAB_QG);
            fa::attn_unit<128, 128, PRJ_LD, PRJ_LD, PRJ_LD, 1024, false, 0, 4, true, false, OUTPROJ_F8 != 0>(tid, U, (char*)lds_raw); }
    }
    SEAM(14);

    if (IN(15)) { PHASE_PTRS
        constexpr size_t ES_ = OUTPROJ_F8 ? 1 : 2;
        pg8::DenseOrder S{(const char*)OB, (const char*)(wts + WO_CO), NLAT / 256, 4, G, bid, (size_t)256 * 1024 * ES_, (size_t)256 * 1024 * ES_};
        pg8::EpiResidT<xr_t, xr_t> E{XR, XR, XR, MOD + 17 * 6144 + 2048, OUTPROJ_F8 ? 0.03125f : 1.0f};
        pg8::gemm_phase<pg8::EpiResidT<xr_t, xr_t>, pg8::DenseOrder, true, true, OUTPROJ_F8 != 0>(tid, LDSB, 1024, 1024, S, E);
    }
    SEAM(15);

    if (IN(16)) { PHASE_PTRS ROUTER_PHASE(1, NLAT); }
    SEAM(16);
#if MOE_F8_L1
    if (IN(17)) { PHASE_PTRS PERMUTE_PHASE_F8(1, NLAT); }
    SEAM(17);
    if (IN(18)) { PHASE_PTRS MOE_FAST1_F8(1); }
    SEAM(18);
    if (IN(19)) { PHASE_PTRS if constexpr (MOE_F8_DOWN) { MOE_FAST2_F8(1); } else { MOE_FAST2(1); } }
    SEAM(19);
#else
    if (IN(17)) { PHASE_PTRS PERMUTE_PHASE(1, NLAT); }
    SEAM(17);
    if (IN(18)) { PHASE_PTRS MOE_FAST1(1); }
    SEAM(18);
    if (IN(19)) { PHASE_PTRS MOE_FAST2(1); }
    SEAM(19);
#endif

    if (IN(20)) { PHASE_PTRS
        COMBINE_PRE(NLAT)
        ROWS2(NLAT) { ROWS2_IDX(NLAT)
            float v[2][16]; COMBINE_ROWS2(1, v, NLAT, (Y8_L1 && MOE_F8_L1 && MOE_F8_DOWN));
            float s0 = 0.f, s1 = 0.f;
#pragma unroll
            for (int j = 0; j < 16; ++j) { s0 = fmaf(v[0][j], v[0][j], s0); s1 = fmaf(v[1][j], v[1][j], s1); }
            wave_sum2(s0, s1); const float ri0 = 1.0f / sqrtf(s0 * (1.0f / 1024.0f) + RMS_EPS), ri1 = 1.0f / sqrtf(s1 * (1.0f / 1024.0f) + RMS_EPS);
            int ln_ = lane; asm volatile("" : "+v"(ln_));
            float g[16]; ld16f(p.final_g + 16 * ln_, g);
#pragma unroll
            for (int j = 0; j < 16; ++j) { v[0][j] = v[0][j] * ri0 * g[j]; v[1][j] = v[1][j] * ri1 * g[j]; }
            st16f(p.out + (size_t)rr_[0] * 1024 + 16 * ln_, v[0]); if (two_) st16f(p.out + (size_t)rr_[1] * 1024 + 16 * ln_, v[1]);
        }
    }
#undef IN
#undef SEAM
}

#ifndef MK_PER_PHASE
#define MK_PER_PHASE 0
#endif
extern "C" void kernel_launch(void* const* d_in, const int* in_sizes, int n_in, void* d_out, int out_size, void* d_ws, size_t ws_size, hipStream_t stream) {
    static int grid = 0;
    if (grid == 0) {
        if (n_in != 26 || out_size != NLAT * DM || ws_size < WS_END) { fprintf(stderr, "kernel_launch: unexpected shapes (n_in %d out %d ws %zu need %zu)\n", n_in, out_size, ws_size, (size_t)WS_END); grid = -1; return; }
        int dev = 0, cus = 0;
        if (hipGetDevice(&dev) != hipSuccess || hipDeviceGetAttribute(&cus, hipDeviceAttributeMultiprocessorCount, dev) != hipSuccess) { grid = -1; return; }
        if (hipFuncSetAttribute((const void*)fwd_kernel, hipFuncAttributeMaxDynamicSharedMemorySize, LDS_BYTES) != hipSuccess) { fprintf(stderr, "kernel_launch: hipFuncSetAttribute failed\n"); grid = -1; return; }
        int per_cu = 0;
        if (hipOccupancyMaxActiveBlocksPerMultiprocessor(&per_cu, (const void*)fwd_kernel, NTHR, LDS_BYTES) != hipSuccess || per_cu < 1) { fprintf(stderr, "kernel_launch: occupancy query says %d\n", per_cu); }
        (void)hipGetLastError();
        grid = cus;
    }
    if (grid < 0) return;
    (void)hipMemsetAsync((char*)d_ws + WS_CTL, 0, CTL_BYTES, stream);
    Params p{};
    const float** pp = (const float**)&p;
    for (int i = 0; i < 26; ++i) pp[i] = (const float*)d_in[i];
    p.out = (float*)d_out; p.ws = (unsigned char*)d_ws;
#if MK_PER_PHASE
    for (int k = 0; k < N_PHASES; ++k) { p.ph_lo = k; p.ph_hi = k + 1; hipLaunchKernelGGL(fwd_kernel, dim3(grid), dim3(NTHR), LDS_BYTES, stream, p); }
#else
    p.ph_lo = 0; p.ph_hi = N_PHASES;
    hipLaunchKernelGGL(fwd_kernel, dim3(grid), dim3(NTHR), LDS_BYTES, stream, p);
#endif
}
```

```cpp
#include <hip/hip_runtime.h>
#include <cstdio>
#include <cstdint>

typedef unsigned short bf16_t;
typedef bf16_t act_t;
#define GAS __attribute__((address_space(1)))
#define LAS __attribute__((address_space(3)))

constexpr int DM = 1024, NB = 16, SEQ = 2048, NCX = 256, GRIDW = 64;
constexpr int NLAT = NB * SEQ, NCTX = NB * NCX, NROW = NLAT + NCTX;
constexpr int AB_IN = 1440, C_IN = 1536, PRJ_LD = 1536;
constexpr int NEXP = 32, DFF = 1024;
constexpr int CAP = 155648;
constexpr float RMS_EPS = 1e-6f;
constexpr int NTHR = 512;

constexpr size_t MiB = 1u << 20;
constexpr size_t ASZ = sizeof(act_t);
constexpr size_t WS_CTL = 0, CTL_BYTES = 1 * MiB;
constexpr size_t WS_MOD = 1 * MiB;
constexpr size_t WS_TOKE = 2 * MiB, WS_TOKP = 3 * MiB, WS_TOKG = 4 * MiB;
constexpr size_t WS_RINV = 5 * MiB;
constexpr size_t WS_TAB = 6 * MiB;
constexpr size_t TAB_A = 0, TAB_B = (size_t)SEQ * 32 * 8, TAB_C = TAB_B + (size_t)SEQ * 16 * 8, TAB_QG = TAB_C + (size_t)SEQ * 64 * 8;
constexpr size_t WS_XR = 16 * MiB;
constexpr size_t WS_H = WS_XR + 144 * MiB;
constexpr size_t WS_BIG = WS_H + (size_t)NROW * 1024 * ASZ;
constexpr size_t OFF_PRJ = 0;
constexpr size_t OFF_QB = OFF_PRJ + (size_t)NROW * 1536 * ASZ;
constexpr size_t OFF_KVB = OFF_QB + (size_t)NROW * 768 * ASZ;
constexpr size_t OFF_O = OFF_KVB + (size_t)NROW * 1024 * ASZ;
constexpr size_t BIG_A = OFF_O + (size_t)NROW * 1024 * ASZ;
constexpr size_t BIG_Y = (size_t)CAP * 1024 * ASZ;
constexpr size_t BIG_BYTES = BIG_A > BIG_Y ? BIG_A : BIG_Y;
constexpr size_t WS_ACT = WS_BIG + BIG_BYTES;
constexpr size_t WS_XS = WS_ACT + (size_t)CAP * 1024 * ASZ;
constexpr size_t WS_W = WS_XS + (size_t)CAP * 1024 * ASZ;
constexpr size_t WO_AB = 0;
constexpr size_t WO_QB = WO_AB + (size_t)1536 * 1024 * 2;
constexpr size_t WO_KVB = WO_QB + (size_t)768 * 384 * 2;
constexpr size_t WO_ABO = WO_KVB + (size_t)1024 * 256 * 2;
constexpr size_t WO_C = WO_ABO + (size_t)1024 * 1024 * 2;
constexpr size_t WO_CO = WO_C + (size_t)1536 * 1024 * 2;
constexpr size_t WO_W1 = WO_CO + (size_t)1024 * 1024 * 2;
constexpr size_t WO_W2 = WO_W1 + (size_t)64 * 2048 * 1024 * 2;
constexpr size_t WS_END = WS_W + WO_W2 + (size_t)64 * 1024 * 1024 * 2;

constexpr int CW_CNT = 64;
constexpr int CW_BAR = 4096;

__device__ __forceinline__ float bf2f(bf16_t v) { return __uint_as_float(((unsigned)v) << 16); }
__device__ __forceinline__ bf16_t f2bf(float f) { unsigned u = __float_as_uint(f); return (bf16_t)((u + 0x7fffu + ((u >> 16) & 1u)) >> 16); }
__device__ __forceinline__ float ldA(const float* p) { return *p; }
__device__ __forceinline__ float ldA(const bf16_t* p) { return bf2f(*p); }
__device__ __forceinline__ void stA(float* p, float v) { *p = v; }
__device__ __forceinline__ void stA(bf16_t* p, float v) { *p = f2bf(v); }
template <int N> __device__ __forceinline__ void load_vec(const float* p, float (&o)[N]) {
#pragma unroll
    for (int i = 0; i < N / 4; ++i) { const float4 t = ((const float4*)p)[i]; o[4 * i] = t.x; o[4 * i + 1] = t.y; o[4 * i + 2] = t.z; o[4 * i + 3] = t.w; }
}
template <int N> __device__ __forceinline__ void load_vec(const bf16_t* p, float (&o)[N]) {
#pragma unroll
    for (int i = 0; i < N / 8; ++i) { const uint4 t = ((const uint4*)p)[i];
        o[8 * i] = __uint_as_float(t.x << 16); o[8 * i + 1] = __uint_as_float(t.x & 0xffff0000u); o[8 * i + 2] = __uint_as_float(t.y << 16); o[8 * i + 3] = __uint_as_float(t.y & 0xffff0000u);
        o[8 * i + 4] = __uint_as_float(t.z << 16); o[8 * i + 5] = __uint_as_float(t.z & 0xffff0000u); o[8 * i + 6] = __uint_as_float(t.w << 16); o[8 * i + 7] = __uint_as_float(t.w & 0xffff0000u); }
}
__device__ __forceinline__ float wave_sum(float v) {
#pragma unroll
    for (int o = 1; o < 64; o <<= 1) v += __shfl_xor(v, o);
    return v;
}

__device__ __forceinline__ void wave_sum2(float& a, float& b) {
#pragma unroll
    for (int o = 1; o < 64; o <<= 1) { const float ta = __shfl_xor(a, o), tb = __shfl_xor(b, o); a += ta; b += tb; }
}
__device__ __forceinline__ void ld16f(const float* p, float (&v)[16]) {
#pragma unroll
    for (int i = 0; i < 4; ++i) { const float4 t = ((const float4*)p)[i]; v[4 * i] = t.x; v[4 * i + 1] = t.y; v[4 * i + 2] = t.z; v[4 * i + 3] = t.w; }
}
__device__ __forceinline__ void st16f(float* p, const float (&v)[16]) {
#pragma unroll
    for (int i = 0; i < 4; ++i) ((float4*)p)[i] = make_float4(v[4 * i], v[4 * i + 1], v[4 * i + 2], v[4 * i + 3]);
}
__device__ __forceinline__ unsigned cvtpk2(float lo, float hi) { unsigned r; asm volatile("v_cvt_pk_bf16_f32 %0, %1, %2" : "=v"(r) : "v"(lo), "v"(hi)); return r; }
__device__ __forceinline__ void st16bf(bf16_t* p, const float (&v)[16]) {
    ((uint4*)p)[0] = make_uint4(cvtpk2(v[0], v[1]), cvtpk2(v[2], v[3]), cvtpk2(v[4], v[5]), cvtpk2(v[6], v[7]));
    ((uint4*)p)[1] = make_uint4(cvtpk2(v[8], v[9]), cvtpk2(v[10], v[11]), cvtpk2(v[12], v[13]), cvtpk2(v[14], v[15]));
}

#ifndef XR16
#define XR16 1
#endif
#if XR16
typedef bf16_t xr_t;
#else
typedef float xr_t;
#endif
__device__ __forceinline__ void ld16x(const float* p, float (&v)[16]) { ld16f(p, v); }
__device__ __forceinline__ void st16x(float* p, const float (&v)[16]) { st16f(p, v); }
__device__ __forceinline__ void ld16x(const bf16_t* p, float (&v)[16]) {
#pragma unroll
    for (int i = 0; i < 2; ++i) { const uint4 t = ((const uint4*)p)[i]; const unsigned w[4] = {t.x, t.y, t.z, t.w};
#pragma unroll
        for (int j = 0; j < 4; ++j) { v[8 * i + 2 * j] = __uint_as_float(w[j] << 16); v[8 * i + 2 * j + 1] = __uint_as_float(w[j] & 0xffff0000u); } }
}
__device__ __forceinline__ void st16x(bf16_t* p, const float (&v)[16]) { st16bf(p, v); }
__device__ __forceinline__ void st16f8(unsigned char* p, const float (&v)[16]) {
    int o[4];
#pragma unroll
    for (int j = 0; j < 4; ++j) { const int t = __builtin_amdgcn_cvt_pk_fp8_f32(v[4 * j], v[4 * j + 1], 0, false); o[j] = __builtin_amdgcn_cvt_pk_fp8_f32(v[4 * j + 2], v[4 * j + 3], t, true); }
    *(int4*)p = make_int4(o[0], o[1], o[2], o[3]);
}
#define XB_TMO      128
#define XB_XCNT(j)  (256  + 64 * (j))
#define XB_XSUB(j)  (1280 + 64 * (j))
#define XB_XGEN(j)  (2304 + 64 * (j))
#define XB_TOP      3328
#define XB_TOPGEN   3392
#define XCD_BAR_WORDS 3456
#define XB_SPIN_CAP (1u << 22)
__device__ __forceinline__ unsigned xb_ld(unsigned* p)              { return __hip_atomic_load(p, __ATOMIC_RELAXED, __HIP_MEMORY_SCOPE_AGENT); }
__device__ __forceinline__ unsigned xb_add(unsigned* p, unsigned v) { return __hip_atomic_fetch_add(p, v, __ATOMIC_RELAXED, __HIP_MEMORY_SCOPE_AGENT); }
__device__ __forceinline__ unsigned xb_xcc_id() { return (unsigned)__builtin_amdgcn_s_getreg((3 << 11) | 20) & 0xFu; }
#define XB_SPIN(cond, bar) do { unsigned _sp = 0; while (cond) { __builtin_amdgcn_s_sleep(1); \
    if ((++_sp & 255u) == 0u) { if (xb_ld(&(bar)[XB_TMO])) break; if (_sp > XB_SPIN_CAP) { atomicAdd(&(bar)[XB_TMO], 1u); break; } } } } while (0)
struct XcdBarrier { unsigned* bar; unsigned x; volatile LAS unsigned* st; };
__device__ __forceinline__ bool xb_is_leader(int wave0) { return wave0 == 0 && __builtin_amdgcn_mbcnt_hi(~0u, __builtin_amdgcn_mbcnt_lo(~0u, 0u)) == 0u; }
__device__ __forceinline__ XcdBarrier xcd_barrier_post(unsigned* bar, volatile LAS unsigned* st, int wave0) {
    XcdBarrier b; b.bar = bar; b.x = xb_xcc_id(); b.st = st;
    if (xb_is_leader(wave0)) (void)xb_add(&bar[XB_XCNT(b.x)], 1u);
    return b;
}
__device__ __forceinline__ void xcd_barrier_complete(unsigned* bar, unsigned x, unsigned& nloc, unsigned& nx) {
    const unsigned G = gridDim.x * gridDim.y * gridDim.z;
    unsigned sum, cnt, mine, sp = 0u;
    for (;;) {
        sum = 0u; cnt = 0u; mine = 0u;
#pragma unroll
        for (unsigned j = 0; j < 16; ++j) { const unsigned c = xb_ld(&bar[XB_XCNT(j)]); sum += c; cnt += (c > 0u) ? 1u : 0u; mine = (j == x) ? c : mine; }
        if (sum == G) break;
        __builtin_amdgcn_s_sleep(1);
        if ((++sp & 255u) == 0u) { if (xb_ld(&bar[XB_TMO])) break; if (sp > XB_SPIN_CAP) { atomicAdd(&bar[XB_TMO], 1u); break; } }
    }
    nloc = mine > 0u ? mine : 1u; nx = cnt > 0u ? cnt : 1u;
}
__device__ __forceinline__ void xcd_barrier(const XcdBarrier& b, int wave0) {
    asm volatile("s_waitcnt vmcnt(0)" ::: "memory");
    __syncthreads();
    if (xb_is_leader(wave0)) {
        unsigned* bar = b.bar;
        __builtin_amdgcn_s_waitcnt(0);
        unsigned nloc = b.st[0], nx = b.st[1];
        if (nloc == 0u) { xcd_barrier_complete(bar, b.x, nloc, nx); b.st[0] = nloc; b.st[1] = nx; }
        const unsigned old = xb_add(&bar[XB_XSUB(b.x)], 1u);
        const unsigned gen = old / nloc;
        if (old + 1u == (gen + 1u) * nloc) {
            __builtin_amdgcn_fence(__ATOMIC_RELEASE, "agent");
            asm volatile("s_waitcnt vmcnt(0)" ::: "memory");
            const unsigned og = xb_add(&bar[XB_TOP], 1u);
            const unsigned tg = og / nx;
            if (og + 1u == (tg + 1u) * nx) xb_add(&bar[XB_TOPGEN], 1u);
            else XB_SPIN(xb_ld(&bar[XB_TOPGEN]) == tg, bar);
            __builtin_amdgcn_fence(__ATOMIC_ACQUIRE, "agent");
            xb_add(&bar[XB_XGEN(b.x)], 1u);
            asm volatile("s_waitcnt vmcnt(0)" ::: "memory");
        } else {
            XB_SPIN(xb_ld(&bar[XB_XGEN(b.x)]) == gen, bar);
            __builtin_amdgcn_fence(__ATOMIC_ACQUIRE, "agent");
            asm volatile("s_waitcnt vmcnt(0)" ::: "memory");
        }
    }
    __syncthreads();
}


#ifndef FAST_GEMM
#define FAST_GEMM 1
#endif
namespace pg8 {
#define PG8_LAS __attribute__((address_space(3)))
typedef short bf16x8 __attribute__((ext_vector_type(8)));
typedef float f32x4 __attribute__((ext_vector_type(4)));
typedef unsigned u32x4 __attribute__((ext_vector_type(4)));
constexpr int BM = 256, BK = 64, HALF = 128, HTB = HALF * BK * 2  , STAGE_BYTES = 8 * HTB, NXCD = 8, WGM = 8;

__host__ __device__ __forceinline__ int lds_byte(int r, int c) { const int st = (r >> 4) * 2 + (c >> 5), rr = r & 15, cc = c & 31, ob = rr * 64 + cc * 2; return st * 1024 + (ob ^ (((ob >> 9) & 1) << 5)); }
__host__ __device__ __forceinline__ void stage_rc(int b, int& R, int& C) { const int st = b / 1024, sb = b % 1024, swz = sb ^ (((sb >> 9) & 1) << 5); R = (st >> 1) * 16 + swz / 64; C = (st & 1) * 32 + (swz % 64) / 2; }
__host__ __device__ __forceinline__ int perm32(int rho) { const int n = rho >> 4, i = rho & 15; return 8 * (i >> 2) + 4 * n + (i & 3); }


struct Unit { const char* a; const char* b; int pm, pn, aux; };
__device__ __forceinline__ unsigned cvt_pk_bf16(float lo, float hi) { unsigned r; asm volatile("v_cvt_pk_bf16_f32 %0, %1, %2" : "=v"(r) : "v"(lo), "v"(hi)); return r; }
typedef int v8i32 __attribute__((ext_vector_type(8)));
__device__ __forceinline__ v8i32 cat16(bf16x8 lo, bf16x8 hi) { typedef int v4i32 __attribute__((ext_vector_type(4))); const v4i32 a = __builtin_bit_cast(v4i32, lo), b = __builtin_bit_cast(v4i32, hi); return __builtin_shufflevector(a, b, 0, 1, 2, 3, 4, 5, 6, 7); }
template <class Epi, class Sched, bool ALIGN_EPI = false, bool SP2 = false, bool F8 = false>
__device__ __forceinline__ void gemm_phase(const int tid, PG8_LAS unsigned char* lds, const int K, const int lda, const Sched& S, const Epi& E) {
    const int wid = __builtin_amdgcn_readfirstlane(tid >> 6), lane = tid & 63, wr = wid >> 2, wc = wid & 3, fr = lane & 15, fq = lane >> 4;
    const int nt = F8 ? K / (2 * BK) : K / BK;
    unsigned voffA[2], voffB[2];
#pragma unroll
    for (int i = 0; i < 2; ++i) { int R, C; stage_rc(tid * 16 + i * 8192, R, C); const int Rb = Epi::PERM ? ((R & ~31) + perm32(R & 31)) : R;
        voffA[i] = F8 ? (unsigned)(R * lda + 2 * C) : (unsigned)(R * lda + C) * 2u; voffB[i] = F8 ? (unsigned)(Rb * K + 2 * C) : (unsigned)(Rb * K + C) * 2u; }
    const size_t kstep = (size_t)(BK * 2);
    const size_t hstepA = (size_t)HALF * lda * (F8 ? 1 : 2);
    const size_t hstep = (size_t)HALF * K * (F8 ? 1 : 2);
    const unsigned ldsbase = (unsigned)__builtin_amdgcn_readfirstlane((int)((unsigned)(uintptr_t)lds + (unsigned)wid * 1024u));
    const unsigned ldsw = (unsigned)wid * 1024u;
    const int aoff = lds_byte(wr * 64 + fr, fq * 8), boff = lds_byte(wc * 32 + fr, fq * 8);
#define PG8_SA(b, h) (((b) * 2 + (h)) * HTB)
#define PG8_SB(b, h) ((4 + (b) * 2 + (h)) * HTB)
#define PG8_STAGE(bufoff, gbase, voff) do { _Pragma("unroll") for (int _i = 0; _i < 2; ++_i) { \
        if constexpr (F8) { unsigned keep_; asm volatile("s_mov_b32 %0, m0\n\ts_mov_b32 m0, %3\n\ts_nop 0\n\tglobal_load_lds_dwordx4 %1, %2\n\ts_mov_b32 m0, %0" : "=&s"(keep_) : "v"((voff)[_i]), "s"((const char*)(gbase)), "s"(ldsbase + (unsigned)((bufoff) + _i * 8192)) : "memory"); } \
        else __builtin_amdgcn_global_load_lds((const unsigned*)((const char*)(gbase) + (voff)[_i]), (PG8_LAS unsigned*)(lds + (bufoff) + ldsw + _i * 8192), 16, 0, 0); } } while (0)
#define PG8_LDA(dst, b, h) do { _Pragma("unroll") for (int m = 0; m < 4; ++m) { _Pragma("unroll") for (int k = 0; k < 2; ++k) dst[m][k] = *(const PG8_LAS bf16x8*)(lds + PG8_SA(b, h) + aoff + m * 2048 + k * 1024); \
        if constexpr (F8) dst##8[m] = cat16(dst[m][0], dst[m][1]); } } while (0)
#define PG8_LDB(dst, b, h) do { _Pragma("unroll") for (int n = 0; n < 2; ++n) { _Pragma("unroll") for (int k = 0; k < 2; ++k) dst[n][k] = *(const PG8_LAS bf16x8*)(lds + PG8_SB(b, h) + boff + n * 2048 + k * 1024); \
        if constexpr (F8) dst##8[n] = cat16(dst[n][0], dst[n][1]); } } while (0)
#define PG8_MMA(ai, bj, At, Bt) do { __builtin_amdgcn_s_setprio(1); _Pragma("unroll") for (int m = 0; m < 4; ++m) _Pragma("unroll") for (int n = 0; n < 2; ++n) { \
        if constexpr (F8) acc[ai][bj][m][n] = __builtin_amdgcn_mfma_scale_f32_16x16x128_f8f6f4(Bt##8[n], At##8[m], acc[ai][bj][m][n], 0, 0, 0, 0x7f7f7f7f, 0, 0x7f7f7f7f); \
        else { _Pragma("unroll") for (int k = 0; k < 2; ++k) acc[ai][bj][m][n] = __builtin_amdgcn_mfma_f32_16x16x32_bf16(Bt[n][k], At[m][k], acc[ai][bj][m][n], 0, 0, 0); } } __builtin_amdgcn_s_setprio(0); } while (0)
#define PG8_WAIT_V(n) asm volatile("s_waitcnt vmcnt(" #n ")" ::: "memory")
#define PG8_WAIT_L(n) asm volatile("s_waitcnt lgkmcnt(" #n ")" ::: "memory")
#define PG8_BAR __builtin_amdgcn_s_barrier()
#define PG8_SCHED __builtin_amdgcn_sched_barrier(0)
    Unit cur, nxt; int ui = 0;
    if (!S.next(0, cur)) return;
    f32x4 acc[2][2][4][2];
#pragma unroll
    for (int a = 0; a < 2; ++a)
#pragma unroll
        for (int b = 0; b < 2; ++b)
#pragma unroll
            for (int m = 0; m < 4; ++m)
#pragma unroll
                for (int n = 0; n < 2; ++n) acc[a][b][m][n] = (f32x4){0.f, 0.f, 0.f, 0.f};
    bf16x8 At[4][2], B0[2][2], B1[2][2]; v8i32 At8[4], B08[2], B18[2]; (void)At8; (void)B08; (void)B18;
    const char* cA = cur.a; const char* cB = cur.b;
    S.a_ready(cur);
    if constexpr (SP2) {
        PG8_STAGE(PG8_SB(0, 0), cB, voffB); PG8_STAGE(PG8_SB(0, 1), cB + hstep, voffB); PG8_STAGE(PG8_SA(0, 0), cA, voffA); PG8_STAGE(PG8_SA(0, 1), cA + hstepA, voffA);
        if (wr == 1) PG8_BAR;
        PG8_WAIT_V(2); PG8_BAR;
        PG8_STAGE(PG8_SB(1, 0), cB + kstep, voffB); PG8_STAGE(PG8_SA(1, 0), cA + kstep, voffA); PG8_STAGE(PG8_SB(1, 1), cB + hstep + kstep, voffB);
        PG8_WAIT_V(6); PG8_BAR;
    } else {
        PG8_STAGE(PG8_SB(0, 0), cB, voffB); PG8_STAGE(PG8_SA(0, 0), cA, voffA); PG8_STAGE(PG8_SB(0, 1), cB + hstep, voffB); PG8_STAGE(PG8_SA(0, 1), cA + hstepA, voffA);
        if (wr == 1) PG8_BAR;
        PG8_WAIT_V(4); PG8_BAR;
        PG8_STAGE(PG8_SB(1, 0), cB + kstep, voffB); PG8_STAGE(PG8_SA(1, 0), cA + kstep, voffA); PG8_STAGE(PG8_SB(1, 1), cB + hstep + kstep, voffB);
        PG8_WAIT_V(6); PG8_BAR;
    }
    for (;;) {
        const bool has_next = S.next(ui + 1, nxt);
        const char* nA = has_next ? nxt.a : cA; const char* nB = has_next ? nxt.b : cB;
#pragma unroll 1
        for (int t = 0; t < nt; t += 2) {
            const bool last = (t == nt - 2);
            const char* a1 = cA + (size_t)(t + 1) * kstep;
            const char* a2 = last ? nA : cA + (size_t)(t + 2) * kstep; const char* b2 = last ? nB : cB + (size_t)(t + 2) * kstep;
            const char* a3 = a2 + kstep; const char* b3 = b2 + kstep;
            if (last && has_next) S.a_ready(nxt);
            if constexpr (SP2) {
            PG8_LDB(B0, 0, 0); PG8_LDB(B1, 0, 1); PG8_SCHED; PG8_LDA(At, 0, 0); PG8_STAGE(PG8_SA(1, 1), a1 + hstepA, voffA);
            PG8_WAIT_V(8); PG8_WAIT_L(0); PG8_BAR; PG8_MMA(0, 0, At, B0); PG8_MMA(0, 1, At, B1); PG8_BAR; PG8_SCHED;
            PG8_LDA(At, 0, 1); PG8_STAGE(PG8_SB(0, 0), b2, voffB); PG8_STAGE(PG8_SB(0, 1), b2 + hstep, voffB); PG8_STAGE(PG8_SA(0, 0), a2, voffA);
            PG8_WAIT_V(8); PG8_WAIT_L(0); PG8_BAR; PG8_MMA(1, 0, At, B0); PG8_MMA(1, 1, At, B1); PG8_BAR; PG8_SCHED;
            PG8_LDB(B0, 1, 0); PG8_LDB(B1, 1, 1); PG8_SCHED; PG8_LDA(At, 1, 0); PG8_STAGE(PG8_SA(0, 1), a2 + hstepA, voffA);
            PG8_WAIT_V(8); PG8_WAIT_L(0); PG8_BAR; PG8_MMA(0, 0, At, B0); PG8_MMA(0, 1, At, B1); PG8_BAR; PG8_SCHED;
            PG8_LDA(At, 1, 1); PG8_STAGE(PG8_SB(1, 0), b3, voffB); PG8_STAGE(PG8_SB(1, 1), b3 + hstep, voffB); PG8_STAGE(PG8_SA(1, 0), a3, voffA);
            PG8_WAIT_V(8); PG8_WAIT_L(0); PG8_BAR; PG8_MMA(1, 0, At, B0); PG8_MMA(1, 1, At, B1); PG8_BAR; PG8_SCHED;
            } else {
            PG8_LDB(B0, 0, 0); PG8_SCHED; PG8_LDA(At, 0, 0); PG8_STAGE(PG8_SA(1, 1), a1 + hstepA, voffA);
            PG8_WAIT_L(8); PG8_BAR; PG8_WAIT_L(0); PG8_MMA(0, 0, At, B0); PG8_BAR; PG8_SCHED;
            PG8_LDB(B1, 0, 1); PG8_STAGE(PG8_SB(0, 0), b2, voffB);
            PG8_BAR; PG8_WAIT_L(0); PG8_MMA(0, 1, At, B1); PG8_BAR;
            PG8_LDA(At, 0, 1); PG8_STAGE(PG8_SA(0, 0), a2, voffA);
            PG8_BAR; PG8_WAIT_L(0); PG8_MMA(1, 0, At, B0); PG8_BAR; PG8_SCHED;
            PG8_STAGE(PG8_SB(0, 1), b2 + hstep, voffB);
            PG8_WAIT_V(6); PG8_BAR; PG8_MMA(1, 1, At, B1); PG8_BAR;
            PG8_LDB(B0, 1, 0); PG8_SCHED; PG8_LDA(At, 1, 0); PG8_STAGE(PG8_SA(0, 1), a2 + hstepA, voffA);
            PG8_WAIT_L(8); PG8_BAR; PG8_WAIT_L(0); PG8_MMA(0, 0, At, B0); PG8_BAR; PG8_SCHED;
            PG8_LDB(B1, 1, 1); PG8_STAGE(PG8_SB(1, 0), b3, voffB);
            PG8_BAR; PG8_WAIT_L(0); PG8_MMA(0, 1, At, B1); PG8_BAR;
            PG8_LDA(At, 1, 1); PG8_STAGE(PG8_SA(1, 0), a3, voffA);
            PG8_BAR; PG8_WAIT_L(0); PG8_MMA(1, 0, At, B0); PG8_BAR; PG8_SCHED;
            PG8_STAGE(PG8_SB(1, 1), b3 + hstep, voffB);
            PG8_WAIT_V(6); PG8_BAR; PG8_MMA(1, 1, At, B1); PG8_BAR;
            }
        }
        if constexpr (ALIGN_EPI) { if (wr == 0) PG8_BAR; }
        if constexpr (!Epi::AFTER_DRAIN) { int tl_ = tid; asm volatile("" : "+v"(tl_)); E(acc, cur, wr, wc, tl_ & 15, (tl_ & 63) >> 4); S.done(cur); }
        if (!has_next) break;
#pragma unroll
        for (int a = 0; a < 2; ++a)
#pragma unroll
            for (int b = 0; b < 2; ++b)
#pragma unroll
                for (int m = 0; m < 4; ++m)
#pragma unroll
                    for (int n = 0; n < 2; ++n) acc[a][b][m][n] = (f32x4){0.f, 0.f, 0.f, 0.f};
        cur = nxt; cA = nA; cB = nB; ++ui;
        if constexpr (ALIGN_EPI) { if (wr == 1) PG8_BAR; }
    }
    PG8_WAIT_V(0);
    if constexpr (!ALIGN_EPI) { if (wr == 0) PG8_BAR; }
    PG8_BAR;
    if constexpr (Epi::AFTER_DRAIN) { E.fused(acc, cur, wr, wc, fr, fq, lds, wid, lane); S.done(cur); }
#undef PG8_SA
#undef PG8_SB
#undef PG8_STAGE
#undef PG8_LDA
#undef PG8_LDB
#undef PG8_MMA
#undef PG8_WAIT_V
#undef PG8_WAIT_L
#undef PG8_BAR
#undef PG8_SCHED
}
}
namespace pg8 {
struct OrderMap {
    __device__ __forceinline__ static bool map(int i, int G, int c, int nM, int nN, int& pm, int& pn) {
        const int nwg = nM * nN; const long L = (long)i * G + c; if (L >= nwg) return false;
        int wgid = (int)L; { const int q = nwg / NXCD, r = nwg % NXCD, xcd = wgid % NXCD, off = wgid / NXCD; wgid = (xcd < r ? xcd * (q + 1) : r * (q + 1) + (xcd - r) * q) + off; }
        const int nig = WGM * nN, gid = wgid / nig, fm = gid * WGM, gsz = (nM - fm) < WGM ? (nM - fm) : WGM;
        pm = fm + ((wgid % nig) % gsz); pn = (wgid % nig) / gsz; return true;
    }
};
struct DenseOrder {
    const char* A; const char* B; int nM, nN, G, c; size_t tstepA, tstepB;
    __device__ __forceinline__ bool next(int i, Unit& u) const { int pm, pn; if (!OrderMap::map(i, G, c, nM, nN, pm, pn)) return false; u.pm = pm; u.pn = pn; u.aux = 0; u.a = A + (size_t)pm * tstepA; u.b = B + (size_t)pn * tstepB; return true; }
    __device__ __forceinline__ void a_ready(const Unit&) const {}
    __device__ __forceinline__ void done(const Unit&) const {}
};
struct MoeOrder {
    const char* A; const char* B; const PG8_LAS int* tile_e; int nM, nN, G, c; size_t tstep, estep;
    __device__ __forceinline__ bool next(int i, Unit& u) const { int pm, pn; if (!OrderMap::map(i, G, c, nM, nN, pm, pn)) return false; const int e = __builtin_amdgcn_readfirstlane(tile_e[pm]); u.pm = pm; u.pn = pn; u.aux = e;
        u.a = A + (size_t)pm * tstep; u.b = B + (size_t)e * estep + (size_t)pn * tstep; return true; }
    __device__ __forceinline__ void a_ready(const Unit&) const {}
    __device__ __forceinline__ void done(const Unit&) const {}
};
struct EpiStoreBf16 { static constexpr bool PERM = true, AFTER_DRAIN = false;
    bf16_t* O; int ldc; float ascale;
    __device__ __forceinline__ void operator()(const f32x4 (&acc)[2][2][4][2], const Unit& u, int wr, int wc, int fr, int fq) const {
        bf16_t* base = O + (size_t)(u.pm * BM + wr * 64 + fr) * ldc + u.pn * BM + wc * 32 + 8 * fq;
        float asc = ascale; asm volatile("" : "+v"(asc));
#pragma unroll
        for (int ai = 0; ai < 2; ++ai)
#pragma unroll
            for (int m = 0; m < 4; ++m) { bf16_t* rowp = base + (size_t)(ai * HALF + m * 16) * ldc;
#pragma unroll
                for (int bj = 0; bj < 2; ++bj) { const f32x4 v0 = acc[ai][bj][m][0] * asc, v1 = acc[ai][bj][m][1] * asc; u32x4 w;
                    w.x = cvt_pk_bf16(v0[0], v0[1]); w.y = cvt_pk_bf16(v0[2], v0[3]); w.z = cvt_pk_bf16(v1[0], v1[1]); w.w = cvt_pk_bf16(v1[2], v1[3]);
                    *(u32x4*)(rowp + bj * HALF) = w; } }
    }
};
struct EpiScaleBf16 { static constexpr bool PERM = true, AFTER_DRAIN = false;
    bf16_t* O; int ldc; const float* rs;
    __device__ __forceinline__ void operator()(const f32x4 (&acc)[2][2][4][2], const Unit& u, int wr, int wc, int fr, int fq) const {
        const int row0 = u.pm * BM + wr * 64 + fr; bf16_t* base = O + (size_t)row0 * ldc + u.pn * BM + wc * 32 + 8 * fq;
#pragma unroll
        for (int ai = 0; ai < 2; ++ai)
#pragma unroll
            for (int m = 0; m < 4; ++m) { bf16_t* rowp = base + (size_t)(ai * HALF + m * 16) * ldc; const float sc = rs[2 * (row0 + ai * HALF + m * 16)];
#pragma unroll
                for (int bj = 0; bj < 2; ++bj) { const f32x4 v0 = acc[ai][bj][m][0] * sc, v1 = acc[ai][bj][m][1] * sc; u32x4 w;
                    w.x = cvt_pk_bf16(v0[0], v0[1]); w.y = cvt_pk_bf16(v0[2], v0[3]); w.z = cvt_pk_bf16(v1[0], v1[1]); w.w = cvt_pk_bf16(v1[2], v1[3]);
                    *(u32x4*)(rowp + bj * HALF) = w; } }
    }
};
template <typename ST, typename OT>
struct EpiResidT { static constexpr bool PERM = true, AFTER_DRAIN = false;
    const ST* src_lat; const ST* src_ctx; OT* out; const float* mod_g1; float ascale;
    __device__ __forceinline__ void operator()(const f32x4 (&acc)[2][2][4][2], const Unit& u, int wr, int wc, int fr, int fq) const {
        const int row_t = u.pm * BM; const int mrow = row_t < NLAT ? row_t / SEQ : NB;
        const float* g = mod_g1 + (size_t)mrow * 6144 + u.pn * BM + wc * 32 + 8 * fq;
        const ST* sb = (row_t < NLAT ? src_lat + (size_t)row_t * 1024 : src_ctx + (size_t)(row_t - NLAT) * 1024) + u.pn * BM + wc * 32 + 8 * fq;
        OT* ob = out + (size_t)row_t * 1024 + u.pn * BM + wc * 32 + 8 * fq;
        f32x4 gv[2][2];
#pragma unroll
        for (int bj = 0; bj < 2; ++bj)
#pragma unroll
            for (int n = 0; n < 2; ++n) gv[bj][n] = *(const f32x4*)(g + bj * HALF + 4 * n) * ascale;
#pragma unroll
        for (int ai = 0; ai < 2; ++ai)
#pragma unroll
            for (int m = 0; m < 4; ++m) { const size_t off = (size_t)(wr * 64 + fr + ai * HALF + m * 16) * 1024;
#pragma unroll
                for (int bj = 0; bj < 2; ++bj) { f32x4 sv[2];
                    if constexpr (sizeof(ST) == 2) { const u32x4 t = *(const u32x4*)(sb + off + bj * HALF);
                        sv[0] = (f32x4){__uint_as_float(t[0] << 16), __uint_as_float(t[0] & 0xffff0000u), __uint_as_float(t[1] << 16), __uint_as_float(t[1] & 0xffff0000u)};
                        sv[1] = (f32x4){__uint_as_float(t[2] << 16), __uint_as_float(t[2] & 0xffff0000u), __uint_as_float(t[3] << 16), __uint_as_float(t[3] & 0xffff0000u)}; }
                    else { sv[0] = *(const f32x4*)(sb + off + bj * HALF); sv[1] = *(const f32x4*)(sb + off + bj * HALF + 4); }
                    const f32x4 o0 = sv[0] + gv[bj][0] * acc[ai][bj][m][0], o1 = sv[1] + gv[bj][1] * acc[ai][bj][m][1];
                    if constexpr (sizeof(OT) == 2) { u32x4 t; t[0] = cvt_pk_bf16(o0[0], o0[1]); t[1] = cvt_pk_bf16(o0[2], o0[3]); t[2] = cvt_pk_bf16(o1[0], o1[1]); t[3] = cvt_pk_bf16(o1[2], o1[3]); *(u32x4*)(ob + off + bj * HALF) = t; }
                    else { *(f32x4*)(ob + off + bj * HALF) = o0; *(f32x4*)(ob + off + bj * HALF + 4) = o1; } }
                asm volatile("" ::: "memory"); }
    }
};
__device__ __forceinline__ float swiglu1(float g, float l, float c7, float cn) {
    const float glu = fminf(g, c7), lin = fminf(fmaxf(l, -c7), c7);
    const float sg = __builtin_amdgcn_rcpf(1.0f + __builtin_amdgcn_exp2f(cn * glu));
    return glu * sg * (lin + 1.0f);
}
struct EpiSwiglu { static constexpr bool PERM = true, AFTER_DRAIN = false;
    bf16_t* O; const float* bias; float ascale;
    __device__ __forceinline__ void operator()(const f32x4 (&acc)[2][2][4][2], const Unit& u, int wr, int wc, int fr, int fq) const {
        const int col0 = u.pn * BM + wc * 32 + 8 * fq; const float* b = bias + (size_t)u.aux * 2048 + col0;
        float c7 = 7.0f, cn = -1.702f * 1.4426950408889634f; asm volatile("" : "+v"(c7), "+v"(cn));
        bf16_t* base = O + (size_t)(u.pm * BM + wr * 64 + fr) * 1024 + (col0 >> 1);
        f32x4 bv[2][2];
#pragma unroll
        for (int bj = 0; bj < 2; ++bj)
#pragma unroll
            for (int n = 0; n < 2; ++n) bv[bj][n] = *(const f32x4*)(b + bj * HALF + 4 * n);
#pragma unroll
        for (int ai = 0; ai < 2; ++ai)
#pragma unroll
            for (int m = 0; m < 4; ++m) { bf16_t* rowp = base + (size_t)(ai * HALF + m * 16) * 1024;
#pragma unroll
                for (int bj = 0; bj < 2; ++bj) { const f32x4 v0 = acc[ai][bj][m][0] * ascale + bv[bj][0], v1 = acc[ai][bj][m][1] * ascale + bv[bj][1];
                    uint2 w; w.x = cvt_pk_bf16(swiglu1(v0[0], v0[1], c7, cn), swiglu1(v0[2], v0[3], c7, cn)); w.y = cvt_pk_bf16(swiglu1(v1[0], v1[1], c7, cn), swiglu1(v1[2], v1[3], c7, cn));
                    *(uint2*)(rowp + bj * (HALF / 2)) = w; } }
    }
};
struct EpiSwigluF8 { static constexpr bool PERM = true, AFTER_DRAIN = false;
    unsigned char* O; const float* bias;
    __device__ __forceinline__ void operator()(const f32x4 (&acc)[2][2][4][2], const Unit& u, int wr, int wc, int fr, int fq) const {
        const int col0 = u.pn * BM + wc * 32 + 8 * fq; const float* b = bias + (size_t)u.aux * 2048 + col0;
        float c7 = 7.0f, cn = -1.702f * 1.4426950408889634f, c32 = 0.03125f; asm volatile("" : "+v"(c7), "+v"(cn), "+v"(c32));
        unsigned char* base = O + (size_t)(u.pm * BM + wr * 64 + fr) * 1024 + (col0 >> 1);
        f32x4 bv[2][2];
#pragma unroll
        for (int bj = 0; bj < 2; ++bj)
#pragma unroll
            for (int n = 0; n < 2; ++n) bv[bj][n] = *(const f32x4*)(b + bj * HALF + 4 * n);
#pragma unroll
        for (int ai = 0; ai < 2; ++ai)
#pragma unroll
            for (int m = 0; m < 4; ++m) { unsigned char* rowp = base + (size_t)(ai * HALF + m * 16) * 1024;
#pragma unroll
                for (int bj = 0; bj < 2; ++bj) { const f32x4 v0 = acc[ai][bj][m][0] * c32 + bv[bj][0], v1 = acc[ai][bj][m][1] * c32 + bv[bj][1];
                    int w = __builtin_amdgcn_cvt_pk_fp8_f32(swiglu1(v0[0], v0[1], c7, cn), swiglu1(v0[2], v0[3], c7, cn), 0, false); w = __builtin_amdgcn_cvt_pk_fp8_f32(swiglu1(v1[0], v1[1], c7, cn), swiglu1(v1[2], v1[3], c7, cn), w, true);
                    *(int*)(rowp + bj * (HALF / 2)) = w; } }
    }
};
struct EpiBiasF8 { static constexpr bool PERM = true, AFTER_DRAIN = false;
    unsigned char* O; const float* bias; float ascale;
    __device__ __forceinline__ void operator()(const f32x4 (&acc)[2][2][4][2], const Unit& u, int wr, int wc, int fr, int fq) const {
        const int col0 = u.pn * BM + wc * 32 + 8 * fq; const float* b = bias + (size_t)u.aux * 1024 + col0;
        float asc = ascale; asm volatile("" : "+v"(asc));
        unsigned char* base = O + (size_t)(u.pm * BM + wr * 64 + fr) * 1024 + col0;
        f32x4 bv[2][2];
#pragma unroll
        for (int bj = 0; bj < 2; ++bj)
#pragma unroll
            for (int n = 0; n < 2; ++n) bv[bj][n] = *(const f32x4*)(b + bj * HALF + 4 * n);
#pragma unroll
        for (int ai = 0; ai < 2; ++ai)
#pragma unroll
            for (int m = 0; m < 4; ++m) { unsigned char* rowp = base + (size_t)(ai * HALF + m * 16) * 1024;
#pragma unroll
                for (int bj = 0; bj < 2; ++bj) { const f32x4 v0 = acc[ai][bj][m][0] * asc + bv[bj][0], v1 = acc[ai][bj][m][1] * asc + bv[bj][1];
                    int lo = __builtin_amdgcn_cvt_pk_fp8_f32(v0[0], v0[1], 0, false); lo = __builtin_amdgcn_cvt_pk_fp8_f32(v0[2], v0[3], lo, true);
                    int hi = __builtin_amdgcn_cvt_pk_fp8_f32(v1[0], v1[1], 0, false); hi = __builtin_amdgcn_cvt_pk_fp8_f32(v1[2], v1[3], hi, true);
                    *(int2*)(rowp + bj * HALF) = make_int2(lo, hi); } }
    }
};
struct EpiBiasBf16 { static constexpr bool PERM = true, AFTER_DRAIN = false;
    bf16_t* O; const float* bias; float ascale;
    __device__ __forceinline__ void operator()(const f32x4 (&acc)[2][2][4][2], const Unit& u, int wr, int wc, int fr, int fq) const {
        const int col0 = u.pn * BM + wc * 32 + 8 * fq; const float* b = bias + (size_t)u.aux * 1024 + col0;
        float asc = ascale; asm volatile("" : "+v"(asc));
        bf16_t* base = O + (size_t)(u.pm * BM + wr * 64 + fr) * 1024 + col0;
        f32x4 bv[2][2];
#pragma unroll
        for (int bj = 0; bj < 2; ++bj)
#pragma unroll
            for (int n = 0; n < 2; ++n) bv[bj][n] = *(const f32x4*)(b + bj * HALF + 4 * n);
#pragma unroll
        for (int ai = 0; ai < 2; ++ai)
#pragma unroll
            for (int m = 0; m < 4; ++m) { bf16_t* rowp = base + (size_t)(ai * HALF + m * 16) * 1024;
#pragma unroll
                for (int bj = 0; bj < 2; ++bj) { const f32x4 v0 = acc[ai][bj][m][0] * asc + bv[bj][0], v1 = acc[ai][bj][m][1] * asc + bv[bj][1]; u32x4 w;
                    w.x = cvt_pk_bf16(v0[0], v0[1]); w.y = cvt_pk_bf16(v0[2], v0[3]); w.z = cvt_pk_bf16(v1[0], v1[1]); w.w = cvt_pk_bf16(v1[2], v1[3]);
                    *(u32x4*)(rowp + bj * HALF) = w; } }
    }
};
}
__device__ __forceinline__ unsigned pk2(float lo, float hi) { return (unsigned)f2bf(lo) | ((unsigned)f2bf(hi) << 16); }
__device__ __forceinline__ void transpose_item(const float* __restrict__ W, int K, int N, bf16_t* __restrict__ WT, LAS float* scr, int item, int lane, const float* rowscale = nullptr, float cscale = 1.0f, int cs_ncols = 1 << 30) {
    const int nblk = N / 32, kb = item / nblk, nb = item % nblk, k0 = 64 * kb, n0 = 32 * nb;
    const float cs = n0 < cs_ncols ? cscale : 1.0f;
#pragma unroll 8
    for (int i = 0; i < 32; ++i) { const int kk = 2 * i + (lane >> 5); float w = W[(size_t)(k0 + kk) * N + n0 + (lane & 31)]; if (rowscale) w *= rowscale[k0 + kk]; scr[kk * 33 + (lane & 31)] = w * cs; }
    asm volatile("s_waitcnt lgkmcnt(0)" ::: "memory");
    const int c = lane & 7;
#pragma unroll
    for (int j = 0; j < 4; ++j) { const int n = (lane >> 3) + 8 * j; const LAS float* sp = scr + (8 * c) * 33 + n;
        uint4 o; o.x = pk2(sp[0 * 33], sp[1 * 33]); o.y = pk2(sp[2 * 33], sp[3 * 33]); o.z = pk2(sp[4 * 33], sp[5 * 33]); o.w = pk2(sp[6 * 33], sp[7 * 33]);
        *(uint4*)(WT + (size_t)(n0 + n) * K + k0 + 8 * c) = o; }
    asm volatile("s_waitcnt lgkmcnt(0)" ::: "memory");
}

__device__ __forceinline__ void transpose_item_f8(const float* __restrict__ W, int K, int N, unsigned char* __restrict__ WT, LAS float* scr, int item, int lane, float cscale = 1.0f, int cs_ncols = 1 << 30) {
    const int nblk = N / 32, kb = item / nblk, nb = item % nblk, k0 = 64 * kb, n0 = 32 * nb;
    const float cs = 32.0f * (n0 < cs_ncols ? cscale : 1.0f);
#pragma unroll 8
    for (int i = 0; i < 32; ++i) { const int kk = 2 * i + (lane >> 5); scr[kk * 33 + (lane & 31)] = W[(size_t)(k0 + kk) * N + n0 + (lane & 31)] * cs; }
    asm volatile("s_waitcnt lgkmcnt(0)" ::: "memory");
    const int c = lane & 7;
#pragma unroll
    for (int j = 0; j < 4; ++j) { const int n = (lane >> 3) + 8 * j; const LAS float* sp = scr + (8 * c) * 33 + n;
        int lo = __builtin_amdgcn_cvt_pk_fp8_f32(sp[0 * 33], sp[1 * 33], 0, false); lo = __builtin_amdgcn_cvt_pk_fp8_f32(sp[2 * 33], sp[3 * 33], lo, true);
        int hi = __builtin_amdgcn_cvt_pk_fp8_f32(sp[4 * 33], sp[5 * 33], 0, false); hi = __builtin_amdgcn_cvt_pk_fp8_f32(sp[6 * 33], sp[7 * 33], hi, true);
        *(int2*)(WT + (size_t)(n0 + n) * K + k0 + 8 * c) = make_int2(lo, hi); }
    asm volatile("s_waitcnt lgkmcnt(0)" ::: "memory");
}
template <bool F8OUT>
__device__ __forceinline__ void transpose_item64(const float* __restrict__ W, int K, int N, void* __restrict__ WT, LAS float* scr, int item, int lane, const float* rowscale = nullptr, float cscale = 1.0f) {
    const int nblk = N / 64, kb = item / nblk, nb = item % nblk, k0 = 64 * kb, n0 = 64 * nb;
    const float cs = cscale * (F8OUT ? 32.0f : 1.0f);
    float4 wv[16];
#pragma unroll
    for (int i = 0; i < 16; ++i) wv[i] = *(const float4*)(W + (size_t)(k0 + 4 * i + (lane >> 4)) * N + n0 + 4 * (lane & 15));
#pragma unroll
    for (int i = 0; i < 16; ++i) { const int kk = 4 * i + (lane >> 4); const float4 w = wv[i];
        const float rs = rowscale ? rowscale[k0 + kk] * cs : cs; LAS float* d = scr + kk * 65 + 4 * (lane & 15); d[0] = w.x * rs; d[1] = w.y * rs; d[2] = w.z * rs; d[3] = w.w * rs; }
    asm volatile("s_waitcnt lgkmcnt(0)" ::: "memory");
    const int c = lane & 7;
#pragma unroll
    for (int j = 0; j < 8; ++j) { const int n = (lane >> 3) + 8 * j; const LAS float* sp = scr + (8 * c) * 65 + n;
        if constexpr (F8OUT) { int lo = __builtin_amdgcn_cvt_pk_fp8_f32(sp[0 * 65], sp[1 * 65], 0, false); lo = __builtin_amdgcn_cvt_pk_fp8_f32(sp[2 * 65], sp[3 * 65], lo, true);
            int hi = __builtin_amdgcn_cvt_pk_fp8_f32(sp[4 * 65], sp[5 * 65], 0, false); hi = __builtin_amdgcn_cvt_pk_fp8_f32(sp[6 * 65], sp[7 * 65], hi, true);
            *(int2*)((unsigned char*)WT + (size_t)(n0 + n) * K + k0 + 8 * c) = make_int2(lo, hi); }
        else { uint4 o; o.x = pk2(sp[0 * 65], sp[1 * 65]); o.y = pk2(sp[2 * 65], sp[3 * 65]); o.z = pk2(sp[4 * 65], sp[5 * 65]); o.w = pk2(sp[6 * 65], sp[7 * 65]);
            *(uint4*)((bf16_t*)WT + (size_t)(n0 + n) * K + k0 + 8 * c) = o; } }
    asm volatile("s_waitcnt lgkmcnt(0)" ::: "memory");
}
namespace fa {
using bf16x8 = __attribute__((ext_vector_type(8))) short;
using s16x4  = __attribute__((ext_vector_type(4))) short;
using f32x16 = __attribute__((ext_vector_type(16))) float;
using u32x4  = __attribute__((ext_vector_type(4))) unsigned;
constexpr int QBLK = 32, KVBLK = 64, NW = 8;
constexpr int SHM_V = KVBLK * 128 * 2, SHM_K = KVBLK * 128 * 2, SHM_ATTN = 2 * SHM_V + 2 * SHM_K + NW * 64 * 4;
constexpr float LOG2E = 1.4426950408889634f, THR = 8.0f, NEGS = -1.0e30f;
#define FA_KSWZ(row, colB) ((row) * 256 + ((colB) ^ (((row) & 7) << 4)))
#define FA_SBAR() __builtin_amdgcn_sched_barrier(0)
__device__ __forceinline__ int crow(int r, int hi) { return (r & 3) + 8 * (r >> 2) + 4 * hi; }
__device__ __forceinline__ unsigned cvtpk(float lo, float hi) { unsigned r; asm volatile("v_cvt_pk_bf16_f32 %0, %1, %2" : "=v"(r) : "v"(lo), "v"(hi)); return r; }
__device__ __forceinline__ void partialSM(f32x16& p0, f32x16& p1, float& m_reg, float& mn, float& alpha) {
  float pmax = p0[0];
#pragma unroll
  for (int r = 1; r < 16; ++r) pmax = fmaxf(pmax, p0[r]);
#pragma unroll
  for (int r = 0; r < 16; ++r) pmax = fmaxf(pmax, p1[r]);
  { auto rr = __builtin_amdgcn_permlane32_swap(__float_as_uint(pmax), __float_as_uint(pmax), false, false);
    pmax = fmaxf(__uint_as_float(rr[0]), __uint_as_float(rr[1])); }
  if (__builtin_expect(__all(pmax - m_reg <= THR), 1)) { mn = m_reg; alpha = 1.f; }
  else { mn = fmaxf(m_reg, pmax); alpha = __builtin_amdgcn_exp2f((m_reg - mn) * LOG2E); m_reg = mn; }
  const float mnC = -mn * LOG2E;
#pragma unroll
  for (int r = 0; r < 16; ++r) p0[r] = fmaf(p0[r], LOG2E, mnC);
#pragma unroll
  for (int r = 0; r < 16; ++r) p1[r] = fmaf(p1[r], LOG2E, mnC);
#pragma unroll
  for (int r = 0; r < 16; ++r) p0[r] = __builtin_amdgcn_exp2f(p0[r]);
}
__device__ __forceinline__ void finishSM(f32x16& p0, f32x16& p1, float alpha, float& l_reg, bf16x8& pa0, bf16x8& pa1, bf16x8& pa2, bf16x8& pa3) {
#pragma unroll
  for (int r = 0; r < 16; ++r) p1[r] = __builtin_amdgcn_exp2f(p1[r]);
  float ps = 0;
#pragma unroll
  for (int r = 0; r < 16; ++r) ps += p0[r];
#pragma unroll
  for (int r = 0; r < 16; ++r) ps += p1[r];
  { auto rr = __builtin_amdgcn_permlane32_swap(__float_as_uint(ps), __float_as_uint(ps), false, false);
    ps = __uint_as_float(rr[0]) + __uint_as_float(rr[1]); }
  l_reg = l_reg * alpha + ps;
#define FA_PK4(P, BASE, OUT) do { unsigned a0 = cvtpk(P[BASE + 0], P[BASE + 1]), a1 = cvtpk(P[BASE + 2], P[BASE + 3]);   \
    unsigned b0 = cvtpk(P[BASE + 4], P[BASE + 5]), b1 = cvtpk(P[BASE + 6], P[BASE + 7]);                              \
    auto r0 = __builtin_amdgcn_permlane32_swap(a0, b0, false, false); auto r1 = __builtin_amdgcn_permlane32_swap(a1, b1, false, false); \
    u32x4 w = {r0[0], r1[0], r0[1], r1[1]}; OUT = *reinterpret_cast<bf16x8*>(&w); } while (0)
  FA_PK4(p0, 0, pa0); FA_PK4(p0, 8, pa1); FA_PK4(p1, 0, pa2); FA_PK4(p1, 8, pa3);
#undef FA_PK4
}
template <int NQ> __device__ __forceinline__ void qkt(f32x16& p0, f32x16& p1, const char* Ks, const bf16x8* qr, int r32, int hi) {
  p0 = f32x16{}; p1 = f32x16{};
#pragma unroll
  for (int d0 = 0; d0 < NQ; ++d0) { const int cb = (d0 * 16 + hi * 8) * 2;
    const bf16x8 b0 = *reinterpret_cast<const bf16x8*>(Ks + FA_KSWZ(r32, cb));
    const bf16x8 b1 = *reinterpret_cast<const bf16x8*>(Ks + FA_KSWZ(32 + r32, cb));
    p0 = __builtin_amdgcn_mfma_f32_32x32x16_bf16(b0, qr[d0], p0, 0, 0, 0);
    p1 = __builtin_amdgcn_mfma_f32_32x32x16_bf16(b1, qr[d0], p1, 0, 0, 0); }
}
__device__ __forceinline__ int v_st(int k, int c) { const int kk = (k & ~0xC) | ((k & 4) << 1) | ((k & 8) >> 1); return ((kk >> 3) * 4 + (c >> 5)) * 512 + ((kk & 7) * 32 + (c & 31)) * 2; }
__device__ __forceinline__ int v_rd_base(int lane) { return ((lane & 3) << 3) | (((lane >> 2) & 3) << 6) | (((lane >> 4) & 1) << 5) | (((lane >> 5) & 1) << 8); }
constexpr int v_rd_off(int d0, int ks, int half) { return d0 * 512 + ks * 4096 + half * 2048; }
template <int OFF> __device__ __forceinline__ s16x4 tr_read(int vb) {
  s16x4 r; asm volatile("ds_read_b64_tr_b16 %0, %1 offset:%2" : "=&v"(r) : "v"(vb), "i"(OFF) : "memory"); return r;
}
template <int D0> __device__ __forceinline__ void pv_one(f32x16& od, int vb, bf16x8 pa0, bf16x8 pa1, bf16x8 pa2, bf16x8 pa3) {
  const s16x4 l0 = tr_read<v_rd_off(D0, 0, 0)>(vb), h0 = tr_read<v_rd_off(D0, 0, 1)>(vb), l1 = tr_read<v_rd_off(D0, 1, 0)>(vb), h1 = tr_read<v_rd_off(D0, 1, 1)>(vb);
  const s16x4 l2 = tr_read<v_rd_off(D0, 2, 0)>(vb), h2 = tr_read<v_rd_off(D0, 2, 1)>(vb), l3 = tr_read<v_rd_off(D0, 3, 0)>(vb), h3 = tr_read<v_rd_off(D0, 3, 1)>(vb);
  asm volatile("s_waitcnt lgkmcnt(0)" ::: "memory"); FA_SBAR();
#define FA_PK(L, H) (bf16x8){L[0], L[1], L[2], L[3], H[0], H[1], H[2], H[3]}
  od = __builtin_amdgcn_mfma_f32_32x32x16_bf16(pa0, FA_PK(l0, h0), od, 0, 0, 0);
  od = __builtin_amdgcn_mfma_f32_32x32x16_bf16(pa1, FA_PK(l1, h1), od, 0, 0, 0);
  od = __builtin_amdgcn_mfma_f32_32x32x16_bf16(pa2, FA_PK(l2, h2), od, 0, 0, 0);
  od = __builtin_amdgcn_mfma_f32_32x32x16_bf16(pa3, FA_PK(l3, h3), od, 0, 0, 0);
#undef FA_PK
}
template <int NV> __device__ __forceinline__ void pv_all(f32x16* o, int vb, bf16x8 pa0, bf16x8 pa1, bf16x8 pa2, bf16x8 pa3) {
  pv_one<0>(o[0], vb, pa0, pa1, pa2, pa3); pv_one<1>(o[1], vb, pa0, pa1, pa2, pa3);
  if constexpr (NV == 4) { pv_one<2>(o[2], vb, pa0, pa1, pa2, pa3); pv_one<3>(o[3], vb, pa0, pa1, pa2, pa3); }
}
__device__ __forceinline__ void wmask(f32x16& p0, f32x16& p1, int dq4) {
#pragma unroll
  for (int r = 0; r < 16; ++r) { const int d = dq4 + (r & 3) + 8 * (r >> 2); if ((unsigned)(d + 128) > 256u) p0[r] = NEGS; if ((unsigned)(d + 32 + 128) > 256u) p1[r] = NEGS; }
}

struct Unit {
  const bf16_t* Q; const bf16_t* K; const bf16_t* V; bf16_t* O;
  int rowa, nta, rowb, ntb;
  int window, qpos0, kposb0;
  float sink; int has_sink;
  const bf16_t* K2;
  const float* tab; int pos0;
  const float* qg;
};
template <int DQ, int DV, int LDQ, int LDK, int LDV, int LDO, bool WIN, int RD0, int RH, bool QNORM, bool KSPLIT, bool O8>
__device__ __forceinline__ void attn_unit(const int tid, const Unit& U, char* lds) {
  constexpr int NQ = DQ / 16, NV = DV / 32;
  const int wid = tid >> 6, lane = tid & 63, r32 = lane & 31, hi = lane >> 5;
  char* V_lds = lds; char* K_lds = lds + 2 * SHM_V;
  float* ws = (float*)(lds + 2 * SHM_V + 2 * SHM_K) + wid * 64; float* li_l = ws; float* al_l = ws + 32;
  float m_reg = -1e30f, l_reg = 0; f32x16 o[NV]; bf16x8 qr[NQ];
#pragma unroll
  for (int d = 0; d < NV; ++d) o[d] = f32x16{};
  const bf16_t* Qw = U.Q + (size_t)(wid * QBLK + r32) * LDQ + hi * 8;
#pragma unroll
  for (int d0 = 0; d0 < NQ; ++d0) qr[d0] = *reinterpret_cast<const bf16x8*>(Qw + d0 * 16);
  if constexpr (QNORM || RH > 0) {
    float qf[NQ][8];
#pragma unroll
    for (int d0 = 0; d0 < NQ; ++d0)
#pragma unroll
      for (int j = 0; j < 8; ++j) qf[d0][j] = __uint_as_float(((unsigned)(unsigned short)qr[d0][j]) << 16);
    if constexpr (QNORM) {
      float ss = 0.f;
#pragma unroll
      for (int d0 = 0; d0 < NQ; ++d0)
#pragma unroll
        for (int j = 0; j < 8; ++j) ss = fmaf(qf[d0][j], qf[d0][j], ss);
      { auto rr = __builtin_amdgcn_permlane32_swap(__float_as_uint(ss), __float_as_uint(ss), false, false); ss = __uint_as_float(rr[0]) + __uint_as_float(rr[1]); }
      const float ri = 1.0f / sqrtf(ss * (1.0f / DQ) + 1e-6f);
#pragma unroll
      for (int d0 = 0; d0 < NQ; ++d0) { const float4 g0 = *(const float4*)(U.qg + 16 * d0 + 8 * hi), g1 = *(const float4*)(U.qg + 16 * d0 + 8 * hi + 4);
        qf[d0][0] *= ri * g0.x; qf[d0][1] *= ri * g0.y; qf[d0][2] *= ri * g0.z; qf[d0][3] *= ri * g0.w; qf[d0][4] *= ri * g1.x; qf[d0][5] *= ri * g1.y; qf[d0][6] *= ri * g1.z; qf[d0][7] *= ri * g1.w; }
    }
    if constexpr (RH > 0) { if (U.tab) {
      const float4* tb = (const float4*)(U.tab + ((size_t)(U.pos0 + wid * QBLK + r32) * (RH * 16) + 8 * hi) * 2);
#pragma unroll
      for (int dd = 0; dd < RH; ++dd) {
#pragma unroll
        for (int j2 = 0; j2 < 4; ++j2) { const float4 t = tb[dd * 8 + j2];
          { const float x1 = qf[RD0 + dd][2 * j2], x2 = qf[RD0 + RH + dd][2 * j2]; qf[RD0 + dd][2 * j2] = x1 * t.x - x2 * t.y; qf[RD0 + RH + dd][2 * j2] = x2 * t.x + x1 * t.y; }
          { const float x1 = qf[RD0 + dd][2 * j2 + 1], x2 = qf[RD0 + RH + dd][2 * j2 + 1]; qf[RD0 + dd][2 * j2 + 1] = x1 * t.z - x2 * t.w; qf[RD0 + RH + dd][2 * j2 + 1] = x2 * t.z + x1 * t.w; } } } } }
#pragma unroll
    for (int d0 = 0; d0 < NQ; ++d0) { u32x4 w = {cvtpk(qf[d0][0], qf[d0][1]), cvtpk(qf[d0][2], qf[d0][3]), cvtpk(qf[d0][4], qf[d0][5]), cvtpk(qf[d0][6], qf[d0][7])}; qr[d0] = *reinterpret_cast<bf16x8*>(&w); }
  }
  const int sr = tid >> 4, sc = (tid & 15) * 8, vst0 = v_st(sr, sc), vst1 = v_st(32 + sr, sc);
  const int sck = sc < DQ - 8 ? sc : DQ - 8, scv = sc < DV - 8 ? sc : DV - 8;
  const int vb0 = (int)(uintptr_t)V_lds + v_rd_base(lane);
  const int nta = U.nta, NT = U.nta + U.ntb;
  const unsigned kof0 = (unsigned)((sr * LDK + sck) * 2), kof1 = kof0 + 32u * LDK * 2u, vof0 = (unsigned)((sr * LDV + scv) * 2), vof1 = vof0 + 32u * LDV * 2u;
  constexpr int LDK2 = 1536;
  const int ci = tid & 15; const bool ksec = KSPLIT && ci >= 8; const int kld = ksec ? LDK2 : LDK;
  const bf16_t* kp0 = ksec ? U.K2 + (size_t)sr * LDK2 + ((ci < 11 ? ci : 11) - 8) * 8 : U.K + (size_t)sr * LDK + ci * 8; const bf16_t* kp1 = kp0 + (size_t)32 * kld;
  (void)kof0; (void)kof1; (void)kp0; (void)kp1; (void)kld;
  struct { bf16x8 vs0, vs1, ks0, ks1; } sr_[2];
#define FA_KROW(j) ((j) < nta ? U.rowa + (j) * KVBLK : U.rowb + ((j) - nta) * KVBLK)
#define FA_SLOAD(i, j) do { const size_t k0_ = (size_t)(FA_KROW(j)); const char* kt_ = (const char*)U.K + k0_ * (LDK * 2); const char* vt_ = (const char*)U.V + k0_ * (LDV * 2); \
    sr_[i].vs0 = *reinterpret_cast<const bf16x8*>(vt_ + vof0); sr_[i].vs1 = *reinterpret_cast<const bf16x8*>(vt_ + vof1); \
    if constexpr (KSPLIT) { sr_[i].ks0 = *reinterpret_cast<const bf16x8*>(kp0 + k0_ * kld); sr_[i].ks1 = *reinterpret_cast<const bf16x8*>(kp1 + k0_ * kld); } \
    else { sr_[i].ks0 = *reinterpret_cast<const bf16x8*>(kt_ + kof0); sr_[i].ks1 = *reinterpret_cast<const bf16x8*>(kt_ + kof1); } } while (0)
#define FA_SWRITE(b, i) do { *(bf16x8*)(V_lds + (b) * SHM_V + vst0) = sr_[i].vs0; *(bf16x8*)(V_lds + (b) * SHM_V + vst1) = sr_[i].vs1; const int kc = sc * 2; \
    *(bf16x8*)(K_lds + (b) * SHM_K + FA_KSWZ(sr, kc)) = sr_[i].ks0; *(bf16x8*)(K_lds + (b) * SHM_K + FA_KSWZ(32 + sr, kc)) = sr_[i].ks1; } while (0)
#define FA_SWAIT() asm volatile("s_waitcnt vmcnt(4)" ::: "memory")
#define FA_RESC(a) do { if (__any((a) < 1.f)) { if (hi == 0) al_l[r32] = (a); asm volatile("s_waitcnt lgkmcnt(0)" ::: "memory"); \
    _Pragma("unroll") for (int d = 0; d < NV; ++d) _Pragma("unroll") for (int r = 0; r < 16; ++r) o[d][r] *= al_l[crow(r, hi)]; } } while (0)
  const int qw0 = U.qpos0 + wid * QBLK;
#define FA_MASK(P0, P1, t) do { if (WIN && U.window && (t) >= nta) { const int kb_ = U.kposb0 + ((t) - nta) * KVBLK; \
    if (kb_ + 63 - qw0 > 128 || qw0 + 31 - kb_ > 128) wmask(P0, P1, kb_ - (qw0 + r32) + 4 * hi); } } while (0)
  f32x16 pA0, pA1, pB0, pB1; float mnA, mnB, alA, alB; bf16x8 pa0, pa1, pa2, pa3;
  constexpr int SE = 0, SO = 1;
  FA_SLOAD(SE, 0); asm volatile("s_waitcnt vmcnt(0)" ::: "memory"); FA_SWRITE(0, SE); __syncthreads();
  qkt<NQ>(pA0, pA1, K_lds, qr, r32, hi); FA_MASK(pA0, pA1, 0); partialSM(pA0, pA1, m_reg, mnA, alA);
  FA_SLOAD(SO, 1); if (2 < NT) FA_SLOAD(SE, 2);
  FA_SWAIT(); FA_SWRITE(1, SO); __syncthreads();
  for (int j = 1; j + 1 < NT; j += 2) {
    FA_SBAR(); qkt<NQ>(pB0, pB1, K_lds + SHM_K, qr, r32, hi);
    finishSM(pA0, pA1, alA, l_reg, pa0, pa1, pa2, pa3); FA_SBAR();
    FA_SLOAD(SO, j + 2); FA_SBAR();
    pv_all<NV>(o, vb0, pa0, pa1, pa2, pa3); FA_MASK(pB0, pB1, j); partialSM(pB0, pB1, m_reg, mnB, alB);
    __syncthreads(); FA_SWAIT(); FA_SWRITE(0, SE);
    FA_RESC(alB); __syncthreads();
    FA_SBAR(); qkt<NQ>(pA0, pA1, K_lds, qr, r32, hi);
    finishSM(pB0, pB1, alB, l_reg, pa0, pa1, pa2, pa3); FA_SBAR();
    if (j + 3 < NT) FA_SLOAD(SE, j + 3); FA_SBAR();
    pv_all<NV>(o, vb0 + SHM_V, pa0, pa1, pa2, pa3); FA_MASK(pA0, pA1, j + 1); partialSM(pA0, pA1, m_reg, mnA, alA);
    __syncthreads(); FA_SWAIT(); FA_SWRITE(1, SO);
    FA_RESC(alA); __syncthreads();
  }
  FA_SBAR(); qkt<NQ>(pB0, pB1, K_lds + SHM_K, qr, r32, hi);
  finishSM(pA0, pA1, alA, l_reg, pa0, pa1, pa2, pa3); FA_SBAR();
  pv_all<NV>(o, vb0, pa0, pa1, pa2, pa3); FA_MASK(pB0, pB1, NT - 1); partialSM(pB0, pB1, m_reg, mnB, alB);
  __syncthreads(); FA_RESC(alB);
  finishSM(pB0, pB1, alB, l_reg, pa0, pa1, pa2, pa3); FA_SBAR();
  pv_all<NV>(o, vb0 + SHM_V, pa0, pa1, pa2, pa3);
  if (U.has_sink) l_reg += __builtin_amdgcn_exp2f((U.sink - m_reg) * LOG2E);
  if (hi == 0) li_l[r32] = l_reg;
  asm volatile("s_waitcnt lgkmcnt(0)" ::: "memory");
  __syncthreads();
  int lane2 = lane; asm volatile("" : "+v"(lane2));
  const int r32e = lane2 & 31, hie = lane2 >> 5;
  if constexpr (O8) {
    unsigned char* stg = (unsigned char*)(lds + wid * 8192);
    unsigned char* stw = stg + hie * 4 * DV + r32e;
#pragma unroll
    for (int r = 0; r < 16; ++r) { const int orow0 = (r & 3) + 8 * (r >> 2); const float rl = __builtin_amdgcn_rcpf(li_l[orow0 + 4 * hie]);
#pragma unroll
      for (int d0 = 0; d0 < NV; ++d0) stw[orow0 * DV + d0 * 32] = (unsigned char)(__builtin_amdgcn_cvt_pk_fp8_f32(o[d0][r] * rl, 0.f, 0, false) & 0xff); }
    asm volatile("s_waitcnt lgkmcnt(0)" ::: "memory");
    constexpr int CPR = DV / 16, RPI = 64 / CPR;
    const int erow = lane2 / CPR, ech = lane2 % CPR;
    unsigned char* Ow = (unsigned char*)U.O + (size_t)(wid * QBLK + erow) * LDO + ech * 16; const unsigned char* str = stg + erow * DV + ech * 16;
#pragma unroll
    for (int i = 0; i < 32 / RPI; ++i) { const u32x4 v = *(const u32x4*)(str + i * RPI * DV); *(u32x4*)(Ow + (size_t)(i * RPI) * LDO) = v; }
  } else {
  bf16_t* stg = (bf16_t*)(lds + wid * 8192);
  bf16_t* stw = stg + hie * 4 * DV + r32e;
#pragma unroll
  for (int r = 0; r < 16; ++r) { const int orow0 = (r & 3) + 8 * (r >> 2); const float rl = __builtin_amdgcn_rcpf(li_l[orow0 + 4 * hie]);
#pragma unroll
    for (int d0 = 0; d0 < NV; ++d0) stw[orow0 * DV + d0 * 32] = f2bf(o[d0][r] * rl); }
  asm volatile("s_waitcnt lgkmcnt(0)" ::: "memory");
  constexpr int CPR = DV / 8, RPI = 64 / CPR;
  const int erow = lane2 / CPR, ech = lane2 % CPR;
  bf16_t* Ow = U.O + (size_t)(wid * QBLK + erow) * LDO + ech * 8; const bf16_t* str = stg + erow * DV + ech * 8;
#pragma unroll
  for (int i = 0; i < 32 / RPI; ++i) { const u32x4 v = *(const u32x4*)(str + i * RPI * DV); *(u32x4*)(Ow + (size_t)(i * RPI) * LDO) = v; }
  }
  __syncthreads();
#undef FA_KROW
#undef FA_SLOAD
#undef FA_SWRITE
#undef FA_SWAIT
#undef FA_RESC
#undef FA_MASK
}
}

__device__ __forceinline__ void route_reduce(const float (&acc)[32], const int lane, const int el, const float rb, float (&tv)[4], int (&ti)[4]) {
    float a16[16], a8[8], a4[4], a2[2];
#pragma unroll
    for (int k = 0; k < 16; ++k) { const bool up = (lane & 32) != 0; const float keep = up ? acc[k + 16] : acc[k], send = up ? acc[k] : acc[k + 16]; a16[k] = keep + __shfl_xor(send, 32); }
#pragma unroll
    for (int k = 0; k < 8; ++k) { const bool up = (lane & 16) != 0; const float keep = up ? a16[k + 8] : a16[k], send = up ? a16[k] : a16[k + 8]; a8[k] = keep + __shfl_xor(send, 16); }
#pragma unroll
    for (int k = 0; k < 4; ++k) { const bool up = (lane & 8) != 0; const float keep = up ? a8[k + 4] : a8[k], send = up ? a8[k] : a8[k + 4]; a4[k] = keep + __shfl_xor(send, 8); }
#pragma unroll
    for (int k = 0; k < 2; ++k) { const bool up = (lane & 4) != 0; const float keep = up ? a4[k + 2] : a4[k], send = up ? a4[k] : a4[k + 2]; a2[k] = keep + __shfl_xor(send, 4); }
    float lg; { const bool up = (lane & 2) != 0; const float keep = up ? a2[1] : a2[0], send = up ? a2[0] : a2[1]; lg = keep + __shfl_xor(send, 2); }
    lg += __shfl_xor(lg, 1); lg += rb;
    unsigned key; { const unsigned u = __float_as_uint(lg); const unsigned ou = (u & 0x80000000u) ? ~u : (u | 0x80000000u); key = (ou & ~31u) | (unsigned)(31 - el); }
#pragma unroll
    for (int k = 0; k < 4; ++k) { unsigned bk = key;
#pragma unroll
        for (int o = 1; o < 64; o <<= 1) { const unsigned ok = (unsigned)__shfl_xor((int)bk, o); bk = ok > bk ? ok : bk; }
        const int bi = 31 - (int)(bk & 31u); const unsigned ou = bk & ~31u; const unsigned ub = (ou & 0x80000000u) ? (ou ^ 0x80000000u) : ~ou;
        tv[k] = __uint_as_float(ub); ti[k] = bi; if (el == bi) key = 0u; }
}

template <int CTRL> __device__ __forceinline__ float dpp_f32(const float x) { return __builtin_bit_cast(float, __builtin_amdgcn_update_dpp(0, __builtin_bit_cast(int, x), CTRL, 0xf, 0xf, true)); }
template <int CTRL> __device__ __forceinline__ unsigned dpp_u32(const unsigned x) { return (unsigned)__builtin_amdgcn_update_dpp(0, (int)x, CTRL, 0xf, 0xf, true); }
template <int M> __device__ __forceinline__ float xlane_f32(const float x) {
    if constexpr (M == 1) return dpp_f32<0xB1>(x);
    else if constexpr (M == 2) return dpp_f32<0x4E>(x);
    else if constexpr (M == 4) return dpp_f32<0x1B>(dpp_f32<0x141>(x));
    else return dpp_f32<0x128>(x);
}
template <int M> __device__ __forceinline__ unsigned xlane_u32(const unsigned x) {
    if constexpr (M == 1) return dpp_u32<0xB1>(x);
    else if constexpr (M == 2) return dpp_u32<0x4E>(x);
    else if constexpr (M == 4) return dpp_u32<0x1B>(dpp_u32<0x141>(x));
    else return dpp_u32<0x128>(x);
}
typedef unsigned u32x2_t __attribute__((ext_vector_type(2)));
__device__ __forceinline__ float half_sum32(float v) {
    v += xlane_f32<1>(v); v += xlane_f32<2>(v); v += xlane_f32<4>(v); v += xlane_f32<8>(v);
    const u32x2_t r = __builtin_amdgcn_permlane16_swap(__float_as_uint(v), __float_as_uint(v), false, false);
    return __uint_as_float(r[0]) + __uint_as_float(r[1]);
}
__device__ __forceinline__ void route_reduce32(const float (&acc)[32], const int l5, const float rb, float (&tv)[4], int (&ti)[4]) {
    float a16[16], a8[8], a4[4], a2[2];
#pragma unroll
    for (int k = 0; k < 16; ++k) { const u32x2_t r = __builtin_amdgcn_permlane16_swap(__float_as_uint(acc[k]), __float_as_uint(acc[k + 16]), false, false); a16[k] = __uint_as_float(r[0]) + __uint_as_float(r[1]); }
#pragma unroll
    for (int k = 0; k < 8; ++k) { const bool up = (l5 & 8) != 0; const float keep = up ? a16[k + 8] : a16[k], send = up ? a16[k] : a16[k + 8]; a8[k] = keep + xlane_f32<8>(send); }
#pragma unroll
    for (int k = 0; k < 4; ++k) { const bool up = (l5 & 4) != 0; const float keep = up ? a8[k + 4] : a8[k], send = up ? a8[k] : a8[k + 4]; a4[k] = keep + xlane_f32<4>(send); }
#pragma unroll
    for (int k = 0; k < 2; ++k) { const bool up = (l5 & 2) != 0; const float keep = up ? a4[k + 2] : a4[k], send = up ? a4[k] : a4[k + 2]; a2[k] = keep + xlane_f32<2>(send); }
    float lg; { const bool up = (l5 & 1) != 0; const float keep = up ? a2[1] : a2[0], send = up ? a2[0] : a2[1]; lg = keep + xlane_f32<1>(send); }
    lg += rb;
    unsigned key; { const unsigned u = __float_as_uint(lg); const unsigned ou = (u & 0x80000000u) ? ~u : (u | 0x80000000u); key = (ou & ~31u) | (unsigned)(31 - l5); }
#pragma unroll
    for (int k = 0; k < 4; ++k) { unsigned bk = key;
        { const unsigned ok = xlane_u32<1>(bk); bk = ok > bk ? ok : bk; } { const unsigned ok = xlane_u32<2>(bk); bk = ok > bk ? ok : bk; }
        { const unsigned ok = xlane_u32<4>(bk); bk = ok > bk ? ok : bk; } { const unsigned ok = xlane_u32<8>(bk); bk = ok > bk ? ok : bk; }
        { const u32x2_t r = __builtin_amdgcn_permlane16_swap(bk, bk, false, false); bk = r[0] > r[1] ? r[0] : r[1]; }
        const int bi = 31 - (int)(bk & 31u); const unsigned ou = bk & ~31u; const unsigned ub = (ou & 0x80000000u) ? (ou ^ 0x80000000u) : ~ou;
        tv[k] = __uint_as_float(ub); ti[k] = bi; if (l5 == bi) key = 0u; }
}

struct Params {
    const float *x, *c, *ctx, *c_ctx, *ada_w, *ada_b, *norm_mix_g, *norm_ffn_g, *ab_w_in, *mla_q_g, *mla_wq_b, *mla_kv_g, *mla_wkv_b, *swa_sink, *ab_w_out,
        *c_w_in, *c_q_g, *c_k_g, *c_w_out, *router_w, *router_b, *moe_w_in, *moe_b_in, *moe_w_out, *moe_b_out, *final_g;
    float* out; unsigned char* ws; int ph_lo, ph_hi;
};
__device__ __forceinline__ int mod_row_of(int r) { return r < NLAT ? r / SEQ : NB; }
__device__ __forceinline__ float rope_angle(int i, int quarter, int prow, int pcol) {
    const int ii = i < quarter ? i : i - quarter; const float inv = powf(10000.f, -(float)ii / (float)quarter);
    return (float)(i < quarter ? prow : pcol) * inv;
}

#ifndef OUTPROJ_F8
#define OUTPROJ_F8 1
#endif
#ifndef Y8_L1
#define Y8_L1 1
#endif
#ifndef Y8_L0
#define Y8_L0 1
#endif
#ifndef INPROJ_F8
#define INPROJ_F8 1
#endif
#ifndef MOE_F8_DOWN
#define MOE_F8_DOWN 1
#endif
#ifndef MOE_F8_L0
#define MOE_F8_L0 1
#endif
#ifndef MOE_F8_L1
#define MOE_F8_L1 1
#endif
constexpr int LDS_BYTES = 147456;
constexpr int LDS_MISC = 143360;
constexpr int N_PHASES = 21;

__global__ void __launch_bounds__(NTHR, 2) fwd_kernel(Params p) {
    extern __shared__ __attribute__((aligned(16))) unsigned char lds_raw[];
    float* ldsf = (float*)lds_raw;
    LAS unsigned* misc = (LAS unsigned*)(lds_raw + LDS_MISC + 320);
    const int wave0 = __builtin_amdgcn_readfirstlane((int)(threadIdx.x >> 6));
    const int G = gridDim.x, bid = blockIdx.x;
    const int NGW = G * 8;
    unsigned* ctl0 = (unsigned*)(p.ws + WS_CTL);
#define PHASE_PTRS \
    int tid = wave0 * 64 + (int)__builtin_amdgcn_mbcnt_hi(~0u, __builtin_amdgcn_mbcnt_lo(~0u, 0u)); asm volatile("" : "+v"(tid)); const int lane = tid & 63, wave = tid >> 6, gw = bid * 8 + wave; (void)lane; (void)gw; \
    size_t wsz_ = 0; asm volatile("" : "+s"(wsz_)); unsigned char* ws = p.ws + wsz_; \
    unsigned* ctl = (unsigned*)(ws + WS_CTL); (void)ctl; \
    float* MOD = (float*)(ws + WS_MOD); (void)MOD; \
    int* TOKE = (int*)(ws + WS_TOKE); int* TOKP = (int*)(ws + WS_TOKP); float* TOKG = (float*)(ws + WS_TOKG); (void)TOKE; (void)TOKP; (void)TOKG; \
    float* RINV = (float*)(ws + WS_RINV); (void)RINV; unsigned char* tabs = ws + WS_TAB; (void)tabs; \
    xr_t* XR = (xr_t*)(ws + WS_XR); (void)XR; \
    act_t* H = (act_t*)(ws + WS_H); (void)H; \
    unsigned char* big = ws + WS_BIG; \
    act_t* PRJ = (act_t*)(big + OFF_PRJ); act_t* QB = (act_t*)(big + OFF_QB); act_t* KVB = (act_t*)(big + OFF_KVB); act_t* OB = (act_t*)(big + OFF_O); (void)PRJ; (void)QB; (void)KVB; (void)OB; \
    act_t* Y = (act_t*)big; act_t* ACT = (act_t*)(ws + WS_ACT); act_t* XS = (act_t*)(ws + WS_XS); unsigned char* wts = ws + WS_W; (void)Y; (void)ACT; (void)XS; (void)wts;

    if (threadIdx.x < 32) misc[threadIdx.x] = 0u;
    __syncthreads();
    XcdBarrier bar = xcd_barrier_post(ctl0 + CW_BAR, (volatile LAS unsigned*)(misc + 8), wave0);
    const int lo = p.ph_lo, hi = p.ph_hi;
#ifndef PHASE_MASK
#define PHASE_MASK 0x1FFFFFu
#endif
#define IN(k) ((((PHASE_MASK) >> (k)) & 1u) && lo <= (k) && (k) < hi)
#define SEAM(k) do { if (IN(k) && IN((k) + 1)) xcd_barrier(bar, wave0); } while (0)
#define LDSB ((LAS unsigned char*)lds_raw)

    if (IN(0)) { PHASE_PTRS
        {   LAS float* scr = (LAS float*)(LDSB + wave * 16640);
            constexpr int I_AB = 16 * 45  , I_QB = 6 * 12, I_KVB = 4 * 16, I_ABO = 16 * 16, I_C = 16 * 24, I_CO = 16 * 16, I_W1 = 16 * 32, I_W2 = 16 * 16;
            constexpr int T_W1 = 64 * I_W1, T_W2 = 64 * I_W2, T_ALL = T_W1 + T_W2 + I_AB + I_QB + I_KVB + I_ABO + I_C + I_CO;
            for (int it = gw; it < T_ALL; it += NGW) {
                int r = it;
                if (r < T_W1) { const int mi = r / I_W1; const float* src = p.moe_w_in + (size_t)mi * 1024 * 2048;
                    if ((mi >= 32 && MOE_F8_L1) || (mi < 32 && MOE_F8_L0)) transpose_item64<true>(src, 1024, 2048, (unsigned char*)(wts + WO_W1) + (size_t)(mi >> 5) * 32 * 2048 * 1024 * 2 + (size_t)(mi & 31) * 2048 * 1024, scr, r % I_W1, lane);
                    else transpose_item64<false>(src, 1024, 2048, (bf16_t*)(wts + WO_W1) + (size_t)mi * 2048 * 1024, scr, r % I_W1, lane);
                    continue; } r -= T_W1;
                if (r < T_W2) { const int mi = r / I_W2; const float* src = p.moe_w_out + (size_t)mi * 1024 * 1024;
                    if (MOE_F8_DOWN && ((mi >= 32 && MOE_F8_L1) || (mi < 32 && MOE_F8_L0))) transpose_item64<true>(src, 1024, 1024, (unsigned char*)(wts + WO_W2) + (size_t)(mi >> 5) * 32 * 1024 * 1024 * 2 + (size_t)(mi & 31) * 1024 * 1024, scr, r % I_W2, lane);
                    else transpose_item64<false>(src, 1024, 1024, (bf16_t*)(wts + WO_W2) + (size_t)mi * 1024 * 1024, scr, r % I_W2, lane);
                    continue; } r -= T_W2;
                if (r < I_AB) { if (INPROJ_F8) transpose_item_f8(p.ab_w_in, 1024, AB_IN, (unsigned char*)(wts + WO_AB), scr, r, lane, 0.125f, 512);
                    else transpose_item(p.ab_w_in, 1024, AB_IN, (bf16_t*)(wts + WO_AB), scr, r, lane, nullptr, 0.125f, 512); continue; } r -= I_AB;
                if (r < I_QB) { transpose_item64<false>(p.mla_wq_b, 384, 768, (bf16_t*)(wts + WO_QB), scr, r, lane, p.mla_q_g, 0.10206207261596575f); continue; } r -= I_QB;
                if (r < I_KVB) { transpose_item64<false>(p.mla_wkv_b, 256, 1024, (bf16_t*)(wts + WO_KVB), scr, r, lane, p.mla_kv_g, 1.0f); continue; } r -= I_KVB;
                if (r < I_ABO) { if (OUTPROJ_F8) transpose_item64<true>(p.ab_w_out, 1024, 1024, (unsigned char*)(wts + WO_ABO), scr, r, lane); else transpose_item64<false>(p.ab_w_out, 1024, 1024, (bf16_t*)(wts + WO_ABO), scr, r, lane); continue; } r -= I_ABO;
                if (r < I_C) { if (INPROJ_F8) transpose_item64<true>(p.c_w_in, 1024, C_IN, (unsigned char*)(wts + WO_C), scr, r, lane); else transpose_item64<false>(p.c_w_in, 1024, C_IN, (bf16_t*)(wts + WO_C), scr, r, lane); continue; } r -= I_C;
                if (OUTPROJ_F8) transpose_item64<true>(p.c_w_out, 1024, 1024, (unsigned char*)(wts + WO_CO), scr, r, lane); else transpose_item64<false>(p.c_w_out, 1024, 1024, (bf16_t*)(wts + WO_CO), scr, r, lane);
            }
            uint4* z = (uint4*)((unsigned char*)(wts + WO_AB) + (size_t)AB_IN * 1024 * (INPROJ_F8 ? 1 : 2));
            for (int i = gw * 64 + lane; i < 96 * 1024 * (INPROJ_F8 ? 1 : 2) / 16; i += NGW * 64) z[i] = make_uint4(0u, 0u, 0u, 0u);
        }
        {
            float2* TA = (float2*)(tabs + TAB_A); float2* TB = (float2*)(tabs + TAB_B); float2* TC = (float2*)(tabs + TAB_C);
            for (int e = bid * NTHR + tid; e < SEQ * 112; e += G * NTHR) { const int s = e / 112, i = e % 112, prow = s / GRIDW, pcol = s % GRIDW;
                int quarter, ii; float2* dst;
                if (i < 32) { quarter = 16; ii = i; dst = TA + s * 32 + ii; } else if (i < 48) { quarter = 8; ii = i - 32; dst = TB + s * 16 + ii; } else { quarter = 32; ii = i - 48; dst = TC + s * 64 + ii; }
                const float ang = rope_angle(ii, quarter, prow, pcol); *dst = make_float2(cosf(ang), sinf(ang)); }
            if (bid == 0 && tid < 128) ((float*)(tabs + TAB_QG))[tid] = p.c_q_g[tid] * 0.08838834764831845f;
        }
        __syncthreads();
        float* ca = ldsf;
        float* red = ldsf + 17 * 1024;
        {   float cv[34];
#pragma unroll
            for (int j = 0; j < 34; ++j) cv[j] = j < 2 * NB ? p.c[j * NTHR + tid] : p.c_ctx[(j - 2 * NB) * NTHR + tid];
#pragma unroll
            for (int j = 0; j < 34; ++j) ca[j * NTHR + tid] = cv[j] / (1.f + expf(-cv[j])); }
        __syncthreads();
        for (int blk = bid; blk < 2 * 6144 / 64; blk += G) {
            typedef float f4m_ __attribute__((ext_vector_type(4)));
            const int l = blk / 96, ks = wave, kr = lane >> 4, c4 = (lane & 15) * 4;
            f4m_ acc[17];
#pragma unroll
            for (int b = 0; b < 17; ++b) acc[b] = (f4m_){0.f, 0.f, 0.f, 0.f};
            const float* wp = p.ada_w + (size_t)l * 1024 * 6144 + (blk % 96) * 64 + c4 + (size_t)(ks * 128 + kr) * 6144;
            const float* cap = ca + ks * 128 + kr;
#pragma unroll 1
            for (int g4 = 0; g4 < 8; ++g4) {
                f4m_ w[4];
#pragma unroll
                for (int j = 0; j < 4; ++j) w[j] = __builtin_nontemporal_load((const f4m_*)(wp + (size_t)((g4 * 4 + j) * 4) * 6144));
#pragma unroll
                for (int j = 0; j < 4; ++j) {
#pragma unroll
                    for (int b = 0; b < 17; ++b) acc[b] += cap[b * 1024 + (g4 * 4 + j) * 4] * w[j]; }
            }
#pragma unroll
            for (int b = 0; b < 17; ++b) {
#pragma unroll
                for (int c = 0; c < 4; ++c) { float v = acc[b][c]; v += __shfl_xor(v, 16); v += __shfl_xor(v, 32); acc[b][c] = v; } }
            if (lane < 16) {
#pragma unroll
                for (int b = 0; b < 17; ++b) *(f4m_*)(red + (ks * 17 + b) * 64 + c4) = acc[b]; }
            __syncthreads();
            for (int i = tid; i < 17 * 64; i += NTHR) { const int b = i >> 6, nl = i & 63; float s = 0.f;
#pragma unroll
                for (int k2 = 0; k2 < 8; ++k2) s += red[(k2 * 17 + b) * 64 + nl];
                const int nn = (blk % 96) * 64 + nl; float mv = s + p.ada_b[l * 6144 + nn];
                if (nn >= 4096 && nn < 5120) mv = p.norm_ffn_g[l * 1024 + nn - 4096] * (1.0f + mv);
                MOD[((size_t)l * 17 + b) * 6144 + nn] = mv; }
            __syncthreads();
        }
    }
    SEAM(0);

#define NORM_MOD16(v, g, mr_) do { float ss_ = 0.f; \
        _Pragma("unroll") for (int j = 0; j < 16; ++j) ss_ = fmaf(v[j], v[j], ss_); \
        ss_ = wave_sum(ss_); const float ri_ = 1.0f / sqrtf(ss_ * (1.0f / 1024.0f) + RMS_EPS); \
        float sh_[16], sc_[16]; ld16f((mr_), sh_); ld16f((mr_) + 1024, sc_); \
        _Pragma("unroll") for (int j = 0; j < 16; ++j) v[j] = (v[j] * ri_ * g[j]) * (1.0f + sc_[j]) + sh_[j]; } while (0)

#define NORM_MOD16x2(v, g, mr0_, mr1_) do { float s0_ = 0.f, s1_ = 0.f; \
        _Pragma("unroll") for (int j = 0; j < 16; ++j) { s0_ = fmaf(v[0][j], v[0][j], s0_); s1_ = fmaf(v[1][j], v[1][j], s1_); } \
        wave_sum2(s0_, s1_); const float ri0_ = 1.0f / sqrtf(s0_ * (1.0f / 1024.0f) + RMS_EPS), ri1_ = 1.0f / sqrtf(s1_ * (1.0f / 1024.0f) + RMS_EPS); \
        float sh_[16], sc_[16]; ld16f((mr0_), sh_); ld16f((mr0_) + 1024, sc_); \
        _Pragma("unroll") for (int j = 0; j < 16; ++j) v[0][j] = (v[0][j] * ri0_ * g[j]) * (1.0f + sc_[j]) + sh_[j]; \
        ld16f((mr1_), sh_); ld16f((mr1_) + 1024, sc_); \
        _Pragma("unroll") for (int j = 0; j < 16; ++j) v[1][j] = (v[1][j] * ri1_ * g[j]) * (1.0f + sc_[j]) + sh_[j]; } while (0)
#define ROWS2(nrows) _Pragma("unroll 1") for (int r0_ = gw; r0_ < (nrows); r0_ += 2 * NGW)
#define ROWS2_IDX(nrows) const bool two_ = (r0_ + NGW) < (nrows); const int rr_[2] = {r0_, two_ ? r0_ + NGW : r0_};

    if (IN(1)) { PHASE_PTRS
        float g[16]; ld16f(p.norm_mix_g + 16 * lane, g);
        ROWS2(NROW) { ROWS2_IDX(NROW)
            float v[2][16]; const float* mr[2];
#pragma unroll
            for (int u = 0; u < 2; ++u) { const int r = rr_[u]; const float* src = r < NLAT ? p.x + (size_t)r * 1024 : p.ctx + (size_t)(r - NLAT) * 1024;
                mr[u] = MOD + (size_t)(0 * 17 + mod_row_of(r)) * 6144 + 16 * lane; ld16f(src + 16 * lane, v[u]); }
            NORM_MOD16x2(v, g, mr[0], mr[1]);
            if (INPROJ_F8) { st16f8((unsigned char*)H + (size_t)rr_[0] * 1024 + 16 * lane, v[0]); if (two_) st16f8((unsigned char*)H + (size_t)rr_[1] * 1024 + 16 * lane, v[1]); }
            else { st16bf(H + (size_t)rr_[0] * 1024 + 16 * lane, v[0]); if (two_) st16bf(H + (size_t)rr_[1] * 1024 + 16 * lane, v[1]); }
        }
    }
    SEAM(1);

    if (IN(2)) { PHASE_PTRS
        constexpr size_t ES_ = INPROJ_F8 ? 1 : 2;
        pg8::DenseOrder S{(const char*)H, (const char*)(wts + WO_AB), NROW / 256, 6, G, bid, (size_t)256 * 1024 * ES_, (size_t)256 * 1024 * ES_};
        pg8::EpiStoreBf16 E{PRJ, PRJ_LD, INPROJ_F8 ? 0.03125f : 1.0f};
        pg8::gemm_phase<pg8::EpiStoreBf16, pg8::DenseOrder, true, true, INPROJ_F8 != 0>(tid, LDSB, 1024, 1024, S, E);
    }
    SEAM(2);

    if (IN(3)) { PHASE_PTRS
        const float2* TA = (const float2*)(tabs + TAB_A); const float2* TB = (const float2*)(tabs + TAB_B);
        for (int r = gw; r < NROW; r += NGW) {
            bf16_t* pr = PRJ + (size_t)r * PRJ_LD;
            if (r < NLAT) { const int s = r % SEQ;
                { bf16_t* kp = pr + 512 + (lane >> 5) * 64 + (lane & 31); const float x1 = bf2f(kp[0]), x2 = bf2f(kp[32]); const float2 t = TA[s * 32 + (lane & 31)];
                  kp[0] = f2bf(x1 * t.x - x2 * t.y); kp[32] = f2bf(x2 * t.x + x1 * t.y); }
                if (lane < 16) { bf16_t* rp = pr + 1408 + lane; const float x1 = bf2f(rp[0]), x2 = bf2f(rp[16]); const float2 t = TB[s * 16 + lane];
                  rp[0] = f2bf(x1 * t.x - x2 * t.y); rp[16] = f2bf(x2 * t.x + x1 * t.y); } }
            float s1 = 0.f, s2 = 0.f;
#pragma unroll
            for (int j = 0; j < 6; ++j) { const float xq = bf2f(pr[768 + lane + 64 * j]); s1 = fmaf(xq, xq, s1); }
#pragma unroll
            for (int j = 0; j < 4; ++j) { const float xk = bf2f(pr[1152 + lane + 64 * j]); s2 = fmaf(xk, xk, s2); }
            s1 = wave_sum(s1); s2 = wave_sum(s2);
            if (lane == 0) { RINV[2 * r] = 1.0f / sqrtf(s1 * (1.0f / 384.0f) + RMS_EPS); RINV[2 * r + 1] = 1.0f / sqrtf(s2 * (1.0f / 256.0f) + RMS_EPS); }
        }
    }
    SEAM(3);

    if (IN(4)) { PHASE_PTRS
        { pg8::DenseOrder S{(const char*)(PRJ + 768), (const char*)(wts + WO_QB), NROW / 256, 3, G, bid, (size_t)256 * PRJ_LD * 2, (size_t)256 * 384 * 2};
          pg8::EpiScaleBf16 E{QB, 768, RINV};
          pg8::gemm_phase<pg8::EpiScaleBf16, pg8::DenseOrder, true, true>(tid, LDSB, 384, PRJ_LD, S, E); }
        __syncthreads();
        { pg8::DenseOrder S{(const char*)(PRJ + 1152), (const char*)(wts + WO_KVB), NROW / 256, 4, G, bid, (size_t)256 * PRJ_LD * 2, (size_t)256 * 256 * 2};
          pg8::EpiScaleBf16 E{KVB, 1024, RINV + 1};
          pg8::gemm_phase<pg8::EpiScaleBf16, pg8::DenseOrder, true, true>(tid, LDSB, 256, PRJ_LD, S, E); }
    }
    SEAM(4);

    if (IN(5)) { PHASE_PTRS
        for (int i = 0;; ++i) { const int u = i * G + bid; if (u >= 1152) break;
            const bool isctx = u >= 1024; int b, h, qb;
            if (!isctx) { const int rest = u >> 3; b = 2 * (u & 7) + (rest >> 6); h = (rest & 63) >> 3; qb = rest & 7; } else { b = (u - 1024) >> 3; h = u & 7; qb = 0; }
            const int qrow0 = isctx ? NLAT + b * NCX : b * SEQ + qb * 256;
            fa::Unit U; U.Q = QB + (size_t)qrow0 * 768 + h * 96; U.K = KVB + h * 128; U.K2 = PRJ + 1408; U.V = KVB + h * 128 + 64;
            U.O = OUTPROJ_F8 ? (bf16_t*)((unsigned char*)OB + (size_t)qrow0 * 1024 + 512 + h * 64) : OB + (size_t)qrow0 * 1024 + 512 + h * 64; U.rowa = NLAT + b * NCX; U.nta = 4; U.rowb = b * SEQ; U.ntb = isctx ? 0 : 32;
            U.window = 0; U.qpos0 = 0; U.kposb0 = 0; U.sink = 0.f; U.has_sink = 0; U.tab = isctx ? nullptr : (const float*)(tabs + TAB_B); U.pos0 = qb * 256; U.qg = nullptr;
            fa::attn_unit<96, 64, 768, 1024, 1024, 1024, false, 4, 1, false, true, OUTPROJ_F8 != 0>(tid, U, (char*)lds_raw); }
        for (int i = 0;; ++i) { const int u = i * G + bid; if (u >= 1152) break;
            const bool isctx = u >= 1024; int b, h, qb;
            if (!isctx) { const int rest = u >> 3; b = 2 * (u & 7) + (rest >> 6); h = (rest & 63) >> 3; qb = rest & 7; } else { b = (u - 1024) >> 3; h = u & 7; qb = 0; }
            const int qrow0 = isctx ? NLAT + b * NCX : b * SEQ + qb * 256;
            const int ks = isctx ? 0 : max(0, qb * 256 - 128), ke = isctx ? 0 : min(SEQ, qb * 256 + 384);
            fa::Unit U; U.Q = PRJ + (size_t)qrow0 * PRJ_LD + h * 64; U.K = PRJ + 512 + (h >> 2) * 64; U.K2 = nullptr; U.V = PRJ + 640 + (h >> 2) * 64;
            U.O = OUTPROJ_F8 ? (bf16_t*)((unsigned char*)OB + (size_t)qrow0 * 1024 + h * 64) : OB + (size_t)qrow0 * 1024 + h * 64; U.rowa = NLAT + b * NCX; U.nta = 4; U.rowb = b * SEQ + ks; U.ntb = (ke - ks) / 64;
            U.window = isctx ? 0 : 1; U.qpos0 = qb * 256; U.kposb0 = ks; U.sink = p.swa_sink[h]; U.has_sink = 1; U.tab = isctx ? nullptr : (const float*)(tabs + TAB_A); U.pos0 = qb * 256; U.qg = nullptr;
            fa::attn_unit<64, 64, PRJ_LD, PRJ_LD, PRJ_LD, 1024, true, 0, 2, false, false, OUTPROJ_F8 != 0>(tid, U, (char*)lds_raw); }
    }
    SEAM(5);

    if (IN(6)) { PHASE_PTRS
        constexpr size_t ES_ = OUTPROJ_F8 ? 1 : 2;
        pg8::DenseOrder S{(const char*)OB, (const char*)(wts + WO_ABO), NROW / 256, 4, G, bid, (size_t)256 * 1024 * ES_, (size_t)256 * 1024 * ES_};
        pg8::EpiResidT<float, xr_t> E{p.x, p.ctx, XR, MOD + 2048, OUTPROJ_F8 ? 0.03125f : 1.0f};
        pg8::gemm_phase<pg8::EpiResidT<float, xr_t>, pg8::DenseOrder, true, true, OUTPROJ_F8 != 0>(tid, LDSB, 1024, 1024, S, E);
    }
    SEAM(6);

    typedef float f4a_ __attribute__((ext_vector_type(4)));
#define GLD4(dst, ptr, off) asm volatile("global_load_dwordx4 %0, %1, off offset:" #off : "=v"(dst) : "v"(ptr) : "memory")
#if XR16
#define XR_LOADS(xp_) GLD4(xn0_, xp_, 0); GLD4(xn1_, xp_, 16); GLD4(xn2_, xp_, 32); GLD4(xn3_, xp_, 48); xn4_ = xn0_; xn5_ = xn0_; xn6_ = xn0_; xn7_ = xn0_
#define XR_WAIT_MOD "s_waitcnt vmcnt(4)"
#define XR_UNPACK(v) _Pragma("unroll") for (int q = 0; q < 4; ++q) { const unsigned w0_ = __float_as_uint(xn0_[q]), w1_ = __float_as_uint(xn1_[q]), w2_ = __float_as_uint(xn2_[q]), w3_ = __float_as_uint(xn3_[q]); \
        v[0][2 * q] = __uint_as_float(w0_ << 16); v[0][2 * q + 1] = __uint_as_float(w0_ & 0xffff0000u); v[0][8 + 2 * q] = __uint_as_float(w1_ << 16); v[0][9 + 2 * q] = __uint_as_float(w1_ & 0xffff0000u); \
        v[1][2 * q] = __uint_as_float(w2_ << 16); v[1][2 * q + 1] = __uint_as_float(w2_ & 0xffff0000u); v[1][8 + 2 * q] = __uint_as_float(w3_ << 16); v[1][9 + 2 * q] = __uint_as_float(w3_ & 0xffff0000u); }
#else
#define XR_LOADS(xp_) GLD4(xn0_, xp_, 0); GLD4(xn1_, xp_, 16); GLD4(xn2_, xp_, 32); GLD4(xn3_, xp_, 48); GLD4(xn4_, xp_, 64); GLD4(xn5_, xp_, 80); GLD4(xn6_, xp_, 96); GLD4(xn7_, xp_, 112)
#define XR_WAIT_MOD "s_waitcnt vmcnt(8)"
#define XR_UNPACK(v) _Pragma("unroll") for (int q = 0; q < 4; ++q) { v[0][q] = xn0_[q]; v[0][4 + q] = xn1_[q]; v[0][8 + q] = xn2_[q]; v[0][12 + q] = xn3_[q]; v[1][q] = xn4_[q]; v[1][4 + q] = xn5_[q]; v[1][8 + q] = xn6_[q]; v[1][12 + q] = xn7_[q]; }
#endif
#define ROUTER_PHASE(L, nrows) do { \
        static_assert(XR16, "the two-rows-per-wave router reads the residual stream as bf16"); \
        { const float4* wsrc_ = (const float4*)(p.router_w + (size_t)(L) * 1024 * 32); float4* wl_ = (float4*)lds_raw; \
          for (int q = tid; q < 8192; q += NTHR) { const int c_ = q >> 3, e4_ = q & 7; wl_[(c_ ^ ((c_ >> 7) & 1)) * 8 + (e4_ ^ ((c_ >> 4) & 7))] = wsrc_[q]; } }        \
        __syncthreads(); \
        unsigned* cnt_ = ctl + CW_CNT + (L) * 32; \
        LAS unsigned* lcnt_ = (LAS unsigned*)(LDSB + LDS_MISC + 1024); LAS unsigned* lbase_ = lcnt_ + 32;       \
        if (tid < 32) lcnt_[tid] = 0u; \
        __syncthreads(); \
        const int half_ = lane >> 5, l5_ = lane & 31;                        \
        const float rb_ = p.router_b[(L) * 32 + l5_]; \
        const float4* wl_ = (const float4*)lds_raw + (size_t)(16 * lane) * 8; const int sw_ = lane & 7; \
        LAS unsigned* stash_ = (LAS unsigned*)(LDSB + 131072) + wave * 384;        \
        int it_ = 0; \
          \
        f4a_ xn0_, xn1_, xn2_, xn3_;                                         \
        { const int r = gw * 2 < (nrows) ? gw * 2 : 0; const xr_t* xp_ = XR + (size_t)r * 1024 + 16 * lane; GLD4(xn0_, xp_, 0); GLD4(xn1_, xp_, 16); GLD4(xn2_, xp_, 2048); GLD4(xn3_, xp_, 2064); } \
        for (int rp = gw; rp * 2 < (nrows); rp += NGW, ++it_) { const int r0 = rp * 2, r = r0 + half_; \
            const float* mr = MOD + (size_t)((L) * 17 + mod_row_of(r0)) * 6144 + 3072 + 16 * lane; const float* mr2 = mr + 1024; \
            asm volatile("s_waitcnt vmcnt(0)" : "+v"(xn0_), "+v"(xn1_), "+v"(xn2_), "+v"(xn3_) :: "memory"); \
            float v[2][16]; \
            _Pragma("unroll") for (int q = 0; q < 4; ++q) { const unsigned w0_ = __float_as_uint(xn0_[q]), w1_ = __float_as_uint(xn1_[q]), w2_ = __float_as_uint(xn2_[q]), w3_ = __float_as_uint(xn3_[q]); \
                v[0][2 * q] = __uint_as_float(w0_ << 16); v[0][2 * q + 1] = __uint_as_float(w0_ & 0xffff0000u); v[0][8 + 2 * q] = __uint_as_float(w1_ << 16); v[0][9 + 2 * q] = __uint_as_float(w1_ & 0xffff0000u); \
                v[1][2 * q] = __uint_as_float(w2_ << 16); v[1][2 * q + 1] = __uint_as_float(w2_ & 0xffff0000u); v[1][8 + 2 * q] = __uint_as_float(w3_ << 16); v[1][9 + 2 * q] = __uint_as_float(w3_ & 0xffff0000u); } \
            f4a_ sh0_, sh1_, sh2_, sh3_, sc0_, sc1_, sc2_, sc3_; \
            GLD4(sh0_, mr, 0); GLD4(sh1_, mr, 16); GLD4(sh2_, mr, 32); GLD4(sh3_, mr, 48); GLD4(sc0_, mr2, 0); GLD4(sc1_, mr2, 16); GLD4(sc2_, mr2, 32); GLD4(sc3_, mr2, 48); \
            { const int rn_ = (rp + NGW) * 2 < (nrows) ? (rp + NGW) * 2 : r0; const xr_t* xp_ = XR + (size_t)rn_ * 1024 + 16 * lane; GLD4(xn0_, xp_, 0); GLD4(xn1_, xp_, 16); GLD4(xn2_, xp_, 2048); GLD4(xn3_, xp_, 2064); }        \
            asm volatile("s_waitcnt vmcnt(4)" : "+v"(sh0_), "+v"(sh1_), "+v"(sh2_), "+v"(sh3_), "+v"(sc0_), "+v"(sc1_), "+v"(sc2_), "+v"(sc3_) :: "memory"); \
            float sh_[16], sc_[16]; \
            _Pragma("unroll") for (int q = 0; q < 4; ++q) { sh_[q] = sh0_[q]; sh_[4 + q] = sh1_[q]; sh_[8 + q] = sh2_[q]; sh_[12 + q] = sh3_[q]; sc_[q] = sc0_[q]; sc_[4 + q] = sc1_[q]; sc_[8 + q] = sc2_[q]; sc_[12 + q] = sc3_[q]; } \
            float ss0_ = 0.f, ss1_ = 0.f; \
            _Pragma("unroll") for (int j = 0; j < 16; ++j) { ss0_ = fmaf(v[0][j], v[0][j], ss0_); ss1_ = fmaf(v[1][j], v[1][j], ss1_); } \
            ss0_ = half_sum32(ss0_); ss1_ = half_sum32(ss1_); \
            { const u32x2_t q0_ = __builtin_amdgcn_permlane32_swap(__float_as_uint(ss0_), __float_as_uint(ss0_), false, false); ss0_ = __uint_as_float(q0_[0]) + __uint_as_float(q0_[1]); \
              const u32x2_t q1_ = __builtin_amdgcn_permlane32_swap(__float_as_uint(ss1_), __float_as_uint(ss1_), false, false); ss1_ = __uint_as_float(q1_[0]) + __uint_as_float(q1_[1]); } \
            const float ri0_ = 1.0f / sqrtf(ss0_ * (1.0f / 1024.0f) + RMS_EPS), ri1_ = 1.0f / sqrtf(ss1_ * (1.0f / 1024.0f) + RMS_EPS); \
            _Pragma("unroll") for (int j = 0; j < 16; ++j) { v[0][j] = (v[0][j] * ri0_) * sc_[j] + sh_[j]; v[1][j] = (v[1][j] * ri1_) * sc_[j] + sh_[j]; }        \
            st16f8((unsigned char*)H + (size_t)r0 * 1024 + 16 * lane, v[0]); st16f8((unsigned char*)H + (size_t)(r0 + 1) * 1024 + 16 * lane, v[1]);        \
            if (lane & 8) { _Pragma("unroll") for (int hh = 0; hh < 2; ++hh) _Pragma("unroll") for (int j = 0; j < 16; j += 2) { const float t_ = v[hh][j]; v[hh][j] = v[hh][j + 1]; v[hh][j + 1] = t_; } }        \
            float acc0[32], acc1[32]; \
            _Pragma("unroll") for (int e = 0; e < 32; ++e) { acc0[e] = 0.f; acc1[e] = 0.f; } \
            _Pragma("unroll") for (int j = 0; j < 16; ++j) { \
                _Pragma("unroll") for (int e4 = 0; e4 < 8; ++e4) { const float4 w = wl_[j * 8 + (e4 ^ sw_)]; \
                    acc0[4 * e4] = fmaf(v[0][j], w.x, acc0[4 * e4]); acc0[4 * e4 + 1] = fmaf(v[0][j], w.y, acc0[4 * e4 + 1]); acc0[4 * e4 + 2] = fmaf(v[0][j], w.z, acc0[4 * e4 + 2]); acc0[4 * e4 + 3] = fmaf(v[0][j], w.w, acc0[4 * e4 + 3]); \
                    acc1[4 * e4] = fmaf(v[1][j], w.x, acc1[4 * e4]); acc1[4 * e4 + 1] = fmaf(v[1][j], w.y, acc1[4 * e4 + 1]); acc1[4 * e4 + 2] = fmaf(v[1][j], w.z, acc1[4 * e4 + 2]); acc1[4 * e4 + 3] = fmaf(v[1][j], w.w, acc1[4 * e4 + 3]); } } \
            float acc[32];                                                   \
            _Pragma("unroll") for (int e = 0; e < 32; ++e) { const u32x2_t q_ = __builtin_amdgcn_permlane32_swap(__float_as_uint(acc0[e]), __float_as_uint(acc1[e]), false, false); acc[e] = __uint_as_float(q_[0]) + __uint_as_float(q_[1]); } \
            float tv[4]; int ti[4]; route_reduce32(acc, l5_, rb_, tv, ti); \
            const float e1 = expf(tv[1] - tv[0]), e2 = expf(tv[2] - tv[0]), e3 = expf(tv[3] - tv[0]); const float inv = 1.0f / (1.0f + e1 + e2 + e3); \
            if (l5_ < 4) { const int ek = l5_ == 0 ? ti[0] : l5_ == 1 ? ti[1] : l5_ == 2 ? ti[2] : ti[3]; const float gk = (l5_ == 0 ? 1.0f : l5_ == 1 ? e1 : l5_ == 2 ? e2 : e3) * inv; \
                const unsigned pos = __hip_atomic_fetch_add(lcnt_ + ek, 1u, __ATOMIC_RELAXED, __HIP_MEMORY_SCOPE_WORKGROUP); TOKE[r * 4 + l5_] = ek; TOKG[r * 4 + l5_] = gk; \
                stash_[it_ * 8 + half_ * 4 + l5_] = (unsigned)ek | (pos << 8); } \
        } \
        asm volatile("s_waitcnt vmcnt(0)" : "+v"(xn0_), "+v"(xn1_), "+v"(xn2_), "+v"(xn3_) :: "memory");        \
        __syncthreads(); \
        if (tid < 32) lbase_[tid] = atomicAdd(cnt_ + tid, lcnt_[tid]); \
        __syncthreads(); \
        for (int e_ = lane; e_ < it_ * 8; e_ += 64) { const unsigned w_ = stash_[e_]; const int r = (gw + (e_ >> 3) * NGW) * 2 + ((e_ >> 2) & 1); TOKP[r * 4 + (e_ & 3)] = (int)((w_ >> 8) + lbase_[w_ & 255u]); } \
    } while (0)

#define EXCL_SETUP(L) \
        const int c_ = lane < 32 ? (int)ctl[CW_CNT + (L) * 32 + lane] : 0; const int padc_ = (c_ + 255) / 256 * 256; int pre_ = padc_; \
        _Pragma("unroll") for (int o_ = 1; o_ < 32; o_ <<= 1) { const int t_ = __shfl_up(pre_, o_); if ((lane & 31) >= o_) pre_ += t_; } \
        const int excl_ = pre_ - padc_;
#define PERMUTE_PHASE(L, nrows) do { EXCL_SETUP(L) \
        ROWS2(nrows) { ROWS2_IDX(nrows) \
            const int ra_ = rr_[0], rb_ = rr_[1]; \
            const uint4* sa_ = (const uint4*)(H + (size_t)ra_ * 1024) + lane * 2; const uint4* sb_ = (const uint4*)(H + (size_t)rb_ * 1024) + lane * 2; \
            const uint4 a0_ = sa_[0], a1_ = sa_[1], b0_ = sb_[0], b1_ = sb_[1]; \
            const int4 ea_ = *(const int4*)(TOKE + ra_ * 4), pa_ = *(const int4*)(TOKP + ra_ * 4), eb_ = *(const int4*)(TOKE + rb_ * 4), pb_ = *(const int4*)(TOKP + rb_ * 4); \
            const int sa0 = __shfl(excl_, ea_.x) + pa_.x, sa1 = __shfl(excl_, ea_.y) + pa_.y, sa2 = __shfl(excl_, ea_.z) + pa_.z, sa3 = __shfl(excl_, ea_.w) + pa_.w; \
            const int sb0 = __shfl(excl_, eb_.x) + pb_.x, sb1 = __shfl(excl_, eb_.y) + pb_.y, sb2 = __shfl(excl_, eb_.z) + pb_.z, sb3 = __shfl(excl_, eb_.w) + pb_.w; \
            { uint4* d_ = (uint4*)(XS + (size_t)sa0 * 1024) + lane * 2; d_[0] = a0_; d_[1] = a1_; } { uint4* d_ = (uint4*)(XS + (size_t)sa1 * 1024) + lane * 2; d_[0] = a0_; d_[1] = a1_; } \
            { uint4* d_ = (uint4*)(XS + (size_t)sa2 * 1024) + lane * 2; d_[0] = a0_; d_[1] = a1_; } { uint4* d_ = (uint4*)(XS + (size_t)sa3 * 1024) + lane * 2; d_[0] = a0_; d_[1] = a1_; } \
            if (two_) { \
            { uint4* d_ = (uint4*)(XS + (size_t)sb0 * 1024) + lane * 2; d_[0] = b0_; d_[1] = b1_; } { uint4* d_ = (uint4*)(XS + (size_t)sb1 * 1024) + lane * 2; d_[0] = b0_; d_[1] = b1_; } \
            { uint4* d_ = (uint4*)(XS + (size_t)sb2 * 1024) + lane * 2; d_[0] = b0_; d_[1] = b1_; } { uint4* d_ = (uint4*)(XS + (size_t)sb3 * 1024) + lane * 2; d_[0] = b0_; d_[1] = b1_; } } } \
        for (int e = 0; e < 32; ++e) { const int ce = __shfl(c_, e), be = __shfl(excl_, e), pe = __shfl(padc_, e); \
            for (int rr = ce + gw; rr < pe; rr += NGW) { uint4* d_ = (uint4*)(XS + (size_t)(be + rr) * 1024) + lane * 2; d_[0] = make_uint4(0u, 0u, 0u, 0u); d_[1] = make_uint4(0u, 0u, 0u, 0u); } } \
    } while (0)
#define PERMUTE_PHASE_F8(L, nrows) do { EXCL_SETUP(L) \
        unsigned char* XS8 = (unsigned char*)XS; \
        for (int r = gw; r < (nrows); r += NGW) { \
            const int4 ov_ = *((const int4*)((const unsigned char*)H + (size_t)r * 1024) + lane); \
            _Pragma("unroll") for (int k = 0; k < 4; ++k) { const int ek = TOKE[r * 4 + k], pk = TOKP[r * 4 + k]; const int slot = __shfl(excl_, ek) + pk; \
                *((int4*)(XS8 + (size_t)slot * 1024) + lane) = ov_; if (lane == 0) TOKP[r * 4 + k] = slot; } }        \
        for (int e = 0; e < 32; ++e) { const int ce = __shfl(c_, e), be = __shfl(excl_, e), pe = __shfl(padc_, e); \
            for (int rr = ce + gw; rr < pe; rr += NGW) *((int4*)(XS8 + (size_t)(be + rr) * 1024) + lane) = make_int4(0, 0, 0, 0); } \
    } while (0)
#define MOE_TABLE(L) \
        LAS int* tile_e = (LAS int*)(LDSB + LDS_MISC + 1024); LAS int* nm_p = tile_e + 640; \
        LAS int* tpre_ = nm_p + 1;                                       \
        __syncthreads(); \
        if (tid < 64) { const int c_ = lane < 32 ? (int)ctl[CW_CNT + (L) * 32 + lane] : 0; const int n_ = (c_ + 255) / 256; int pre_ = n_; \
            _Pragma("unroll") for (int o_ = 1; o_ < 32; o_ <<= 1) { const int t_ = __shfl_up(pre_, o_); if ((lane & 31) >= o_) pre_ += t_; } \
            if (lane < 32) tpre_[lane] = pre_ - n_; if (lane == 31) { tpre_[32] = pre_; *nm_p = pre_; } } \
        __syncthreads(); \
        const int nM_ = __builtin_amdgcn_readfirstlane(*nm_p); \
        for (int t_ = tid; t_ < nM_; t_ += NTHR) { int e_ = 0; _Pragma("unroll") for (int q_ = 16; q_ >= 1; q_ >>= 1) { if (tpre_[e_ + q_] <= t_) e_ += q_; } tile_e[t_] = e_; }        \
        __syncthreads();
#define MOE_FAST1(L) do { MOE_TABLE(L) \
        pg8::MoeOrder S{(const char*)XS, (const char*)(wts + WO_W1) + (size_t)(L) * 32 * 2048 * 1024 * 2, tile_e, nM_, 8, G, bid, (size_t)256 * 1024 * 2, (size_t)2048 * 1024 * 2}; \
        pg8::EpiSwiglu E{ACT, p.moe_b_in + (size_t)(L) * 32 * 2048, 1.0f}; \
        pg8::gemm_phase<pg8::EpiSwiglu, pg8::MoeOrder, true, true>(tid, LDSB, 1024, 1024, S, E); } while (0)
#define MOE_FAST2(L) do { MOE_TABLE(L) \
        pg8::MoeOrder S{(const char*)ACT, (const char*)(wts + WO_W2) + (size_t)(L) * 32 * 1024 * 1024 * 2, tile_e, nM_, 4, G, bid, (size_t)256 * 1024 * 2, (size_t)1024 * 1024 * 2}; \
        pg8::EpiBiasBf16 E{Y, p.moe_b_out + (size_t)(L) * 32 * 1024, 1.0f}; \
        pg8::gemm_phase<pg8::EpiBiasBf16, pg8::MoeOrder, true, true>(tid, LDSB, 1024, 1024, S, E); } while (0)
#define MOE_FAST1_F8(L) do { MOE_TABLE(L) \
        pg8::MoeOrder S{(const char*)XS, (const char*)(wts + WO_W1) + (size_t)(L) * 32 * 2048 * 1024 * 2, tile_e, nM_, 8, G, bid, (size_t)256 * 1024, (size_t)2048 * 1024}; \
        if constexpr (MOE_F8_DOWN) { pg8::EpiSwigluF8 E{(unsigned char*)ACT, p.moe_b_in + (size_t)(L) * 32 * 2048}; \
            pg8::gemm_phase<pg8::EpiSwigluF8, pg8::MoeOrder, true, true, true>(tid, LDSB, 1024, 1024, S, E); } \
        else { pg8::EpiSwiglu E{ACT, p.moe_b_in + (size_t)(L) * 32 * 2048, 0.03125f}; \
            pg8::gemm_phase<pg8::EpiSwiglu, pg8::MoeOrder, false, true, true>(tid, LDSB, 1024, 1024, S, E); } } while (0)
#define MOE_FAST2_F8(L) do { MOE_TABLE(L) \
        pg8::MoeOrder S{(const char*)ACT, (const char*)(wts + WO_W2) + (size_t)(L) * 32 * 1024 * 1024 * 2, tile_e, nM_, 4, G, bid, (size_t)256 * 1024, (size_t)1024 * 1024}; \
        if constexpr ((Y8_L1 && (L) == 1) || (Y8_L0 && (L) == 0)) { pg8::EpiBiasF8 E{(unsigned char*)Y, p.moe_b_out + (size_t)(L) * 32 * 1024, 0.03125f}; \
            pg8::gemm_phase<pg8::EpiBiasF8, pg8::MoeOrder, true, true, true>(tid, LDSB, 1024, 1024, S, E); } \
        else { pg8::EpiBiasBf16 E{Y, p.moe_b_out + (size_t)(L) * 32 * 1024, 0.03125f}; \
            pg8::gemm_phase<pg8::EpiBiasBf16, pg8::MoeOrder, true, true, true>(tid, LDSB, 1024, 1024, S, E); } } while (0)
#define COMBINE_PRE(nrows) typedef int i4n_ __attribute__((ext_vector_type(4))); typedef float f4n_ __attribute__((ext_vector_type(4))); i4n_ sl0_, sl1_; f4n_ gt0_, gt1_; \
        { const int ra_ = gw < (nrows) ? gw : 0, rb_ = gw + NGW < (nrows) ? gw + NGW : ra_; sl0_ = *(const i4n_*)(TOKP + ra_ * 4); gt0_ = *(const f4n_*)(TOKG + ra_ * 4); sl1_ = *(const i4n_*)(TOKP + rb_ * 4); gt1_ = *(const f4n_*)(TOKG + rb_ * 4); }
#define COMBINE_ROWS2(L, v, nrows, F8Y) do { \
        const int slc_[2][4] = {{sl0_[0], sl0_[1], sl0_[2], sl0_[3]}, {sl1_[0], sl1_[1], sl1_[2], sl1_[3]}}; \
        const float gk_[2][4] = {{gt0_[0], gt0_[1], gt0_[2], gt0_[3]}, {gt1_[0], gt1_[1], gt1_[2], gt1_[3]}}; \
        uint4 ya_[2][4], yb_[2][4]; \
        _Pragma("unroll") for (int u = 0; u < 2; ++u) { const int r = rr_[u]; \
            _Pragma("unroll") for (int k = 0; k < 4; ++k) { \
                if constexpr (F8Y) { ya_[u][k] = *((const uint4*)((const unsigned char*)Y + (size_t)slc_[u][k] * 1024) + lane); yb_[u][k] = ya_[u][k]; } \
                else { const uint4* yr = (const uint4*)(Y + (size_t)slc_[u][k] * 1024 + 16 * lane); ya_[u][k] = yr[0]; yb_[u][k] = yr[1]; } } \
            ld16x(XR + (size_t)r * 1024 + 16 * lane, v[u]); } \
        { const int n0_ = r0_ + 2 * NGW; if (n0_ < (nrows)) { const int n1_ = n0_ + NGW < (nrows) ? n0_ + NGW : n0_; \
            sl0_ = *(const i4n_*)(TOKP + n0_ * 4); gt0_ = *(const f4n_*)(TOKG + n0_ * 4); sl1_ = *(const i4n_*)(TOKP + n1_ * 4); gt1_ = *(const f4n_*)(TOKG + n1_ * 4); } } \
        _Pragma("unroll") for (int u = 0; u < 2; ++u) { float f_[16]; \
            _Pragma("unroll") for (int j = 0; j < 16; ++j) f_[j] = 0.f; \
            _Pragma("unroll") for (int k = 0; k < 4; ++k) { \
                if constexpr (F8Y) { const int yw[4] = {(int)ya_[u][k].x, (int)ya_[u][k].y, (int)ya_[u][k].z, (int)ya_[u][k].w}; \
                    _Pragma("unroll") for (int j = 0; j < 4; ++j) { const auto lo_ = __builtin_amdgcn_cvt_pk_f32_fp8(yw[j], false); const auto hi_ = __builtin_amdgcn_cvt_pk_f32_fp8(yw[j], true); \
                        f_[4 * j] = fmaf(gk_[u][k], lo_[0], f_[4 * j]); f_[4 * j + 1] = fmaf(gk_[u][k], lo_[1], f_[4 * j + 1]); f_[4 * j + 2] = fmaf(gk_[u][k], hi_[0], f_[4 * j + 2]); f_[4 * j + 3] = fmaf(gk_[u][k], hi_[1], f_[4 * j + 3]); } } \
                else { const unsigned yw[8] = {ya_[u][k].x, ya_[u][k].y, ya_[u][k].z, ya_[u][k].w, yb_[u][k].x, yb_[u][k].y, yb_[u][k].z, yb_[u][k].w}; \
                    _Pragma("unroll") for (int j = 0; j < 8; ++j) { f_[2 * j] = fmaf(gk_[u][k], __uint_as_float(yw[j] << 16), f_[2 * j]); f_[2 * j + 1] = fmaf(gk_[u][k], __uint_as_float(yw[j] & 0xffff0000u), f_[2 * j + 1]); } } } \
            float g2v_[16]; ld16f(MOD + (size_t)((L) * 17 + mod_row_of(rr_[u])) * 6144 + 5120 + 16 * lane, g2v_);        \
            _Pragma("unroll") for (int j = 0; j < 16; ++j) v[u][j] = fmaf(g2v_[j], f_[j], v[u][j]); } } while (0)

    if (IN(7)) { PHASE_PTRS ROUTER_PHASE(0, NROW); }
    SEAM(7);
#if MOE_F8_L0
    if (IN(8)) { PHASE_PTRS PERMUTE_PHASE_F8(0, NROW); }
    SEAM(8);
    if (IN(9)) { PHASE_PTRS MOE_FAST1_F8(0); }
    SEAM(9);
#else
    if (IN(8)) { PHASE_PTRS PERMUTE_PHASE(0, NROW); }
    SEAM(8);
    if (IN(9)) { PHASE_PTRS MOE_FAST1(0); }
    SEAM(9);
#endif
    if (IN(10)) { PHASE_PTRS if constexpr (MOE_F8_L0 && MOE_F8_DOWN) { MOE_FAST2_F8(0); } else { MOE_FAST2(0); } }
    SEAM(10);

    if (IN(11)) { PHASE_PTRS
        float g[16]; ld16f(p.norm_mix_g + 1024 + 16 * lane, g);
        COMBINE_PRE(NROW)
        ROWS2(NROW) { ROWS2_IDX(NROW)
            float v[2][16]; COMBINE_ROWS2(0, v, NROW, (Y8_L0 && MOE_F8_L0 && MOE_F8_DOWN));
            st16x(XR + (size_t)rr_[0] * 1024 + 16 * lane, v[0]); if (two_) st16x(XR + (size_t)rr_[1] * 1024 + 16 * lane, v[1]);
            const float* mr0 = MOD + (size_t)(1 * 17 + mod_row_of(rr_[0])) * 6144 + 16 * lane; const float* mr1 = MOD + (size_t)(1 * 17 + mod_row_of(rr_[1])) * 6144 + 16 * lane;
            NORM_MOD16x2(v, g, mr0, mr1);
            if (INPROJ_F8) { st16f8((unsigned char*)H + (size_t)rr_[0] * 1024 + 16 * lane, v[0]); if (two_) st16f8((unsigned char*)H + (size_t)rr_[1] * 1024 + 16 * lane, v[1]); }
            else { st16bf(H + (size_t)rr_[0] * 1024 + 16 * lane, v[0]); if (two_) st16bf(H + (size_t)rr_[1] * 1024 + 16 * lane, v[1]); }
        }
    }
    SEAM(11);

    if (IN(12)) { PHASE_PTRS
        constexpr size_t ES_ = INPROJ_F8 ? 1 : 2;
        pg8::DenseOrder S{(const char*)H, (const char*)(wts + WO_C), NROW / 256, 6, G, bid, (size_t)256 * 1024 * ES_, (size_t)256 * 1024 * ES_};
        pg8::EpiStoreBf16 E{PRJ, PRJ_LD, INPROJ_F8 ? 0.03125f : 1.0f};
        pg8::gemm_phase<pg8::EpiStoreBf16, pg8::DenseOrder, true, true, INPROJ_F8 != 0>(tid, LDSB, 1024, 1024, S, E);
    }
    SEAM(12);

    if (IN(13)) { PHASE_PTRS
        const float2* TC = (const float2*)(tabs + TAB_C); const float kg1 = p.c_k_g[lane], kg2 = p.c_k_g[64 + lane];
        for (int r = gw; r < NROW; r += NGW) {
            bf16_t* pr = PRJ + (size_t)r * PRJ_LD + 1024; float2 t = make_float2(1.f, 0.f); if (r < NLAT) t = TC[(r % SEQ) * 64 + lane];
#pragma unroll
            for (int kv = 0; kv < 2; ++kv) { float x1 = bf2f(pr[kv * 128 + lane]), x2 = bf2f(pr[kv * 128 + 64 + lane]);
                const float ss = wave_sum(x1 * x1 + x2 * x2); const float ri = 1.0f / sqrtf(ss * (1.0f / 128.0f) + RMS_EPS);
                x1 = x1 * ri * kg1; x2 = x2 * ri * kg2;
                pr[kv * 128 + lane] = f2bf(x1 * t.x - x2 * t.y); pr[kv * 128 + 64 + lane] = f2bf(x2 * t.x + x1 * t.y); }
        }
    }
    SEAM(13);

    if (IN(14)) { PHASE_PTRS
        for (int i = 0;; ++i) { const int u = i * G + bid; if (u >= 1024) break;
            const int rest = u >> 3; const int b = 2 * (u & 7) + (rest >> 6), h = (rest & 63) >> 3, qb = rest & 7; const int qrow0 = b * SEQ + qb * 256;
            fa::Unit U; U.Q = PRJ + (size_t)qrow0 * PRJ_LD + h * 128; U.K = PRJ + 1024 + (h >> 2) * 128; U.K2 = nullptr; U.V = PRJ + 1280 + (h >> 2) * 128;
            U.O = OUTPROJ_F8 ? (bf16_t*)((unsigned char*)OB + (size_t)qrow0 * 1024 + h * 128) : OB + (size_t)qrow0 * 1024 + h * 128; U.rowa = NLAT + b * NCX; U.nta = 4; U.rowb = b * SEQ; U.ntb = 32;
            U.window = 0; U.qpos0 = 0; U.kposb0 = 0; U.sink = 0.f; U.has_sink = 0; U.tab = (const float*)(tabs + TAB_C); U.pos0 = qb * 256; U.qg = (const float*)(tabs + TAB_QG);
            fa::attn_unit<128, 128, PRJ_LD, PRJ_LD, PRJ_LD, 1024, false, 0, 4, true, false, OUTPROJ_F8 != 0>(tid, U, (char*)lds_raw); }
    }
    SEAM(14);

    if (IN(15)) { PHASE_PTRS
        constexpr size_t ES_ = OUTPROJ_F8 ? 1 : 2;
        pg8::DenseOrder S{(const char*)OB, (const char*)(wts + WO_CO), NLAT / 256, 4, G, bid, (size_t)256 * 1024 * ES_, (size_t)256 * 1024 * ES_};
        pg8::EpiResidT<xr_t, xr_t> E{XR, XR, XR, MOD + 17 * 6144 + 2048, OUTPROJ_F8 ? 0.03125f : 1.0f};
        pg8::gemm_phase<pg8::EpiResidT<xr_t, xr_t>, pg8::DenseOrder, true, true, OUTPROJ_F8 != 0>(tid, LDSB, 1024, 1024, S, E);
    }
    SEAM(15);

    if (IN(16)) { PHASE_PTRS ROUTER_PHASE(1, NLAT); }
    SEAM(16);
#if MOE_F8_L1
    if (IN(17)) { PHASE_PTRS PERMUTE_PHASE_F8(1, NLAT); }
    SEAM(17);
    if (IN(18)) { PHASE_PTRS MOE_FAST1_F8(1); }
    SEAM(18);
    if (IN(19)) { PHASE_PTRS if constexpr (MOE_F8_DOWN) { MOE_FAST2_F8(1); } else { MOE_FAST2(1); } }
    SEAM(19);
#else
    if (IN(17)) { PHASE_PTRS PERMUTE_PHASE(1, NLAT); }
    SEAM(17);
    if (IN(18)) { PHASE_PTRS MOE_FAST1(1); }
    SEAM(18);
    if (IN(19)) { PHASE_PTRS MOE_FAST2(1); }
    SEAM(19);
#endif

    if (IN(20)) { PHASE_PTRS
        COMBINE_PRE(NLAT)
        ROWS2(NLAT) { ROWS2_IDX(NLAT)
            float v[2][16]; COMBINE_ROWS2(1, v, NLAT, (Y8_L1 && MOE_F8_L1 && MOE_F8_DOWN));
            float s0 = 0.f, s1 = 0.f;
#pragma unroll
            for (int j = 0; j < 16; ++j) { s0 = fmaf(v[0][j], v[0][j], s0); s1 = fmaf(v[1][j], v[1][j], s1); }
            wave_sum2(s0, s1); const float ri0 = 1.0f / sqrtf(s0 * (1.0f / 1024.0f) + RMS_EPS), ri1 = 1.0f / sqrtf(s1 * (1.0f / 1024.0f) + RMS_EPS);
            int ln_ = lane; asm volatile("" : "+v"(ln_));
            float g[16]; ld16f(p.final_g + 16 * ln_, g);
#pragma unroll
            for (int j = 0; j < 16; ++j) { v[0][j] = v[0][j] * ri0 * g[j]; v[1][j] = v[1][j] * ri1 * g[j]; }
            st16f(p.out + (size_t)rr_[0] * 1024 + 16 * ln_, v[0]); if (two_) st16f(p.out + (size_t)rr_[1] * 1024 + 16 * ln_, v[1]);
        }
    }
#undef IN
#undef SEAM
}

#ifndef MK_PER_PHASE
#define MK_PER_PHASE 0
#endif
extern "C" void kernel_launch(void* const* d_in, const int* in_sizes, int n_in, void* d_out, int out_size, void* d_ws, size_t ws_size, hipStream_t stream) {
    static int grid = 0;
    if (grid == 0) {
        if (n_in != 26 || out_size != NLAT * DM || ws_size < WS_END) { fprintf(stderr, "kernel_launch: unexpected shapes (n_in %d out %d ws %zu need %zu)\n", n_in, out_size, ws_size, (size_t)WS_END); grid = -1; return; }
        int dev = 0, cus = 0;
        if (hipGetDevice(&dev) != hipSuccess || hipDeviceGetAttribute(&cus, hipDeviceAttributeMultiprocessorCount, dev) != hipSuccess) { grid = -1; return; }
        if (hipFuncSetAttribute((const void*)fwd_kernel, hipFuncAttributeMaxDynamicSharedMemorySize, LDS_BYTES) != hipSuccess) { fprintf(stderr, "kernel_launch: hipFuncSetAttribute failed\n"); grid = -1; return; }
        int per_cu = 0;
        if (hipOccupancyMaxActiveBlocksPerMultiprocessor(&per_cu, (const void*)fwd_kernel, NTHR, LDS_BYTES) != hipSuccess || per_cu < 1) { fprintf(stderr, "kernel_launch: occupancy query says %d\n", per_cu); }
        (void)hipGetLastError();
        grid = cus;
    }
    if (grid < 0) return;
    (void)hipMemsetAsync((char*)d_ws + WS_CTL, 0, CTL_BYTES, stream);
    Params p{};
    const float** pp = (const float**)&p;
    for (int i = 0; i < 26; ++i) pp[i] = (const float*)d_in[i];
    p.out = (float*)d_out; p.ws = (unsigned char*)d_ws;
#if MK_PER_PHASE
    for (int k = 0; k < N_PHASES; ++k) { p.ph_lo = k; p.ph_hi = k + 1; hipLaunchKernelGGL(fwd_kernel, dim3(grid), dim3(NTHR), LDS_BYTES, stream, p); }
#else
    p.ph_lo = 0; p.ph_hi = N_PHASES;
    hipLaunchKernelGGL(fwd_kernel, dim3(grid), dim3(NTHR), LDS_BYTES, stream, p);
#endif
}
```

```cpp
#include <hip/hip_runtime.h>
#include <cstdio>
#include <cstdint>

typedef unsigned short bf16_t;
typedef bf16_t act_t;
#define GAS __attribute__((address_space(1)))
#define LAS __attribute__((address_space(3)))

constexpr int DM = 1024, NB = 16, SEQ = 2048, NCX = 256, GRIDW = 64;
constexpr int NLAT = NB * SEQ, NCTX = NB * NCX, NROW = NLAT + NCTX;
constexpr int AB_IN = 1440, C_IN = 1536, PRJ_LD = 1536;
constexpr int NEXP = 32, DFF = 1024;
constexpr int CAP = 155648;
constexpr float RMS_EPS = 1e-6f;
constexpr int NTHR = 512;

constexpr size_t MiB = 1u << 20;
constexpr size_t ASZ = sizeof(act_t);
constexpr size_t WS_CTL = 0, CTL_BYTES = 1 * MiB;
constexpr size_t WS_MOD = 1 * MiB;
constexpr size_t WS_TOKE = 2 * MiB, WS_TOKP = 3 * MiB, WS_TOKG = 4 * MiB;
constexpr size_t WS_RINV = 5 * MiB;
constexpr size_t WS_TAB = 6 * MiB;
constexpr size_t TAB_A = 0, TAB_B = (size_t)SEQ * 32 * 8, TAB_C = TAB_B + (size_t)SEQ * 16 * 8, TAB_QG = TAB_C + (size_t)SEQ * 64 * 8;
constexpr size_t WS_XR = 16 * MiB;
constexpr size_t WS_H = WS_XR + 144 * MiB;
constexpr size_t WS_BIG = WS_H + (size_t)NROW * 1024 * ASZ;
constexpr size_t OFF_PRJ = 0;
constexpr size_t OFF_QB = OFF_PRJ + (size_t)NROW * 1536 * ASZ;
constexpr size_t OFF_KVB = OFF_QB + (size_t)NROW * 768 * ASZ;
constexpr size_t OFF_O = OFF_KVB + (size_t)NROW * 1024 * ASZ;
constexpr size_t BIG_A = OFF_O + (size_t)NROW * 1024 * ASZ;
constexpr size_t BIG_Y = (size_t)CAP * 1024 * ASZ;
constexpr size_t BIG_BYTES = BIG_A > BIG_Y ? BIG_A : BIG_Y;
constexpr size_t WS_ACT = WS_BIG + BIG_BYTES;
constexpr size_t WS_XS = WS_ACT + (size_t)CAP * 1024 * ASZ;
constexpr size_t WS_W = WS_XS + (size_t)CAP * 1024 * ASZ;
constexpr size_t WO_AB = 0;
constexpr size_t WO_QB = WO_AB + (size_t)1536 * 1024 * 2;
constexpr size_t WO_KVB = WO_QB + (size_t)768 * 384 * 2;
constexpr size_t WO_ABO = WO_KVB + (size_t)1024 * 256 * 2;
constexpr size_t WO_C = WO_ABO + (size_t)1024 * 1024 * 2;
constexpr size_t WO_CO = WO_C + (size_t)1536 * 1024 * 2;
constexpr size_t WO_W1 = WO_CO + (size_t)1024 * 1024 * 2;
constexpr size_t WO_W2 = WO_W1 + (size_t)64 * 2048 * 1024 * 2;
constexpr size_t WS_END = WS_W + WO_W2 + (size_t)64 * 1024 * 1024 * 2;

constexpr int CW_CNT = 64;
constexpr int CW_BAR = 4096;

__device__ __forceinline__ float bf2f(bf16_t v) { return __uint_as_float(((unsigned)v) << 16); }
__device__ __forceinline__ bf16_t f2bf(float f) { unsigned u = __float_as_uint(f); return (bf16_t)((u + 0x7fffu + ((u >> 16) & 1u)) >> 16); }
__device__ __forceinline__ float ldA(const float* p) { return *p; }
__device__ __forceinline__ float ldA(const bf16_t* p) { return bf2f(*p); }
__device__ __forceinline__ void stA(float* p, float v) { *p = v; }
__device__ __forceinline__ void stA(bf16_t* p, float v) { *p = f2bf(v); }
template <int N> __device__ __forceinline__ void load_vec(const float* p, float (&o)[N]) {
#pragma unroll
    for (int i = 0; i < N / 4; ++i) { const float4 t = ((const float4*)p)[i]; o[4 * i] = t.x; o[4 * i + 1] = t.y; o[4 * i + 2] = t.z; o[4 * i + 3] = t.w; }
}
template <int N> __device__ __forceinline__ void load_vec(const bf16_t* p, float (&o)[N]) {
#pragma unroll
    for (int i = 0; i < N / 8; ++i) { const uint4 t = ((const uint4*)p)[i];
        o[8 * i] = __uint_as_float(t.x << 16); o[8 * i + 1] = __uint_as_float(t.x & 0xffff0000u); o[8 * i + 2] = __uint_as_float(t.y << 16); o[8 * i + 3] = __uint_as_float(t.y & 0xffff0000u);
        o[8 * i + 4] = __uint_as_float(t.z << 16); o[8 * i + 5] = __uint_as_float(t.z & 0xffff0000u); o[8 * i + 6] = __uint_as_float(t.w << 16); o[8 * i + 7] = __uint_as_float(t.w & 0xffff0000u); }
}
__device__ __forceinline__ float wave_sum(float v) {
#pragma unroll
    for (int o = 1; o < 64; o <<= 1) v += __shfl_xor(v, o);
    return v;
}

__device__ __forceinline__ void wave_sum2(float& a, float& b) {
#pragma unroll
    for (int o = 1; o < 64; o <<= 1) { const float ta = __shfl_xor(a, o), tb = __shfl_xor(b, o); a += ta; b += tb; }
}
__device__ __forceinline__ void ld16f(const float* p, float (&v)[16]) {
#pragma unroll
    for (int i = 0; i < 4; ++i) { const float4 t = ((const float4*)p)[i]; v[4 * i] = t.x; v[4 * i + 1] = t.y; v[4 * i + 2] = t.z; v[4 * i + 3] = t.w; }
}
__device__ __forceinline__ void st16f(float* p, const float (&v)[16]) {
#pragma unroll
    for (int i = 0; i < 4; ++i) ((float4*)p)[i] = make_float4(v[4 * i], v[4 * i + 1], v[4 * i + 2], v[4 * i + 3]);
}
__device__ __forceinline__ unsigned cvtpk2(float lo, float hi) { unsigned r; asm volatile("v_cvt_pk_bf16_f32 %0, %1, %2" : "=v"(r) : "v"(lo), "v"(hi)); return r; }
__device__ __forceinline__ void st16bf(bf16_t* p, const float (&v)[16]) {
    ((uint4*)p)[0] = make_uint4(cvtpk2(v[0], v[1]), cvtpk2(v[2], v[3]), cvtpk2(v[4], v[5]), cvtpk2(v[6], v[7]));
    ((uint4*)p)[1] = make_uint4(cvtpk2(v[8], v[9]), cvtpk2(v[10], v[11]), cvtpk2(v[12], v[13]), cvtpk2(v[14], v[15]));
}

#ifndef XR16
#define XR16 1
#endif
#if XR16
typedef bf16_t xr_t;
#else
typedef float xr_t;
#endif
__device__ __forceinline__ void ld16x(const float* p, float (&v)[16]) { ld16f(p, v); }
__device__ __forceinline__ void st16x(float* p, const float (&v)[16]) { st16f(p, v); }
__device__ __forceinline__ void ld16x(const bf16_t* p, float (&v)[16]) {
#pragma unroll
    for (int i = 0; i < 2; ++i) { const uint4 t = ((const uint4*)p)[i]; const unsigned w[4] = {t.x, t.y, t.z, t.w};
#pragma unroll
        for (int j = 0; j < 4; ++j) { v[8 * i + 2 * j] = __uint_as_float(w[j] << 16); v[8 * i + 2 * j + 1] = __uint_as_float(w[j] & 0xffff0000u); } }
}
__device__ __forceinline__ void st16x(bf16_t* p, const float (&v)[16]) { st16bf(p, v); }
__device__ __forceinline__ void st16f8(unsigned char* p, const float (&v)[16]) {
    int o[4];
#pragma unroll
    for (int j = 0; j < 4; ++j) { const int t = __builtin_amdgcn_cvt_pk_fp8_f32(v[4 * j], v[4 * j + 1], 0, false); o[j] = __builtin_amdgcn_cvt_pk_fp8_f32(v[4 * j + 2], v[4 * j + 3], t, true); }
    *(int4*)p = make_int4(o[0], o[1], o[2], o[3]);
}
#define XB_TMO      128
#define XB_XCNT(j)  (256  + 64 * (j))
#define XB_XSUB(j)  (1280 + 64 * (j))
#define XB_XGEN(j)  (2304 + 64 * (j))
#define XB_TOP      3328
#define XB_TOPGEN   3392
#define XCD_BAR_WORDS 3456
#define XB_SPIN_CAP (1u << 22)
__device__ __forceinline__ unsigned xb_ld(unsigned* p)              { return __hip_atomic_load(p, __ATOMIC_RELAXED, __HIP_MEMORY_SCOPE_AGENT); }
__device__ __forceinline__ unsigned xb_add(unsigned* p, unsigned v) { return __hip_atomic_fetch_add(p, v, __ATOMIC_RELAXED, __HIP_MEMORY_SCOPE_AGENT); }
__device__ __forceinline__ unsigned xb_xcc_id() { return (unsigned)__builtin_amdgcn_s_getreg((3 << 11) | 20) & 0xFu; }
#define XB_SPIN(cond, bar) do { unsigned _sp = 0; while (cond) { __builtin_amdgcn_s_sleep(1); \
    if ((++_sp & 255u) == 0u) { if (xb_ld(&(bar)[XB_TMO])) break; if (_sp > XB_SPIN_CAP) { atomicAdd(&(bar)[XB_TMO], 1u); break; } } } } while (0)
struct XcdBarrier { unsigned* bar; unsigned x; volatile LAS unsigned* st; };
__device__ __forceinline__ bool xb_is_leader(int wave0) { return wave0 == 0 && __builtin_amdgcn_mbcnt_hi(~0u, __builtin_amdgcn_mbcnt_lo(~0u, 0u)) == 0u; }
__device__ __forceinline__ XcdBarrier xcd_barrier_post(unsigned* bar, volatile LAS unsigned* st, int wave0) {
    XcdBarrier b; b.bar = bar; b.x = xb_xcc_id(); b.st = st;
    if (xb_is_leader(wave0)) (void)xb_add(&bar[XB_XCNT(b.x)], 1u);
    return b;
}
__device__ __forceinline__ void xcd_barrier_complete(unsigned* bar, unsigned x, unsigned& nloc, unsigned& nx) {
    const unsigned G = gridDim.x * gridDim.y * gridDim.z;
    unsigned sum, cnt, mine, sp = 0u;
    for (;;) {
        sum = 0u; cnt = 0u; mine = 0u;
#pragma unroll
        for (unsigned j = 0; j < 16; ++j) { const unsigned c = xb_ld(&bar[XB_XCNT(j)]); sum += c; cnt += (c > 0u) ? 1u : 0u; mine = (j == x) ? c : mine; }
        if (sum == G) break;
        __builtin_amdgcn_s_sleep(1);
        if ((++sp & 255u) == 0u) { if (xb_ld(&bar[XB_TMO])) break; if (sp > XB_SPIN_CAP) { atomicAdd(&bar[XB_TMO], 1u); break; } }
    }
    nloc = mine > 0u ? mine : 1u; nx = cnt > 0u ? cnt : 1u;
}
__device__ __forceinline__ void xcd_barrier(const XcdBarrier& b, int wave0) {
    asm volatile("s_waitcnt vmcnt(0)" ::: "memory");
    __syncthreads();
    if (xb_is_leader(wave0)) {
        unsigned* bar = b.bar;
        __builtin_amdgcn_s_waitcnt(0);
        unsigned nloc = b.st[0], nx = b.st[1];
        if (nloc == 0u) { xcd_barrier_complete(bar, b.x, nloc, nx); b.st[0] = nloc; b.st[1] = nx; }
        const unsigned old = xb_add(&bar[XB_XSUB(b.x)], 1u);
        const unsigned gen = old / nloc;
        if (old + 1u == (gen + 1u) * nloc) {
            __builtin_amdgcn_fence(__ATOMIC_RELEASE, "agent");
            asm volatile("s_waitcnt vmcnt(0)" ::: "memory");
            const unsigned og = xb_add(&bar[XB_TOP], 1u);
            const unsigned tg = og / nx;
            if (og + 1u == (tg + 1u) * nx) xb_add(&bar[XB_TOPGEN], 1u);
            else XB_SPIN(xb_ld(&bar[XB_TOPGEN]) == tg, bar);
            __builtin_amdgcn_fence(__ATOMIC_ACQUIRE, "agent");
            xb_add(&bar[XB_XGEN(b.x)], 1u);
            asm volatile("s_waitcnt vmcnt(0)" ::: "memory");
        } else {
            XB_SPIN(xb_ld(&bar[XB_XGEN(b.x)]) == gen, bar);
            __builtin_amdgcn_fence(__ATOMIC_ACQUIRE, "agent");
            asm volatile("s_waitcnt vmcnt(0)" ::: "memory");
        }
    }
    __syncthreads();
}


#ifndef FAST_GEMM
#define FAST_GEMM 1
#endif
namespace pg8 {
#define PG8_LAS __attribute__((address_space(3)))
typedef short bf16x8 __attribute__((ext_vector_type(8)));
typedef float f32x4 __attribute__((ext_vector_type(4)));
typedef unsigned u32x4 __attribute__((ext_vector_type(4)));
constexpr int BM = 256, BK = 64, HALF = 128, HTB = HALF * BK * 2  , STAGE_BYTES = 8 * HTB, NXCD = 8, WGM = 8;

__host__ __device__ __forceinline__ int lds_byte(int r, int c) { const int st = (r >> 4) * 2 + (c >> 5), rr = r & 15, cc = c & 31, ob = rr * 64 + cc * 2; return st * 1024 + (ob ^ (((ob >> 9) & 1) << 5)); }
__host__ __device__ __forceinline__ void stage_rc(int b, int& R, int& C) { const int st = b / 1024, sb = b % 1024, swz = sb ^ (((sb >> 9) & 1) << 5); R = (st >> 1) * 16 + swz / 64; C = (st & 1) * 32 + (swz % 64) / 2; }
__host__ __device__ __forceinline__ int perm32(int rho) { const int n = rho >> 4, i = rho & 15; return 8 * (i >> 2) + 4 * n + (i & 3); }


struct Unit { const char* a; const char* b; int pm, pn, aux; };
__device__ __forceinline__ unsigned cvt_pk_bf16(float lo, float hi) { unsigned r; asm volatile("v_cvt_pk_bf16_f32 %0, %1, %2" : "=v"(r) : "v"(lo), "v"(hi)); return r; }
typedef int v8i32 __attribute__((ext_vector_type(8)));
__device__ __forceinline__ v8i32 cat16(bf16x8 lo, bf16x8 hi) { typedef int v4i32 __attribute__((ext_vector_type(4))); const v4i32 a = __builtin_bit_cast(v4i32, lo), b = __builtin_bit_cast(v4i32, hi); return __builtin_shufflevector(a, b, 0, 1, 2, 3, 4, 5, 6, 7); }
template <class Epi, class Sched, bool ALIGN_EPI = false, bool SP2 = false, bool F8 = false>
__device__ __forceinline__ void gemm_phase(const int tid, PG8_LAS unsigned char* lds, const int K, const int lda, const Sched& S, const Epi& E) {
    const int wid = __builtin_amdgcn_readfirstlane(tid >> 6), lane = tid & 63, wr = wid >> 2, wc = wid & 3, fr = lane & 15, fq = lane >> 4;
    const int nt = F8 ? K / (2 * BK) : K / BK;
    unsigned voffA[2], voffB[2];
#pragma unroll
    for (int i = 0; i < 2; ++i) { int R, C; stage_rc(tid * 16 + i * 8192, R, C); const int Rb = Epi::PERM ? ((R & ~31) + perm32(R & 31)) : R;
        voffA[i] = F8 ? (unsigned)(R * lda + 2 * C) : (unsigned)(R * lda + C) * 2u; voffB[i] = F8 ? (unsigned)(Rb * K + 2 * C) : (unsigned)(Rb * K + C) * 2u; }
    const size_t kstep = (size_t)(BK * 2);
    const size_t hstepA = (size_t)HALF * lda * (F8 ? 1 : 2);
    const size_t hstep = (size_t)HALF * K * (F8 ? 1 : 2);
    const unsigned ldsbase = (unsigned)__builtin_amdgcn_readfirstlane((int)((unsigned)(uintptr_t)lds + (unsigned)wid * 1024u));
    const unsigned ldsw = (unsigned)wid * 1024u;
    const int aoff = lds_byte(wr * 64 + fr, fq * 8), boff = lds_byte(wc * 32 + fr, fq * 8);
#define PG8_SA(b, h) (((b) * 2 + (h)) * HTB)
#define PG8_SB(b, h) ((4 + (b) * 2 + (h)) * HTB)
#define PG8_STAGE(bufoff, gbase, voff) do { _Pragma("unroll") for (int _i = 0; _i < 2; ++_i) { \
        if constexpr (F8) { unsigned keep_; asm volatile("s_mov_b32 %0, m0\n\ts_mov_b32 m0, %3\n\ts_nop 0\n\tglobal_load_lds_dwordx4 %1, %2\n\ts_mov_b32 m0, %0" : "=&s"(keep_) : "v"((voff)[_i]), "s"((const char*)(gbase)), "s"(ldsbase + (unsigned)((bufoff) + _i * 8192)) : "memory"); } \
        else __builtin_amdgcn_global_load_lds((const unsigned*)((const char*)(gbase) + (voff)[_i]), (PG8_LAS unsigned*)(lds + (bufoff) + ldsw + _i * 8192), 16, 0, 0); } } while (0)
#define PG8_LDA(dst, b, h) do { _Pragma("unroll") for (int m = 0; m < 4; ++m) { _Pragma("unroll") for (int k = 0; k < 2; ++k) dst[m][k] = *(const PG8_LAS bf16x8*)(lds + PG8_SA(b, h) + aoff + m * 2048 + k * 1024); \
        if constexpr (F8) dst##8[m] = cat16(dst[m][0], dst[m][1]); } } while (0)
#define PG8_LDB(dst, b, h) do { _Pragma("unroll") for (int n = 0; n < 2; ++n) { _Pragma("unroll") for (int k = 0; k < 2; ++k) dst[n][k] = *(const PG8_LAS bf16x8*)(lds + PG8_SB(b, h) + boff + n * 2048 + k * 1024); \
        if constexpr (F8) dst##8[n] = cat16(dst[n][0], dst[n][1]); } } while (0)
#define PG8_MMA(ai, bj, At, Bt) do { __builtin_amdgcn_s_setprio(1); _Pragma("unroll") for (int m = 0; m < 4; ++m) _Pragma("unroll") for (int n = 0; n < 2; ++n) { \
        if constexpr (F8) acc[ai][bj][m][n] = __builtin_amdgcn_mfma_scale_f32_16x16x128_f8f6f4(Bt##8[n], At##8[m], acc[ai][bj][m][n], 0, 0, 0, 0x7f7f7f7f, 0, 0x7f7f7f7f); \
        else { _Pragma("unroll") for (int k = 0; k < 2; ++k) acc[ai][bj][m][n] = __builtin_amdgcn_mfma_f32_16x16x32_bf16(Bt[n][k], At[m][k], acc[ai][bj][m][n], 0, 0, 0); } } __builtin_amdgcn_s_setprio(0); } while (0)
#define PG8_WAIT_V(n) asm volatile("s_waitcnt vmcnt(" #n ")" ::: "memory")
#define PG8_WAIT_L(n) asm volatile("s_waitcnt lgkmcnt(" #n ")" ::: "memory")
#define PG8_BAR __builtin_amdgcn_s_barrier()
#define PG8_SCHED __builtin_amdgcn_sched_barrier(0)
    Unit cur, nxt; int ui = 0;
    if (!S.next(0, cur)) return;
    f32x4 acc[2][2][4][2];
#pragma unroll
    for (int a = 0; a < 2; ++a)
#pragma unroll
        for (int b = 0; b < 2; ++b)
#pragma unroll
            for (int m = 0; m < 4; ++m)
#pragma unroll
                for (int n = 0; n < 2; ++n) acc[a][b][m][n] = (f32x4){0.f, 0.f, 0.f, 0.f};
    bf16x8 At[4][2], B0[2][2], B1[2][2]; v8i32 At8[4], B08[2], B18[2]; (void)At8; (void)B08; (void)B18;
    const char* cA = cur.a; const char* cB = cur.b;
    S.a_ready(cur);
    if constexpr (SP2) {
        PG8_STAGE(PG8_SB(0, 0), cB, voffB); PG8_STAGE(PG8_SB(0, 1), cB + hstep, voffB); PG8_STAGE(PG8_SA(0, 0), cA, voffA); PG8_STAGE(PG8_SA(0, 1), cA + hstepA, voffA);
        if (wr == 1) PG8_BAR;
        PG8_WAIT_V(2); PG8_BAR;
        PG8_STAGE(PG8_SB(1, 0), cB + kstep, voffB); PG8_STAGE(PG8_SA(1, 0), cA + kstep, voffA); PG8_STAGE(PG8_SB(1, 1), cB + hstep + kstep, voffB);
        PG8_WAIT_V(6); PG8_BAR;
    } else {
        PG8_STAGE(PG8_SB(0, 0), cB, voffB); PG8_STAGE(PG8_SA(0, 0), cA, voffA); PG8_STAGE(PG8_SB(0, 1), cB + hstep, voffB); PG8_STAGE(PG8_SA(0, 1), cA + hstepA, voffA);
        if (wr == 1) PG8_BAR;
        PG8_WAIT_V(4); PG8_BAR;
        PG8_STAGE(PG8_SB(1, 0), cB + kstep, voffB); PG8_STAGE(PG8_SA(1, 0), cA + kstep, voffA); PG8_STAGE(PG8_SB(1, 1), cB + hstep + kstep, voffB);
        PG8_WAIT_V(6); PG8_BAR;
    }
    for (;;) {
        const bool has_next = S.next(ui + 1, nxt);
        const char* nA = has_next ? nxt.a : cA; const char* nB = has_next ? nxt.b : cB;
        if constexpr (F8 && Epi::BIAS_LDS) {
            unsigned zb_ = 0u; asm volatile("" : "+v"(zb_)); unsigned bo_ = __builtin_amdgcn_mbcnt_hi(~0u, __builtin_amdgcn_mbcnt_lo(~0u, zb_)); asm volatile("" : "+v"(bo_)); bo_ = (bo_ << 4) + E.bias_slice_bytes(cur);
            unsigned keep_; asm volatile("s_mov_b32 %0, m0\n\ts_mov_b32 m0, %3\n\ts_nop 0\n\tglobal_load_lds_dwordx4 %1, %2\n\ts_mov_b32 m0, %0" : "=&s"(keep_) : "v"(bo_), "s"((const char*)E.bias), "s"(ldsbase + 131072u) : "memory"); }
#pragma unroll 1
        for (int t = 0; t < nt; t += 2) {
            const bool last = (t == nt - 2);
            const char* a1 = cA + (size_t)(t + 1) * kstep;
            const char* a2 = last ? nA : cA + (size_t)(t + 2) * kstep; const char* b2 = last ? nB : cB + (size_t)(t + 2) * kstep;
            const char* a3 = a2 + kstep; const char* b3 = b2 + kstep;
            if (last && has_next) S.a_ready(nxt);
            if constexpr (SP2) {
            PG8_LDB(B0, 0, 0); PG8_LDB(B1, 0, 1); PG8_SCHED; PG8_LDA(At, 0, 0); PG8_STAGE(PG8_SA(1, 1), a1 + hstepA, voffA);
            PG8_WAIT_V(8); PG8_WAIT_L(0); PG8_BAR; PG8_MMA(0, 0, At, B0); PG8_MMA(0, 1, At, B1); PG8_BAR; PG8_SCHED;
            PG8_LDA(At, 0, 1); PG8_STAGE(PG8_SB(0, 0), b2, voffB); PG8_STAGE(PG8_SB(0, 1), b2 + hstep, voffB); PG8_STAGE(PG8_SA(0, 0), a2, voffA);
            PG8_WAIT_V(8); PG8_WAIT_L(0); PG8_BAR; PG8_MMA(1, 0, At, B0); PG8_MMA(1, 1, At, B1); PG8_BAR; PG8_SCHED;
            PG8_LDB(B0, 1, 0); PG8_LDB(B1, 1, 1); PG8_SCHED; PG8_LDA(At, 1, 0); PG8_STAGE(PG8_SA(0, 1), a2 + hstepA, voffA);
            PG8_WAIT_V(8); PG8_WAIT_L(0); PG8_BAR; PG8_MMA(0, 0, At, B0); PG8_MMA(0, 1, At, B1); PG8_BAR; PG8_SCHED;
            PG8_LDA(At, 1, 1); PG8_STAGE(PG8_SB(1, 0), b3, voffB); PG8_STAGE(PG8_SB(1, 1), b3 + hstep, voffB); PG8_STAGE(PG8_SA(1, 0), a3, voffA);
            PG8_WAIT_V(8); PG8_WAIT_L(0); PG8_BAR; PG8_MMA(1, 0, At, B0); PG8_MMA(1, 1, At, B1); PG8_BAR; PG8_SCHED;
            } else {
            PG8_LDB(B0, 0, 0); PG8_SCHED; PG8_LDA(At, 0, 0); PG8_STAGE(PG8_SA(1, 1), a1 + hstepA, voffA);
            PG8_WAIT_L(8); PG8_BAR; PG8_WAIT_L(0); PG8_MMA(0, 0, At, B0); PG8_BAR; PG8_SCHED;
            PG8_LDB(B1, 0, 1); PG8_STAGE(PG8_SB(0, 0), b2, voffB);
            PG8_BAR; PG8_WAIT_L(0); PG8_MMA(0, 1, At, B1); PG8_BAR;
            PG8_LDA(At, 0, 1); PG8_STAGE(PG8_SA(0, 0), a2, voffA);
            PG8_BAR; PG8_WAIT_L(0); PG8_MMA(1, 0, At, B0); PG8_BAR; PG8_SCHED;
            PG8_STAGE(PG8_SB(0, 1), b2 + hstep, voffB);
            PG8_WAIT_V(6); PG8_BAR; PG8_MMA(1, 1, At, B1); PG8_BAR;
            PG8_LDB(B0, 1, 0); PG8_SCHED; PG8_LDA(At, 1, 0); PG8_STAGE(PG8_SA(0, 1), a2 + hstepA, voffA);
            PG8_WAIT_L(8); PG8_BAR; PG8_WAIT_L(0); PG8_MMA(0, 0, At, B0); PG8_BAR; PG8_SCHED;
            PG8_LDB(B1, 1, 1); PG8_STAGE(PG8_SB(1, 0), b3, voffB);
            PG8_BAR; PG8_WAIT_L(0); PG8_MMA(0, 1, At, B1); PG8_BAR;
            PG8_LDA(At, 1, 1); PG8_STAGE(PG8_SA(1, 0), a3, voffA);
            PG8_BAR; PG8_WAIT_L(0); PG8_MMA(1, 0, At, B0); PG8_BAR; PG8_SCHED;
            PG8_STAGE(PG8_SB(1, 1), b3 + hstep, voffB);
            PG8_WAIT_V(6); PG8_BAR; PG8_MMA(1, 1, At, B1); PG8_BAR;
            }
        }
        if constexpr (ALIGN_EPI) { if (wr == 0) PG8_BAR; }
        if constexpr (!Epi::AFTER_DRAIN) { unsigned zl_ = 0u; asm volatile("" : "+v"(zl_)); int tl_ = (int)__builtin_amdgcn_mbcnt_hi(~0u, __builtin_amdgcn_mbcnt_lo(~0u, zl_)); asm volatile("" : "+v"(tl_));
            if constexpr (F8 && Epi::BIAS_LDS) E(acc, cur, wr, wc, tl_ & 15, (tl_ & 63) >> 4, (const PG8_LAS float*)(lds + 131072 + wid * 1024)); else E(acc, cur, wr, wc, tl_ & 15, (tl_ & 63) >> 4);
            S.done(cur); }
        if (!has_next) break;
#pragma unroll
        for (int a = 0; a < 2; ++a)
#pragma unroll
            for (int b = 0; b < 2; ++b)
#pragma unroll
                for (int m = 0; m < 4; ++m)
#pragma unroll
                    for (int n = 0; n < 2; ++n) acc[a][b][m][n] = (f32x4){0.f, 0.f, 0.f, 0.f};
        cur = nxt; cA = nA; cB = nB; ++ui;
        if constexpr (ALIGN_EPI) { if (wr == 1) PG8_BAR; }
    }
    PG8_WAIT_V(0);
    if constexpr (!ALIGN_EPI) { if (wr == 0) PG8_BAR; }
    PG8_BAR;
    if constexpr (Epi::AFTER_DRAIN) { E.fused(acc, cur, wr, wc, fr, fq, lds, wid, lane); S.done(cur); }
#undef PG8_SA
#undef PG8_SB
#undef PG8_STAGE
#undef PG8_LDA
#undef PG8_LDB
#undef PG8_MMA
#undef PG8_WAIT_V
#undef PG8_WAIT_L
#undef PG8_BAR
#undef PG8_SCHED
}
}
namespace pg8 {
struct OrderMap {
    __device__ __forceinline__ static bool map(int i, int G, int c, int nM, int nN, int& pm, int& pn) {
        const int nwg = nM * nN; const int L = i * G + c; if (L >= nwg) return false;
        int wgid = L; { const int q = nwg / NXCD, r = nwg % NXCD, xcd = wgid % NXCD, off = wgid / NXCD; wgid = (xcd < r ? xcd * (q + 1) : r * (q + 1) + (xcd - r) * q) + off; }
        const int nig = WGM * nN, gid = wgid / nig, fm = gid * WGM, gsz = (nM - fm) < WGM ? (nM - fm) : WGM;
        pm = fm + ((wgid % nig) % gsz); pn = (wgid % nig) / gsz; return true;
    }
};
struct DenseOrder {
    const char* A; const char* B; int nM, nN, G, c; size_t tstepA, tstepB;
    __device__ __forceinline__ bool next(int i, Unit& u) const { int pm, pn; if (!OrderMap::map(i, G, c, nM, nN, pm, pn)) return false; u.pm = pm; u.pn = pn; u.aux = 0; u.a = A + (size_t)pm * tstepA; u.b = B + (size_t)pn * tstepB; return true; }
    __device__ __forceinline__ void a_ready(const Unit&) const {}
    __device__ __forceinline__ void done(const Unit&) const {}
};
struct MoeOrder {
    const char* A; const char* B; const PG8_LAS int* tile_e; int nM, nN, G, c; size_t tstep, estep;
    __device__ __forceinline__ bool next(int i, Unit& u) const { int pm, pn; if (!OrderMap::map(i, G, c, nM, nN, pm, pn)) return false; const int e = __builtin_amdgcn_readfirstlane(tile_e[pm]); u.pm = pm; u.pn = pn; u.aux = e;
        u.a = A + (size_t)pm * tstep; u.b = B + (size_t)e * estep + (size_t)pn * tstep; return true; }
    __device__ __forceinline__ void a_ready(const Unit&) const {}
    __device__ __forceinline__ void done(const Unit&) const {}
};
struct EpiStoreBf16 { static constexpr bool PERM = true, AFTER_DRAIN = false, BIAS_LDS = false;
    bf16_t* O; int ldc; float ascale;
    __device__ __forceinline__ void operator()(const f32x4 (&acc)[2][2][4][2], const Unit& u, int wr, int wc, int fr, int fq) const {
        bf16_t* base = O + (size_t)(u.pm * BM + wr * 64 + fr) * ldc + u.pn * BM + wc * 32 + 8 * fq;
        float asc = ascale; asm volatile("" : "+v"(asc));
#pragma unroll
        for (int ai = 0; ai < 2; ++ai)
#pragma unroll
            for (int m = 0; m < 4; ++m) { bf16_t* rowp = base + (size_t)(ai * HALF + m * 16) * ldc;
#pragma unroll
                for (int bj = 0; bj < 2; ++bj) { const f32x4 v0 = acc[ai][bj][m][0] * asc, v1 = acc[ai][bj][m][1] * asc; u32x4 w;
                    w.x = cvt_pk_bf16(v0[0], v0[1]); w.y = cvt_pk_bf16(v0[2], v0[3]); w.z = cvt_pk_bf16(v1[0], v1[1]); w.w = cvt_pk_bf16(v1[2], v1[3]);
                    *(u32x4*)(rowp + bj * HALF) = w; } }
    }
};
struct EpiScaleBf16 { static constexpr bool PERM = true, AFTER_DRAIN = false, BIAS_LDS = false;
    bf16_t* O; int ldc; const float* rs;
    __device__ __forceinline__ void operator()(const f32x4 (&acc)[2][2][4][2], const Unit& u, int wr, int wc, int fr, int fq) const {
        const int row0 = u.pm * BM + wr * 64 + fr; bf16_t* base = O + (size_t)row0 * ldc + u.pn * BM + wc * 32 + 8 * fq;
#pragma unroll
        for (int ai = 0; ai < 2; ++ai)
#pragma unroll
            for (int m = 0; m < 4; ++m) { bf16_t* rowp = base + (size_t)(ai * HALF + m * 16) * ldc; const float sc = rs[2 * (row0 + ai * HALF + m * 16)];
#pragma unroll
                for (int bj = 0; bj < 2; ++bj) { const f32x4 v0 = acc[ai][bj][m][0] * sc, v1 = acc[ai][bj][m][1] * sc; u32x4 w;
                    w.x = cvt_pk_bf16(v0[0], v0[1]); w.y = cvt_pk_bf16(v0[2], v0[3]); w.z = cvt_pk_bf16(v1[0], v1[1]); w.w = cvt_pk_bf16(v1[2], v1[3]);
                    *(u32x4*)(rowp + bj * HALF) = w; } }
    }
};
template <typename ST, typename OT>
struct EpiResidT { static constexpr bool PERM = true, AFTER_DRAIN = false, BIAS_LDS = false;
    const ST* src_lat; const ST* src_ctx; OT* out; const float* mod_g1; float ascale;
    __device__ __forceinline__ void operator()(const f32x4 (&acc)[2][2][4][2], const Unit& u, int wr, int wc, int fr, int fq) const {
        const int row_t = u.pm * BM; const int mrow = row_t < NLAT ? row_t / SEQ : NB;
        const float* g = mod_g1 + (size_t)mrow * 6144 + u.pn * BM + wc * 32 + 8 * fq;
        const ST* sb = (row_t < NLAT ? src_lat + (size_t)row_t * 1024 : src_ctx + (size_t)(row_t - NLAT) * 1024) + u.pn * BM + wc * 32 + 8 * fq;
        OT* ob = out + (size_t)row_t * 1024 + u.pn * BM + wc * 32 + 8 * fq;
        f32x4 gv[2][2];
#pragma unroll
        for (int bj = 0; bj < 2; ++bj)
#pragma unroll
            for (int n = 0; n < 2; ++n) gv[bj][n] = *(const f32x4*)(g + bj * HALF + 4 * n) * ascale;
#pragma unroll
        for (int ai = 0; ai < 2; ++ai)
#pragma unroll
            for (int m = 0; m < 4; ++m) { const size_t off = (size_t)(wr * 64 + fr + ai * HALF + m * 16) * 1024;
#pragma unroll
                for (int bj = 0; bj < 2; ++bj) { f32x4 sv[2];
                    if constexpr (sizeof(ST) == 2) { const u32x4 t = *(const u32x4*)(sb + off + bj * HALF);
                        sv[0] = (f32x4){__uint_as_float(t[0] << 16), __uint_as_float(t[0] & 0xffff0000u), __uint_as_float(t[1] << 16), __uint_as_float(t[1] & 0xffff0000u)};
                        sv[1] = (f32x4){__uint_as_float(t[2] << 16), __uint_as_float(t[2] & 0xffff0000u), __uint_as_float(t[3] << 16), __uint_as_float(t[3] & 0xffff0000u)}; }
                    else { sv[0] = *(const f32x4*)(sb + off + bj * HALF); sv[1] = *(const f32x4*)(sb + off + bj * HALF + 4); }
                    const f32x4 o0 = sv[0] + gv[bj][0] * acc[ai][bj][m][0], o1 = sv[1] + gv[bj][1] * acc[ai][bj][m][1];
                    if constexpr (sizeof(OT) == 2) { u32x4 t; t[0] = cvt_pk_bf16(o0[0], o0[1]); t[1] = cvt_pk_bf16(o0[2], o0[3]); t[2] = cvt_pk_bf16(o1[0], o1[1]); t[3] = cvt_pk_bf16(o1[2], o1[3]); *(u32x4*)(ob + off + bj * HALF) = t; }
                    else { *(f32x4*)(ob + off + bj * HALF) = o0; *(f32x4*)(ob + off + bj * HALF + 4) = o1; } }
                asm volatile("" ::: "memory"); }
    }
};
__device__ __forceinline__ float swiglu1(float g, float l, float c7, float cn) {
    const float glu = fminf(g, c7), lin = fminf(fmaxf(l, -c7), c7);
    const float sg = __builtin_amdgcn_rcpf(1.0f + __builtin_amdgcn_exp2f(cn * glu));
    return glu * sg * (lin + 1.0f);
}
struct EpiSwiglu { static constexpr bool PERM = true, AFTER_DRAIN = false, BIAS_LDS = false;
    bf16_t* O; const float* bias; float ascale;
    __device__ __forceinline__ void operator()(const f32x4 (&acc)[2][2][4][2], const Unit& u, int wr, int wc, int fr, int fq) const {
        const int col0 = u.pn * BM + wc * 32 + 8 * fq; const float* b = bias + (size_t)u.aux * 2048 + col0;
        float c7 = 7.0f, cn = -1.702f * 1.4426950408889634f; asm volatile("" : "+v"(c7), "+v"(cn));
        bf16_t* base = O + (size_t)(u.pm * BM + wr * 64 + fr) * 1024 + (col0 >> 1);
        f32x4 bv[2][2];
#pragma unroll
        for (int bj = 0; bj < 2; ++bj)
#pragma unroll
            for (int n = 0; n < 2; ++n) bv[bj][n] = *(const f32x4*)(b + bj * HALF + 4 * n);
#pragma unroll
        for (int ai = 0; ai < 2; ++ai)
#pragma unroll
            for (int m = 0; m < 4; ++m) { bf16_t* rowp = base + (size_t)(ai * HALF + m * 16) * 1024;
#pragma unroll
                for (int bj = 0; bj < 2; ++bj) { const f32x4 v0 = acc[ai][bj][m][0] * ascale + bv[bj][0], v1 = acc[ai][bj][m][1] * ascale + bv[bj][1];
                    uint2 w; w.x = cvt_pk_bf16(swiglu1(v0[0], v0[1], c7, cn), swiglu1(v0[2], v0[3], c7, cn)); w.y = cvt_pk_bf16(swiglu1(v1[0], v1[1], c7, cn), swiglu1(v1[2], v1[3], c7, cn));
                    *(uint2*)(rowp + bj * (HALF / 2)) = w; } }
    }
};
struct EpiSwigluF8 { static constexpr bool PERM = true, AFTER_DRAIN = false, BIAS_LDS = true;
    unsigned char* O; const float* bias;
    __device__ __forceinline__ unsigned bias_slice_bytes(const Unit& u) const { return (unsigned)(u.aux * 2048 + u.pn * BM) * 4u; }
    __device__ __forceinline__ void operator()(const f32x4 (&acc)[2][2][4][2], const Unit& u, int wr, int wc, int fr, int fq, const PG8_LAS float* bl) const {
        const int col0 = u.pn * BM + wc * 32 + 8 * fq; const PG8_LAS float* b = bl + wc * 32 + 8 * fq;
        float c7 = 7.0f, cn = -1.702f * 1.4426950408889634f, c32 = 0.03125f; asm volatile("" : "+v"(c7), "+v"(cn), "+v"(c32));
        unsigned char* base = O + (size_t)(u.pm * BM + wr * 64 + fr) * 1024 + (col0 >> 1);
        f32x4 bv[2][2];
#pragma unroll
        for (int bj = 0; bj < 2; ++bj)
#pragma unroll
            for (int n = 0; n < 2; ++n) bv[bj][n] = *(const PG8_LAS f32x4*)(b + bj * HALF + 4 * n);
#pragma unroll
        for (int ai = 0; ai < 2; ++ai)
#pragma unroll
            for (int m = 0; m < 4; ++m) { unsigned char* rowp = base + (size_t)(ai * HALF + m * 16) * 1024;
#pragma unroll
                for (int bj = 0; bj < 2; ++bj) { const f32x4 v0 = acc[ai][bj][m][0] * c32 + bv[bj][0], v1 = acc[ai][bj][m][1] * c32 + bv[bj][1];
                    int w = __builtin_amdgcn_cvt_pk_fp8_f32(swiglu1(v0[0], v0[1], c7, cn), swiglu1(v0[2], v0[3], c7, cn), 0, false); w = __builtin_amdgcn_cvt_pk_fp8_f32(swiglu1(v1[0], v1[1], c7, cn), swiglu1(v1[2], v1[3], c7, cn), w, true);
                    *(int*)(rowp + bj * (HALF / 2)) = w; } }
    }
};
struct EpiBiasF8 { static constexpr bool PERM = true, AFTER_DRAIN = false, BIAS_LDS = true;
    unsigned char* O; const float* bias; float ascale;
    __device__ __forceinline__ unsigned bias_slice_bytes(const Unit& u) const { return (unsigned)(u.aux * 1024 + u.pn * BM) * 4u; }
    __device__ __forceinline__ void operator()(const f32x4 (&acc)[2][2][4][2], const Unit& u, int wr, int wc, int fr, int fq, const PG8_LAS float* bl) const {
        const int col0 = u.pn * BM + wc * 32 + 8 * fq; const PG8_LAS float* b = bl + wc * 32 + 8 * fq;
        float asc = ascale; asm volatile("" : "+v"(asc));
        unsigned char* base = O + (size_t)(u.pm * BM + wr * 64 + fr) * 1024 + col0;
        f32x4 bv[2][2];
#pragma unroll
        for (int bj = 0; bj < 2; ++bj)
#pragma unroll
            for (int n = 0; n < 2; ++n) bv[bj][n] = *(const PG8_LAS f32x4*)(b + bj * HALF + 4 * n);
#pragma unroll
        for (int ai = 0; ai < 2; ++ai)
#pragma unroll
            for (int m = 0; m < 4; ++m) { unsigned char* rowp = base + (size_t)(ai * HALF + m * 16) * 1024;
#pragma unroll
                for (int bj = 0; bj < 2; ++bj) { const f32x4 v0 = acc[ai][bj][m][0] * asc + bv[bj][0], v1 = acc[ai][bj][m][1] * asc + bv[bj][1];
                    int lo = __builtin_amdgcn_cvt_pk_fp8_f32(v0[0], v0[1], 0, false); lo = __builtin_amdgcn_cvt_pk_fp8_f32(v0[2], v0[3], lo, true);
                    int hi = __builtin_amdgcn_cvt_pk_fp8_f32(v1[0], v1[1], 0, false); hi = __builtin_amdgcn_cvt_pk_fp8_f32(v1[2], v1[3], hi, true);
                    *(int2*)(rowp + bj * HALF) = make_int2(lo, hi); } }
    }
};
struct EpiBiasBf16 { static constexpr bool PERM = true, AFTER_DRAIN = false, BIAS_LDS = false;
    bf16_t* O; const float* bias; float ascale;
    __device__ __forceinline__ void operator()(const f32x4 (&acc)[2][2][4][2], const Unit& u, int wr, int wc, int fr, int fq) const {
        const int col0 = u.pn * BM + wc * 32 + 8 * fq; const float* b = bias + (size_t)u.aux * 1024 + col0;
        float asc = ascale; asm volatile("" : "+v"(asc));
        bf16_t* base = O + (size_t)(u.pm * BM + wr * 64 + fr) * 1024 + col0;
        f32x4 bv[2][2];
#pragma unroll
        for (int bj = 0; bj < 2; ++bj)
#pragma unroll
            for (int n = 0; n < 2; ++n) bv[bj][n] = *(const f32x4*)(b + bj * HALF + 4 * n);
#pragma unroll
        for (int ai = 0; ai < 2; ++ai)
#pragma unroll
            for (int m = 0; m < 4; ++m) { bf16_t* rowp = base + (size_t)(ai * HALF + m * 16) * 1024;
#pragma unroll
                for (int bj = 0; bj < 2; ++bj) { const f32x4 v0 = acc[ai][bj][m][0] * asc + bv[bj][0], v1 = acc[ai][bj][m][1] * asc + bv[bj][1]; u32x4 w;
                    w.x = cvt_pk_bf16(v0[0], v0[1]); w.y = cvt_pk_bf16(v0[2], v0[3]); w.z = cvt_pk_bf16(v1[0], v1[1]); w.w = cvt_pk_bf16(v1[2], v1[3]);
                    *(u32x4*)(rowp + bj * HALF) = w; } }
    }
};
}
__device__ __forceinline__ unsigned pk2(float lo, float hi) { return (unsigned)f2bf(lo) | ((unsigned)f2bf(hi) << 16); }
__device__ __forceinline__ void transpose_item(const float* __restrict__ W, int K, int N, bf16_t* __restrict__ WT, LAS float* scr, int item, int lane, const float* rowscale = nullptr, float cscale = 1.0f, int cs_ncols = 1 << 30) {
    const int nblk = N / 32, kb = item / nblk, nb = item % nblk, k0 = 64 * kb, n0 = 32 * nb;
    const float cs = n0 < cs_ncols ? cscale : 1.0f;
#pragma unroll 8
    for (int i = 0; i < 32; ++i) { const int kk = 2 * i + (lane >> 5); float w = W[(size_t)(k0 + kk) * N + n0 + (lane & 31)]; if (rowscale) w *= rowscale[k0 + kk]; scr[kk * 33 + (lane & 31)] = w * cs; }
    asm volatile("s_waitcnt lgkmcnt(0)" ::: "memory");
    const int c = lane & 7;
#pragma unroll
    for (int j = 0; j < 4; ++j) { const int n = (lane >> 3) + 8 * j; const LAS float* sp = scr + (8 * c) * 33 + n;
        uint4 o; o.x = pk2(sp[0 * 33], sp[1 * 33]); o.y = pk2(sp[2 * 33], sp[3 * 33]); o.z = pk2(sp[4 * 33], sp[5 * 33]); o.w = pk2(sp[6 * 33], sp[7 * 33]);
        *(uint4*)(WT + (size_t)(n0 + n) * K + k0 + 8 * c) = o; }
    asm volatile("s_waitcnt lgkmcnt(0)" ::: "memory");
}

__device__ __forceinline__ void transpose_item_f8(const float* __restrict__ W, int K, int N, unsigned char* __restrict__ WT, LAS float* scr, int item, int lane, float cscale = 1.0f, int cs_ncols = 1 << 30) {
    const int nblk = N / 32, kb = item / nblk, nb = item % nblk, k0 = 64 * kb, n0 = 32 * nb;
    const float cs = 32.0f * (n0 < cs_ncols ? cscale : 1.0f);
#pragma unroll 8
    for (int i = 0; i < 32; ++i) { const int kk = 2 * i + (lane >> 5); scr[kk * 33 + (lane & 31)] = W[(size_t)(k0 + kk) * N + n0 + (lane & 31)] * cs; }
    asm volatile("s_waitcnt lgkmcnt(0)" ::: "memory");
    const int c = lane & 7;
#pragma unroll
    for (int j = 0; j < 4; ++j) { const int n = (lane >> 3) + 8 * j; const LAS float* sp = scr + (8 * c) * 33 + n;
        int lo = __builtin_amdgcn_cvt_pk_fp8_f32(sp[0 * 33], sp[1 * 33], 0, false); lo = __builtin_amdgcn_cvt_pk_fp8_f32(sp[2 * 33], sp[3 * 33], lo, true);
        int hi = __builtin_amdgcn_cvt_pk_fp8_f32(sp[4 * 33], sp[5 * 33], 0, false); hi = __builtin_amdgcn_cvt_pk_fp8_f32(sp[6 * 33], sp[7 * 33], hi, true);
        *(int2*)(WT + (size_t)(n0 + n) * K + k0 + 8 * c) = make_int2(lo, hi); }
    asm volatile("s_waitcnt lgkmcnt(0)" ::: "memory");
}
template <bool F8OUT>
__device__ __forceinline__ void transpose_item64(const float* __restrict__ W, int K, int N, void* __restrict__ WT, LAS float* scr, int item, int lane, const float* rowscale = nullptr, float cscale = 1.0f) {
    const int nblk = N / 64, kb = item / nblk, nb = item % nblk, k0 = 64 * kb, n0 = 64 * nb;
    const float cs = cscale * (F8OUT ? 32.0f : 1.0f);
    float4 wv[16];
#pragma unroll
    for (int i = 0; i < 16; ++i) wv[i] = *(const float4*)(W + (size_t)(k0 + 4 * i + (lane >> 4)) * N + n0 + 4 * (lane & 15));
#pragma unroll
    for (int i = 0; i < 16; ++i) { const int kk = 4 * i + (lane >> 4); const float4 w = wv[i];
        const float rs = rowscale ? rowscale[k0 + kk] * cs : cs; LAS float* d = scr + kk * 65 + 4 * (lane & 15); d[0] = w.x * rs; d[1] = w.y * rs; d[2] = w.z * rs; d[3] = w.w * rs; }
    asm volatile("s_waitcnt lgkmcnt(0)" ::: "memory");
    const int c = lane & 7;
#pragma unroll
    for (int j = 0; j < 8; ++j) { const int n = (lane >> 3) + 8 * j; const LAS float* sp = scr + (8 * c) * 65 + n;
        if constexpr (F8OUT) { int lo = __builtin_amdgcn_cvt_pk_fp8_f32(sp[0 * 65], sp[1 * 65], 0, false); lo = __builtin_amdgcn_cvt_pk_fp8_f32(sp[2 * 65], sp[3 * 65], lo, true);
            int hi = __builtin_amdgcn_cvt_pk_fp8_f32(sp[4 * 65], sp[5 * 65], 0, false); hi = __builtin_amdgcn_cvt_pk_fp8_f32(sp[6 * 65], sp[7 * 65], hi, true);
            *(int2*)((unsigned char*)WT + (size_t)(n0 + n) * K + k0 + 8 * c) = make_int2(lo, hi); }
        else { uint4 o; o.x = pk2(sp[0 * 65], sp[1 * 65]); o.y = pk2(sp[2 * 65], sp[3 * 65]); o.z = pk2(sp[4 * 65], sp[5 * 65]); o.w = pk2(sp[6 * 65], sp[7 * 65]);
            *(uint4*)((bf16_t*)WT + (size_t)(n0 + n) * K + k0 + 8 * c) = o; } }
    asm volatile("s_waitcnt lgkmcnt(0)" ::: "memory");
}
namespace fa {
using bf16x8 = __attribute__((ext_vector_type(8))) short;
using s16x4  = __attribute__((ext_vector_type(4))) short;
using f32x16 = __attribute__((ext_vector_type(16))) float;
using u32x4  = __attribute__((ext_vector_type(4))) unsigned;
constexpr int QBLK = 32, KVBLK = 64, NW = 8;
constexpr int SHM_V = KVBLK * 128 * 2, SHM_K = KVBLK * 128 * 2, SHM_ATTN = 2 * SHM_V + 2 * SHM_K + NW * 64 * 4;
constexpr float LOG2E = 1.4426950408889634f, THR = 8.0f, NEGS = -1.0e30f;
#define FA_KSWZ(row, colB) ((row) * 256 + ((colB) ^ (((row) & 7) << 4)))
#define FA_SBAR() __builtin_amdgcn_sched_barrier(0)
__device__ __forceinline__ int crow(int r, int hi) { return (r & 3) + 8 * (r >> 2) + 4 * hi; }
__device__ __forceinline__ unsigned cvtpk(float lo, float hi) { unsigned r; asm volatile("v_cvt_pk_bf16_f32 %0, %1, %2" : "=v"(r) : "v"(lo), "v"(hi)); return r; }
__device__ __forceinline__ void partialSM(f32x16& p0, f32x16& p1, float& m_reg, float& mn, float& alpha) {
  float pmax = p0[0];
#pragma unroll
  for (int r = 1; r < 16; ++r) pmax = fmaxf(pmax, p0[r]);
#pragma unroll
  for (int r = 0; r < 16; ++r) pmax = fmaxf(pmax, p1[r]);
  { auto rr = __builtin_amdgcn_permlane32_swap(__float_as_uint(pmax), __float_as_uint(pmax), false, false);
    pmax = fmaxf(__uint_as_float(rr[0]), __uint_as_float(rr[1])); }
  if (__builtin_expect(__all(pmax - m_reg <= THR), 1)) { mn = m_reg; alpha = 1.f; }
  else { mn = fmaxf(m_reg, pmax); alpha = __builtin_amdgcn_exp2f((m_reg - mn) * LOG2E); m_reg = mn; }
  const float mnC = -mn * LOG2E;
#pragma unroll
  for (int r = 0; r < 16; ++r) p0[r] = fmaf(p0[r], LOG2E, mnC);
#pragma unroll
  for (int r = 0; r < 16; ++r) p1[r] = fmaf(p1[r], LOG2E, mnC);
#pragma unroll
  for (int r = 0; r < 16; ++r) p0[r] = __builtin_amdgcn_exp2f(p0[r]);
}
__device__ __forceinline__ void finishSM(f32x16& p0, f32x16& p1, float alpha, float& l_reg, bf16x8& pa0, bf16x8& pa1, bf16x8& pa2, bf16x8& pa3) {
#pragma unroll
  for (int r = 0; r < 16; ++r) p1[r] = __builtin_amdgcn_exp2f(p1[r]);
  float ps = 0;
#pragma unroll
  for (int r = 0; r < 16; ++r) ps += p0[r];
#pragma unroll
  for (int r = 0; r < 16; ++r) ps += p1[r];
  { auto rr = __builtin_amdgcn_permlane32_swap(__float_as_uint(ps), __float_as_uint(ps), false, false);
    ps = __uint_as_float(rr[0]) + __uint_as_float(rr[1]); }
  l_reg = l_reg * alpha + ps;
#define FA_PK4(P, BASE, OUT) do { unsigned a0 = cvtpk(P[BASE + 0], P[BASE + 1]), a1 = cvtpk(P[BASE + 2], P[BASE + 3]);   \
    unsigned b0 = cvtpk(P[BASE + 4], P[BASE + 5]), b1 = cvtpk(P[BASE + 6], P[BASE + 7]);                              \
    auto r0 = __builtin_amdgcn_permlane32_swap(a0, b0, false, false); auto r1 = __builtin_amdgcn_permlane32_swap(a1, b1, false, false); \
    u32x4 w = {r0[0], r1[0], r0[1], r1[1]}; OUT = *reinterpret_cast<bf16x8*>(&w); } while (0)
  FA_PK4(p0, 0, pa0); FA_PK4(p0, 8, pa1); FA_PK4(p1, 0, pa2); FA_PK4(p1, 8, pa3);
#undef FA_PK4
}
template <int NQ> __device__ __forceinline__ void qkt(f32x16& p0, f32x16& p1, const char* Ks, const bf16x8* qr, int r32, int hi) {
  p0 = f32x16{}; p1 = f32x16{};
#pragma unroll
  for (int d0 = 0; d0 < NQ; ++d0) { const int cb = (d0 * 16 + hi * 8) * 2;
    const bf16x8 b0 = *reinterpret_cast<const bf16x8*>(Ks + FA_KSWZ(r32, cb));
    const bf16x8 b1 = *reinterpret_cast<const bf16x8*>(Ks + FA_KSWZ(32 + r32, cb));
    p0 = __builtin_amdgcn_mfma_f32_32x32x16_bf16(b0, qr[d0], p0, 0, 0, 0);
    p1 = __builtin_amdgcn_mfma_f32_32x32x16_bf16(b1, qr[d0], p1, 0, 0, 0); }
}
__device__ __forceinline__ int v_st(int k, int c) { const int kk = (k & ~0xC) | ((k & 4) << 1) | ((k & 8) >> 1); return ((kk >> 3) * 4 + (c >> 5)) * 512 + ((kk & 7) * 32 + (c & 31)) * 2; }
__device__ __forceinline__ int v_rd_base(int lane) { return ((lane & 3) << 3) | (((lane >> 2) & 3) << 6) | (((lane >> 4) & 1) << 5) | (((lane >> 5) & 1) << 8); }
constexpr int v_rd_off(int d0, int ks, int half) { return d0 * 512 + ks * 4096 + half * 2048; }
template <int OFF> __device__ __forceinline__ s16x4 tr_read(int vb) {
  s16x4 r; asm volatile("ds_read_b64_tr_b16 %0, %1 offset:%2" : "=&v"(r) : "v"(vb), "i"(OFF) : "memory"); return r;
}
template <int D0> __device__ __forceinline__ void pv_one(f32x16& od, int vb, bf16x8 pa0, bf16x8 pa1, bf16x8 pa2, bf16x8 pa3) {
  const s16x4 l0 = tr_read<v_rd_off(D0, 0, 0)>(vb), h0 = tr_read<v_rd_off(D0, 0, 1)>(vb), l1 = tr_read<v_rd_off(D0, 1, 0)>(vb), h1 = tr_read<v_rd_off(D0, 1, 1)>(vb);
  const s16x4 l2 = tr_read<v_rd_off(D0, 2, 0)>(vb), h2 = tr_read<v_rd_off(D0, 2, 1)>(vb), l3 = tr_read<v_rd_off(D0, 3, 0)>(vb), h3 = tr_read<v_rd_off(D0, 3, 1)>(vb);
  asm volatile("s_waitcnt lgkmcnt(0)" ::: "memory"); FA_SBAR();
#define FA_PK(L, H) (bf16x8){L[0], L[1], L[2], L[3], H[0], H[1], H[2], H[3]}
  od = __builtin_amdgcn_mfma_f32_32x32x16_bf16(pa0, FA_PK(l0, h0), od, 0, 0, 0);
  od = __builtin_amdgcn_mfma_f32_32x32x16_bf16(pa1, FA_PK(l1, h1), od, 0, 0, 0);
  od = __builtin_amdgcn_mfma_f32_32x32x16_bf16(pa2, FA_PK(l2, h2), od, 0, 0, 0);
  od = __builtin_amdgcn_mfma_f32_32x32x16_bf16(pa3, FA_PK(l3, h3), od, 0, 0, 0);
#undef FA_PK
}
template <int NV> __device__ __forceinline__ void pv_all(f32x16* o, int vb, bf16x8 pa0, bf16x8 pa1, bf16x8 pa2, bf16x8 pa3) {
  pv_one<0>(o[0], vb, pa0, pa1, pa2, pa3); pv_one<1>(o[1], vb, pa0, pa1, pa2, pa3);
  if constexpr (NV == 4) { pv_one<2>(o[2], vb, pa0, pa1, pa2, pa3); pv_one<3>(o[3], vb, pa0, pa1, pa2, pa3); }
}
__device__ __forceinline__ void wmask(f32x16& p0, f32x16& p1, int dq4) {
#pragma unroll
  for (int r = 0; r < 16; ++r) { const int d = dq4 + (r & 3) + 8 * (r >> 2); if ((unsigned)(d + 128) > 256u) p0[r] = NEGS; if ((unsigned)(d + 32 + 128) > 256u) p1[r] = NEGS; }
}

struct Unit {
  const bf16_t* Q; const bf16_t* K; const bf16_t* V; bf16_t* O;
  int rowa, nta, rowb, ntb;
  int window, qpos0, kposb0;
  float sink; int has_sink;
  const bf16_t* K2;
  const float* tab; int pos0;
  const float* qg;
};
template <int DQ, int DV, int LDQ, int LDK, int LDV, int LDO, bool WIN, int RD0, int RH, bool QNORM, bool KSPLIT, bool O8>
__device__ __forceinline__ void attn_unit(const int tid, const Unit& U, char* lds) {
  constexpr int NQ = DQ / 16, NV = DV / 32;
  const int wid = tid >> 6, lane = tid & 63, r32 = lane & 31, hi = lane >> 5;
  char* V_lds = lds; char* K_lds = lds + 2 * SHM_V;
  float* ws = (float*)(lds + 2 * SHM_V + 2 * SHM_K) + wid * 64; float* li_l = ws; float* al_l = ws + 32;
  float m_reg = -1e30f, l_reg = 0; f32x16 o[NV]; bf16x8 qr[NQ];
#pragma unroll
  for (int d = 0; d < NV; ++d) o[d] = f32x16{};
  const bf16_t* Qw = U.Q + (size_t)(wid * QBLK + r32) * LDQ + hi * 8;
#pragma unroll
  for (int d0 = 0; d0 < NQ; ++d0) qr[d0] = *reinterpret_cast<const bf16x8*>(Qw + d0 * 16);
  if constexpr (QNORM || RH > 0) {
    float qf[NQ][8];
#pragma unroll
    for (int d0 = 0; d0 < NQ; ++d0)
#pragma unroll
      for (int j = 0; j < 8; ++j) qf[d0][j] = __uint_as_float(((unsigned)(unsigned short)qr[d0][j]) << 16);
    if constexpr (QNORM) {
      float ss = 0.f;
#pragma unroll
      for (int d0 = 0; d0 < NQ; ++d0)
#pragma unroll
        for (int j = 0; j < 8; ++j) ss = fmaf(qf[d0][j], qf[d0][j], ss);
      { auto rr = __builtin_amdgcn_permlane32_swap(__float_as_uint(ss), __float_as_uint(ss), false, false); ss = __uint_as_float(rr[0]) + __uint_as_float(rr[1]); }
      const float ri = 1.0f / sqrtf(ss * (1.0f / DQ) + 1e-6f);
#pragma unroll
      for (int d0 = 0; d0 < NQ; ++d0) { const float4 g0 = *(const float4*)(U.qg + 16 * d0 + 8 * hi), g1 = *(const float4*)(U.qg + 16 * d0 + 8 * hi + 4);
        qf[d0][0] *= ri * g0.x; qf[d0][1] *= ri * g0.y; qf[d0][2] *= ri * g0.z; qf[d0][3] *= ri * g0.w; qf[d0][4] *= ri * g1.x; qf[d0][5] *= ri * g1.y; qf[d0][6] *= ri * g1.z; qf[d0][7] *= ri * g1.w; }
    }
    if constexpr (RH > 0) { if (U.tab) {
      const float4* tb = (const float4*)(U.tab + ((size_t)(U.pos0 + wid * QBLK + r32) * (RH * 16) + 8 * hi) * 2);
#pragma unroll
      for (int dd = 0; dd < RH; ++dd) {
#pragma unroll
        for (int j2 = 0; j2 < 4; ++j2) { const float4 t = tb[dd * 8 + j2];
          { const float x1 = qf[RD0 + dd][2 * j2], x2 = qf[RD0 + RH + dd][2 * j2]; qf[RD0 + dd][2 * j2] = x1 * t.x - x2 * t.y; qf[RD0 + RH + dd][2 * j2] = x2 * t.x + x1 * t.y; }
          { const float x1 = qf[RD0 + dd][2 * j2 + 1], x2 = qf[RD0 + RH + dd][2 * j2 + 1]; qf[RD0 + dd][2 * j2 + 1] = x1 * t.z - x2 * t.w; qf[RD0 + RH + dd][2 * j2 + 1] = x2 * t.z + x1 * t.w; } } } } }
#pragma unroll
    for (int d0 = 0; d0 < NQ; ++d0) { u32x4 w = {cvtpk(qf[d0][0], qf[d0][1]), cvtpk(qf[d0][2], qf[d0][3]), cvtpk(qf[d0][4], qf[d0][5]), cvtpk(qf[d0][6], qf[d0][7])}; qr[d0] = *reinterpret_cast<bf16x8*>(&w); }
  }
  const int sr = tid >> 4, sc = (tid & 15) * 8, vst0 = v_st(sr, sc), vst1 = v_st(32 + sr, sc);
  const int sck = sc < DQ - 8 ? sc : DQ - 8, scv = sc < DV - 8 ? sc : DV - 8;
  const int vb0 = (int)(uintptr_t)V_lds + v_rd_base(lane);
  const int nta = U.nta, NT = U.nta + U.ntb;
  const unsigned kof0 = (unsigned)((sr * LDK + sck) * 2), kof1 = kof0 + 32u * LDK * 2u, vof0 = (unsigned)((sr * LDV + scv) * 2), vof1 = vof0 + 32u * LDV * 2u;
  constexpr int LDK2 = 1536;
  const int ci = tid & 15; const bool ksec = KSPLIT && ci >= 8; const int kld = ksec ? LDK2 : LDK;
  const bf16_t* kp0 = ksec ? U.K2 + (size_t)sr * LDK2 + ((ci < 11 ? ci : 11) - 8) * 8 : U.K + (size_t)sr * LDK + ci * 8; const bf16_t* kp1 = kp0 + (size_t)32 * kld;
  (void)kof0; (void)kof1; (void)kp0; (void)kp1; (void)kld;
  struct { bf16x8 vs0, vs1, ks0, ks1; } sr_[2];
#define FA_KROW(j) ((j) < nta ? U.rowa + (j) * KVBLK : U.rowb + ((j) - nta) * KVBLK)
#define FA_SLOAD(i, j) do { const size_t k0_ = (size_t)(FA_KROW(j)); const char* kt_ = (const char*)U.K + k0_ * (LDK * 2); const char* vt_ = (const char*)U.V + k0_ * (LDV * 2); \
    sr_[i].vs0 = *reinterpret_cast<const bf16x8*>(vt_ + vof0); sr_[i].vs1 = *reinterpret_cast<const bf16x8*>(vt_ + vof1); \
    if constexpr (KSPLIT) { sr_[i].ks0 = *reinterpret_cast<const bf16x8*>(kp0 + k0_ * kld); sr_[i].ks1 = *reinterpret_cast<const bf16x8*>(kp1 + k0_ * kld); } \
    else { sr_[i].ks0 = *reinterpret_cast<const bf16x8*>(kt_ + kof0); sr_[i].ks1 = *reinterpret_cast<const bf16x8*>(kt_ + kof1); } } while (0)
#define FA_SWRITE(b, i) do { *(bf16x8*)(V_lds + (b) * SHM_V + vst0) = sr_[i].vs0; *(bf16x8*)(V_lds + (b) * SHM_V + vst1) = sr_[i].vs1; const int kc = sc * 2; \
    *(bf16x8*)(K_lds + (b) * SHM_K + FA_KSWZ(sr, kc)) = sr_[i].ks0; *(bf16x8*)(K_lds + (b) * SHM_K + FA_KSWZ(32 + sr, kc)) = sr_[i].ks1; } while (0)
#define FA_SWAIT() asm volatile("s_waitcnt vmcnt(4)" ::: "memory")
#define FA_RESC(a) do { if (__any((a) < 1.f)) { if (hi == 0) al_l[r32] = (a); asm volatile("s_waitcnt lgkmcnt(0)" ::: "memory"); \
    _Pragma("unroll") for (int d = 0; d < NV; ++d) _Pragma("unroll") for (int r = 0; r < 16; ++r) o[d][r] *= al_l[crow(r, hi)]; } } while (0)
  const int qw0 = U.qpos0 + wid * QBLK;
#define FA_MASK(P0, P1, t) do { if (WIN && U.window && (t) >= nta) { const int kb_ = U.kposb0 + ((t) - nta) * KVBLK; \
    if (kb_ + 63 - qw0 > 128 || qw0 + 31 - kb_ > 128) wmask(P0, P1, kb_ - (qw0 + r32) + 4 * hi); } } while (0)
  f32x16 pA0, pA1, pB0, pB1; float mnA, mnB, alA, alB; bf16x8 pa0, pa1, pa2, pa3;
  constexpr int SE = 0, SO = 1;
  FA_SLOAD(SE, 0); asm volatile("s_waitcnt vmcnt(0)" ::: "memory"); FA_SWRITE(0, SE); __syncthreads();
  qkt<NQ>(pA0, pA1, K_lds, qr, r32, hi); FA_MASK(pA0, pA1, 0); partialSM(pA0, pA1, m_reg, mnA, alA);
  FA_SLOAD(SO, 1); if (2 < NT) FA_SLOAD(SE, 2);
  FA_SWAIT(); FA_SWRITE(1, SO); __syncthreads();
  for (int j = 1; j + 1 < NT; j += 2) {
    FA_SBAR(); qkt<NQ>(pB0, pB1, K_lds + SHM_K, qr, r32, hi);
    finishSM(pA0, pA1, alA, l_reg, pa0, pa1, pa2, pa3); FA_SBAR();
    FA_SLOAD(SO, j + 2); FA_SBAR();
    pv_all<NV>(o, vb0, pa0, pa1, pa2, pa3); FA_MASK(pB0, pB1, j); partialSM(pB0, pB1, m_reg, mnB, alB);
    __syncthreads(); FA_SWAIT(); FA_SWRITE(0, SE);
    FA_RESC(alB); __syncthreads();
    FA_SBAR(); qkt<NQ>(pA0, pA1, K_lds, qr, r32, hi);
    finishSM(pB0, pB1, alB, l_reg, pa0, pa1, pa2, pa3); FA_SBAR();
    if (j + 3 < NT) FA_SLOAD(SE, j + 3); FA_SBAR();
    pv_all<NV>(o, vb0 + SHM_V, pa0, pa1, pa2, pa3); FA_MASK(pA0, pA1, j + 1); partialSM(pA0, pA1, m_reg, mnA, alA);
    __syncthreads(); FA_SWAIT(); FA_SWRITE(1, SO);
    FA_RESC(alA); __syncthreads();
  }
  FA_SBAR(); qkt<NQ>(pB0, pB1, K_lds + SHM_K, qr, r32, hi);
  finishSM(pA0, pA1, alA, l_reg, pa0, pa1, pa2, pa3); FA_SBAR();
  pv_all<NV>(o, vb0, pa0, pa1, pa2, pa3); FA_MASK(pB0, pB1, NT - 1); partialSM(pB0, pB1, m_reg, mnB, alB);
  __syncthreads(); FA_RESC(alB);
  finishSM(pB0, pB1, alB, l_reg, pa0, pa1, pa2, pa3); FA_SBAR();
  pv_all<NV>(o, vb0 + SHM_V, pa0, pa1, pa2, pa3);
  if (U.has_sink) l_reg += __builtin_amdgcn_exp2f((U.sink - m_reg) * LOG2E);
  if (hi == 0) li_l[r32] = l_reg;
  asm volatile("s_waitcnt lgkmcnt(0)" ::: "memory");
  __syncthreads();
  int lane2 = lane; asm volatile("" : "+v"(lane2));
  const int r32e = lane2 & 31, hie = lane2 >> 5;
  if constexpr (O8) {
    unsigned char* stg = (unsigned char*)(lds + wid * 8192);
    unsigned char* stw = stg + hie * 4 * DV + r32e;
#pragma unroll
    for (int r = 0; r < 16; ++r) { const int orow0 = (r & 3) + 8 * (r >> 2); const float rl = __builtin_amdgcn_rcpf(li_l[orow0 + 4 * hie]);
#pragma unroll
      for (int d0 = 0; d0 < NV; ++d0) stw[orow0 * DV + d0 * 32] = (unsigned char)(__builtin_amdgcn_cvt_pk_fp8_f32(o[d0][r] * rl, 0.f, 0, false) & 0xff); }
    asm volatile("s_waitcnt lgkmcnt(0)" ::: "memory");
    constexpr int CPR = DV / 16, RPI = 64 / CPR;
    const int erow = lane2 / CPR, ech = lane2 % CPR;
    unsigned char* Ow = (unsigned char*)U.O + (size_t)(wid * QBLK + erow) * LDO + ech * 16; const unsigned char* str = stg + erow * DV + ech * 16;
#pragma unroll
    for (int i = 0; i < 32 / RPI; ++i) { const u32x4 v = *(const u32x4*)(str + i * RPI * DV); *(u32x4*)(Ow + (size_t)(i * RPI) * LDO) = v; }
  } else {
  bf16_t* stg = (bf16_t*)(lds + wid * 8192);
  bf16_t* stw = stg + hie * 4 * DV + r32e;
#pragma unroll
  for (int r = 0; r < 16; ++r) { const int orow0 = (r & 3) + 8 * (r >> 2); const float rl = __builtin_amdgcn_rcpf(li_l[orow0 + 4 * hie]);
#pragma unroll
    for (int d0 = 0; d0 < NV; ++d0) stw[orow0 * DV + d0 * 32] = f2bf(o[d0][r] * rl); }
  asm volatile("s_waitcnt lgkmcnt(0)" ::: "memory");
  constexpr int CPR = DV / 8, RPI = 64 / CPR;
  const int erow = lane2 / CPR, ech = lane2 % CPR;
  bf16_t* Ow = U.O + (size_t)(wid * QBLK + erow) * LDO + ech * 8; const bf16_t* str = stg + erow * DV + ech * 8;
#pragma unroll
  for (int i = 0; i < 32 / RPI; ++i) { const u32x4 v = *(const u32x4*)(str + i * RPI * DV); *(u32x4*)(Ow + (size_t)(i * RPI) * LDO) = v; }
  }
  __syncthreads();
#undef FA_KROW
#undef FA_SLOAD
#undef FA_SWRITE
#undef FA_SWAIT
#undef FA_RESC
#undef FA_MASK
}
}

__device__ __forceinline__ void route_reduce(const float (&acc)[32], const int lane, const int el, const float rb, float (&tv)[4], int (&ti)[4]) {
    float a16[16], a8[8], a4[4], a2[2];
#pragma unroll
    for (int k = 0; k < 16; ++k) { const bool up = (lane & 32) != 0; const float keep = up ? acc[k + 16] : acc[k], send = up ? acc[k] : acc[k + 16]; a16[k] = keep + __shfl_xor(send, 32); }
#pragma unroll
    for (int k = 0; k < 8; ++k) { const bool up = (lane & 16) != 0; const float keep = up ? a16[k + 8] : a16[k], send = up ? a16[k] : a16[k + 8]; a8[k] = keep + __shfl_xor(send, 16); }
#pragma unroll
    for (int k = 0; k < 4; ++k) { const bool up = (lane & 8) != 0; const float keep = up ? a8[k + 4] : a8[k], send = up ? a8[k] : a8[k + 4]; a4[k] = keep + __shfl_xor(send, 8); }
#pragma unroll
    for (int k = 0; k < 2; ++k) { const bool up = (lane & 4) != 0; const float keep = up ? a4[k + 2] : a4[k], send = up ? a4[k] : a4[k + 2]; a2[k] = keep + __shfl_xor(send, 4); }
    float lg; { const bool up = (lane & 2) != 0; const float keep = up ? a2[1] : a2[0], send = up ? a2[0] : a2[1]; lg = keep + __shfl_xor(send, 2); }
    lg += __shfl_xor(lg, 1); lg += rb;
    unsigned key; { const unsigned u = __float_as_uint(lg); const unsigned ou = (u & 0x80000000u) ? ~u : (u | 0x80000000u); key = (ou & ~31u) | (unsigned)(31 - el); }
#pragma unroll
    for (int k = 0; k < 4; ++k) { unsigned bk = key;
#pragma unroll
        for (int o = 1; o < 64; o <<= 1) { const unsigned ok = (unsigned)__shfl_xor((int)bk, o); bk = ok > bk ? ok : bk; }
        const int bi = 31 - (int)(bk & 31u); const unsigned ou = bk & ~31u; const unsigned ub = (ou & 0x80000000u) ? (ou ^ 0x80000000u) : ~ou;
        tv[k] = __uint_as_float(ub); ti[k] = bi; if (el == bi) key = 0u; }
}

template <int CTRL> __device__ __forceinline__ float dpp_f32(const float x) { return __builtin_bit_cast(float, __builtin_amdgcn_update_dpp(0, __builtin_bit_cast(int, x), CTRL, 0xf, 0xf, true)); }
template <int CTRL> __device__ __forceinline__ unsigned dpp_u32(const unsigned x) { return (unsigned)__builtin_amdgcn_update_dpp(0, (int)x, CTRL, 0xf, 0xf, true); }
template <int M> __device__ __forceinline__ float xlane_f32(const float x) {
    if constexpr (M == 1) return dpp_f32<0xB1>(x);
    else if constexpr (M == 2) return dpp_f32<0x4E>(x);
    else if constexpr (M == 4) return dpp_f32<0x1B>(dpp_f32<0x141>(x));
    else return dpp_f32<0x128>(x);
}
template <int M> __device__ __forceinline__ unsigned xlane_u32(const unsigned x) {
    if constexpr (M == 1) return dpp_u32<0xB1>(x);
    else if constexpr (M == 2) return dpp_u32<0x4E>(x);
    else if constexpr (M == 4) return dpp_u32<0x1B>(dpp_u32<0x141>(x));
    else return dpp_u32<0x128>(x);
}
typedef unsigned u32x2_t __attribute__((ext_vector_type(2)));
__device__ __forceinline__ float half_sum32(float v) {
    v += xlane_f32<1>(v); v += xlane_f32<2>(v); v += xlane_f32<4>(v); v += xlane_f32<8>(v);
    const u32x2_t r = __builtin_amdgcn_permlane16_swap(__float_as_uint(v), __float_as_uint(v), false, false);
    return __uint_as_float(r[0]) + __uint_as_float(r[1]);
}
__device__ __forceinline__ void route_reduce32(const float (&acc)[32], const int l5, const float rb, float (&tv)[4], int (&ti)[4]) {
    float a16[16], a8[8], a4[4], a2[2];
#pragma unroll
    for (int k = 0; k < 16; ++k) { const u32x2_t r = __builtin_amdgcn_permlane16_swap(__float_as_uint(acc[k]), __float_as_uint(acc[k + 16]), false, false); a16[k] = __uint_as_float(r[0]) + __uint_as_float(r[1]); }
#pragma unroll
    for (int k = 0; k < 8; ++k) { const bool up = (l5 & 8) != 0; const float keep = up ? a16[k + 8] : a16[k], send = up ? a16[k] : a16[k + 8]; a8[k] = keep + xlane_f32<8>(send); }
#pragma unroll
    for (int k = 0; k < 4; ++k) { const bool up = (l5 & 4) != 0; const float keep = up ? a8[k + 4] : a8[k], send = up ? a8[k] : a8[k + 4]; a4[k] = keep + xlane_f32<4>(send); }
#pragma unroll
    for (int k = 0; k < 2; ++k) { const bool up = (l5 & 2) != 0; const float keep = up ? a4[k + 2] : a4[k], send = up ? a4[k] : a4[k + 2]; a2[k] = keep + xlane_f32<2>(send); }
    float lg; { const bool up = (l5 & 1) != 0; const float keep = up ? a2[1] : a2[0], send = up ? a2[0] : a2[1]; lg = keep + xlane_f32<1>(send); }
    lg += rb;
    unsigned key; { const unsigned u = __float_as_uint(lg); const unsigned ou = (u & 0x80000000u) ? ~u : (u | 0x80000000u); key = (ou & ~31u) | (unsigned)(31 - l5); }
#pragma unroll
    for (int k = 0; k < 4; ++k) { unsigned bk = key;
        { const unsigned ok = xlane_u32<1>(bk); bk = ok > bk ? ok : bk; } { const unsigned ok = xlane_u32<2>(bk); bk = ok > bk ? ok : bk; }
        { const unsigned ok = xlane_u32<4>(bk); bk = ok > bk ? ok : bk; } { const unsigned ok = xlane_u32<8>(bk); bk = ok > bk ? ok : bk; }
        { const u32x2_t r = __builtin_amdgcn_permlane16_swap(bk, bk, false, false); bk = r[0] > r[1] ? r[0] : r[1]; }
        const int bi = 31 - (int)(bk & 31u); const unsigned ou = bk & ~31u; const unsigned ub = (ou & 0x80000000u) ? (ou ^ 0x80000000u) : ~ou;
        tv[k] = __uint_as_float(ub); ti[k] = bi; if (l5 == bi) key = 0u; }
}

struct Params {
    const float *x, *c, *ctx, *c_ctx, *ada_w, *ada_b, *norm_mix_g, *norm_ffn_g, *ab_w_in, *mla_q_g, *mla_wq_b, *mla_kv_g, *mla_wkv_b, *swa_sink, *ab_w_out,
        *c_w_in, *c_q_g, *c_k_g, *c_w_out, *router_w, *router_b, *moe_w_in, *moe_b_in, *moe_w_out, *moe_b_out, *final_g;
    float* out; unsigned char* ws; int ph_lo, ph_hi;
};
__device__ __forceinline__ int mod_row_of(int r) { return r < NLAT ? r / SEQ : NB; }
__device__ __forceinline__ float rope_angle(int i, int quarter, int prow, int pcol) {
    const int ii = i < quarter ? i : i - quarter; const float inv = powf(10000.f, -(float)ii / (float)quarter);
    return (float)(i < quarter ? prow : pcol) * inv;
}

#ifndef OUTPROJ_F8
#define OUTPROJ_F8 1
#endif
#ifndef Y8_L1
#define Y8_L1 1
#endif
#ifndef Y8_L0
#define Y8_L0 1
#endif
#ifndef INPROJ_F8
#define INPROJ_F8 1
#endif
#ifndef MOE_F8_DOWN
#define MOE_F8_DOWN 1
#endif
#ifndef MOE_F8_L0
#define MOE_F8_L0 1
#endif
#ifndef MOE_F8_L1
#define MOE_F8_L1 1
#endif
constexpr int LDS_BYTES = 147456;
constexpr int LDS_MISC = 143360;
constexpr int N_PHASES = 21;

__global__ void __launch_bounds__(NTHR, 2) fwd_kernel(Params p) {
    extern __shared__ __attribute__((aligned(16))) unsigned char lds_raw[];
    float* ldsf = (float*)lds_raw;
    LAS unsigned* misc = (LAS unsigned*)(lds_raw + LDS_MISC + 320);
    const int wave0 = __builtin_amdgcn_readfirstlane((int)(threadIdx.x >> 6));
    const int G = gridDim.x, bid = blockIdx.x;
    const int NGW = G * 8;
    unsigned* ctl0 = (unsigned*)(p.ws + WS_CTL);
#define PHASE_PTRS \
    int tid = wave0 * 64 + (int)__builtin_amdgcn_mbcnt_hi(~0u, __builtin_amdgcn_mbcnt_lo(~0u, 0u)); asm volatile("" : "+v"(tid)); const int lane = tid & 63, wave = tid >> 6, gw = bid * 8 + wave; (void)lane; (void)gw; \
    size_t wsz_ = 0; asm volatile("" : "+s"(wsz_)); unsigned char* ws = p.ws + wsz_; \
    unsigned* ctl = (unsigned*)(ws + WS_CTL); (void)ctl; \
    float* MOD = (float*)(ws + WS_MOD); (void)MOD; \
    int* TOKE = (int*)(ws + WS_TOKE); int* TOKP = (int*)(ws + WS_TOKP); float* TOKG = (float*)(ws + WS_TOKG); (void)TOKE; (void)TOKP; (void)TOKG; \
    float* RINV = (float*)(ws + WS_RINV); (void)RINV; unsigned char* tabs = ws + WS_TAB; (void)tabs; \
    xr_t* XR = (xr_t*)(ws + WS_XR); (void)XR; \
    act_t* H = (act_t*)(ws + WS_H); (void)H; \
    unsigned char* big = ws + WS_BIG; \
    act_t* PRJ = (act_t*)(big + OFF_PRJ); act_t* QB = (act_t*)(big + OFF_QB); act_t* KVB = (act_t*)(big + OFF_KVB); act_t* OB = (act_t*)(big + OFF_O); (void)PRJ; (void)QB; (void)KVB; (void)OB; \
    act_t* Y = (act_t*)big; act_t* ACT = (act_t*)(ws + WS_ACT); act_t* XS = (act_t*)(ws + WS_XS); unsigned char* wts = ws + WS_W; (void)Y; (void)ACT; (void)XS; (void)wts;

    if (threadIdx.x < 32) misc[threadIdx.x] = 0u;
    __syncthreads();
    XcdBarrier bar = xcd_barrier_post(ctl0 + CW_BAR, (volatile LAS unsigned*)(misc + 8), wave0);
    const int lo = p.ph_lo, hi = p.ph_hi;
#ifndef PHASE_MASK
#define PHASE_MASK 0x1FFFFFu
#endif
#define IN(k) ((((PHASE_MASK) >> (k)) & 1u) && lo <= (k) && (k) < hi)
#define SEAM(k) do { if (IN(k) && IN((k) + 1)) xcd_barrier(bar, wave0); } while (0)
#define LDSB ((LAS unsigned char*)lds_raw)

    if (IN(0)) { PHASE_PTRS
        {   LAS float* scr = (LAS float*)(LDSB + wave * 16640);
            constexpr int I_AB = 16 * 45  , I_QB = 6 * 12, I_KVB = 4 * 16, I_ABO = 16 * 16, I_C = 16 * 24, I_CO = 16 * 16, I_W1 = 16 * 32, I_W2 = 16 * 16;
            constexpr int T_W1 = 64 * I_W1, T_W2 = 64 * I_W2, T_ALL = T_W1 + T_W2 + I_AB + I_QB + I_KVB + I_ABO + I_C + I_CO;
            for (int it = gw; it < T_ALL; it += NGW) {
                int r = it;
                if (r < T_W1) { const int mi = r / I_W1; const float* src = p.moe_w_in + (size_t)mi * 1024 * 2048;
                    if ((mi >= 32 && MOE_F8_L1) || (mi < 32 && MOE_F8_L0)) transpose_item64<true>(src, 1024, 2048, (unsigned char*)(wts + WO_W1) + (size_t)(mi >> 5) * 32 * 2048 * 1024 * 2 + (size_t)(mi & 31) * 2048 * 1024, scr, r % I_W1, lane);
                    else transpose_item64<false>(src, 1024, 2048, (bf16_t*)(wts + WO_W1) + (size_t)mi * 2048 * 1024, scr, r % I_W1, lane);
                    continue; } r -= T_W1;
                if (r < T_W2) { const int mi = r / I_W2; const float* src = p.moe_w_out + (size_t)mi * 1024 * 1024;
                    if (MOE_F8_DOWN && ((mi >= 32 && MOE_F8_L1) || (mi < 32 && MOE_F8_L0))) transpose_item64<true>(src, 1024, 1024, (unsigned char*)(wts + WO_W2) + (size_t)(mi >> 5) * 32 * 1024 * 1024 * 2 + (size_t)(mi & 31) * 1024 * 1024, scr, r % I_W2, lane);
                    else transpose_item64<false>(src, 1024, 1024, (bf16_t*)(wts + WO_W2) + (size_t)mi * 1024 * 1024, scr, r % I_W2, lane);
                    continue; } r -= T_W2;
                if (r < I_AB) { if (INPROJ_F8) transpose_item_f8(p.ab_w_in, 1024, AB_IN, (unsigned char*)(wts + WO_AB), scr, r, lane, 0.125f, 512);
                    else transpose_item(p.ab_w_in, 1024, AB_IN, (bf16_t*)(wts + WO_AB), scr, r, lane, nullptr, 0.125f, 512); continue; } r -= I_AB;
                if (r < I_QB) { transpose_item64<false>(p.mla_wq_b, 384, 768, (bf16_t*)(wts + WO_QB), scr, r, lane, p.mla_q_g, 0.10206207261596575f); continue; } r -= I_QB;
                if (r < I_KVB) { transpose_item64<false>(p.mla_wkv_b, 256, 1024, (bf16_t*)(wts + WO_KVB), scr, r, lane, p.mla_kv_g, 1.0f); continue; } r -= I_KVB;
                if (r < I_ABO) { if (OUTPROJ_F8) transpose_item64<true>(p.ab_w_out, 1024, 1024, (unsigned char*)(wts + WO_ABO), scr, r, lane); else transpose_item64<false>(p.ab_w_out, 1024, 1024, (bf16_t*)(wts + WO_ABO), scr, r, lane); continue; } r -= I_ABO;
                if (r < I_C) { if (INPROJ_F8) transpose_item64<true>(p.c_w_in, 1024, C_IN, (unsigned char*)(wts + WO_C), scr, r, lane); else transpose_item64<false>(p.c_w_in, 1024, C_IN, (bf16_t*)(wts + WO_C), scr, r, lane); continue; } r -= I_C;
                if (OUTPROJ_F8) transpose_item64<true>(p.c_w_out, 1024, 1024, (unsigned char*)(wts + WO_CO), scr, r, lane); else transpose_item64<false>(p.c_w_out, 1024, 1024, (bf16_t*)(wts + WO_CO), scr, r, lane);
            }
            uint4* z = (uint4*)((unsigned char*)(wts + WO_AB) + (size_t)AB_IN * 1024 * (INPROJ_F8 ? 1 : 2));
            for (int i = gw * 64 + lane; i < 96 * 1024 * (INPROJ_F8 ? 1 : 2) / 16; i += NGW * 64) z[i] = make_uint4(0u, 0u, 0u, 0u);
        }
        {
            float2* TA = (float2*)(tabs + TAB_A); float2* TB = (float2*)(tabs + TAB_B); float2* TC = (float2*)(tabs + TAB_C);
            for (int e = bid * NTHR + tid; e < SEQ * 112; e += G * NTHR) { const int s = e / 112, i = e % 112, prow = s / GRIDW, pcol = s % GRIDW;
                int quarter, ii; float2* dst;
                if (i < 32) { quarter = 16; ii = i; dst = TA + s * 32 + ii; } else if (i < 48) { quarter = 8; ii = i - 32; dst = TB + s * 16 + ii; } else { quarter = 32; ii = i - 48; dst = TC + s * 64 + ii; }
                const float ang = rope_angle(ii, quarter, prow, pcol); *dst = make_float2(cosf(ang), sinf(ang)); }
            if (bid == 0 && tid < 128) ((float*)(tabs + TAB_QG))[tid] = p.c_q_g[tid] * 0.08838834764831845f;
        }
        __syncthreads();
        float* ca = ldsf;
        float* red = ldsf + 17 * 1024;
        {   float cv[34];
#pragma unroll
            for (int j = 0; j < 34; ++j) cv[j] = j < 2 * NB ? p.c[j * NTHR + tid] : p.c_ctx[(j - 2 * NB) * NTHR + tid];
#pragma unroll
            for (int j = 0; j < 34; ++j) ca[j * NTHR + tid] = cv[j] / (1.f + expf(-cv[j])); }
        __syncthreads();
        for (int blk = bid; blk < 2 * 6144 / 64; blk += G) {
            typedef float f4m_ __attribute__((ext_vector_type(4)));
            const int l = blk / 96, ks = wave, kr = lane >> 4, c4 = (lane & 15) * 4;
            f4m_ acc[17];
#pragma unroll
            for (int b = 0; b < 17; ++b) acc[b] = (f4m_){0.f, 0.f, 0.f, 0.f};
            const float* wp = p.ada_w + (size_t)l * 1024 * 6144 + (blk % 96) * 64 + c4 + (size_t)(ks * 128 + kr) * 6144;
            const float* cap = ca + ks * 128 + kr;
#pragma unroll 1
            for (int g4 = 0; g4 < 8; ++g4) {
                f4m_ w[4];
#pragma unroll
                for (int j = 0; j < 4; ++j) w[j] = __builtin_nontemporal_load((const f4m_*)(wp + (size_t)((g4 * 4 + j) * 4) * 6144));
#pragma unroll
                for (int j = 0; j < 4; ++j) {
#pragma unroll
                    for (int b = 0; b < 17; ++b) acc[b] += cap[b * 1024 + (g4 * 4 + j) * 4] * w[j]; }
            }
#pragma unroll
            for (int b = 0; b < 17; ++b) {
#pragma unroll
                for (int c = 0; c < 4; ++c) { float v = acc[b][c]; v += __shfl_xor(v, 16); v += __shfl_xor(v, 32); acc[b][c] = v; } }
            if (lane < 16) {
#pragma unroll
                for (int b = 0; b < 17; ++b) *(f4m_*)(red + (ks * 17 + b) * 64 + c4) = acc[b]; }
            __syncthreads();
            for (int i = tid; i < 17 * 64; i += NTHR) { const int b = i >> 6, nl = i & 63; float s = 0.f;
#pragma unroll
                for (int k2 = 0; k2 < 8; ++k2) s += red[(k2 * 17 + b) * 64 + nl];
                const int nn = (blk % 96) * 64 + nl; float mv = s + p.ada_b[l * 6144 + nn];
                if (nn >= 4096 && nn < 5120) mv = p.norm_ffn_g[l * 1024 + nn - 4096] * (1.0f + mv);
                MOD[((size_t)l * 17 + b) * 6144 + nn] = mv; }
            __syncthreads();
        }
    }
    SEAM(0);

#define NORM_MOD16(v, g, mr_) do { float ss_ = 0.f; \
        _Pragma("unroll") for (int j = 0; j < 16; ++j) ss_ = fmaf(v[j], v[j], ss_); \
        ss_ = wave_sum(ss_); const float ri_ = 1.0f / sqrtf(ss_ * (1.0f / 1024.0f) + RMS_EPS); \
        float sh_[16], sc_[16]; ld16f((mr_), sh_); ld16f((mr_) + 1024, sc_); \
        _Pragma("unroll") for (int j = 0; j < 16; ++j) v[j] = (v[j] * ri_ * g[j]) * (1.0f + sc_[j]) + sh_[j]; } while (0)

#define NORM_MOD16x2(v, g, mr0_, mr1_) do { float s0_ = 0.f, s1_ = 0.f; \
        _Pragma("unroll") for (int j = 0; j < 16; ++j) { s0_ = fmaf(v[0][j], v[0][j], s0_); s1_ = fmaf(v[1][j], v[1][j], s1_); } \
        wave_sum2(s0_, s1_); const float ri0_ = 1.0f / sqrtf(s0_ * (1.0f / 1024.0f) + RMS_EPS), ri1_ = 1.0f / sqrtf(s1_ * (1.0f / 1024.0f) + RMS_EPS); \
        float sh_[16], sc_[16]; ld16f((mr0_), sh_); ld16f((mr0_) + 1024, sc_); \
        _Pragma("unroll") for (int j = 0; j < 16; ++j) v[0][j] = (v[0][j] * ri0_ * g[j]) * (1.0f + sc_[j]) + sh_[j]; \
        ld16f((mr1_), sh_); ld16f((mr1_) + 1024, sc_); \
        _Pragma("unroll") for (int j = 0; j < 16; ++j) v[1][j] = (v[1][j] * ri1_ * g[j]) * (1.0f + sc_[j]) + sh_[j]; } while (0)
#define ROWS2(nrows) _Pragma("unroll 1") for (int r0_ = gw; r0_ < (nrows); r0_ += 2 * NGW)
#define ROWS2_IDX(nrows) const bool two_ = (r0_ + NGW) < (nrows); const int rr_[2] = {r0_, two_ ? r0_ + NGW : r0_};

    if (IN(1)) { PHASE_PTRS
        float g[16]; ld16f(p.norm_mix_g + 16 * lane, g);
        ROWS2(NROW) { ROWS2_IDX(NROW)
            float v[2][16]; const float* mr[2];
#pragma unroll
            for (int u = 0; u < 2; ++u) { const int r = rr_[u]; const float* src = r < NLAT ? p.x + (size_t)r * 1024 : p.ctx + (size_t)(r - NLAT) * 1024;
                mr[u] = MOD + (size_t)(0 * 17 + mod_row_of(r)) * 6144 + 16 * lane; ld16f(src + 16 * lane, v[u]); }
            NORM_MOD16x2(v, g, mr[0], mr[1]);
            if (INPROJ_F8) { st16f8((unsigned char*)H + (size_t)rr_[0] * 1024 + 16 * lane, v[0]); if (two_) st16f8((unsigned char*)H + (size_t)rr_[1] * 1024 + 16 * lane, v[1]); }
            else { st16bf(H + (size_t)rr_[0] * 1024 + 16 * lane, v[0]); if (two_) st16bf(H + (size_t)rr_[1] * 1024 + 16 * lane, v[1]); }
        }
    }
    SEAM(1);

    if (IN(2)) { PHASE_PTRS
        constexpr size_t ES_ = INPROJ_F8 ? 1 : 2;
        pg8::DenseOrder S{(const char*)H, (const char*)(wts + WO_AB), NROW / 256, 6, G, bid, (size_t)256 * 1024 * ES_, (size_t)256 * 1024 * ES_};
        pg8::EpiStoreBf16 E{PRJ, PRJ_LD, INPROJ_F8 ? 0.03125f : 1.0f};
        pg8::gemm_phase<pg8::EpiStoreBf16, pg8::DenseOrder, true, true, INPROJ_F8 != 0>(tid, LDSB, 1024, 1024, S, E);
    }
    SEAM(2);

    if (IN(3)) { PHASE_PTRS
        const float2* TA = (const float2*)(tabs + TAB_A); const float2* TB = (const float2*)(tabs + TAB_B);
        for (int r = gw; r < NROW; r += NGW) {
            bf16_t* pr = PRJ + (size_t)r * PRJ_LD;
            if (r < NLAT) { const int s = r % SEQ;
                { bf16_t* kp = pr + 512 + (lane >> 5) * 64 + (lane & 31); const float x1 = bf2f(kp[0]), x2 = bf2f(kp[32]); const float2 t = TA[s * 32 + (lane & 31)];
                  kp[0] = f2bf(x1 * t.x - x2 * t.y); kp[32] = f2bf(x2 * t.x + x1 * t.y); }
                if (lane < 16) { bf16_t* rp = pr + 1408 + lane; const float x1 = bf2f(rp[0]), x2 = bf2f(rp[16]); const float2 t = TB[s * 16 + lane];
                  rp[0] = f2bf(x1 * t.x - x2 * t.y); rp[16] = f2bf(x2 * t.x + x1 * t.y); } }
            float s1 = 0.f, s2 = 0.f;
#pragma unroll
            for (int j = 0; j < 6; ++j) { const float xq = bf2f(pr[768 + lane + 64 * j]); s1 = fmaf(xq, xq, s1); }
#pragma unroll
            for (int j = 0; j < 4; ++j) { const float xk = bf2f(pr[1152 + lane + 64 * j]); s2 = fmaf(xk, xk, s2); }
            s1 = wave_sum(s1); s2 = wave_sum(s2);
            if (lane == 0) { RINV[2 * r] = 1.0f / sqrtf(s1 * (1.0f / 384.0f) + RMS_EPS); RINV[2 * r + 1] = 1.0f / sqrtf(s2 * (1.0f / 256.0f) + RMS_EPS); }
        }
    }
    SEAM(3);

    if (IN(4)) { PHASE_PTRS
        { pg8::DenseOrder S{(const char*)(PRJ + 768), (const char*)(wts + WO_QB), NROW / 256, 3, G, bid, (size_t)256 * PRJ_LD * 2, (size_t)256 * 384 * 2};
          pg8::EpiScaleBf16 E{QB, 768, RINV};
          pg8::gemm_phase<pg8::EpiScaleBf16, pg8::DenseOrder, true, true>(tid, LDSB, 384, PRJ_LD, S, E); }
        __syncthreads();
        { pg8::DenseOrder S{(const char*)(PRJ + 1152), (const char*)(wts + WO_KVB), NROW / 256, 4, G, bid, (size_t)256 * PRJ_LD * 2, (size_t)256 * 256 * 2};
          pg8::EpiScaleBf16 E{KVB, 1024, RINV + 1};
          pg8::gemm_phase<pg8::EpiScaleBf16, pg8::DenseOrder, true, true>(tid, LDSB, 256, PRJ_LD, S, E); }
    }
    SEAM(4);

    if (IN(5)) { PHASE_PTRS
        for (int i = 0;; ++i) { const int u = i * G + bid; if (u >= 1152) break;
            const bool isctx = u >= 1024; int b, h, qb;
            if (!isctx) { const int rest = u >> 3; b = 2 * (u & 7) + (rest >> 6); h = (rest & 63) >> 3; qb = rest & 7; } else { b = (u - 1024) >> 3; h = u & 7; qb = 0; }
            const int qrow0 = isctx ? NLAT + b * NCX : b * SEQ + qb * 256;
            fa::Unit U; U.Q = QB + (size_t)qrow0 * 768 + h * 96; U.K = KVB + h * 128; U.K2 = PRJ + 1408; U.V = KVB + h * 128 + 64;
            U.O = OUTPROJ_F8 ? (bf16_t*)((unsigned char*)OB + (size_t)qrow0 * 1024 + 512 + h * 64) : OB + (size_t)qrow0 * 1024 + 512 + h * 64; U.rowa = NLAT + b * NCX; U.nta = 4; U.rowb = b * SEQ; U.ntb = isctx ? 0 : 32;
            U.window = 0; U.qpos0 = 0; U.kposb0 = 0; U.sink = 0.f; U.has_sink = 0; U.tab = isctx ? nullptr : (const float*)(tabs + TAB_B); U.pos0 = qb * 256; U.qg = nullptr;
            fa::attn_unit<96, 64, 768, 1024, 1024, 1024, false, 4, 1, false, true, OUTPROJ_F8 != 0>(tid, U, (char*)lds_raw); }
        for (int i = 0;; ++i) { const int u = i * G + bid; if (u >= 1152) break;
            const bool isctx = u >= 1024; int b, h, qb;
            if (!isctx) { const int rest = u >> 3; b = 2 * (u & 7) + (rest >> 6); h = (rest & 63) >> 3; qb = rest & 7; } else { b = (u - 1024) >> 3; h = u & 7; qb = 0; }
            const int qrow0 = isctx ? NLAT + b * NCX : b * SEQ + qb * 256;
            const int ks = isctx ? 0 : max(0, qb * 256 - 128), ke = isctx ? 0 : min(SEQ, qb * 256 + 384);
            fa::Unit U; U.Q = PRJ + (size_t)qrow0 * PRJ_LD + h * 64; U.K = PRJ + 512 + (h >> 2) * 64; U.K2 = nullptr; U.V = PRJ + 640 + (h >> 2) * 64;
            U.O = OUTPROJ_F8 ? (bf16_t*)((unsigned char*)OB + (size_t)qrow0 * 1024 + h * 64) : OB + (size_t)qrow0 * 1024 + h * 64; U.rowa = NLAT + b * NCX; U.nta = 4; U.rowb = b * SEQ + ks; U.ntb = (ke - ks) / 64;
            U.window = isctx ? 0 : 1; U.qpos0 = qb * 256; U.kposb0 = ks; U.sink = p.swa_sink[h]; U.has_sink = 1; U.tab = isctx ? nullptr : (const float*)(tabs + TAB_A); U.pos0 = qb * 256; U.qg = nullptr;
            fa::attn_unit<64, 64, PRJ_LD, PRJ_LD, PRJ_LD, 1024, true, 0, 2, false, false, OUTPROJ_F8 != 0>(tid, U, (char*)lds_raw); }
    }
    SEAM(5);

    if (IN(6)) { PHASE_PTRS
        constexpr size_t ES_ = OUTPROJ_F8 ? 1 : 2;
        pg8::DenseOrder S{(const char*)OB, (const char*)(wts + WO_ABO), NROW / 256, 4, G, bid, (size_t)256 * 1024 * ES_, (size_t)256 * 1024 * ES_};
        pg8::EpiResidT<float, xr_t> E{p.x, p.ctx, XR, MOD + 2048, OUTPROJ_F8 ? 0.03125f : 1.0f};
        pg8::gemm_phase<pg8::EpiResidT<float, xr_t>, pg8::DenseOrder, true, true, OUTPROJ_F8 != 0>(tid, LDSB, 1024, 1024, S, E);
    }
    SEAM(6);

    typedef float f4a_ __attribute__((ext_vector_type(4)));
#define GLD4(dst, ptr, off) asm volatile("global_load_dwordx4 %0, %1, off offset:" #off : "=v"(dst) : "v"(ptr) : "memory")
#if XR16
#define XR_LOADS(xp_) GLD4(xn0_, xp_, 0); GLD4(xn1_, xp_, 16); GLD4(xn2_, xp_, 32); GLD4(xn3_, xp_, 48); xn4_ = xn0_; xn5_ = xn0_; xn6_ = xn0_; xn7_ = xn0_
#define XR_WAIT_MOD "s_waitcnt vmcnt(4)"
#define XR_UNPACK(v) _Pragma("unroll") for (int q = 0; q < 4; ++q) { const unsigned w0_ = __float_as_uint(xn0_[q]), w1_ = __float_as_uint(xn1_[q]), w2_ = __float_as_uint(xn2_[q]), w3_ = __float_as_uint(xn3_[q]); \
        v[0][2 * q] = __uint_as_float(w0_ << 16); v[0][2 * q + 1] = __uint_as_float(w0_ & 0xffff0000u); v[0][8 + 2 * q] = __uint_as_float(w1_ << 16); v[0][9 + 2 * q] = __uint_as_float(w1_ & 0xffff0000u); \
        v[1][2 * q] = __uint_as_float(w2_ << 16); v[1][2 * q + 1] = __uint_as_float(w2_ & 0xffff0000u); v[1][8 + 2 * q] = __uint_as_float(w3_ << 16); v[1][9 + 2 * q] = __uint_as_float(w3_ & 0xffff0000u); }
#else
#define XR_LOADS(xp_) GLD4(xn0_, xp_, 0); GLD4(xn1_, xp_, 16); GLD4(xn2_, xp_, 32); GLD4(xn3_, xp_, 48); GLD4(xn4_, xp_, 64); GLD4(xn5_, xp_, 80); GLD4(xn6_, xp_, 96); GLD4(xn7_, xp_, 112)
#define XR_WAIT_MOD "s_waitcnt vmcnt(8)"
#define XR_UNPACK(v) _Pragma("unroll") for (int q = 0; q < 4; ++q) { v[0][q] = xn0_[q]; v[0][4 + q] = xn1_[q]; v[0][8 + q] = xn2_[q]; v[0][12 + q] = xn3_[q]; v[1][q] = xn4_[q]; v[1][4 + q] = xn5_[q]; v[1][8 + q] = xn6_[q]; v[1][12 + q] = xn7_[q]; }
#endif
#define ROUTER_PHASE(L, nrows) do { \
        static_assert(XR16, "the two-rows-per-wave router reads the residual stream as bf16"); \
        { const float4* wsrc_ = (const float4*)(p.router_w + (size_t)(L) * 1024 * 32); float4* wl_ = (float4*)lds_raw; \
          for (int q = tid; q < 8192; q += NTHR) { const int c_ = q >> 3, e4_ = q & 7; wl_[(c_ ^ ((c_ >> 7) & 1)) * 8 + (e4_ ^ ((c_ >> 4) & 7))] = wsrc_[q]; } }        \
        __syncthreads(); \
        unsigned* cnt_ = ctl + CW_CNT + (L) * 32; \
        LAS unsigned* lcnt_ = (LAS unsigned*)(LDSB + LDS_MISC + 1024); LAS unsigned* lbase_ = lcnt_ + 32;       \
        if (tid < 32) lcnt_[tid] = 0u; \
        __syncthreads(); \
        const int half_ = lane >> 5, l5_ = lane & 31;                        \
        const float rb_ = p.router_b[(L) * 32 + l5_]; \
        const float4* wl_ = (const float4*)lds_raw + (size_t)(16 * lane) * 8; const int sw_ = lane & 7; \
        LAS unsigned* stash_ = (LAS unsigned*)(LDSB + 131072) + wave * 384;        \
        int it_ = 0; \
          \
        f4a_ xn0_, xn1_, xn2_, xn3_;                                         \
        { const int r = gw * 2 < (nrows) ? gw * 2 : 0; const xr_t* xp_ = XR + (size_t)r * 1024 + 16 * lane; GLD4(xn0_, xp_, 0); GLD4(xn1_, xp_, 16); GLD4(xn2_, xp_, 2048); GLD4(xn3_, xp_, 2064); } \
        for (int rp = gw; rp * 2 < (nrows); rp += NGW, ++it_) { const int r0 = rp * 2, r = r0 + half_; \
            const float* mr = MOD + (size_t)((L) * 17 + mod_row_of(r0)) * 6144 + 3072 + 16 * lane; const float* mr2 = mr + 1024; \
            asm volatile("s_waitcnt vmcnt(0)" : "+v"(xn0_), "+v"(xn1_), "+v"(xn2_), "+v"(xn3_) :: "memory"); \
            float v[2][16]; \
            _Pragma("unroll") for (int q = 0; q < 4; ++q) { const unsigned w0_ = __float_as_uint(xn0_[q]), w1_ = __float_as_uint(xn1_[q]), w2_ = __float_as_uint(xn2_[q]), w3_ = __float_as_uint(xn3_[q]); \
                v[0][2 * q] = __uint_as_float(w0_ << 16); v[0][2 * q + 1] = __uint_as_float(w0_ & 0xffff0000u); v[0][8 + 2 * q] = __uint_as_float(w1_ << 16); v[0][9 + 2 * q] = __uint_as_float(w1_ & 0xffff0000u); \
                v[1][2 * q] = __uint_as_float(w2_ << 16); v[1][2 * q + 1] = __uint_as_float(w2_ & 0xffff0000u); v[1][8 + 2 * q] = __uint_as_float(w3_ << 16); v[1][9 + 2 * q] = __uint_as_float(w3_ & 0xffff0000u); } \
            f4a_ sh0_, sh1_, sh2_, sh3_, sc0_, sc1_, sc2_, sc3_; \
            GLD4(sh0_, mr, 0); GLD4(sh1_, mr, 16); GLD4(sh2_, mr, 32); GLD4(sh3_, mr, 48); GLD4(sc0_, mr2, 0); GLD4(sc1_, mr2, 16); GLD4(sc2_, mr2, 32); GLD4(sc3_, mr2, 48); \
            { const int rn_ = (rp + NGW) * 2 < (nrows) ? (rp + NGW) * 2 : r0; const xr_t* xp_ = XR + (size_t)rn_ * 1024 + 16 * lane; GLD4(xn0_, xp_, 0); GLD4(xn1_, xp_, 16); GLD4(xn2_, xp_, 2048); GLD4(xn3_, xp_, 2064); }        \
            asm volatile("s_waitcnt vmcnt(4)" : "+v"(sh0_), "+v"(sh1_), "+v"(sh2_), "+v"(sh3_), "+v"(sc0_), "+v"(sc1_), "+v"(sc2_), "+v"(sc3_) :: "memory"); \
            float sh_[16], sc_[16]; \
            _Pragma("unroll") for (int q = 0; q < 4; ++q) { sh_[q] = sh0_[q]; sh_[4 + q] = sh1_[q]; sh_[8 + q] = sh2_[q]; sh_[12 + q] = sh3_[q]; sc_[q] = sc0_[q]; sc_[4 + q] = sc1_[q]; sc_[8 + q] = sc2_[q]; sc_[12 + q] = sc3_[q]; } \
            float ss0_ = 0.f, ss1_ = 0.f; \
            _Pragma("unroll") for (int j = 0; j < 16; ++j) { ss0_ = fmaf(v[0][j], v[0][j], ss0_); ss1_ = fmaf(v[1][j], v[1][j], ss1_); } \
            ss0_ = half_sum32(ss0_); ss1_ = half_sum32(ss1_); \
            { const u32x2_t q0_ = __builtin_amdgcn_permlane32_swap(__float_as_uint(ss0_), __float_as_uint(ss0_), false, false); ss0_ = __uint_as_float(q0_[0]) + __uint_as_float(q0_[1]); \
              const u32x2_t q1_ = __builtin_amdgcn_permlane32_swap(__float_as_uint(ss1_), __float_as_uint(ss1_), false, false); ss1_ = __uint_as_float(q1_[0]) + __uint_as_float(q1_[1]); } \
            const float ri0_ = 1.0f / sqrtf(ss0_ * (1.0f / 1024.0f) + RMS_EPS), ri1_ = 1.0f / sqrtf(ss1_ * (1.0f / 1024.0f) + RMS_EPS); \
            _Pragma("unroll") for (int j = 0; j < 16; ++j) { v[0][j] = (v[0][j] * ri0_) * sc_[j] + sh_[j]; v[1][j] = (v[1][j] * ri1_) * sc_[j] + sh_[j]; }        \
            st16f8((unsigned char*)H + (size_t)r0 * 1024 + 16 * lane, v[0]); st16f8((unsigned char*)H + (size_t)(r0 + 1) * 1024 + 16 * lane, v[1]);        \
            if (lane & 8) { _Pragma("unroll") for (int hh = 0; hh < 2; ++hh) _Pragma("unroll") for (int j = 0; j < 16; j += 2) { const float t_ = v[hh][j]; v[hh][j] = v[hh][j + 1]; v[hh][j + 1] = t_; } }        \
            float acc0[32], acc1[32]; \
            _Pragma("unroll") for (int e = 0; e < 32; ++e) { acc0[e] = 0.f; acc1[e] = 0.f; } \
            _Pragma("unroll") for (int j = 0; j < 16; ++j) { \
                _Pragma("unroll") for (int e4 = 0; e4 < 8; ++e4) { const float4 w = wl_[j * 8 + (e4 ^ sw_)]; \
                    acc0[4 * e4] = fmaf(v[0][j], w.x, acc0[4 * e4]); acc0[4 * e4 + 1] = fmaf(v[0][j], w.y, acc0[4 * e4 + 1]); acc0[4 * e4 + 2] = fmaf(v[0][j], w.z, acc0[4 * e4 + 2]); acc0[4 * e4 + 3] = fmaf(v[0][j], w.w, acc0[4 * e4 + 3]); \
                    acc1[4 * e4] = fmaf(v[1][j], w.x, acc1[4 * e4]); acc1[4 * e4 + 1] = fmaf(v[1][j], w.y, acc1[4 * e4 + 1]); acc1[4 * e4 + 2] = fmaf(v[1][j], w.z, acc1[4 * e4 + 2]); acc1[4 * e4 + 3] = fmaf(v[1][j], w.w, acc1[4 * e4 + 3]); } } \
            float acc[32];                                                   \
            _Pragma("unroll") for (int e = 0; e < 32; ++e) { const u32x2_t q_ = __builtin_amdgcn_permlane32_swap(__float_as_uint(acc0[e]), __float_as_uint(acc1[e]), false, false); acc[e] = __uint_as_float(q_[0]) + __uint_as_float(q_[1]); } \
            float tv[4]; int ti[4]; route_reduce32(acc, l5_, rb_, tv, ti); \
            const float e1 = expf(tv[1] - tv[0]), e2 = expf(tv[2] - tv[0]), e3 = expf(tv[3] - tv[0]); const float inv = 1.0f / (1.0f + e1 + e2 + e3); \
            if (l5_ < 4) { const int ek = l5_ == 0 ? ti[0] : l5_ == 1 ? ti[1] : l5_ == 2 ? ti[2] : ti[3]; const float gk = (l5_ == 0 ? 1.0f : l5_ == 1 ? e1 : l5_ == 2 ? e2 : e3) * inv; \
                const unsigned pos = __hip_atomic_fetch_add(lcnt_ + ek, 1u, __ATOMIC_RELAXED, __HIP_MEMORY_SCOPE_WORKGROUP); TOKE[r * 4 + l5_] = ek; TOKG[r * 4 + l5_] = gk; \
                stash_[it_ * 8 + half_ * 4 + l5_] = (unsigned)ek | (pos << 8); } \
        } \
        asm volatile("s_waitcnt vmcnt(0)" : "+v"(xn0_), "+v"(xn1_), "+v"(xn2_), "+v"(xn3_) :: "memory");        \
        __syncthreads(); \
        if (tid < 32) lbase_[tid] = atomicAdd(cnt_ + tid, lcnt_[tid]); \
        __syncthreads(); \
        for (int e_ = lane; e_ < it_ * 8; e_ += 64) { const unsigned w_ = stash_[e_]; const int r = (gw + (e_ >> 3) * NGW) * 2 + ((e_ >> 2) & 1); TOKP[r * 4 + (e_ & 3)] = (int)((w_ >> 8) + lbase_[w_ & 255u]); } \
    } while (0)

#define EXCL_SETUP(L) \
        const int c_ = lane < 32 ? (int)ctl[CW_CNT + (L) * 32 + lane] : 0; const int padc_ = (c_ + 255) / 256 * 256; int pre_ = padc_; \
        _Pragma("unroll") for (int o_ = 1; o_ < 32; o_ <<= 1) { const int t_ = __shfl_up(pre_, o_); if ((lane & 31) >= o_) pre_ += t_; } \
        const int excl_ = pre_ - padc_;
#define PERMUTE_PHASE(L, nrows) do { EXCL_SETUP(L) \
        ROWS2(nrows) { ROWS2_IDX(nrows) \
            const int ra_ = rr_[0], rb_ = rr_[1]; \
            const uint4* sa_ = (const uint4*)(H + (size_t)ra_ * 1024) + lane * 2; const uint4* sb_ = (const uint4*)(H + (size_t)rb_ * 1024) + lane * 2; \
            const uint4 a0_ = sa_[0], a1_ = sa_[1], b0_ = sb_[0], b1_ = sb_[1]; \
            const int4 ea_ = *(const int4*)(TOKE + ra_ * 4), pa_ = *(const int4*)(TOKP + ra_ * 4), eb_ = *(const int4*)(TOKE + rb_ * 4), pb_ = *(const int4*)(TOKP + rb_ * 4); \
            const int sa0 = __shfl(excl_, ea_.x) + pa_.x, sa1 = __shfl(excl_, ea_.y) + pa_.y, sa2 = __shfl(excl_, ea_.z) + pa_.z, sa3 = __shfl(excl_, ea_.w) + pa_.w; \
            const int sb0 = __shfl(excl_, eb_.x) + pb_.x, sb1 = __shfl(excl_, eb_.y) + pb_.y, sb2 = __shfl(excl_, eb_.z) + pb_.z, sb3 = __shfl(excl_, eb_.w) + pb_.w; \
            { uint4* d_ = (uint4*)(XS + (size_t)sa0 * 1024) + lane * 2; d_[0] = a0_; d_[1] = a1_; } { uint4* d_ = (uint4*)(XS + (size_t)sa1 * 1024) + lane * 2; d_[0] = a0_; d_[1] = a1_; } \
            { uint4* d_ = (uint4*)(XS + (size_t)sa2 * 1024) + lane * 2; d_[0] = a0_; d_[1] = a1_; } { uint4* d_ = (uint4*)(XS + (size_t)sa3 * 1024) + lane * 2; d_[0] = a0_; d_[1] = a1_; } \
            if (two_) { \
            { uint4* d_ = (uint4*)(XS + (size_t)sb0 * 1024) + lane * 2; d_[0] = b0_; d_[1] = b1_; } { uint4* d_ = (uint4*)(XS + (size_t)sb1 * 1024) + lane * 2; d_[0] = b0_; d_[1] = b1_; } \
            { uint4* d_ = (uint4*)(XS + (size_t)sb2 * 1024) + lane * 2; d_[0] = b0_; d_[1] = b1_; } { uint4* d_ = (uint4*)(XS + (size_t)sb3 * 1024) + lane * 2; d_[0] = b0_; d_[1] = b1_; } } } \
        for (int e = 0; e < 32; ++e) { const int ce = __shfl(c_, e), be = __shfl(excl_, e), pe = __shfl(padc_, e); \
            for (int rr = ce + gw; rr < pe; rr += NGW) { uint4* d_ = (uint4*)(XS + (size_t)(be + rr) * 1024) + lane * 2; d_[0] = make_uint4(0u, 0u, 0u, 0u); d_[1] = make_uint4(0u, 0u, 0u, 0u); } } \
    } while (0)
#define PERMUTE_PHASE_F8(L, nrows) do { EXCL_SETUP(L) \
        unsigned char* XS8 = (unsigned char*)XS; \
        for (int r = gw; r < (nrows); r += NGW) { \
            const int4 ov_ = *((const int4*)((const unsigned char*)H + (size_t)r * 1024) + lane); \
            _Pragma("unroll") for (int k = 0; k < 4; ++k) { const int ek = TOKE[r * 4 + k], pk = TOKP[r * 4 + k]; const int slot = __shfl(excl_, ek) + pk; \
                *((int4*)(XS8 + (size_t)slot * 1024) + lane) = ov_; if (lane == 0) TOKP[r * 4 + k] = slot; } }        \
        for (int e = 0; e < 32; ++e) { const int ce = __shfl(c_, e), be = __shfl(excl_, e), pe = __shfl(padc_, e); \
            for (int rr = ce + gw; rr < pe; rr += NGW) *((int4*)(XS8 + (size_t)(be + rr) * 1024) + lane) = make_int4(0, 0, 0, 0); } \
    } while (0)
#define MOE_TABLE(L) \
        LAS int* tile_e = (LAS int*)(LDSB + LDS_MISC + 1024); LAS int* nm_p = tile_e + 640; \
        LAS int* tpre_ = nm_p + 1;                                       \
        __syncthreads(); \
        if (tid < 64) { const int c_ = lane < 32 ? (int)ctl[CW_CNT + (L) * 32 + lane] : 0; const int n_ = (c_ + 255) / 256; int pre_ = n_; \
            _Pragma("unroll") for (int o_ = 1; o_ < 32; o_ <<= 1) { const int t_ = __shfl_up(pre_, o_); if ((lane & 31) >= o_) pre_ += t_; } \
            if (lane < 32) tpre_[lane] = pre_ - n_; if (lane == 31) { tpre_[32] = pre_; *nm_p = pre_; } } \
        __syncthreads(); \
        const int nM_ = __builtin_amdgcn_readfirstlane(*nm_p); \
        for (int t_ = tid; t_ < nM_; t_ += NTHR) { int e_ = 0; _Pragma("unroll") for (int q_ = 16; q_ >= 1; q_ >>= 1) { if (tpre_[e_ + q_] <= t_) e_ += q_; } tile_e[t_] = e_; }        \
        __syncthreads();
#define MOE_FAST1(L) do { MOE_TABLE(L) \
        pg8::MoeOrder S{(const char*)XS, (const char*)(wts + WO_W1) + (size_t)(L) * 32 * 2048 * 1024 * 2, tile_e, nM_, 8, G, bid, (size_t)256 * 1024 * 2, (size_t)2048 * 1024 * 2}; \
        pg8::EpiSwiglu E{ACT, p.moe_b_in + (size_t)(L) * 32 * 2048, 1.0f}; \
        pg8::gemm_phase<pg8::EpiSwiglu, pg8::MoeOrder, true, true>(tid, LDSB, 1024, 1024, S, E); } while (0)
#define MOE_FAST2(L) do { MOE_TABLE(L) \
        pg8::MoeOrder S{(const char*)ACT, (const char*)(wts + WO_W2) + (size_t)(L) * 32 * 1024 * 1024 * 2, tile_e, nM_, 4, G, bid, (size_t)256 * 1024 * 2, (size_t)1024 * 1024 * 2}; \
        pg8::EpiBiasBf16 E{Y, p.moe_b_out + (size_t)(L) * 32 * 1024, 1.0f}; \
        pg8::gemm_phase<pg8::EpiBiasBf16, pg8::MoeOrder, true, true>(tid, LDSB, 1024, 1024, S, E); } while (0)
#define MOE_FAST1_F8(L) do { MOE_TABLE(L) \
        pg8::MoeOrder S{(const char*)XS, (const char*)(wts + WO_W1) + (size_t)(L) * 32 * 2048 * 1024 * 2, tile_e, nM_, 8, G, bid, (size_t)256 * 1024, (size_t)2048 * 1024}; \
        if constexpr (MOE_F8_DOWN) { pg8::EpiSwigluF8 E{(unsigned char*)ACT, p.moe_b_in + (size_t)(L) * 32 * 2048}; \
            pg8::gemm_phase<pg8::EpiSwigluF8, pg8::MoeOrder, true, true, true>(tid, LDSB, 1024, 1024, S, E); } \
        else { pg8::EpiSwiglu E{ACT, p.moe_b_in + (size_t)(L) * 32 * 2048, 0.03125f}; \
            pg8::gemm_phase<pg8::EpiSwiglu, pg8::MoeOrder, false, true, true>(tid, LDSB, 1024, 1024, S, E); } } while (0)
#define MOE_FAST2_F8(L) do { MOE_TABLE(L) \
        pg8::MoeOrder S{(const char*)ACT, (const char*)(wts + WO_W2) + (size_t)(L) * 32 * 1024 * 1024 * 2, tile_e, nM_, 4, G, bid, (size_t)256 * 1024, (size_t)1024 * 1024}; \
        if constexpr ((Y8_L1 && (L) == 1) || (Y8_L0 && (L) == 0)) { pg8::EpiBiasF8 E{(unsigned char*)Y, p.moe_b_out + (size_t)(L) * 32 * 1024, 0.03125f}; \
            pg8::gemm_phase<pg8::EpiBiasF8, pg8::MoeOrder, true, true, true>(tid, LDSB, 1024, 1024, S, E); } \
        else { pg8::EpiBiasBf16 E{Y, p.moe_b_out + (size_t)(L) * 32 * 1024, 0.03125f}; \
            pg8::gemm_phase<pg8::EpiBiasBf16, pg8::MoeOrder, true, true, true>(tid, LDSB, 1024, 1024, S, E); } } while (0)
#define COMBINE_PRE(nrows) typedef int i4n_ __attribute__((ext_vector_type(4))); typedef float f4n_ __attribute__((ext_vector_type(4))); i4n_ sl0_, sl1_; f4n_ gt0_, gt1_; \
        { const int ra_ = gw < (nrows) ? gw : 0, rb_ = gw + NGW < (nrows) ? gw + NGW : ra_; sl0_ = *(const i4n_*)(TOKP + ra_ * 4); gt0_ = *(const f4n_*)(TOKG + ra_ * 4); sl1_ = *(const i4n_*)(TOKP + rb_ * 4); gt1_ = *(const f4n_*)(TOKG + rb_ * 4); }
#define COMBINE_ROWS2(L, v, nrows, F8Y) do { \
        const int slc_[2][4] = {{sl0_[0], sl0_[1], sl0_[2], sl0_[3]}, {sl1_[0], sl1_[1], sl1_[2], sl1_[3]}}; \
        const float gk_[2][4] = {{gt0_[0], gt0_[1], gt0_[2], gt0_[3]}, {gt1_[0], gt1_[1], gt1_[2], gt1_[3]}}; \
        uint4 ya_[2][4], yb_[2][4]; \
        _Pragma("unroll") for (int u = 0; u < 2; ++u) { const int r = rr_[u]; \
            _Pragma("unroll") for (int k = 0; k < 4; ++k) { \
                if constexpr (F8Y) { ya_[u][k] = *((const uint4*)((const unsigned char*)Y + (size_t)slc_[u][k] * 1024) + lane); yb_[u][k] = ya_[u][k]; } \
                else { const uint4* yr = (const uint4*)(Y + (size_t)slc_[u][k] * 1024 + 16 * lane); ya_[u][k] = yr[0]; yb_[u][k] = yr[1]; } } \
            ld16x(XR + (size_t)r * 1024 + 16 * lane, v[u]); } \
        { const int n0_ = r0_ + 2 * NGW; if (n0_ < (nrows)) { const int n1_ = n0_ + NGW < (nrows) ? n0_ + NGW : n0_; \
            sl0_ = *(const i4n_*)(TOKP + n0_ * 4); gt0_ = *(const f4n_*)(TOKG + n0_ * 4); sl1_ = *(const i4n_*)(TOKP + n1_ * 4); gt1_ = *(const f4n_*)(TOKG + n1_ * 4); } } \
        _Pragma("unroll") for (int u = 0; u < 2; ++u) { float f_[16]; \
            _Pragma("unroll") for (int j = 0; j < 16; ++j) f_[j] = 0.f; \
            _Pragma("unroll") for (int k = 0; k < 4; ++k) { \
                if constexpr (F8Y) { const int yw[4] = {(int)ya_[u][k].x, (int)ya_[u][k].y, (int)ya_[u][k].z, (int)ya_[u][k].w}; \
                    _Pragma("unroll") for (int j = 0; j < 4; ++j) { const auto lo_ = __builtin_amdgcn_cvt_pk_f32_fp8(yw[j], false); const auto hi_ = __builtin_amdgcn_cvt_pk_f32_fp8(yw[j], true); \
                        f_[4 * j] = fmaf(gk_[u][k], lo_[0], f_[4 * j]); f_[4 * j + 1] = fmaf(gk_[u][k], lo_[1], f_[4 * j + 1]); f_[4 * j + 2] = fmaf(gk_[u][k], hi_[0], f_[4 * j + 2]); f_[4 * j + 3] = fmaf(gk_[u][k], hi_[1], f_[4 * j + 3]); } } \
                else { const unsigned yw[8] = {ya_[u][k].x, ya_[u][k].y, ya_[u][k].z, ya_[u][k].w, yb_[u][k].x, yb_[u][k].y, yb_[u][k].z, yb_[u][k].w}; \
                    _Pragma("unroll") for (int j = 0; j < 8; ++j) { f_[2 * j] = fmaf(gk_[u][k], __uint_as_float(yw[j] << 16), f_[2 * j]); f_[2 * j + 1] = fmaf(gk_[u][k], __uint_as_float(yw[j] & 0xffff0000u), f_[2 * j + 1]); } } } \
            float g2v_[16]; ld16f(MOD + (size_t)((L) * 17 + mod_row_of(rr_[u])) * 6144 + 5120 + 16 * lane, g2v_);        \
            _Pragma("unroll") for (int j = 0; j < 16; ++j) v[u][j] = fmaf(g2v_[j], f_[j], v[u][j]); } } while (0)

    if (IN(7)) { PHASE_PTRS ROUTER_PHASE(0, NROW); }
    SEAM(7);
#if MOE_F8_L0
    if (IN(8)) { PHASE_PTRS PERMUTE_PHASE_F8(0, NROW); }
    SEAM(8);
    if (IN(9)) { PHASE_PTRS MOE_FAST1_F8(0); }
    SEAM(9);
#else
    if (IN(8)) { PHASE_PTRS PERMUTE_PHASE(0, NROW); }
    SEAM(8);
    if (IN(9)) { PHASE_PTRS MOE_FAST1(0); }
    SEAM(9);
#endif
    if (IN(10)) { PHASE_PTRS if constexpr (MOE_F8_L0 && MOE_F8_DOWN) { MOE_FAST2_F8(0); } else { MOE_FAST2(0); } }
    SEAM(10);

    if (IN(11)) { PHASE_PTRS
        float g[16]; ld16f(p.norm_mix_g + 1024 + 16 * lane, g);
        COMBINE_PRE(NROW)
        ROWS2(NROW) { ROWS2_IDX(NROW)
            float v[2][16]; COMBINE_ROWS2(0, v, NROW, (Y8_L0 && MOE_F8_L0 && MOE_F8_DOWN));
            st16x(XR + (size_t)rr_[0] * 1024 + 16 * lane, v[0]); if (two_) st16x(XR + (size_t)rr_[1] * 1024 + 16 * lane, v[1]);
            const float* mr0 = MOD + (size_t)(1 * 17 + mod_row_of(rr_[0])) * 6144 + 16 * lane; const float* mr1 = MOD + (size_t)(1 * 17 + mod_row_of(rr_[1])) * 6144 + 16 * lane;
            NORM_MOD16x2(v, g, mr0, mr1);
            if (INPROJ_F8) { st16f8((unsigned char*)H + (size_t)rr_[0] * 1024 + 16 * lane, v[0]); if (two_) st16f8((unsigned char*)H + (size_t)rr_[1] * 1024 + 16 * lane, v[1]); }
            else { st16bf(H + (size_t)rr_[0] * 1024 + 16 * lane, v[0]); if (two_) st16bf(H + (size_t)rr_[1] * 1024 + 16 * lane, v[1]); }
        }
    }
    SEAM(11);

    if (IN(12)) { PHASE_PTRS
        constexpr size_t ES_ = INPROJ_F8 ? 1 : 2;
        pg8::DenseOrder S{(const char*)H, (const char*)(wts + WO_C), NROW / 256, 6, G, bid, (size_t)256 * 1024 * ES_, (size_t)256 * 1024 * ES_};
        pg8::EpiStoreBf16 E{PRJ, PRJ_LD, INPROJ_F8 ? 0.03125f : 1.0f};
        pg8::gemm_phase<pg8::EpiStoreBf16, pg8::DenseOrder, true, true, INPROJ_F8 != 0>(tid, LDSB, 1024, 1024, S, E);
    }
    SEAM(12);

    if (IN(13)) { PHASE_PTRS
        const float2* TC = (const float2*)(tabs + TAB_C); const float kg1 = p.c_k_g[lane], kg2 = p.c_k_g[64 + lane];
        for (int r = gw; r < NROW; r += NGW) {
            bf16_t* pr = PRJ + (size_t)r * PRJ_LD + 1024; float2 t = make_float2(1.f, 0.f); if (r < NLAT) t = TC[(r % SEQ) * 64 + lane];
#pragma unroll
            for (int kv = 0; kv < 2; ++kv) { float x1 = bf2f(pr[kv * 128 + lane]), x2 = bf2f(pr[kv * 128 + 64 + lane]);
                const float ss = wave_sum(x1 * x1 + x2 * x2); const float ri = 1.0f / sqrtf(ss * (1.0f / 128.0f) + RMS_EPS);
                x1 = x1 * ri * kg1; x2 = x2 * ri * kg2;
                pr[kv * 128 + lane] = f2bf(x1 * t.x - x2 * t.y); pr[kv * 128 + 64 + lane] = f2bf(x2 * t.x + x1 * t.y); }
        }
    }
    SEAM(13);

    if (IN(14)) { PHASE_PTRS
        for (int i = 0;; ++i) { const int u = i * G + bid; if (u >= 1024) break;
            const int rest = u >> 3; const int b = 2 * (u & 7) + (rest >> 6), h = (rest & 63) >> 3, qb = rest & 7; const int qrow0 = b * SEQ + qb * 256;
            fa::Unit U; U.Q = PRJ + (size_t)qrow0 * PRJ_LD + h * 128; U.K = PRJ + 1024 + (h >> 2) * 128; U.K2 = nullptr; U.V = PRJ + 1280 + (h >> 2) * 128;
            U.O = OUTPROJ_F8 ? (bf16_t*)((unsigned char*)OB + (size_t)qrow0 * 1024 + h * 128) : OB + (size_t)qrow0 * 1024 + h * 128; U.rowa = NLAT + b * NCX; U.nta = 4; U.rowb = b * SEQ; U.ntb = 32;
            U.window = 0; U.qpos0 = 0; U.kposb0 = 0; U.sink = 0.f; U.has_sink = 0; U.tab = (const float*)(tabs + TAB_C); U.pos0 = qb * 256; U.qg = (const float*)(tabs + TAB_QG);
            fa::attn_unit<128, 128, PRJ_LD, PRJ_LD, PRJ_LD, 1024, false, 0, 4, true, false, OUTPROJ_F8 != 0>(tid, U, (char*)lds_raw); }
    }
    SEAM(14);

    if (IN(15)) { PHASE_PTRS
        constexpr size_t ES_ = OUTPROJ_F8 ? 1 : 2;
        pg8::DenseOrder S{(const char*)OB, (const char*)(wts + WO_CO), NLAT / 256, 4, G, bid, (size_t)256 * 1024 * ES_, (size_t)256 * 1024 * ES_};
        pg8::EpiResidT<xr_t, xr_t> E{XR, XR, XR, MOD + 17 * 6144 + 2048, OUTPROJ_F8 ? 0.03125f : 1.0f};
        pg8::gemm_phase<pg8::EpiResidT<xr_t, xr_t>, pg8::DenseOrder, true, true, OUTPROJ_F8 != 0>(tid, LDSB, 1024, 1024, S, E);
    }
    SEAM(15);

    if (IN(16)) { PHASE_PTRS ROUTER_PHASE(1, NLAT); }
    SEAM(16);
#if MOE_F8_L1
    if (IN(17)) { PHASE_PTRS PERMUTE_PHASE_F8(1, NLAT); }
    SEAM(17);
    if (IN(18)) { PHASE_PTRS MOE_FAST1_F8(1); }
    SEAM(18);
    if (IN(19)) { PHASE_PTRS if constexpr (MOE_F8_DOWN) { MOE_FAST2_F8(1); } else { MOE_FAST2(1); } }
    SEAM(19);
#else
    if (IN(17)) { PHASE_PTRS PERMUTE_PHASE(1, NLAT); }
    SEAM(17);
    if (IN(18)) { PHASE_PTRS MOE_FAST1(1); }
    SEAM(18);
    if (IN(19)) { PHASE_PTRS MOE_FAST2(1); }
    SEAM(19);
#endif

    if (IN(20)) { PHASE_PTRS
        COMBINE_PRE(NLAT)
        ROWS2(NLAT) { ROWS2_IDX(NLAT)
            float v[2][16]; COMBINE_ROWS2(1, v, NLAT, (Y8_L1 && MOE_F8_L1 && MOE_F8_DOWN));
            float s0 = 0.f, s1 = 0.f;
#pragma unroll
            for (int j = 0; j < 16; ++j) { s0 = fmaf(v[0][j], v[0][j], s0); s1 = fmaf(v[1][j], v[1][j], s1); }
            wave_sum2(s0, s1); const float ri0 = 1.0f / sqrtf(s0 * (1.0f / 1024.0f) + RMS_EPS), ri1 = 1.0f / sqrtf(s1 * (1.0f / 1024.0f) + RMS_EPS);
            int ln_ = lane; asm volatile("" : "+v"(ln_));
            float g[16]; ld16f(p.final_g + 16 * ln_, g);
#pragma unroll
            for (int j = 0; j < 16; ++j) { v[0][j] = v[0][j] * ri0 * g[j]; v[1][j] = v[1][j] * ri1 * g[j]; }
            st16f(p.out + (size_t)rr_[0] * 1024 + 16 * ln_, v[0]); if (two_) st16f(p.out + (size_t)rr_[1] * 1024 + 16 * ln_, v[1]);
        }
    }
#undef IN
#undef SEAM
}

#ifndef MK_PER_PHASE
#define MK_PER_PHASE 0
#endif
extern "C" void kernel_launch(void* const* d_in, const int* in_sizes, int n_in, void* d_out, int out_size, void* d_ws, size_t ws_size, hipStream_t stream) {
    static int grid = 0;
    if (grid == 0) {
        if (n_in != 26 || out_size != NLAT * DM || ws_size < WS_END) { fprintf(stderr, "kernel_launch: unexpected shapes (n_in %d out %d ws %zu need %zu)\n", n_in, out_size, ws_size, (size_t)WS_END); grid = -1; return; }
        int dev = 0, cus = 0;
        if (hipGetDevice(&dev) != hipSuccess || hipDeviceGetAttribute(&cus, hipDeviceAttributeMultiprocessorCount, dev) != hipSuccess) { grid = -1; return; }
        if (hipFuncSetAttribute((const void*)fwd_kernel, hipFuncAttributeMaxDynamicSharedMemorySize, LDS_BYTES) != hipSuccess) { fprintf(stderr, "kernel_launch: hipFuncSetAttribute failed\n"); grid = -1; return; }
        int per_cu = 0;
        if (hipOccupancyMaxActiveBlocksPerMultiprocessor(&per_cu, (const void*)fwd_kernel, NTHR, LDS_BYTES) != hipSuccess || per_cu < 1) { fprintf(stderr, "kernel_launch: occupancy query says %d\n", per_cu); }
        (void)hipGetLastError();
        grid = cus;
    }
    if (grid < 0) return;
    (void)hipMemsetAsync((char*)d_ws + WS_CTL, 0, CTL_BYTES, stream);
    Params p{};
    const float** pp = (const float**)&p;
    for (int i = 0; i < 26; ++i) pp[i] = (const float*)d_in[i];
    p.out = (float*)d_out; p.ws = (unsigned char*)d_ws;
#if MK_PER_PHASE
    for (int k = 0; k < N_PHASES; ++k) { p.ph_lo = k; p.ph_hi = k + 1; hipLaunchKernelGGL(fwd_kernel, dim3(grid), dim3(NTHR), LDS_BYTES, stream, p); }
#else
    p.ph_lo = 0; p.ph_hi = N_PHASES;
    hipLaunchKernelGGL(fwd_kernel, dim3(grid), dim3(NTHR), LDS_BYTES, stream, p);
#endif
}
```

```cpp
#include <hip/hip_runtime.h>
#include <cstdio>
#include <cstdint>

typedef unsigned short bf16_t;
typedef bf16_t act_t;
#define GAS __attribute__((address_space(1)))
#define LAS __attribute__((address_space(3)))

constexpr int DM = 1024, NB = 16, SEQ = 2048, NCX = 256, GRIDW = 64;
constexpr int NLAT = NB * SEQ, NCTX = NB * NCX, NROW = NLAT + NCTX;
constexpr int AB_IN = 1440, C_IN = 1536, PRJ_LD = 1536;
constexpr int NEXP = 32, DFF = 1024;
constexpr int CAP = 155648;
constexpr float RMS_EPS = 1e-6f;
constexpr int NTHR = 512;

constexpr size_t MiB = 1u << 20;
constexpr size_t ASZ = sizeof(act_t);
constexpr size_t WS_CTL = 0, CTL_BYTES = 1 * MiB;
constexpr size_t WS_MOD = 1 * MiB;
constexpr size_t WS_TOKE = 2 * MiB, WS_TOKP = 3 * MiB, WS_TOKG = 4 * MiB;
constexpr size_t WS_RINV = 5 * MiB;
constexpr size_t WS_TAB = 6 * MiB;
constexpr size_t TAB_A = 0, TAB_B = (size_t)SEQ * 32 * 8, TAB_C = TAB_B + (size_t)SEQ * 16 * 8, TAB_QG = TAB_C + (size_t)SEQ * 64 * 8;
constexpr size_t WS_XR = 16 * MiB;
constexpr size_t WS_H = WS_XR + 144 * MiB;
constexpr size_t WS_BIG = WS_H + (size_t)NROW * 1024 * ASZ;
constexpr size_t OFF_PRJ = 0;
constexpr size_t OFF_QB = OFF_PRJ + (size_t)NROW * 1536 * ASZ;
constexpr size_t OFF_KVB = OFF_QB + (size_t)NROW * 768 * ASZ;
constexpr size_t OFF_O = OFF_KVB + (size_t)NROW * 1024 * ASZ;
constexpr size_t BIG_A = OFF_O + (size_t)NROW * 1024 * ASZ;
constexpr size_t BIG_Y = (size_t)CAP * 1024 * ASZ;
constexpr size_t BIG_BYTES = BIG_A > BIG_Y ? BIG_A : BIG_Y;
constexpr size_t WS_ACT = WS_BIG + BIG_BYTES;
constexpr size_t WS_XS = WS_ACT + (size_t)CAP * 1024 * ASZ;
constexpr size_t WS_W = WS_XS + (size_t)CAP * 1024 * ASZ;
constexpr size_t WO_AB = 0;
constexpr size_t WO_QB = WO_AB + (size_t)1536 * 1024 * 2;
constexpr size_t WO_KVB = WO_QB + (size_t)768 * 384 * 2;
constexpr size_t WO_ABO = WO_KVB + (size_t)1024 * 256 * 2;
constexpr size_t WO_C = WO_ABO + (size_t)1024 * 1024 * 2;
constexpr size_t WO_CO = WO_C + (size_t)1536 * 1024 * 2;
constexpr size_t WO_W1 = WO_CO + (size_t)1024 * 1024 * 2;
constexpr size_t WO_W2 = WO_W1 + (size_t)64 * 2048 * 1024 * 2;
constexpr size_t WS_END = WS_W + WO_W2 + (size_t)64 * 1024 * 1024 * 2;

constexpr int CW_CNT = 64;
constexpr int CW_BAR = 4096;

__device__ __forceinline__ float bf2f(bf16_t v) { return __uint_as_float(((unsigned)v) << 16); }
__device__ __forceinline__ bf16_t f2bf(float f) { unsigned u = __float_as_uint(f); return (bf16_t)((u + 0x7fffu + ((u >> 16) & 1u)) >> 16); }
__device__ __forceinline__ float ldA(const float* p) { return *p; }
__device__ __forceinline__ float ldA(const bf16_t* p) { return bf2f(*p); }
__device__ __forceinline__ void stA(float* p, float v) { *p = v; }
__device__ __forceinline__ void stA(bf16_t* p, float v) { *p = f2bf(v); }
template <int N> __device__ __forceinline__ void load_vec(const float* p, float (&o)[N]) {
#pragma unroll
    for (int i = 0; i < N / 4; ++i) { const float4 t = ((const float4*)p)[i]; o[4 * i] = t.x; o[4 * i + 1] = t.y; o[4 * i + 2] = t.z; o[4 * i + 3] = t.w; }
}
template <int N> __device__ __forceinline__ void load_vec(const bf16_t* p, float (&o)[N]) {
#pragma unroll
    for (int i = 0; i < N / 8; ++i) { const uint4 t = ((const uint4*)p)[i];
        o[8 * i] = __uint_as_float(t.x << 16); o[8 * i + 1] = __uint_as_float(t.x & 0xffff0000u); o[8 * i + 2] = __uint_as_float(t.y << 16); o[8 * i + 3] = __uint_as_float(t.y & 0xffff0000u);
        o[8 * i + 4] = __uint_as_float(t.z << 16); o[8 * i + 5] = __uint_as_float(t.z & 0xffff0000u); o[8 * i + 6] = __uint_as_float(t.w << 16); o[8 * i + 7] = __uint_as_float(t.w & 0xffff0000u); }
}
__device__ __forceinline__ float wave_sum(float v) {
#pragma unroll
    for (int o = 1; o < 64; o <<= 1) v += __shfl_xor(v, o);
    return v;
}

__device__ __forceinline__ void wave_sum2(float& a, float& b) {
#pragma unroll
    for (int o = 1; o < 64; o <<= 1) { const float ta = __shfl_xor(a, o), tb = __shfl_xor(b, o); a += ta; b += tb; }
}
__device__ __forceinline__ void ld16f(const float* p, float (&v)[16]) {
#pragma unroll
    for (int i = 0; i < 4; ++i) { const float4 t = ((const float4*)p)[i]; v[4 * i] = t.x; v[4 * i + 1] = t.y; v[4 * i + 2] = t.z; v[4 * i + 3] = t.w; }
}
__device__ __forceinline__ void st16f(float* p, const float (&v)[16]) {
#pragma unroll
    for (int i = 0; i < 4; ++i) ((float4*)p)[i] = make_float4(v[4 * i], v[4 * i + 1], v[4 * i + 2], v[4 * i + 3]);
}
__device__ __forceinline__ unsigned cvtpk2(float lo, float hi) { unsigned r; asm volatile("v_cvt_pk_bf16_f32 %0, %1, %2" : "=v"(r) : "v"(lo), "v"(hi)); return r; }
__device__ __forceinline__ void st16bf(bf16_t* p, const float (&v)[16]) {
    ((uint4*)p)[0] = make_uint4(cvtpk2(v[0], v[1]), cvtpk2(v[2], v[3]), cvtpk2(v[4], v[5]), cvtpk2(v[6], v[7]));
    ((uint4*)p)[1] = make_uint4(cvtpk2(v[8], v[9]), cvtpk2(v[10], v[11]), cvtpk2(v[12], v[13]), cvtpk2(v[14], v[15]));
}

#ifndef XR16
#define XR16 1
#endif
#if XR16
typedef bf16_t xr_t;
#else
typedef float xr_t;
#endif
__device__ __forceinline__ void ld16x(const float* p, float (&v)[16]) { ld16f(p, v); }
__device__ __forceinline__ void st16x(float* p, const float (&v)[16]) { st16f(p, v); }
__device__ __forceinline__ void ld16x(const bf16_t* p, float (&v)[16]) {
#pragma unroll
    for (int i = 0; i < 2; ++i) { const uint4 t = ((const uint4*)p)[i]; const unsigned w[4] = {t.x, t.y, t.z, t.w};
#pragma unroll
        for (int j = 0; j < 4; ++j) { v[8 * i + 2 * j] = __uint_as_float(w[j] << 16); v[8 * i + 2 * j + 1] = __uint_as_float(w[j] & 0xffff0000u); } }
}
__device__ __forceinline__ void st16x(bf16_t* p, const float (&v)[16]) { st16bf(p, v); }
__device__ __forceinline__ void st16f8(unsigned char* p, const float (&v)[16]) {
    int o[4];
#pragma unroll
    for (int j = 0; j < 4; ++j) { const int t = __builtin_amdgcn_cvt_pk_fp8_f32(v[4 * j], v[4 * j + 1], 0, false); o[j] = __builtin_amdgcn_cvt_pk_fp8_f32(v[4 * j + 2], v[4 * j + 3], t, true); }
    *(int4*)p = make_int4(o[0], o[1], o[2], o[3]);
}
#define XB_TMO      128
#define XB_XCNT(j)  (256  + 64 * (j))
#define XB_XSUB(j)  (1280 + 64 * (j))
#define XB_XGEN(j)  (2304 + 64 * (j))
#define XB_TOP      3328
#define XB_TOPGEN   3392
#define XCD_BAR_WORDS 3456
#define XB_SPIN_CAP (1u << 22)
__device__ __forceinline__ unsigned xb_ld(unsigned* p)              { return __hip_atomic_load(p, __ATOMIC_RELAXED, __HIP_MEMORY_SCOPE_AGENT); }
__device__ __forceinline__ unsigned xb_add(unsigned* p, unsigned v) { return __hip_atomic_fetch_add(p, v, __ATOMIC_RELAXED, __HIP_MEMORY_SCOPE_AGENT); }
__device__ __forceinline__ unsigned xb_xcc_id() { return (unsigned)__builtin_amdgcn_s_getreg((3 << 11) | 20) & 0xFu; }
#define XB_SPIN(cond, bar) do { unsigned _sp = 0; while (cond) { __builtin_amdgcn_s_sleep(1); \
    if ((++_sp & 255u) == 0u) { if (xb_ld(&(bar)[XB_TMO])) break; if (_sp > XB_SPIN_CAP) { atomicAdd(&(bar)[XB_TMO], 1u); break; } } } } while (0)
struct XcdBarrier { unsigned* bar; unsigned x; volatile LAS unsigned* st; };
__device__ __forceinline__ bool xb_is_leader(int wave0) { return wave0 == 0 && __builtin_amdgcn_mbcnt_hi(~0u, __builtin_amdgcn_mbcnt_lo(~0u, 0u)) == 0u; }
__device__ __forceinline__ XcdBarrier xcd_barrier_post(unsigned* bar, volatile LAS unsigned* st, int wave0) {
    XcdBarrier b; b.bar = bar; b.x = xb_xcc_id(); b.st = st;
    if (xb_is_leader(wave0)) (void)xb_add(&bar[XB_XCNT(b.x)], 1u);
    return b;
}
__device__ __forceinline__ void xcd_barrier_complete(unsigned* bar, unsigned x, unsigned& nloc, unsigned& nx) {
    const unsigned G = gridDim.x * gridDim.y * gridDim.z;
    unsigned sum, cnt, mine, sp = 0u;
    for (;;) {
        sum = 0u; cnt = 0u; mine = 0u;
#pragma unroll
        for (unsigned j = 0; j < 16; ++j) { const unsigned c = xb_ld(&bar[XB_XCNT(j)]); sum += c; cnt += (c > 0u) ? 1u : 0u; mine = (j == x) ? c : mine; }
        if (sum == G) break;
        __builtin_amdgcn_s_sleep(1);
        if ((++sp & 255u) == 0u) { if (xb_ld(&bar[XB_TMO])) break; if (sp > XB_SPIN_CAP) { atomicAdd(&bar[XB_TMO], 1u); break; } }
    }
    nloc = mine > 0u ? mine : 1u; nx = cnt > 0u ? cnt : 1u;
}
__device__ __forceinline__ void xcd_barrier(const XcdBarrier& b, int wave0) {
    asm volatile("s_waitcnt vmcnt(0)" ::: "memory");
    __syncthreads();
    if (xb_is_leader(wave0)) {
        unsigned* bar = b.bar;
        __builtin_amdgcn_s_waitcnt(0);
        unsigned nloc = b.st[0], nx = b.st[1];
        if (nloc == 0u) { xcd_barrier_complete(bar, b.x, nloc, nx); b.st[0] = nloc; b.st[1] = nx; }
        const unsigned old = xb_add(&bar[XB_XSUB(b.x)], 1u);
        const unsigned gen = old / nloc;
        if (old + 1u == (gen + 1u) * nloc) {
            __builtin_amdgcn_fence(__ATOMIC_RELEASE, "agent");
            asm volatile("s_waitcnt vmcnt(0)" ::: "memory");
            const unsigned og = xb_add(&bar[XB_TOP], 1u);
            const unsigned tg = og / nx;
            if (og + 1u == (tg + 1u) * nx) xb_add(&bar[XB_TOPGEN], 1u);
            else XB_SPIN(xb_ld(&bar[XB_TOPGEN]) == tg, bar);
            __builtin_amdgcn_fence(__ATOMIC_ACQUIRE, "agent");
            xb_add(&bar[XB_XGEN(b.x)], 1u);
            asm volatile("s_waitcnt vmcnt(0)" ::: "memory");
        } else {
            XB_SPIN(xb_ld(&bar[XB_XGEN(b.x)]) == gen, bar);
            __builtin_amdgcn_fence(__ATOMIC_ACQUIRE, "agent");
            asm volatile("s_waitcnt vmcnt(0)" ::: "memory");
        }
    }
    __syncthreads();
}


#ifndef FAST_GEMM
#define FAST_GEMM 1
#endif
namespace pg8 {
#define PG8_LAS __attribute__((address_space(3)))
typedef short bf16x8 __attribute__((ext_vector_type(8)));
typedef float f32x4 __attribute__((ext_vector_type(4)));
typedef unsigned u32x4 __attribute__((ext_vector_type(4)));
constexpr int BM = 256, BK = 64, HALF = 128, HTB = HALF * BK * 2  , STAGE_BYTES = 8 * HTB, NXCD = 8, WGM = 8;

__host__ __device__ __forceinline__ int lds_byte(int r, int c) { const int st = (r >> 4) * 2 + (c >> 5), rr = r & 15, cc = c & 31, ob = rr * 64 + cc * 2; return st * 1024 + (ob ^ (((ob >> 9) & 1) << 5)); }
__host__ __device__ __forceinline__ void stage_rc(int b, int& R, int& C) { const int st = b / 1024, sb = b % 1024, swz = sb ^ (((sb >> 9) & 1) << 5); R = (st >> 1) * 16 + swz / 64; C = (st & 1) * 32 + (swz % 64) / 2; }
__host__ __device__ __forceinline__ int perm32(int rho) { const int n = rho >> 4, i = rho & 15; return 8 * (i >> 2) + 4 * n + (i & 3); }


struct Unit { const char* a; const char* b; int pm, pn, aux; };
__device__ __forceinline__ unsigned cvt_pk_bf16(float lo, float hi) { unsigned r; asm volatile("v_cvt_pk_bf16_f32 %0, %1, %2" : "=v"(r) : "v"(lo), "v"(hi)); return r; }
typedef int v8i32 __attribute__((ext_vector_type(8)));
__device__ __forceinline__ v8i32 cat16(bf16x8 lo, bf16x8 hi) { typedef int v4i32 __attribute__((ext_vector_type(4))); const v4i32 a = __builtin_bit_cast(v4i32, lo), b = __builtin_bit_cast(v4i32, hi); return __builtin_shufflevector(a, b, 0, 1, 2, 3, 4, 5, 6, 7); }
template <class Epi, class Sched, bool ALIGN_EPI = false, bool SP2 = false, bool F8 = false>
__device__ __forceinline__ void gemm_phase(const int tid, PG8_LAS unsigned char* lds, const int K, const int lda, const Sched& S, const Epi& E) {
    const int wid = __builtin_amdgcn_readfirstlane(tid >> 6), lane = tid & 63, wr = wid >> 2, wc = wid & 3, fr = lane & 15, fq = lane >> 4;
    const int nt = F8 ? K / (2 * BK) : K / BK;
    unsigned voffA[2], voffB[2];
#pragma unroll
    for (int i = 0; i < 2; ++i) { int R, C; stage_rc(tid * 16 + i * 8192, R, C); const int Rb = Epi::PERM ? ((R & ~31) + perm32(R & 31)) : R;
        voffA[i] = F8 ? (unsigned)(R * lda + 2 * C) : (unsigned)(R * lda + C) * 2u; voffB[i] = F8 ? (unsigned)(Rb * K + 2 * C) : (unsigned)(Rb * K + C) * 2u; }
    const size_t kstep = (size_t)(BK * 2);
    const size_t hstepA = (size_t)HALF * lda * (F8 ? 1 : 2);
    const size_t hstep = (size_t)HALF * K * (F8 ? 1 : 2);
    const unsigned ldsbase = (unsigned)__builtin_amdgcn_readfirstlane((int)((unsigned)(uintptr_t)lds + (unsigned)wid * 1024u));
    const unsigned ldsw = (unsigned)wid * 1024u;
    const int aoff = lds_byte(wr * 64 + fr, fq * 8), boff = lds_byte(wc * 32 + fr, fq * 8);
#define PG8_SA(b, h) (((b) * 2 + (h)) * HTB)
#define PG8_SB(b, h) ((4 + (b) * 2 + (h)) * HTB)
#define PG8_STAGE(bufoff, gbase, voff) do { _Pragma("unroll") for (int _i = 0; _i < 2; ++_i) { \
        if constexpr (F8) { unsigned keep_; asm volatile("s_mov_b32 %0, m0\n\ts_mov_b32 m0, %3\n\ts_nop 0\n\tglobal_load_lds_dwordx4 %1, %2\n\ts_mov_b32 m0, %0" : "=&s"(keep_) : "v"((voff)[_i]), "s"((const char*)(gbase)), "s"(ldsbase + (unsigned)((bufoff) + _i * 8192)) : "memory"); } \
        else __builtin_amdgcn_global_load_lds((const unsigned*)((const char*)(gbase) + (voff)[_i]), (PG8_LAS unsigned*)(lds + (bufoff) + ldsw + _i * 8192), 16, 0, 0); } } while (0)
#define PG8_LDA(dst, b, h) do { _Pragma("unroll") for (int m = 0; m < 4; ++m) { _Pragma("unroll") for (int k = 0; k < 2; ++k) dst[m][k] = *(const PG8_LAS bf16x8*)(lds + PG8_SA(b, h) + aoff + m * 2048 + k * 1024); \
        if constexpr (F8) dst##8[m] = cat16(dst[m][0], dst[m][1]); } } while (0)
#define PG8_LDB(dst, b, h) do { _Pragma("unroll") for (int n = 0; n < 2; ++n) { _Pragma("unroll") for (int k = 0; k < 2; ++k) dst[n][k] = *(const PG8_LAS bf16x8*)(lds + PG8_SB(b, h) + boff + n * 2048 + k * 1024); \
        if constexpr (F8) dst##8[n] = cat16(dst[n][0], dst[n][1]); } } while (0)
#define PG8_MMA(ai, bj, At, Bt) do { __builtin_amdgcn_s_setprio(1); _Pragma("unroll") for (int m = 0; m < 4; ++m) _Pragma("unroll") for (int n = 0; n < 2; ++n) { \
        if constexpr (F8) acc[ai][bj][m][n] = __builtin_amdgcn_mfma_scale_f32_16x16x128_f8f6f4(Bt##8[n], At##8[m], acc[ai][bj][m][n], 0, 0, 0, 0x7f7f7f7f, 0, 0x7f7f7f7f); \
        else { _Pragma("unroll") for (int k = 0; k < 2; ++k) acc[ai][bj][m][n] = __builtin_amdgcn_mfma_f32_16x16x32_bf16(Bt[n][k], At[m][k], acc[ai][bj][m][n], 0, 0, 0); } } __builtin_amdgcn_s_setprio(0); } while (0)
#define PG8_WAIT_V(n) asm volatile("s_waitcnt vmcnt(" #n ")" ::: "memory")
#define PG8_WAIT_L(n) asm volatile("s_waitcnt lgkmcnt(" #n ")" ::: "memory")
#define PG8_BAR __builtin_amdgcn_s_barrier()
#define PG8_SCHED __builtin_amdgcn_sched_barrier(0)
    Unit cur, nxt; int ui = 0;
    if (!S.next(0, cur)) return;
    f32x4 acc[2][2][4][2];
#pragma unroll
    for (int a = 0; a < 2; ++a)
#pragma unroll
        for (int b = 0; b < 2; ++b)
#pragma unroll
            for (int m = 0; m < 4; ++m)
#pragma unroll
                for (int n = 0; n < 2; ++n) acc[a][b][m][n] = (f32x4){0.f, 0.f, 0.f, 0.f};
    bf16x8 At[4][2], B0[2][2], B1[2][2]; v8i32 At8[4], B08[2], B18[2]; (void)At8; (void)B08; (void)B18;
    const char* cA = cur.a; const char* cB = cur.b;
    S.a_ready(cur);
    if constexpr (SP2) {
        PG8_STAGE(PG8_SB(0, 0), cB, voffB); PG8_STAGE(PG8_SB(0, 1), cB + hstep, voffB); PG8_STAGE(PG8_SA(0, 0), cA, voffA); PG8_STAGE(PG8_SA(0, 1), cA + hstepA, voffA);
        if (wr == 1) PG8_BAR;
        PG8_WAIT_V(2); PG8_BAR;
        PG8_STAGE(PG8_SB(1, 0), cB + kstep, voffB); PG8_STAGE(PG8_SA(1, 0), cA + kstep, voffA); PG8_STAGE(PG8_SB(1, 1), cB + hstep + kstep, voffB);
        PG8_WAIT_V(6); PG8_BAR;
    } else {
        PG8_STAGE(PG8_SB(0, 0), cB, voffB); PG8_STAGE(PG8_SA(0, 0), cA, voffA); PG8_STAGE(PG8_SB(0, 1), cB + hstep, voffB); PG8_STAGE(PG8_SA(0, 1), cA + hstepA, voffA);
        if (wr == 1) PG8_BAR;
        PG8_WAIT_V(4); PG8_BAR;
        PG8_STAGE(PG8_SB(1, 0), cB + kstep, voffB); PG8_STAGE(PG8_SA(1, 0), cA + kstep, voffA); PG8_STAGE(PG8_SB(1, 1), cB + hstep + kstep, voffB);
        PG8_WAIT_V(6); PG8_BAR;
    }
    for (;;) {
        const bool has_next = S.next(ui + 1, nxt);
        const char* nA = has_next ? nxt.a : cA; const char* nB = has_next ? nxt.b : cB;
        if constexpr (F8 && Epi::BIAS_LDS) {
            unsigned zb_ = 0u; asm volatile("" : "+v"(zb_)); unsigned bo_ = __builtin_amdgcn_mbcnt_hi(~0u, __builtin_amdgcn_mbcnt_lo(~0u, zb_)); asm volatile("" : "+v"(bo_)); bo_ = (bo_ << 4) + E.bias_slice_bytes(cur);
            unsigned keep_; asm volatile("s_mov_b32 %0, m0\n\ts_mov_b32 m0, %3\n\ts_nop 0\n\tglobal_load_lds_dwordx4 %1, %2\n\ts_mov_b32 m0, %0" : "=&s"(keep_) : "v"(bo_), "s"((const char*)E.bias), "s"(ldsbase + 131072u) : "memory"); }
#pragma unroll 1
        for (int t = 0; t < nt; t += 2) {
            const bool last = (t == nt - 2);
            const char* a1 = cA + (size_t)(t + 1) * kstep;
            const char* a2 = last ? nA : cA + (size_t)(t + 2) * kstep; const char* b2 = last ? nB : cB + (size_t)(t + 2) * kstep;
            const char* a3 = a2 + kstep; const char* b3 = b2 + kstep;
            if (last && has_next) S.a_ready(nxt);
            if constexpr (SP2) {
            PG8_LDB(B0, 0, 0); PG8_LDB(B1, 0, 1); PG8_SCHED; PG8_LDA(At, 0, 0); PG8_STAGE(PG8_SA(1, 1), a1 + hstepA, voffA);
            PG8_WAIT_V(8); PG8_WAIT_L(0); PG8_BAR; PG8_MMA(0, 0, At, B0); PG8_MMA(0, 1, At, B1); PG8_BAR; PG8_SCHED;
            PG8_LDA(At, 0, 1); PG8_STAGE(PG8_SB(0, 0), b2, voffB); PG8_STAGE(PG8_SB(0, 1), b2 + hstep, voffB); PG8_STAGE(PG8_SA(0, 0), a2, voffA);
            PG8_WAIT_V(8); PG8_WAIT_L(0); PG8_BAR; PG8_MMA(1, 0, At, B0); PG8_MMA(1, 1, At, B1); PG8_BAR; PG8_SCHED;
            PG8_LDB(B0, 1, 0); PG8_LDB(B1, 1, 1); PG8_SCHED; PG8_LDA(At, 1, 0); PG8_STAGE(PG8_SA(0, 1), a2 + hstepA, voffA);
            PG8_WAIT_V(8); PG8_WAIT_L(0); PG8_BAR; PG8_MMA(0, 0, At, B0); PG8_MMA(0, 1, At, B1); PG8_BAR; PG8_SCHED;
            PG8_LDA(At, 1, 1); PG8_STAGE(PG8_SB(1, 0), b3, voffB); PG8_STAGE(PG8_SB(1, 1), b3 + hstep, voffB); PG8_STAGE(PG8_SA(1, 0), a3, voffA);
            PG8_WAIT_V(8); PG8_WAIT_L(0); PG8_BAR; PG8_MMA(1, 0, At, B0); PG8_MMA(1, 1, At, B1); PG8_BAR; PG8_SCHED;
            } else {
            PG8_LDB(B0, 0, 0); PG8_SCHED; PG8_LDA(At, 0, 0); PG8_STAGE(PG8_SA(1, 1), a1 + hstepA, voffA);
            PG8_WAIT_L(8); PG8_BAR; PG8_WAIT_L(0); PG8_MMA(0, 0, At, B0); PG8_BAR; PG8_SCHED;
            PG8_LDB(B1, 0, 1); PG8_STAGE(PG8_SB(0, 0), b2, voffB);
            PG8_BAR; PG8_WAIT_L(0); PG8_MMA(0, 1, At, B1); PG8_BAR;
            PG8_LDA(At, 0, 1); PG8_STAGE(PG8_SA(0, 0), a2, voffA);
            PG8_BAR; PG8_WAIT_L(0); PG8_MMA(1, 0, At, B0); PG8_BAR; PG8_SCHED;
            PG8_STAGE(PG8_SB(0, 1), b2 + hstep, voffB);
            PG8_WAIT_V(6); PG8_BAR; PG8_MMA(1, 1, At, B1); PG8_BAR;
            PG8_LDB(B0, 1, 0); PG8_SCHED; PG8_LDA(At, 1, 0); PG8_STAGE(PG8_SA(0, 1), a2 + hstepA, voffA);
            PG8_WAIT_L(8); PG8_BAR; PG8_WAIT_L(0); PG8_MMA(0, 0, At, B0); PG8_BAR; PG8_SCHED;
            PG8_LDB(B1, 1, 1); PG8_STAGE(PG8_SB(1, 0), b3, voffB);
            PG8_BAR; PG8_WAIT_L(0); PG8_MMA(0, 1, At, B1); PG8_BAR;
            PG8_LDA(At, 1, 1); PG8_STAGE(PG8_SA(1, 0), a3, voffA);
            PG8_BAR; PG8_WAIT_L(0); PG8_MMA(1, 0, At, B0); PG8_BAR; PG8_SCHED;
            PG8_STAGE(PG8_SB(1, 1), b3 + hstep, voffB);
            PG8_WAIT_V(6); PG8_BAR; PG8_MMA(1, 1, At, B1); PG8_BAR;
            }
        }
        if constexpr (ALIGN_EPI) { if (wr == 0) PG8_BAR; }
        if constexpr (!Epi::AFTER_DRAIN) { unsigned zl_ = 0u; asm volatile("" : "+v"(zl_)); int tl_ = (int)__builtin_amdgcn_mbcnt_hi(~0u, __builtin_amdgcn_mbcnt_lo(~0u, zl_)); asm volatile("" : "+v"(tl_));
            if constexpr (F8 && Epi::BIAS_LDS) E(acc, cur, wr, wc, tl_ & 15, (tl_ & 63) >> 4, (const PG8_LAS float*)(lds + 131072 + wid * 1024)); else E(acc, cur, wr, wc, tl_ & 15, (tl_ & 63) >> 4);
            S.done(cur); }
        if (!has_next) break;
#pragma unroll
        for (int a = 0; a < 2; ++a)
#pragma unroll
            for (int b = 0; b < 2; ++b)
#pragma unroll
                for (int m = 0; m < 4; ++m)
#pragma unroll
                    for (int n = 0; n < 2; ++n) acc[a][b][m][n] = (f32x4){0.f, 0.f, 0.f, 0.f};
        cur = nxt; cA = nA; cB = nB; ++ui;
        if constexpr (ALIGN_EPI) { if (wr == 1) PG8_BAR; }
    }
    PG8_WAIT_V(0);
    if constexpr (!ALIGN_EPI) { if (wr == 0) PG8_BAR; }
    PG8_BAR;
    if constexpr (Epi::AFTER_DRAIN) { E.fused(acc, cur, wr, wc, fr, fq, lds, wid, lane); S.done(cur); }
#undef PG8_SA
#undef PG8_SB
#undef PG8_STAGE
#undef PG8_LDA
#undef PG8_LDB
#undef PG8_MMA
#undef PG8_WAIT_V
#undef PG8_WAIT_L
#undef PG8_BAR
#undef PG8_SCHED
}
}
namespace pg8 {
struct OrderMap {
    __device__ __forceinline__ static bool map(int i, int G, int c, int nM, int nN, int& pm, int& pn) {
        const int nwg = nM * nN; const int L = i * G + c; if (L >= nwg) return false;
        int wgid = L; { const int q = nwg / NXCD, r = nwg % NXCD, xcd = wgid % NXCD, off = wgid / NXCD; wgid = (xcd < r ? xcd * (q + 1) : r * (q + 1) + (xcd - r) * q) + off; }
        const int nig = WGM * nN, gid = wgid / nig, fm = gid * WGM, gsz = (nM - fm) < WGM ? (nM - fm) : WGM;
        pm = fm + ((wgid % nig) % gsz); pn = (wgid % nig) / gsz; return true;
    }
};
struct DenseOrder {
    const char* A; const char* B; int nM, nN, G, c; size_t tstepA, tstepB;
    __device__ __forceinline__ bool next(int i, Unit& u) const { int pm, pn; if (!OrderMap::map(i, G, c, nM, nN, pm, pn)) return false; u.pm = pm; u.pn = pn; u.aux = 0; u.a = A + (size_t)pm * tstepA; u.b = B + (size_t)pn * tstepB; return true; }
    __device__ __forceinline__ void a_ready(const Unit&) const {}
    __device__ __forceinline__ void done(const Unit&) const {}
};
struct MoeOrder {
    const char* A; const char* B; const PG8_LAS int* tile_e; int nM, nN, G, c; size_t tstep, estep;
    __device__ __forceinline__ bool next(int i, Unit& u) const { int pm, pn; if (!OrderMap::map(i, G, c, nM, nN, pm, pn)) return false; const int e = __builtin_amdgcn_readfirstlane(tile_e[pm]); u.pm = pm; u.pn = pn; u.aux = e;
        u.a = A + (size_t)pm * tstep; u.b = B + (size_t)e * estep + (size_t)pn * tstep; return true; }
    __device__ __forceinline__ void a_ready(const Unit&) const {}
    __device__ __forceinline__ void done(const Unit&) const {}
};
struct EpiStoreBf16 { static constexpr bool PERM = true, AFTER_DRAIN = false, BIAS_LDS = false;
    bf16_t* O; int ldc; float ascale;
    __device__ __forceinline__ void operator()(const f32x4 (&acc)[2][2][4][2], const Unit& u, int wr, int wc, int fr, int fq) const {
        bf16_t* base = O + (size_t)(u.pm * BM + wr * 64 + fr) * ldc + u.pn * BM + wc * 32 + 8 * fq;
        float asc = ascale; asm volatile("" : "+v"(asc));
#pragma unroll
        for (int ai = 0; ai < 2; ++ai)
#pragma unroll
            for (int m = 0; m < 4; ++m) { bf16_t* rowp = base + (size_t)(ai * HALF + m * 16) * ldc;
#pragma unroll
                for (int bj = 0; bj < 2; ++bj) { const f32x4 v0 = acc[ai][bj][m][0] * asc, v1 = acc[ai][bj][m][1] * asc; u32x4 w;
                    w.x = cvt_pk_bf16(v0[0], v0[1]); w.y = cvt_pk_bf16(v0[2], v0[3]); w.z = cvt_pk_bf16(v1[0], v1[1]); w.w = cvt_pk_bf16(v1[2], v1[3]);
                    *(u32x4*)(rowp + bj * HALF) = w; } }
    }
};
struct EpiScaleBf16 { static constexpr bool PERM = true, AFTER_DRAIN = false, BIAS_LDS = false;
    bf16_t* O; int ldc; const float* rs;
    __device__ __forceinline__ void operator()(const f32x4 (&acc)[2][2][4][2], const Unit& u, int wr, int wc, int fr, int fq) const {
        const int row0 = u.pm * BM + wr * 64 + fr; bf16_t* base = O + (size_t)row0 * ldc + u.pn * BM + wc * 32 + 8 * fq;
#pragma unroll
        for (int ai = 0; ai < 2; ++ai)
#pragma unroll
            for (int m = 0; m < 4; ++m) { bf16_t* rowp = base + (size_t)(ai * HALF + m * 16) * ldc; const float sc = rs[2 * (row0 + ai * HALF + m * 16)];
#pragma unroll
                for (int bj = 0; bj < 2; ++bj) { const f32x4 v0 = acc[ai][bj][m][0] * sc, v1 = acc[ai][bj][m][1] * sc; u32x4 w;
                    w.x = cvt_pk_bf16(v0[0], v0[1]); w.y = cvt_pk_bf16(v0[2], v0[3]); w.z = cvt_pk_bf16(v1[0], v1[1]); w.w = cvt_pk_bf16(v1[2], v1[3]);
                    *(u32x4*)(rowp + bj * HALF) = w; } }
    }
};
template <typename ST, typename OT>
struct EpiResidT { static constexpr bool PERM = true, AFTER_DRAIN = false, BIAS_LDS = false;
    const ST* src_lat; const ST* src_ctx; OT* out; const float* mod_g1; float ascale;
    __device__ __forceinline__ void operator()(const f32x4 (&acc)[2][2][4][2], const Unit& u, int wr, int wc, int fr, int fq) const {
        const int row_t = u.pm * BM; const int mrow = row_t < NLAT ? row_t / SEQ : NB;
        const float* g = mod_g1 + (size_t)mrow * 6144 + u.pn * BM + wc * 32 + 8 * fq;
        const ST* sb = (row_t < NLAT ? src_lat + (size_t)row_t * 1024 : src_ctx + (size_t)(row_t - NLAT) * 1024) + u.pn * BM + wc * 32 + 8 * fq;
        OT* ob = out + (size_t)row_t * 1024 + u.pn * BM + wc * 32 + 8 * fq;
        f32x4 gv[2][2];
#pragma unroll
        for (int bj = 0; bj < 2; ++bj)
#pragma unroll
            for (int n = 0; n < 2; ++n) gv[bj][n] = *(const f32x4*)(g + bj * HALF + 4 * n) * ascale;
#pragma unroll
        for (int ai = 0; ai < 2; ++ai)
#pragma unroll
            for (int m = 0; m < 4; ++m) { const size_t off = (size_t)(wr * 64 + fr + ai * HALF + m * 16) * 1024;
#pragma unroll
                for (int bj = 0; bj < 2; ++bj) { f32x4 sv[2];
                    if constexpr (sizeof(ST) == 2) { const u32x4 t = *(const u32x4*)(sb + off + bj * HALF);
                        sv[0] = (f32x4){__uint_as_float(t[0] << 16), __uint_as_float(t[0] & 0xffff0000u), __uint_as_float(t[1] << 16), __uint_as_float(t[1] & 0xffff0000u)};
                        sv[1] = (f32x4){__uint_as_float(t[2] << 16), __uint_as_float(t[2] & 0xffff0000u), __uint_as_float(t[3] << 16), __uint_as_float(t[3] & 0xffff0000u)}; }
                    else { sv[0] = *(const f32x4*)(sb + off + bj * HALF); sv[1] = *(const f32x4*)(sb + off + bj * HALF + 4); }
                    const f32x4 o0 = sv[0] + gv[bj][0] * acc[ai][bj][m][0], o1 = sv[1] + gv[bj][1] * acc[ai][bj][m][1];
                    if constexpr (sizeof(OT) == 2) { u32x4 t; t[0] = cvt_pk_bf16(o0[0], o0[1]); t[1] = cvt_pk_bf16(o0[2], o0[3]); t[2] = cvt_pk_bf16(o1[0], o1[1]); t[3] = cvt_pk_bf16(o1[2], o1[3]); *(u32x4*)(ob + off + bj * HALF) = t; }
                    else { *(f32x4*)(ob + off + bj * HALF) = o0; *(f32x4*)(ob + off + bj * HALF + 4) = o1; } }
                asm volatile("" ::: "memory"); }
    }
};
__device__ __forceinline__ float swiglu1(float g, float l, float c7, float cn) {
    const float glu = fminf(g, c7), lin = __builtin_amdgcn_fmed3f(l, -c7, c7);
    const float s = glu * __builtin_amdgcn_rcpf(1.0f + __builtin_amdgcn_exp2f(cn * glu));
    return fmaf(s, lin, s);
}
struct EpiSwiglu { static constexpr bool PERM = true, AFTER_DRAIN = false, BIAS_LDS = false;
    bf16_t* O; const float* bias; float ascale;
    __device__ __forceinline__ void operator()(const f32x4 (&acc)[2][2][4][2], const Unit& u, int wr, int wc, int fr, int fq) const {
        const int col0 = u.pn * BM + wc * 32 + 8 * fq; const float* b = bias + (size_t)u.aux * 2048 + col0;
        float c7 = 7.0f, cn = -1.702f * 1.4426950408889634f; asm volatile("" : "+v"(c7), "+v"(cn));
        bf16_t* base = O + (size_t)(u.pm * BM + wr * 64 + fr) * 1024 + (col0 >> 1);
        f32x4 bv[2][2];
#pragma unroll
        for (int bj = 0; bj < 2; ++bj)
#pragma unroll
            for (int n = 0; n < 2; ++n) bv[bj][n] = *(const f32x4*)(b + bj * HALF + 4 * n);
#pragma unroll
        for (int ai = 0; ai < 2; ++ai)
#pragma unroll
            for (int m = 0; m < 4; ++m) { bf16_t* rowp = base + (size_t)(ai * HALF + m * 16) * 1024;
#pragma unroll
                for (int bj = 0; bj < 2; ++bj) { const f32x4 v0 = acc[ai][bj][m][0] * ascale + bv[bj][0], v1 = acc[ai][bj][m][1] * ascale + bv[bj][1];
                    uint2 w; w.x = cvt_pk_bf16(swiglu1(v0[0], v0[1], c7, cn), swiglu1(v0[2], v0[3], c7, cn)); w.y = cvt_pk_bf16(swiglu1(v1[0], v1[1], c7, cn), swiglu1(v1[2], v1[3], c7, cn));
                    *(uint2*)(rowp + bj * (HALF / 2)) = w; } }
    }
};
struct EpiSwigluF8 { static constexpr bool PERM = true, AFTER_DRAIN = false, BIAS_LDS = true;
    unsigned char* O; const float* bias;
    __device__ __forceinline__ unsigned bias_slice_bytes(const Unit& u) const { return (unsigned)(u.aux * 2048 + u.pn * BM) * 4u; }
    __device__ __forceinline__ void operator()(const f32x4 (&acc)[2][2][4][2], const Unit& u, int wr, int wc, int fr, int fq, const PG8_LAS float* bl) const {
        const int col0 = u.pn * BM + wc * 32 + 8 * fq; const PG8_LAS float* b = bl + wc * 32 + 8 * fq;
        float c7 = 7.0f, cn = -1.702f * 1.4426950408889634f, c32 = 0.03125f; asm volatile("" : "+v"(c7), "+v"(cn), "+v"(c32));
        unsigned char* base = O + (size_t)(u.pm * BM + wr * 64 + fr) * 1024 + (col0 >> 1);
        f32x4 bv[2][2];
#pragma unroll
        for (int bj = 0; bj < 2; ++bj)
#pragma unroll
            for (int n = 0; n < 2; ++n) bv[bj][n] = *(const PG8_LAS f32x4*)(b + bj * HALF + 4 * n);
#pragma unroll
        for (int ai = 0; ai < 2; ++ai)
#pragma unroll
            for (int m = 0; m < 4; ++m) { unsigned char* rowp = base + (size_t)(ai * HALF + m * 16) * 1024;
#pragma unroll
                for (int bj = 0; bj < 2; ++bj) { const f32x4 v0 = acc[ai][bj][m][0] * c32 + bv[bj][0], v1 = acc[ai][bj][m][1] * c32 + bv[bj][1];
                    int w = __builtin_amdgcn_cvt_pk_fp8_f32(swiglu1(v0[0], v0[1], c7, cn), swiglu1(v0[2], v0[3], c7, cn), 0, false); w = __builtin_amdgcn_cvt_pk_fp8_f32(swiglu1(v1[0], v1[1], c7, cn), swiglu1(v1[2], v1[3], c7, cn), w, true);
                    *(int*)(rowp + bj * (HALF / 2)) = w; } }
    }
};
struct EpiBiasF8 { static constexpr bool PERM = true, AFTER_DRAIN = false, BIAS_LDS = true;
    unsigned char* O; const float* bias; float ascale;
    __device__ __forceinline__ unsigned bias_slice_bytes(const Unit& u) const { return (unsigned)(u.aux * 1024 + u.pn * BM) * 4u; }
    __device__ __forceinline__ void operator()(const f32x4 (&acc)[2][2][4][2], const Unit& u, int wr, int wc, int fr, int fq, const PG8_LAS float* bl) const {
        const int col0 = u.pn * BM + wc * 32 + 8 * fq; const PG8_LAS float* b = bl + wc * 32 + 8 * fq;
        float asc = ascale; asm volatile("" : "+v"(asc));
        unsigned char* base = O + (size_t)(u.pm * BM + wr * 64 + fr) * 1024 + col0;
        f32x4 bv[2][2];
#pragma unroll
        for (int bj = 0; bj < 2; ++bj)
#pragma unroll
            for (int n = 0; n < 2; ++n) bv[bj][n] = *(const PG8_LAS f32x4*)(b + bj * HALF + 4 * n);
#pragma unroll
        for (int ai = 0; ai < 2; ++ai)
#pragma unroll
            for (int m = 0; m < 4; ++m) { unsigned char* rowp = base + (size_t)(ai * HALF + m * 16) * 1024;
#pragma unroll
                for (int bj = 0; bj < 2; ++bj) { const f32x4 v0 = acc[ai][bj][m][0] * asc + bv[bj][0], v1 = acc[ai][bj][m][1] * asc + bv[bj][1];
                    int lo = __builtin_amdgcn_cvt_pk_fp8_f32(v0[0], v0[1], 0, false); lo = __builtin_amdgcn_cvt_pk_fp8_f32(v0[2], v0[3], lo, true);
                    int hi = __builtin_amdgcn_cvt_pk_fp8_f32(v1[0], v1[1], 0, false); hi = __builtin_amdgcn_cvt_pk_fp8_f32(v1[2], v1[3], hi, true);
                    *(int2*)(rowp + bj * HALF) = make_int2(lo, hi); } }
    }
};
struct EpiBiasBf16 { static constexpr bool PERM = true, AFTER_DRAIN = false, BIAS_LDS = false;
    bf16_t* O; const float* bias; float ascale;
    __device__ __forceinline__ void operator()(const f32x4 (&acc)[2][2][4][2], const Unit& u, int wr, int wc, int fr, int fq) const {
        const int col0 = u.pn * BM + wc * 32 + 8 * fq; const float* b = bias + (size_t)u.aux * 1024 + col0;
        float asc = ascale; asm volatile("" : "+v"(asc));
        bf16_t* base = O + (size_t)(u.pm * BM + wr * 64 + fr) * 1024 + col0;
        f32x4 bv[2][2];
#pragma unroll
        for (int bj = 0; bj < 2; ++bj)
#pragma unroll
            for (int n = 0; n < 2; ++n) bv[bj][n] = *(const f32x4*)(b + bj * HALF + 4 * n);
#pragma unroll
        for (int ai = 0; ai < 2; ++ai)
#pragma unroll
            for (int m = 0; m < 4; ++m) { bf16_t* rowp = base + (size_t)(ai * HALF + m * 16) * 1024;
#pragma unroll
                for (int bj = 0; bj < 2; ++bj) { const f32x4 v0 = acc[ai][bj][m][0] * asc + bv[bj][0], v1 = acc[ai][bj][m][1] * asc + bv[bj][1]; u32x4 w;
                    w.x = cvt_pk_bf16(v0[0], v0[1]); w.y = cvt_pk_bf16(v0[2], v0[3]); w.z = cvt_pk_bf16(v1[0], v1[1]); w.w = cvt_pk_bf16(v1[2], v1[3]);
                    *(u32x4*)(rowp + bj * HALF) = w; } }
    }
};
}
__device__ __forceinline__ unsigned pk2(float lo, float hi) { return (unsigned)f2bf(lo) | ((unsigned)f2bf(hi) << 16); }
__device__ __forceinline__ void transpose_item(const float* __restrict__ W, int K, int N, bf16_t* __restrict__ WT, LAS float* scr, int item, int lane, const float* rowscale = nullptr, float cscale = 1.0f, int cs_ncols = 1 << 30) {
    const int nblk = N / 32, kb = item / nblk, nb = item % nblk, k0 = 64 * kb, n0 = 32 * nb;
    const float cs = n0 < cs_ncols ? cscale : 1.0f;
#pragma unroll 8
    for (int i = 0; i < 32; ++i) { const int kk = 2 * i + (lane >> 5); float w = W[(size_t)(k0 + kk) * N + n0 + (lane & 31)]; if (rowscale) w *= rowscale[k0 + kk]; scr[kk * 33 + (lane & 31)] = w * cs; }
    asm volatile("s_waitcnt lgkmcnt(0)" ::: "memory");
    const int c = lane & 7;
#pragma unroll
    for (int j = 0; j < 4; ++j) { const int n = (lane >> 3) + 8 * j; const LAS float* sp = scr + (8 * c) * 33 + n;
        uint4 o; o.x = pk2(sp[0 * 33], sp[1 * 33]); o.y = pk2(sp[2 * 33], sp[3 * 33]); o.z = pk2(sp[4 * 33], sp[5 * 33]); o.w = pk2(sp[6 * 33], sp[7 * 33]);
        *(uint4*)(WT + (size_t)(n0 + n) * K + k0 + 8 * c) = o; }
    asm volatile("s_waitcnt lgkmcnt(0)" ::: "memory");
}

__device__ __forceinline__ void transpose_item_f8(const float* __restrict__ W, int K, int N, unsigned char* __restrict__ WT, LAS float* scr, int item, int lane, float cscale = 1.0f, int cs_ncols = 1 << 30) {
    const int nblk = N / 32, kb = item / nblk, nb = item % nblk, k0 = 64 * kb, n0 = 32 * nb;
    const float cs = 32.0f * (n0 < cs_ncols ? cscale : 1.0f);
#pragma unroll 8
    for (int i = 0; i < 32; ++i) { const int kk = 2 * i + (lane >> 5); scr[kk * 33 + (lane & 31)] = W[(size_t)(k0 + kk) * N + n0 + (lane & 31)] * cs; }
    asm volatile("s_waitcnt lgkmcnt(0)" ::: "memory");
    const int c = lane & 7;
#pragma unroll
    for (int j = 0; j < 4; ++j) { const int n = (lane >> 3) + 8 * j; const LAS float* sp = scr + (8 * c) * 33 + n;
        int lo = __builtin_amdgcn_cvt_pk_fp8_f32(sp[0 * 33], sp[1 * 33], 0, false); lo = __builtin_amdgcn_cvt_pk_fp8_f32(sp[2 * 33], sp[3 * 33], lo, true);
        int hi = __builtin_amdgcn_cvt_pk_fp8_f32(sp[4 * 33], sp[5 * 33], 0, false); hi = __builtin_amdgcn_cvt_pk_fp8_f32(sp[6 * 33], sp[7 * 33], hi, true);
        *(int2*)(WT + (size_t)(n0 + n) * K + k0 + 8 * c) = make_int2(lo, hi); }
    asm volatile("s_waitcnt lgkmcnt(0)" ::: "memory");
}
template <bool F8OUT>
__device__ __forceinline__ void transpose_item64(const float* __restrict__ W, int K, int N, void* __restrict__ WT, LAS float* scr, int item, int lane, const float* rowscale = nullptr, float cscale = 1.0f) {
    const int nblk = N / 64, kb = item / nblk, nb = item % nblk, k0 = 64 * kb, n0 = 64 * nb;
    const float cs = cscale * (F8OUT ? 32.0f : 1.0f);
    float4 wv[16];
#pragma unroll
    for (int i = 0; i < 16; ++i) wv[i] = *(const float4*)(W + (size_t)(k0 + 4 * i + (lane >> 4)) * N + n0 + 4 * (lane & 15));
#pragma unroll
    for (int i = 0; i < 16; ++i) { const int kk = 4 * i + (lane >> 4); const float4 w = wv[i];
        const float rs = rowscale ? rowscale[k0 + kk] * cs : cs; LAS float* d = scr + kk * 65 + 4 * (lane & 15); d[0] = w.x * rs; d[1] = w.y * rs; d[2] = w.z * rs; d[3] = w.w * rs; }
    asm volatile("s_waitcnt lgkmcnt(0)" ::: "memory");
    const int c = lane & 7;
#pragma unroll
    for (int j = 0; j < 8; ++j) { const int n = (lane >> 3) + 8 * j; const LAS float* sp = scr + (8 * c) * 65 + n;
        if constexpr (F8OUT) { int lo = __builtin_amdgcn_cvt_pk_fp8_f32(sp[0 * 65], sp[1 * 65], 0, false); lo = __builtin_amdgcn_cvt_pk_fp8_f32(sp[2 * 65], sp[3 * 65], lo, true);
            int hi = __builtin_amdgcn_cvt_pk_fp8_f32(sp[4 * 65], sp[5 * 65], 0, false); hi = __builtin_amdgcn_cvt_pk_fp8_f32(sp[6 * 65], sp[7 * 65], hi, true);
            *(int2*)((unsigned char*)WT + (size_t)(n0 + n) * K + k0 + 8 * c) = make_int2(lo, hi); }
        else { uint4 o; o.x = pk2(sp[0 * 65], sp[1 * 65]); o.y = pk2(sp[2 * 65], sp[3 * 65]); o.z = pk2(sp[4 * 65], sp[5 * 65]); o.w = pk2(sp[6 * 65], sp[7 * 65]);
            *(uint4*)((bf16_t*)WT + (size_t)(n0 + n) * K + k0 + 8 * c) = o; } }
    asm volatile("s_waitcnt lgkmcnt(0)" ::: "memory");
}
namespace fa {
using bf16x8 = __attribute__((ext_vector_type(8))) short;
using s16x4  = __attribute__((ext_vector_type(4))) short;
using f32x16 = __attribute__((ext_vector_type(16))) float;
using u32x4  = __attribute__((ext_vector_type(4))) unsigned;
constexpr int QBLK = 32, KVBLK = 64, NW = 8;
constexpr int SHM_V = KVBLK * 128 * 2, SHM_K = KVBLK * 128 * 2, SHM_ATTN = 2 * SHM_V + 2 * SHM_K + NW * 64 * 4;
constexpr float LOG2E = 1.4426950408889634f, THR = 8.0f, NEGS = -1.0e30f;
#define FA_KSWZ(row, colB) ((row) * 256 + ((colB) ^ (((row) & 7) << 4)))
#define FA_SBAR() __builtin_amdgcn_sched_barrier(0)
__device__ __forceinline__ int crow(int r, int hi) { return (r & 3) + 8 * (r >> 2) + 4 * hi; }
__device__ __forceinline__ unsigned cvtpk(float lo, float hi) { unsigned r; asm volatile("v_cvt_pk_bf16_f32 %0, %1, %2" : "=v"(r) : "v"(lo), "v"(hi)); return r; }
__device__ __forceinline__ void partialSM(f32x16& p0, f32x16& p1, float& m_reg, float& mn, float& alpha) {
  float pmax = p0[0];
#pragma unroll
  for (int r = 1; r < 16; ++r) pmax = fmaxf(pmax, p0[r]);
#pragma unroll
  for (int r = 0; r < 16; ++r) pmax = fmaxf(pmax, p1[r]);
  { auto rr = __builtin_amdgcn_permlane32_swap(__float_as_uint(pmax), __float_as_uint(pmax), false, false);
    pmax = fmaxf(__uint_as_float(rr[0]), __uint_as_float(rr[1])); }
  if (__builtin_expect(__all(pmax - m_reg <= THR), 1)) { mn = m_reg; alpha = 1.f; }
  else { mn = fmaxf(m_reg, pmax); alpha = __builtin_amdgcn_exp2f((m_reg - mn) * LOG2E); m_reg = mn; }
  const float mnC = -mn * LOG2E;
#pragma unroll
  for (int r = 0; r < 16; ++r) p0[r] = fmaf(p0[r], LOG2E, mnC);
#pragma unroll
  for (int r = 0; r < 16; ++r) p1[r] = fmaf(p1[r], LOG2E, mnC);
#pragma unroll
  for (int r = 0; r < 16; ++r) p0[r] = __builtin_amdgcn_exp2f(p0[r]);
}
__device__ __forceinline__ void finishSM(f32x16& p0, f32x16& p1, float alpha, float& l_reg, bf16x8& pa0, bf16x8& pa1, bf16x8& pa2, bf16x8& pa3) {
#pragma unroll
  for (int r = 0; r < 16; ++r) p1[r] = __builtin_amdgcn_exp2f(p1[r]);
  float ps = 0;
#pragma unroll
  for (int r = 0; r < 16; ++r) ps += p0[r];
#pragma unroll
  for (int r = 0; r < 16; ++r) ps += p1[r];
  { auto rr = __builtin_amdgcn_permlane32_swap(__float_as_uint(ps), __float_as_uint(ps), false, false);
    ps = __uint_as_float(rr[0]) + __uint_as_float(rr[1]); }
  l_reg = l_reg * alpha + ps;
#define FA_PK4(P, BASE, OUT) do { unsigned a0 = cvtpk(P[BASE + 0], P[BASE + 1]), a1 = cvtpk(P[BASE + 2], P[BASE + 3]);   \
    unsigned b0 = cvtpk(P[BASE + 4], P[BASE + 5]), b1 = cvtpk(P[BASE + 6], P[BASE + 7]);                              \
    auto r0 = __builtin_amdgcn_permlane32_swap(a0, b0, false, false); auto r1 = __builtin_amdgcn_permlane32_swap(a1, b1, false, false); \
    u32x4 w = {r0[0], r1[0], r0[1], r1[1]}; OUT = *reinterpret_cast<bf16x8*>(&w); } while (0)
  FA_PK4(p0, 0, pa0); FA_PK4(p0, 8, pa1); FA_PK4(p1, 0, pa2); FA_PK4(p1, 8, pa3);
#undef FA_PK4
}
template <int NQ> __device__ __forceinline__ void qkt(f32x16& p0, f32x16& p1, const char* Ks, const bf16x8* qr, int r32, int hi) {
  p0 = f32x16{}; p1 = f32x16{};
#pragma unroll
  for (int d0 = 0; d0 < NQ; ++d0) { const int cb = (d0 * 16 + hi * 8) * 2;
    const bf16x8 b0 = *reinterpret_cast<const bf16x8*>(Ks + FA_KSWZ(r32, cb));
    const bf16x8 b1 = *reinterpret_cast<const bf16x8*>(Ks + FA_KSWZ(32 + r32, cb));
    p0 = __builtin_amdgcn_mfma_f32_32x32x16_bf16(b0, qr[d0], p0, 0, 0, 0);
    p1 = __builtin_amdgcn_mfma_f32_32x32x16_bf16(b1, qr[d0], p1, 0, 0, 0); }
}
__device__ __forceinline__ int v_st(int k, int c) { const int kk = (k & ~0xC) | ((k & 4) << 1) | ((k & 8) >> 1); return ((kk >> 3) * 4 + (c >> 5)) * 512 + ((kk & 7) * 32 + (c & 31)) * 2; }
__device__ __forceinline__ int v_rd_base(int lane) { return ((lane & 3) << 3) | (((lane >> 2) & 3) << 6) | (((lane >> 4) & 1) << 5) | (((lane >> 5) & 1) << 8); }
constexpr int v_rd_off(int d0, int ks, int half) { return d0 * 512 + ks * 4096 + half * 2048; }
template <int OFF> __device__ __forceinline__ s16x4 tr_read(int vb) {
  s16x4 r; asm volatile("ds_read_b64_tr_b16 %0, %1 offset:%2" : "=&v"(r) : "v"(vb), "i"(OFF) : "memory"); return r;
}
template <int D0> __device__ __forceinline__ void pv_one(f32x16& od, int vb, bf16x8 pa0, bf16x8 pa1, bf16x8 pa2, bf16x8 pa3) {
  const s16x4 l0 = tr_read<v_rd_off(D0, 0, 0)>(vb), h0 = tr_read<v_rd_off(D0, 0, 1)>(vb), l1 = tr_read<v_rd_off(D0, 1, 0)>(vb), h1 = tr_read<v_rd_off(D0, 1, 1)>(vb);
  const s16x4 l2 = tr_read<v_rd_off(D0, 2, 0)>(vb), h2 = tr_read<v_rd_off(D0, 2, 1)>(vb), l3 = tr_read<v_rd_off(D0, 3, 0)>(vb), h3 = tr_read<v_rd_off(D0, 3, 1)>(vb);
  asm volatile("s_waitcnt lgkmcnt(0)" ::: "memory"); FA_SBAR();
#define FA_PK(L, H) (bf16x8){L[0], L[1], L[2], L[3], H[0], H[1], H[2], H[3]}
  od = __builtin_amdgcn_mfma_f32_32x32x16_bf16(pa0, FA_PK(l0, h0), od, 0, 0, 0);
  od = __builtin_amdgcn_mfma_f32_32x32x16_bf16(pa1, FA_PK(l1, h1), od, 0, 0, 0);
  od = __builtin_amdgcn_mfma_f32_32x32x16_bf16(pa2, FA_PK(l2, h2), od, 0, 0, 0);
  od = __builtin_amdgcn_mfma_f32_32x32x16_bf16(pa3, FA_PK(l3, h3), od, 0, 0, 0);
#undef FA_PK
}
template <int NV> __device__ __forceinline__ void pv_all(f32x16* o, int vb, bf16x8 pa0, bf16x8 pa1, bf16x8 pa2, bf16x8 pa3) {
  pv_one<0>(o[0], vb, pa0, pa1, pa2, pa3); pv_one<1>(o[1], vb, pa0, pa1, pa2, pa3);
  if constexpr (NV == 4) { pv_one<2>(o[2], vb, pa0, pa1, pa2, pa3); pv_one<3>(o[3], vb, pa0, pa1, pa2, pa3); }
}
__device__ __forceinline__ void wmask(f32x16& p0, f32x16& p1, int dq4) {
#pragma unroll
  for (int r = 0; r < 16; ++r) { const int d = dq4 + (r & 3) + 8 * (r >> 2); if ((unsigned)(d + 128) > 256u) p0[r] = NEGS; if ((unsigned)(d + 32 + 128) > 256u) p1[r] = NEGS; }
}

struct Unit {
  const bf16_t* Q; const bf16_t* K; const bf16_t* V; bf16_t* O;
  int rowa, nta, rowb, ntb;
  int window, qpos0, kposb0;
  float sink; int has_sink;
  const bf16_t* K2;
  const float* tab; int pos0;
  const float* qg;
};
template <int DQ, int DV, int LDQ, int LDK, int LDV, int LDO, bool WIN, int RD0, int RH, bool QNORM, bool KSPLIT, bool O8>
__device__ __forceinline__ void attn_unit(const int tid, const Unit& U, char* lds) {
  constexpr int NQ = DQ / 16, NV = DV / 32;
  const int wid = tid >> 6, lane = tid & 63, r32 = lane & 31, hi = lane >> 5;
  char* V_lds = lds; char* K_lds = lds + 2 * SHM_V;
  float* ws = (float*)(lds + 2 * SHM_V + 2 * SHM_K) + wid * 64; float* li_l = ws; float* al_l = ws + 32;
  float m_reg = -1e30f, l_reg = 0; f32x16 o[NV]; bf16x8 qr[NQ];
#pragma unroll
  for (int d = 0; d < NV; ++d) o[d] = f32x16{};
  const bf16_t* Qw = U.Q + (size_t)(wid * QBLK + r32) * LDQ + hi * 8;
#pragma unroll
  for (int d0 = 0; d0 < NQ; ++d0) qr[d0] = *reinterpret_cast<const bf16x8*>(Qw + d0 * 16);
  if constexpr (QNORM || RH > 0) {
    float qf[NQ][8];
#pragma unroll
    for (int d0 = 0; d0 < NQ; ++d0)
#pragma unroll
      for (int j = 0; j < 8; ++j) qf[d0][j] = __uint_as_float(((unsigned)(unsigned short)qr[d0][j]) << 16);
    if constexpr (QNORM) {
      float ss = 0.f;
#pragma unroll
      for (int d0 = 0; d0 < NQ; ++d0)
#pragma unroll
        for (int j = 0; j < 8; ++j) ss = fmaf(qf[d0][j], qf[d0][j], ss);
      { auto rr = __builtin_amdgcn_permlane32_swap(__float_as_uint(ss), __float_as_uint(ss), false, false); ss = __uint_as_float(rr[0]) + __uint_as_float(rr[1]); }
      const float ri = 1.0f / sqrtf(ss * (1.0f / DQ) + 1e-6f);
#pragma unroll
      for (int d0 = 0; d0 < NQ; ++d0) { const float4 g0 = *(const float4*)(U.qg + 16 * d0 + 8 * hi), g1 = *(const float4*)(U.qg + 16 * d0 + 8 * hi + 4);
        qf[d0][0] *= ri * g0.x; qf[d0][1] *= ri * g0.y; qf[d0][2] *= ri * g0.z; qf[d0][3] *= ri * g0.w; qf[d0][4] *= ri * g1.x; qf[d0][5] *= ri * g1.y; qf[d0][6] *= ri * g1.z; qf[d0][7] *= ri * g1.w; }
    }
    if constexpr (RH > 0) { if (U.tab) {
      const float4* tb = (const float4*)(U.tab + ((size_t)(U.pos0 + wid * QBLK + r32) * (RH * 16) + 8 * hi) * 2);
#pragma unroll
      for (int dd = 0; dd < RH; ++dd) {
#pragma unroll
        for (int j2 = 0; j2 < 4; ++j2) { const float4 t = tb[dd * 8 + j2];
          { const float x1 = qf[RD0 + dd][2 * j2], x2 = qf[RD0 + RH + dd][2 * j2]; qf[RD0 + dd][2 * j2] = x1 * t.x - x2 * t.y; qf[RD0 + RH + dd][2 * j2] = x2 * t.x + x1 * t.y; }
          { const float x1 = qf[RD0 + dd][2 * j2 + 1], x2 = qf[RD0 + RH + dd][2 * j2 + 1]; qf[RD0 + dd][2 * j2 + 1] = x1 * t.z - x2 * t.w; qf[RD0 + RH + dd][2 * j2 + 1] = x2 * t.z + x1 * t.w; } } } } }
#pragma unroll
    for (int d0 = 0; d0 < NQ; ++d0) { u32x4 w = {cvtpk(qf[d0][0], qf[d0][1]), cvtpk(qf[d0][2], qf[d0][3]), cvtpk(qf[d0][4], qf[d0][5]), cvtpk(qf[d0][6], qf[d0][7])}; qr[d0] = *reinterpret_cast<bf16x8*>(&w); }
  }
  const int sr = tid >> 4, sc = (tid & 15) * 8, vst0 = v_st(sr, sc), vst1 = v_st(32 + sr, sc);
  const int sck = sc < DQ - 8 ? sc : DQ - 8, scv = sc < DV - 8 ? sc : DV - 8;
  const int vb0 = (int)(uintptr_t)V_lds + v_rd_base(lane);
  const int nta = U.nta, NT = U.nta + U.ntb;
  const unsigned kof0 = (unsigned)((sr * LDK + sck) * 2), kof1 = kof0 + 32u * LDK * 2u, vof0 = (unsigned)((sr * LDV + scv) * 2), vof1 = vof0 + 32u * LDV * 2u;
  constexpr int LDK2 = 1536;
  const int ci = tid & 15; const bool ksec = KSPLIT && ci >= 8; const int kld = ksec ? LDK2 : LDK;
  const bf16_t* kp0 = ksec ? U.K2 + (size_t)sr * LDK2 + ((ci < 11 ? ci : 11) - 8) * 8 : U.K + (size_t)sr * LDK + ci * 8; const bf16_t* kp1 = kp0 + (size_t)32 * kld;
  (void)kof0; (void)kof1; (void)kp0; (void)kp1; (void)kld;
  struct { bf16x8 vs0, vs1, ks0, ks1; } sr_[2];
#define FA_KROW(j) ((j) < nta ? U.rowa + (j) * KVBLK : U.rowb + ((j) - nta) * KVBLK)
#define FA_SLOAD(i, j) do { const size_t k0_ = (size_t)(FA_KROW(j)); const char* kt_ = (const char*)U.K + k0_ * (LDK * 2); const char* vt_ = (const char*)U.V + k0_ * (LDV * 2); \
    sr_[i].vs0 = *reinterpret_cast<const bf16x8*>(vt_ + vof0); sr_[i].vs1 = *reinterpret_cast<const bf16x8*>(vt_ + vof1); \
    if constexpr (KSPLIT) { sr_[i].ks0 = *reinterpret_cast<const bf16x8*>(kp0 + k0_ * kld); sr_[i].ks1 = *reinterpret_cast<const bf16x8*>(kp1 + k0_ * kld); } \
    else { sr_[i].ks0 = *reinterpret_cast<const bf16x8*>(kt_ + kof0); sr_[i].ks1 = *reinterpret_cast<const bf16x8*>(kt_ + kof1); } } while (0)
#define FA_SWRITE(b, i) do { *(bf16x8*)(V_lds + (b) * SHM_V + vst0) = sr_[i].vs0; *(bf16x8*)(V_lds + (b) * SHM_V + vst1) = sr_[i].vs1; const int kc = sc * 2; \
    *(bf16x8*)(K_lds + (b) * SHM_K + FA_KSWZ(sr, kc)) = sr_[i].ks0; *(bf16x8*)(K_lds + (b) * SHM_K + FA_KSWZ(32 + sr, kc)) = sr_[i].ks1; } while (0)
#define FA_SWAIT() asm volatile("s_waitcnt vmcnt(4)" ::: "memory")
#define FA_RESC(a) do { if (__any((a) < 1.f)) { if (hi == 0) al_l[r32] = (a); asm volatile("s_waitcnt lgkmcnt(0)" ::: "memory"); \
    _Pragma("unroll") for (int d = 0; d < NV; ++d) _Pragma("unroll") for (int r = 0; r < 16; ++r) o[d][r] *= al_l[crow(r, hi)]; } } while (0)
  const int qw0 = U.qpos0 + wid * QBLK;
#define FA_MASK(P0, P1, t) do { if (WIN && U.window && (t) >= nta) { const int kb_ = U.kposb0 + ((t) - nta) * KVBLK; \
    if (kb_ + 63 - qw0 > 128 || qw0 + 31 - kb_ > 128) wmask(P0, P1, kb_ - (qw0 + r32) + 4 * hi); } } while (0)
  f32x16 pA0, pA1, pB0, pB1; float mnA, mnB, alA, alB; bf16x8 pa0, pa1, pa2, pa3;
  constexpr int SE = 0, SO = 1;
  FA_SLOAD(SE, 0); asm volatile("s_waitcnt vmcnt(0)" ::: "memory"); FA_SWRITE(0, SE); __syncthreads();
  qkt<NQ>(pA0, pA1, K_lds, qr, r32, hi); FA_MASK(pA0, pA1, 0); partialSM(pA0, pA1, m_reg, mnA, alA);
  FA_SLOAD(SO, 1); if (2 < NT) FA_SLOAD(SE, 2);
  FA_SWAIT(); FA_SWRITE(1, SO); __syncthreads();
  for (int j = 1; j + 1 < NT; j += 2) {
    FA_SBAR(); qkt<NQ>(pB0, pB1, K_lds + SHM_K, qr, r32, hi);
    finishSM(pA0, pA1, alA, l_reg, pa0, pa1, pa2, pa3); FA_SBAR();
    FA_SLOAD(SO, j + 2); FA_SBAR();
    pv_all<NV>(o, vb0, pa0, pa1, pa2, pa3); FA_MASK(pB0, pB1, j); partialSM(pB0, pB1, m_reg, mnB, alB);
    __syncthreads(); FA_SWAIT(); FA_SWRITE(0, SE);
    FA_RESC(alB); __syncthreads();
    FA_SBAR(); qkt<NQ>(pA0, pA1, K_lds, qr, r32, hi);
    finishSM(pB0, pB1, alB, l_reg, pa0, pa1, pa2, pa3); FA_SBAR();
    if (j + 3 < NT) FA_SLOAD(SE, j + 3); FA_SBAR();
    pv_all<NV>(o, vb0 + SHM_V, pa0, pa1, pa2, pa3); FA_MASK(pA0, pA1, j + 1); partialSM(pA0, pA1, m_reg, mnA, alA);
    __syncthreads(); FA_SWAIT(); FA_SWRITE(1, SO);
    FA_RESC(alA); __syncthreads();
  }
  FA_SBAR(); qkt<NQ>(pB0, pB1, K_lds + SHM_K, qr, r32, hi);
  finishSM(pA0, pA1, alA, l_reg, pa0, pa1, pa2, pa3); FA_SBAR();
  pv_all<NV>(o, vb0, pa0, pa1, pa2, pa3); FA_MASK(pB0, pB1, NT - 1); partialSM(pB0, pB1, m_reg, mnB, alB);
  __syncthreads(); FA_RESC(alB);
  finishSM(pB0, pB1, alB, l_reg, pa0, pa1, pa2, pa3); FA_SBAR();
  pv_all<NV>(o, vb0 + SHM_V, pa0, pa1, pa2, pa3);
  if (U.has_sink) l_reg += __builtin_amdgcn_exp2f((U.sink - m_reg) * LOG2E);
  if (hi == 0) li_l[r32] = l_reg;
  asm volatile("s_waitcnt lgkmcnt(0)" ::: "memory");
  __syncthreads();
  int lane2 = lane; asm volatile("" : "+v"(lane2));
  const int r32e = lane2 & 31, hie = lane2 >> 5;
  if constexpr (O8) {
    unsigned char* stg = (unsigned char*)(lds + wid * 8192);
    unsigned char* stw = stg + hie * 4 * DV + r32e;
#pragma unroll
    for (int r = 0; r < 16; ++r) { const int orow0 = (r & 3) + 8 * (r >> 2); const float rl = __builtin_amdgcn_rcpf(li_l[orow0 + 4 * hie]);
#pragma unroll
      for (int d0 = 0; d0 < NV; ++d0) stw[orow0 * DV + d0 * 32] = (unsigned char)(__builtin_amdgcn_cvt_pk_fp8_f32(o[d0][r] * rl, 0.f, 0, false) & 0xff); }
    asm volatile("s_waitcnt lgkmcnt(0)" ::: "memory");
    constexpr int CPR = DV / 16, RPI = 64 / CPR;
    const int erow = lane2 / CPR, ech = lane2 % CPR;
    unsigned char* Ow = (unsigned char*)U.O + (size_t)(wid * QBLK + erow) * LDO + ech * 16; const unsigned char* str = stg + erow * DV + ech * 16;
#pragma unroll
    for (int i = 0; i < 32 / RPI; ++i) { const u32x4 v = *(const u32x4*)(str + i * RPI * DV); *(u32x4*)(Ow + (size_t)(i * RPI) * LDO) = v; }
  } else {
  bf16_t* stg = (bf16_t*)(lds + wid * 8192);
  bf16_t* stw = stg + hie * 4 * DV + r32e;
#pragma unroll
  for (int r = 0; r < 16; ++r) { const int orow0 = (r & 3) + 8 * (r >> 2); const float rl = __builtin_amdgcn_rcpf(li_l[orow0 + 4 * hie]);
#pragma unroll
    for (int d0 = 0; d0 < NV; ++d0) stw[orow0 * DV + d0 * 32] = f2bf(o[d0][r] * rl); }
  asm volatile("s_waitcnt lgkmcnt(0)" ::: "memory");
  constexpr int CPR = DV / 8, RPI = 64 / CPR;
  const int erow = lane2 / CPR, ech = lane2 % CPR;
  bf16_t* Ow = U.O + (size_t)(wid * QBLK + erow) * LDO + ech * 8; const bf16_t* str = stg + erow * DV + ech * 8;
#pragma unroll
  for (int i = 0; i < 32 / RPI; ++i) { const u32x4 v = *(const u32x4*)(str + i * RPI * DV); *(u32x4*)(Ow + (size_t)(i * RPI) * LDO) = v; }
  }
  __syncthreads();
#undef FA_KROW
#undef FA_SLOAD
#undef FA_SWRITE
#undef FA_SWAIT
#undef FA_RESC
#undef FA_MASK
}
}

__device__ __forceinline__ void route_reduce(const float (&acc)[32], const int lane, const int el, const float rb, float (&tv)[4], int (&ti)[4]) {
    float a16[16], a8[8], a4[4], a2[2];
#pragma unroll
    for (int k = 0; k < 16; ++k) { const bool up = (lane & 32) != 0; const float keep = up ? acc[k + 16] : acc[k], send = up ? acc[k] : acc[k + 16]; a16[k] = keep + __shfl_xor(send, 32); }
#pragma unroll
    for (int k = 0; k < 8; ++k) { const bool up = (lane & 16) != 0; const float keep = up ? a16[k + 8] : a16[k], send = up ? a16[k] : a16[k + 8]; a8[k] = keep + __shfl_xor(send, 16); }
#pragma unroll
    for (int k = 0; k < 4; ++k) { const bool up = (lane & 8) != 0; const float keep = up ? a8[k + 4] : a8[k], send = up ? a8[k] : a8[k + 4]; a4[k] = keep + __shfl_xor(send, 8); }
#pragma unroll
    for (int k = 0; k < 2; ++k) { const bool up = (lane & 4) != 0; const float keep = up ? a4[k + 2] : a4[k], send = up ? a4[k] : a4[k + 2]; a2[k] = keep + __shfl_xor(send, 4); }
    float lg; { const bool up = (lane & 2) != 0; const float keep = up ? a2[1] : a2[0], send = up ? a2[0] : a2[1]; lg = keep + __shfl_xor(send, 2); }
    lg += __shfl_xor(lg, 1); lg += rb;
    unsigned key; { const unsigned u = __float_as_uint(lg); const unsigned ou = (u & 0x80000000u) ? ~u : (u | 0x80000000u); key = (ou & ~31u) | (unsigned)(31 - el); }
#pragma unroll
    for (int k = 0; k < 4; ++k) { unsigned bk = key;
#pragma unroll
        for (int o = 1; o < 64; o <<= 1) { const unsigned ok = (unsigned)__shfl_xor((int)bk, o); bk = ok > bk ? ok : bk; }
        const int bi = 31 - (int)(bk & 31u); const unsigned ou = bk & ~31u; const unsigned ub = (ou & 0x80000000u) ? (ou ^ 0x80000000u) : ~ou;
        tv[k] = __uint_as_float(ub); ti[k] = bi; if (el == bi) key = 0u; }
}

template <int CTRL> __device__ __forceinline__ float dpp_f32(const float x) { return __builtin_bit_cast(float, __builtin_amdgcn_update_dpp(0, __builtin_bit_cast(int, x), CTRL, 0xf, 0xf, true)); }
template <int CTRL> __device__ __forceinline__ unsigned dpp_u32(const unsigned x) { return (unsigned)__builtin_amdgcn_update_dpp(0, (int)x, CTRL, 0xf, 0xf, true); }
template <int M> __device__ __forceinline__ float xlane_f32(const float x) {
    if constexpr (M == 1) return dpp_f32<0xB1>(x);
    else if constexpr (M == 2) return dpp_f32<0x4E>(x);
    else if constexpr (M == 4) return dpp_f32<0x1B>(dpp_f32<0x141>(x));
    else return dpp_f32<0x128>(x);
}
template <int M> __device__ __forceinline__ unsigned xlane_u32(const unsigned x) {
    if constexpr (M == 1) return dpp_u32<0xB1>(x);
    else if constexpr (M == 2) return dpp_u32<0x4E>(x);
    else if constexpr (M == 4) return dpp_u32<0x1B>(dpp_u32<0x141>(x));
    else return dpp_u32<0x128>(x);
}
typedef unsigned u32x2_t __attribute__((ext_vector_type(2)));
__device__ __forceinline__ float half_sum32(float v) {
    v += xlane_f32<1>(v); v += xlane_f32<2>(v); v += xlane_f32<4>(v); v += xlane_f32<8>(v);
    const u32x2_t r = __builtin_amdgcn_permlane16_swap(__float_as_uint(v), __float_as_uint(v), false, false);
    return __uint_as_float(r[0]) + __uint_as_float(r[1]);
}
__device__ __forceinline__ void route_reduce32(const float (&acc)[32], const int l5, const float rb, float (&tv)[4], int (&ti)[4]) {
    float a16[16], a8[8], a4[4], a2[2];
#pragma unroll
    for (int k = 0; k < 16; ++k) { const u32x2_t r = __builtin_amdgcn_permlane16_swap(__float_as_uint(acc[k]), __float_as_uint(acc[k + 16]), false, false); a16[k] = __uint_as_float(r[0]) + __uint_as_float(r[1]); }
#pragma unroll
    for (int k = 0; k < 8; ++k) { const bool up = (l5 & 8) != 0; const float keep = up ? a16[k + 8] : a16[k], send = up ? a16[k] : a16[k + 8]; a8[k] = keep + xlane_f32<8>(send); }
#pragma unroll
    for (int k = 0; k < 4; ++k) { const bool up = (l5 & 4) != 0; const float keep = up ? a8[k + 4] : a8[k], send = up ? a8[k] : a8[k + 4]; a4[k] = keep + xlane_f32<4>(send); }
#pragma unroll
    for (int k = 0; k < 2; ++k) { const bool up = (l5 & 2) != 0; const float keep = up ? a4[k + 2] : a4[k], send = up ? a4[k] : a4[k + 2]; a2[k] = keep + xlane_f32<2>(send); }
    float lg; { const bool up = (l5 & 1) != 0; const float keep = up ? a2[1] : a2[0], send = up ? a2[0] : a2[1]; lg = keep + xlane_f32<1>(send); }
    lg += rb;
    unsigned key; { const unsigned u = __float_as_uint(lg); const unsigned ou = (u & 0x80000000u) ? ~u : (u | 0x80000000u); key = (ou & ~31u) | (unsigned)(31 - l5); }
#pragma unroll
    for (int k = 0; k < 4; ++k) { unsigned bk = key;
        { const unsigned ok = xlane_u32<1>(bk); bk = ok > bk ? ok : bk; } { const unsigned ok = xlane_u32<2>(bk); bk = ok > bk ? ok : bk; }
        { const unsigned ok = xlane_u32<4>(bk); bk = ok > bk ? ok : bk; } { const unsigned ok = xlane_u32<8>(bk); bk = ok > bk ? ok : bk; }
        { const u32x2_t r = __builtin_amdgcn_permlane16_swap(bk, bk, false, false); bk = r[0] > r[1] ? r[0] : r[1]; }
        const int bi = 31 - (int)(bk & 31u); const unsigned ou = bk & ~31u; const unsigned ub = (ou & 0x80000000u) ? (ou ^ 0x80000000u) : ~ou;
        tv[k] = __uint_as_float(ub); ti[k] = bi; if (l5 == bi) key = 0u; }
}

struct Params {
    const float *x, *c, *ctx, *c_ctx, *ada_w, *ada_b, *norm_mix_g, *norm_ffn_g, *ab_w_in, *mla_q_g, *mla_wq_b, *mla_kv_g, *mla_wkv_b, *swa_sink, *ab_w_out,
        *c_w_in, *c_q_g, *c_k_g, *c_w_out, *router_w, *router_b, *moe_w_in, *moe_b_in, *moe_w_out, *moe_b_out, *final_g;
    float* out; unsigned char* ws; int ph_lo, ph_hi;
};
__device__ __forceinline__ int mod_row_of(int r) { return r < NLAT ? r / SEQ : NB; }
__device__ __forceinline__ float rope_angle(int i, int quarter, int prow, int pcol) {
    const int ii = i < quarter ? i : i - quarter; const float inv = powf(10000.f, -(float)ii / (float)quarter);
    return (float)(i < quarter ? prow : pcol) * inv;
}

#ifndef OUTPROJ_F8
#define OUTPROJ_F8 1
#endif
#ifndef Y8_L1
#define Y8_L1 1
#endif
#ifndef Y8_L0
#define Y8_L0 1
#endif
#ifndef INPROJ_F8
#define INPROJ_F8 1
#endif
#ifndef MOE_F8_DOWN
#define MOE_F8_DOWN 1
#endif
#ifndef MOE_F8_L0
#define MOE_F8_L0 1
#endif
#ifndef MOE_F8_L1
#define MOE_F8_L1 1
#endif
constexpr int LDS_BYTES = 147456;
constexpr int LDS_MISC = 143360;
constexpr int N_PHASES = 21;

__global__ void __launch_bounds__(NTHR, 2) fwd_kernel(Params p) {
    extern __shared__ __attribute__((aligned(16))) unsigned char lds_raw[];
    float* ldsf = (float*)lds_raw;
    LAS unsigned* misc = (LAS unsigned*)(lds_raw + LDS_MISC + 320);
    const int wave0 = __builtin_amdgcn_readfirstlane((int)(threadIdx.x >> 6));
    const int G = gridDim.x, bid = blockIdx.x;
    const int NGW = G * 8;
    unsigned* ctl0 = (unsigned*)(p.ws + WS_CTL);
#define PHASE_PTRS \
    int tid = wave0 * 64 + (int)__builtin_amdgcn_mbcnt_hi(~0u, __builtin_amdgcn_mbcnt_lo(~0u, 0u)); asm volatile("" : "+v"(tid)); const int lane = tid & 63, wave = tid >> 6, gw = bid * 8 + wave; (void)lane; (void)gw; \
    size_t wsz_ = 0; asm volatile("" : "+s"(wsz_)); unsigned char* ws = p.ws + wsz_; \
    unsigned* ctl = (unsigned*)(ws + WS_CTL); (void)ctl; \
    float* MOD = (float*)(ws + WS_MOD); (void)MOD; \
    int* TOKE = (int*)(ws + WS_TOKE); int* TOKP = (int*)(ws + WS_TOKP); float* TOKG = (float*)(ws + WS_TOKG); (void)TOKE; (void)TOKP; (void)TOKG; \
    float* RINV = (float*)(ws + WS_RINV); (void)RINV; unsigned char* tabs = ws + WS_TAB; (void)tabs; \
    xr_t* XR = (xr_t*)(ws + WS_XR); (void)XR; \
    act_t* H = (act_t*)(ws + WS_H); (void)H; \
    unsigned char* big = ws + WS_BIG; \
    act_t* PRJ = (act_t*)(big + OFF_PRJ); act_t* QB = (act_t*)(big + OFF_QB); act_t* KVB = (act_t*)(big + OFF_KVB); act_t* OB = (act_t*)(big + OFF_O); (void)PRJ; (void)QB; (void)KVB; (void)OB; \
    act_t* Y = (act_t*)big; act_t* ACT = (act_t*)(ws + WS_ACT); act_t* XS = (act_t*)(ws + WS_XS); unsigned char* wts = ws + WS_W; (void)Y; (void)ACT; (void)XS; (void)wts;

    if (threadIdx.x < 32) misc[threadIdx.x] = 0u;
    __syncthreads();
    XcdBarrier bar = xcd_barrier_post(ctl0 + CW_BAR, (volatile LAS unsigned*)(misc + 8), wave0);
    const int lo = p.ph_lo, hi = p.ph_hi;
#ifndef PHASE_MASK
#define PHASE_MASK 0x1FFFFFu
#endif
#define IN(k) ((((PHASE_MASK) >> (k)) & 1u) && lo <= (k) && (k) < hi)
#define SEAM(k) do { if (IN(k) && IN((k) + 1)) xcd_barrier(bar, wave0); } while (0)
#define LDSB ((LAS unsigned char*)lds_raw)

    if (IN(0)) { PHASE_PTRS
        {   LAS float* scr = (LAS float*)(LDSB + wave * 16640);
            constexpr int I_AB = 16 * 45  , I_QB = 6 * 12, I_KVB = 4 * 16, I_ABO = 16 * 16, I_C = 16 * 24, I_CO = 16 * 16, I_W1 = 16 * 32, I_W2 = 16 * 16;
            constexpr int T_W1 = 64 * I_W1, T_W2 = 64 * I_W2, T_ALL = T_W1 + T_W2 + I_AB + I_QB + I_KVB + I_ABO + I_C + I_CO;
            for (int it = gw; it < T_ALL; it += NGW) {
                int r = it;
                if (r < T_W1) { const int mi = r / I_W1; const float* src = p.moe_w_in + (size_t)mi * 1024 * 2048;
                    if ((mi >= 32 && MOE_F8_L1) || (mi < 32 && MOE_F8_L0)) transpose_item64<true>(src, 1024, 2048, (unsigned char*)(wts + WO_W1) + (size_t)(mi >> 5) * 32 * 2048 * 1024 * 2 + (size_t)(mi & 31) * 2048 * 1024, scr, r % I_W1, lane);
                    else transpose_item64<false>(src, 1024, 2048, (bf16_t*)(wts + WO_W1) + (size_t)mi * 2048 * 1024, scr, r % I_W1, lane);
                    continue; } r -= T_W1;
                if (r < T_W2) { const int mi = r / I_W2; const float* src = p.moe_w_out + (size_t)mi * 1024 * 1024;
                    if (MOE_F8_DOWN && ((mi >= 32 && MOE_F8_L1) || (mi < 32 && MOE_F8_L0))) transpose_item64<true>(src, 1024, 1024, (unsigned char*)(wts + WO_W2) + (size_t)(mi >> 5) * 32 * 1024 * 1024 * 2 + (size_t)(mi & 31) * 1024 * 1024, scr, r % I_W2, lane);
                    else transpose_item64<false>(src, 1024, 1024, (bf16_t*)(wts + WO_W2) + (size_t)mi * 1024 * 1024, scr, r % I_W2, lane);
                    continue; } r -= T_W2;
                if (r < I_AB) { if (INPROJ_F8) transpose_item_f8(p.ab_w_in, 1024, AB_IN, (unsigned char*)(wts + WO_AB), scr, r, lane, 0.125f, 512);
                    else transpose_item(p.ab_w_in, 1024, AB_IN, (bf16_t*)(wts + WO_AB), scr, r, lane, nullptr, 0.125f, 512); continue; } r -= I_AB;
                if (r < I_QB) { transpose_item64<false>(p.mla_wq_b, 384, 768, (bf16_t*)(wts + WO_QB), scr, r, lane, p.mla_q_g, 0.10206207261596575f); continue; } r -= I_QB;
                if (r < I_KVB) { transpose_item64<false>(p.mla_wkv_b, 256, 1024, (bf16_t*)(wts + WO_KVB), scr, r, lane, p.mla_kv_g, 1.0f); continue; } r -= I_KVB;
                if (r < I_ABO) { if (OUTPROJ_F8) transpose_item64<true>(p.ab_w_out, 1024, 1024, (unsigned char*)(wts + WO_ABO), scr, r, lane); else transpose_item64<false>(p.ab_w_out, 1024, 1024, (bf16_t*)(wts + WO_ABO), scr, r, lane); continue; } r -= I_ABO;
                if (r < I_C) { if (INPROJ_F8) transpose_item64<true>(p.c_w_in, 1024, C_IN, (unsigned char*)(wts + WO_C), scr, r, lane); else transpose_item64<false>(p.c_w_in, 1024, C_IN, (bf16_t*)(wts + WO_C), scr, r, lane); continue; } r -= I_C;
                if (OUTPROJ_F8) transpose_item64<true>(p.c_w_out, 1024, 1024, (unsigned char*)(wts + WO_CO), scr, r, lane); else transpose_item64<false>(p.c_w_out, 1024, 1024, (bf16_t*)(wts + WO_CO), scr, r, lane);
            }
            uint4* z = (uint4*)((unsigned char*)(wts + WO_AB) + (size_t)AB_IN * 1024 * (INPROJ_F8 ? 1 : 2));
            for (int i = gw * 64 + lane; i < 96 * 1024 * (INPROJ_F8 ? 1 : 2) / 16; i += NGW * 64) z[i] = make_uint4(0u, 0u, 0u, 0u);
        }
        {
            float2* TA = (float2*)(tabs + TAB_A); float2* TB = (float2*)(tabs + TAB_B); float2* TC = (float2*)(tabs + TAB_C);
            for (int e = bid * NTHR + tid; e < SEQ * 112; e += G * NTHR) { const int s = e / 112, i = e % 112, prow = s / GRIDW, pcol = s % GRIDW;
                int quarter, ii; float2* dst;
                if (i < 32) { quarter = 16; ii = i; dst = TA + s * 32 + ii; } else if (i < 48) { quarter = 8; ii = i - 32; dst = TB + s * 16 + ii; } else { quarter = 32; ii = i - 48; dst = TC + s * 64 + ii; }
                const float ang = rope_angle(ii, quarter, prow, pcol); *dst = make_float2(cosf(ang), sinf(ang)); }
            if (bid == 0 && tid < 128) ((float*)(tabs + TAB_QG))[tid] = p.c_q_g[tid] * 0.08838834764831845f;
        }
        __syncthreads();
        float* ca = ldsf;
        float* red = ldsf + 17 * 1024;
        {   float cv[34];
#pragma unroll
            for (int j = 0; j < 34; ++j) cv[j] = j < 2 * NB ? p.c[j * NTHR + tid] : p.c_ctx[(j - 2 * NB) * NTHR + tid];
#pragma unroll
            for (int j = 0; j < 34; ++j) ca[j * NTHR + tid] = cv[j] / (1.f + expf(-cv[j])); }
        __syncthreads();
        for (int blk = bid; blk < 2 * 6144 / 64; blk += G) {
            typedef float f4m_ __attribute__((ext_vector_type(4)));
            const int l = blk / 96, ks = wave, kr = lane >> 4, c4 = (lane & 15) * 4;
            f4m_ acc[17];
#pragma unroll
            for (int b = 0; b < 17; ++b) acc[b] = (f4m_){0.f, 0.f, 0.f, 0.f};
            const float* wp = p.ada_w + (size_t)l * 1024 * 6144 + (blk % 96) * 64 + c4 + (size_t)(ks * 128 + kr) * 6144;
            const float* cap = ca + ks * 128 + kr;
#pragma unroll 1
            for (int g4 = 0; g4 < 8; ++g4) {
                f4m_ w[4];
#pragma unroll
                for (int j = 0; j < 4; ++j) w[j] = __builtin_nontemporal_load((const f4m_*)(wp + (size_t)((g4 * 4 + j) * 4) * 6144));
#pragma unroll
                for (int j = 0; j < 4; ++j) {
#pragma unroll
                    for (int b = 0; b < 17; ++b) acc[b] += cap[b * 1024 + (g4 * 4 + j) * 4] * w[j]; }
            }
#pragma unroll
            for (int b = 0; b < 17; ++b) {
#pragma unroll
                for (int c = 0; c < 4; ++c) { float v = acc[b][c]; v += __shfl_xor(v, 16); v += __shfl_xor(v, 32); acc[b][c] = v; } }
            if (lane < 16) {
#pragma unroll
                for (int b = 0; b < 17; ++b) *(f4m_*)(red + (ks * 17 + b) * 64 + c4) = acc[b]; }
            __syncthreads();
            for (int i = tid; i < 17 * 64; i += NTHR) { const int b = i >> 6, nl = i & 63; float s = 0.f;
#pragma unroll
                for (int k2 = 0; k2 < 8; ++k2) s += red[(k2 * 17 + b) * 64 + nl];
                const int nn = (blk % 96) * 64 + nl; float mv = s + p.ada_b[l * 6144 + nn];
                if (nn >= 4096 && nn < 5120) mv = p.norm_ffn_g[l * 1024 + nn - 4096] * (1.0f + mv);
                MOD[((size_t)l * 17 + b) * 6144 + nn] = mv; }
            __syncthreads();
        }
    }
    SEAM(0);

#define NORM_MOD16(v, g, mr_) do { float ss_ = 0.f; \
        _Pragma("unroll") for (int j = 0; j < 16; ++j) ss_ = fmaf(v[j], v[j], ss_); \
        ss_ = wave_sum(ss_); const float ri_ = 1.0f / sqrtf(ss_ * (1.0f / 1024.0f) + RMS_EPS); \
        float sh_[16], sc_[16]; ld16f((mr_), sh_); ld16f((mr_) + 1024, sc_); \
        _Pragma("unroll") for (int j = 0; j < 16; ++j) v[j] = (v[j] * ri_ * g[j]) * (1.0f + sc_[j]) + sh_[j]; } while (0)

#define NORM_MOD16x2(v, g, mr0_, mr1_) do { float s0_ = 0.f, s1_ = 0.f; \
        _Pragma("unroll") for (int j = 0; j < 16; ++j) { s0_ = fmaf(v[0][j], v[0][j], s0_); s1_ = fmaf(v[1][j], v[1][j], s1_); } \
        wave_sum2(s0_, s1_); const float ri0_ = 1.0f / sqrtf(s0_ * (1.0f / 1024.0f) + RMS_EPS), ri1_ = 1.0f / sqrtf(s1_ * (1.0f / 1024.0f) + RMS_EPS); \
        float sh_[16], sc_[16]; ld16f((mr0_), sh_); ld16f((mr0_) + 1024, sc_); \
        _Pragma("unroll") for (int j = 0; j < 16; ++j) v[0][j] = (v[0][j] * ri0_ * g[j]) * (1.0f + sc_[j]) + sh_[j]; \
        ld16f((mr1_), sh_); ld16f((mr1_) + 1024, sc_); \
        _Pragma("unroll") for (int j = 0; j < 16; ++j) v[1][j] = (v[1][j] * ri1_ * g[j]) * (1.0f + sc_[j]) + sh_[j]; } while (0)
#define ROWS2(nrows) _Pragma("unroll 1") for (int r0_ = gw; r0_ < (nrows); r0_ += 2 * NGW)
#define ROWS2_IDX(nrows) const bool two_ = (r0_ + NGW) < (nrows); const int rr_[2] = {r0_, two_ ? r0_ + NGW : r0_};

    if (IN(1)) { PHASE_PTRS
        float g[16]; ld16f(p.norm_mix_g + 16 * lane, g);
        ROWS2(NROW) { ROWS2_IDX(NROW)
            float v[2][16]; const float* mr[2];
#pragma unroll
            for (int u = 0; u < 2; ++u) { const int r = rr_[u]; const float* src = r < NLAT ? p.x + (size_t)r * 1024 : p.ctx + (size_t)(r - NLAT) * 1024;
                mr[u] = MOD + (size_t)(0 * 17 + mod_row_of(r)) * 6144 + 16 * lane; ld16f(src + 16 * lane, v[u]); }
            NORM_MOD16x2(v, g, mr[0], mr[1]);
            if (INPROJ_F8) { st16f8((unsigned char*)H + (size_t)rr_[0] * 1024 + 16 * lane, v[0]); if (two_) st16f8((unsigned char*)H + (size_t)rr_[1] * 1024 + 16 * lane, v[1]); }
            else { st16bf(H + (size_t)rr_[0] * 1024 + 16 * lane, v[0]); if (two_) st16bf(H + (size_t)rr_[1] * 1024 + 16 * lane, v[1]); }
        }
    }
    SEAM(1);

    if (IN(2)) { PHASE_PTRS
        constexpr size_t ES_ = INPROJ_F8 ? 1 : 2;
        pg8::DenseOrder S{(const char*)H, (const char*)(wts + WO_AB), NROW / 256, 6, G, bid, (size_t)256 * 1024 * ES_, (size_t)256 * 1024 * ES_};
        pg8::EpiStoreBf16 E{PRJ, PRJ_LD, INPROJ_F8 ? 0.03125f : 1.0f};
        pg8::gemm_phase<pg8::EpiStoreBf16, pg8::DenseOrder, true, true, INPROJ_F8 != 0>(tid, LDSB, 1024, 1024, S, E);
    }
    SEAM(2);

    if (IN(3)) { PHASE_PTRS
        const float2* TA = (const float2*)(tabs + TAB_A); const float2* TB = (const float2*)(tabs + TAB_B);
        for (int r = gw; r < NROW; r += NGW) {
            bf16_t* pr = PRJ + (size_t)r * PRJ_LD;
            if (r < NLAT) { const int s = r % SEQ;
                { bf16_t* kp = pr + 512 + (lane >> 5) * 64 + (lane & 31); const float x1 = bf2f(kp[0]), x2 = bf2f(kp[32]); const float2 t = TA[s * 32 + (lane & 31)];
                  kp[0] = f2bf(x1 * t.x - x2 * t.y); kp[32] = f2bf(x2 * t.x + x1 * t.y); }
                if (lane < 16) { bf16_t* rp = pr + 1408 + lane; const float x1 = bf2f(rp[0]), x2 = bf2f(rp[16]); const float2 t = TB[s * 16 + lane];
                  rp[0] = f2bf(x1 * t.x - x2 * t.y); rp[16] = f2bf(x2 * t.x + x1 * t.y); } }
            float s1 = 0.f, s2 = 0.f;
#pragma unroll
            for (int j = 0; j < 6; ++j) { const float xq = bf2f(pr[768 + lane + 64 * j]); s1 = fmaf(xq, xq, s1); }
#pragma unroll
            for (int j = 0; j < 4; ++j) { const float xk = bf2f(pr[1152 + lane + 64 * j]); s2 = fmaf(xk, xk, s2); }
            s1 = wave_sum(s1); s2 = wave_sum(s2);
            if (lane == 0) { RINV[2 * r] = 1.0f / sqrtf(s1 * (1.0f / 384.0f) + RMS_EPS); RINV[2 * r + 1] = 1.0f / sqrtf(s2 * (1.0f / 256.0f) + RMS_EPS); }
        }
    }
    SEAM(3);

    if (IN(4)) { PHASE_PTRS
        { pg8::DenseOrder S{(const char*)(PRJ + 768), (const char*)(wts + WO_QB), NROW / 256, 3, G, bid, (size_t)256 * PRJ_LD * 2, (size_t)256 * 384 * 2};
          pg8::EpiScaleBf16 E{QB, 768, RINV};
          pg8::gemm_phase<pg8::EpiScaleBf16, pg8::DenseOrder, true, true>(tid, LDSB, 384, PRJ_LD, S, E); }
        __syncthreads();
        { pg8::DenseOrder S{(const char*)(PRJ + 1152), (const char*)(wts + WO_KVB), NROW / 256, 4, G, bid, (size_t)256 * PRJ_LD * 2, (size_t)256 * 256 * 2};
          pg8::EpiScaleBf16 E{KVB, 1024, RINV + 1};
          pg8::gemm_phase<pg8::EpiScaleBf16, pg8::DenseOrder, true, true>(tid, LDSB, 256, PRJ_LD, S, E); }
    }
    SEAM(4);

    if (IN(5)) { PHASE_PTRS
        for (int i = 0;; ++i) { const int u = i * G + bid; if (u >= 1152) break;
            const bool isctx = u >= 1024; int b, h, qb;
            if (!isctx) { const int rest = u >> 3; b = 2 * (u & 7) + (rest >> 6); h = (rest & 63) >> 3; qb = rest & 7; } else { b = (u - 1024) >> 3; h = u & 7; qb = 0; }
            const int qrow0 = isctx ? NLAT + b * NCX : b * SEQ + qb * 256;
            fa::Unit U; U.Q = QB + (size_t)qrow0 * 768 + h * 96; U.K = KVB + h * 128; U.K2 = PRJ + 1408; U.V = KVB + h * 128 + 64;
            U.O = OUTPROJ_F8 ? (bf16_t*)((unsigned char*)OB + (size_t)qrow0 * 1024 + 512 + h * 64) : OB + (size_t)qrow0 * 1024 + 512 + h * 64; U.rowa = NLAT + b * NCX; U.nta = 4; U.rowb = b * SEQ; U.ntb = isctx ? 0 : 32;
            U.window = 0; U.qpos0 = 0; U.kposb0 = 0; U.sink = 0.f; U.has_sink = 0; U.tab = isctx ? nullptr : (const float*)(tabs + TAB_B); U.pos0 = qb * 256; U.qg = nullptr;
            fa::attn_unit<96, 64, 768, 1024, 1024, 1024, false, 4, 1, false, true, OUTPROJ_F8 != 0>(tid, U, (char*)lds_raw); }
        for (int i = 0;; ++i) { const int u = i * G + bid; if (u >= 1152) break;
            const bool isctx = u >= 1024; int b, h, qb;
            if (!isctx) { const int rest = u >> 3; b = 2 * (u & 7) + (rest >> 6); h = (rest & 63) >> 3; qb = rest & 7; } else { b = (u - 1024) >> 3; h = u & 7; qb = 0; }
            const int qrow0 = isctx ? NLAT + b * NCX : b * SEQ + qb * 256;
            const int ks = isctx ? 0 : max(0, qb * 256 - 128), ke = isctx ? 0 : min(SEQ, qb * 256 + 384);
            fa::Unit U; U.Q = PRJ + (size_t)qrow0 * PRJ_LD + h * 64; U.K = PRJ + 512 + (h >> 2) * 64; U.K2 = nullptr; U.V = PRJ + 640 + (h >> 2) * 64;
            U.O = OUTPROJ_F8 ? (bf16_t*)((unsigned char*)OB + (size_t)qrow0 * 1024 + h * 64) : OB + (size_t)qrow0 * 1024 + h * 64; U.rowa = NLAT + b * NCX; U.nta = 4; U.rowb = b * SEQ + ks; U.ntb = (ke - ks) / 64;
            U.window = isctx ? 0 : 1; U.qpos0 = qb * 256; U.kposb0 = ks; U.sink = p.swa_sink[h]; U.has_sink = 1; U.tab = isctx ? nullptr : (const float*)(tabs + TAB_A); U.pos0 = qb * 256; U.qg = nullptr;
            fa::attn_unit<64, 64, PRJ_LD, PRJ_LD, PRJ_LD, 1024, true, 0, 2, false, false, OUTPROJ_F8 != 0>(tid, U, (char*)lds_raw); }
    }
    SEAM(5);

    if (IN(6)) { PHASE_PTRS
        constexpr size_t ES_ = OUTPROJ_F8 ? 1 : 2;
        pg8::DenseOrder S{(const char*)OB, (const char*)(wts + WO_ABO), NROW / 256, 4, G, bid, (size_t)256 * 1024 * ES_, (size_t)256 * 1024 * ES_};
        pg8::EpiResidT<float, xr_t> E{p.x, p.ctx, XR, MOD + 2048, OUTPROJ_F8 ? 0.03125f : 1.0f};
        pg8::gemm_phase<pg8::EpiResidT<float, xr_t>, pg8::DenseOrder, true, true, OUTPROJ_F8 != 0>(tid, LDSB, 1024, 1024, S, E);
    }
    SEAM(6);

    typedef float f4a_ __attribute__((ext_vector_type(4)));
#define GLD4(dst, ptr, off) asm volatile("global_load_dwordx4 %0, %1, off offset:" #off : "=v"(dst) : "v"(ptr) : "memory")
#if XR16
#define XR_LOADS(xp_) GLD4(xn0_, xp_, 0); GLD4(xn1_, xp_, 16); GLD4(xn2_, xp_, 32); GLD4(xn3_, xp_, 48); xn4_ = xn0_; xn5_ = xn0_; xn6_ = xn0_; xn7_ = xn0_
#define XR_WAIT_MOD "s_waitcnt vmcnt(4)"
#define XR_UNPACK(v) _Pragma("unroll") for (int q = 0; q < 4; ++q) { const unsigned w0_ = __float_as_uint(xn0_[q]), w1_ = __float_as_uint(xn1_[q]), w2_ = __float_as_uint(xn2_[q]), w3_ = __float_as_uint(xn3_[q]); \
        v[0][2 * q] = __uint_as_float(w0_ << 16); v[0][2 * q + 1] = __uint_as_float(w0_ & 0xffff0000u); v[0][8 + 2 * q] = __uint_as_float(w1_ << 16); v[0][9 + 2 * q] = __uint_as_float(w1_ & 0xffff0000u); \
        v[1][2 * q] = __uint_as_float(w2_ << 16); v[1][2 * q + 1] = __uint_as_float(w2_ & 0xffff0000u); v[1][8 + 2 * q] = __uint_as_float(w3_ << 16); v[1][9 + 2 * q] = __uint_as_float(w3_ & 0xffff0000u); }
#else
#define XR_LOADS(xp_) GLD4(xn0_, xp_, 0); GLD4(xn1_, xp_, 16); GLD4(xn2_, xp_, 32); GLD4(xn3_, xp_, 48); GLD4(xn4_, xp_, 64); GLD4(xn5_, xp_, 80); GLD4(xn6_, xp_, 96); GLD4(xn7_, xp_, 112)
#define XR_WAIT_MOD "s_waitcnt vmcnt(8)"
#define XR_UNPACK(v) _Pragma("unroll") for (int q = 0; q < 4; ++q) { v[0][q] = xn0_[q]; v[0][4 + q] = xn1_[q]; v[0][8 + q] = xn2_[q]; v[0][12 + q] = xn3_[q]; v[1][q] = xn4_[q]; v[1][4 + q] = xn5_[q]; v[1][8 + q] = xn6_[q]; v[1][12 + q] = xn7_[q]; }
#endif
#define ROUTER_PHASE(L, nrows) do { \
        static_assert(XR16, "the two-rows-per-wave router reads the residual stream as bf16"); \
        { const float4* wsrc_ = (const float4*)(p.router_w + (size_t)(L) * 1024 * 32); float4* wl_ = (float4*)lds_raw; \
          for (int q = tid; q < 8192; q += NTHR) { const int c_ = q >> 3, e4_ = q & 7; wl_[(c_ ^ ((c_ >> 7) & 1)) * 8 + (e4_ ^ ((c_ >> 4) & 7))] = wsrc_[q]; } }        \
        __syncthreads(); \
        unsigned* cnt_ = ctl + CW_CNT + (L) * 32; \
        LAS unsigned* lcnt_ = (LAS unsigned*)(LDSB + LDS_MISC + 1024); LAS unsigned* lbase_ = lcnt_ + 32;       \
        if (tid < 32) lcnt_[tid] = 0u; \
        __syncthreads(); \
        const int half_ = lane >> 5, l5_ = lane & 31;                        \
        const float rb_ = p.router_b[(L) * 32 + l5_]; \
        const float4* wl_ = (const float4*)lds_raw + (size_t)(16 * lane) * 8; const int sw_ = lane & 7; \
        LAS unsigned* stash_ = (LAS unsigned*)(LDSB + 131072) + wave * 384;        \
        int it_ = 0; \
          \
        f4a_ xn0_, xn1_, xn2_, xn3_;                                         \
        { const int r = gw * 2 < (nrows) ? gw * 2 : 0; const xr_t* xp_ = XR + (size_t)r * 1024 + 16 * lane; GLD4(xn0_, xp_, 0); GLD4(xn1_, xp_, 16); GLD4(xn2_, xp_, 2048); GLD4(xn3_, xp_, 2064); } \
        for (int rp = gw; rp * 2 < (nrows); rp += NGW, ++it_) { const int r0 = rp * 2, r = r0 + half_; \
            const float* mr = MOD + (size_t)((L) * 17 + mod_row_of(r0)) * 6144 + 3072 + 16 * lane; const float* mr2 = mr + 1024; \
            asm volatile("s_waitcnt vmcnt(0)" : "+v"(xn0_), "+v"(xn1_), "+v"(xn2_), "+v"(xn3_) :: "memory"); \
            float v[2][16]; \
            _Pragma("unroll") for (int q = 0; q < 4; ++q) { const unsigned w0_ = __float_as_uint(xn0_[q]), w1_ = __float_as_uint(xn1_[q]), w2_ = __float_as_uint(xn2_[q]), w3_ = __float_as_uint(xn3_[q]); \
                v[0][2 * q] = __uint_as_float(w0_ << 16); v[0][2 * q + 1] = __uint_as_float(w0_ & 0xffff0000u); v[0][8 + 2 * q] = __uint_as_float(w1_ << 16); v[0][9 + 2 * q] = __uint_as_float(w1_ & 0xffff0000u); \
                v[1][2 * q] = __uint_as_float(w2_ << 16); v[1][2 * q + 1] = __uint_as_float(w2_ & 0xffff0000u); v[1][8 + 2 * q] = __uint_as_float(w3_ << 16); v[1][9 + 2 * q] = __uint_as_float(w3_ & 0xffff0000u); } \
            f4a_ sh0_, sh1_, sh2_, sh3_, sc0_, sc1_, sc2_, sc3_; \
            GLD4(sh0_, mr, 0); GLD4(sh1_, mr, 16); GLD4(sh2_, mr, 32); GLD4(sh3_, mr, 48); GLD4(sc0_, mr2, 0); GLD4(sc1_, mr2, 16); GLD4(sc2_, mr2, 32); GLD4(sc3_, mr2, 48); \
            { const int rn_ = (rp + NGW) * 2 < (nrows) ? (rp + NGW) * 2 : r0; const xr_t* xp_ = XR + (size_t)rn_ * 1024 + 16 * lane; GLD4(xn0_, xp_, 0); GLD4(xn1_, xp_, 16); GLD4(xn2_, xp_, 2048); GLD4(xn3_, xp_, 2064); }        \
            asm volatile("s_waitcnt vmcnt(4)" : "+v"(sh0_), "+v"(sh1_), "+v"(sh2_), "+v"(sh3_), "+v"(sc0_), "+v"(sc1_), "+v"(sc2_), "+v"(sc3_) :: "memory"); \
            float sh_[16], sc_[16]; \
            _Pragma("unroll") for (int q = 0; q < 4; ++q) { sh_[q] = sh0_[q]; sh_[4 + q] = sh1_[q]; sh_[8 + q] = sh2_[q]; sh_[12 + q] = sh3_[q]; sc_[q] = sc0_[q]; sc_[4 + q] = sc1_[q]; sc_[8 + q] = sc2_[q]; sc_[12 + q] = sc3_[q]; } \
            float ss0_ = 0.f, ss1_ = 0.f; \
            _Pragma("unroll") for (int j = 0; j < 16; ++j) { ss0_ = fmaf(v[0][j], v[0][j], ss0_); ss1_ = fmaf(v[1][j], v[1][j], ss1_); } \
            ss0_ = half_sum32(ss0_); ss1_ = half_sum32(ss1_); \
            { const u32x2_t q0_ = __builtin_amdgcn_permlane32_swap(__float_as_uint(ss0_), __float_as_uint(ss0_), false, false); ss0_ = __uint_as_float(q0_[0]) + __uint_as_float(q0_[1]); \
              const u32x2_t q1_ = __builtin_amdgcn_permlane32_swap(__float_as_uint(ss1_), __float_as_uint(ss1_), false, false); ss1_ = __uint_as_float(q1_[0]) + __uint_as_float(q1_[1]); } \
            const float ri0_ = 1.0f / sqrtf(ss0_ * (1.0f / 1024.0f) + RMS_EPS), ri1_ = 1.0f / sqrtf(ss1_ * (1.0f / 1024.0f) + RMS_EPS); \
            _Pragma("unroll") for (int j = 0; j < 16; ++j) { v[0][j] = (v[0][j] * ri0_) * sc_[j] + sh_[j]; v[1][j] = (v[1][j] * ri1_) * sc_[j] + sh_[j]; }        \
            st16f8((unsigned char*)H + (size_t)r0 * 1024 + 16 * lane, v[0]); st16f8((unsigned char*)H + (size_t)(r0 + 1) * 1024 + 16 * lane, v[1]);        \
            if (lane & 8) { _Pragma("unroll") for (int hh = 0; hh < 2; ++hh) _Pragma("unroll") for (int j = 0; j < 16; j += 2) { const float t_ = v[hh][j]; v[hh][j] = v[hh][j + 1]; v[hh][j + 1] = t_; } }        \
            float acc0[32], acc1[32]; \
            _Pragma("unroll") for (int e = 0; e < 32; ++e) { acc0[e] = 0.f; acc1[e] = 0.f; } \
            _Pragma("unroll") for (int j = 0; j < 16; ++j) { \
                _Pragma("unroll") for (int e4 = 0; e4 < 8; ++e4) { const float4 w = wl_[j * 8 + (e4 ^ sw_)]; \
                    acc0[4 * e4] = fmaf(v[0][j], w.x, acc0[4 * e4]); acc0[4 * e4 + 1] = fmaf(v[0][j], w.y, acc0[4 * e4 + 1]); acc0[4 * e4 + 2] = fmaf(v[0][j], w.z, acc0[4 * e4 + 2]); acc0[4 * e4 + 3] = fmaf(v[0][j], w.w, acc0[4 * e4 + 3]); \
                    acc1[4 * e4] = fmaf(v[1][j], w.x, acc1[4 * e4]); acc1[4 * e4 + 1] = fmaf(v[1][j], w.y, acc1[4 * e4 + 1]); acc1[4 * e4 + 2] = fmaf(v[1][j], w.z, acc1[4 * e4 + 2]); acc1[4 * e4 + 3] = fmaf(v[1][j], w.w, acc1[4 * e4 + 3]); } } \
            float acc[32];                                                   \
            _Pragma("unroll") for (int e = 0; e < 32; ++e) { const u32x2_t q_ = __builtin_amdgcn_permlane32_swap(__float_as_uint(acc0[e]), __float_as_uint(acc1[e]), false, false); acc[e] = __uint_as_float(q_[0]) + __uint_as_float(q_[1]); } \
            float tv[4]; int ti[4]; route_reduce32(acc, l5_, rb_, tv, ti); \
            const float e1 = expf(tv[1] - tv[0]), e2 = expf(tv[2] - tv[0]), e3 = expf(tv[3] - tv[0]); const float inv = 1.0f / (1.0f + e1 + e2 + e3); \
            if (l5_ < 4) { const int ek = l5_ == 0 ? ti[0] : l5_ == 1 ? ti[1] : l5_ == 2 ? ti[2] : ti[3]; const float gk = (l5_ == 0 ? 1.0f : l5_ == 1 ? e1 : l5_ == 2 ? e2 : e3) * inv; \
                const unsigned pos = __hip_atomic_fetch_add(lcnt_ + ek, 1u, __ATOMIC_RELAXED, __HIP_MEMORY_SCOPE_WORKGROUP); TOKE[r * 4 + l5_] = ek; TOKG[r * 4 + l5_] = gk; \
                stash_[it_ * 8 + half_ * 4 + l5_] = (unsigned)ek | (pos << 8); } \
        } \
        asm volatile("s_waitcnt vmcnt(0)" : "+v"(xn0_), "+v"(xn1_), "+v"(xn2_), "+v"(xn3_) :: "memory");        \
        __syncthreads(); \
        if (tid < 32) lbase_[tid] = atomicAdd(cnt_ + tid, lcnt_[tid]); \
        __syncthreads(); \
        for (int e_ = lane; e_ < it_ * 8; e_ += 64) { const unsigned w_ = stash_[e_]; const int r = (gw + (e_ >> 3) * NGW) * 2 + ((e_ >> 2) & 1); TOKP[r * 4 + (e_ & 3)] = (int)((w_ >> 8) + lbase_[w_ & 255u]); } \
    } while (0)

#define EXCL_SETUP(L) \
        const int c_ = lane < 32 ? (int)ctl[CW_CNT + (L) * 32 + lane] : 0; const int padc_ = (c_ + 255) / 256 * 256; int pre_ = padc_; \
        _Pragma("unroll") for (int o_ = 1; o_ < 32; o_ <<= 1) { const int t_ = __shfl_up(pre_, o_); if ((lane & 31) >= o_) pre_ += t_; } \
        const int excl_ = pre_ - padc_;
#define PERMUTE_PHASE(L, nrows) do { EXCL_SETUP(L) \
        ROWS2(nrows) { ROWS2_IDX(nrows) \
            const int ra_ = rr_[0], rb_ = rr_[1]; \
            const uint4* sa_ = (const uint4*)(H + (size_t)ra_ * 1024) + lane * 2; const uint4* sb_ = (const uint4*)(H + (size_t)rb_ * 1024) + lane * 2; \
            const uint4 a0_ = sa_[0], a1_ = sa_[1], b0_ = sb_[0], b1_ = sb_[1]; \
            const int4 ea_ = *(const int4*)(TOKE + ra_ * 4), pa_ = *(const int4*)(TOKP + ra_ * 4), eb_ = *(const int4*)(TOKE + rb_ * 4), pb_ = *(const int4*)(TOKP + rb_ * 4); \
            const int sa0 = __shfl(excl_, ea_.x) + pa_.x, sa1 = __shfl(excl_, ea_.y) + pa_.y, sa2 = __shfl(excl_, ea_.z) + pa_.z, sa3 = __shfl(excl_, ea_.w) + pa_.w; \
            const int sb0 = __shfl(excl_, eb_.x) + pb_.x, sb1 = __shfl(excl_, eb_.y) + pb_.y, sb2 = __shfl(excl_, eb_.z) + pb_.z, sb3 = __shfl(excl_, eb_.w) + pb_.w; \
            { uint4* d_ = (uint4*)(XS + (size_t)sa0 * 1024) + lane * 2; d_[0] = a0_; d_[1] = a1_; } { uint4* d_ = (uint4*)(XS + (size_t)sa1 * 1024) + lane * 2; d_[0] = a0_; d_[1] = a1_; } \
            { uint4* d_ = (uint4*)(XS + (size_t)sa2 * 1024) + lane * 2; d_[0] = a0_; d_[1] = a1_; } { uint4* d_ = (uint4*)(XS + (size_t)sa3 * 1024) + lane * 2; d_[0] = a0_; d_[1] = a1_; } \
            if (two_) { \
            { uint4* d_ = (uint4*)(XS + (size_t)sb0 * 1024) + lane * 2; d_[0] = b0_; d_[1] = b1_; } { uint4* d_ = (uint4*)(XS + (size_t)sb1 * 1024) + lane * 2; d_[0] = b0_; d_[1] = b1_; } \
            { uint4* d_ = (uint4*)(XS + (size_t)sb2 * 1024) + lane * 2; d_[0] = b0_; d_[1] = b1_; } { uint4* d_ = (uint4*)(XS + (size_t)sb3 * 1024) + lane * 2; d_[0] = b0_; d_[1] = b1_; } } } \
        for (int e = 0; e < 32; ++e) { const int ce = __shfl(c_, e), be = __shfl(excl_, e), pe = __shfl(padc_, e); \
            for (int rr = ce + gw; rr < pe; rr += NGW) { uint4* d_ = (uint4*)(XS + (size_t)(be + rr) * 1024) + lane * 2; d_[0] = make_uint4(0u, 0u, 0u, 0u); d_[1] = make_uint4(0u, 0u, 0u, 0u); } } \
    } while (0)
#define PERMUTE_PHASE_F8(L, nrows) do { EXCL_SETUP(L) \
        unsigned char* XS8 = (unsigned char*)XS; \
        for (int r = gw; r < (nrows); r += NGW) { \
            const int4 ov_ = *((const int4*)((const unsigned char*)H + (size_t)r * 1024) + lane); \
            _Pragma("unroll") for (int k = 0; k < 4; ++k) { const int ek = TOKE[r * 4 + k], pk = TOKP[r * 4 + k]; const int slot = __shfl(excl_, ek) + pk; \
                *((int4*)(XS8 + (size_t)slot * 1024) + lane) = ov_; if (lane == 0) TOKP[r * 4 + k] = slot; } }        \
        for (int e = 0; e < 32; ++e) { const int ce = __shfl(c_, e), be = __shfl(excl_, e), pe = __shfl(padc_, e); \
            for (int rr = ce + gw; rr < pe; rr += NGW) *((int4*)(XS8 + (size_t)(be + rr) * 1024) + lane) = make_int4(0, 0, 0, 0); } \
    } while (0)
#define MOE_TABLE(L) \
        LAS int* tile_e = (LAS int*)(LDSB + LDS_MISC + 1024); LAS int* nm_p = tile_e + 640; \
        LAS int* tpre_ = nm_p + 1;                                       \
        __syncthreads(); \
        if (tid < 64) { const int c_ = lane < 32 ? (int)ctl[CW_CNT + (L) * 32 + lane] : 0; const int n_ = (c_ + 255) / 256; int pre_ = n_; \
            _Pragma("unroll") for (int o_ = 1; o_ < 32; o_ <<= 1) { const int t_ = __shfl_up(pre_, o_); if ((lane & 31) >= o_) pre_ += t_; } \
            if (lane < 32) tpre_[lane] = pre_ - n_; if (lane == 31) { tpre_[32] = pre_; *nm_p = pre_; } } \
        __syncthreads(); \
        const int nM_ = __builtin_amdgcn_readfirstlane(*nm_p); \
        for (int t_ = tid; t_ < nM_; t_ += NTHR) { int e_ = 0; _Pragma("unroll") for (int q_ = 16; q_ >= 1; q_ >>= 1) { if (tpre_[e_ + q_] <= t_) e_ += q_; } tile_e[t_] = e_; }        \
        __syncthreads();
#define MOE_FAST1(L) do { MOE_TABLE(L) \
        pg8::MoeOrder S{(const char*)XS, (const char*)(wts + WO_W1) + (size_t)(L) * 32 * 2048 * 1024 * 2, tile_e, nM_, 8, G, bid, (size_t)256 * 1024 * 2, (size_t)2048 * 1024 * 2}; \
        pg8::EpiSwiglu E{ACT, p.moe_b_in + (size_t)(L) * 32 * 2048, 1.0f}; \
        pg8::gemm_phase<pg8::EpiSwiglu, pg8::MoeOrder, true, true>(tid, LDSB, 1024, 1024, S, E); } while (0)
#define MOE_FAST2(L) do { MOE_TABLE(L) \
        pg8::MoeOrder S{(const char*)ACT, (const char*)(wts + WO_W2) + (size_t)(L) * 32 * 1024 * 1024 * 2, tile_e, nM_, 4, G, bid, (size_t)256 * 1024 * 2, (size_t)1024 * 1024 * 2}; \
        pg8::EpiBiasBf16 E{Y, p.moe_b_out + (size_t)(L) * 32 * 1024, 1.0f}; \
        pg8::gemm_phase<pg8::EpiBiasBf16, pg8::MoeOrder, true, true>(tid, LDSB, 1024, 1024, S, E); } while (0)
#define MOE_FAST1_F8(L) do { MOE_TABLE(L) \
        pg8::MoeOrder S{(const char*)XS, (const char*)(wts + WO_W1) + (size_t)(L) * 32 * 2048 * 1024 * 2, tile_e, nM_, 8, G, bid, (size_t)256 * 1024, (size_t)2048 * 1024}; \
        if constexpr (MOE_F8_DOWN) { pg8::EpiSwigluF8 E{(unsigned char*)ACT, p.moe_b_in + (size_t)(L) * 32 * 2048}; \
            pg8::gemm_phase<pg8::EpiSwigluF8, pg8::MoeOrder, true, true, true>(tid, LDSB, 1024, 1024, S, E); } \
        else { pg8::EpiSwiglu E{ACT, p.moe_b_in + (size_t)(L) * 32 * 2048, 0.03125f}; \
            pg8::gemm_phase<pg8::EpiSwiglu, pg8::MoeOrder, false, true, true>(tid, LDSB, 1024, 1024, S, E); } } while (0)
#define MOE_FAST2_F8(L) do { MOE_TABLE(L) \
        pg8::MoeOrder S{(const char*)ACT, (const char*)(wts + WO_W2) + (size_t)(L) * 32 * 1024 * 1024 * 2, tile_e, nM_, 4, G, bid, (size_t)256 * 1024, (size_t)1024 * 1024}; \
        if constexpr ((Y8_L1 && (L) == 1) || (Y8_L0 && (L) == 0)) { pg8::EpiBiasF8 E{(unsigned char*)Y, p.moe_b_out + (size_t)(L) * 32 * 1024, 0.03125f}; \
            pg8::gemm_phase<pg8::EpiBiasF8, pg8::MoeOrder, true, true, true>(tid, LDSB, 1024, 1024, S, E); } \
        else { pg8::EpiBiasBf16 E{Y, p.moe_b_out + (size_t)(L) * 32 * 1024, 0.03125f}; \
            pg8::gemm_phase<pg8::EpiBiasBf16, pg8::MoeOrder, true, true, true>(tid, LDSB, 1024, 1024, S, E); } } while (0)
#define COMBINE_PRE(nrows) typedef int i4n_ __attribute__((ext_vector_type(4))); typedef float f4n_ __attribute__((ext_vector_type(4))); i4n_ sl0_, sl1_; f4n_ gt0_, gt1_; \
        { const int ra_ = gw < (nrows) ? gw : 0, rb_ = gw + NGW < (nrows) ? gw + NGW : ra_; sl0_ = *(const i4n_*)(TOKP + ra_ * 4); gt0_ = *(const f4n_*)(TOKG + ra_ * 4); sl1_ = *(const i4n_*)(TOKP + rb_ * 4); gt1_ = *(const f4n_*)(TOKG + rb_ * 4); }
#define COMBINE_ROWS2(L, v, nrows, F8Y) do { \
        const int slc_[2][4] = {{sl0_[0], sl0_[1], sl0_[2], sl0_[3]}, {sl1_[0], sl1_[1], sl1_[2], sl1_[3]}}; \
        const float gk_[2][4] = {{gt0_[0], gt0_[1], gt0_[2], gt0_[3]}, {gt1_[0], gt1_[1], gt1_[2], gt1_[3]}}; \
        uint4 ya_[2][4], yb_[2][4]; \
        _Pragma("unroll") for (int u = 0; u < 2; ++u) { const int r = rr_[u]; \
            _Pragma("unroll") for (int k = 0; k < 4; ++k) { \
                if constexpr (F8Y) { ya_[u][k] = *((const uint4*)((const unsigned char*)Y + (size_t)slc_[u][k] * 1024) + lane); yb_[u][k] = ya_[u][k]; } \
                else { const uint4* yr = (const uint4*)(Y + (size_t)slc_[u][k] * 1024 + 16 * lane); ya_[u][k] = yr[0]; yb_[u][k] = yr[1]; } } \
            ld16x(XR + (size_t)r * 1024 + 16 * lane, v[u]); } \
        { const int n0_ = r0_ + 2 * NGW; if (n0_ < (nrows)) { const int n1_ = n0_ + NGW < (nrows) ? n0_ + NGW : n0_; \
            sl0_ = *(const i4n_*)(TOKP + n0_ * 4); gt0_ = *(const f4n_*)(TOKG + n0_ * 4); sl1_ = *(const i4n_*)(TOKP + n1_ * 4); gt1_ = *(const f4n_*)(TOKG + n1_ * 4); } } \
        _Pragma("unroll") for (int u = 0; u < 2; ++u) { float f_[16]; \
            _Pragma("unroll") for (int j = 0; j < 16; ++j) f_[j] = 0.f; \
            _Pragma("unroll") for (int k = 0; k < 4; ++k) { \
                if constexpr (F8Y) { const int yw[4] = {(int)ya_[u][k].x, (int)ya_[u][k].y, (int)ya_[u][k].z, (int)ya_[u][k].w}; \
                    _Pragma("unroll") for (int j = 0; j < 4; ++j) { const auto lo_ = __builtin_amdgcn_cvt_pk_f32_fp8(yw[j], false); const auto hi_ = __builtin_amdgcn_cvt_pk_f32_fp8(yw[j], true); \
                        f_[4 * j] = fmaf(gk_[u][k], lo_[0], f_[4 * j]); f_[4 * j + 1] = fmaf(gk_[u][k], lo_[1], f_[4 * j + 1]); f_[4 * j + 2] = fmaf(gk_[u][k], hi_[0], f_[4 * j + 2]); f_[4 * j + 3] = fmaf(gk_[u][k], hi_[1], f_[4 * j + 3]); } } \
                else { const unsigned yw[8] = {ya_[u][k].x, ya_[u][k].y, ya_[u][k].z, ya_[u][k].w, yb_[u][k].x, yb_[u][k].y, yb_[u][k].z, yb_[u][k].w}; \
                    _Pragma("unroll") for (int j = 0; j < 8; ++j) { f_[2 * j] = fmaf(gk_[u][k], __uint_as_float(yw[j] << 16), f_[2 * j]); f_[2 * j + 1] = fmaf(gk_[u][k], __uint_as_float(yw[j] & 0xffff0000u), f_[2 * j + 1]); } } } \
            float g2v_[16]; ld16f(MOD + (size_t)((L) * 17 + mod_row_of(rr_[u])) * 6144 + 5120 + 16 * lane, g2v_);        \
            _Pragma("unroll") for (int j = 0; j < 16; ++j) v[u][j] = fmaf(g2v_[j], f_[j], v[u][j]); } } while (0)

    if (IN(7)) { PHASE_PTRS ROUTER_PHASE(0, NROW); }
    SEAM(7);
#if MOE_F8_L0
    if (IN(8)) { PHASE_PTRS PERMUTE_PHASE_F8(0, NROW); }
    SEAM(8);
    if (IN(9)) { PHASE_PTRS MOE_FAST1_F8(0); }
    SEAM(9);
#else
    if (IN(8)) { PHASE_PTRS PERMUTE_PHASE(0, NROW); }
    SEAM(8);
    if (IN(9)) { PHASE_PTRS MOE_FAST1(0); }
    SEAM(9);
#endif
    if (IN(10)) { PHASE_PTRS if constexpr (MOE_F8_L0 && MOE_F8_DOWN) { MOE_FAST2_F8(0); } else { MOE_FAST2(0); } }
    SEAM(10);

    if (IN(11)) { PHASE_PTRS
        float g[16]; ld16f(p.norm_mix_g + 1024 + 16 * lane, g);
        COMBINE_PRE(NROW)
        ROWS2(NROW) { ROWS2_IDX(NROW)
            float v[2][16]; COMBINE_ROWS2(0, v, NROW, (Y8_L0 && MOE_F8_L0 && MOE_F8_DOWN));
            st16x(XR + (size_t)rr_[0] * 1024 + 16 * lane, v[0]); if (two_) st16x(XR + (size_t)rr_[1] * 1024 + 16 * lane, v[1]);
            const float* mr0 = MOD + (size_t)(1 * 17 + mod_row_of(rr_[0])) * 6144 + 16 * lane; const float* mr1 = MOD + (size_t)(1 * 17 + mod_row_of(rr_[1])) * 6144 + 16 * lane;
            NORM_MOD16x2(v, g, mr0, mr1);
            if (INPROJ_F8) { st16f8((unsigned char*)H + (size_t)rr_[0] * 1024 + 16 * lane, v[0]); if (two_) st16f8((unsigned char*)H + (size_t)rr_[1] * 1024 + 16 * lane, v[1]); }
            else { st16bf(H + (size_t)rr_[0] * 1024 + 16 * lane, v[0]); if (two_) st16bf(H + (size_t)rr_[1] * 1024 + 16 * lane, v[1]); }
        }
    }
    SEAM(11);

    if (IN(12)) { PHASE_PTRS
        constexpr size_t ES_ = INPROJ_F8 ? 1 : 2;
        pg8::DenseOrder S{(const char*)H, (const char*)(wts + WO_C), NROW / 256, 6, G, bid, (size_t)256 * 1024 * ES_, (size_t)256 * 1024 * ES_};
        pg8::EpiStoreBf16 E{PRJ, PRJ_LD, INPROJ_F8 ? 0.03125f : 1.0f};
        pg8::gemm_phase<pg8::EpiStoreBf16, pg8::DenseOrder, true, true, INPROJ_F8 != 0>(tid, LDSB, 1024, 1024, S, E);
    }
    SEAM(12);

    if (IN(13)) { PHASE_PTRS
        const float2* TC = (const float2*)(tabs + TAB_C); const float kg1 = p.c_k_g[lane], kg2 = p.c_k_g[64 + lane];
        for (int r = gw; r < NROW; r += NGW) {
            bf16_t* pr = PRJ + (size_t)r * PRJ_LD + 1024; float2 t = make_float2(1.f, 0.f); if (r < NLAT) t = TC[(r % SEQ) * 64 + lane];
#pragma unroll
            for (int kv = 0; kv < 2; ++kv) { float x1 = bf2f(pr[kv * 128 + lane]), x2 = bf2f(pr[kv * 128 + 64 + lane]);
                const float ss = wave_sum(x1 * x1 + x2 * x2); const float ri = 1.0f / sqrtf(ss * (1.0f / 128.0f) + RMS_EPS);
                x1 = x1 * ri * kg1; x2 = x2 * ri * kg2;
                pr[kv * 128 + lane] = f2bf(x1 * t.x - x2 * t.y); pr[kv * 128 + 64 + lane] = f2bf(x2 * t.x + x1 * t.y); }
        }
    }
    SEAM(13);

    if (IN(14)) { PHASE_PTRS
        for (int i = 0;; ++i) { const int u = i * G + bid; if (u >= 1024) break;
            const int rest = u >> 3; const int b = 2 * (u & 7) + (rest >> 6), h = (rest & 63) >> 3, qb = rest & 7; const int qrow0 = b * SEQ + qb * 256;
            fa::Unit U; U.Q = PRJ + (size_t)qrow0 * PRJ_LD + h * 128; U.K = PRJ + 1024 + (h >> 2) * 128; U.K2 = nullptr; U.V = PRJ + 1280 + (h >> 2) * 128;
            U.O = OUTPROJ_F8 ? (bf16_t*)((unsigned char*)OB + (size_t)qrow0 * 1024 + h * 128) : OB + (size_t)qrow0 * 1024 + h * 128; U.rowa = NLAT + b * NCX; U.nta = 4; U.rowb = b * SEQ; U.ntb = 32;
            U.window = 0; U.qpos0 = 0; U.kposb0 = 0; U.sink = 0.f; U.has_sink = 0; U.tab = (const float*)(tabs + TAB_C); U.pos0 = qb * 256; U.qg = (const float*)(tabs + TAB_QG);
            fa::attn_unit<128, 128, PRJ_LD, PRJ_LD, PRJ_LD, 1024, false, 0, 4, true, false, OUTPROJ_F8 != 0>(tid, U, (char*)lds_raw); }
    }
    SEAM(14);

    if (IN(15)) { PHASE_PTRS
        constexpr size_t ES_ = OUTPROJ_F8 ? 1 : 2;
        pg8::DenseOrder S{(const char*)OB, (const char*)(wts + WO_CO), NLAT / 256, 4, G, bid, (size_t)256 * 1024 * ES_, (size_t)256 * 1024 * ES_};
        pg8::EpiResidT<xr_t, xr_t> E{XR, XR, XR, MOD + 17 * 6144 + 2048, OUTPROJ_F8 ? 0.03125f : 1.0f};
        pg8::gemm_phase<pg8::EpiResidT<xr_t, xr_t>, pg8::DenseOrder, true, true, OUTPROJ_F8 != 0>(tid, LDSB, 1024, 1024, S, E);
    }
    SEAM(15);

    if (IN(16)) { PHASE_PTRS ROUTER_PHASE(1, NLAT); }
    SEAM(16);
#if MOE_F8_L1
    if (IN(17)) { PHASE_PTRS PERMUTE_PHASE_F8(1, NLAT); }
    SEAM(17);
    if (IN(18)) { PHASE_PTRS MOE_FAST1_F8(1); }
    SEAM(18);
    if (IN(19)) { PHASE_PTRS if constexpr (MOE_F8_DOWN) { MOE_FAST2_F8(1); } else { MOE_FAST2(1); } }
    SEAM(19);
#else
    if (IN(17)) { PHASE_PTRS PERMUTE_PHASE(1, NLAT); }
    SEAM(17);
    if (IN(18)) { PHASE_PTRS MOE_FAST1(1); }
    SEAM(18);
    if (IN(19)) { PHASE_PTRS MOE_FAST2(1); }
    SEAM(19);
#endif

    if (IN(20)) { PHASE_PTRS
        COMBINE_PRE(NLAT)
        ROWS2(NLAT) { ROWS2_IDX(NLAT)
            float v[2][16]; COMBINE_ROWS2(1, v, NLAT, (Y8_L1 && MOE_F8_L1 && MOE_F8_DOWN));
            float s0 = 0.f, s1 = 0.f;
#pragma unroll
            for (int j = 0; j < 16; ++j) { s0 = fmaf(v[0][j], v[0][j], s0); s1 = fmaf(v[1][j], v[1][j], s1); }
            wave_sum2(s0, s1); const float ri0 = 1.0f / sqrtf(s0 * (1.0f / 1024.0f) + RMS_EPS), ri1 = 1.0f / sqrtf(s1 * (1.0f / 1024.0f) + RMS_EPS);
            int ln_ = lane; asm volatile("" : "+v"(ln_));
            float g[16]; ld16f(p.final_g + 16 * ln_, g);
#pragma unroll
            for (int j = 0; j < 16; ++j) { v[0][j] = v[0][j] * ri0 * g[j]; v[1][j] = v[1][j] * ri1 * g[j]; }
            st16f(p.out + (size_t)rr_[0] * 1024 + 16 * ln_, v[0]); if (two_) st16f(p.out + (size_t)rr_[1] * 1024 + 16 * ln_, v[1]);
        }
    }
#undef IN
#undef SEAM
}

#ifndef MK_PER_PHASE
#define MK_PER_PHASE 0
#endif
extern "C" void kernel_launch(void* const* d_in, const int* in_sizes, int n_in, void* d_out, int out_size, void* d_ws, size_t ws_size, hipStream_t stream) {
    static int grid = 0;
    if (grid == 0) {
        if (n_in != 26 || out_size != NLAT * DM || ws_size < WS_END) { fprintf(stderr, "kernel_launch: unexpected shapes (n_in %d out %d ws %zu need %zu)\n", n_in, out_size, ws_size, (size_t)WS_END); grid = -1; return; }
        int dev = 0, cus = 0;
        if (hipGetDevice(&dev) != hipSuccess || hipDeviceGetAttribute(&cus, hipDeviceAttributeMultiprocessorCount, dev) != hipSuccess) { grid = -1; return; }
        if (hipFuncSetAttribute((const void*)fwd_kernel, hipFuncAttributeMaxDynamicSharedMemorySize, LDS_BYTES) != hipSuccess) { fprintf(stderr, "kernel_launch: hipFuncSetAttribute failed\n"); grid = -1; return; }
        int per_cu = 0;
        if (hipOccupancyMaxActiveBlocksPerMultiprocessor(&per_cu, (const void*)fwd_kernel, NTHR, LDS_BYTES) != hipSuccess || per_cu < 1) { fprintf(stderr, "kernel_launch: occupancy query says %d\n", per_cu); }
        (void)hipGetLastError();
        grid = cus;
    }
    if (grid < 0) return;
    (void)hipMemsetAsync((char*)d_ws + WS_CTL, 0, CTL_BYTES, stream);
    Params p{};
    const float** pp = (const float**)&p;
    for (int i = 0; i < 26; ++i) pp[i] = (const float*)d_in[i];
    p.out = (float*)d_out; p.ws = (unsigned char*)d_ws;
#if MK_PER_PHASE
    for (int k = 0; k < N_PHASES; ++k) { p.ph_lo = k; p.ph_hi = k + 1; hipLaunchKernelGGL(fwd_kernel, dim3(grid), dim3(NTHR), LDS_BYTES, stream, p); }
#else
    p.ph_lo = 0; p.ph_hi = N_PHASES;
    hipLaunchKernelGGL(fwd_kernel, dim3(grid), dim3(NTHR), LDS_BYTES, stream, p);
#endif
}
```
